# Optimizing an MI355X kernel written in HIP

```python
import jax
import jax.numpy as jnp
from jax import lax
import numpy as np

D_MODEL = 1024
BATCH = 1
SEQ = 16384
DEPTH = 1

GRID_W = 64
CTX_LEN = 256
D_MIX = D_MODEL
D_RWKV = D_MIX // 2
RWKV_HEAD = 64
RWKV_HEADS = D_RWKV // RWKV_HEAD
D_POOL = D_MIX - D_RWKV
POOL_WINDOWS = (2, 4, 8, 16)
POOL_GROUPS = len(POOL_WINDOWS)
POOL_GW = D_POOL // POOL_GROUPS
DECAY_LORA = 64
AAA_LORA = 64
GATE_LORA = 128
RWKV_SIZES = (D_RWKV, D_RWKV, D_RWKV, DECAY_LORA, DECAY_LORA, AAA_LORA, AAA_LORA, GATE_LORA)
D_SHIFT = sum(RWKV_SIZES)
D_IN = D_SHIFT + D_POOL
N_GROUPS = 4
EXPERTS_PER_GROUP = 8
N_EXPERTS = N_GROUPS * EXPERTS_PER_GROUP
TOP_K = 2
D_EXPERT = 512
MOE_BLOCK = 128
NORM_EPS = 1e-6
GN_EPS = 64e-5
POS_THETA = 10000.0
DECAY_SCALE = 0.6065306597

kernel_name = 'hymba_rwkv7_pool_hmoe_dit_block'


def _rmsnorm(h, g):
    hf = h.astype(jnp.float32)
    hf = hf * lax.rsqrt(jnp.mean(hf * hf, axis=-1, keepdims=True) + NORM_EPS)
    return (hf * g.astype(jnp.float32)).astype(h.dtype)


def _modulate(h, shift, scale):
    return h * (1 + scale[:, None, :]) + shift[:, None, :]


def _grid_pos_embed(rows, d):
    quarter = d // 4
    freq = POS_THETA ** (-jnp.arange(quarter, dtype=jnp.float32) / quarter)
    row = jnp.repeat(jnp.arange(rows, dtype=jnp.float32), GRID_W)[:, None] * freq
    col = jnp.tile(jnp.arange(GRID_W, dtype=jnp.float32), rows)[:, None] * freq
    return jnp.concatenate([jnp.sin(row), jnp.cos(row), jnp.sin(col), jnp.cos(col)], axis=-1)


def _centred_shift(h, mu):
    zero = jnp.zeros_like(h[:, :1])
    prev = jnp.concatenate([zero, h[:, :-1]], axis=1)
    nxt = jnp.concatenate([h[:, 1:], zero], axis=1)
    return h + mu * (0.5 * (prev + nxt) - h)


def _rwkv_features(u, mu, w0_f, w2_f, w0_b, w2_b, a0_f, a2_f, a0_b, a2_b, g2, k_k, k_a):
    B, T, _ = u.shape
    s = _centred_shift(u[..., :D_SHIFT], mu).astype(jnp.float32)
    cuts = np.cumsum(RWKV_SIZES)[:-1].tolist()
    r, k, v, wl_f, wl_b, al_f, al_b, gl = jnp.split(s, cuts, axis=-1)

    def heads(t):
        return t.reshape(B, T, RWKV_HEADS, RWKV_HEAD)

    def decay(wl, w0, w2):
        return jnp.exp(-DECAY_SCALE * jax.nn.sigmoid(w0 + jnp.tanh(wl) @ w2))

    w_f = decay(wl_f, w0_f, w2_f)
    w_b = decay(wl_b, w0_b, w2_b)
    a_f = jax.nn.sigmoid(a0_f + al_f @ a2_f)
    a_b = jax.nn.sigmoid(a0_b + al_b @ a2_b)
    g = jax.nn.sigmoid(gl) @ g2
    kk = heads(k * k_k)
    kk = kk / jnp.maximum(jnp.sqrt(jnp.sum(kk * kk, axis=-1, keepdims=True)), 1e-12)
    k_f = k * (1 + (a_f - 1) * k_a)
    k_b = k * (1 + (a_b - 1) * k_a)
    return {'r': heads(r), 'v': heads(v), 'kk': kk, 'g': g,
            'k_f': heads(k_f), 'w_f': heads(w_f), 'a_f': heads(a_f),
            'k_b': heads(k_b), 'w_b': heads(w_b), 'a_b': heads(a_b)}


def _rwkv7_scan(s0, r, w, k, v, kk, a, reverse):
    xs = tuple(jnp.moveaxis(t.astype(jnp.float32), 1, 0) for t in (r, w, k, v, kk, a))

    def step(S, inp):
        r_t, w_t, k_t, v_t, kk_t, a_t = inp
        sa = jnp.einsum('bhij,bhj->bhi', S, -kk_t)
        S = (S * w_t[:, :, None, :] + sa[..., None] * (kk_t * a_t)[:, :, None, :]
             + v_t[..., None] * k_t[:, :, None, :])
        return S, jnp.einsum('bhij,bhj->bhi', S, r_t)

    s_final, ys = lax.scan(step, s0, xs, reverse=reverse)
    return s_final, jnp.moveaxis(ys, 0, 1)


def _rwkv_stream(f, s0_f, s0_b, r_k_f, r_k_b, gn_w, gn_b, readout):
    s_f, y_f = _rwkv7_scan(s0_f, f['r'], f['w_f'], f['k_f'], f['v'], f['kk'], f['a_f'], False)
    s_b, y_b = _rwkv7_scan(s0_b, f['r'], f['w_b'], f['k_b'], f['v'], f['kk'], f['a_b'], True)
    if not readout:
        return None, s_f, s_b
    B, T, H, N = y_f.shape
    y = y_f + y_b
    mean = jnp.mean(y, axis=-1, keepdims=True)
    var = jnp.mean(jnp.square(y - mean), axis=-1, keepdims=True)
    y = ((y - mean) * lax.rsqrt(var + GN_EPS)).reshape(B, T, D_RWKV) * gn_w + gn_b
    bonus = (jnp.sum(f['r'] * f['k_f'] * r_k_f.reshape(H, N), axis=-1, keepdims=True)
             + jnp.sum(f['r'] * f['k_b'] * r_k_b.reshape(H, N), axis=-1, keepdims=True)) * f['v']
    return (y + bonus.reshape(B, T, D_RWKV)) * f['g'], s_f, s_b


def _centred_window_mean(h, win):
    T = h.shape[1]
    cs = jnp.concatenate([jnp.zeros_like(h[:, :1]), jnp.cumsum(h, axis=1)], axis=1)
    t = jnp.arange(T)
    lo = jnp.clip(t - win // 2, 0, T)
    hi = jnp.clip(t - win // 2 + win, 0, T)
    return (cs[:, hi] - cs[:, lo]) / (hi - lo).astype(h.dtype)[None, :, None]


def _pool_mixer(p, w_pool, pool_scale):
    B, T, _ = p.shape
    grp = p.reshape(B, T, POOL_GROUPS, POOL_GW).astype(jnp.float32)
    pooled = jnp.stack([_centred_window_mean(grp[:, :, i], win) for i, win in enumerate(POOL_WINDOWS)],
                       axis=2) - grp
    mixed = jnp.einsum('btgc,gcd->btgd', pooled, w_pool)
    return mixed.reshape(B, T, D_POOL) * pool_scale


def _hier_moe(h, w_rg, b_rg, w_re, b_re, w_gate, w_up, w_down):
    B, T, D = h.shape
    xt = h.reshape(-1, D)
    n = xt.shape[0]
    grp_logits = (xt @ w_rg + b_rg).astype(jnp.float32)
    grp = jnp.argmax(grp_logits, axis=-1)
    p_grp = jnp.take_along_axis(jax.nn.softmax(grp_logits, axis=-1), grp[:, None], axis=1)
    exp_logits = (xt @ w_re + b_re).astype(jnp.float32).reshape(n, N_GROUPS, EXPERTS_PER_GROUP)
    sel = jnp.take_along_axis(exp_logits, grp[:, None, None], axis=1)[:, 0]
    top_val, top_idx = lax.top_k(sel, TOP_K)
    gates = p_grp * jax.nn.softmax(top_val, axis=-1)
    expert = (grp[:, None] * EXPERTS_PER_GROUP + top_idx).astype(jnp.int32)

    m = n * TOP_K
    flat_e = expert.reshape(-1)
    flat_tok = jnp.repeat(jnp.arange(n, dtype=jnp.int32), TOP_K)
    flat_g = gates.reshape(-1)
    order = jnp.argsort(flat_e)
    se, stok, sg = flat_e[order], flat_tok[order], flat_g[order]
    counts = jax.ops.segment_sum(jnp.ones((m,), jnp.int32), flat_e, num_segments=N_EXPERTS)
    starts = jnp.cumsum(counts) - counts
    pcounts = (counts + MOE_BLOCK - 1) // MOE_BLOCK * MOE_BLOCK
    pends = jnp.cumsum(pcounts)
    pstarts = pends - pcounts
    dest = pstarts[se] + (jnp.arange(m, dtype=jnp.int32) - starts[se])
    n_blocks = (m + N_EXPERTS * (MOE_BLOCK - 1) + MOE_BLOCK - 1) // MOE_BLOCK
    P = n_blocks * MOE_BLOCK
    buf_tok = jnp.full((P,), n, jnp.int32).at[dest].set(stok)
    buf_g = jnp.zeros((P,), jnp.float32).at[dest].set(sg)
    blk_expert = jnp.minimum(
        jnp.searchsorted(pends, jnp.arange(n_blocks, dtype=jnp.int32) * MOE_BLOCK, side='right'),
        N_EXPERTS - 1).astype(jnp.int32)
    x_pad = jnp.concatenate([xt, jnp.zeros((1, D), xt.dtype)], axis=0)

    def run_block(args):
        tok, e = args
        xb = x_pad[tok]
        hid = jax.nn.silu(xb @ w_gate[e]) * (xb @ w_up[e])
        return hid @ w_down[e]

    yb = lax.map(run_block, (buf_tok.reshape(n_blocks, MOE_BLOCK), blk_expert))
    yb = yb.reshape(P, D) * buf_g[:, None].astype(yb.dtype)
    y = jax.ops.segment_sum(yb, buf_tok, num_segments=n + 1)[:n]
    return y.reshape(B, T, D).astype(h.dtype)


def setup_inputs(seed: int = 0) -> dict:
    key = jax.random.key(seed)
    ks = jax.random.split(key, 40)
    L, D = DEPTH, D_MODEL

    def nrm(k, shape, scale):
        return jax.random.normal(k, shape, jnp.float32) * scale

    return {
        'x': nrm(ks[0], (BATCH, SEQ, D), 1.0),
        'c': nrm(ks[1], (BATCH, D), 1.0),
        'ctx': nrm(ks[2], (BATCH, CTX_LEN, D), 1.0),
        'c_ctx': nrm(ks[3], (D,), 1.0),
        'norm1_g': 1.0 + nrm(ks[4], (L, D), 0.02),
        'w_mod': nrm(ks[5], (L, D, 6 * D), 0.5 * D ** -0.5),
        'b_mod': nrm(ks[6], (L, 6 * D), 0.02),
        'w_in': nrm(ks[7], (L, D, D_IN), D ** -0.5),
        'mu_shift': jax.random.uniform(ks[8], (L, D_SHIFT), jnp.float32),
        'w0_f': nrm(ks[9], (L, D_RWKV), 0.5),
        'w2_f': nrm(ks[10], (L, DECAY_LORA, D_RWKV), DECAY_LORA ** -0.5),
        'w0_b': nrm(ks[11], (L, D_RWKV), 0.5),
        'w2_b': nrm(ks[12], (L, DECAY_LORA, D_RWKV), DECAY_LORA ** -0.5),
        'a0_f': nrm(ks[13], (L, D_RWKV), 0.5),
        'a2_f': nrm(ks[14], (L, AAA_LORA, D_RWKV), AAA_LORA ** -0.5),
        'a0_b': nrm(ks[15], (L, D_RWKV), 0.5),
        'a2_b': nrm(ks[16], (L, AAA_LORA, D_RWKV), AAA_LORA ** -0.5),
        'g2': nrm(ks[17], (L, GATE_LORA, D_RWKV), GATE_LORA ** -0.5),
        'k_k': 0.85 + nrm(ks[18], (L, D_RWKV), 0.02),
        'k_a': 1.0 + nrm(ks[19], (L, D_RWKV), 0.02),
        'r_k_f': nrm(ks[20], (L, D_RWKV), 0.1),
        'r_k_b': nrm(ks[21], (L, D_RWKV), 0.1),
        'gn_w': 1.0 + nrm(ks[22], (L, D_RWKV), 0.02),
        'gn_b': nrm(ks[23], (L, D_RWKV), 0.02),
        'w_pool': nrm(ks[24], (L, POOL_GROUPS, POOL_GW, POOL_GW), POOL_GW ** -0.5),
        'pool_scale': 1.0 + nrm(ks[25], (L, D_POOL), 0.02),
        'w_out': nrm(ks[26], (L, D_MIX, D), D_MIX ** -0.5),
        'norm2_g': 1.0 + nrm(ks[27], (L, D), 0.02),
        'w_router_grp': nrm(ks[28], (L, D, N_GROUPS), D ** -0.5),
        'b_router_grp': nrm(ks[29], (L, N_GROUPS), 0.01),
        'w_router_exp': nrm(ks[30], (L, D, N_EXPERTS), D ** -0.5),
        'b_router_exp': nrm(ks[31], (L, N_EXPERTS), 0.01),
        'w_gate': nrm(ks[32], (L, N_EXPERTS, D, D_EXPERT), D ** -0.5),
        'w_up': nrm(ks[33], (L, N_EXPERTS, D, D_EXPERT), D ** -0.5),
        'w_down': nrm(ks[34], (L, N_EXPERTS, D_EXPERT, D), D_EXPERT ** -0.5),
        'final_g': 1.0 + nrm(ks[35], (D,), 0.02),
    }


def reference(x, c, ctx, c_ctx, norm1_g, w_mod, b_mod, w_in, mu_shift, w0_f, w2_f, w0_b, w2_b,
              a0_f, a2_f, a0_b, a2_b, g2, k_k, k_a, r_k_f, r_k_b, gn_w, gn_b, w_pool, pool_scale,
              w_out, norm2_g, w_router_grp, b_router_grp, w_router_exp, b_router_exp,
              w_gate, w_up, w_down, final_g):
    B, S, D = x.shape
    rows = S // GRID_W
    x = x + _grid_pos_embed(rows, D)[None].astype(x.dtype)
    xc = ctx
    for l in range(DEPTH):
        need_ctx = l < DEPTH - 1
        mod_x = jax.nn.silu(c) @ w_mod[l] + b_mod[l]
        mod_c = jax.nn.silu(c_ctx)[None] @ w_mod[l] + b_mod[l]
        sh_a, sc_a, gt_a, sh_f, sc_f, gt_f = jnp.split(mod_x, 6, axis=-1)
        csh_a, csc_a, cgt_a, csh_f, csc_f, cgt_f = jnp.split(mod_c, 6, axis=-1)

        u_x = _modulate(_rmsnorm(x, norm1_g[l]), sh_a, sc_a) @ w_in[l]
        u_c = _modulate(_rmsnorm(xc, norm1_g[l]), csh_a, csc_a) @ w_in[l]
        rw_args = (mu_shift[l], w0_f[l], w2_f[l], w0_b[l], w2_b[l], a0_f[l], a2_f[l],
                   a0_b[l], a2_b[l], g2[l], k_k[l], k_a[l])
        f_c = _rwkv_features(u_c, *rw_args)
        f_x = _rwkv_features(u_x, *rw_args)
        s0 = jnp.zeros((xc.shape[0], RWKV_HEADS, RWKV_HEAD, RWKV_HEAD), jnp.float32)
        rw_c, s_ctx_f, s_ctx_b = _rwkv_stream(f_c, s0, s0, r_k_f[l], r_k_b[l], gn_w[l], gn_b[l], need_ctx)
        rw_x, _, _ = _rwkv_stream(f_x, s_ctx_f, s_ctx_b, r_k_f[l], r_k_b[l], gn_w[l], gn_b[l], True)
        pool_x = _pool_mixer(u_x[..., D_SHIFT:], w_pool[l], pool_scale[l])
        mix_x = jnp.concatenate([rw_x, pool_x], axis=-1) @ w_out[l]
        x = x + (gt_a[:, None, :] * mix_x).astype(x.dtype)
        if need_ctx:
            pool_c = _pool_mixer(u_c[..., D_SHIFT:], w_pool[l], pool_scale[l])
            mix_c = jnp.concatenate([rw_c, pool_c], axis=-1) @ w_out[l]
            xc = xc + (cgt_a[:, None, :] * mix_c).astype(xc.dtype)

        moe_args = (w_router_grp[l], b_router_grp[l], w_router_exp[l], b_router_exp[l],
                    w_gate[l], w_up[l], w_down[l])
        h_x = _modulate(_rmsnorm(x, norm2_g[l]), sh_f, sc_f)
        if need_ctx:
            h_c = _modulate(_rmsnorm(xc, norm2_g[l]), csh_f, csc_f)
            y = _hier_moe(jnp.concatenate([h_c, h_x], axis=1), *moe_args)
            n_ctx = xc.shape[1]
            xc = xc + (cgt_f[:, None, :] * y[:, :n_ctx]).astype(xc.dtype)
            x = x + (gt_f[:, None, :] * y[:, n_ctx:]).astype(x.dtype)
        else:
            x = x + (gt_f[:, None, :] * _hier_moe(h_x, *moe_args)).astype(x.dtype)
    return _rmsnorm(x, final_g)
```

```cpp
#include <hip/hip_runtime.h>
#include <stdint.h>
#include <stdio.h>

#define DI __device__ __forceinline__
typedef unsigned short bf16_t;
typedef short bf16x8 __attribute__((ext_vector_type(8)));
typedef short s16x4 __attribute__((ext_vector_type(4)));
typedef float f32x4 __attribute__((ext_vector_type(4)));
typedef float f32x2 __attribute__((ext_vector_type(2)));
typedef __bf16 bf16x2_t __attribute__((ext_vector_type(2)));
typedef unsigned u32x4 __attribute__((ext_vector_type(4)));
typedef unsigned u32x2 __attribute__((ext_vector_type(2)));
#define LAS __attribute__((address_space(3)))

constexpr int D = 1024, S = 16384, CTX = 256, NT = S + CTX, DIN = 2432, DSH = 1920, DR = 512;
constexpr int C_WLF = 1536, C_WLB = 1600, C_ALF = 1664, C_ALB = 1728, C_GL = 1792, C_POOL = 1920;
constexpr int NE = 32, DE = 512, LCAP = 32768;
constexpr float DECAY_SCALE = 0.6065306597f;

constexpr size_t SZ_U = (size_t)NT * DIN * 2;
constexpr size_t SZ_F = (size_t)NT * DR * 2;
constexpr size_t OFF_U = 0;
constexpr size_t OFF_XN = OFF_U + SZ_U;
constexpr size_t OFF_R = OFF_XN, OFF_K = OFF_XN + SZ_F;
constexpr size_t OFF_V = OFF_XN + 2 * SZ_F, OFF_AF = OFF_V + SZ_F, OFF_AB = OFF_AF + SZ_F;
constexpr size_t OFF_WF = OFF_AB + SZ_F, OFF_WB = OFF_WF + 2 * SZ_F;
constexpr size_t OFF_G = OFF_WB + 2 * SZ_F;
constexpr size_t OFF_MIX = OFF_G + (size_t)S * DR * 2;
constexpr size_t OFF_SMALL = OFF_MIX + (size_t)S * D * 2;
constexpr size_t OFF_MODX = OFF_SMALL, OFF_MODC = OFF_MODX + 6144 * 4;
constexpr size_t OFF_ROWTAB = OFF_MODC + 6144 * 4, OFF_COLTAB = OFF_ROWTAB + 256 * 512 * 4;
constexpr size_t OFF_CNT = OFF_COLTAB + 64 * 512 * 4;
constexpr size_t OFF_GATE = OFF_CNT + 256;
constexpr size_t OFF_LIST = OFF_GATE + (size_t)S * 2 * 4;
constexpr size_t WS_NEED = OFF_LIST + (size_t)NE * LCAP * 4;
constexpr size_t OFF_YF = OFF_U, OFF_YB = OFF_U + (size_t)S * DR * 4;
constexpr size_t OFF_X2 = OFF_WF;
constexpr size_t OFF_YBUF = OFF_XN;
constexpr size_t OFF_H2 = OFF_U;
constexpr size_t OFF_HID = OFF_U + (size_t)S * D * 2;

struct Params {
    const float *x, *c, *ctx, *c_ctx, *norm1_g, *w_mod, *b_mod, *w_in, *mu, *w0_f, *w2_f, *w0_b, *w2_b, *a0_f, *a2_f, *a0_b, *a2_b,
        *g2, *k_k, *k_a, *r_k_f, *r_k_b, *gn_w, *gn_b, *w_pool, *pool_scale, *w_out, *norm2_g, *w_rg, *b_rg, *w_re, *b_re,
        *w_gate, *w_up, *w_down, *final_g;
    float* out;
    char* ws;
};

DI unsigned pack2(float lo, float hi) { f32x2 v = {lo, hi}; bf16x2_t b = __builtin_convertvector(v, bf16x2_t); return __builtin_bit_cast(unsigned, b); }
DI float bf2f(bf16_t h) { return __uint_as_float(((unsigned)h) << 16); }
DI float bflo(unsigned u) { return __uint_as_float(u << 16); }
DI float bfhi(unsigned u) { return __uint_as_float(u & 0xffff0000u); }
DI void unpack8(const u32x4& p, float* f) { f[0] = bflo(p.x); f[1] = bfhi(p.x); f[2] = bflo(p.y); f[3] = bfhi(p.y); f[4] = bflo(p.z); f[5] = bfhi(p.z); f[6] = bflo(p.w); f[7] = bfhi(p.w); }
DI u32x4 pack8(const float* f) { u32x4 p; p.x = pack2(f[0], f[1]); p.y = pack2(f[2], f[3]); p.z = pack2(f[4], f[5]); p.w = pack2(f[6], f[7]); return p; }
DI float sigmoidf_(float x) { return 1.f / (1.f + __expf(-x)); }
DI float wave_sum(float v) {
#pragma unroll
    for (int o = 32; o > 0; o >>= 1) v += __shfl_xor(v, o, 64);
    return v;
}
DI f32x4 wave_sum4(f32x4 v) {
#pragma unroll
    for (int o = 32; o > 0; o >>= 1) { v[0] += __shfl_xor(v[0], o, 64); v[1] += __shfl_xor(v[1], o, 64); v[2] += __shfl_xor(v[2], o, 64); v[3] += __shfl_xor(v[3], o, 64); }
    return v;
}
DI float pos_val(const float* rowtab, const float* coltab, int t, int d) { return d < 512 ? rowtab[(t >> 6) * 512 + d] : coltab[(t & 63) * 512 + (d - 512)]; }

DI void phase_p0(const Params& p, int bid, int nblk, char* lds) {
    const int tid = threadIdx.x;
    float* modx = (float*)(p.ws + OFF_MODX); float* modc = (float*)(p.ws + OFF_MODC);
    float* red = (float*)lds;
    for (int item = bid; item < 96; item += nblk) {
        const int col0 = item * 64, cg = tid & 15, kg = tid >> 4;
        f32x4 ax = {0, 0, 0, 0}, ac = {0, 0, 0, 0};
        for (int kk = 0; kk < 64; ++kk) {
            const int k = kg * 64 + kk;
            const float cv = p.c[k], cc = p.c_ctx[k];
            const float sx = cv * sigmoidf_(cv), sc = cc * sigmoidf_(cc);
            const f32x4 w = *(const f32x4*)(p.w_mod + (size_t)k * 6144 + col0 + cg * 4);
            ax += w * sx; ac += w * sc;
        }
        __syncthreads();
#pragma unroll
        for (int j = 0; j < 4; ++j) { red[(kg * 64 + cg * 4 + j) * 2] = ax[j]; red[(kg * 64 + cg * 4 + j) * 2 + 1] = ac[j]; }
        __syncthreads();
        if (tid < 128) {
            const int col = tid & 63, which = tid >> 6;
            float s = 0.f;
            for (int g = 0; g < 16; ++g) s += red[(g * 64 + col) * 2 + which];
            s += p.b_mod[col0 + col];
            (which ? modc : modx)[col0 + col] = s;
        }
    }
    float* rowtab = (float*)(p.ws + OFF_ROWTAB); float* coltab = (float*)(p.ws + OFF_COLTAB);
    for (int i = bid * 256 + tid; i < (256 + 64) * 256; i += nblk * 256) {
        const int pos = i >> 8, f = i & 255;
        const float freq = powf(10000.f, -(float)f / 256.f);
        if (pos < 256) { const float a = (float)pos * freq; rowtab[pos * 512 + f] = sinf(a); rowtab[pos * 512 + 256 + f] = cosf(a); }
        else { const int cp = pos - 256; const float a = (float)cp * freq; coltab[cp * 512 + f] = sinf(a); coltab[cp * 512 + 256 + f] = cosf(a); }
    }
    if (bid == 0 && tid < 64) ((int*)(p.ws + OFF_CNT))[tid] = 0;
}

DI void phase_xn(const Params& p, int bid, int nblk) {
    const int lane = threadIdx.x & 63, wid = threadIdx.x >> 6;
    const float* modx = (const float*)(p.ws + OFF_MODX); const float* modc = (const float*)(p.ws + OFF_MODC);
    const float* rowtab = (const float*)(p.ws + OFF_ROWTAB); const float* coltab = (const float*)(p.ws + OFF_COLTAB);
    bf16_t* xn = (bf16_t*)(p.ws + OFF_XN);
    for (int g = bid * 4 + wid; g < NT; g += nblk * 4) {
        const bool isctx = g < CTX; const int t = g - CTX;
        const float* src = isctx ? p.ctx + (size_t)g * D : p.x + (size_t)t * D;
        const float* md = isctx ? modc : modx;
        f32x4 v[4]; float ss = 0.f;
#pragma unroll
        for (int i = 0; i < 4; ++i) {
            const int d = (i * 64 + lane) * 4;
            v[i] = *(const f32x4*)(src + d);
            if (!isctx) {
#pragma unroll
                for (int j = 0; j < 4; ++j) v[i][j] += pos_val(rowtab, coltab, t, d + j);
            }
            ss += v[i][0] * v[i][0] + v[i][1] * v[i][1] + v[i][2] * v[i][2] + v[i][3] * v[i][3];
        }
        ss = wave_sum(ss);
        const float rstd = rsqrtf(ss * (1.f / 1024.f) + 1e-6f);
#pragma unroll
        for (int i = 0; i < 4; ++i) {
            const int d = (i * 64 + lane) * 4;
            const f32x4 gg = *(const f32x4*)(p.norm1_g + d), sh = *(const f32x4*)(md + d), sc = *(const f32x4*)(md + 1024 + d);
            f32x4 o;
#pragma unroll
            for (int j = 0; j < 4; ++j) o[j] = (v[i][j] * rstd * gg[j]) * (1.f + sc[j]) + sh[j];
            u32x2 pk = {pack2(o[0], o[1]), pack2(o[2], o[3])};
            *(u32x2*)(xn + (size_t)g * D + d) = pk;
        }
    }
}

constexpr int GEMM_LDS = 10240 + 2 * 8704;
template <int NB, class AL, class EPI>
DI void gemm128(AL& al, const float* __restrict__ B0, const float* __restrict__ B1, int ldb, int K, char* lds, EPI& epi) {
    const int tid = threadIdx.x, lane = tid & 63, wid = tid >> 6, wr = wid >> 1, wc = wid & 1, fr = lane & 15, fq = lane >> 4;
    bf16_t* sA = (bf16_t*)lds; bf16_t* sB0 = (bf16_t*)(lds + 10240); bf16_t* sB1 = (bf16_t*)(lds + 10240 + 8704);
    f32x4 acc0[4][4], acc1[4][4];
#pragma unroll
    for (int m = 0; m < 4; ++m)
#pragma unroll
        for (int n = 0; n < 4; ++n) { acc0[m][n] = (f32x4){0, 0, 0, 0}; acc1[m][n] = (f32x4){0, 0, 0, 0}; }
    u32x4 ra[2]; f32x4 rb0[4], rb1[4];
    auto gload = [&](int k0) {
#pragma unroll
        for (int i = 0; i < 2; ++i) { const int c = tid + 256 * i; ra[i] = al.load(i, c >> 2, k0 + (c & 3) * 8); }
#pragma unroll
        for (int i = 0; i < 4; ++i) {
            const int c = tid + 256 * i, kr = c >> 5, n4 = c & 31;
            rb0[i] = *(const f32x4*)(B0 + (size_t)(k0 + kr) * ldb + n4 * 4);
            if (NB == 2) rb1[i] = *(const f32x4*)(B1 + (size_t)(k0 + kr) * ldb + n4 * 4);
        }
    };
    gload(0);
    for (int k0 = 0; k0 < K; k0 += 32) {
        __syncthreads();
#pragma unroll
        for (int i = 0; i < 2; ++i) { const int c = tid + 256 * i; *(u32x4*)(sA + (c >> 2) * 40 + (c & 3) * 8) = ra[i]; }
#pragma unroll
        for (int i = 0; i < 4; ++i) {
            const int c = tid + 256 * i, kr = c >> 5, n4 = c & 31;
            u32x2 pk = {pack2(rb0[i][0], rb0[i][1]), pack2(rb0[i][2], rb0[i][3])};
            *(u32x2*)(sB0 + kr * 136 + n4 * 4) = pk;
            if (NB == 2) { u32x2 pk1 = {pack2(rb1[i][0], rb1[i][1]), pack2(rb1[i][2], rb1[i][3])}; *(u32x2*)(sB1 + kr * 136 + n4 * 4) = pk1; }
        }
        __syncthreads();
        if (k0 + 32 < K) gload(k0 + 32);
        bf16x8 af[4], bf0[4], bf1[4];
#pragma unroll
        for (int m = 0; m < 4; ++m) af[m] = *(const bf16x8*)(sA + (wr * 64 + m * 16 + fr) * 40 + fq * 8);
#pragma unroll
        for (int n = 0; n < 4; ++n) {
            const int off = (fq * 8 + (fr >> 2)) * 136 + wc * 64 + n * 16 + 4 * (fr & 3);
            s16x4 lo = __builtin_amdgcn_ds_read_tr16_b64_v4i16((LAS s16x4*)(sB0 + off));
            s16x4 hi = __builtin_amdgcn_ds_read_tr16_b64_v4i16((LAS s16x4*)(sB0 + off + 4 * 136));
            bf0[n] = __builtin_shufflevector(lo, hi, 0, 1, 2, 3, 4, 5, 6, 7);
            if (NB == 2) {
                s16x4 lo1 = __builtin_amdgcn_ds_read_tr16_b64_v4i16((LAS s16x4*)(sB1 + off));
                s16x4 hi1 = __builtin_amdgcn_ds_read_tr16_b64_v4i16((LAS s16x4*)(sB1 + off + 4 * 136));
                bf1[n] = __builtin_shufflevector(lo1, hi1, 0, 1, 2, 3, 4, 5, 6, 7);
            }
        }
#pragma unroll
        for (int m = 0; m < 4; ++m)
#pragma unroll
            for (int n = 0; n < 4; ++n) {
                acc0[m][n] = __builtin_amdgcn_mfma_f32_16x16x32_bf16(bf0[n], af[m], acc0[m][n], 0, 0, 0);
                if (NB == 2) acc1[m][n] = __builtin_amdgcn_mfma_f32_16x16x32_bf16(bf1[n], af[m], acc1[m][n], 0, 0, 0);
            }
    }
#pragma unroll
    for (int m = 0; m < 4; ++m)
#pragma unroll
        for (int n = 0; n < 4; ++n) epi(wr * 64 + m * 16 + fr, wc * 64 + n * 16 + 4 * fq, acc0[m][n], acc1[m][n]);
    __syncthreads();
}

struct PlainA {
    const bf16_t* base; int lda;
    DI u32x4 load(int, int row, int k) const { return *(const u32x4*)(base + (size_t)row * lda + k); }
};
struct GatherA {
    const bf16_t* rp[2];
    DI u32x4 load(int i, int, int k) const { return *(const u32x4*)(rp[i] + k); }
};
template <int ACT> struct LoraA {
    const bf16_t* u; const float* mu; int row0, cb;
    DI u32x4 load(int, int row, int k) const {
        const int g = row0 + row;
        const bf16_t* pc = u + (size_t)g * DIN + cb + k;
        float c[8], pv[8], nx[8];
        unpack8(*(const u32x4*)pc, c);
        const bool hasp = (g != 0) && (g != CTX), hasn = (g != CTX - 1) && (g != NT - 1);
        if (hasp) unpack8(*(const u32x4*)(pc - DIN), pv); else { for (int j = 0; j < 8; ++j) pv[j] = 0.f; }
        if (hasn) unpack8(*(const u32x4*)(pc + DIN), nx); else { for (int j = 0; j < 8; ++j) nx[j] = 0.f; }
        float o[8];
#pragma unroll
        for (int j = 0; j < 8; ++j) {
            const float m = mu[cb + k + j];
            float s = c[j] + m * (0.5f * (pv[j] + nx[j]) - c[j]);
            if (ACT == 1) s = tanhf(s); else if (ACT == 2) s = sigmoidf_(s);
            o[j] = s;
        }
        return pack8(o);
    }
};

struct EpiStoreBf16 { bf16_t* o; int ldo; DI void operator()(int r, int c, const f32x4& v, const f32x4&) const { u32x2 pk = {pack2(v[0], v[1]), pack2(v[2], v[3])}; *(u32x2*)(o + (size_t)r * ldo + c) = pk; } };
DI void phase_g1(const Params& p, int bid, int nblk, char* lds) {
    const bf16_t* xn = (const bf16_t*)(p.ws + OFF_XN); bf16_t* u = (bf16_t*)(p.ws + OFF_U);
    for (int item = bid; item < 130 * 19; item += nblk) {
        const int tm = item / 19, tn = item % 19;
        PlainA al{xn + (size_t)tm * 128 * D, D};
        EpiStoreBf16 epi{u + (size_t)tm * 128 * DIN + tn * 128, DIN};
        gemm128<1>(al, p.w_in + tn * 128, nullptr, DIN, D, lds, epi);
    }
}

DI void phase_feat(const Params& p, int bid, int nblk) {
    const int lane = threadIdx.x & 63, wid = threadIdx.x >> 6;
    const bf16_t* u = (const bf16_t*)(p.ws + OFF_U);
    bf16_t* mix = (bf16_t*)(p.ws + OFF_MIX);
    for (int g = bid * 4 + wid; g < NT; g += nblk * 4) {
        const bool hasp = (g != 0) && (g != CTX), hasn = (g != CTX - 1) && (g != NT - 1);
#pragma unroll
        for (int i = 0; i < 3; ++i) {
            const int col = i * 512 + lane * 8;
            const bf16_t* pc = u + (size_t)g * DIN + col;
            float c[8], pv[8], nx[8], o[8];
            unpack8(*(const u32x4*)pc, c);
            if (hasp) unpack8(*(const u32x4*)(pc - DIN), pv); else { for (int j = 0; j < 8; ++j) pv[j] = 0.f; }
            if (hasn) unpack8(*(const u32x4*)(pc + DIN), nx); else { for (int j = 0; j < 8; ++j) nx[j] = 0.f; }
#pragma unroll
            for (int j = 0; j < 8; ++j) { const float m = p.mu[col + j]; o[j] = c[j] + m * (0.5f * (pv[j] + nx[j]) - c[j]); }
            bf16_t* dst = (bf16_t*)(p.ws + OFF_R + (size_t)i * SZ_F) + (size_t)g * DR + lane * 8;
            *(u32x4*)dst = pack8(o);
        }
        if (g >= CTX) {
            const int t = g - CTX, gi = lane >> 4, win = 2 << gi;
            int lo = t - win / 2, hi = lo + win; lo = lo < 0 ? 0 : lo; hi = hi > S ? S : hi;
            float s[8], c[8];
            for (int j = 0; j < 8; ++j) s[j] = 0.f;
            for (int tt = lo; tt < hi; ++tt) {
                float q[8]; unpack8(*(const u32x4*)(u + (size_t)(tt + CTX) * DIN + C_POOL + lane * 8), q);
                for (int j = 0; j < 8; ++j) s[j] += q[j];
            }
            unpack8(*(const u32x4*)(u + (size_t)g * DIN + C_POOL + lane * 8), c);
            const float inv = 1.f / (float)(hi - lo);
            float o[8];
            for (int j = 0; j < 8; ++j) o[j] = s[j] * inv - c[j];
            *(u32x4*)(mix + (size_t)t * D + lane * 8) = pack8(o);
        }
    }
}

struct EpiDecay { float* o; const float* w0; int col0; DI void operator()(int r, int c, const f32x4& v, const f32x4&) const {
    f32x4 res;
#pragma unroll
    for (int j = 0; j < 4; ++j) res[j] = __expf(-DECAY_SCALE * sigmoidf_(w0[col0 + c + j] + v[j]));
    *(f32x4*)(o + (size_t)r * DR + c) = res; } };
struct EpiSigBf16 { bf16_t* o; const float* a0; int col0; DI void operator()(int r, int c, const f32x4& v, const f32x4&) const {
    float s[4];
#pragma unroll
    for (int j = 0; j < 4; ++j) s[j] = sigmoidf_(a0[col0 + c + j] + v[j]);
    u32x2 pk = {pack2(s[0], s[1]), pack2(s[2], s[3])}; *(u32x2*)(o + (size_t)r * DR + c) = pk; } };
struct EpiGate { bf16_t* o; int row0; DI void operator()(int r, int c, const f32x4& v, const f32x4&) const {
    const int t = row0 + r - CTX; if (t < 0) return;
    u32x2 pk = {pack2(v[0], v[1]), pack2(v[2], v[3])}; *(u32x2*)(o + (size_t)t * DR + c) = pk; } };
struct EpiPool { bf16_t* o; const float* sc; DI void operator()(int r, int c, const f32x4& v, const f32x4&) const {
    u32x2 pk = {pack2(v[0] * sc[c], v[1] * sc[c + 1]), pack2(v[2] * sc[c + 2], v[3] * sc[c + 3])}; *(u32x2*)(o + (size_t)r * D + c) = pk; } };

DI void phase_lora(const Params& p, int bid, int nblk, char* lds) {
    const bf16_t* u = (const bf16_t*)(p.ws + OFF_U);
    const int n_lora = 5 * 130 * 4, n_pool = 4 * 128;
    for (int item = bid; item < n_lora + n_pool; item += nblk) {
        if (item < n_lora) {
            const int which = item / 520, rem = item % 520, tm = rem >> 2, tn = rem & 3, row0 = tm * 128, col0 = tn * 128;
            if (which == 0) { LoraA<1> al{u, p.mu, row0, C_WLF}; EpiDecay e{(float*)(p.ws + OFF_WF) + (size_t)row0 * DR + col0, p.w0_f, col0}; gemm128<1>(al, p.w2_f + col0, nullptr, DR, 64, lds, e); }
            else if (which == 1) { LoraA<1> al{u, p.mu, row0, C_WLB}; EpiDecay e{(float*)(p.ws + OFF_WB) + (size_t)row0 * DR + col0, p.w0_b, col0}; gemm128<1>(al, p.w2_b + col0, nullptr, DR, 64, lds, e); }
            else if (which == 2) { LoraA<0> al{u, p.mu, row0, C_ALF}; EpiSigBf16 e{(bf16_t*)(p.ws + OFF_AF) + (size_t)row0 * DR + col0, p.a0_f, col0}; gemm128<1>(al, p.a2_f + col0, nullptr, DR, 64, lds, e); }
            else if (which == 3) { LoraA<0> al{u, p.mu, row0, C_ALB}; EpiSigBf16 e{(bf16_t*)(p.ws + OFF_AB) + (size_t)row0 * DR + col0, p.a0_b, col0}; gemm128<1>(al, p.a2_b + col0, nullptr, DR, 64, lds, e); }
            else { LoraA<2> al{u, p.mu, row0, C_GL}; EpiGate e{(bf16_t*)(p.ws + OFF_G) + col0, row0}; gemm128<1>(al, p.g2 + col0, nullptr, DR, 128, lds, e); }
        } else {
            const int it = item - n_lora, gi = it >> 7, tm = it & 127;
            const bf16_t* mix = (const bf16_t*)(p.ws + OFF_MIX);
            PlainA al{mix + (size_t)tm * 128 * D + gi * 128, D};
            EpiPool e{(bf16_t*)(p.ws + OFF_MIX) + (size_t)tm * 128 * D + 512 + gi * 128, p.pool_scale + gi * 128};
            gemm128<1>(al, p.w_pool + (size_t)gi * 128 * 128, nullptr, 128, 128, lds, e);
        }
    }
}

constexpr int SCAN_PITCH = 68;
constexpr int SCAN_LDS = 6 * 64 * SCAN_PITCH * 4;
DI void phase_scan(const Params& p, int chain, char* lds) {
    const int lane = threadIdx.x, dir = chain >> 3, h = chain & 7;
    float* sW = (float*)lds; float* sKF = sW + 64 * SCAN_PITCH; float* sKKA = sKF + 64 * SCAN_PITCH; float* sNKK = sKKA + 64 * SCAN_PITCH;
    float* sR = sNKK + 64 * SCAN_PITCH; float* sV = sR + 64 * SCAN_PITCH;
    const bf16_t* fr_ = (const bf16_t*)(p.ws + OFF_R); const bf16_t* fk = (const bf16_t*)(p.ws + OFF_K); const bf16_t* fv = (const bf16_t*)(p.ws + OFF_V);
    const bf16_t* fa = (const bf16_t*)(p.ws + (dir ? OFF_AB : OFF_AF)); const float* fw = (const float*)(p.ws + (dir ? OFF_WB : OFF_WF));
    float* yo = (float*)(p.ws + (dir ? OFF_YB : OFF_YF));
    float St[64];
#pragma unroll
    for (int j = 0; j < 64; ++j) St[j] = 0.f;
    for (int blk = 0; blk < NT / 64; ++blk) {
        {
            const int n = blk * 64 + lane;
            const int g = dir == 0 ? n : (n < CTX ? CTX - 1 - n : NT - 1 - (n - CTX));
            const size_t base = (size_t)g * DR + h * 64;
            float ss = 0.f;
#pragma unroll
            for (int ch = 0; ch < 8; ++ch) {
                float kv[8]; unpack8(*(const u32x4*)(fk + base + ch * 8), kv);
#pragma unroll
                for (int j = 0; j < 8; ++j) { const float q = kv[j] * p.k_k[h * 64 + ch * 8 + j]; ss += q * q; }
            }
            const float inv = 1.f / fmaxf(sqrtf(ss), 1e-12f);
#pragma unroll
            for (int ch = 0; ch < 8; ++ch) {
                float kv[8], av[8], rv[8], vv[8];
                unpack8(*(const u32x4*)(fk + base + ch * 8), kv); unpack8(*(const u32x4*)(fa + base + ch * 8), av);
                unpack8(*(const u32x4*)(fr_ + base + ch * 8), rv); unpack8(*(const u32x4*)(fv + base + ch * 8), vv);
                const f32x4 w0 = *(const f32x4*)(fw + base + ch * 8), w1 = *(const f32x4*)(fw + base + ch * 8 + 4);
#pragma unroll
                for (int hh = 0; hh < 2; ++hh) {
                    f32x4 okf, okka, onkk, orr, ovv;
#pragma unroll
                    for (int j = 0; j < 4; ++j) {
                        const int jj = hh * 4 + j, c = h * 64 + ch * 8 + jj;
                        const float kkn = kv[jj] * p.k_k[c] * inv;
                        okf[j] = kv[jj] * (1.f + (av[jj] - 1.f) * p.k_a[c]);
                        okka[j] = kkn * av[jj]; onkk[j] = -kkn; orr[j] = rv[jj]; ovv[j] = vv[jj];
                    }
                    const int o = lane * SCAN_PITCH + ch * 8 + hh * 4;
                    *(f32x4*)(sKF + o) = okf; *(f32x4*)(sKKA + o) = okka; *(f32x4*)(sNKK + o) = onkk; *(f32x4*)(sR + o) = orr; *(f32x4*)(sV + o) = ovv;
                    *(f32x4*)(sW + o) = hh ? w1 : w0;
                }
            }
        }
        __syncthreads();
        for (int s = 0; s < 64; ++s) {
            const int n = blk * 64 + s;
            const int g = dir == 0 ? n : (n < CTX ? CTX - 1 - n : NT - 1 - (n - CTX));
            const int o = s * SCAN_PITCH;
            float sa = 0.f;
#pragma unroll
            for (int j4 = 0; j4 < 16; ++j4) { const f32x4 q = *(const f32x4*)(sNKK + o + j4 * 4); sa += St[j4 * 4] * q[0] + St[j4 * 4 + 1] * q[1] + St[j4 * 4 + 2] * q[2] + St[j4 * 4 + 3] * q[3]; }
            const float vi = sV[o + lane];
            float y = 0.f;
#pragma unroll
            for (int j4 = 0; j4 < 16; ++j4) {
                const f32x4 w = *(const f32x4*)(sW + o + j4 * 4), ka = *(const f32x4*)(sKKA + o + j4 * 4), kf = *(const f32x4*)(sKF + o + j4 * 4), r = *(const f32x4*)(sR + o + j4 * 4);
#pragma unroll
                for (int j = 0; j < 4; ++j) { const float ns = St[j4 * 4 + j] * w[j] + (sa * ka[j] + vi * kf[j]); St[j4 * 4 + j] = ns; y += ns * r[j]; }
            }
            if (g >= CTX) yo[(size_t)(g - CTX) * DR + h * 64 + lane] = y;
        }
        __syncthreads();
    }
}

DI void phase_combine(const Params& p, int bid, int nblk) {
    const int lane = threadIdx.x & 63, wid = threadIdx.x >> 6;
    const float* yf = (const float*)(p.ws + OFF_YF); const float* yb = (const float*)(p.ws + OFF_YB);
    bf16_t* mix = (bf16_t*)(p.ws + OFF_MIX);
    for (int t = bid * 4 + wid; t < S; t += nblk * 4) {
        const int c0 = lane * 8; const size_t gb = (size_t)(t + CTX) * DR + c0;
        float y[8];
        { const f32x4 a0 = *(const f32x4*)(yf + (size_t)t * DR + c0), a1 = *(const f32x4*)(yf + (size_t)t * DR + c0 + 4), b0 = *(const f32x4*)(yb + (size_t)t * DR + c0), b1 = *(const f32x4*)(yb + (size_t)t * DR + c0 + 4);
          for (int j = 0; j < 4; ++j) { y[j] = a0[j] + b0[j]; y[4 + j] = a1[j] + b1[j]; } }
        float s = 0.f; for (int j = 0; j < 8; ++j) s += y[j];
        s += __shfl_xor(s, 1, 64); s += __shfl_xor(s, 2, 64); s += __shfl_xor(s, 4, 64);
        const float mean = s * (1.f / 64.f);
        float q = 0.f; for (int j = 0; j < 8; ++j) { const float d = y[j] - mean; q += d * d; }
        q += __shfl_xor(q, 1, 64); q += __shfl_xor(q, 2, 64); q += __shfl_xor(q, 4, 64);
        const float rs = rsqrtf(q * (1.f / 64.f) + 64e-5f);
        float r[8], k[8], v[8], af[8], ab[8], gg[8];
        unpack8(*(const u32x4*)((const bf16_t*)(p.ws + OFF_R) + gb), r); unpack8(*(const u32x4*)((const bf16_t*)(p.ws + OFF_K) + gb), k);
        unpack8(*(const u32x4*)((const bf16_t*)(p.ws + OFF_V) + gb), v); unpack8(*(const u32x4*)((const bf16_t*)(p.ws + OFF_AF) + gb), af);
        unpack8(*(const u32x4*)((const bf16_t*)(p.ws + OFF_AB) + gb), ab); unpack8(*(const u32x4*)((const bf16_t*)(p.ws + OFF_G) + (size_t)t * DR + c0), gg);
        float bsum = 0.f;
        for (int j = 0; j < 8; ++j) {
            const int c = c0 + j; const float ka = p.k_a[c];
            const float kf = k[j] * (1.f + (af[j] - 1.f) * ka), kb = k[j] * (1.f + (ab[j] - 1.f) * ka);
            bsum += r[j] * (kf * p.r_k_f[c] + kb * p.r_k_b[c]);
        }
        bsum += __shfl_xor(bsum, 1, 64); bsum += __shfl_xor(bsum, 2, 64); bsum += __shfl_xor(bsum, 4, 64);
        float o[8];
        for (int j = 0; j < 8; ++j) { const int c = c0 + j; o[j] = ((y[j] - mean) * rs * p.gn_w[c] + p.gn_b[c] + bsum * v[j]) * gg[j]; }
        *(u32x4*)(mix + (size_t)t * D + c0) = pack8(o);
    }
}

struct EpiX2 { float* o; const float* x; const float* gt; const float* rowtab; const float* coltab; int row0, col0;
    DI void operator()(int r, int c, const f32x4& v, const f32x4&) const {
        const int t = row0 + r, d = col0 + c; const f32x4 xv = *(const f32x4*)(x + (size_t)t * D + d); f32x4 res;
#pragma unroll
        for (int j = 0; j < 4; ++j) res[j] = xv[j] + pos_val(rowtab, coltab, t, d + j) + gt[d + j] * v[j];
        *(f32x4*)(o + (size_t)t * D + d) = res; } };
DI void phase_g2(const Params& p, int bid, int nblk, char* lds) {
    const bf16_t* mix = (const bf16_t*)(p.ws + OFF_MIX);
    for (int item = bid; item < 128 * 8; item += nblk) {
        const int tm = item >> 3, tn = item & 7;
        PlainA al{mix + (size_t)tm * 128 * D, D};
        EpiX2 e{(float*)(p.ws + OFF_X2), p.x, (const float*)(p.ws + OFF_MODX) + 2048, (const float*)(p.ws + OFF_ROWTAB), (const float*)(p.ws + OFF_COLTAB), tm * 128, tn * 128};
        gemm128<1>(al, p.w_out + tn * 128, nullptr, D, D, lds, e);
    }
}

DI void phase_router(const Params& p, int bid, int nblk) {
    const int lane = threadIdx.x & 63, wid = threadIdx.x >> 6;
    const float* x2 = (const float*)(p.ws + OFF_X2); const float* modx = (const float*)(p.ws + OFF_MODX);
    bf16_t* h2 = (bf16_t*)(p.ws + OFF_H2); int* cnt = (int*)(p.ws + OFF_CNT); float* gate = (float*)(p.ws + OFF_GATE); int* list = (int*)(p.ws + OFF_LIST);
    for (int t = bid * 4 + wid; t < S; t += nblk * 4) {
        f32x4 v[4]; float ss = 0.f;
#pragma unroll
        for (int i = 0; i < 4; ++i) { v[i] = *(const f32x4*)(x2 + (size_t)t * D + (i * 64 + lane) * 4); ss += v[i][0] * v[i][0] + v[i][1] * v[i][1] + v[i][2] * v[i][2] + v[i][3] * v[i][3]; }
        ss = wave_sum(ss);
        const float rstd = rsqrtf(ss * (1.f / 1024.f) + 1e-6f);
        f32x4 lg4 = {0, 0, 0, 0}, le4[8];
#pragma unroll
        for (int n = 0; n < 8; ++n) le4[n] = (f32x4){0, 0, 0, 0};
#pragma unroll
        for (int i = 0; i < 4; ++i) {
            const int d = (i * 64 + lane) * 4;
            const f32x4 gg = *(const f32x4*)(p.norm2_g + d), sh = *(const f32x4*)(modx + 3072 + d), sc = *(const f32x4*)(modx + 4096 + d);
            f32x4 hv;
#pragma unroll
            for (int j = 0; j < 4; ++j) hv[j] = (v[i][j] * rstd * gg[j]) * (1.f + sc[j]) + sh[j];
            u32x2 pk = {pack2(hv[0], hv[1]), pack2(hv[2], hv[3])};
            *(u32x2*)(h2 + (size_t)t * D + d) = pk;
#pragma unroll
            for (int j = 0; j < 4; ++j) {
                const float hj = hv[j];
                lg4 += *(const f32x4*)(p.w_rg + (size_t)(d + j) * 4) * hj;
#pragma unroll
                for (int n4 = 0; n4 < 8; ++n4) le4[n4] += *(const f32x4*)(p.w_re + (size_t)(d + j) * 32 + n4 * 4) * hj;
            }
        }
        lg4 = wave_sum4(lg4);
#pragma unroll
        for (int n = 0; n < 8; ++n) le4[n] = wave_sum4(le4[n]);
        const float l0 = lg4[0] + p.b_rg[0], l1 = lg4[1] + p.b_rg[1], l2 = lg4[2] + p.b_rg[2], l3 = lg4[3] + p.b_rg[3];
        int grp = 0; float mx = l0;
        if (l1 > mx) { mx = l1; grp = 1; }
        if (l2 > mx) { mx = l2; grp = 2; }
        if (l3 > mx) { mx = l3; grp = 3; }
        const float den = __expf(l0 - mx) + __expf(l1 - mx) + __expf(l2 - mx) + __expf(l3 - mx);
        const float pgrp = 1.f / den;
        const float m0 = grp == 0 ? 1.f : 0.f, m1 = grp == 1 ? 1.f : 0.f, m2 = grp == 2 ? 1.f : 0.f, m3 = grp == 3 ? 1.f : 0.f;
        f32x4 sa = le4[0] * m0 + le4[2] * m1 + le4[4] * m2 + le4[6] * m3;
        f32x4 sb = le4[1] * m0 + le4[3] * m1 + le4[5] * m2 + le4[7] * m3;
        sa += *(const f32x4*)(p.b_re + grp * 8); sb += *(const f32x4*)(p.b_re + grp * 8 + 4);
        const float s0 = sa[0], s1 = sa[1], s2 = sa[2], s3 = sa[3], s4 = sb[0], s5 = sb[1], s6 = sb[2], s7 = sb[3];
        int i1 = 0; float v1 = s0;
        if (s1 > v1) { v1 = s1; i1 = 1; }
        if (s2 > v1) { v1 = s2; i1 = 2; }
        if (s3 > v1) { v1 = s3; i1 = 3; }
        if (s4 > v1) { v1 = s4; i1 = 4; }
        if (s5 > v1) { v1 = s5; i1 = 5; }
        if (s6 > v1) { v1 = s6; i1 = 6; }
        if (s7 > v1) { v1 = s7; i1 = 7; }
        int i2 = -1; float v2 = -3.0e38f;
        if (i1 != 0 && s0 > v2) { v2 = s0; i2 = 0; }
        if (i1 != 1 && s1 > v2) { v2 = s1; i2 = 1; }
        if (i1 != 2 && s2 > v2) { v2 = s2; i2 = 2; }
        if (i1 != 3 && s3 > v2) { v2 = s3; i2 = 3; }
        if (i1 != 4 && s4 > v2) { v2 = s4; i2 = 4; }
        if (i1 != 5 && s5 > v2) { v2 = s5; i2 = 5; }
        if (i1 != 6 && s6 > v2) { v2 = s6; i2 = 6; }
        if (i1 != 7 && s7 > v2) { v2 = s7; i2 = 7; }
        const float e2 = __expf(v2 - v1), g1 = pgrp / (1.f + e2), g2v = pgrp * e2 / (1.f + e2);
        if (lane == 0) {
            const int ea = grp * 8 + i1, eb = grp * 8 + i2;
            const int pa = atomicAdd(&cnt[ea], 1), pb = atomicAdd(&cnt[eb], 1);
            list[ea * LCAP + pa] = t * 2; list[eb * LCAP + pb] = t * 2 + 1;
            gate[t * 2] = g1; gate[t * 2 + 1] = g2v;
        }
    }
}

DI void moe_tiles(const int* cnt, int* tstart  ) {
    if (threadIdx.x == 0) { int acc = 0; for (int e = 0; e < NE; ++e) { tstart[e] = acc; acc += (cnt[e] + 127) >> 7; } tstart[NE] = acc; }
    __syncthreads();
}
struct EpiHid { bf16_t* o; DI void operator()(int r, int c, const f32x4& g, const f32x4& u) const {
    float h[4];
#pragma unroll
    for (int j = 0; j < 4; ++j) h[j] = g[j] * sigmoidf_(g[j]) * u[j];
    u32x2 pk = {pack2(h[0], h[1]), pack2(h[2], h[3])}; *(u32x2*)(o + (size_t)r * DE + c) = pk; } };
DI void phase_g3(const Params& p, int bid, int nblk, char* lds) {
    int* tstart = (int*)(lds + GEMM_LDS);
    const int* cnt = (const int*)(p.ws + OFF_CNT); const int* list = (const int*)(p.ws + OFF_LIST);
    const bf16_t* h2 = (const bf16_t*)(p.ws + OFF_H2); bf16_t* hid = (bf16_t*)(p.ws + OFF_HID);
    moe_tiles(cnt, tstart);
    const int ntiles = tstart[NE];
    for (int item = bid; item < ntiles * 4; item += nblk) {
        const int ti = item >> 2, cj = item & 3;
        int e = 0; while (e < NE - 1 && tstart[e + 1] <= ti) ++e;
        const int lt = ti - tstart[e], ne = cnt[e];
        GatherA al;
#pragma unroll
        for (int i = 0; i < 2; ++i) { const int row = (threadIdx.x + 256 * i) >> 2, pos = lt * 128 + row; const int tok = pos < ne ? (list[e * LCAP + pos] >> 1) : 0; al.rp[i] = h2 + (size_t)tok * D; }
        EpiHid epi{hid + (size_t)ti * 128 * DE + cj * 128};
        gemm128<2>(al, p.w_gate + (size_t)e * D * DE + cj * 128, p.w_up + (size_t)e * D * DE + cj * 128, DE, D, lds, epi);
    }
}
struct EpiDown { bf16_t* ybuf; const int* lst; const float* gate; int nvalid; int col0;
    DI void operator()(int r, int c, const f32x4& v, const f32x4&) const {
        if (r >= nvalid) return; const int slot = lst[r]; const float g = gate[slot];
        u32x2 pk = {pack2(v[0] * g, v[1] * g), pack2(v[2] * g, v[3] * g)}; *(u32x2*)(ybuf + (size_t)slot * D + col0 + c) = pk; } };
DI void phase_g4(const Params& p, int bid, int nblk, char* lds) {
    int* tstart = (int*)(lds + GEMM_LDS);
    const int* cnt = (const int*)(p.ws + OFF_CNT); const int* list = (const int*)(p.ws + OFF_LIST);
    const bf16_t* hid = (const bf16_t*)(p.ws + OFF_HID);
    moe_tiles(cnt, tstart);
    const int ntiles = tstart[NE];
    for (int item = bid; item < ntiles * 8; item += nblk) {
        const int ti = item >> 3, cj = item & 7;
        int e = 0; while (e < NE - 1 && tstart[e + 1] <= ti) ++e;
        const int lt = ti - tstart[e], ne = cnt[e];
        PlainA al{hid + (size_t)ti * 128 * DE, DE};
        EpiDown epi{(bf16_t*)(p.ws + OFF_YBUF), list + e * LCAP + lt * 128, (const float*)(p.ws + OFF_GATE), ne - lt * 128, cj * 128};
        gemm128<1>(al, p.w_down + (size_t)e * DE * D + cj * 128, nullptr, D, DE, lds, epi);
    }
}

DI void phase_final(const Params& p, int bid, int nblk) {
    const int lane = threadIdx.x & 63, wid = threadIdx.x >> 6;
    const float* x2 = (const float*)(p.ws + OFF_X2); const float* gt = (const float*)(p.ws + OFF_MODX) + 5120; const bf16_t* yb = (const bf16_t*)(p.ws + OFF_YBUF);
    for (int t = bid * 4 + wid; t < S; t += nblk * 4) {
        f32x4 v[4]; float ss = 0.f;
#pragma unroll
        for (int i = 0; i < 4; ++i) {
            const int d = (i * 64 + lane) * 4;
            v[i] = *(const f32x4*)(x2 + (size_t)t * D + d);
            const u32x2 a = *(const u32x2*)(yb + (size_t)(2 * t) * D + d), b = *(const u32x2*)(yb + (size_t)(2 * t + 1) * D + d);
            const f32x4 g = *(const f32x4*)(gt + d);
            v[i][0] += g[0] * (bflo(a.x) + bflo(b.x)); v[i][1] += g[1] * (bfhi(a.x) + bfhi(b.x));
            v[i][2] += g[2] * (bflo(a.y) + bflo(b.y)); v[i][3] += g[3] * (bfhi(a.y) + bfhi(b.y));
            ss += v[i][0] * v[i][0] + v[i][1] * v[i][1] + v[i][2] * v[i][2] + v[i][3] * v[i][3];
        }
        ss = wave_sum(ss);
        const float rstd = rsqrtf(ss * (1.f / 1024.f) + 1e-6f);
#pragma unroll
        for (int i = 0; i < 4; ++i) {
            const int d = (i * 64 + lane) * 4; const f32x4 fg = *(const f32x4*)(p.final_g + d); f32x4 o;
#pragma unroll
            for (int j = 0; j < 4; ++j) o[j] = v[i][j] * rstd * fg[j];
            *(f32x4*)(p.out + (size_t)t * D + d) = o;
        }
    }
}

__global__ void __launch_bounds__(256) k_p0(Params p) { __shared__ __attribute__((aligned(16))) char lds[8192]; phase_p0(p, blockIdx.x, gridDim.x, lds); }
__global__ void __launch_bounds__(256) k_xn(Params p) { phase_xn(p, blockIdx.x, gridDim.x); }
__global__ void __launch_bounds__(256) k_g1(Params p) { __shared__ __attribute__((aligned(16))) char lds[GEMM_LDS + 256]; phase_g1(p, blockIdx.x, gridDim.x, lds); }
__global__ void __launch_bounds__(256) k_feat(Params p) { phase_feat(p, blockIdx.x, gridDim.x); }
__global__ void __launch_bounds__(256) k_lora(Params p) { __shared__ __attribute__((aligned(16))) char lds[GEMM_LDS + 256]; phase_lora(p, blockIdx.x, gridDim.x, lds); }
__global__ void __launch_bounds__(64) k_scan(Params p) { extern __shared__ __attribute__((aligned(16))) char dlds[]; phase_scan(p, blockIdx.x, dlds); }
__global__ void __launch_bounds__(256) k_combine(Params p) { phase_combine(p, blockIdx.x, gridDim.x); }
__global__ void __launch_bounds__(256) k_g2(Params p) { __shared__ __attribute__((aligned(16))) char lds[GEMM_LDS + 256]; phase_g2(p, blockIdx.x, gridDim.x, lds); }
__global__ void __launch_bounds__(256) k_router(Params p) { phase_router(p, blockIdx.x, gridDim.x); }
__global__ void __launch_bounds__(256) k_g3(Params p) { __shared__ __attribute__((aligned(16))) char lds[GEMM_LDS + 256]; phase_g3(p, blockIdx.x, gridDim.x, lds); }
__global__ void __launch_bounds__(256) k_g4(Params p) { __shared__ __attribute__((aligned(16))) char lds[GEMM_LDS + 256]; phase_g4(p, blockIdx.x, gridDim.x, lds); }
__global__ void __launch_bounds__(256) k_final(Params p) { phase_final(p, blockIdx.x, gridDim.x); }

extern "C" void kernel_launch(void* const* d_in, const int* in_sizes, int n_in, void* d_out, int out_size, void* d_ws, size_t ws_size, hipStream_t stream) {
    if (ws_size < WS_NEED) { fprintf(stderr, "workspace too small: %zu < %zu\n", ws_size, (size_t)WS_NEED); return; }
    Params p{};
    const float** f = (const float**)&p;
    for (int i = 0; i < 36; ++i) f[i] = (const float*)d_in[i];
    p.out = (float*)d_out; p.ws = (char*)d_ws;
    static bool attr = false;
    if (!attr) { hipFuncSetAttribute((const void*)k_scan, hipFuncAttributeMaxDynamicSharedMemorySize, SCAN_LDS); attr = true; }
    k_p0<<<256, 256, 0, stream>>>(p);
    k_xn<<<1024, 256, 0, stream>>>(p);
    k_g1<<<130 * 19, 256, 0, stream>>>(p);
    k_feat<<<2048, 256, 0, stream>>>(p);
    k_lora<<<5 * 130 * 4 + 512, 256, 0, stream>>>(p);
    k_scan<<<16, 64, SCAN_LDS, stream>>>(p);
    k_combine<<<2048, 256, 0, stream>>>(p);
    k_g2<<<1024, 256, 0, stream>>>(p);
    k_router<<<2048, 256, 0, stream>>>(p);
    k_g3<<<1152, 256, 0, stream>>>(p);
    k_g4<<<2304, 256, 0, stream>>>(p);
    k_final<<<2048, 256, 0, stream>>>(p);
}
```

```cpp
#include <hip/hip_runtime.h>
#include <stdint.h>
#include <stdio.h>
#include <hip/hip_cooperative_groups.h>
namespace cg = cooperative_groups;

#define DI __device__ __forceinline__
typedef unsigned short bf16_t;
typedef short bf16x8 __attribute__((ext_vector_type(8)));
typedef short s16x4 __attribute__((ext_vector_type(4)));
typedef float f32x4 __attribute__((ext_vector_type(4)));
typedef float f32x2 __attribute__((ext_vector_type(2)));
typedef __bf16 bf16x2_t __attribute__((ext_vector_type(2)));
typedef unsigned u32x4 __attribute__((ext_vector_type(4)));
typedef unsigned u32x2 __attribute__((ext_vector_type(2)));
#define LAS __attribute__((address_space(3)))

constexpr int D = 1024, S = 16384, CTX = 256, NT = S + CTX, DIN = 2432, DSH = 1920, DR = 512;
constexpr int C_WLF = 1536, C_WLB = 1600, C_ALF = 1664, C_ALB = 1728, C_GL = 1792, C_POOL = 1920;
constexpr int NE = 32, DE = 512, LCAP = 32768;
constexpr float DECAY_SCALE = 0.6065306597f;

constexpr size_t SZ_U = (size_t)NT * DIN * 2;
constexpr size_t SZ_F = (size_t)NT * DR * 2;
constexpr size_t OFF_U = 0;
constexpr size_t OFF_XN = OFF_U + SZ_U;
constexpr size_t OFF_R = OFF_XN, OFF_K = OFF_XN + SZ_F;
constexpr size_t OFF_V = OFF_XN + 2 * SZ_F, OFF_AF = OFF_V + SZ_F, OFF_AB = OFF_AF + SZ_F;
constexpr size_t OFF_WF = OFF_AB + SZ_F, OFF_WB = OFF_WF + 2 * SZ_F;
constexpr size_t OFF_G = OFF_WB + 2 * SZ_F;
constexpr size_t OFF_MIX = OFF_G + (size_t)S * DR * 2;
constexpr size_t OFF_SMALL = OFF_MIX + (size_t)S * D * 2;
constexpr size_t OFF_MODX = OFF_SMALL, OFF_MODC = OFF_MODX + 6144 * 4;
constexpr size_t OFF_ROWTAB = OFF_MODC + 6144 * 4, OFF_COLTAB = OFF_ROWTAB + 256 * 512 * 4;
constexpr size_t OFF_CNT = OFF_COLTAB + 64 * 512 * 4;
constexpr size_t OFF_GATE = OFF_CNT + 256;
constexpr size_t OFF_LIST = OFF_GATE + (size_t)S * 2 * 4;
constexpr size_t WS_NEED = OFF_LIST + (size_t)NE * LCAP * 4;
constexpr size_t OFF_YF = OFF_U, OFF_YB = OFF_U + (size_t)S * DR * 4;
constexpr size_t OFF_X2 = OFF_WF;
constexpr size_t OFF_YBUF = OFF_XN;
constexpr size_t OFF_H2 = OFF_U;
constexpr size_t OFF_HID = OFF_U + (size_t)S * D * 2;

struct Params {
    const float *x, *c, *ctx, *c_ctx, *norm1_g, *w_mod, *b_mod, *w_in, *mu, *w0_f, *w2_f, *w0_b, *w2_b, *a0_f, *a2_f, *a0_b, *a2_b,
        *g2, *k_k, *k_a, *r_k_f, *r_k_b, *gn_w, *gn_b, *w_pool, *pool_scale, *w_out, *norm2_g, *w_rg, *b_rg, *w_re, *b_re,
        *w_gate, *w_up, *w_down, *final_g;
    float* out;
    char* ws;
};

DI unsigned pack2(float lo, float hi) { f32x2 v = {lo, hi}; bf16x2_t b = __builtin_convertvector(v, bf16x2_t); return __builtin_bit_cast(unsigned, b); }
DI float bf2f(bf16_t h) { return __uint_as_float(((unsigned)h) << 16); }
DI float bflo(unsigned u) { return __uint_as_float(u << 16); }
DI float bfhi(unsigned u) { return __uint_as_float(u & 0xffff0000u); }
DI void unpack8(const u32x4& p, float* f) { f[0] = bflo(p.x); f[1] = bfhi(p.x); f[2] = bflo(p.y); f[3] = bfhi(p.y); f[4] = bflo(p.z); f[5] = bfhi(p.z); f[6] = bflo(p.w); f[7] = bfhi(p.w); }
DI u32x4 pack8(const float* f) { u32x4 p; p.x = pack2(f[0], f[1]); p.y = pack2(f[2], f[3]); p.z = pack2(f[4], f[5]); p.w = pack2(f[6], f[7]); return p; }
DI float sigmoidf_(float x) { return 1.f / (1.f + __expf(-x)); }
DI float wave_sum(float v) {
#pragma unroll
    for (int o = 32; o > 0; o >>= 1) v += __shfl_xor(v, o, 64);
    return v;
}
DI f32x4 wave_sum4(f32x4 v) {
#pragma unroll
    for (int o = 32; o > 0; o >>= 1) { v[0] += __shfl_xor(v[0], o, 64); v[1] += __shfl_xor(v[1], o, 64); v[2] += __shfl_xor(v[2], o, 64); v[3] += __shfl_xor(v[3], o, 64); }
    return v;
}
DI float pos_val(const float* rowtab, const float* coltab, int t, int d) { return d < 512 ? rowtab[(t >> 6) * 512 + d] : coltab[(t & 63) * 512 + (d - 512)]; }

DI void phase_p0(const Params& p, int bid, int nblk, char* lds) {
    const int tid = threadIdx.x;
    float* modx = (float*)(p.ws + OFF_MODX); float* modc = (float*)(p.ws + OFF_MODC);
    float* red = (float*)lds;
    for (int item = bid; item < 96; item += nblk) {
        const int col0 = item * 64, cg = tid & 15, kg = tid >> 4;
        f32x4 ax = {0, 0, 0, 0}, ac = {0, 0, 0, 0};
        for (int kk = 0; kk < 64; ++kk) {
            const int k = kg * 64 + kk;
            const float cv = p.c[k], cc = p.c_ctx[k];
            const float sx = cv * sigmoidf_(cv), sc = cc * sigmoidf_(cc);
            const f32x4 w = *(const f32x4*)(p.w_mod + (size_t)k * 6144 + col0 + cg * 4);
            ax += w * sx; ac += w * sc;
        }
        __syncthreads();
#pragma unroll
        for (int j = 0; j < 4; ++j) { red[(kg * 64 + cg * 4 + j) * 2] = ax[j]; red[(kg * 64 + cg * 4 + j) * 2 + 1] = ac[j]; }
        __syncthreads();
        if (tid < 128) {
            const int col = tid & 63, which = tid >> 6;
            float s = 0.f;
            for (int g = 0; g < 16; ++g) s += red[(g * 64 + col) * 2 + which];
            s += p.b_mod[col0 + col];
            (which ? modc : modx)[col0 + col] = s;
        }
    }
    float* rowtab = (float*)(p.ws + OFF_ROWTAB); float* coltab = (float*)(p.ws + OFF_COLTAB);
    for (int i = bid * 256 + tid; i < (256 + 64) * 256; i += nblk * 256) {
        const int pos = i >> 8, f = i & 255;
        const float freq = powf(10000.f, -(float)f / 256.f);
        if (pos < 256) { const float a = (float)pos * freq; rowtab[pos * 512 + f] = sinf(a); rowtab[pos * 512 + 256 + f] = cosf(a); }
        else { const int cp = pos - 256; const float a = (float)cp * freq; coltab[cp * 512 + f] = sinf(a); coltab[cp * 512 + 256 + f] = cosf(a); }
    }
    if (bid == 0 && tid < 64) ((int*)(p.ws + OFF_CNT))[tid] = 0;
}

DI void phase_xn(const Params& p, int bid, int nblk) {
    const int lane = threadIdx.x & 63, wid = threadIdx.x >> 6;
    const float* modx = (const float*)(p.ws + OFF_MODX); const float* modc = (const float*)(p.ws + OFF_MODC);
    const float* rowtab = (const float*)(p.ws + OFF_ROWTAB); const float* coltab = (const float*)(p.ws + OFF_COLTAB);
    bf16_t* xn = (bf16_t*)(p.ws + OFF_XN);
    for (int g = bid * 4 + wid; g < NT; g += nblk * 4) {
        const bool isctx = g < CTX; const int t = g - CTX;
        const float* src = isctx ? p.ctx + (size_t)g * D : p.x + (size_t)t * D;
        const float* md = isctx ? modc : modx;
        f32x4 v[4]; float ss = 0.f;
#pragma unroll
        for (int i = 0; i < 4; ++i) {
            const int d = (i * 64 + lane) * 4;
            v[i] = *(const f32x4*)(src + d);
            if (!isctx) {
#pragma unroll
                for (int j = 0; j < 4; ++j) v[i][j] += pos_val(rowtab, coltab, t, d + j);
            }
            ss += v[i][0] * v[i][0] + v[i][1] * v[i][1] + v[i][2] * v[i][2] + v[i][3] * v[i][3];
        }
        ss = wave_sum(ss);
        const float rstd = rsqrtf(ss * (1.f / 1024.f) + 1e-6f);
#pragma unroll
        for (int i = 0; i < 4; ++i) {
            const int d = (i * 64 + lane) * 4;
            const f32x4 gg = *(const f32x4*)(p.norm1_g + d), sh = *(const f32x4*)(md + d), sc = *(const f32x4*)(md + 1024 + d);
            f32x4 o;
#pragma unroll
            for (int j = 0; j < 4; ++j) o[j] = (v[i][j] * rstd * gg[j]) * (1.f + sc[j]) + sh[j];
            u32x2 pk = {pack2(o[0], o[1]), pack2(o[2], o[3])};
            *(u32x2*)(xn + (size_t)g * D + d) = pk;
        }
    }
}

constexpr int GEMM_LDS = 10240 + 2 * 8704;
template <int NB, class AL, class EPI>
DI void gemm128(AL& al, const float* __restrict__ B0, const float* __restrict__ B1, int ldb, int K, char* lds, EPI& epi) {
    const int tid = threadIdx.x, lane = tid & 63, wid = tid >> 6, wr = wid >> 1, wc = wid & 1, fr = lane & 15, fq = lane >> 4;
    bf16_t* sA = (bf16_t*)lds; bf16_t* sB0 = (bf16_t*)(lds + 10240); bf16_t* sB1 = (bf16_t*)(lds + 10240 + 8704);
    f32x4 acc0[4][4], acc1[4][4];
#pragma unroll
    for (int m = 0; m < 4; ++m)
#pragma unroll
        for (int n = 0; n < 4; ++n) { acc0[m][n] = (f32x4){0, 0, 0, 0}; acc1[m][n] = (f32x4){0, 0, 0, 0}; }
    u32x4 ra[2]; f32x4 rb0[4], rb1[4];
    auto gload = [&](int k0) {
#pragma unroll
        for (int i = 0; i < 2; ++i) { const int c = tid + 256 * i; ra[i] = al.load(i, c >> 2, k0 + (c & 3) * 8); }
#pragma unroll
        for (int i = 0; i < 4; ++i) {
            const int c = tid + 256 * i, kr = c >> 5, n4 = c & 31;
            rb0[i] = *(const f32x4*)(B0 + (size_t)(k0 + kr) * ldb + n4 * 4);
            if (NB == 2) rb1[i] = *(const f32x4*)(B1 + (size_t)(k0 + kr) * ldb + n4 * 4);
        }
    };
    gload(0);
    for (int k0 = 0; k0 < K; k0 += 32) {
        __syncthreads();
#pragma unroll
        for (int i = 0; i < 2; ++i) { const int c = tid + 256 * i; *(u32x4*)(sA + (c >> 2) * 40 + (c & 3) * 8) = ra[i]; }
#pragma unroll
        for (int i = 0; i < 4; ++i) {
            const int c = tid + 256 * i, kr = c >> 5, n4 = c & 31;
            u32x2 pk = {pack2(rb0[i][0], rb0[i][1]), pack2(rb0[i][2], rb0[i][3])};
            *(u32x2*)(sB0 + kr * 136 + n4 * 4) = pk;
            if (NB == 2) { u32x2 pk1 = {pack2(rb1[i][0], rb1[i][1]), pack2(rb1[i][2], rb1[i][3])}; *(u32x2*)(sB1 + kr * 136 + n4 * 4) = pk1; }
        }
        __syncthreads();
        if (k0 + 32 < K) gload(k0 + 32);
        bf16x8 af[4], bf0[4], bf1[4];
#pragma unroll
        for (int m = 0; m < 4; ++m) af[m] = *(const bf16x8*)(sA + (wr * 64 + m * 16 + fr) * 40 + fq * 8);
#pragma unroll
        for (int n = 0; n < 4; ++n) {
            const int off = (fq * 8 + (fr >> 2)) * 136 + wc * 64 + n * 16 + 4 * (fr & 3);
            s16x4 lo = __builtin_amdgcn_ds_read_tr16_b64_v4i16((LAS s16x4*)(sB0 + off));
            s16x4 hi = __builtin_amdgcn_ds_read_tr16_b64_v4i16((LAS s16x4*)(sB0 + off + 4 * 136));
            bf0[n] = __builtin_shufflevector(lo, hi, 0, 1, 2, 3, 4, 5, 6, 7);
            if (NB == 2) {
                s16x4 lo1 = __builtin_amdgcn_ds_read_tr16_b64_v4i16((LAS s16x4*)(sB1 + off));
                s16x4 hi1 = __builtin_amdgcn_ds_read_tr16_b64_v4i16((LAS s16x4*)(sB1 + off + 4 * 136));
                bf1[n] = __builtin_shufflevector(lo1, hi1, 0, 1, 2, 3, 4, 5, 6, 7);
            }
        }
#pragma unroll
        for (int m = 0; m < 4; ++m)
#pragma unroll
            for (int n = 0; n < 4; ++n) {
                acc0[m][n] = __builtin_amdgcn_mfma_f32_16x16x32_bf16(bf0[n], af[m], acc0[m][n], 0, 0, 0);
                if (NB == 2) acc1[m][n] = __builtin_amdgcn_mfma_f32_16x16x32_bf16(bf1[n], af[m], acc1[m][n], 0, 0, 0);
            }
    }
#pragma unroll
    for (int m = 0; m < 4; ++m)
#pragma unroll
        for (int n = 0; n < 4; ++n) epi(wr * 64 + m * 16 + fr, wc * 64 + n * 16 + 4 * fq, acc0[m][n], acc1[m][n]);
    __syncthreads();
}

struct PlainA {
    const bf16_t* base; int lda;
    DI u32x4 load(int, int row, int k) const { return *(const u32x4*)(base + (size_t)row * lda + k); }
};
struct GatherA {
    const bf16_t* rp[2];
    DI u32x4 load(int i, int, int k) const { return *(const u32x4*)(rp[i] + k); }
};
template <int ACT> struct LoraA {
    const bf16_t* u; const float* mu; int row0, cb;
    DI u32x4 load(int, int row, int k) const {
        const int g = row0 + row;
        const bf16_t* pc = u + (size_t)g * DIN + cb + k;
        float c[8], pv[8], nx[8];
        unpack8(*(const u32x4*)pc, c);
        const bool hasp = (g != 0) && (g != CTX), hasn = (g != CTX - 1) && (g != NT - 1);
        if (hasp) unpack8(*(const u32x4*)(pc - DIN), pv); else { for (int j = 0; j < 8; ++j) pv[j] = 0.f; }
        if (hasn) unpack8(*(const u32x4*)(pc + DIN), nx); else { for (int j = 0; j < 8; ++j) nx[j] = 0.f; }
        float o[8];
#pragma unroll
        for (int j = 0; j < 8; ++j) {
            const float m = mu[cb + k + j];
            float s = c[j] + m * (0.5f * (pv[j] + nx[j]) - c[j]);
            if (ACT == 1) s = tanhf(s); else if (ACT == 2) s = sigmoidf_(s);
            o[j] = s;
        }
        return pack8(o);
    }
};

struct EpiStoreBf16 { bf16_t* o; int ldo; DI void operator()(int r, int c, const f32x4& v, const f32x4&) const { u32x2 pk = {pack2(v[0], v[1]), pack2(v[2], v[3])}; *(u32x2*)(o + (size_t)r * ldo + c) = pk; } };
DI void phase_g1(const Params& p, int bid, int nblk, char* lds) {
    const bf16_t* xn = (const bf16_t*)(p.ws + OFF_XN); bf16_t* u = (bf16_t*)(p.ws + OFF_U);
    for (int item = bid; item < 130 * 19; item += nblk) {
        const int tm = item / 19, tn = item % 19;
        PlainA al{xn + (size_t)tm * 128 * D, D};
        EpiStoreBf16 epi{u + (size_t)tm * 128 * DIN + tn * 128, DIN};
        gemm128<1>(al, p.w_in + tn * 128, nullptr, DIN, D, lds, epi);
    }
}

DI void phase_feat(const Params& p, int bid, int nblk) {
    const int lane = threadIdx.x & 63, wid = threadIdx.x >> 6;
    const bf16_t* u = (const bf16_t*)(p.ws + OFF_U);
    bf16_t* mix = (bf16_t*)(p.ws + OFF_MIX);
    for (int g = bid * 4 + wid; g < NT; g += nblk * 4) {
        const bool hasp = (g != 0) && (g != CTX), hasn = (g != CTX - 1) && (g != NT - 1);
#pragma unroll
        for (int i = 0; i < 3; ++i) {
            const int col = i * 512 + lane * 8;
            const bf16_t* pc = u + (size_t)g * DIN + col;
            float c[8], pv[8], nx[8], o[8];
            unpack8(*(const u32x4*)pc, c);
            if (hasp) unpack8(*(const u32x4*)(pc - DIN), pv); else { for (int j = 0; j < 8; ++j) pv[j] = 0.f; }
            if (hasn) unpack8(*(const u32x4*)(pc + DIN), nx); else { for (int j = 0; j < 8; ++j) nx[j] = 0.f; }
#pragma unroll
            for (int j = 0; j < 8; ++j) { const float m = p.mu[col + j]; o[j] = c[j] + m * (0.5f * (pv[j] + nx[j]) - c[j]); }
            bf16_t* dst = (bf16_t*)(p.ws + OFF_R + (size_t)i * SZ_F) + (size_t)g * DR + lane * 8;
            *(u32x4*)dst = pack8(o);
        }
        if (g >= CTX) {
            const int t = g - CTX, gi = lane >> 4, win = 2 << gi;
            int lo = t - win / 2, hi = lo + win; lo = lo < 0 ? 0 : lo; hi = hi > S ? S : hi;
            float s[8], c[8];
            for (int j = 0; j < 8; ++j) s[j] = 0.f;
            for (int tt = lo; tt < hi; ++tt) {
                float q[8]; unpack8(*(const u32x4*)(u + (size_t)(tt + CTX) * DIN + C_POOL + lane * 8), q);
                for (int j = 0; j < 8; ++j) s[j] += q[j];
            }
            unpack8(*(const u32x4*)(u + (size_t)g * DIN + C_POOL + lane * 8), c);
            const float inv = 1.f / (float)(hi - lo);
            float o[8];
            for (int j = 0; j < 8; ++j) o[j] = s[j] * inv - c[j];
            *(u32x4*)(mix + (size_t)t * D + lane * 8) = pack8(o);
        }
    }
}

struct EpiDecay { float* o; const float* w0; int col0; DI void operator()(int r, int c, const f32x4& v, const f32x4&) const {
    f32x4 res;
#pragma unroll
    for (int j = 0; j < 4; ++j) res[j] = __expf(-DECAY_SCALE * sigmoidf_(w0[col0 + c + j] + v[j]));
    *(f32x4*)(o + (size_t)r * DR + c) = res; } };
struct EpiSigBf16 { bf16_t* o; const float* a0; int col0; DI void operator()(int r, int c, const f32x4& v, const f32x4&) const {
    float s[4];
#pragma unroll
    for (int j = 0; j < 4; ++j) s[j] = sigmoidf_(a0[col0 + c + j] + v[j]);
    u32x2 pk = {pack2(s[0], s[1]), pack2(s[2], s[3])}; *(u32x2*)(o + (size_t)r * DR + c) = pk; } };
struct EpiGate { bf16_t* o; int row0; DI void operator()(int r, int c, const f32x4& v, const f32x4&) const {
    const int t = row0 + r - CTX; if (t < 0) return;
    u32x2 pk = {pack2(v[0], v[1]), pack2(v[2], v[3])}; *(u32x2*)(o + (size_t)t * DR + c) = pk; } };
struct EpiPool { bf16_t* o; const float* sc; DI void operator()(int r, int c, const f32x4& v, const f32x4&) const {
    u32x2 pk = {pack2(v[0] * sc[c], v[1] * sc[c + 1]), pack2(v[2] * sc[c + 2], v[3] * sc[c + 3])}; *(u32x2*)(o + (size_t)r * D + c) = pk; } };

DI void phase_lora(const Params& p, int bid, int nblk, char* lds) {
    const bf16_t* u = (const bf16_t*)(p.ws + OFF_U);
    const int n_lora = 5 * 130 * 4, n_pool = 4 * 128;
    for (int item = bid; item < n_lora + n_pool; item += nblk) {
        if (item < n_lora) {
            const int which = item / 520, rem = item % 520, tm = rem >> 2, tn = rem & 3, row0 = tm * 128, col0 = tn * 128;
            if (which == 0) { LoraA<1> al{u, p.mu, row0, C_WLF}; EpiDecay e{(float*)(p.ws + OFF_WF) + (size_t)row0 * DR + col0, p.w0_f, col0}; gemm128<1>(al, p.w2_f + col0, nullptr, DR, 64, lds, e); }
            else if (which == 1) { LoraA<1> al{u, p.mu, row0, C_WLB}; EpiDecay e{(float*)(p.ws + OFF_WB) + (size_t)row0 * DR + col0, p.w0_b, col0}; gemm128<1>(al, p.w2_b + col0, nullptr, DR, 64, lds, e); }
            else if (which == 2) { LoraA<0> al{u, p.mu, row0, C_ALF}; EpiSigBf16 e{(bf16_t*)(p.ws + OFF_AF) + (size_t)row0 * DR + col0, p.a0_f, col0}; gemm128<1>(al, p.a2_f + col0, nullptr, DR, 64, lds, e); }
            else if (which == 3) { LoraA<0> al{u, p.mu, row0, C_ALB}; EpiSigBf16 e{(bf16_t*)(p.ws + OFF_AB) + (size_t)row0 * DR + col0, p.a0_b, col0}; gemm128<1>(al, p.a2_b + col0, nullptr, DR, 64, lds, e); }
            else { LoraA<2> al{u, p.mu, row0, C_GL}; EpiGate e{(bf16_t*)(p.ws + OFF_G) + col0, row0}; gemm128<1>(al, p.g2 + col0, nullptr, DR, 128, lds, e); }
        } else {
            const int it = item - n_lora, gi = it >> 7, tm = it & 127;
            const bf16_t* mix = (const bf16_t*)(p.ws + OFF_MIX);
            PlainA al{mix + (size_t)tm * 128 * D + gi * 128, D};
            EpiPool e{(bf16_t*)(p.ws + OFF_MIX) + (size_t)tm * 128 * D + 512 + gi * 128, p.pool_scale + gi * 128};
            gemm128<1>(al, p.w_pool + (size_t)gi * 128 * 128, nullptr, 128, 128, lds, e);
        }
    }
}

constexpr int SCAN_PITCH = 68;
constexpr int SCAN_LDS = 6 * 64 * SCAN_PITCH * 4;
DI void phase_scan(const Params& p, int chain, char* lds) {
    const int lane = threadIdx.x, dir = chain >> 3, h = chain & 7;
    float* sW = (float*)lds; float* sKF = sW + 64 * SCAN_PITCH; float* sKKA = sKF + 64 * SCAN_PITCH; float* sNKK = sKKA + 64 * SCAN_PITCH;
    float* sR = sNKK + 64 * SCAN_PITCH; float* sV = sR + 64 * SCAN_PITCH;
    const bf16_t* fr_ = (const bf16_t*)(p.ws + OFF_R); const bf16_t* fk = (const bf16_t*)(p.ws + OFF_K); const bf16_t* fv = (const bf16_t*)(p.ws + OFF_V);
    const bf16_t* fa = (const bf16_t*)(p.ws + (dir ? OFF_AB : OFF_AF)); const float* fw = (const float*)(p.ws + (dir ? OFF_WB : OFF_WF));
    float* yo = (float*)(p.ws + (dir ? OFF_YB : OFF_YF));
    float St[64];
#pragma unroll
    for (int j = 0; j < 64; ++j) St[j] = 0.f;
    for (int blk = 0; blk < NT / 64; ++blk) {
        {
            const int n = blk * 64 + lane;
            const int g = dir == 0 ? n : (n < CTX ? CTX - 1 - n : NT - 1 - (n - CTX));
            const size_t base = (size_t)g * DR + h * 64;
            float ss = 0.f;
#pragma unroll
            for (int ch = 0; ch < 8; ++ch) {
                float kv[8]; unpack8(*(const u32x4*)(fk + base + ch * 8), kv);
#pragma unroll
                for (int j = 0; j < 8; ++j) { const float q = kv[j] * p.k_k[h * 64 + ch * 8 + j]; ss += q * q; }
            }
            const float inv = 1.f / fmaxf(sqrtf(ss), 1e-12f);
#pragma unroll
            for (int ch = 0; ch < 8; ++ch) {
                float kv[8], av[8], rv[8], vv[8];
                unpack8(*(const u32x4*)(fk + base + ch * 8), kv); unpack8(*(const u32x4*)(fa + base + ch * 8), av);
                unpack8(*(const u32x4*)(fr_ + base + ch * 8), rv); unpack8(*(const u32x4*)(fv + base + ch * 8), vv);
                const f32x4 w0 = *(const f32x4*)(fw + base + ch * 8), w1 = *(const f32x4*)(fw + base + ch * 8 + 4);
#pragma unroll
                for (int hh = 0; hh < 2; ++hh) {
                    f32x4 okf, okka, onkk, orr, ovv;
#pragma unroll
                    for (int j = 0; j < 4; ++j) {
                        const int jj = hh * 4 + j, c = h * 64 + ch * 8 + jj;
                        const float kkn = kv[jj] * p.k_k[c] * inv;
                        okf[j] = kv[jj] * (1.f + (av[jj] - 1.f) * p.k_a[c]);
                        okka[j] = kkn * av[jj]; onkk[j] = -kkn; orr[j] = rv[jj]; ovv[j] = vv[jj];
                    }
                    const int o = lane * SCAN_PITCH + ch * 8 + hh * 4;
                    *(f32x4*)(sKF + o) = okf; *(f32x4*)(sKKA + o) = okka; *(f32x4*)(sNKK + o) = onkk; *(f32x4*)(sR + o) = orr; *(f32x4*)(sV + o) = ovv;
                    *(f32x4*)(sW + o) = hh ? w1 : w0;
                }
            }
        }
        asm volatile("s_waitcnt vmcnt(0) lgkmcnt(0)" ::: "memory"); __builtin_amdgcn_wave_barrier();
        for (int s = 0; s < 64; ++s) {
            const int n = blk * 64 + s;
            const int g = dir == 0 ? n : (n < CTX ? CTX - 1 - n : NT - 1 - (n - CTX));
            const int o = s * SCAN_PITCH;
            float sa = 0.f;
#pragma unroll
            for (int j4 = 0; j4 < 16; ++j4) { const f32x4 q = *(const f32x4*)(sNKK + o + j4 * 4); sa += St[j4 * 4] * q[0] + St[j4 * 4 + 1] * q[1] + St[j4 * 4 + 2] * q[2] + St[j4 * 4 + 3] * q[3]; }
            const float vi = sV[o + lane];
            float y = 0.f;
#pragma unroll
            for (int j4 = 0; j4 < 16; ++j4) {
                const f32x4 w = *(const f32x4*)(sW + o + j4 * 4), ka = *(const f32x4*)(sKKA + o + j4 * 4), kf = *(const f32x4*)(sKF + o + j4 * 4), r = *(const f32x4*)(sR + o + j4 * 4);
#pragma unroll
                for (int j = 0; j < 4; ++j) { const float ns = St[j4 * 4 + j] * w[j] + (sa * ka[j] + vi * kf[j]); St[j4 * 4 + j] = ns; y += ns * r[j]; }
            }
            if (g >= CTX) yo[(size_t)(g - CTX) * DR + h * 64 + lane] = y;
        }
        asm volatile("s_waitcnt vmcnt(0) lgkmcnt(0)" ::: "memory"); __builtin_amdgcn_wave_barrier();
    }
}

DI void phase_combine(const Params& p, int bid, int nblk) {
    const int lane = threadIdx.x & 63, wid = threadIdx.x >> 6;
    const float* yf = (const float*)(p.ws + OFF_YF); const float* yb = (const float*)(p.ws + OFF_YB);
    bf16_t* mix = (bf16_t*)(p.ws + OFF_MIX);
    for (int t = bid * 4 + wid; t < S; t += nblk * 4) {
        const int c0 = lane * 8; const size_t gb = (size_t)(t + CTX) * DR + c0;
        float y[8];
        { const f32x4 a0 = *(const f32x4*)(yf + (size_t)t * DR + c0), a1 = *(const f32x4*)(yf + (size_t)t * DR + c0 + 4), b0 = *(const f32x4*)(yb + (size_t)t * DR + c0), b1 = *(const f32x4*)(yb + (size_t)t * DR + c0 + 4);
          for (int j = 0; j < 4; ++j) { y[j] = a0[j] + b0[j]; y[4 + j] = a1[j] + b1[j]; } }
        float s = 0.f; for (int j = 0; j < 8; ++j) s += y[j];
        s += __shfl_xor(s, 1, 64); s += __shfl_xor(s, 2, 64); s += __shfl_xor(s, 4, 64);
        const float mean = s * (1.f / 64.f);
        float q = 0.f; for (int j = 0; j < 8; ++j) { const float d = y[j] - mean; q += d * d; }
        q += __shfl_xor(q, 1, 64); q += __shfl_xor(q, 2, 64); q += __shfl_xor(q, 4, 64);
        const float rs = rsqrtf(q * (1.f / 64.f) + 64e-5f);
        float r[8], k[8], v[8], af[8], ab[8], gg[8];
        unpack8(*(const u32x4*)((const bf16_t*)(p.ws + OFF_R) + gb), r); unpack8(*(const u32x4*)((const bf16_t*)(p.ws + OFF_K) + gb), k);
        unpack8(*(const u32x4*)((const bf16_t*)(p.ws + OFF_V) + gb), v); unpack8(*(const u32x4*)((const bf16_t*)(p.ws + OFF_AF) + gb), af);
        unpack8(*(const u32x4*)((const bf16_t*)(p.ws + OFF_AB) + gb), ab); unpack8(*(const u32x4*)((const bf16_t*)(p.ws + OFF_G) + (size_t)t * DR + c0), gg);
        float bsum = 0.f;
        for (int j = 0; j < 8; ++j) {
            const int c = c0 + j; const float ka = p.k_a[c];
            const float kf = k[j] * (1.f + (af[j] - 1.f) * ka), kb = k[j] * (1.f + (ab[j] - 1.f) * ka);
            bsum += r[j] * (kf * p.r_k_f[c] + kb * p.r_k_b[c]);
        }
        bsum += __shfl_xor(bsum, 1, 64); bsum += __shfl_xor(bsum, 2, 64); bsum += __shfl_xor(bsum, 4, 64);
        float o[8];
        for (int j = 0; j < 8; ++j) { const int c = c0 + j; o[j] = ((y[j] - mean) * rs * p.gn_w[c] + p.gn_b[c] + bsum * v[j]) * gg[j]; }
        *(u32x4*)(mix + (size_t)t * D + c0) = pack8(o);
    }
}

struct EpiX2 { float* o; const float* x; const float* gt; const float* rowtab; const float* coltab; int row0, col0;
    DI void operator()(int r, int c, const f32x4& v, const f32x4&) const {
        const int t = row0 + r, d = col0 + c; const f32x4 xv = *(const f32x4*)(x + (size_t)t * D + d); f32x4 res;
#pragma unroll
        for (int j = 0; j < 4; ++j) res[j] = xv[j] + pos_val(rowtab, coltab, t, d + j) + gt[d + j] * v[j];
        *(f32x4*)(o + (size_t)t * D + d) = res; } };
DI void phase_g2(const Params& p, int bid, int nblk, char* lds) {
    const bf16_t* mix = (const bf16_t*)(p.ws + OFF_MIX);
    for (int item = bid; item < 128 * 8; item += nblk) {
        const int tm = item >> 3, tn = item & 7;
        PlainA al{mix + (size_t)tm * 128 * D, D};
        EpiX2 e{(float*)(p.ws + OFF_X2), p.x, (const float*)(p.ws + OFF_MODX) + 2048, (const float*)(p.ws + OFF_ROWTAB), (const float*)(p.ws + OFF_COLTAB), tm * 128, tn * 128};
        gemm128<1>(al, p.w_out + tn * 128, nullptr, D, D, lds, e);
    }
}

DI void phase_router(const Params& p, int bid, int nblk) {
    const int lane = threadIdx.x & 63, wid = threadIdx.x >> 6;
    const float* x2 = (const float*)(p.ws + OFF_X2); const float* modx = (const float*)(p.ws + OFF_MODX);
    bf16_t* h2 = (bf16_t*)(p.ws + OFF_H2); int* cnt = (int*)(p.ws + OFF_CNT); float* gate = (float*)(p.ws + OFF_GATE); int* list = (int*)(p.ws + OFF_LIST);
    for (int t = bid * 4 + wid; t < S; t += nblk * 4) {
        f32x4 v[4]; float ss = 0.f;
#pragma unroll
        for (int i = 0; i < 4; ++i) { v[i] = *(const f32x4*)(x2 + (size_t)t * D + (i * 64 + lane) * 4); ss += v[i][0] * v[i][0] + v[i][1] * v[i][1] + v[i][2] * v[i][2] + v[i][3] * v[i][3]; }
        ss = wave_sum(ss);
        const float rstd = rsqrtf(ss * (1.f / 1024.f) + 1e-6f);
        f32x4 lg4 = {0, 0, 0, 0}, le4[8];
#pragma unroll
        for (int n = 0; n < 8; ++n) le4[n] = (f32x4){0, 0, 0, 0};
#pragma unroll
        for (int i = 0; i < 4; ++i) {
            const int d = (i * 64 + lane) * 4;
            const f32x4 gg = *(const f32x4*)(p.norm2_g + d), sh = *(const f32x4*)(modx + 3072 + d), sc = *(const f32x4*)(modx + 4096 + d);
            f32x4 hv;
#pragma unroll
            for (int j = 0; j < 4; ++j) hv[j] = (v[i][j] * rstd * gg[j]) * (1.f + sc[j]) + sh[j];
            u32x2 pk = {pack2(hv[0], hv[1]), pack2(hv[2], hv[3])};
            *(u32x2*)(h2 + (size_t)t * D + d) = pk;
#pragma unroll
            for (int j = 0; j < 4; ++j) {
                const float hj = hv[j];
                lg4 += *(const f32x4*)(p.w_rg + (size_t)(d + j) * 4) * hj;
#pragma unroll
                for (int n4 = 0; n4 < 8; ++n4) le4[n4] += *(const f32x4*)(p.w_re + (size_t)(d + j) * 32 + n4 * 4) * hj;
            }
        }
        lg4 = wave_sum4(lg4);
#pragma unroll
        for (int n = 0; n < 8; ++n) le4[n] = wave_sum4(le4[n]);
        const float l0 = lg4[0] + p.b_rg[0], l1 = lg4[1] + p.b_rg[1], l2 = lg4[2] + p.b_rg[2], l3 = lg4[3] + p.b_rg[3];
        int grp = 0; float mx = l0;
        if (l1 > mx) { mx = l1; grp = 1; }
        if (l2 > mx) { mx = l2; grp = 2; }
        if (l3 > mx) { mx = l3; grp = 3; }
        const float den = __expf(l0 - mx) + __expf(l1 - mx) + __expf(l2 - mx) + __expf(l3 - mx);
        const float pgrp = 1.f / den;
        const float m0 = grp == 0 ? 1.f : 0.f, m1 = grp == 1 ? 1.f : 0.f, m2 = grp == 2 ? 1.f : 0.f, m3 = grp == 3 ? 1.f : 0.f;
        f32x4 sa = le4[0] * m0 + le4[2] * m1 + le4[4] * m2 + le4[6] * m3;
        f32x4 sb = le4[1] * m0 + le4[3] * m1 + le4[5] * m2 + le4[7] * m3;
        sa += *(const f32x4*)(p.b_re + grp * 8); sb += *(const f32x4*)(p.b_re + grp * 8 + 4);
        const float s0 = sa[0], s1 = sa[1], s2 = sa[2], s3 = sa[3], s4 = sb[0], s5 = sb[1], s6 = sb[2], s7 = sb[3];
        int i1 = 0; float v1 = s0;
        if (s1 > v1) { v1 = s1; i1 = 1; }
        if (s2 > v1) { v1 = s2; i1 = 2; }
        if (s3 > v1) { v1 = s3; i1 = 3; }
        if (s4 > v1) { v1 = s4; i1 = 4; }
        if (s5 > v1) { v1 = s5; i1 = 5; }
        if (s6 > v1) { v1 = s6; i1 = 6; }
        if (s7 > v1) { v1 = s7; i1 = 7; }
        int i2 = -1; float v2 = -3.0e38f;
        if (i1 != 0 && s0 > v2) { v2 = s0; i2 = 0; }
        if (i1 != 1 && s1 > v2) { v2 = s1; i2 = 1; }
        if (i1 != 2 && s2 > v2) { v2 = s2; i2 = 2; }
        if (i1 != 3 && s3 > v2) { v2 = s3; i2 = 3; }
        if (i1 != 4 && s4 > v2) { v2 = s4; i2 = 4; }
        if (i1 != 5 && s5 > v2) { v2 = s5; i2 = 5; }
        if (i1 != 6 && s6 > v2) { v2 = s6; i2 = 6; }
        if (i1 != 7 && s7 > v2) { v2 = s7; i2 = 7; }
        const float e2 = __expf(v2 - v1), g1 = pgrp / (1.f + e2), g2v = pgrp * e2 / (1.f + e2);
        if (lane == 0) {
            const int ea = grp * 8 + i1, eb = grp * 8 + i2;
            const int pa = atomicAdd(&cnt[ea], 1), pb = atomicAdd(&cnt[eb], 1);
            list[ea * LCAP + pa] = t * 2; list[eb * LCAP + pb] = t * 2 + 1;
            gate[t * 2] = g1; gate[t * 2 + 1] = g2v;
        }
    }
}

DI void moe_tiles(const int* cnt, int* tstart  ) {
    if (threadIdx.x == 0) { int acc = 0; for (int e = 0; e < NE; ++e) { tstart[e] = acc; acc += (cnt[e] + 127) >> 7; } tstart[NE] = acc; }
    __syncthreads();
}
struct EpiHid { bf16_t* o; DI void operator()(int r, int c, const f32x4& g, const f32x4& u) const {
    float h[4];
#pragma unroll
    for (int j = 0; j < 4; ++j) h[j] = g[j] * sigmoidf_(g[j]) * u[j];
    u32x2 pk = {pack2(h[0], h[1]), pack2(h[2], h[3])}; *(u32x2*)(o + (size_t)r * DE + c) = pk; } };
DI void phase_g3(const Params& p, int bid, int nblk, char* lds) {
    int* tstart = (int*)(lds + GEMM_LDS);
    const int* cnt = (const int*)(p.ws + OFF_CNT); const int* list = (const int*)(p.ws + OFF_LIST);
    const bf16_t* h2 = (const bf16_t*)(p.ws + OFF_H2); bf16_t* hid = (bf16_t*)(p.ws + OFF_HID);
    moe_tiles(cnt, tstart);
    const int ntiles = tstart[NE];
    for (int item = bid; item < ntiles * 4; item += nblk) {
        const int ti = item >> 2, cj = item & 3;
        int e = 0; while (e < NE - 1 && tstart[e + 1] <= ti) ++e;
        const int lt = ti - tstart[e], ne = cnt[e];
        GatherA al;
#pragma unroll
        for (int i = 0; i < 2; ++i) { const int row = (threadIdx.x + 256 * i) >> 2, pos = lt * 128 + row; const int tok = pos < ne ? (list[e * LCAP + pos] >> 1) : 0; al.rp[i] = h2 + (size_t)tok * D; }
        EpiHid epi{hid + (size_t)ti * 128 * DE + cj * 128};
        gemm128<2>(al, p.w_gate + (size_t)e * D * DE + cj * 128, p.w_up + (size_t)e * D * DE + cj * 128, DE, D, lds, epi);
    }
}
struct EpiDown { bf16_t* ybuf; const int* lst; const float* gate; int nvalid; int col0;
    DI void operator()(int r, int c, const f32x4& v, const f32x4&) const {
        if (r >= nvalid) return; const int slot = lst[r]; const float g = gate[slot];
        u32x2 pk = {pack2(v[0] * g, v[1] * g), pack2(v[2] * g, v[3] * g)}; *(u32x2*)(ybuf + (size_t)slot * D + col0 + c) = pk; } };
DI void phase_g4(const Params& p, int bid, int nblk, char* lds) {
    int* tstart = (int*)(lds + GEMM_LDS);
    const int* cnt = (const int*)(p.ws + OFF_CNT); const int* list = (const int*)(p.ws + OFF_LIST);
    const bf16_t* hid = (const bf16_t*)(p.ws + OFF_HID);
    moe_tiles(cnt, tstart);
    const int ntiles = tstart[NE];
    for (int item = bid; item < ntiles * 8; item += nblk) {
        const int ti = item >> 3, cj = item & 7;
        int e = 0; while (e < NE - 1 && tstart[e + 1] <= ti) ++e;
        const int lt = ti - tstart[e], ne = cnt[e];
        PlainA al{hid + (size_t)ti * 128 * DE, DE};
        EpiDown epi{(bf16_t*)(p.ws + OFF_YBUF), list + e * LCAP + lt * 128, (const float*)(p.ws + OFF_GATE), ne - lt * 128, cj * 128};
        gemm128<1>(al, p.w_down + (size_t)e * DE * D + cj * 128, nullptr, D, DE, lds, epi);
    }
}

DI void phase_final(const Params& p, int bid, int nblk) {
    const int lane = threadIdx.x & 63, wid = threadIdx.x >> 6;
    const float* x2 = (const float*)(p.ws + OFF_X2); const float* gt = (const float*)(p.ws + OFF_MODX) + 5120; const bf16_t* yb = (const bf16_t*)(p.ws + OFF_YBUF);
    for (int t = bid * 4 + wid; t < S; t += nblk * 4) {
        f32x4 v[4]; float ss = 0.f;
#pragma unroll
        for (int i = 0; i < 4; ++i) {
            const int d = (i * 64 + lane) * 4;
            v[i] = *(const f32x4*)(x2 + (size_t)t * D + d);
            const u32x2 a = *(const u32x2*)(yb + (size_t)(2 * t) * D + d), b = *(const u32x2*)(yb + (size_t)(2 * t + 1) * D + d);
            const f32x4 g = *(const f32x4*)(gt + d);
            v[i][0] += g[0] * (bflo(a.x) + bflo(b.x)); v[i][1] += g[1] * (bfhi(a.x) + bfhi(b.x));
            v[i][2] += g[2] * (bflo(a.y) + bflo(b.y)); v[i][3] += g[3] * (bfhi(a.y) + bfhi(b.y));
            ss += v[i][0] * v[i][0] + v[i][1] * v[i][1] + v[i][2] * v[i][2] + v[i][3] * v[i][3];
        }
        ss = wave_sum(ss);
        const float rstd = rsqrtf(ss * (1.f / 1024.f) + 1e-6f);
#pragma unroll
        for (int i = 0; i < 4; ++i) {
            const int d = (i * 64 + lane) * 4; const f32x4 fg = *(const f32x4*)(p.final_g + d); f32x4 o;
#pragma unroll
            for (int j = 0; j < 4; ++j) o[j] = v[i][j] * rstd * fg[j];
            *(f32x4*)(p.out + (size_t)t * D + d) = o;
        }
    }
}

constexpr int MEGA_LDS = SCAN_LDS > (GEMM_LDS + 256) ? SCAN_LDS : (GEMM_LDS + 256);
__global__ void __launch_bounds__(256) k_mega(Params p) {
    extern __shared__ __attribute__((aligned(16))) char lds[];
    cg::grid_group grid = cg::this_grid();
    const int bid = blockIdx.x, nblk = gridDim.x;
    phase_p0(p, bid, nblk, lds); grid.sync();
    phase_xn(p, bid, nblk); grid.sync();
    phase_g1(p, bid, nblk, lds); grid.sync();
    phase_feat(p, bid, nblk); grid.sync();
    phase_lora(p, bid, nblk, lds); grid.sync();
    if (bid < 16 && threadIdx.x < 64) phase_scan(p, bid, lds);
    grid.sync();
    phase_combine(p, bid, nblk); grid.sync();
    phase_g2(p, bid, nblk, lds); grid.sync();
    phase_router(p, bid, nblk); grid.sync();
    phase_g3(p, bid, nblk, lds); grid.sync();
    phase_g4(p, bid, nblk, lds); grid.sync();
    phase_final(p, bid, nblk);
}

extern "C" void kernel_launch(void* const* d_in, const int* in_sizes, int n_in, void* d_out, int out_size, void* d_ws, size_t ws_size, hipStream_t stream) {
    if (ws_size < WS_NEED) { fprintf(stderr, "workspace too small: %zu < %zu\n", ws_size, (size_t)WS_NEED); return; }
    Params p{};
    const float** f = (const float**)&p;
    for (int i = 0; i < 36; ++i) f[i] = (const float*)d_in[i];
    p.out = (float*)d_out; p.ws = (char*)d_ws;
    static int grid_blocks = 0;
    if (!grid_blocks) {
        (void)hipFuncSetAttribute((const void*)k_mega, hipFuncAttributeMaxDynamicSharedMemorySize, MEGA_LDS);
        int dev = 0, cus = 0, per_cu = 0;
        (void)hipGetDevice(&dev);
        (void)hipDeviceGetAttribute(&cus, hipDeviceAttributeMultiprocessorCount, dev);
        (void)hipOccupancyMaxActiveBlocksPerMultiprocessor(&per_cu, k_mega, 256, MEGA_LDS);
        if (per_cu > 1) per_cu = 1;
        grid_blocks = cus * per_cu;
    }
    void* args[] = {&p};
    hipError_t e = hipLaunchCooperativeKernel((const void*)k_mega, dim3(grid_blocks), dim3(256), args, MEGA_LDS, stream);
    if (e != hipSuccess) fprintf(stderr, "cooperative launch failed: %s (grid %d)\n", hipGetErrorString(e), grid_blocks);
}
```

```cpp
#include <hip/hip_runtime.h>
#include <stdint.h>
#include <stdio.h>
#include <hip/hip_cooperative_groups.h>
namespace cg = cooperative_groups;

#define DI __device__ __forceinline__
typedef unsigned short bf16_t;
typedef short bf16x8 __attribute__((ext_vector_type(8)));
typedef short s16x4 __attribute__((ext_vector_type(4)));
typedef float f32x4 __attribute__((ext_vector_type(4)));
typedef float f32x2 __attribute__((ext_vector_type(2)));
typedef __bf16 bf16x2_t __attribute__((ext_vector_type(2)));
typedef unsigned u32x4 __attribute__((ext_vector_type(4)));
typedef unsigned u32x2 __attribute__((ext_vector_type(2)));
#define LAS __attribute__((address_space(3)))

constexpr int D = 1024, S = 16384, CTX = 256, NT = S + CTX, DIN = 2432, DSH = 1920, DR = 512;
constexpr int C_WLF = 1536, C_WLB = 1600, C_ALF = 1664, C_ALB = 1728, C_GL = 1792, C_POOL = 1920;
constexpr int NE = 32, DE = 512, LCAP = 32768;
constexpr float DECAY_SCALE = 0.6065306597f;

constexpr int NCH = NT / 64;
constexpr size_t SZ_U = (size_t)NT * DIN * 2;
constexpr size_t SZ_CH = (size_t)16 * NCH * 8192;
constexpr size_t OFF_U = 0;
constexpr size_t OFF_XN = OFF_U + SZ_U;
constexpr size_t OFF_P = OFF_XN;
constexpr size_t OFF_Q = OFF_P + SZ_CH;
constexpr size_t OFF_WYT = OFF_Q + SZ_CH;
constexpr size_t OFF_YL = OFF_WYT + (size_t)256 * 16 * 8192;
constexpr size_t OFF_V = OFF_YL + (size_t)256 * 16 * 8192;
constexpr size_t OFF_G = OFF_V + (size_t)S * DR * 2;
constexpr size_t OFF_MIX = OFF_G + (size_t)S * DR * 2;
constexpr size_t OFF_SMALL = OFF_MIX + (size_t)S * D * 2;
constexpr size_t OFF_MODX = OFF_SMALL, OFF_MODC = OFF_MODX + 6144 * 4;
constexpr size_t OFF_ROWTAB = OFF_MODC + 6144 * 4, OFF_COLTAB = OFF_ROWTAB + 256 * 512 * 4;
constexpr size_t OFF_CNT = OFF_COLTAB + 64 * 512 * 4;
constexpr size_t OFF_GATE = OFF_CNT + 256;
constexpr size_t OFF_LIST = OFF_GATE + (size_t)S * 2 * 4;
constexpr size_t OFF_DOT = OFF_LIST + (size_t)NE * LCAP * 4;
constexpr size_t WS_NEED = OFF_DOT + (size_t)NT * 16 * 4;
constexpr size_t OFF_Z = OFF_U;
constexpr size_t OFF_X2 = OFF_P;
constexpr size_t OFF_YBUF = OFF_WYT;
constexpr size_t OFF_H2 = OFF_U;
constexpr size_t OFF_HID = OFF_U + SZ_CH;

struct Params {
    const float *x, *c, *ctx, *c_ctx, *norm1_g, *w_mod, *b_mod, *w_in, *mu, *w0_f, *w2_f, *w0_b, *w2_b, *a0_f, *a2_f, *a0_b, *a2_b,
        *g2, *k_k, *k_a, *r_k_f, *r_k_b, *gn_w, *gn_b, *w_pool, *pool_scale, *w_out, *norm2_g, *w_rg, *b_rg, *w_re, *b_re,
        *w_gate, *w_up, *w_down, *final_g;
    float* out;
    char* ws;
};

DI unsigned pack2(float lo, float hi) { f32x2 v = {lo, hi}; bf16x2_t b = __builtin_convertvector(v, bf16x2_t); return __builtin_bit_cast(unsigned, b); }
DI float bf2f(bf16_t h) { return __uint_as_float(((unsigned)h) << 16); }
DI float bflo(unsigned u) { return __uint_as_float(u << 16); }
DI float bfhi(unsigned u) { return __uint_as_float(u & 0xffff0000u); }
DI void unpack8(const u32x4& p, float* f) { f[0] = bflo(p.x); f[1] = bfhi(p.x); f[2] = bflo(p.y); f[3] = bfhi(p.y); f[4] = bflo(p.z); f[5] = bfhi(p.z); f[6] = bflo(p.w); f[7] = bfhi(p.w); }
DI u32x4 pack8(const float* f) { u32x4 p; p.x = pack2(f[0], f[1]); p.y = pack2(f[2], f[3]); p.z = pack2(f[4], f[5]); p.w = pack2(f[6], f[7]); return p; }
DI float sigmoidf_(float x) { return 1.f / (1.f + __expf(-x)); }
DI float wave_sum(float v) {
#pragma unroll
    for (int o = 32; o > 0; o >>= 1) v += __shfl_xor(v, o, 64);
    return v;
}
DI f32x4 wave_sum4(f32x4 v) {
#pragma unroll
    for (int o = 32; o > 0; o >>= 1) { v[0] += __shfl_xor(v[0], o, 64); v[1] += __shfl_xor(v[1], o, 64); v[2] += __shfl_xor(v[2], o, 64); v[3] += __shfl_xor(v[3], o, 64); }
    return v;
}
DI float pos_val(const float* rowtab, const float* coltab, int t, int d) { return d < 512 ? rowtab[(t >> 6) * 512 + d] : coltab[(t & 63) * 512 + (d - 512)]; }

DI void phase_p0(const Params& p, int bid, int nblk, char* lds) {
    const int tid = threadIdx.x;
    float* modx = (float*)(p.ws + OFF_MODX); float* modc = (float*)(p.ws + OFF_MODC);
    float* red = (float*)lds;
    for (int item = bid; item < 96; item += nblk) {
        const int col0 = item * 64, cg = tid & 15, kg = tid >> 4;
        f32x4 ax = {0, 0, 0, 0}, ac = {0, 0, 0, 0};
        for (int kk = 0; kk < 64; ++kk) {
            const int k = kg * 64 + kk;
            const float cv = p.c[k], cc = p.c_ctx[k];
            const float sx = cv * sigmoidf_(cv), sc = cc * sigmoidf_(cc);
            const f32x4 w = *(const f32x4*)(p.w_mod + (size_t)k * 6144 + col0 + cg * 4);
            ax += w * sx; ac += w * sc;
        }
        __syncthreads();
#pragma unroll
        for (int j = 0; j < 4; ++j) { red[(kg * 64 + cg * 4 + j) * 2] = ax[j]; red[(kg * 64 + cg * 4 + j) * 2 + 1] = ac[j]; }
        __syncthreads();
        if (tid < 128) {
            const int col = tid & 63, which = tid >> 6;
            float s = 0.f;
            for (int g = 0; g < 16; ++g) s += red[(g * 64 + col) * 2 + which];
            s += p.b_mod[col0 + col];
            (which ? modc : modx)[col0 + col] = s;
        }
    }
    float* rowtab = (float*)(p.ws + OFF_ROWTAB); float* coltab = (float*)(p.ws + OFF_COLTAB);
    for (int i = bid * 256 + tid; i < (256 + 64) * 256; i += nblk * 256) {
        const int pos = i >> 8, f = i & 255;
        const float freq = powf(10000.f, -(float)f / 256.f);
        if (pos < 256) { const float a = (float)pos * freq; rowtab[pos * 512 + f] = sinf(a); rowtab[pos * 512 + 256 + f] = cosf(a); }
        else { const int cp = pos - 256; const float a = (float)cp * freq; coltab[cp * 512 + f] = sinf(a); coltab[cp * 512 + 256 + f] = cosf(a); }
    }
    if (bid == 0 && tid < 64) ((int*)(p.ws + OFF_CNT))[tid] = 0;
}

DI void phase_xn(const Params& p, int bid, int nblk) {
    const int lane = threadIdx.x & 63, wid = threadIdx.x >> 6;
    const float* modx = (const float*)(p.ws + OFF_MODX); const float* modc = (const float*)(p.ws + OFF_MODC);
    const float* rowtab = (const float*)(p.ws + OFF_ROWTAB); const float* coltab = (const float*)(p.ws + OFF_COLTAB);
    bf16_t* xn = (bf16_t*)(p.ws + OFF_XN);
    for (int g = bid * 4 + wid; g < NT; g += nblk * 4) {
        const bool isctx = g < CTX; const int t = g - CTX;
        const float* src = isctx ? p.ctx + (size_t)g * D : p.x + (size_t)t * D;
        const float* md = isctx ? modc : modx;
        f32x4 v[4]; float ss = 0.f;
#pragma unroll
        for (int i = 0; i < 4; ++i) {
            const int d = (i * 64 + lane) * 4;
            v[i] = *(const f32x4*)(src + d);
            if (!isctx) {
#pragma unroll
                for (int j = 0; j < 4; ++j) v[i][j] += pos_val(rowtab, coltab, t, d + j);
            }
            ss += v[i][0] * v[i][0] + v[i][1] * v[i][1] + v[i][2] * v[i][2] + v[i][3] * v[i][3];
        }
        ss = wave_sum(ss);
        const float rstd = rsqrtf(ss * (1.f / 1024.f) + 1e-6f);
#pragma unroll
        for (int i = 0; i < 4; ++i) {
            const int d = (i * 64 + lane) * 4;
            const f32x4 gg = *(const f32x4*)(p.norm1_g + d), sh = *(const f32x4*)(md + d), sc = *(const f32x4*)(md + 1024 + d);
            f32x4 o;
#pragma unroll
            for (int j = 0; j < 4; ++j) o[j] = (v[i][j] * rstd * gg[j]) * (1.f + sc[j]) + sh[j];
            u32x2 pk = {pack2(o[0], o[1]), pack2(o[2], o[3])};
            *(u32x2*)(xn + (size_t)g * D + d) = pk;
        }
    }
}

constexpr int GEMM_LDS = 10240 + 2 * 8704;
template <int NB, class AL, class EPI>
DI void gemm128(AL& al, const float* __restrict__ B0, const float* __restrict__ B1, int ldb, int K, char* lds, EPI& epi) {
    const int tid = threadIdx.x, lane = tid & 63, wid = tid >> 6, wr = wid >> 1, wc = wid & 1, fr = lane & 15, fq = lane >> 4;
    bf16_t* sA = (bf16_t*)lds; bf16_t* sB0 = (bf16_t*)(lds + 10240); bf16_t* sB1 = (bf16_t*)(lds + 10240 + 8704);
    f32x4 acc0[4][4], acc1[4][4];
#pragma unroll
    for (int m = 0; m < 4; ++m)
#pragma unroll
        for (int n = 0; n < 4; ++n) { acc0[m][n] = (f32x4){0, 0, 0, 0}; acc1[m][n] = (f32x4){0, 0, 0, 0}; }
    u32x4 ra[2]; f32x4 rb0[4], rb1[4];
    auto gload = [&](int k0) {
#pragma unroll
        for (int i = 0; i < 2; ++i) { const int c = tid + 256 * i; ra[i] = al.load(i, c >> 2, k0 + (c & 3) * 8); }
#pragma unroll
        for (int i = 0; i < 4; ++i) {
            const int c = tid + 256 * i, kr = c >> 5, n4 = c & 31;
            rb0[i] = *(const f32x4*)(B0 + (size_t)(k0 + kr) * ldb + n4 * 4);
            if (NB == 2) rb1[i] = *(const f32x4*)(B1 + (size_t)(k0 + kr) * ldb + n4 * 4);
        }
    };
    gload(0);
    for (int k0 = 0; k0 < K; k0 += 32) {
        __syncthreads();
#pragma unroll
        for (int i = 0; i < 2; ++i) { const int c = tid + 256 * i; *(u32x4*)(sA + (c >> 2) * 40 + (c & 3) * 8) = ra[i]; }
#pragma unroll
        for (int i = 0; i < 4; ++i) {
            const int c = tid + 256 * i, kr = c >> 5, n4 = c & 31;
            u32x2 pk = {pack2(rb0[i][0], rb0[i][1]), pack2(rb0[i][2], rb0[i][3])};
            *(u32x2*)(sB0 + kr * 136 + n4 * 4) = pk;
            if (NB == 2) { u32x2 pk1 = {pack2(rb1[i][0], rb1[i][1]), pack2(rb1[i][2], rb1[i][3])}; *(u32x2*)(sB1 + kr * 136 + n4 * 4) = pk1; }
        }
        __syncthreads();
        if (k0 + 32 < K) gload(k0 + 32);
        bf16x8 af[4], bf0[4], bf1[4];
#pragma unroll
        for (int m = 0; m < 4; ++m) af[m] = *(const bf16x8*)(sA + (wr * 64 + m * 16 + fr) * 40 + fq * 8);
#pragma unroll
        for (int n = 0; n < 4; ++n) {
            const int off = (fq * 8 + (fr >> 2)) * 136 + wc * 64 + n * 16 + 4 * (fr & 3);
            s16x4 lo = __builtin_amdgcn_ds_read_tr16_b64_v4i16((LAS s16x4*)(sB0 + off));
            s16x4 hi = __builtin_amdgcn_ds_read_tr16_b64_v4i16((LAS s16x4*)(sB0 + off + 4 * 136));
            bf0[n] = __builtin_shufflevector(lo, hi, 0, 1, 2, 3, 4, 5, 6, 7);
            if (NB == 2) {
                s16x4 lo1 = __builtin_amdgcn_ds_read_tr16_b64_v4i16((LAS s16x4*)(sB1 + off));
                s16x4 hi1 = __builtin_amdgcn_ds_read_tr16_b64_v4i16((LAS s16x4*)(sB1 + off + 4 * 136));
                bf1[n] = __builtin_shufflevector(lo1, hi1, 0, 1, 2, 3, 4, 5, 6, 7);
            }
        }
#pragma unroll
        for (int m = 0; m < 4; ++m)
#pragma unroll
            for (int n = 0; n < 4; ++n) {
                acc0[m][n] = __builtin_amdgcn_mfma_f32_16x16x32_bf16(bf0[n], af[m], acc0[m][n], 0, 0, 0);
                if (NB == 2) acc1[m][n] = __builtin_amdgcn_mfma_f32_16x16x32_bf16(bf1[n], af[m], acc1[m][n], 0, 0, 0);
            }
    }
#pragma unroll
    for (int m = 0; m < 4; ++m)
#pragma unroll
        for (int n = 0; n < 4; ++n) epi(wr * 64 + m * 16 + fr, wc * 64 + n * 16 + 4 * fq, acc0[m][n], acc1[m][n]);
    __syncthreads();
}

struct PlainA {
    const bf16_t* base; int lda;
    DI u32x4 load(int, int row, int k) const { return *(const u32x4*)(base + (size_t)row * lda + k); }
};
struct GatherA {
    const bf16_t* rp[2];
    DI u32x4 load(int i, int, int k) const { return *(const u32x4*)(rp[i] + k); }
};
template <int ACT> struct LoraA {
    const bf16_t* u; const float* mu; int row0, cb;
    DI u32x4 load(int, int row, int k) const {
        const int g = row0 + row;
        const bf16_t* pc = u + (size_t)g * DIN + cb + k;
        float c[8], pv[8], nx[8];
        unpack8(*(const u32x4*)pc, c);
        const bool hasp = (g != 0) && (g != CTX), hasn = (g != CTX - 1) && (g != NT - 1);
        if (hasp) unpack8(*(const u32x4*)(pc - DIN), pv); else { for (int j = 0; j < 8; ++j) pv[j] = 0.f; }
        if (hasn) unpack8(*(const u32x4*)(pc + DIN), nx); else { for (int j = 0; j < 8; ++j) nx[j] = 0.f; }
        float o[8];
#pragma unroll
        for (int j = 0; j < 8; ++j) {
            const float m = mu[cb + k + j];
            float s = c[j] + m * (0.5f * (pv[j] + nx[j]) - c[j]);
            if (ACT == 1) s = tanhf(s); else if (ACT == 2) s = sigmoidf_(s);
            o[j] = s;
        }
        return pack8(o);
    }
};

struct EpiStoreBf16 { bf16_t* o; int ldo; DI void operator()(int r, int c, const f32x4& v, const f32x4&) const { u32x2 pk = {pack2(v[0], v[1]), pack2(v[2], v[3])}; *(u32x2*)(o + (size_t)r * ldo + c) = pk; } };
DI void phase_g1(const Params& p, int bid, int nblk, char* lds) {
    const bf16_t* xn = (const bf16_t*)(p.ws + OFF_XN); bf16_t* u = (bf16_t*)(p.ws + OFF_U);
    for (int item = bid; item < 130 * 19; item += nblk) {
        const int tm = item / 19, tn = item % 19;
        PlainA al{xn + (size_t)tm * 128 * D, D};
        EpiStoreBf16 epi{u + (size_t)tm * 128 * DIN + tn * 128, DIN};
        gemm128<1>(al, p.w_in + tn * 128, nullptr, DIN, D, lds, epi);
    }
}

DI void phase_pool(const Params& p, int bid, int nblk) {
    const int lane = threadIdx.x & 63, wid = threadIdx.x >> 6;
    const bf16_t* u = (const bf16_t*)(p.ws + OFF_U);
    bf16_t* mix = (bf16_t*)(p.ws + OFF_MIX);
    for (int t = bid * 4 + wid; t < S; t += nblk * 4) {
        const int gi = lane >> 4, win = 2 << gi;
        int lo = t - win / 2, hi = lo + win; lo = lo < 0 ? 0 : lo; hi = hi > S ? S : hi;
        float s[8], c[8];
        for (int j = 0; j < 8; ++j) s[j] = 0.f;
        for (int tt = lo; tt < hi; ++tt) {
            float q[8]; unpack8(*(const u32x4*)(u + (size_t)(tt + CTX) * DIN + C_POOL + lane * 8), q);
            for (int j = 0; j < 8; ++j) s[j] += q[j];
        }
        unpack8(*(const u32x4*)(u + (size_t)(t + CTX) * DIN + C_POOL + lane * 8), c);
        const float inv = 1.f / (float)(hi - lo);
        float o[8];
        for (int j = 0; j < 8; ++j) o[j] = s[j] * inv - c[j];
        *(u32x4*)(mix + (size_t)t * D + lane * 8) = pack8(o);
    }
}
struct EpiPool { bf16_t* o; const float* sc; DI void operator()(int r, int c, const f32x4& v, const f32x4&) const {
    u32x2 pk = {pack2(v[0] * sc[c], v[1] * sc[c + 1]), pack2(v[2] * sc[c + 2], v[3] * sc[c + 3])}; *(u32x2*)(o + (size_t)r * D + c) = pk; } };
DI void phase_poolgemm(const Params& p, int bid, int nblk, char* lds) {
    if (nblk <= 0) return;
    for (int it = bid; it < 4 * 128; it += nblk) {
        const int gi = it >> 7, tm = it & 127;
        const bf16_t* mix = (const bf16_t*)(p.ws + OFF_MIX);
        PlainA al{mix + (size_t)tm * 128 * D + gi * 128, D};
        EpiPool e{(bf16_t*)(p.ws + OFF_MIX) + (size_t)tm * 128 * D + 512 + gi * 128, p.pool_scale + gi * 128};
        gemm128<1>(al, p.w_pool + (size_t)gi * 128 * 128, nullptr, 128, 128, lds, e);
    }
}

typedef float f32x16 __attribute__((ext_vector_type(16)));
constexpr int MP = 72, MSZ = 64 * MP;
constexpr int FP = 68;
constexpr int SCANA_LDS = 14 * MSZ * 2 + 2048;
DI s16x4 tr16(const bf16_t* a) { return __builtin_amdgcn_ds_read_tr16_b64_v4i16((LAS s16x4*)a); }
template <bool KS> DI bf16x8 frag32(const bf16_t* base, int x0, int s, int lane) {
    if (!KS) return *(const bf16x8*)(base + (x0 + (lane & 31)) * MP + 16 * s + 8 * (lane >> 5));
    const int gi = lane >> 4, i = lane & 15;
    const bf16_t* a = base + (16 * s + 8 * (gi >> 1) + (i >> 2)) * MP + x0 + 16 * (gi & 1) + 4 * (i & 3);
    s16x4 lo = tr16(a), hi = tr16(a + 4 * MP);
    return __builtin_shufflevector(lo, hi, 0, 1, 2, 3, 4, 5, 6, 7);
}
template <bool XKS, bool YKS> DI f32x16 mm32(const bf16_t* X, int x0, const bf16_t* Y, int y0, f32x16 acc, int lane) {
#pragma unroll
    for (int s = 0; s < 4; ++s) acc = __builtin_amdgcn_mfma_f32_32x32x16_bf16(frag32<XKS>(X, x0, s, lane), frag32<YKS>(Y, y0, s, lane), acc, 0, 0, 0);
    return acc;
}
DI f32x16 zero16() { f32x16 z; for (int i = 0; i < 16; ++i) z[i] = 0.f; return z; }
template <class F> DI void store_acc(bf16_t* out, int x0, int y0, const f32x16& acc, int lane, F f) {
    const int y = y0 + (lane & 31), hh = lane >> 5;
#pragma unroll
    for (int q = 0; q < 4; ++q) {
        const int x = x0 + 8 * q + 4 * hh;
        u32x2 pk = {pack2(f(acc[4 * q], x, y), f(acc[4 * q + 1], x + 1, y)), pack2(f(acc[4 * q + 2], x + 2, y), f(acc[4 * q + 3], x + 3, y))};
        *(u32x2*)(out + y * MP + x) = pk;
    }
}
DI unsigned rot16(unsigned x) { return (x >> 16) | (x << 16); }

DI int chain_pos(int c, int dir) { return dir == 0 ? c : (c < 4 ? 3 - c : NCH + 3 - c); }

DI void phase_scanA(const Params& p, int bid, int nblk, char* lds) {
    const int tid = threadIdx.x, lane = tid & 63, w = tid >> 6, xq = 32 * (w & 1), yq = 32 * (w >> 1);
    bf16_t* M = (bf16_t*)lds;
    bf16_t *sAT = M, *sBT = M + MSZ, *sKT = M + 2 * MSZ, *sRT = M + 3 * MSZ, *sVT = M + 4 * MSZ;
    float* fGC = (float*)(lds + 14 * MSZ * 2);
    float* fSeg = fGC + 64;
    float* fLogw = (float*)(M + 12 * MSZ);
    float* fA = (float*)(M + 10 * MSZ);
    const bf16_t* u = (const bf16_t*)(p.ws + OFF_U);
    for (int inst = bid; inst < NCH * 16; inst += nblk) {
        const int c = inst >> 4, h = (inst >> 1) & 7, dir = inst & 1;
        const bool latent = c >= 4, want_g = latent && dir == 0;
        const float* w2 = dir ? p.w2_b : p.w2_f; const float* a2 = dir ? p.a2_b : p.a2_f;
        const float* w0 = dir ? p.w0_b : p.w0_f; const float* a0 = dir ? p.a0_b : p.a0_f;
        const float* rkd = dir ? p.r_k_b : p.r_k_f;
        const int cwl = dir ? C_WLB : C_WLF, cal = dir ? C_ALB : C_ALF;
        const int ch = tid & 7;
        float fr_[2][8], fk_[2][8], fv_[2][8];
#pragma unroll
        for (int i = 0; i < 2; ++i) {
            const int tau = (tid >> 3) + 32 * i, g = dir ? c * 64 + 63 - tau : c * 64 + tau;
            const bool hasp = (g != 0) && (g != CTX), hasn = (g != CTX - 1) && (g != NT - 1);
            auto shifted = [&](int col, float* o) {
                const bf16_t* pc = u + (size_t)g * DIN + col;
                float cc[8], pv[8], nx[8];
                unpack8(*(const u32x4*)pc, cc);
                if (hasp) unpack8(*(const u32x4*)(pc - DIN), pv); else { for (int j = 0; j < 8; ++j) pv[j] = 0.f; }
                if (hasn) unpack8(*(const u32x4*)(pc + DIN), nx); else { for (int j = 0; j < 8; ++j) nx[j] = 0.f; }
#pragma unroll
                for (int j = 0; j < 8; ++j) { const float m = p.mu[col + j]; o[j] = cc[j] + m * (0.5f * (pv[j] + nx[j]) - cc[j]); }
            };
            shifted(h * 64 + ch * 8, fr_[i]); shifted(512 + h * 64 + ch * 8, fk_[i]); shifted(1024 + h * 64 + ch * 8, fv_[i]);
            float t8[8];
            shifted(cwl + ch * 8, t8);
#pragma unroll
            for (int j = 0; j < 8; ++j) t8[j] = tanhf(t8[j]);
            *(u32x4*)(M + 5 * MSZ + tau * MP + ch * 8) = pack8(t8);
            shifted(cal + ch * 8, t8);
            *(u32x4*)(M + 6 * MSZ + tau * MP + ch * 8) = pack8(t8);
        }
#pragma unroll
        for (int i = 0; i < 4; ++i) {
            const int idx = tid + 256 * i, kr = idx >> 4, n4 = idx & 15;
            const f32x4 a = *(const f32x4*)(w2 + (size_t)kr * DR + h * 64 + n4 * 4), b = *(const f32x4*)(a2 + (size_t)kr * DR + h * 64 + n4 * 4);
            u32x2 pa = {pack2(a[0], a[1]), pack2(a[2], a[3])}, pb = {pack2(b[0], b[1]), pack2(b[2], b[3])};
            *(u32x2*)(M + 7 * MSZ + kr * MP + n4 * 4) = pa; *(u32x2*)(M + 8 * MSZ + kr * MP + n4 * 4) = pb;
        }
        __syncthreads();
        {
            f32x16 accW = mm32<true, false>(M + 7 * MSZ, xq, M + 5 * MSZ, yq, zero16(), lane);
            f32x16 accA = mm32<true, false>(M + 8 * MSZ, xq, M + 6 * MSZ, yq, zero16(), lane);
            const int y = yq + (lane & 31), hh = lane >> 5;
#pragma unroll
            for (int q = 0; q < 4; ++q) {
                const int x = xq + 8 * q + 4 * hh;
                f32x4 lw, av;
#pragma unroll
                for (int e = 0; e < 4; ++e) { lw[e] = -DECAY_SCALE * sigmoidf_(w0[h * 64 + x + e] + accW[4 * q + e]); av[e] = sigmoidf_(a0[h * 64 + x + e] + accA[4 * q + e]); }
                *(f32x4*)(fLogw + y * FP + x) = lw; *(f32x4*)(fA + y * FP + x) = av;
            }
        }
        __syncthreads();
        {
            const int n = tid & 63, qq = tid >> 6; float run = 0.f;
            for (int t = 16 * qq; t < 16 * qq + 16; ++t) { run += fLogw[t * FP + n]; fLogw[t * FP + n] = run; }
            fSeg[qq * 64 + n] = run;
        }
        if (want_g) {
#pragma unroll
            for (int i = 0; i < 2; ++i) {
                const int tau = (tid >> 3) + 32 * i, g = c * 64 + tau;
                const bool hasp = (g != 0) && (g != CTX), hasn = (g != CTX - 1) && (g != NT - 1);
#pragma unroll
                for (int half = 0; half < 2; ++half) {
                    const int col = C_GL + half * 64 + ch * 8;
                    const bf16_t* pc = u + (size_t)g * DIN + col;
                    float cc[8], pv[8], nx[8], o[8];
                    unpack8(*(const u32x4*)pc, cc);
                    if (hasp) unpack8(*(const u32x4*)(pc - DIN), pv); else { for (int j = 0; j < 8; ++j) pv[j] = 0.f; }
                    if (hasn) unpack8(*(const u32x4*)(pc + DIN), nx); else { for (int j = 0; j < 8; ++j) nx[j] = 0.f; }
#pragma unroll
                    for (int j = 0; j < 8; ++j) { const float m = p.mu[col + j]; o[j] = sigmoidf_(cc[j] + m * (0.5f * (pv[j] + nx[j]) - cc[j])); }
                    *(u32x4*)(M + (5 + half) * MSZ + tau * MP + ch * 8) = pack8(o);
                }
            }
#pragma unroll
            for (int i = 0; i < 8; ++i) {
                const int idx = tid + 256 * i, kr = idx >> 4, n4 = idx & 15;
                const f32x4 a = *(const f32x4*)(p.g2 + (size_t)kr * DR + h * 64 + n4 * 4);
                u32x2 pa = {pack2(a[0], a[1]), pack2(a[2], a[3])};
                *(u32x2*)(M + (7 + (kr >> 6)) * MSZ + (kr & 63) * MP + n4 * 4) = pa;
            }
        }
        __syncthreads();
        {
            const int n = tid & 63, qq = tid >> 6; float off = 0.f;
            for (int q2 = 0; q2 < qq; ++q2) off += fSeg[q2 * 64 + n];
            if (qq) for (int t = 16 * qq; t < 16 * qq + 16; ++t) fLogw[t * FP + n] += off;
        }
        __syncthreads();
#pragma unroll
        for (int i = 0; i < 2; ++i) {
            const int tau = (tid >> 3) + 32 * i, g = dir ? c * 64 + 63 - tau : c * 64 + tau;
            float oa[8], ob[8], ok[8], orr[8], kkv[8], kd[8];
            float ss = 0.f, dsum = 0.f;
#pragma unroll
            for (int j = 0; j < 8; ++j) { const int cch = h * 64 + ch * 8 + j; kkv[j] = fk_[i][j] * p.k_k[cch]; ss += kkv[j] * kkv[j]; }
            ss += __shfl_xor(ss, 1, 64); ss += __shfl_xor(ss, 2, 64); ss += __shfl_xor(ss, 4, 64);
            const float inv = 1.f / fmaxf(sqrtf(ss), 1e-12f);
#pragma unroll
            for (int j = 0; j < 8; ++j) {
                const int jj = ch * 8 + j, cch = h * 64 + jj;
                const float cum = fLogw[tau * FP + jj], cprev = tau ? fLogw[(tau - 1) * FP + jj] : 0.f, av = fA[tau * FP + jj];
                const float gam = __expf(cum), gprev = __expf(cprev), ginv = __expf(-cum);
                const float kkn = kkv[j] * inv;
                kd[j] = fk_[i][j] * (1.f + (av - 1.f) * p.k_a[cch]);
                oa[j] = -kkn * gprev; ob[j] = kkn * av * ginv; ok[j] = kd[j] * ginv; orr[j] = fr_[i][j] * gam;
                dsum += fr_[i][j] * kd[j] * rkd[cch];
                if (tau == 63) fGC[jj] = gam;
            }
            dsum += __shfl_xor(dsum, 1, 64); dsum += __shfl_xor(dsum, 2, 64); dsum += __shfl_xor(dsum, 4, 64);
            if (ch == 0) ((float*)(p.ws + OFF_DOT))[((size_t)g * 8 + h) * 2 + dir] = dsum;
            *(u32x4*)(sAT + tau * MP + ch * 8) = pack8(oa); *(u32x4*)(sBT + tau * MP + ch * 8) = pack8(ob);
            *(u32x4*)(sKT + tau * MP + ch * 8) = pack8(ok); *(u32x4*)(sRT + tau * MP + ch * 8) = pack8(orr);
            const u32x4 pv8 = pack8(fv_[i]);
            *(u32x4*)(sVT + tau * MP + ch * 8) = pv8;
            if (want_g) *(u32x4*)((bf16_t*)(p.ws + OFF_V) + (size_t)(g - CTX) * DR + h * 64 + ch * 8) = pv8;
        }
        if (want_g) {
            f32x16 accG = mm32<true, false>(M + 7 * MSZ, xq, M + 5 * MSZ, yq, zero16(), lane);
            accG = mm32<true, false>(M + 8 * MSZ, xq, M + 6 * MSZ, yq, accG, lane);
            const int y = yq + (lane & 31), hh = lane >> 5, t = c * 64 + y - CTX;
#pragma unroll
            for (int q = 0; q < 4; ++q) {
                const int x = xq + 8 * q + 4 * hh;
                u32x2 pk = {pack2(accG[4 * q], accG[4 * q + 1]), pack2(accG[4 * q + 2], accG[4 * q + 3])};
                *(u32x2*)((bf16_t*)(p.ws + OFF_G) + (size_t)t * DR + h * 64 + x) = pk;
            }
        }
        __syncthreads();
        {
            f32x16 acc = mm32<false, false>(sAT, xq, sBT, yq, zero16(), lane);
            store_acc(M + 5 * MSZ, xq, yq, acc, lane, [](float v, int x, int y) { return y < x ? v : 0.f; });
            store_acc(M + 7 * MSZ, xq, yq, acc, lane, [](float v, int x, int y) { return y < x ? v : (y == x ? 1.f : 0.f); });
            acc = mm32<false, false>(sAT, xq, sKT, yq, zero16(), lane);
            store_acc(M + 9 * MSZ, xq, yq, acc, lane, [](float v, int x, int y) { return y < x ? v : 0.f; });
            acc = mm32<false, false>(sRT, xq, sBT, yq, zero16(), lane);
            store_acc(M + 10 * MSZ, xq, yq, acc, lane, [](float v, int x, int y) { return y <= x ? v : 0.f; });
            acc = mm32<false, false>(sRT, xq, sKT, yq, zero16(), lane);
            store_acc(M + 11 * MSZ, xq, yq, acc, lane, [](float v, int x, int y) { return y <= x ? v : 0.f; });
        }
        __syncthreads();
        int xs = 5, xo = 6, ts = 7, to = 8;
        {
            f32x16 acc = mm32<true, false>(M + xs * MSZ, xq, M + xs * MSZ, yq, zero16(), lane);
            store_acc(M + xo * MSZ, xq, yq, acc, lane, [](float v, int, int) { return v; });
            int t_ = xs; xs = xo; xo = t_;
        }
        __syncthreads();
        for (int k = 0; k < 5; ++k) {
            const bf16_t* Told = M + ts * MSZ;
            f32x16 acc = mm32<true, false>(M + xs * MSZ, xq, Told, yq, zero16(), lane);
            store_acc(M + to * MSZ, xq, yq, acc, lane, [Told](float v, int x, int y) { return v + bf2f(Told[y * MP + x]); });
            if (k < 4) {
                acc = mm32<true, false>(M + xs * MSZ, xq, M + xs * MSZ, yq, zero16(), lane);
                store_acc(M + xo * MSZ, xq, yq, acc, lane, [](float v, int, int) { return v; });
            }
            int t_ = xs; xs = xo; xo = t_; t_ = ts; ts = to; to = t_;
            __syncthreads();
        }
        const bf16_t* sT = M + ts * MSZ;
        {
            f32x16 acc = mm32<true, true>(sT, xq, sAT, yq, zero16(), lane);
            store_acc(M + 12 * MSZ, xq, yq, acc, lane, [](float v, int, int) { return v; });
            acc = mm32<true, false>(sT, xq, M + 9 * MSZ, yq, zero16(), lane);
            store_acc(M + 13 * MSZ, xq, yq, acc, lane, [](float v, int, int) { return v; });
        }
        __syncthreads();
        {
            const bf16_t *sAbar = M + 12 * MSZ, *sG = M + 13 * MSZ, *sABR = M + 10 * MSZ, *sAKR = M + 11 * MSZ;
            f32x16 acc = mm32<false, true>(sAbar, xq, sBT, yq, zero16(), lane);
            store_acc(M + 5 * MSZ, xq, yq, acc, lane, [fGC](float v, int x, int y) { return ((x == y ? 1.f : 0.f) + v) * fGC[y]; });
            acc = mm32<false, true>(sAbar, xq, sABR, yq, zero16(), lane);
            store_acc(M + 6 * MSZ, xq, yq, acc, lane, [sRT](float v, int x, int y) { return v + bf2f(sRT[y * MP + x]); });
            acc = mm32<true, false>(sBT, xq, sG, yq, zero16(), lane);
            store_acc(M + 7 * MSZ, xq, yq, acc, lane, [sKT, fGC](float v, int x, int y) { return (v + bf2f(sKT[y * MP + x])) * fGC[x]; });
            acc = mm32<true, false>(sABR, xq, sG, yq, zero16(), lane);
            store_acc(M + 9 * MSZ, xq, yq, acc, lane, [sAKR](float v, int x, int y) { return v + bf2f(sAKR[y * MP + x]); });
        }
        __syncthreads();
        const int chain = dir * 8 + h, npos = chain_pos(c, dir);
        {
            u32x4* Pg = (u32x4*)(p.ws + OFF_P) + ((size_t)chain * NCH + npos) * 512;
#pragma unroll
            for (int i = 0; i < 2; ++i) {
                const int item = tid + 256 * i, ln = item & 63, as = item >> 6, a = as >> 1, s2 = as & 1, fr = ln & 15, fq = ln >> 4;
                const bf16_t* src = M + 5 * MSZ + (16 * a + fr) * MP + 32 * s2 + 4 * fq;
                const u32x2 lo = *(const u32x2*)src, hi = *(const u32x2*)(src + 16);
                Pg[as * 64 + ln] = (u32x4){lo.x, lo.y, hi.x, hi.y};
            }
            if (latent) {
                u32x4* Wg = (u32x4*)(p.ws + OFF_WYT) + ((size_t)((c - 4) * 8 + h) * 2 + dir) * 512;
#pragma unroll
                for (int i = 0; i < 2; ++i) { const int item = tid + 256 * i, row = item >> 3, ck = item & 7; Wg[item] = *(const u32x4*)(M + 6 * MSZ + row * MP + ck * 8); }
            }
        }
        {
            f32x16 acc = mm32<true, true>(M + 7 * MSZ, xq, sVT, yq, zero16(), lane);
            store_acc(M + 12 * MSZ, xq, yq, acc, lane, [](float v, int, int) { return v; });
            acc = mm32<true, true>(M + 9 * MSZ, xq, sVT, yq, zero16(), lane);
            store_acc(M + 13 * MSZ, xq, yq, acc, lane, [](float v, int, int) { return v; });
        }
        __syncthreads();
        {
            u32x2* Qg = (u32x2*)(p.ws + OFF_Q) + ((size_t)chain * NCH + npos) * 1024;
#pragma unroll
            for (int i = 0; i < 4; ++i) {
                const int item = tid + 256 * i, ln = item & 63, wa = item >> 6, wi = wa >> 2, a = wa & 3, fr = ln & 15, fq = ln >> 4;
                Qg[item] = *(const u32x2*)(M + 12 * MSZ + (16 * wi + fr) * MP + 16 * a + 4 * fq);
            }
            if (latent) {
                u32x2* Yg = (u32x2*)(p.ws + OFF_YL) + ((size_t)((c - 4) * 8 + h) * 2 + dir) * 1024;
#pragma unroll
                for (int i = 0; i < 4; ++i) {
                    const int item = tid + 256 * i, ln = item & 63, wn = item >> 6, wt = wn >> 2, ni = wn & 3, fr = ln & 15, fq = ln >> 4;
                    const bf16_t* row = M + 13 * MSZ + (16 * ni + fr) * MP;
                    u32x2 v;
                    if (dir == 0) v = *(const u32x2*)(row + 16 * wt + 4 * fq);
                    else { const u32x2 r2 = *(const u32x2*)(row + 60 - 16 * wt - 4 * fq); v = (u32x2){rot16(r2.y), rot16(r2.x)}; }
                    Yg[item] = v;
                }
            }
        }
        __syncthreads();
    }
}

DI void phase_chain(const Params& p, int chain) {
    const int lane = threadIdx.x & 63, w = threadIdx.x >> 6;
    const u32x4* Pg = (const u32x4*)(p.ws + OFF_P) + (size_t)chain * NCH * 512;
    const u32x2* Qg = (const u32x2*)(p.ws + OFF_Q) + (size_t)chain * NCH * 1024;
    u32x4* Zg = (u32x4*)(p.ws + OFF_Z) + (size_t)chain * NCH * 512;
    f32x4 acc[4];
#pragma unroll
    for (int a = 0; a < 4; ++a) acc[a] = (f32x4){0, 0, 0, 0};
    u32x4 pf[8]; u32x2 qf[4];
#pragma unroll
    for (int i = 0; i < 8; ++i) pf[i] = Pg[i * 64 + lane];
#pragma unroll
    for (int a = 0; a < 4; ++a) qf[a] = Qg[(w * 4 + a) * 64 + lane];
    for (int n = 0; n < NCH; ++n) {
        u32x4 pc[8]; u32x2 qc[4];
#pragma unroll
        for (int i = 0; i < 8; ++i) pc[i] = pf[i];
#pragma unroll
        for (int a = 0; a < 4; ++a) qc[a] = qf[a];
        if (n + 1 < NCH) {
#pragma unroll
            for (int i = 0; i < 8; ++i) pf[i] = Pg[(size_t)(n + 1) * 512 + i * 64 + lane];
#pragma unroll
            for (int a = 0; a < 4; ++a) qf[a] = Qg[(size_t)(n + 1) * 1024 + (w * 4 + a) * 64 + lane];
        }
        u32x4 z0 = {pack2(acc[0][0], acc[0][1]), pack2(acc[0][2], acc[0][3]), pack2(acc[1][0], acc[1][1]), pack2(acc[1][2], acc[1][3])};
        u32x4 z1 = {pack2(acc[2][0], acc[2][1]), pack2(acc[2][2], acc[2][3]), pack2(acc[3][0], acc[3][1]), pack2(acc[3][2], acc[3][3])};
        Zg[((size_t)n * 4 + w) * 128 + lane] = z0; Zg[((size_t)n * 4 + w) * 128 + 64 + lane] = z1;
        const bf16x8 zb0 = __builtin_bit_cast(bf16x8, z0), zb1 = __builtin_bit_cast(bf16x8, z1);
#pragma unroll
        for (int a = 0; a < 4; ++a) {
            f32x4 ini = {bflo(qc[a].x), bfhi(qc[a].x), bflo(qc[a].y), bfhi(qc[a].y)};
            ini = __builtin_amdgcn_mfma_f32_16x16x32_bf16(__builtin_bit_cast(bf16x8, pc[2 * a]), zb0, ini, 0, 0, 0);
            acc[a] = __builtin_amdgcn_mfma_f32_16x16x32_bf16(__builtin_bit_cast(bf16x8, pc[2 * a + 1]), zb1, ini, 0, 0, 0);
        }
    }
}

DI void phase_scanC(const Params& p, int bid, int nblk) {
    const int lane = threadIdx.x & 63, w = threadIdx.x >> 6, fr = lane & 15, fq = lane >> 4;
    bf16_t* mix = (bf16_t*)(p.ws + OFF_MIX);
    const float* dot = (const float*)(p.ws + OFF_DOT);
    for (int unit = bid; unit < 256 * 8; unit += nblk) {
        const int c = 4 + (unit >> 3), h = unit & 7;
        f32x4 y[4];
#pragma unroll
        for (int ni = 0; ni < 4; ++ni) y[ni] = (f32x4){0, 0, 0, 0};
#pragma unroll
        for (int dir = 0; dir < 2; ++dir) {
            const int chain = dir * 8 + h, npos = chain_pos(c, dir);
            const u32x4* Zg = (const u32x4*)(p.ws + OFF_Z) + ((size_t)chain * NCH + npos) * 512;
            const bf16_t* Wg = (const bf16_t*)(p.ws + OFF_WYT) + ((size_t)((c - 4) * 8 + h) * 2 + dir) * 4096;
            const u32x2* Yg = (const u32x2*)(p.ws + OFF_YL) + ((size_t)((c - 4) * 8 + h) * 2 + dir) * 1024;
            const int rho = 16 * w + fr, row = dir ? 63 - rho : rho;
            bf16x8 af[2];
#pragma unroll
            for (int s2 = 0; s2 < 2; ++s2) {
                const u32x2 lo = *(const u32x2*)(Wg + row * 64 + 32 * s2 + 4 * fq), hi = *(const u32x2*)(Wg + row * 64 + 32 * s2 + 16 + 4 * fq);
                af[s2] = __builtin_bit_cast(bf16x8, (u32x4){lo.x, lo.y, hi.x, hi.y});
            }
#pragma unroll
            for (int ni = 0; ni < 4; ++ni) {
                const u32x2 yl = Yg[(w * 4 + ni) * 64 + lane];
                f32x4 acc = {bflo(yl.x), bfhi(yl.x), bflo(yl.y), bfhi(yl.y)};
                acc = __builtin_amdgcn_mfma_f32_16x16x32_bf16(af[0], __builtin_bit_cast(bf16x8, Zg[(ni * 2 + 0) * 64 + lane]), acc, 0, 0, 0);
                acc = __builtin_amdgcn_mfma_f32_16x16x32_bf16(af[1], __builtin_bit_cast(bf16x8, Zg[(ni * 2 + 1) * 64 + lane]), acc, 0, 0, 0);
                y[ni] += acc;
            }
        }
#pragma unroll
        for (int e = 0; e < 4; ++e) {
            const int t = (c - 4) * 64 + 16 * w + 4 * fq + e, g = t + CTX;
            float s = y[0][e] + y[1][e] + y[2][e] + y[3][e];
            s += __shfl_xor(s, 1, 64); s += __shfl_xor(s, 2, 64); s += __shfl_xor(s, 4, 64); s += __shfl_xor(s, 8, 64);
            const float mean = s * (1.f / 64.f);
            float q = 0.f;
#pragma unroll
            for (int ni = 0; ni < 4; ++ni) { const float d = y[ni][e] - mean; q += d * d; }
            q += __shfl_xor(q, 1, 64); q += __shfl_xor(q, 2, 64); q += __shfl_xor(q, 4, 64); q += __shfl_xor(q, 8, 64);
            const float rs = rsqrtf(q * (1.f / 64.f) + 64e-5f);
            const float bon = dot[((size_t)g * 8 + h) * 2] + dot[((size_t)g * 8 + h) * 2 + 1];
#pragma unroll
            for (int ni = 0; ni < 4; ++ni) {
                const int cch = h * 64 + 16 * ni + fr;
                const float vv = bf2f(((const bf16_t*)(p.ws + OFF_V))[(size_t)t * DR + cch]), gg = bf2f(((const bf16_t*)(p.ws + OFF_G))[(size_t)t * DR + cch]);
                const float o = ((y[ni][e] - mean) * rs * p.gn_w[cch] + p.gn_b[cch] + bon * vv) * gg;
                const unsigned pk = pack2(o, 0.f);
                mix[(size_t)t * D + cch] = (bf16_t)(pk & 0xffffu);
            }
        }
    }
}

struct EpiX2 { float* o; const float* x; const float* gt; const float* rowtab; const float* coltab; int row0, col0;
    DI void operator()(int r, int c, const f32x4& v, const f32x4&) const {
        const int t = row0 + r, d = col0 + c; const f32x4 xv = *(const f32x4*)(x + (size_t)t * D + d); f32x4 res;
#pragma unroll
        for (int j = 0; j < 4; ++j) res[j] = xv[j] + pos_val(rowtab, coltab, t, d + j) + gt[d + j] * v[j];
        *(f32x4*)(o + (size_t)t * D + d) = res; } };
DI void phase_g2(const Params& p, int bid, int nblk, char* lds) {
    const bf16_t* mix = (const bf16_t*)(p.ws + OFF_MIX);
    for (int item = bid; item < 128 * 8; item += nblk) {
        const int tm = item >> 3, tn = item & 7;
        PlainA al{mix + (size_t)tm * 128 * D, D};
        EpiX2 e{(float*)(p.ws + OFF_X2), p.x, (const float*)(p.ws + OFF_MODX) + 2048, (const float*)(p.ws + OFF_ROWTAB), (const float*)(p.ws + OFF_COLTAB), tm * 128, tn * 128};
        gemm128<1>(al, p.w_out + tn * 128, nullptr, D, D, lds, e);
    }
}

DI void phase_router(const Params& p, int bid, int nblk) {
    const int lane = threadIdx.x & 63, wid = threadIdx.x >> 6;
    const float* x2 = (const float*)(p.ws + OFF_X2); const float* modx = (const float*)(p.ws + OFF_MODX);
    bf16_t* h2 = (bf16_t*)(p.ws + OFF_H2); int* cnt = (int*)(p.ws + OFF_CNT); float* gate = (float*)(p.ws + OFF_GATE); int* list = (int*)(p.ws + OFF_LIST);
    for (int t = bid * 4 + wid; t < S; t += nblk * 4) {
        f32x4 v[4]; float ss = 0.f;
#pragma unroll
        for (int i = 0; i < 4; ++i) { v[i] = *(const f32x4*)(x2 + (size_t)t * D + (i * 64 + lane) * 4); ss += v[i][0] * v[i][0] + v[i][1] * v[i][1] + v[i][2] * v[i][2] + v[i][3] * v[i][3]; }
        ss = wave_sum(ss);
        const float rstd = rsqrtf(ss * (1.f / 1024.f) + 1e-6f);
        f32x4 lg4 = {0, 0, 0, 0}, le4[8];
#pragma unroll
        for (int n = 0; n < 8; ++n) le4[n] = (f32x4){0, 0, 0, 0};
#pragma unroll
        for (int i = 0; i < 4; ++i) {
            const int d = (i * 64 + lane) * 4;
            const f32x4 gg = *(const f32x4*)(p.norm2_g + d), sh = *(const f32x4*)(modx + 3072 + d), sc = *(const f32x4*)(modx + 4096 + d);
            f32x4 hv;
#pragma unroll
            for (int j = 0; j < 4; ++j) hv[j] = (v[i][j] * rstd * gg[j]) * (1.f + sc[j]) + sh[j];
            u32x2 pk = {pack2(hv[0], hv[1]), pack2(hv[2], hv[3])};
            *(u32x2*)(h2 + (size_t)t * D + d) = pk;
#pragma unroll
            for (int j = 0; j < 4; ++j) {
                const float hj = hv[j];
                lg4 += *(const f32x4*)(p.w_rg + (size_t)(d + j) * 4) * hj;
#pragma unroll
                for (int n4 = 0; n4 < 8; ++n4) le4[n4] += *(const f32x4*)(p.w_re + (size_t)(d + j) * 32 + n4 * 4) * hj;
            }
        }
        lg4 = wave_sum4(lg4);
#pragma unroll
        for (int n = 0; n < 8; ++n) le4[n] = wave_sum4(le4[n]);
        const float l0 = lg4[0] + p.b_rg[0], l1 = lg4[1] + p.b_rg[1], l2 = lg4[2] + p.b_rg[2], l3 = lg4[3] + p.b_rg[3];
        int grp = 0; float mx = l0;
        if (l1 > mx) { mx = l1; grp = 1; }
        if (l2 > mx) { mx = l2; grp = 2; }
        if (l3 > mx) { mx = l3; grp = 3; }
        const float den = __expf(l0 - mx) + __expf(l1 - mx) + __expf(l2 - mx) + __expf(l3 - mx);
        const float pgrp = 1.f / den;
        const float m0 = grp == 0 ? 1.f : 0.f, m1 = grp == 1 ? 1.f : 0.f, m2 = grp == 2 ? 1.f : 0.f, m3 = grp == 3 ? 1.f : 0.f;
        f32x4 sa = le4[0] * m0 + le4[2] * m1 + le4[4] * m2 + le4[6] * m3;
        f32x4 sb = le4[1] * m0 + le4[3] * m1 + le4[5] * m2 + le4[7] * m3;
        sa += *(const f32x4*)(p.b_re + grp * 8); sb += *(const f32x4*)(p.b_re + grp * 8 + 4);
        const float s0 = sa[0], s1 = sa[1], s2 = sa[2], s3 = sa[3], s4 = sb[0], s5 = sb[1], s6 = sb[2], s7 = sb[3];
        int i1 = 0; float v1 = s0;
        if (s1 > v1) { v1 = s1; i1 = 1; }
        if (s2 > v1) { v1 = s2; i1 = 2; }
        if (s3 > v1) { v1 = s3; i1 = 3; }
        if (s4 > v1) { v1 = s4; i1 = 4; }
        if (s5 > v1) { v1 = s5; i1 = 5; }
        if (s6 > v1) { v1 = s6; i1 = 6; }
        if (s7 > v1) { v1 = s7; i1 = 7; }
        int i2 = -1; float v2 = -3.0e38f;
        if (i1 != 0 && s0 > v2) { v2 = s0; i2 = 0; }
        if (i1 != 1 && s1 > v2) { v2 = s1; i2 = 1; }
        if (i1 != 2 && s2 > v2) { v2 = s2; i2 = 2; }
        if (i1 != 3 && s3 > v2) { v2 = s3; i2 = 3; }
        if (i1 != 4 && s4 > v2) { v2 = s4; i2 = 4; }
        if (i1 != 5 && s5 > v2) { v2 = s5; i2 = 5; }
        if (i1 != 6 && s6 > v2) { v2 = s6; i2 = 6; }
        if (i1 != 7 && s7 > v2) { v2 = s7; i2 = 7; }
        const float e2 = __expf(v2 - v1), g1 = pgrp / (1.f + e2), g2v = pgrp * e2 / (1.f + e2);
        if (lane == 0) {
            const int ea = grp * 8 + i1, eb = grp * 8 + i2;
            const int pa = atomicAdd(&cnt[ea], 1), pb = atomicAdd(&cnt[eb], 1);
            list[ea * LCAP + pa] = t * 2; list[eb * LCAP + pb] = t * 2 + 1;
            gate[t * 2] = g1; gate[t * 2 + 1] = g2v;
        }
    }
}

DI void moe_tiles(const int* cnt, int* tstart  ) {
    if (threadIdx.x == 0) { int acc = 0; for (int e = 0; e < NE; ++e) { tstart[e] = acc; acc += (cnt[e] + 127) >> 7; } tstart[NE] = acc; }
    __syncthreads();
}
struct EpiHid { bf16_t* o; DI void operator()(int r, int c, const f32x4& g, const f32x4& u) const {
    float h[4];
#pragma unroll
    for (int j = 0; j < 4; ++j) h[j] = g[j] * sigmoidf_(g[j]) * u[j];
    u32x2 pk = {pack2(h[0], h[1]), pack2(h[2], h[3])}; *(u32x2*)(o + (size_t)r * DE + c) = pk; } };
DI void phase_g3(const Params& p, int bid, int nblk, char* lds) {
    int* tstart = (int*)(lds + GEMM_LDS);
    const int* cnt = (const int*)(p.ws + OFF_CNT); const int* list = (const int*)(p.ws + OFF_LIST);
    const bf16_t* h2 = (const bf16_t*)(p.ws + OFF_H2); bf16_t* hid = (bf16_t*)(p.ws + OFF_HID);
    moe_tiles(cnt, tstart);
    const int ntiles = tstart[NE];
    for (int item = bid; item < ntiles * 4; item += nblk) {
        const int ti = item >> 2, cj = item & 3;
        int e = 0; while (e < NE - 1 && tstart[e + 1] <= ti) ++e;
        const int lt = ti - tstart[e], ne = cnt[e];
        GatherA al;
#pragma unroll
        for (int i = 0; i < 2; ++i) { const int row = (threadIdx.x + 256 * i) >> 2, pos = lt * 128 + row; const int tok = pos < ne ? (list[e * LCAP + pos] >> 1) : 0; al.rp[i] = h2 + (size_t)tok * D; }
        EpiHid epi{hid + (size_t)ti * 128 * DE + cj * 128};
        gemm128<2>(al, p.w_gate + (size_t)e * D * DE + cj * 128, p.w_up + (size_t)e * D * DE + cj * 128, DE, D, lds, epi);
    }
}
struct EpiDown { bf16_t* ybuf; const int* lst; const float* gate; int nvalid; int col0;
    DI void operator()(int r, int c, const f32x4& v, const f32x4&) const {
        if (r >= nvalid) return; const int slot = lst[r]; const float g = gate[slot];
        u32x2 pk = {pack2(v[0] * g, v[1] * g), pack2(v[2] * g, v[3] * g)}; *(u32x2*)(ybuf + (size_t)slot * D + col0 + c) = pk; } };
DI void phase_g4(const Params& p, int bid, int nblk, char* lds) {
    int* tstart = (int*)(lds + GEMM_LDS);
    const int* cnt = (const int*)(p.ws + OFF_CNT); const int* list = (const int*)(p.ws + OFF_LIST);
    const bf16_t* hid = (const bf16_t*)(p.ws + OFF_HID);
    moe_tiles(cnt, tstart);
    const int ntiles = tstart[NE];
    for (int item = bid; item < ntiles * 8; item += nblk) {
        const int ti = item >> 3, cj = item & 7;
        int e = 0; while (e < NE - 1 && tstart[e + 1] <= ti) ++e;
        const int lt = ti - tstart[e], ne = cnt[e];
        PlainA al{hid + (size_t)ti * 128 * DE, DE};
        EpiDown epi{(bf16_t*)(p.ws + OFF_YBUF), list + e * LCAP + lt * 128, (const float*)(p.ws + OFF_GATE), ne - lt * 128, cj * 128};
        gemm128<1>(al, p.w_down + (size_t)e * DE * D + cj * 128, nullptr, D, DE, lds, epi);
    }
}

DI void phase_final(const Params& p, int bid, int nblk) {
    const int lane = threadIdx.x & 63, wid = threadIdx.x >> 6;
    const float* x2 = (const float*)(p.ws + OFF_X2); const float* gt = (const float*)(p.ws + OFF_MODX) + 5120; const bf16_t* yb = (const bf16_t*)(p.ws + OFF_YBUF);
    for (int t = bid * 4 + wid; t < S; t += nblk * 4) {
        f32x4 v[4]; float ss = 0.f;
#pragma unroll
        for (int i = 0; i < 4; ++i) {
            const int d = (i * 64 + lane) * 4;
            v[i] = *(const f32x4*)(x2 + (size_t)t * D + d);
            const u32x2 a = *(const u32x2*)(yb + (size_t)(2 * t) * D + d), b = *(const u32x2*)(yb + (size_t)(2 * t + 1) * D + d);
            const f32x4 g = *(const f32x4*)(gt + d);
            v[i][0] += g[0] * (bflo(a.x) + bflo(b.x)); v[i][1] += g[1] * (bfhi(a.x) + bfhi(b.x));
            v[i][2] += g[2] * (bflo(a.y) + bflo(b.y)); v[i][3] += g[3] * (bfhi(a.y) + bfhi(b.y));
            ss += v[i][0] * v[i][0] + v[i][1] * v[i][1] + v[i][2] * v[i][2] + v[i][3] * v[i][3];
        }
        ss = wave_sum(ss);
        const float rstd = rsqrtf(ss * (1.f / 1024.f) + 1e-6f);
#pragma unroll
        for (int i = 0; i < 4; ++i) {
            const int d = (i * 64 + lane) * 4; const f32x4 fg = *(const f32x4*)(p.final_g + d); f32x4 o;
#pragma unroll
            for (int j = 0; j < 4; ++j) o[j] = v[i][j] * rstd * fg[j];
            *(f32x4*)(p.out + (size_t)t * D + d) = o;
        }
    }
}

constexpr int MEGA_LDS = SCANA_LDS > (GEMM_LDS + 256) ? SCANA_LDS : (GEMM_LDS + 256);
__global__ void __launch_bounds__(256) k_mega(Params p) {
    extern __shared__ __attribute__((aligned(16))) char lds[];
    cg::grid_group grid = cg::this_grid();
    const int bid = blockIdx.x, nblk = gridDim.x;
    phase_p0(p, bid, nblk, lds); grid.sync();
    phase_xn(p, bid, nblk); grid.sync();
    phase_g1(p, bid, nblk, lds); grid.sync();
    phase_pool(p, bid, nblk);
    phase_scanA(p, bid, nblk, lds); grid.sync();
    if (bid < 16) phase_chain(p, bid); else phase_poolgemm(p, bid - 16, nblk - 16, lds);
    grid.sync();
    phase_scanC(p, bid, nblk); grid.sync();
    phase_g2(p, bid, nblk, lds); grid.sync();
    phase_router(p, bid, nblk); grid.sync();
    phase_g3(p, bid, nblk, lds); grid.sync();
    phase_g4(p, bid, nblk, lds); grid.sync();
    phase_final(p, bid, nblk);
}

extern "C" void kernel_launch(void* const* d_in, const int* in_sizes, int n_in, void* d_out, int out_size, void* d_ws, size_t ws_size, hipStream_t stream) {
    if (ws_size < WS_NEED) { fprintf(stderr, "workspace too small: %zu < %zu\n", ws_size, (size_t)WS_NEED); return; }
    Params p{};
    const float** f = (const float**)&p;
    for (int i = 0; i < 36; ++i) f[i] = (const float*)d_in[i];
    p.out = (float*)d_out; p.ws = (char*)d_ws;
    static int grid_blocks = 0;
    if (!grid_blocks) {
        (void)hipFuncSetAttribute((const void*)k_mega, hipFuncAttributeMaxDynamicSharedMemorySize, MEGA_LDS);
        int dev = 0, cus = 0, per_cu = 0;
        (void)hipGetDevice(&dev);
        (void)hipDeviceGetAttribute(&cus, hipDeviceAttributeMultiprocessorCount, dev);
        (void)hipOccupancyMaxActiveBlocksPerMultiprocessor(&per_cu, k_mega, 256, MEGA_LDS);
        if (per_cu > 1) per_cu = 1;
        grid_blocks = cus * per_cu;
    }
    void* args[] = {&p};
    hipError_t e = hipLaunchCooperativeKernel((const void*)k_mega, dim3(grid_blocks), dim3(256), args, MEGA_LDS, stream);
    if (e != hipSuccess) fprintf(stderr, "cooperative launch failed: %s (grid %d)\n", hipGetErrorString(e), grid_blocks);
}
```

```cpp
#include <hip/hip_runtime.h>
#include <stdint.h>
#include <stdio.h>
#include <hip/hip_cooperative_groups.h>
namespace cg = cooperative_groups;

#define DI __device__ __forceinline__
typedef unsigned short bf16_t;
typedef short bf16x8 __attribute__((ext_vector_type(8)));
typedef short s16x4 __attribute__((ext_vector_type(4)));
typedef float f32x4 __attribute__((ext_vector_type(4)));
typedef float f32x2 __attribute__((ext_vector_type(2)));
typedef __bf16 bf16x2_t __attribute__((ext_vector_type(2)));
typedef unsigned u32x4 __attribute__((ext_vector_type(4)));
typedef unsigned u32x2 __attribute__((ext_vector_type(2)));
#define LAS __attribute__((address_space(3)))

constexpr int D = 1024, S = 16384, CTX = 256, NT = S + CTX, DIN = 2432, DSH = 1920, DR = 512;
constexpr int C_WLF = 1536, C_WLB = 1600, C_ALF = 1664, C_ALB = 1728, C_GL = 1792, C_POOL = 1920;
constexpr int NE = 32, DE = 512, LCAP = 32768;
constexpr float DECAY_SCALE = 0.6065306597f;

constexpr int NCH = NT / 64;
constexpr size_t SZ_U = (size_t)NT * DIN * 2;
constexpr size_t SZ_CH = (size_t)16 * NCH * 8192;
constexpr size_t OFF_U = 0;
constexpr size_t OFF_XN = OFF_U + SZ_U;
constexpr size_t OFF_P = OFF_XN;
constexpr size_t OFF_Q = OFF_P + SZ_CH;
constexpr size_t OFF_WYT = OFF_Q + SZ_CH;
constexpr size_t OFF_YL = OFF_WYT + (size_t)256 * 16 * 8192;
constexpr size_t OFF_V = OFF_YL + (size_t)256 * 16 * 8192;
constexpr size_t OFF_G = OFF_V + (size_t)S * DR * 2;
constexpr size_t OFF_MIX = OFF_G + (size_t)S * DR * 2;
constexpr size_t OFF_SMALL = OFF_MIX + (size_t)S * D * 2;
constexpr size_t OFF_MODX = OFF_SMALL, OFF_MODC = OFF_MODX + 6144 * 4;
constexpr size_t OFF_ROWTAB = OFF_MODC + 6144 * 4, OFF_COLTAB = OFF_ROWTAB + 256 * 512 * 4;
constexpr size_t OFF_CNT = OFF_COLTAB + 64 * 512 * 4;
constexpr size_t OFF_GATE = OFF_CNT + 256;
constexpr size_t OFF_LIST = OFF_GATE + (size_t)S * 2 * 4;
constexpr size_t OFF_DOT = OFF_LIST + (size_t)NE * LCAP * 4;
constexpr size_t OFF_BAR = OFF_DOT + (size_t)NT * 16 * 4;
constexpr size_t WS_NEED = OFF_BAR + 16384;
constexpr size_t OFF_Z = OFF_U;
constexpr size_t OFF_X2 = OFF_P;
constexpr size_t OFF_YBUF = OFF_WYT;
constexpr size_t OFF_H2 = OFF_U;
constexpr size_t OFF_HID = OFF_U + SZ_CH;

struct Params {
    const float *x, *c, *ctx, *c_ctx, *norm1_g, *w_mod, *b_mod, *w_in, *mu, *w0_f, *w2_f, *w0_b, *w2_b, *a0_f, *a2_f, *a0_b, *a2_b,
        *g2, *k_k, *k_a, *r_k_f, *r_k_b, *gn_w, *gn_b, *w_pool, *pool_scale, *w_out, *norm2_g, *w_rg, *b_rg, *w_re, *b_re,
        *w_gate, *w_up, *w_down, *final_g;
    float* out;
    char* ws;
};

DI unsigned pack2(float lo, float hi) { f32x2 v = {lo, hi}; bf16x2_t b = __builtin_convertvector(v, bf16x2_t); return __builtin_bit_cast(unsigned, b); }
DI float bf2f(bf16_t h) { return __uint_as_float(((unsigned)h) << 16); }
DI float bflo(unsigned u) { return __uint_as_float(u << 16); }
DI float bfhi(unsigned u) { return __uint_as_float(u & 0xffff0000u); }
DI void unpack8(const u32x4& p, float* f) { f[0] = bflo(p.x); f[1] = bfhi(p.x); f[2] = bflo(p.y); f[3] = bfhi(p.y); f[4] = bflo(p.z); f[5] = bfhi(p.z); f[6] = bflo(p.w); f[7] = bfhi(p.w); }
DI u32x4 pack8(const float* f) { u32x4 p; p.x = pack2(f[0], f[1]); p.y = pack2(f[2], f[3]); p.z = pack2(f[4], f[5]); p.w = pack2(f[6], f[7]); return p; }
DI float sigmoidf_(float x) { return 1.f / (1.f + __expf(-x)); }
DI float wave_sum(float v) {
#pragma unroll
    for (int o = 32; o > 0; o >>= 1) v += __shfl_xor(v, o, 64);
    return v;
}
DI f32x4 wave_sum4(f32x4 v) {
#pragma unroll
    for (int o = 32; o > 0; o >>= 1) { v[0] += __shfl_xor(v[0], o, 64); v[1] += __shfl_xor(v[1], o, 64); v[2] += __shfl_xor(v[2], o, 64); v[3] += __shfl_xor(v[3], o, 64); }
    return v;
}
DI float pos_val(const float* rowtab, const float* coltab, int t, int d) { return d < 512 ? rowtab[(t >> 6) * 512 + d] : coltab[(t & 63) * 512 + (d - 512)]; }

DI void phase_p0(const Params& p, int bid, int nblk, char* lds) {
    const int tid = threadIdx.x;
    float* modx = (float*)(p.ws + OFF_MODX); float* modc = (float*)(p.ws + OFF_MODC);
    float* red = (float*)lds;
    for (int item = bid; item < 96; item += nblk) {
        const int col0 = item * 64, cg = tid & 15, kg = tid >> 4;
        f32x4 ax = {0, 0, 0, 0}, ac = {0, 0, 0, 0};
        for (int kk = 0; kk < 64; ++kk) {
            const int k = kg * 64 + kk;
            const float cv = p.c[k], cc = p.c_ctx[k];
            const float sx = cv * sigmoidf_(cv), sc = cc * sigmoidf_(cc);
            const f32x4 w = *(const f32x4*)(p.w_mod + (size_t)k * 6144 + col0 + cg * 4);
            ax += w * sx; ac += w * sc;
        }
        __syncthreads();
#pragma unroll
        for (int j = 0; j < 4; ++j) { red[(kg * 64 + cg * 4 + j) * 2] = ax[j]; red[(kg * 64 + cg * 4 + j) * 2 + 1] = ac[j]; }
        __syncthreads();
        if (tid < 128) {
            const int col = tid & 63, which = tid >> 6;
            float s = 0.f;
            for (int g = 0; g < 16; ++g) s += red[(g * 64 + col) * 2 + which];
            s += p.b_mod[col0 + col];
            (which ? modc : modx)[col0 + col] = s;
        }
    }
    float* rowtab = (float*)(p.ws + OFF_ROWTAB); float* coltab = (float*)(p.ws + OFF_COLTAB);
    for (int i = bid * 256 + tid; i < (256 + 64) * 256; i += nblk * 256) {
        const int pos = i >> 8, f = i & 255;
        const float freq = powf(10000.f, -(float)f / 256.f);
        if (pos < 256) { const float a = (float)pos * freq; rowtab[pos * 512 + f] = sinf(a); rowtab[pos * 512 + 256 + f] = cosf(a); }
        else { const int cp = pos - 256; const float a = (float)cp * freq; coltab[cp * 512 + f] = sinf(a); coltab[cp * 512 + 256 + f] = cosf(a); }
    }
    if (bid == 0 && tid < 64) ((int*)(p.ws + OFF_CNT))[tid] = 0;
}

DI void phase_xn(const Params& p, int bid, int nblk) {
    const int lane = threadIdx.x & 63, wid = threadIdx.x >> 6;
    const float* modx = (const float*)(p.ws + OFF_MODX); const float* modc = (const float*)(p.ws + OFF_MODC);
    const float* rowtab = (const float*)(p.ws + OFF_ROWTAB); const float* coltab = (const float*)(p.ws + OFF_COLTAB);
    bf16_t* xn = (bf16_t*)(p.ws + OFF_XN);
    for (int g = bid * 4 + wid; g < NT; g += nblk * 4) {
        const bool isctx = g < CTX; const int t = g - CTX;
        const float* src = isctx ? p.ctx + (size_t)g * D : p.x + (size_t)t * D;
        const float* md = isctx ? modc : modx;
        f32x4 v[4]; float ss = 0.f;
#pragma unroll
        for (int i = 0; i < 4; ++i) {
            const int d = (i * 64 + lane) * 4;
            v[i] = *(const f32x4*)(src + d);
            if (!isctx) {
#pragma unroll
                for (int j = 0; j < 4; ++j) v[i][j] += pos_val(rowtab, coltab, t, d + j);
            }
            ss += v[i][0] * v[i][0] + v[i][1] * v[i][1] + v[i][2] * v[i][2] + v[i][3] * v[i][3];
        }
        ss = wave_sum(ss);
        const float rstd = rsqrtf(ss * (1.f / 1024.f) + 1e-6f);
#pragma unroll
        for (int i = 0; i < 4; ++i) {
            const int d = (i * 64 + lane) * 4;
            const f32x4 gg = *(const f32x4*)(p.norm1_g + d), sh = *(const f32x4*)(md + d), sc = *(const f32x4*)(md + 1024 + d);
            f32x4 o;
#pragma unroll
            for (int j = 0; j < 4; ++j) o[j] = (v[i][j] * rstd * gg[j]) * (1.f + sc[j]) + sh[j];
            u32x2 pk = {pack2(o[0], o[1]), pack2(o[2], o[3])};
            *(u32x2*)(xn + (size_t)g * D + d) = pk;
        }
    }
}

constexpr int GEMM_LDS = 10240 + 2 * 8704;
template <int NB, class AL, class EPI>
DI void gemm128(AL& al, const float* __restrict__ B0, const float* __restrict__ B1, int ldb, int K, char* lds, EPI& epi) {
    const int tid = threadIdx.x, lane = tid & 63, wid = tid >> 6, wr = wid >> 1, wc = wid & 1, fr = lane & 15, fq = lane >> 4;
    bf16_t* sA = (bf16_t*)lds; bf16_t* sB0 = (bf16_t*)(lds + 10240); bf16_t* sB1 = (bf16_t*)(lds + 10240 + 8704);
    f32x4 acc0[4][4], acc1[4][4];
#pragma unroll
    for (int m = 0; m < 4; ++m)
#pragma unroll
        for (int n = 0; n < 4; ++n) { acc0[m][n] = (f32x4){0, 0, 0, 0}; acc1[m][n] = (f32x4){0, 0, 0, 0}; }
    u32x4 ra[2]; f32x4 rb0[4], rb1[4];
    auto gload = [&](int k0) {
#pragma unroll
        for (int i = 0; i < 2; ++i) { const int c = tid + 256 * i; ra[i] = al.load(i, c >> 2, k0 + (c & 3) * 8); }
#pragma unroll
        for (int i = 0; i < 4; ++i) {
            const int c = tid + 256 * i, kr = c >> 5, n4 = c & 31;
            rb0[i] = *(const f32x4*)(B0 + (size_t)(k0 + kr) * ldb + n4 * 4);
            if (NB == 2) rb1[i] = *(const f32x4*)(B1 + (size_t)(k0 + kr) * ldb + n4 * 4);
        }
    };
    gload(0);
    for (int k0 = 0; k0 < K; k0 += 32) {
        __syncthreads();
#pragma unroll
        for (int i = 0; i < 2; ++i) { const int c = tid + 256 * i; *(u32x4*)(sA + (c >> 2) * 40 + (c & 3) * 8) = ra[i]; }
#pragma unroll
        for (int i = 0; i < 4; ++i) {
            const int c = tid + 256 * i, kr = c >> 5, n4 = c & 31;
            u32x2 pk = {pack2(rb0[i][0], rb0[i][1]), pack2(rb0[i][2], rb0[i][3])};
            *(u32x2*)(sB0 + kr * 136 + n4 * 4) = pk;
            if (NB == 2) { u32x2 pk1 = {pack2(rb1[i][0], rb1[i][1]), pack2(rb1[i][2], rb1[i][3])}; *(u32x2*)(sB1 + kr * 136 + n4 * 4) = pk1; }
        }
        __syncthreads();
        if (k0 + 32 < K) gload(k0 + 32);
        bf16x8 af[4], bf0[4], bf1[4];
#pragma unroll
        for (int m = 0; m < 4; ++m) af[m] = *(const bf16x8*)(sA + (wr * 64 + m * 16 + fr) * 40 + fq * 8);
#pragma unroll
        for (int n = 0; n < 4; ++n) {
            const int off = (fq * 8 + (fr >> 2)) * 136 + wc * 64 + n * 16 + 4 * (fr & 3);
            s16x4 lo = __builtin_amdgcn_ds_read_tr16_b64_v4i16((LAS s16x4*)(sB0 + off));
            s16x4 hi = __builtin_amdgcn_ds_read_tr16_b64_v4i16((LAS s16x4*)(sB0 + off + 4 * 136));
            bf0[n] = __builtin_shufflevector(lo, hi, 0, 1, 2, 3, 4, 5, 6, 7);
            if (NB == 2) {
                s16x4 lo1 = __builtin_amdgcn_ds_read_tr16_b64_v4i16((LAS s16x4*)(sB1 + off));
                s16x4 hi1 = __builtin_amdgcn_ds_read_tr16_b64_v4i16((LAS s16x4*)(sB1 + off + 4 * 136));
                bf1[n] = __builtin_shufflevector(lo1, hi1, 0, 1, 2, 3, 4, 5, 6, 7);
            }
        }
#pragma unroll
        for (int m = 0; m < 4; ++m)
#pragma unroll
            for (int n = 0; n < 4; ++n) {
                acc0[m][n] = __builtin_amdgcn_mfma_f32_16x16x32_bf16(bf0[n], af[m], acc0[m][n], 0, 0, 0);
                if (NB == 2) acc1[m][n] = __builtin_amdgcn_mfma_f32_16x16x32_bf16(bf1[n], af[m], acc1[m][n], 0, 0, 0);
            }
    }
#pragma unroll
    for (int m = 0; m < 4; ++m)
#pragma unroll
        for (int n = 0; n < 4; ++n) epi(wr * 64 + m * 16 + fr, wc * 64 + n * 16 + 4 * fq, acc0[m][n], acc1[m][n]);
    __syncthreads();
}

struct PlainA {
    const bf16_t* base; int lda;
    DI u32x4 load(int, int row, int k) const { return *(const u32x4*)(base + (size_t)row * lda + k); }
};
struct GatherA {
    const bf16_t* rp[2];
    DI u32x4 load(int i, int, int k) const { return *(const u32x4*)(rp[i] + k); }
};
template <int ACT> struct LoraA {
    const bf16_t* u; const float* mu; int row0, cb;
    DI u32x4 load(int, int row, int k) const {
        const int g = row0 + row;
        const bf16_t* pc = u + (size_t)g * DIN + cb + k;
        float c[8], pv[8], nx[8];
        unpack8(*(const u32x4*)pc, c);
        const bool hasp = (g != 0) && (g != CTX), hasn = (g != CTX - 1) && (g != NT - 1);
        if (hasp) unpack8(*(const u32x4*)(pc - DIN), pv); else { for (int j = 0; j < 8; ++j) pv[j] = 0.f; }
        if (hasn) unpack8(*(const u32x4*)(pc + DIN), nx); else { for (int j = 0; j < 8; ++j) nx[j] = 0.f; }
        float o[8];
#pragma unroll
        for (int j = 0; j < 8; ++j) {
            const float m = mu[cb + k + j];
            float s = c[j] + m * (0.5f * (pv[j] + nx[j]) - c[j]);
            if (ACT == 1) s = tanhf(s); else if (ACT == 2) s = sigmoidf_(s);
            o[j] = s;
        }
        return pack8(o);
    }
};

struct EpiStoreBf16 { bf16_t* o; int ldo; DI void operator()(int r, int c, const f32x4& v, const f32x4&) const { u32x2 pk = {pack2(v[0], v[1]), pack2(v[2], v[3])}; *(u32x2*)(o + (size_t)r * ldo + c) = pk; } };
DI void phase_g1(const Params& p, int bid, int nblk, char* lds) {
    const bf16_t* xn = (const bf16_t*)(p.ws + OFF_XN); bf16_t* u = (bf16_t*)(p.ws + OFF_U);
    for (int item = bid; item < 130 * 19; item += nblk) {
        const int tm = item / 19, tn = item % 19;
        PlainA al{xn + (size_t)tm * 128 * D, D};
        EpiStoreBf16 epi{u + (size_t)tm * 128 * DIN + tn * 128, DIN};
        gemm128<1>(al, p.w_in + tn * 128, nullptr, DIN, D, lds, epi);
    }
}

DI void phase_pool(const Params& p, int bid, int nblk) {
    const int lane = threadIdx.x & 63, wid = threadIdx.x >> 6;
    const bf16_t* u = (const bf16_t*)(p.ws + OFF_U);
    bf16_t* mix = (bf16_t*)(p.ws + OFF_MIX);
    for (int t = bid * 4 + wid; t < S; t += nblk * 4) {
        const int gi = lane >> 4, win = 2 << gi;
        int lo = t - win / 2, hi = lo + win; lo = lo < 0 ? 0 : lo; hi = hi > S ? S : hi;
        float s[8], c[8];
        for (int j = 0; j < 8; ++j) s[j] = 0.f;
        for (int tt = lo; tt < hi; ++tt) {
            float q[8]; unpack8(*(const u32x4*)(u + (size_t)(tt + CTX) * DIN + C_POOL + lane * 8), q);
            for (int j = 0; j < 8; ++j) s[j] += q[j];
        }
        unpack8(*(const u32x4*)(u + (size_t)(t + CTX) * DIN + C_POOL + lane * 8), c);
        const float inv = 1.f / (float)(hi - lo);
        float o[8];
        for (int j = 0; j < 8; ++j) o[j] = s[j] * inv - c[j];
        *(u32x4*)(mix + (size_t)t * D + lane * 8) = pack8(o);
    }
}
struct EpiPool { bf16_t* o; const float* sc; DI void operator()(int r, int c, const f32x4& v, const f32x4&) const {
    u32x2 pk = {pack2(v[0] * sc[c], v[1] * sc[c + 1]), pack2(v[2] * sc[c + 2], v[3] * sc[c + 3])}; *(u32x2*)(o + (size_t)r * D + c) = pk; } };
DI void phase_poolgemm(const Params& p, int bid, int nblk, char* lds) {
    if (nblk <= 0) return;
    for (int it = bid; it < 4 * 128; it += nblk) {
        const int gi = it >> 7, tm = it & 127;
        const bf16_t* mix = (const bf16_t*)(p.ws + OFF_MIX);
        PlainA al{mix + (size_t)tm * 128 * D + gi * 128, D};
        EpiPool e{(bf16_t*)(p.ws + OFF_MIX) + (size_t)tm * 128 * D + 512 + gi * 128, p.pool_scale + gi * 128};
        gemm128<1>(al, p.w_pool + (size_t)gi * 128 * 128, nullptr, 128, 128, lds, e);
    }
}

typedef float f32x16 __attribute__((ext_vector_type(16)));
constexpr int MP = 72, MSZ = 64 * MP;
constexpr int FP = 68;
constexpr int SCANA_LDS = 14 * MSZ * 2 + 2048;
DI s16x4 tr16(const bf16_t* a) { return __builtin_amdgcn_ds_read_tr16_b64_v4i16((LAS s16x4*)a); }
template <bool KS> DI bf16x8 frag32(const bf16_t* base, int x0, int s, int lane) {
    if (!KS) return *(const bf16x8*)(base + (x0 + (lane & 31)) * MP + 16 * s + 8 * (lane >> 5));
    const int gi = lane >> 4, i = lane & 15;
    const bf16_t* a = base + (16 * s + 8 * (gi >> 1) + (i >> 2)) * MP + x0 + 16 * (gi & 1) + 4 * (i & 3);
    s16x4 lo = tr16(a), hi = tr16(a + 4 * MP);
    return __builtin_shufflevector(lo, hi, 0, 1, 2, 3, 4, 5, 6, 7);
}
template <bool XKS, bool YKS> DI f32x16 mm32(const bf16_t* X, int x0, const bf16_t* Y, int y0, f32x16 acc, int lane) {
#pragma unroll
    for (int s = 0; s < 4; ++s) acc = __builtin_amdgcn_mfma_f32_32x32x16_bf16(frag32<XKS>(X, x0, s, lane), frag32<YKS>(Y, y0, s, lane), acc, 0, 0, 0);
    return acc;
}
DI f32x16 zero16() { f32x16 z; for (int i = 0; i < 16; ++i) z[i] = 0.f; return z; }
template <class F> DI void store_acc(bf16_t* out, int x0, int y0, const f32x16& acc, int lane, F f) {
    const int y = y0 + (lane & 31), hh = lane >> 5;
#pragma unroll
    for (int q = 0; q < 4; ++q) {
        const int x = x0 + 8 * q + 4 * hh;
        u32x2 pk = {pack2(f(acc[4 * q], x, y), f(acc[4 * q + 1], x + 1, y)), pack2(f(acc[4 * q + 2], x + 2, y), f(acc[4 * q + 3], x + 3, y))};
        *(u32x2*)(out + y * MP + x) = pk;
    }
}
DI unsigned rot16(unsigned x) { return (x >> 16) | (x << 16); }

DI int chain_pos(int c, int dir) { return dir == 0 ? c : (c < 4 ? 3 - c : NCH + 3 - c); }

DI void phase_scanA(const Params& p, int bid, int nblk, char* lds) {
    const int tid = threadIdx.x, lane = tid & 63, w = tid >> 6, xq = 32 * (w & 1), yq = 32 * (w >> 1);
    bf16_t* M = (bf16_t*)lds;
    bf16_t *sAT = M, *sBT = M + MSZ, *sKT = M + 2 * MSZ, *sRT = M + 3 * MSZ, *sVT = M + 4 * MSZ;
    float* fGC = (float*)(lds + 14 * MSZ * 2);
    float* fSeg = fGC + 64;
    float* fLogw = (float*)(M + 12 * MSZ);
    float* fA = (float*)(M + 10 * MSZ);
    const bf16_t* u = (const bf16_t*)(p.ws + OFF_U);
    for (int inst = bid; inst < NCH * 16; inst += nblk) {
        const int c = inst >> 4, h = (inst >> 1) & 7, dir = inst & 1;
        const bool latent = c >= 4, want_g = latent && dir == 0;
        const float* w2 = dir ? p.w2_b : p.w2_f; const float* a2 = dir ? p.a2_b : p.a2_f;
        const float* w0 = dir ? p.w0_b : p.w0_f; const float* a0 = dir ? p.a0_b : p.a0_f;
        const float* rkd = dir ? p.r_k_b : p.r_k_f;
        const int cwl = dir ? C_WLB : C_WLF, cal = dir ? C_ALB : C_ALF;
        const int ch = tid & 7;
        float fr_[2][8], fk_[2][8], fv_[2][8];
#pragma unroll
        for (int i = 0; i < 2; ++i) {
            const int tau = (tid >> 3) + 32 * i, g = dir ? c * 64 + 63 - tau : c * 64 + tau;
            const bool hasp = (g != 0) && (g != CTX), hasn = (g != CTX - 1) && (g != NT - 1);
            auto shifted = [&](int col, float* o) {
                const bf16_t* pc = u + (size_t)g * DIN + col;
                float cc[8], pv[8], nx[8];
                unpack8(*(const u32x4*)pc, cc);
                if (hasp) unpack8(*(const u32x4*)(pc - DIN), pv); else { for (int j = 0; j < 8; ++j) pv[j] = 0.f; }
                if (hasn) unpack8(*(const u32x4*)(pc + DIN), nx); else { for (int j = 0; j < 8; ++j) nx[j] = 0.f; }
#pragma unroll
                for (int j = 0; j < 8; ++j) { const float m = p.mu[col + j]; o[j] = cc[j] + m * (0.5f * (pv[j] + nx[j]) - cc[j]); }
            };
            shifted(h * 64 + ch * 8, fr_[i]); shifted(512 + h * 64 + ch * 8, fk_[i]); shifted(1024 + h * 64 + ch * 8, fv_[i]);
            float t8[8];
            shifted(cwl + ch * 8, t8);
#pragma unroll
            for (int j = 0; j < 8; ++j) t8[j] = tanhf(t8[j]);
            *(u32x4*)(M + 5 * MSZ + tau * MP + ch * 8) = pack8(t8);
            shifted(cal + ch * 8, t8);
            *(u32x4*)(M + 6 * MSZ + tau * MP + ch * 8) = pack8(t8);
        }
#pragma unroll
        for (int i = 0; i < 4; ++i) {
            const int idx = tid + 256 * i, kr = idx >> 4, n4 = idx & 15;
            const f32x4 a = *(const f32x4*)(w2 + (size_t)kr * DR + h * 64 + n4 * 4), b = *(const f32x4*)(a2 + (size_t)kr * DR + h * 64 + n4 * 4);
            u32x2 pa = {pack2(a[0], a[1]), pack2(a[2], a[3])}, pb = {pack2(b[0], b[1]), pack2(b[2], b[3])};
            *(u32x2*)(M + 7 * MSZ + kr * MP + n4 * 4) = pa; *(u32x2*)(M + 8 * MSZ + kr * MP + n4 * 4) = pb;
        }
        __syncthreads();
        {
            f32x16 accW = mm32<true, false>(M + 7 * MSZ, xq, M + 5 * MSZ, yq, zero16(), lane);
            f32x16 accA = mm32<true, false>(M + 8 * MSZ, xq, M + 6 * MSZ, yq, zero16(), lane);
            const int y = yq + (lane & 31), hh = lane >> 5;
#pragma unroll
            for (int q = 0; q < 4; ++q) {
                const int x = xq + 8 * q + 4 * hh;
                f32x4 lw, av;
#pragma unroll
                for (int e = 0; e < 4; ++e) { lw[e] = -DECAY_SCALE * sigmoidf_(w0[h * 64 + x + e] + accW[4 * q + e]); av[e] = sigmoidf_(a0[h * 64 + x + e] + accA[4 * q + e]); }
                *(f32x4*)(fLogw + y * FP + x) = lw; *(f32x4*)(fA + y * FP + x) = av;
            }
        }
        __syncthreads();
        {
            const int n = tid & 63, qq = tid >> 6; float run = 0.f;
            for (int t = 16 * qq; t < 16 * qq + 16; ++t) { run += fLogw[t * FP + n]; fLogw[t * FP + n] = run; }
            fSeg[qq * 64 + n] = run;
        }
        if (want_g) {
#pragma unroll
            for (int i = 0; i < 2; ++i) {
                const int tau = (tid >> 3) + 32 * i, g = c * 64 + tau;
                const bool hasp = (g != 0) && (g != CTX), hasn = (g != CTX - 1) && (g != NT - 1);
#pragma unroll
                for (int half = 0; half < 2; ++half) {
                    const int col = C_GL + half * 64 + ch * 8;
                    const bf16_t* pc = u + (size_t)g * DIN + col;
                    float cc[8], pv[8], nx[8], o[8];
                    unpack8(*(const u32x4*)pc, cc);
                    if (hasp) unpack8(*(const u32x4*)(pc - DIN), pv); else { for (int j = 0; j < 8; ++j) pv[j] = 0.f; }
                    if (hasn) unpack8(*(const u32x4*)(pc + DIN), nx); else { for (int j = 0; j < 8; ++j) nx[j] = 0.f; }
#pragma unroll
                    for (int j = 0; j < 8; ++j) { const float m = p.mu[col + j]; o[j] = sigmoidf_(cc[j] + m * (0.5f * (pv[j] + nx[j]) - cc[j])); }
                    *(u32x4*)(M + (5 + half) * MSZ + tau * MP + ch * 8) = pack8(o);
                }
            }
#pragma unroll
            for (int i = 0; i < 8; ++i) {
                const int idx = tid + 256 * i, kr = idx >> 4, n4 = idx & 15;
                const f32x4 a = *(const f32x4*)(p.g2 + (size_t)kr * DR + h * 64 + n4 * 4);
                u32x2 pa = {pack2(a[0], a[1]), pack2(a[2], a[3])};
                *(u32x2*)(M + (7 + (kr >> 6)) * MSZ + (kr & 63) * MP + n4 * 4) = pa;
            }
        }
        __syncthreads();
        {
            const int n = tid & 63, qq = tid >> 6; float off = 0.f;
            for (int q2 = 0; q2 < qq; ++q2) off += fSeg[q2 * 64 + n];
            if (qq) for (int t = 16 * qq; t < 16 * qq + 16; ++t) fLogw[t * FP + n] += off;
        }
        __syncthreads();
#pragma unroll
        for (int i = 0; i < 2; ++i) {
            const int tau = (tid >> 3) + 32 * i, g = dir ? c * 64 + 63 - tau : c * 64 + tau;
            float oa[8], ob[8], ok[8], orr[8], kkv[8], kd[8];
            float ss = 0.f, dsum = 0.f;
#pragma unroll
            for (int j = 0; j < 8; ++j) { const int cch = h * 64 + ch * 8 + j; kkv[j] = fk_[i][j] * p.k_k[cch]; ss += kkv[j] * kkv[j]; }
            ss += __shfl_xor(ss, 1, 64); ss += __shfl_xor(ss, 2, 64); ss += __shfl_xor(ss, 4, 64);
            const float inv = 1.f / fmaxf(sqrtf(ss), 1e-12f);
#pragma unroll
            for (int j = 0; j < 8; ++j) {
                const int jj = ch * 8 + j, cch = h * 64 + jj;
                const float cum = fLogw[tau * FP + jj], cprev = tau ? fLogw[(tau - 1) * FP + jj] : 0.f, av = fA[tau * FP + jj];
                const float gam = __expf(cum), gprev = __expf(cprev), ginv = __expf(-cum);
                const float kkn = kkv[j] * inv;
                kd[j] = fk_[i][j] * (1.f + (av - 1.f) * p.k_a[cch]);
                oa[j] = -kkn * gprev; ob[j] = kkn * av * ginv; ok[j] = kd[j] * ginv; orr[j] = fr_[i][j] * gam;
                dsum += fr_[i][j] * kd[j] * rkd[cch];
                if (tau == 63) fGC[jj] = gam;
            }
            dsum += __shfl_xor(dsum, 1, 64); dsum += __shfl_xor(dsum, 2, 64); dsum += __shfl_xor(dsum, 4, 64);
            if (ch == 0) ((float*)(p.ws + OFF_DOT))[((size_t)g * 8 + h) * 2 + dir] = dsum;
            *(u32x4*)(sAT + tau * MP + ch * 8) = pack8(oa); *(u32x4*)(sBT + tau * MP + ch * 8) = pack8(ob);
            *(u32x4*)(sKT + tau * MP + ch * 8) = pack8(ok); *(u32x4*)(sRT + tau * MP + ch * 8) = pack8(orr);
            const u32x4 pv8 = pack8(fv_[i]);
            *(u32x4*)(sVT + tau * MP + ch * 8) = pv8;
            if (want_g) *(u32x4*)((bf16_t*)(p.ws + OFF_V) + (size_t)(g - CTX) * DR + h * 64 + ch * 8) = pv8;
        }
        if (want_g) {
            f32x16 accG = mm32<true, false>(M + 7 * MSZ, xq, M + 5 * MSZ, yq, zero16(), lane);
            accG = mm32<true, false>(M + 8 * MSZ, xq, M + 6 * MSZ, yq, accG, lane);
            const int y = yq + (lane & 31), hh = lane >> 5, t = c * 64 + y - CTX;
#pragma unroll
            for (int q = 0; q < 4; ++q) {
                const int x = xq + 8 * q + 4 * hh;
                u32x2 pk = {pack2(accG[4 * q], accG[4 * q + 1]), pack2(accG[4 * q + 2], accG[4 * q + 3])};
                *(u32x2*)((bf16_t*)(p.ws + OFF_G) + (size_t)t * DR + h * 64 + x) = pk;
            }
        }
        __syncthreads();
        {
            f32x16 acc = mm32<false, false>(sAT, xq, sBT, yq, zero16(), lane);
            store_acc(M + 5 * MSZ, xq, yq, acc, lane, [](float v, int x, int y) { return y < x ? v : 0.f; });
            store_acc(M + 7 * MSZ, xq, yq, acc, lane, [](float v, int x, int y) { return y < x ? v : (y == x ? 1.f : 0.f); });
            acc = mm32<false, false>(sAT, xq, sKT, yq, zero16(), lane);
            store_acc(M + 9 * MSZ, xq, yq, acc, lane, [](float v, int x, int y) { return y < x ? v : 0.f; });
            acc = mm32<false, false>(sRT, xq, sBT, yq, zero16(), lane);
            store_acc(M + 10 * MSZ, xq, yq, acc, lane, [](float v, int x, int y) { return y <= x ? v : 0.f; });
            acc = mm32<false, false>(sRT, xq, sKT, yq, zero16(), lane);
            store_acc(M + 11 * MSZ, xq, yq, acc, lane, [](float v, int x, int y) { return y <= x ? v : 0.f; });
        }
        __syncthreads();
        int xs = 5, xo = 6, ts = 7, to = 8;
        {
            f32x16 acc = mm32<true, false>(M + xs * MSZ, xq, M + xs * MSZ, yq, zero16(), lane);
            store_acc(M + xo * MSZ, xq, yq, acc, lane, [](float v, int, int) { return v; });
            int t_ = xs; xs = xo; xo = t_;
        }
        __syncthreads();
        for (int k = 0; k < 5; ++k) {
            const bf16_t* Told = M + ts * MSZ;
            f32x16 acc = mm32<true, false>(M + xs * MSZ, xq, Told, yq, zero16(), lane);
            store_acc(M + to * MSZ, xq, yq, acc, lane, [Told](float v, int x, int y) { return v + bf2f(Told[y * MP + x]); });
            if (k < 4) {
                acc = mm32<true, false>(M + xs * MSZ, xq, M + xs * MSZ, yq, zero16(), lane);
                store_acc(M + xo * MSZ, xq, yq, acc, lane, [](float v, int, int) { return v; });
            }
            int t_ = xs; xs = xo; xo = t_; t_ = ts; ts = to; to = t_;
            __syncthreads();
        }
        const bf16_t* sT = M + ts * MSZ;
        {
            f32x16 acc = mm32<true, true>(sT, xq, sAT, yq, zero16(), lane);
            store_acc(M + 12 * MSZ, xq, yq, acc, lane, [](float v, int, int) { return v; });
            acc = mm32<true, false>(sT, xq, M + 9 * MSZ, yq, zero16(), lane);
            store_acc(M + 13 * MSZ, xq, yq, acc, lane, [](float v, int, int) { return v; });
        }
        __syncthreads();
        {
            const bf16_t *sAbar = M + 12 * MSZ, *sG = M + 13 * MSZ, *sABR = M + 10 * MSZ, *sAKR = M + 11 * MSZ;
            f32x16 acc = mm32<false, true>(sAbar, xq, sBT, yq, zero16(), lane);
            store_acc(M + 5 * MSZ, xq, yq, acc, lane, [fGC](float v, int x, int y) { return ((x == y ? 1.f : 0.f) + v) * fGC[y]; });
            acc = mm32<false, true>(sAbar, xq, sABR, yq, zero16(), lane);
            store_acc(M + 6 * MSZ, xq, yq, acc, lane, [sRT](float v, int x, int y) { return v + bf2f(sRT[y * MP + x]); });
            acc = mm32<true, false>(sBT, xq, sG, yq, zero16(), lane);
            store_acc(M + 7 * MSZ, xq, yq, acc, lane, [sKT, fGC](float v, int x, int y) { return (v + bf2f(sKT[y * MP + x])) * fGC[x]; });
            acc = mm32<true, false>(sABR, xq, sG, yq, zero16(), lane);
            store_acc(M + 9 * MSZ, xq, yq, acc, lane, [sAKR](float v, int x, int y) { return v + bf2f(sAKR[y * MP + x]); });
        }
        __syncthreads();
        const int chain = dir * 8 + h, npos = chain_pos(c, dir);
        {
            u32x4* Pg = (u32x4*)(p.ws + OFF_P) + ((size_t)chain * NCH + npos) * 512;
#pragma unroll
            for (int i = 0; i < 2; ++i) {
                const int item = tid + 256 * i, ln = item & 63, as = item >> 6, a = as >> 1, s2 = as & 1, fr = ln & 15, fq = ln >> 4;
                const bf16_t* src = M + 5 * MSZ + (16 * a + fr) * MP + 32 * s2 + 4 * fq;
                const u32x2 lo = *(const u32x2*)src, hi = *(const u32x2*)(src + 16);
                Pg[as * 64 + ln] = (u32x4){lo.x, lo.y, hi.x, hi.y};
            }
            if (latent) {
                u32x4* Wg = (u32x4*)(p.ws + OFF_WYT) + ((size_t)((c - 4) * 8 + h) * 2 + dir) * 512;
#pragma unroll
                for (int i = 0; i < 2; ++i) { const int item = tid + 256 * i, row = item >> 3, ck = item & 7; Wg[item] = *(const u32x4*)(M + 6 * MSZ + row * MP + ck * 8); }
            }
        }
        {
            f32x16 acc = mm32<true, true>(M + 7 * MSZ, xq, sVT, yq, zero16(), lane);
            store_acc(M + 12 * MSZ, xq, yq, acc, lane, [](float v, int, int) { return v; });
            acc = mm32<true, true>(M + 9 * MSZ, xq, sVT, yq, zero16(), lane);
            store_acc(M + 13 * MSZ, xq, yq, acc, lane, [](float v, int, int) { return v; });
        }
        __syncthreads();
        {
            u32x2* Qg = (u32x2*)(p.ws + OFF_Q) + ((size_t)chain * NCH + npos) * 1024;
#pragma unroll
            for (int i = 0; i < 4; ++i) {
                const int item = tid + 256 * i, ln = item & 63, wa = item >> 6, wi = wa >> 2, a = wa & 3, fr = ln & 15, fq = ln >> 4;
                Qg[item] = *(const u32x2*)(M + 12 * MSZ + (16 * wi + fr) * MP + 16 * a + 4 * fq);
            }
            if (latent) {
                u32x2* Yg = (u32x2*)(p.ws + OFF_YL) + ((size_t)((c - 4) * 8 + h) * 2 + dir) * 1024;
#pragma unroll
                for (int i = 0; i < 4; ++i) {
                    const int item = tid + 256 * i, ln = item & 63, wn = item >> 6, wt = wn >> 2, ni = wn & 3, fr = ln & 15, fq = ln >> 4;
                    const bf16_t* row = M + 13 * MSZ + (16 * ni + fr) * MP;
                    u32x2 v;
                    if (dir == 0) v = *(const u32x2*)(row + 16 * wt + 4 * fq);
                    else { const u32x2 r2 = *(const u32x2*)(row + 60 - 16 * wt - 4 * fq); v = (u32x2){rot16(r2.y), rot16(r2.x)}; }
                    Yg[item] = v;
                }
            }
        }
        __syncthreads();
    }
}

DI void phase_chain(const Params& p, int chain) {
    const int lane = threadIdx.x & 63, w = threadIdx.x >> 6;
    const u32x4* Pg = (const u32x4*)(p.ws + OFF_P) + (size_t)chain * NCH * 512;
    const u32x2* Qg = (const u32x2*)(p.ws + OFF_Q) + (size_t)chain * NCH * 1024;
    u32x4* Zg = (u32x4*)(p.ws + OFF_Z) + (size_t)chain * NCH * 512;
    f32x4 acc[4];
#pragma unroll
    for (int a = 0; a < 4; ++a) acc[a] = (f32x4){0, 0, 0, 0};
    u32x4 pf[8]; u32x2 qf[4];
#pragma unroll
    for (int i = 0; i < 8; ++i) pf[i] = Pg[i * 64 + lane];
#pragma unroll
    for (int a = 0; a < 4; ++a) qf[a] = Qg[(w * 4 + a) * 64 + lane];
    for (int n = 0; n < NCH; ++n) {
        u32x4 pc[8]; u32x2 qc[4];
#pragma unroll
        for (int i = 0; i < 8; ++i) pc[i] = pf[i];
#pragma unroll
        for (int a = 0; a < 4; ++a) qc[a] = qf[a];
        if (n + 1 < NCH) {
#pragma unroll
            for (int i = 0; i < 8; ++i) pf[i] = Pg[(size_t)(n + 1) * 512 + i * 64 + lane];
#pragma unroll
            for (int a = 0; a < 4; ++a) qf[a] = Qg[(size_t)(n + 1) * 1024 + (w * 4 + a) * 64 + lane];
        }
        u32x4 z0 = {pack2(acc[0][0], acc[0][1]), pack2(acc[0][2], acc[0][3]), pack2(acc[1][0], acc[1][1]), pack2(acc[1][2], acc[1][3])};
        u32x4 z1 = {pack2(acc[2][0], acc[2][1]), pack2(acc[2][2], acc[2][3]), pack2(acc[3][0], acc[3][1]), pack2(acc[3][2], acc[3][3])};
        Zg[((size_t)n * 4 + w) * 128 + lane] = z0; Zg[((size_t)n * 4 + w) * 128 + 64 + lane] = z1;
        const bf16x8 zb0 = __builtin_bit_cast(bf16x8, z0), zb1 = __builtin_bit_cast(bf16x8, z1);
#pragma unroll
        for (int a = 0; a < 4; ++a) {
            f32x4 ini = {bflo(qc[a].x), bfhi(qc[a].x), bflo(qc[a].y), bfhi(qc[a].y)};
            ini = __builtin_amdgcn_mfma_f32_16x16x32_bf16(__builtin_bit_cast(bf16x8, pc[2 * a]), zb0, ini, 0, 0, 0);
            acc[a] = __builtin_amdgcn_mfma_f32_16x16x32_bf16(__builtin_bit_cast(bf16x8, pc[2 * a + 1]), zb1, ini, 0, 0, 0);
        }
    }
}

DI void phase_scanC(const Params& p, int bid, int nblk) {
    const int lane = threadIdx.x & 63, w = threadIdx.x >> 6, fr = lane & 15, fq = lane >> 4;
    bf16_t* mix = (bf16_t*)(p.ws + OFF_MIX);
    const float* dot = (const float*)(p.ws + OFF_DOT);
    for (int unit = bid; unit < 256 * 8; unit += nblk) {
        const int c = 4 + (unit >> 3), h = unit & 7;
        f32x4 y[4];
#pragma unroll
        for (int ni = 0; ni < 4; ++ni) y[ni] = (f32x4){0, 0, 0, 0};
#pragma unroll
        for (int dir = 0; dir < 2; ++dir) {
            const int chain = dir * 8 + h, npos = chain_pos(c, dir);
            const u32x4* Zg = (const u32x4*)(p.ws + OFF_Z) + ((size_t)chain * NCH + npos) * 512;
            const bf16_t* Wg = (const bf16_t*)(p.ws + OFF_WYT) + ((size_t)((c - 4) * 8 + h) * 2 + dir) * 4096;
            const u32x2* Yg = (const u32x2*)(p.ws + OFF_YL) + ((size_t)((c - 4) * 8 + h) * 2 + dir) * 1024;
            const int rho = 16 * w + fr, row = dir ? 63 - rho : rho;
            bf16x8 af[2];
#pragma unroll
            for (int s2 = 0; s2 < 2; ++s2) {
                const u32x2 lo = *(const u32x2*)(Wg + row * 64 + 32 * s2 + 4 * fq), hi = *(const u32x2*)(Wg + row * 64 + 32 * s2 + 16 + 4 * fq);
                af[s2] = __builtin_bit_cast(bf16x8, (u32x4){lo.x, lo.y, hi.x, hi.y});
            }
#pragma unroll
            for (int ni = 0; ni < 4; ++ni) {
                const u32x2 yl = Yg[(w * 4 + ni) * 64 + lane];
                f32x4 acc = {bflo(yl.x), bfhi(yl.x), bflo(yl.y), bfhi(yl.y)};
                acc = __builtin_amdgcn_mfma_f32_16x16x32_bf16(af[0], __builtin_bit_cast(bf16x8, Zg[(ni * 2 + 0) * 64 + lane]), acc, 0, 0, 0);
                acc = __builtin_amdgcn_mfma_f32_16x16x32_bf16(af[1], __builtin_bit_cast(bf16x8, Zg[(ni * 2 + 1) * 64 + lane]), acc, 0, 0, 0);
                y[ni] += acc;
            }
        }
#pragma unroll
        for (int e = 0; e < 4; ++e) {
            const int t = (c - 4) * 64 + 16 * w + 4 * fq + e, g = t + CTX;
            float s = y[0][e] + y[1][e] + y[2][e] + y[3][e];
            s += __shfl_xor(s, 1, 64); s += __shfl_xor(s, 2, 64); s += __shfl_xor(s, 4, 64); s += __shfl_xor(s, 8, 64);
            const float mean = s * (1.f / 64.f);
            float q = 0.f;
#pragma unroll
            for (int ni = 0; ni < 4; ++ni) { const float d = y[ni][e] - mean; q += d * d; }
            q += __shfl_xor(q, 1, 64); q += __shfl_xor(q, 2, 64); q += __shfl_xor(q, 4, 64); q += __shfl_xor(q, 8, 64);
            const float rs = rsqrtf(q * (1.f / 64.f) + 64e-5f);
            const float bon = dot[((size_t)g * 8 + h) * 2] + dot[((size_t)g * 8 + h) * 2 + 1];
#pragma unroll
            for (int ni = 0; ni < 4; ++ni) {
                const int cch = h * 64 + 16 * ni + fr;
                const float vv = bf2f(((const bf16_t*)(p.ws + OFF_V))[(size_t)t * DR + cch]), gg = bf2f(((const bf16_t*)(p.ws + OFF_G))[(size_t)t * DR + cch]);
                const float o = ((y[ni][e] - mean) * rs * p.gn_w[cch] + p.gn_b[cch] + bon * vv) * gg;
                const unsigned pk = pack2(o, 0.f);
                mix[(size_t)t * D + cch] = (bf16_t)(pk & 0xffffu);
            }
        }
    }
}

struct EpiX2 { float* o; const float* x; const float* gt; const float* rowtab; const float* coltab; int row0, col0;
    DI void operator()(int r, int c, const f32x4& v, const f32x4&) const {
        const int t = row0 + r, d = col0 + c; const f32x4 xv = *(const f32x4*)(x + (size_t)t * D + d); f32x4 res;
#pragma unroll
        for (int j = 0; j < 4; ++j) res[j] = xv[j] + pos_val(rowtab, coltab, t, d + j) + gt[d + j] * v[j];
        *(f32x4*)(o + (size_t)t * D + d) = res; } };
DI void phase_g2(const Params& p, int bid, int nblk, char* lds) {
    const bf16_t* mix = (const bf16_t*)(p.ws + OFF_MIX);
    for (int item = bid; item < 128 * 8; item += nblk) {
        const int tm = item >> 3, tn = item & 7;
        PlainA al{mix + (size_t)tm * 128 * D, D};
        EpiX2 e{(float*)(p.ws + OFF_X2), p.x, (const float*)(p.ws + OFF_MODX) + 2048, (const float*)(p.ws + OFF_ROWTAB), (const float*)(p.ws + OFF_COLTAB), tm * 128, tn * 128};
        gemm128<1>(al, p.w_out + tn * 128, nullptr, D, D, lds, e);
    }
}

DI void phase_router(const Params& p, int bid, int nblk) {
    const int lane = threadIdx.x & 63, wid = threadIdx.x >> 6;
    const float* x2 = (const float*)(p.ws + OFF_X2); const float* modx = (const float*)(p.ws + OFF_MODX);
    bf16_t* h2 = (bf16_t*)(p.ws + OFF_H2); int* cnt = (int*)(p.ws + OFF_CNT); float* gate = (float*)(p.ws + OFF_GATE); int* list = (int*)(p.ws + OFF_LIST);
    for (int t = bid * 4 + wid; t < S; t += nblk * 4) {
        f32x4 v[4]; float ss = 0.f;
#pragma unroll
        for (int i = 0; i < 4; ++i) { v[i] = *(const f32x4*)(x2 + (size_t)t * D + (i * 64 + lane) * 4); ss += v[i][0] * v[i][0] + v[i][1] * v[i][1] + v[i][2] * v[i][2] + v[i][3] * v[i][3]; }
        ss = wave_sum(ss);
        const float rstd = rsqrtf(ss * (1.f / 1024.f) + 1e-6f);
        f32x4 lg4 = {0, 0, 0, 0}, le4[8];
#pragma unroll
        for (int n = 0; n < 8; ++n) le4[n] = (f32x4){0, 0, 0, 0};
#pragma unroll
        for (int i = 0; i < 4; ++i) {
            const int d = (i * 64 + lane) * 4;
            const f32x4 gg = *(const f32x4*)(p.norm2_g + d), sh = *(const f32x4*)(modx + 3072 + d), sc = *(const f32x4*)(modx + 4096 + d);
            f32x4 hv;
#pragma unroll
            for (int j = 0; j < 4; ++j) hv[j] = (v[i][j] * rstd * gg[j]) * (1.f + sc[j]) + sh[j];
            u32x2 pk = {pack2(hv[0], hv[1]), pack2(hv[2], hv[3])};
            *(u32x2*)(h2 + (size_t)t * D + d) = pk;
#pragma unroll
            for (int j = 0; j < 4; ++j) {
                const float hj = hv[j];
                lg4 += *(const f32x4*)(p.w_rg + (size_t)(d + j) * 4) * hj;
#pragma unroll
                for (int n4 = 0; n4 < 8; ++n4) le4[n4] += *(const f32x4*)(p.w_re + (size_t)(d + j) * 32 + n4 * 4) * hj;
            }
        }
        lg4 = wave_sum4(lg4);
#pragma unroll
        for (int n = 0; n < 8; ++n) le4[n] = wave_sum4(le4[n]);
        const float l0 = lg4[0] + p.b_rg[0], l1 = lg4[1] + p.b_rg[1], l2 = lg4[2] + p.b_rg[2], l3 = lg4[3] + p.b_rg[3];
        int grp = 0; float mx = l0;
        if (l1 > mx) { mx = l1; grp = 1; }
        if (l2 > mx) { mx = l2; grp = 2; }
        if (l3 > mx) { mx = l3; grp = 3; }
        const float den = __expf(l0 - mx) + __expf(l1 - mx) + __expf(l2 - mx) + __expf(l3 - mx);
        const float pgrp = 1.f / den;
        const float m0 = grp == 0 ? 1.f : 0.f, m1 = grp == 1 ? 1.f : 0.f, m2 = grp == 2 ? 1.f : 0.f, m3 = grp == 3 ? 1.f : 0.f;
        f32x4 sa = le4[0] * m0 + le4[2] * m1 + le4[4] * m2 + le4[6] * m3;
        f32x4 sb = le4[1] * m0 + le4[3] * m1 + le4[5] * m2 + le4[7] * m3;
        sa += *(const f32x4*)(p.b_re + grp * 8); sb += *(const f32x4*)(p.b_re + grp * 8 + 4);
        const float s0 = sa[0], s1 = sa[1], s2 = sa[2], s3 = sa[3], s4 = sb[0], s5 = sb[1], s6 = sb[2], s7 = sb[3];
        int i1 = 0; float v1 = s0;
        if (s1 > v1) { v1 = s1; i1 = 1; }
        if (s2 > v1) { v1 = s2; i1 = 2; }
        if (s3 > v1) { v1 = s3; i1 = 3; }
        if (s4 > v1) { v1 = s4; i1 = 4; }
        if (s5 > v1) { v1 = s5; i1 = 5; }
        if (s6 > v1) { v1 = s6; i1 = 6; }
        if (s7 > v1) { v1 = s7; i1 = 7; }
        int i2 = -1; float v2 = -3.0e38f;
        if (i1 != 0 && s0 > v2) { v2 = s0; i2 = 0; }
        if (i1 != 1 && s1 > v2) { v2 = s1; i2 = 1; }
        if (i1 != 2 && s2 > v2) { v2 = s2; i2 = 2; }
        if (i1 != 3 && s3 > v2) { v2 = s3; i2 = 3; }
        if (i1 != 4 && s4 > v2) { v2 = s4; i2 = 4; }
        if (i1 != 5 && s5 > v2) { v2 = s5; i2 = 5; }
        if (i1 != 6 && s6 > v2) { v2 = s6; i2 = 6; }
        if (i1 != 7 && s7 > v2) { v2 = s7; i2 = 7; }
        const float e2 = __expf(v2 - v1), g1 = pgrp / (1.f + e2), g2v = pgrp * e2 / (1.f + e2);
        if (lane == 0) {
            const int ea = grp * 8 + i1, eb = grp * 8 + i2;
            const int pa = atomicAdd(&cnt[ea], 1), pb = atomicAdd(&cnt[eb], 1);
            list[ea * LCAP + pa] = t * 2; list[eb * LCAP + pb] = t * 2 + 1;
            gate[t * 2] = g1; gate[t * 2 + 1] = g2v;
        }
    }
}

DI void moe_tiles(const int* cnt, int* tstart  ) {
    if (threadIdx.x == 0) { int acc = 0; for (int e = 0; e < NE; ++e) { tstart[e] = acc; acc += (cnt[e] + 127) >> 7; } tstart[NE] = acc; }
    __syncthreads();
}
struct EpiHid { bf16_t* o; DI void operator()(int r, int c, const f32x4& g, const f32x4& u) const {
    float h[4];
#pragma unroll
    for (int j = 0; j < 4; ++j) h[j] = g[j] * sigmoidf_(g[j]) * u[j];
    u32x2 pk = {pack2(h[0], h[1]), pack2(h[2], h[3])}; *(u32x2*)(o + (size_t)r * DE + c) = pk; } };
DI void phase_g3(const Params& p, int bid, int nblk, char* lds) {
    int* tstart = (int*)(lds + GEMM_LDS);
    const int* cnt = (const int*)(p.ws + OFF_CNT); const int* list = (const int*)(p.ws + OFF_LIST);
    const bf16_t* h2 = (const bf16_t*)(p.ws + OFF_H2); bf16_t* hid = (bf16_t*)(p.ws + OFF_HID);
    moe_tiles(cnt, tstart);
    const int ntiles = tstart[NE];
    for (int item = bid; item < ntiles * 4; item += nblk) {
        const int ti = item >> 2, cj = item & 3;
        int e = 0; while (e < NE - 1 && tstart[e + 1] <= ti) ++e;
        const int lt = ti - tstart[e], ne = cnt[e];
        GatherA al;
#pragma unroll
        for (int i = 0; i < 2; ++i) { const int row = (threadIdx.x + 256 * i) >> 2, pos = lt * 128 + row; const int tok = pos < ne ? (list[e * LCAP + pos] >> 1) : 0; al.rp[i] = h2 + (size_t)tok * D; }
        EpiHid epi{hid + (size_t)ti * 128 * DE + cj * 128};
        gemm128<2>(al, p.w_gate + (size_t)e * D * DE + cj * 128, p.w_up + (size_t)e * D * DE + cj * 128, DE, D, lds, epi);
    }
}
struct EpiDown { bf16_t* ybuf; const int* lst; const float* gate; int nvalid; int col0;
    DI void operator()(int r, int c, const f32x4& v, const f32x4&) const {
        if (r >= nvalid) return; const int slot = lst[r]; const float g = gate[slot];
        u32x2 pk = {pack2(v[0] * g, v[1] * g), pack2(v[2] * g, v[3] * g)}; *(u32x2*)(ybuf + (size_t)slot * D + col0 + c) = pk; } };
DI void phase_g4(const Params& p, int bid, int nblk, char* lds) {
    int* tstart = (int*)(lds + GEMM_LDS);
    const int* cnt = (const int*)(p.ws + OFF_CNT); const int* list = (const int*)(p.ws + OFF_LIST);
    const bf16_t* hid = (const bf16_t*)(p.ws + OFF_HID);
    moe_tiles(cnt, tstart);
    const int ntiles = tstart[NE];
    for (int item = bid; item < ntiles * 8; item += nblk) {
        const int ti = item >> 3, cj = item & 7;
        int e = 0; while (e < NE - 1 && tstart[e + 1] <= ti) ++e;
        const int lt = ti - tstart[e], ne = cnt[e];
        PlainA al{hid + (size_t)ti * 128 * DE, DE};
        EpiDown epi{(bf16_t*)(p.ws + OFF_YBUF), list + e * LCAP + lt * 128, (const float*)(p.ws + OFF_GATE), ne - lt * 128, cj * 128};
        gemm128<1>(al, p.w_down + (size_t)e * DE * D + cj * 128, nullptr, D, DE, lds, epi);
    }
}

DI void phase_final(const Params& p, int bid, int nblk) {
    const int lane = threadIdx.x & 63, wid = threadIdx.x >> 6;
    const float* x2 = (const float*)(p.ws + OFF_X2); const float* gt = (const float*)(p.ws + OFF_MODX) + 5120; const bf16_t* yb = (const bf16_t*)(p.ws + OFF_YBUF);
    for (int t = bid * 4 + wid; t < S; t += nblk * 4) {
        f32x4 v[4]; float ss = 0.f;
#pragma unroll
        for (int i = 0; i < 4; ++i) {
            const int d = (i * 64 + lane) * 4;
            v[i] = *(const f32x4*)(x2 + (size_t)t * D + d);
            const u32x2 a = *(const u32x2*)(yb + (size_t)(2 * t) * D + d), b = *(const u32x2*)(yb + (size_t)(2 * t + 1) * D + d);
            const f32x4 g = *(const f32x4*)(gt + d);
            v[i][0] += g[0] * (bflo(a.x) + bflo(b.x)); v[i][1] += g[1] * (bfhi(a.x) + bfhi(b.x));
            v[i][2] += g[2] * (bflo(a.y) + bflo(b.y)); v[i][3] += g[3] * (bfhi(a.y) + bfhi(b.y));
            ss += v[i][0] * v[i][0] + v[i][1] * v[i][1] + v[i][2] * v[i][2] + v[i][3] * v[i][3];
        }
        ss = wave_sum(ss);
        const float rstd = rsqrtf(ss * (1.f / 1024.f) + 1e-6f);
#pragma unroll
        for (int i = 0; i < 4; ++i) {
            const int d = (i * 64 + lane) * 4; const f32x4 fg = *(const f32x4*)(p.final_g + d); f32x4 o;
#pragma unroll
            for (int j = 0; j < 4; ++j) o[j] = v[i][j] * rstd * fg[j];
            *(f32x4*)(p.out + (size_t)t * D + d) = o;
        }
    }
}

#define XB_TMO      128
#define XB_XCNT(j)  (256  + 64 * (j))
#define XB_XSUB(j)  (1280 + 64 * (j))
#define XB_XGEN(j)  (2304 + 64 * (j))
#define XB_TOP      3328
#define XB_TOPGEN   3392
#define XCD_BAR_WORDS 3456
#define XB_SPIN_CAP (1u << 18)
DI unsigned xb_ld(unsigned* p) { return __hip_atomic_load(p, __ATOMIC_RELAXED, __HIP_MEMORY_SCOPE_AGENT); }
DI unsigned xb_add(unsigned* p, unsigned v) { return __hip_atomic_fetch_add(p, v, __ATOMIC_RELAXED, __HIP_MEMORY_SCOPE_AGENT); }
DI unsigned xb_xcc_id() { return (unsigned)__builtin_amdgcn_s_getreg((3 << 11) | 20) & 0xFu; }
#define XB_SPIN(cond, bar) do { unsigned _sp = 0; while (cond) { __builtin_amdgcn_s_sleep(1); \
    if ((++_sp & 255u) == 0u) { if (xb_ld(&(bar)[XB_TMO])) break; if (_sp > XB_SPIN_CAP) { atomicAdd(&(bar)[XB_TMO], 1u); break; } } } } while (0)
struct XcdBarrier { unsigned* bar; unsigned x; volatile LAS unsigned* st; };
DI XcdBarrier xcd_barrier_post(unsigned* bar, volatile LAS unsigned* st) {
    XcdBarrier b; b.bar = bar; b.x = xb_xcc_id(); b.st = st;
    if (threadIdx.x == 0) (void)xb_add(&bar[XB_XCNT(b.x)], 1u);
    return b;
}
DI void xcd_barrier_complete(unsigned* bar, unsigned x, unsigned& nloc, unsigned& nx) {
    const unsigned G = gridDim.x * gridDim.y * gridDim.z;
    unsigned sum, cnt, mine, sp = 0u;
    for (;;) {
        sum = 0u; cnt = 0u; mine = 0u;
#pragma unroll
        for (unsigned j = 0; j < 16; ++j) { const unsigned c = xb_ld(&bar[XB_XCNT(j)]); sum += c; cnt += (c > 0u) ? 1u : 0u; mine = (j == x) ? c : mine; }
        if (sum == G) break;
        __builtin_amdgcn_s_sleep(1);
        if ((++sp & 255u) == 0u) { if (xb_ld(&bar[XB_TMO])) break; if (sp > XB_SPIN_CAP) { atomicAdd(&bar[XB_TMO], 1u); break; } }
    }
    nloc = mine > 0u ? mine : 1u; nx = cnt > 0u ? cnt : 1u;
}
DI void xcd_barrier(const XcdBarrier& b) {
    asm volatile("s_waitcnt vmcnt(0)" ::: "memory");
    __syncthreads();
    if (threadIdx.x == 0) {
        unsigned* bar = b.bar;
        __builtin_amdgcn_s_waitcnt(0);
        unsigned nloc = b.st[0], nx = b.st[1];
        if (nloc == 0u) { xcd_barrier_complete(bar, b.x, nloc, nx); b.st[0] = nloc; b.st[1] = nx; }
        const unsigned old = xb_add(&bar[XB_XSUB(b.x)], 1u);
        const unsigned gen = old / nloc;
        if (old + 1u == (gen + 1u) * nloc) {
            __builtin_amdgcn_fence(__ATOMIC_RELEASE, "agent");
            asm volatile("s_waitcnt vmcnt(0)" ::: "memory");
            const unsigned og = xb_add(&bar[XB_TOP], 1u);
            const unsigned tg = og / nx;
            if (og + 1u == (tg + 1u) * nx) xb_add(&bar[XB_TOPGEN], 1u);
            else XB_SPIN(xb_ld(&bar[XB_TOPGEN]) == tg, bar);
            __builtin_amdgcn_fence(__ATOMIC_ACQUIRE, "agent");
            xb_add(&bar[XB_XGEN(b.x)], 1u);
            asm volatile("s_waitcnt vmcnt(0)" ::: "memory");
        } else {
            XB_SPIN(xb_ld(&bar[XB_XGEN(b.x)]) == gen, bar);
            __builtin_amdgcn_fence(__ATOMIC_ACQUIRE, "agent");
            asm volatile("s_waitcnt vmcnt(0)" ::: "memory");
        }
    }
    __syncthreads();
}

constexpr int MEGA_LDS = SCANA_LDS > (GEMM_LDS + 256) ? SCANA_LDS : (GEMM_LDS + 256);
__global__ void __launch_bounds__(256) k_mega(Params p) {
    extern __shared__ __attribute__((aligned(16))) char lds[];
    const int bid = blockIdx.x, nblk = gridDim.x;
    volatile LAS unsigned* st = (volatile LAS unsigned*)(lds + MEGA_LDS);
    if (threadIdx.x < 4) st[threadIdx.x] = 0u;
    __syncthreads();
    const XcdBarrier gb = xcd_barrier_post((unsigned*)(p.ws + OFF_BAR), st);
#define GSYNC() xcd_barrier(gb)
    phase_p0(p, bid, nblk, lds); GSYNC();
    phase_xn(p, bid, nblk); GSYNC();
    phase_g1(p, bid, nblk, lds); GSYNC();
    phase_pool(p, bid, nblk);
    phase_scanA(p, bid, nblk, lds); GSYNC();
    if (bid < 16) phase_chain(p, bid); else phase_poolgemm(p, bid - 16, nblk - 16, lds);
    GSYNC();
    phase_scanC(p, bid, nblk); GSYNC();
    phase_g2(p, bid, nblk, lds); GSYNC();
    phase_router(p, bid, nblk); GSYNC();
    phase_g3(p, bid, nblk, lds); GSYNC();
    phase_g4(p, bid, nblk, lds); GSYNC();
    phase_final(p, bid, nblk);
}

extern "C" void kernel_launch(void* const* d_in, const int* in_sizes, int n_in, void* d_out, int out_size, void* d_ws, size_t ws_size, hipStream_t stream) {
    if (ws_size < WS_NEED) { fprintf(stderr, "workspace too small: %zu < %zu\n", ws_size, (size_t)WS_NEED); return; }
    Params p{};
    const float** f = (const float**)&p;
    for (int i = 0; i < 36; ++i) f[i] = (const float*)d_in[i];
    p.out = (float*)d_out; p.ws = (char*)d_ws;
    static int grid_blocks = 0;
    if (!grid_blocks) {
        (void)hipFuncSetAttribute((const void*)k_mega, hipFuncAttributeMaxDynamicSharedMemorySize, MEGA_LDS + 16);
        int dev = 0, cus = 0, per_cu = 0;
        (void)hipGetDevice(&dev);
        (void)hipDeviceGetAttribute(&cus, hipDeviceAttributeMultiprocessorCount, dev);
        (void)hipOccupancyMaxActiveBlocksPerMultiprocessor(&per_cu, k_mega, 256, MEGA_LDS + 16);
        if (per_cu > 1) per_cu = 1;
        grid_blocks = cus * per_cu;
    }
    (void)hipMemsetAsync((char*)d_ws + OFF_BAR, 0, 16384, stream);
    void* args[] = {&p};
    hipError_t e = hipLaunchCooperativeKernel((const void*)k_mega, dim3(grid_blocks), dim3(256), args, MEGA_LDS + 16, stream);
    if (e != hipSuccess) fprintf(stderr, "cooperative launch failed: %s (grid %d)\n", hipGetErrorString(e), grid_blocks);
}
```

```cpp
#include <hip/hip_runtime.h>
#include <stdint.h>
#include <stdio.h>
#include <hip/hip_cooperative_groups.h>
namespace cg = cooperative_groups;

#define DI __device__ __forceinline__
typedef unsigned short bf16_t;
typedef short bf16x8 __attribute__((ext_vector_type(8)));
typedef short s16x4 __attribute__((ext_vector_type(4)));
typedef float f32x4 __attribute__((ext_vector_type(4)));
typedef float f32x2 __attribute__((ext_vector_type(2)));
typedef __bf16 bf16x2_t __attribute__((ext_vector_type(2)));
typedef unsigned u32x4 __attribute__((ext_vector_type(4)));
typedef unsigned u32x2 __attribute__((ext_vector_type(2)));
#define LAS __attribute__((address_space(3)))

constexpr int D = 1024, S = 16384, CTX = 256, NT = S + CTX, DIN = 2432, DSH = 1920, DR = 512;
constexpr int C_WLF = 1536, C_WLB = 1600, C_ALF = 1664, C_ALB = 1728, C_GL = 1792, C_POOL = 1920;
constexpr int NE = 32, DE = 512, LCAP = 32768;
constexpr float DECAY_SCALE = 0.6065306597f;

constexpr int NCH = NT / 64;
constexpr size_t SZ_U = (size_t)NT * DIN * 2;
constexpr size_t SZ_CH = (size_t)16 * NCH * 8192;
constexpr size_t OFF_U = 0;
constexpr size_t OFF_XN = OFF_U + SZ_U;
constexpr size_t OFF_P = OFF_XN;
constexpr size_t OFF_Q = OFF_P + SZ_CH;
constexpr size_t OFF_WYT = OFF_Q + SZ_CH;
constexpr size_t OFF_YL = OFF_WYT + (size_t)256 * 16 * 8192;
constexpr size_t OFF_V = OFF_YL + (size_t)256 * 16 * 8192;
constexpr size_t OFF_G = OFF_V + (size_t)S * DR * 2;
constexpr size_t OFF_MIX = OFF_G + (size_t)S * DR * 2;
constexpr size_t OFF_SMALL = OFF_MIX + (size_t)S * D * 2;
constexpr size_t OFF_MODX = OFF_SMALL, OFF_MODC = OFF_MODX + 6144 * 4;
constexpr size_t OFF_ROWTAB = OFF_MODC + 6144 * 4, OFF_COLTAB = OFF_ROWTAB + 256 * 512 * 4;
constexpr size_t OFF_CNT = OFF_COLTAB + 64 * 512 * 4;
constexpr size_t OFF_GATE = OFF_CNT + 256;
constexpr size_t OFF_LIST = OFF_GATE + (size_t)S * 2 * 4;
constexpr size_t OFF_DOT = OFF_LIST + (size_t)NE * LCAP * 4;
constexpr size_t OFF_WP = OFF_DOT + (size_t)NT * 16 * 4;
constexpr size_t OFF_B2 = OFF_WP + 64 * 4 * 3 * 64 * 4;
constexpr size_t OFF_BAR = OFF_B2 + 256;
constexpr size_t WS_NEED = OFF_BAR + 16384;
constexpr size_t OFF_Z = OFF_U;
constexpr size_t OFF_X2 = OFF_P;
constexpr size_t OFF_YBUF = OFF_WYT;
constexpr size_t OFF_H2 = OFF_U;
constexpr size_t OFF_HID = OFF_U + SZ_CH;

struct Params {
    const float *x, *c, *ctx, *c_ctx, *norm1_g, *w_mod, *b_mod, *w_in, *mu, *w0_f, *w2_f, *w0_b, *w2_b, *a0_f, *a2_f, *a0_b, *a2_b,
        *g2, *k_k, *k_a, *r_k_f, *r_k_b, *gn_w, *gn_b, *w_pool, *pool_scale, *w_out, *norm2_g, *w_rg, *b_rg, *w_re, *b_re,
        *w_gate, *w_up, *w_down, *final_g;
    float* out;
    char* ws;
};

DI unsigned pack2(float lo, float hi) { f32x2 v = {lo, hi}; bf16x2_t b = __builtin_convertvector(v, bf16x2_t); return __builtin_bit_cast(unsigned, b); }
DI float bf2f(bf16_t h) { return __uint_as_float(((unsigned)h) << 16); }
DI float bflo(unsigned u) { return __uint_as_float(u << 16); }
DI float bfhi(unsigned u) { return __uint_as_float(u & 0xffff0000u); }
DI void unpack8(const u32x4& p, float* f) { f[0] = bflo(p.x); f[1] = bfhi(p.x); f[2] = bflo(p.y); f[3] = bfhi(p.y); f[4] = bflo(p.z); f[5] = bfhi(p.z); f[6] = bflo(p.w); f[7] = bfhi(p.w); }
DI u32x4 pack8(const float* f) { u32x4 p; p.x = pack2(f[0], f[1]); p.y = pack2(f[2], f[3]); p.z = pack2(f[4], f[5]); p.w = pack2(f[6], f[7]); return p; }
DI float sigmoidf_(float x) { return 1.f / (1.f + __expf(-x)); }
DI float wave_sum(float v) {
#pragma unroll
    for (int o = 32; o > 0; o >>= 1) v += __shfl_xor(v, o, 64);
    return v;
}
DI f32x4 wave_sum4(f32x4 v) {
#pragma unroll
    for (int o = 32; o > 0; o >>= 1) { v[0] += __shfl_xor(v[0], o, 64); v[1] += __shfl_xor(v[1], o, 64); v[2] += __shfl_xor(v[2], o, 64); v[3] += __shfl_xor(v[3], o, 64); }
    return v;
}
typedef float f32x16 __attribute__((ext_vector_type(16)));
DI f32x16 zero16() { f32x16 z; for (int i = 0; i < 16; ++i) z[i] = 0.f; return z; }
DI s16x4 tr16(const bf16_t* a) { return __builtin_amdgcn_ds_read_tr16_b64_v4i16((LAS s16x4*)a); }
DI float pos_val(const float* rowtab, const float* coltab, int t, int d) { return d < 512 ? rowtab[(t >> 6) * 512 + d] : coltab[(t & 63) * 512 + (d - 512)]; }

DI void phase_p0(const Params& p, int bid, int nblk, char* lds) {
    const int tid = threadIdx.x;
    float* modx = (float*)(p.ws + OFF_MODX); float* modc = (float*)(p.ws + OFF_MODC);
    float* red = (float*)lds;
    for (int item = bid; item < 96; item += nblk) {
        const int col0 = item * 64, cg = tid & 15, kg = tid >> 4;
        f32x4 ax = {0, 0, 0, 0}, ac = {0, 0, 0, 0};
        for (int kk = 0; kk < 64; ++kk) {
            const int k = kg * 64 + kk;
            const float cv = p.c[k], cc = p.c_ctx[k];
            const float sx = cv * sigmoidf_(cv), sc = cc * sigmoidf_(cc);
            const f32x4 w = *(const f32x4*)(p.w_mod + (size_t)k * 6144 + col0 + cg * 4);
            ax += w * sx; ac += w * sc;
        }
        __syncthreads();
#pragma unroll
        for (int j = 0; j < 4; ++j) { red[(kg * 64 + cg * 4 + j) * 2] = ax[j]; red[(kg * 64 + cg * 4 + j) * 2 + 1] = ac[j]; }
        __syncthreads();
        if (tid < 128) {
            const int col = tid & 63, which = tid >> 6;
            float s = 0.f;
            for (int g = 0; g < 16; ++g) s += red[(g * 64 + col) * 2 + which];
            s += p.b_mod[col0 + col];
            (which ? modc : modx)[col0 + col] = s;
        }
    }
    float* rowtab = (float*)(p.ws + OFF_ROWTAB); float* coltab = (float*)(p.ws + OFF_COLTAB);
    for (int i = bid * 256 + tid; i < (256 + 64) * 256; i += nblk * 256) {
        const int pos = i >> 8, f = i & 255;
        const float freq = powf(10000.f, -(float)f / 256.f);
        if (pos < 256) { const float a = (float)pos * freq; rowtab[pos * 512 + f] = sinf(a); rowtab[pos * 512 + 256 + f] = cosf(a); }
        else { const int cp = pos - 256; const float a = (float)cp * freq; coltab[cp * 512 + f] = sinf(a); coltab[cp * 512 + 256 + f] = cosf(a); }
    }
    if (bid == 0 && tid < 64) ((int*)(p.ws + OFF_CNT))[tid] = 0;
}

DI void phase_xn(const Params& p, int bid, int nblk) {
    const int lane = threadIdx.x & 63, wid = threadIdx.x >> 6;
    const float* modx = (const float*)(p.ws + OFF_MODX); const float* modc = (const float*)(p.ws + OFF_MODC);
    const float* rowtab = (const float*)(p.ws + OFF_ROWTAB); const float* coltab = (const float*)(p.ws + OFF_COLTAB);
    bf16_t* xn = (bf16_t*)(p.ws + OFF_XN);
    for (int g = bid * 4 + wid; g < NT; g += nblk * 4) {
        const bool isctx = g < CTX; const int t = g - CTX;
        const float* src = isctx ? p.ctx + (size_t)g * D : p.x + (size_t)t * D;
        const float* md = isctx ? modc : modx;
        f32x4 v[4]; float ss = 0.f;
#pragma unroll
        for (int i = 0; i < 4; ++i) {
            const int d = (i * 64 + lane) * 4;
            v[i] = *(const f32x4*)(src + d);
            if (!isctx) {
#pragma unroll
                for (int j = 0; j < 4; ++j) v[i][j] += pos_val(rowtab, coltab, t, d + j);
            }
            ss += v[i][0] * v[i][0] + v[i][1] * v[i][1] + v[i][2] * v[i][2] + v[i][3] * v[i][3];
        }
        ss = wave_sum(ss);
        const float rstd = rsqrtf(ss * (1.f / 1024.f) + 1e-6f);
#pragma unroll
        for (int i = 0; i < 4; ++i) {
            const int d = (i * 64 + lane) * 4;
            const f32x4 gg = *(const f32x4*)(p.norm1_g + d), sh = *(const f32x4*)(md + d), sc = *(const f32x4*)(md + 1024 + d);
            f32x4 o;
#pragma unroll
            for (int j = 0; j < 4; ++j) o[j] = (v[i][j] * rstd * gg[j]) * (1.f + sc[j]) + sh[j];
            u32x2 pk = {pack2(o[0], o[1]), pack2(o[2], o[3])};
            *(u32x2*)(xn + (size_t)g * D + d) = pk;
        }
    }
}

constexpr int GA_SZ = 256 * 72 * 2, GB_SZ = 64 * 136 * 2, GBUF_SZ = GA_SZ + GB_SZ;
constexpr int GB2_SZ = 64 * 72 * 2;
constexpr int GBUF2_SZ = GA_SZ + 2 * GB2_SZ;
constexpr int GEMM_LDS = 2 * (GBUF_SZ > GBUF2_SZ ? GBUF_SZ : GBUF2_SZ);
template <int NB, class AL, class EPI, int MODE = 0>
DI void gemm256(AL& al, const float* __restrict__ B0, const float* __restrict__ B1, int ldb, int K, char* lds, EPI& epi) {
    constexpr int NT = NB == 1 ? 4 : 2;
    constexpr int BP = NB == 1 ? 136 : 72;
    constexpr int BUF = NB == 1 ? GBUF_SZ : GBUF2_SZ;
    const int tid = threadIdx.x, lane = tid & 63, wid = tid >> 6, wr = wid >> 1, wc = wid & 1, fr = lane & 15, fq = lane >> 4;
    f32x4 acc0[8][NT], acc1[8][NT];
#pragma unroll
    for (int m = 0; m < 8; ++m)
#pragma unroll
        for (int n = 0; n < NT; ++n) { acc0[m][n] = (f32x4){0, 0, 0, 0}; acc1[m][n] = (f32x4){0, 0, 0, 0}; }
    u32x4 ra[8]; f32x4 rb0[NB == 1 ? 8 : 4], rb1[4];
    const int T = K >> 6;
#define G_LOAD(t_) do { const int k0_ = (t_) * 64; \
        _Pragma("unroll") for (int i = 0; i < 8; ++i) { const int c = tid + 256 * i; ra[i] = al.load(i, c >> 3, k0_ + (c & 7) * 8); } \
        if (NB == 1) { _Pragma("unroll") for (int i = 0; i < 8; ++i) { const int c = tid + 256 * i, kr = c >> 5, n4 = c & 31; rb0[i] = *(const f32x4*)(B0 + (size_t)(k0_ + kr) * ldb + n4 * 4); } } \
        else { _Pragma("unroll") for (int i = 0; i < 4; ++i) { const int c = tid + 256 * i, kr = c >> 4, n4 = c & 15; rb0[i] = *(const f32x4*)(B0 + (size_t)(k0_ + kr) * ldb + n4 * 4); rb1[i] = *(const f32x4*)(B1 + (size_t)(k0_ + kr) * ldb + n4 * 4); } } } while (0)
#define G_WRITE(buf) do { bf16_t* sA_ = (bf16_t*)(lds + (buf) * BUF); bf16_t* sB0_ = (bf16_t*)(lds + (buf) * BUF + GA_SZ); bf16_t* sB1_ = sB0_ + 64 * 72; \
        _Pragma("unroll") for (int i = 0; i < 8; ++i) { const int c = tid + 256 * i; *(u32x4*)(sA_ + (c >> 3) * 72 + (c & 7) * 8) = ra[i]; } \
        if (NB == 1) { _Pragma("unroll") for (int i = 0; i < 8; ++i) { const int c = tid + 256 * i, kr = c >> 5, n4 = c & 31, slot = (n4 & 24) * 4 + (n4 & 1) * 16 + ((n4 >> 1) & 3) * 4; \
            u32x2 pk = {pack2(rb0[i][0], rb0[i][1]), pack2(rb0[i][2], rb0[i][3])}; *(u32x2*)(sB0_ + kr * BP + slot) = pk; } } \
        else { _Pragma("unroll") for (int i = 0; i < 4; ++i) { const int c = tid + 256 * i, kr = c >> 4, n4 = c & 15, slot = (n4 & 8) * 4 + (n4 & 1) * 16 + ((n4 >> 1) & 3) * 4; \
            u32x2 pk = {pack2(rb0[i][0], rb0[i][1]), pack2(rb0[i][2], rb0[i][3])}; *(u32x2*)(sB0_ + kr * BP + slot) = pk; \
            u32x2 pk1 = {pack2(rb1[i][0], rb1[i][1]), pack2(rb1[i][2], rb1[i][3])}; *(u32x2*)(sB1_ + kr * BP + slot) = pk1; } } } while (0)
#define G_MMA(buf, kh) do { const bf16_t* sA_ = (const bf16_t*)(lds + (buf) * BUF); const bf16_t* sB0_ = (const bf16_t*)(lds + (buf) * BUF + GA_SZ); const bf16_t* sB1_ = sB0_ + 64 * 72; \
        bf16x8 bf0[NT], bf1[NT]; \
        _Pragma("unroll") for (int n = 0; n < NT; ++n) { const int off = ((kh) * 32 + fq * 8 + (fr >> 2)) * BP + wc * (16 * NT) + n * 16 + 4 * (fr & 3); \
            s16x4 lo = tr16(sB0_ + off), hi = tr16(sB0_ + off + 4 * BP); bf0[n] = __builtin_shufflevector(lo, hi, 0, 1, 2, 3, 4, 5, 6, 7); \
            if (NB == 2) { s16x4 lo1 = tr16(sB1_ + off), hi1 = tr16(sB1_ + off + 4 * BP); bf1[n] = __builtin_shufflevector(lo1, hi1, 0, 1, 2, 3, 4, 5, 6, 7); } } \
        _Pragma("unroll") for (int m = 0; m < 8; ++m) { const bf16x8 af = *(const bf16x8*)(sA_ + (wr * 128 + m * 16 + fr) * 72 + (kh) * 32 + fq * 8); \
            _Pragma("unroll") for (int n = 0; n < NT; ++n) { \
            if (MODE == 2) { asm volatile("" :: "v"(bf0[n]), "v"(af)); } else { \
            acc0[m][n] = __builtin_amdgcn_mfma_f32_16x16x32_bf16(bf0[n], af, acc0[m][n], 0, 0, 0); \
            if (NB == 2) acc1[m][n] = __builtin_amdgcn_mfma_f32_16x16x32_bf16(bf1[n], af, acc1[m][n], 0, 0, 0); } } } } while (0)
    G_LOAD(0);
    G_WRITE(0);
#pragma unroll 1
    for (int t = 0; t < T; ++t) {
        const int buf = t & 1;
        __syncthreads();
        if (t + 1 < T) G_LOAD((MODE == 1 ? 0 : t + 1));
        __builtin_amdgcn_sched_barrier(0);
        G_MMA(buf, 0);
        __builtin_amdgcn_sched_barrier(0);
        G_MMA(buf, 1);
        __builtin_amdgcn_sched_barrier(0);
        if (t + 1 < T) G_WRITE(buf ^ 1);
    }
#undef G_LOAD
#undef G_WRITE
#undef G_MMA
#pragma unroll
    for (int m = 0; m < 8; ++m)
#pragma unroll
        for (int g = 0; g < NT / 2; ++g) epi(wr * 128 + m * 16 + fr, wc * (16 * NT) + g * 32 + 8 * fq, acc0[m][2 * g], acc0[m][2 * g + 1], acc1[m][2 * g], acc1[m][2 * g + 1]);
    __syncthreads();
}

struct PlainA {
    const bf16_t* base; int lda;
    DI u32x4 load(int, int row, int k) const { return *(const u32x4*)(base + (size_t)row * lda + k); }
};
struct GatherA {
    const bf16_t* rp[8];
    DI u32x4 load(int i, int, int k) const { return *(const u32x4*)(rp[i] + k); }
};

struct XcdOrder {
    int base, lim, j, bpx;
    DI XcdOrder(int bid, int nblk, int total) {
        if ((nblk & 7) == 0) { const int x = bid & 7, per = (total + 7) >> 3; bpx = nblk >> 3; j = bid >> 3; base = x * per; lim = base + per < total ? base + per : total; }
        else { bpx = nblk; j = bid; base = 0; lim = total; }
    }
    DI int item(int i) const { const int q = base + i * bpx + j; return q < lim ? q : -1; }
};
DI void tile_rc(int q, int nrow, int ncol, int& r, int& c) {
    const int per_sr = 8 * ncol, sr = q / per_sr, rem = q - sr * per_sr, rows = (nrow - sr * 8) < 8 ? (nrow - sr * 8) : 8;
    c = rem / rows; r = sr * 8 + rem - c * rows;
}

DI u32x4 pack8v(const f32x4& a, const f32x4& b) { return (u32x4){pack2(a[0], a[1]), pack2(a[2], a[3]), pack2(b[0], b[1]), pack2(b[2], b[3])}; }
struct EpiStoreBf16 { bf16_t* o; int ldo; DI void operator()(int r, int c, const f32x4& a, const f32x4& b, const f32x4&, const f32x4&) const { *(u32x4*)(o + (size_t)r * ldo + c) = pack8v(a, b); } };
struct EpiNull { DI void operator()(int, int, const f32x4& v, const f32x4& w, const f32x4&, const f32x4&) const { asm volatile("" :: "v"(v), "v"(w)); } };
template <int MODE> DI void phase_g1_probe(const Params& p, int bid, int nblk, char* lds) {
    const bf16_t* xn = (const bf16_t*)(p.ws + OFF_XN);
    const XcdOrder ord(bid, nblk, 65 * 19);
    for (int i = 0, q; (q = ord.item(i)) >= 0; ++i) {
        int tm, tn; tile_rc(q, 65, 19, tm, tn);
        PlainA al{xn + (size_t)tm * 256 * D, D};
        EpiNull epi;
        gemm256<1, PlainA, EpiNull, MODE>(al, p.w_in + tn * 128, nullptr, DIN, D, lds, epi);
    }
}
DI void phase_mfma_rate(const Params& p, int n_mfma) {
    f32x4 acc[32];
#pragma unroll
    for (int i = 0; i < 32; ++i) acc[i] = (f32x4){0, 0, 0, 0};
    bf16x8 a = __builtin_bit_cast(bf16x8, *(const u32x4*)(p.ws + OFF_XN + threadIdx.x * 16)), b = __builtin_bit_cast(bf16x8, *(const u32x4*)(p.ws + OFF_XN + 8192 + threadIdx.x * 16));
#pragma unroll 1
    for (int it = 0; it < n_mfma; it += 32) {
#pragma unroll
        for (int i = 0; i < 32; ++i) acc[i] = __builtin_amdgcn_mfma_f32_16x16x32_bf16(a, b, acc[i], 0, 0, 0);
    }
    f32x4 sacc = acc[0];
#pragma unroll
    for (int i = 1; i < 32; ++i) sacc += acc[i];
    asm volatile("" :: "v"(sacc));
}
DI void phase_mfma_rate32(const Params& p, int n_mfma) {
    f32x16 acc[8];
#pragma unroll
    for (int i = 0; i < 8; ++i) acc[i] = zero16();
    bf16x8 a = __builtin_bit_cast(bf16x8, *(const u32x4*)(p.ws + OFF_XN + threadIdx.x * 16)), b = __builtin_bit_cast(bf16x8, *(const u32x4*)(p.ws + OFF_XN + 8192 + threadIdx.x * 16));
#pragma unroll 1
    for (int it = 0; it < n_mfma; it += 8) {
#pragma unroll
        for (int i = 0; i < 8; ++i) acc[i] = __builtin_amdgcn_mfma_f32_32x32x16_bf16(a, b, acc[i], 0, 0, 0);
    }
    f32x16 sacc = acc[0];
#pragma unroll
    for (int i = 1; i < 8; ++i) sacc += acc[i];
    asm volatile("" :: "v"(sacc));
}
DI void phase_g1(const Params& p, int bid, int nblk, char* lds) {
    const bf16_t* xn = (const bf16_t*)(p.ws + OFF_XN); bf16_t* u = (bf16_t*)(p.ws + OFF_U);
    const XcdOrder ord(bid, nblk, 65 * 19);
    for (int i = 0, q; (q = ord.item(i)) >= 0; ++i) {
        int tm, tn; tile_rc(q, 65, 19, tm, tn);
        PlainA al{xn + (size_t)tm * 256 * D, D};
        EpiStoreBf16 epi{u + (size_t)tm * 256 * DIN + tn * 128, DIN};
        gemm256<1>(al, p.w_in + tn * 128, nullptr, DIN, D, lds, epi);
    }
}

DI void phase_pool(const Params& p, int bid, int nblk) {
    const int lane = threadIdx.x & 63, wid = threadIdx.x >> 6;
    const bf16_t* u = (const bf16_t*)(p.ws + OFF_U);
    bf16_t* mix = (bf16_t*)(p.ws + OFF_MIX);
    for (int t = bid * 4 + wid; t < S; t += nblk * 4) {
        const int gi = lane >> 4, win = 2 << gi;
        int lo = t - win / 2, hi = lo + win; lo = lo < 0 ? 0 : lo; hi = hi > S ? S : hi;
        float s[8], c[8];
        for (int j = 0; j < 8; ++j) s[j] = 0.f;
        for (int tt = lo; tt < hi; ++tt) {
            float q[8]; unpack8(*(const u32x4*)(u + (size_t)(tt + CTX) * DIN + C_POOL + lane * 8), q);
            for (int j = 0; j < 8; ++j) s[j] += q[j];
        }
        unpack8(*(const u32x4*)(u + (size_t)(t + CTX) * DIN + C_POOL + lane * 8), c);
        const float inv = 1.f / (float)(hi - lo);
        float o[8];
        for (int j = 0; j < 8; ++j) o[j] = s[j] * inv - c[j];
        *(u32x4*)(mix + (size_t)t * D + lane * 8) = pack8(o);
    }
}
struct EpiPool { bf16_t* o; const float* sc; DI void operator()(int r, int c, const f32x4& a, const f32x4& b, const f32x4&, const f32x4&) const {
    const f32x4 s0 = *(const f32x4*)(sc + c), s1 = *(const f32x4*)(sc + c + 4); *(u32x4*)(o + (size_t)r * D + c) = pack8v(a * s0, b * s1); } };
DI void phase_poolgemm(const Params& p, int bid, int nblk, char* lds) {
    if (nblk <= 0) return;
    for (int it = bid; it < 4 * 64; it += nblk) {
        const int gi = it >> 6, tm = it & 63;
        const bf16_t* mix = (const bf16_t*)(p.ws + OFF_MIX);
        PlainA al{mix + (size_t)tm * 256 * D + gi * 128, D};
        EpiPool e{(bf16_t*)(p.ws + OFF_MIX) + (size_t)tm * 256 * D + 512 + gi * 128, p.pool_scale + gi * 128};
        int kk = 128; asm volatile("" : "+s"(kk));
        gemm256<1>(al, p.w_pool + (size_t)gi * 128 * 128, nullptr, 128, kk, lds, e);
    }
}

constexpr int MP = 72, MSZ = 64 * MP;
constexpr int FP = 68;
constexpr int SCANA_LDS = 14 * MSZ * 2 + 2048;
template <bool KS> DI bf16x8 frag32(const bf16_t* base, int x0, int s, int lane) {
    if (!KS) return *(const bf16x8*)(base + (x0 + (lane & 31)) * MP + 16 * s + 8 * (lane >> 5));
    const int gi = lane >> 4, i = lane & 15;
    const bf16_t* a = base + (16 * s + 8 * (gi >> 1) + (i >> 2)) * MP + x0 + 16 * (gi & 1) + 4 * (i & 3);
    s16x4 lo = tr16(a), hi = tr16(a + 4 * MP);
    return __builtin_shufflevector(lo, hi, 0, 1, 2, 3, 4, 5, 6, 7);
}
template <bool XKS, bool YKS> DI f32x16 mm32(const bf16_t* X, int x0, const bf16_t* Y, int y0, f32x16 acc, int lane) {
#pragma unroll
    for (int s = 0; s < 4; ++s) acc = __builtin_amdgcn_mfma_f32_32x32x16_bf16(frag32<XKS>(X, x0, s, lane), frag32<YKS>(Y, y0, s, lane), acc, 0, 0, 0);
    return acc;
}
template <class F> DI void store_acc(bf16_t* out, int x0, int y0, const f32x16& acc, int lane, F f) {
    const int y = y0 + (lane & 31), hh = lane >> 5;
#pragma unroll
    for (int q = 0; q < 4; ++q) {
        const int x = x0 + 8 * q + 4 * hh;
        u32x2 pk = {pack2(f(acc[4 * q], x, y), f(acc[4 * q + 1], x + 1, y)), pack2(f(acc[4 * q + 2], x + 2, y), f(acc[4 * q + 3], x + 3, y))};
        *(u32x2*)(out + y * MP + x) = pk;
    }
}
DI unsigned rot16(unsigned x) { return (x >> 16) | (x << 16); }

DI int chain_pos(int c, int dir) { return dir == 0 ? c : (c < 4 ? 3 - c : NCH + 3 - c); }

template <int STOP = 0> DI void phase_scanA(const Params& p, int bid, int nblk, char* lds) {
    const int tid = threadIdx.x, lane = tid & 63, w = tid >> 6, xq = 32 * (w & 1), yq = 32 * (w >> 1);
    bf16_t* M = (bf16_t*)lds;
    bf16_t *sAT = M, *sBT = M + MSZ, *sKT = M + 2 * MSZ, *sRT = M + 3 * MSZ, *sVT = M + 4 * MSZ;
    float* fGC = (float*)(lds + 14 * MSZ * 2);
    float* fSeg = fGC + 64;
    float* fLogw = (float*)(M + 12 * MSZ);
    float* fA = (float*)(M + 10 * MSZ);
    const bf16_t* u = (const bf16_t*)(p.ws + OFF_U);
    for (int inst = bid; inst < NCH * 16; inst += nblk) {
        const int c = inst >> 4, h = (inst >> 1) & 7, dir = inst & 1;
        const bool latent = c >= 4, want_g = latent && dir == 0;
        const float* w2 = dir ? p.w2_b : p.w2_f; const float* a2 = dir ? p.a2_b : p.a2_f;
        const float* w0 = dir ? p.w0_b : p.w0_f; const float* a0 = dir ? p.a0_b : p.a0_f;
        const float* rkd = dir ? p.r_k_b : p.r_k_f;
        const int cwl = dir ? C_WLB : C_WLF, cal = dir ? C_ALB : C_ALF;
        const int ch = tid & 7;
        float fr_[2][8], fk_[2][8], fv_[2][8];
        const int cols5[5] = {h * 64 + ch * 8, 512 + h * 64 + ch * 8, 1024 + h * 64 + ch * 8, cwl + ch * 8, cal + ch * 8};
        auto shift8 = [&](const u32x4* r3, int col, float mp, float mn, float* o) {
            float cc[8], pv[8], nx[8];
            unpack8(r3[0], cc); unpack8(r3[1], pv); unpack8(r3[2], nx);
            const f32x4 m0 = *(const f32x4*)(p.mu + col), m1 = *(const f32x4*)(p.mu + col + 4);
#pragma unroll
            for (int j = 0; j < 8; ++j) { const float m = j < 4 ? m0[j & 3] : m1[j & 3]; o[j] = cc[j] + m * ((mp * pv[j] + mn * nx[j]) - cc[j]); }
        };
#pragma unroll
        for (int i = 0; i < 2; ++i) {
            const int tau = (tid >> 3) + 32 * i, g = dir ? c * 64 + 63 - tau : c * 64 + tau;
            const bool hasp = (g != 0) && (g != CTX), hasn = (g != CTX - 1) && (g != NT - 1);
            const float mp = hasp ? 0.5f : 0.f, mn = hasn ? 0.5f : 0.f;
            const bf16_t* rc = u + (size_t)g * DIN; const bf16_t* rp = hasp ? rc - DIN : rc; const bf16_t* rn = hasn ? rc + DIN : rc;
            u32x4 raw[5][3], rawg[2][3]; f32x4 wl[8];
#pragma unroll
            for (int q = 0; q < 5; ++q) { raw[q][0] = *(const u32x4*)(rc + cols5[q]); raw[q][1] = *(const u32x4*)(rp + cols5[q]); raw[q][2] = *(const u32x4*)(rn + cols5[q]); }
            if (want_g) {
#pragma unroll
                for (int half = 0; half < 2; ++half) { const int col = C_GL + half * 64 + ch * 8;
                    rawg[half][0] = *(const u32x4*)(rc + col); rawg[half][1] = *(const u32x4*)(rp + col); rawg[half][2] = *(const u32x4*)(rn + col); }
            }
            if (i == 0) {
#pragma unroll
                for (int q = 0; q < 4; ++q) { const int idx = tid + 256 * q, kr = idx >> 4, n4 = idx & 15;
                    wl[q] = *(const f32x4*)(w2 + (size_t)kr * DR + h * 64 + n4 * 4); wl[4 + q] = *(const f32x4*)(a2 + (size_t)kr * DR + h * 64 + n4 * 4); }
            } else if (want_g) {
#pragma unroll
                for (int q = 0; q < 8; ++q) { const int idx = tid + 256 * q, kr = idx >> 4, n4 = idx & 15; wl[q] = *(const f32x4*)(p.g2 + (size_t)kr * DR + h * 64 + n4 * 4); }
            }
            shift8(raw[0], cols5[0], mp, mn, fr_[i]); shift8(raw[1], cols5[1], mp, mn, fk_[i]); shift8(raw[2], cols5[2], mp, mn, fv_[i]);
            float t8[8];
            shift8(raw[3], cols5[3], mp, mn, t8);
#pragma unroll
            for (int j = 0; j < 8; ++j) { const float e2 = __expf(2.f * t8[j]); t8[j] = 1.f - __fdividef(2.f, e2 + 1.f); }
            *(u32x4*)(M + 5 * MSZ + tau * MP + ch * 8) = pack8(t8);
            shift8(raw[4], cols5[4], mp, mn, t8);
            *(u32x4*)(M + 6 * MSZ + tau * MP + ch * 8) = pack8(t8);
            if (want_g) {
#pragma unroll
                for (int half = 0; half < 2; ++half) {
                    shift8(rawg[half], C_GL + half * 64 + ch * 8, mp, mn, t8);
#pragma unroll
                    for (int j = 0; j < 8; ++j) t8[j] = sigmoidf_(t8[j]);
                    *(u32x4*)(M + half * MSZ + tau * MP + ch * 8) = pack8(t8);
                }
            }
            if (i == 0) {
#pragma unroll
                for (int q = 0; q < 4; ++q) { const int idx = tid + 256 * q, kr = idx >> 4, n4 = idx & 15;
                    u32x2 pa = {pack2(wl[q][0], wl[q][1]), pack2(wl[q][2], wl[q][3])}, pb = {pack2(wl[4 + q][0], wl[4 + q][1]), pack2(wl[4 + q][2], wl[4 + q][3])};
                    *(u32x2*)(M + 7 * MSZ + kr * MP + n4 * 4) = pa; *(u32x2*)(M + 8 * MSZ + kr * MP + n4 * 4) = pb; }
            } else if (want_g) {
#pragma unroll
                for (int q = 0; q < 8; ++q) { const int idx = tid + 256 * q, kr = idx >> 4, n4 = idx & 15;
                    u32x2 pa = {pack2(wl[q][0], wl[q][1]), pack2(wl[q][2], wl[q][3])};
                    *(u32x2*)(M + (2 + (kr >> 6)) * MSZ + (kr & 63) * MP + n4 * 4) = pa; }
            }
        }
        __syncthreads();
        {
            f32x16 accW = mm32<true, false>(M + 7 * MSZ, xq, M + 5 * MSZ, yq, zero16(), lane);
            f32x16 accA = mm32<true, false>(M + 8 * MSZ, xq, M + 6 * MSZ, yq, zero16(), lane);
            const int y = yq + (lane & 31), hh = lane >> 5;
#pragma unroll
            for (int q = 0; q < 4; ++q) {
                const int x = xq + 8 * q + 4 * hh;
                f32x4 lw, av; const f32x4 w0v = *(const f32x4*)(w0 + h * 64 + x), a0v = *(const f32x4*)(a0 + h * 64 + x);
#pragma unroll
                for (int e = 0; e < 4; ++e) { lw[e] = -DECAY_SCALE * sigmoidf_(w0v[e] + accW[4 * q + e]); av[e] = sigmoidf_(a0v[e] + accA[4 * q + e]); }
                *(f32x4*)(fLogw + y * FP + x) = lw; *(f32x4*)(fA + y * FP + x) = av;
            }
        }
        if (want_g) {
            f32x16 accG = mm32<true, false>(M + 2 * MSZ, xq, M, yq, zero16(), lane);
            accG = mm32<true, false>(M + 3 * MSZ, xq, M + MSZ, yq, accG, lane);
            const int y = yq + (lane & 31), hh = lane >> 5, t = c * 64 + y - CTX;
#pragma unroll
            for (int q = 0; q < 4; ++q) {
                const int x = xq + 8 * q + 4 * hh;
                u32x2 pk = {pack2(accG[4 * q], accG[4 * q + 1]), pack2(accG[4 * q + 2], accG[4 * q + 3])};
                *(u32x2*)((bf16_t*)(p.ws + OFF_G) + (size_t)t * DR + h * 64 + x) = pk;
            }
        }
        __syncthreads();
        {
            const int n = tid & 63, qq = tid >> 6; float run = 0.f;
            for (int t = 16 * qq; t < 16 * qq + 16; ++t) { run += fLogw[t * FP + n]; fLogw[t * FP + n] = run; }
            fSeg[qq * 64 + n] = run;
        }
        __syncthreads();
        {
            const int n = tid & 63, qq = tid >> 6; float off = 0.f;
            for (int q2 = 0; q2 < qq; ++q2) off += fSeg[q2 * 64 + n];
            if (qq) for (int t = 16 * qq; t < 16 * qq + 16; ++t) fLogw[t * FP + n] += off;
        }
        __syncthreads();
#pragma unroll
        for (int i = 0; i < 2; ++i) {
            const int tau = (tid >> 3) + 32 * i, g = dir ? c * 64 + 63 - tau : c * 64 + tau;
            float oa[8], ob[8], ok[8], orr[8], kkv[8], kd[8];
            float ss = 0.f, dsum = 0.f;
            const int c8 = h * 64 + ch * 8;
            float kkp[8], kap[8], rkp[8];
            { const f32x4 a0_ = *(const f32x4*)(p.k_k + c8), a1_ = *(const f32x4*)(p.k_k + c8 + 4), b0_ = *(const f32x4*)(p.k_a + c8), b1_ = *(const f32x4*)(p.k_a + c8 + 4), c0_ = *(const f32x4*)(rkd + c8), c1_ = *(const f32x4*)(rkd + c8 + 4);
#pragma unroll
              for (int j = 0; j < 4; ++j) { kkp[j] = a0_[j]; kkp[4 + j] = a1_[j]; kap[j] = b0_[j]; kap[4 + j] = b1_[j]; rkp[j] = c0_[j]; rkp[4 + j] = c1_[j]; } }
#pragma unroll
            for (int j = 0; j < 8; ++j) { kkv[j] = fk_[i][j] * kkp[j]; ss += kkv[j] * kkv[j]; }
            ss += __shfl_xor(ss, 1, 64); ss += __shfl_xor(ss, 2, 64); ss += __shfl_xor(ss, 4, 64);
            const float inv = 1.f / fmaxf(sqrtf(ss), 1e-12f);
#pragma unroll
            for (int j = 0; j < 8; ++j) {
                const int jj = ch * 8 + j;
                const float cum = fLogw[tau * FP + jj], cprev = tau ? fLogw[(tau - 1) * FP + jj] : 0.f, av = fA[tau * FP + jj];
                const float gam = __expf(cum), gprev = __expf(cprev), ginv = __expf(-cum);
                const float kkn = kkv[j] * inv;
                kd[j] = fk_[i][j] * (1.f + (av - 1.f) * kap[j]);
                oa[j] = -kkn * gprev; ob[j] = kkn * av * ginv; ok[j] = kd[j] * ginv; orr[j] = fr_[i][j] * gam;
                dsum += fr_[i][j] * kd[j] * rkp[j];
                if (tau == 63) fGC[jj] = gam;
            }
            dsum += __shfl_xor(dsum, 1, 64); dsum += __shfl_xor(dsum, 2, 64); dsum += __shfl_xor(dsum, 4, 64);
            if (ch == 0) ((float*)(p.ws + OFF_DOT))[((size_t)g * 8 + h) * 2 + dir] = dsum;
            *(u32x4*)(sAT + tau * MP + ch * 8) = pack8(oa); *(u32x4*)(sBT + tau * MP + ch * 8) = pack8(ob);
            *(u32x4*)(sKT + tau * MP + ch * 8) = pack8(ok); *(u32x4*)(sRT + tau * MP + ch * 8) = pack8(orr);
            const u32x4 pv8 = pack8(fv_[i]);
            *(u32x4*)(sVT + tau * MP + ch * 8) = pv8;
            if (want_g) *(u32x4*)((bf16_t*)(p.ws + OFF_V) + (size_t)(g - CTX) * DR + h * 64 + ch * 8) = pv8;
        }
        __syncthreads();
        if (STOP == 1) continue;
        {
            f32x16 acc = mm32<false, false>(sAT, xq, sBT, yq, zero16(), lane);
            store_acc(M + 5 * MSZ, xq, yq, acc, lane, [](float v, int x, int y) { return y < x ? v : 0.f; });
            store_acc(M + 7 * MSZ, xq, yq, acc, lane, [](float v, int x, int y) { return y < x ? v : (y == x ? 1.f : 0.f); });
            acc = mm32<false, false>(sAT, xq, sKT, yq, zero16(), lane);
            store_acc(M + 9 * MSZ, xq, yq, acc, lane, [](float v, int x, int y) { return y < x ? v : 0.f; });
            acc = mm32<false, false>(sRT, xq, sBT, yq, zero16(), lane);
            store_acc(M + 10 * MSZ, xq, yq, acc, lane, [](float v, int x, int y) { return y <= x ? v : 0.f; });
            acc = mm32<false, false>(sRT, xq, sKT, yq, zero16(), lane);
            store_acc(M + 11 * MSZ, xq, yq, acc, lane, [](float v, int x, int y) { return y <= x ? v : 0.f; });
        }
        __syncthreads();
        int xs = 5, xo = 6, ts = 7, to = 8;
        {
            f32x16 acc = mm32<true, false>(M + xs * MSZ, xq, M + xs * MSZ, yq, zero16(), lane);
            store_acc(M + xo * MSZ, xq, yq, acc, lane, [](float v, int, int) { return v; });
            int t_ = xs; xs = xo; xo = t_;
        }
        __syncthreads();
        for (int k = 0; k < 5; ++k) {
            const bf16_t* Told = M + ts * MSZ;
            f32x16 acc = mm32<true, false>(M + xs * MSZ, xq, Told, yq, zero16(), lane);
            store_acc(M + to * MSZ, xq, yq, acc, lane, [Told](float v, int x, int y) { return v + bf2f(Told[y * MP + x]); });
            if (k < 4) {
                acc = mm32<true, false>(M + xs * MSZ, xq, M + xs * MSZ, yq, zero16(), lane);
                store_acc(M + xo * MSZ, xq, yq, acc, lane, [](float v, int, int) { return v; });
            }
            int t_ = xs; xs = xo; xo = t_; t_ = ts; ts = to; to = t_;
            __syncthreads();
        }
        if (STOP == 2) continue;
        const bf16_t* sT = M + ts * MSZ;
        {
            f32x16 acc = mm32<true, true>(sT, xq, sAT, yq, zero16(), lane);
            store_acc(M + 12 * MSZ, xq, yq, acc, lane, [](float v, int, int) { return v; });
            acc = mm32<true, false>(sT, xq, M + 9 * MSZ, yq, zero16(), lane);
            store_acc(M + 13 * MSZ, xq, yq, acc, lane, [](float v, int, int) { return v; });
        }
        __syncthreads();
        {
            const bf16_t *sAbar = M + 12 * MSZ, *sG = M + 13 * MSZ, *sABR = M + 10 * MSZ, *sAKR = M + 11 * MSZ;
            f32x16 acc = mm32<false, true>(sAbar, xq, sBT, yq, zero16(), lane);
            store_acc(M + 5 * MSZ, xq, yq, acc, lane, [fGC](float v, int x, int y) { return ((x == y ? 1.f : 0.f) + v) * fGC[y]; });
            acc = mm32<false, true>(sAbar, xq, sABR, yq, zero16(), lane);
            store_acc(M + 6 * MSZ, xq, yq, acc, lane, [sRT](float v, int x, int y) { return v + bf2f(sRT[y * MP + x]); });
            acc = mm32<true, false>(sBT, xq, sG, yq, zero16(), lane);
            store_acc(M + 7 * MSZ, xq, yq, acc, lane, [sKT, fGC](float v, int x, int y) { return (v + bf2f(sKT[y * MP + x])) * fGC[x]; });
            acc = mm32<true, false>(sABR, xq, sG, yq, zero16(), lane);
            store_acc(M + 9 * MSZ, xq, yq, acc, lane, [sAKR](float v, int x, int y) { return v + bf2f(sAKR[y * MP + x]); });
        }
        __syncthreads();
        const int chain = dir * 8 + h, npos = chain_pos(c, dir);
        {
            u32x4* Pg = (u32x4*)(p.ws + OFF_P) + ((size_t)chain * NCH + npos) * 512;
#pragma unroll
            for (int i = 0; i < 2; ++i) {
                const int item = tid + 256 * i, ln = item & 63, as = item >> 6, a = as >> 1, s2 = as & 1, fr = ln & 15, fq = ln >> 4;
                const bf16_t* src = M + 5 * MSZ + (16 * a + fr) * MP + 32 * s2 + 4 * fq;
                const u32x2 lo = *(const u32x2*)src, hi = *(const u32x2*)(src + 16);
                Pg[as * 64 + ln] = (u32x4){lo.x, lo.y, hi.x, hi.y};
            }
            if (latent) {
                u32x4* Wg = (u32x4*)(p.ws + OFF_WYT) + ((size_t)((c - 4) * 8 + h) * 2 + dir) * 512;
#pragma unroll
                for (int i = 0; i < 2; ++i) { const int item = tid + 256 * i, row = item >> 3, ck = item & 7; Wg[item] = *(const u32x4*)(M + 6 * MSZ + row * MP + ck * 8); }
            }
        }
        {
            f32x16 acc = mm32<true, true>(M + 7 * MSZ, xq, sVT, yq, zero16(), lane);
            store_acc(M + 12 * MSZ, xq, yq, acc, lane, [](float v, int, int) { return v; });
            acc = mm32<true, true>(M + 9 * MSZ, xq, sVT, yq, zero16(), lane);
            store_acc(M + 13 * MSZ, xq, yq, acc, lane, [](float v, int, int) { return v; });
        }
        __syncthreads();
        {
            u32x2* Qg = (u32x2*)(p.ws + OFF_Q) + ((size_t)chain * NCH + npos) * 1024;
#pragma unroll
            for (int i = 0; i < 4; ++i) {
                const int item = tid + 256 * i, ln = item & 63, wa = item >> 6, wi = wa >> 2, a = wa & 3, fr = ln & 15, fq = ln >> 4;
                Qg[item] = *(const u32x2*)(M + 12 * MSZ + (16 * wi + fr) * MP + 16 * a + 4 * fq);
            }
            if (latent) {
                u32x2* Yg = (u32x2*)(p.ws + OFF_YL) + ((size_t)((c - 4) * 8 + h) * 2 + dir) * 1024;
#pragma unroll
                for (int i = 0; i < 4; ++i) {
                    const int item = tid + 256 * i, ln = item & 63, wn = item >> 6, wt = wn >> 2, ni = wn & 3, fr = ln & 15, fq = ln >> 4;
                    const bf16_t* row = M + 13 * MSZ + (16 * ni + fr) * MP;
                    u32x2 v;
                    if (dir == 0) v = *(const u32x2*)(row + 16 * wt + 4 * fq);
                    else { const u32x2 r2 = *(const u32x2*)(row + 60 - 16 * wt - 4 * fq); v = (u32x2){rot16(r2.y), rot16(r2.x)}; }
                    Yg[item] = v;
                }
            }
        }
        __syncthreads();
    }
}

DI void phase_chain(const Params& p, int chain) {
    const int lane = threadIdx.x & 63, w = threadIdx.x >> 6;
    const u32x4* Pg = (const u32x4*)(p.ws + OFF_P) + (size_t)chain * NCH * 512;
    const u32x2* Qg = (const u32x2*)(p.ws + OFF_Q) + (size_t)chain * NCH * 1024;
    u32x4* Zg = (u32x4*)(p.ws + OFF_Z) + (size_t)chain * NCH * 512;
    f32x4 acc[4];
#pragma unroll
    for (int a = 0; a < 4; ++a) acc[a] = (f32x4){0, 0, 0, 0};
    constexpr int CPF = 4;
    u32x4 pf[CPF][8]; u32x2 qf[CPF][4];
#pragma unroll
    for (int st = 0; st < CPF; ++st) {
#pragma unroll
        for (int i = 0; i < 8; ++i) pf[st][i] = Pg[(size_t)st * 512 + i * 64 + lane];
#pragma unroll
        for (int a = 0; a < 4; ++a) qf[st][a] = Qg[(size_t)st * 1024 + (w * 4 + a) * 64 + lane];
    }
    for (int nb = 0; nb < NCH; nb += CPF) {
#pragma unroll
        for (int st = 0; st < CPF; ++st) {
            const int n = nb + st;
            u32x4 pc[8]; u32x2 qc[4];
#pragma unroll
            for (int i = 0; i < 8; ++i) pc[i] = pf[st][i];
#pragma unroll
            for (int a = 0; a < 4; ++a) qc[a] = qf[st][a];
            if (n + CPF < NCH) {
#pragma unroll
                for (int i = 0; i < 8; ++i) pf[st][i] = Pg[(size_t)(n + CPF) * 512 + i * 64 + lane];
#pragma unroll
                for (int a = 0; a < 4; ++a) qf[st][a] = Qg[(size_t)(n + CPF) * 1024 + (w * 4 + a) * 64 + lane];
            }
            u32x4 z0 = {pack2(acc[0][0], acc[0][1]), pack2(acc[0][2], acc[0][3]), pack2(acc[1][0], acc[1][1]), pack2(acc[1][2], acc[1][3])};
            u32x4 z1 = {pack2(acc[2][0], acc[2][1]), pack2(acc[2][2], acc[2][3]), pack2(acc[3][0], acc[3][1]), pack2(acc[3][2], acc[3][3])};
            Zg[((size_t)n * 4 + w) * 128 + lane] = z0; Zg[((size_t)n * 4 + w) * 128 + 64 + lane] = z1;
            const bf16x8 zb0 = __builtin_bit_cast(bf16x8, z0), zb1 = __builtin_bit_cast(bf16x8, z1);
#pragma unroll
            for (int a = 0; a < 4; ++a) {
                f32x4 ini = {bflo(qc[a].x), bfhi(qc[a].x), bflo(qc[a].y), bfhi(qc[a].y)};
                ini = __builtin_amdgcn_mfma_f32_16x16x32_bf16(__builtin_bit_cast(bf16x8, pc[2 * a]), zb0, ini, 0, 0, 0);
                acc[a] = __builtin_amdgcn_mfma_f32_16x16x32_bf16(__builtin_bit_cast(bf16x8, pc[2 * a + 1]), zb1, ini, 0, 0, 0);
            }
        }
    }
}

DI void phase_scanC(const Params& p, int bid, int nblk) {
    const int lane = threadIdx.x & 63, w = threadIdx.x >> 6, fr = lane & 15, fq = lane >> 4;
    bf16_t* mix = (bf16_t*)(p.ws + OFF_MIX);
    const float* dot = (const float*)(p.ws + OFF_DOT);
    for (int unit = bid; unit < 256 * 8; unit += nblk) {
        const int c = 4 + (unit >> 3), h = unit & 7;
        f32x4 y[4];
#pragma unroll
        for (int ni = 0; ni < 4; ++ni) y[ni] = (f32x4){0, 0, 0, 0};
#pragma unroll
        for (int dir = 0; dir < 2; ++dir) {
            const int chain = dir * 8 + h, npos = chain_pos(c, dir);
            const u32x4* Zg = (const u32x4*)(p.ws + OFF_Z) + ((size_t)chain * NCH + npos) * 512;
            const bf16_t* Wg = (const bf16_t*)(p.ws + OFF_WYT) + ((size_t)((c - 4) * 8 + h) * 2 + dir) * 4096;
            const u32x2* Yg = (const u32x2*)(p.ws + OFF_YL) + ((size_t)((c - 4) * 8 + h) * 2 + dir) * 1024;
            const int rho = 16 * w + fr, row = dir ? 63 - rho : rho;
            bf16x8 af[2];
#pragma unroll
            for (int s2 = 0; s2 < 2; ++s2) {
                const u32x2 lo = *(const u32x2*)(Wg + row * 64 + 32 * s2 + 4 * fq), hi = *(const u32x2*)(Wg + row * 64 + 32 * s2 + 16 + 4 * fq);
                af[s2] = __builtin_bit_cast(bf16x8, (u32x4){lo.x, lo.y, hi.x, hi.y});
            }
#pragma unroll
            for (int ni = 0; ni < 4; ++ni) {
                const u32x2 yl = Yg[(w * 4 + ni) * 64 + lane];
                f32x4 acc = {bflo(yl.x), bfhi(yl.x), bflo(yl.y), bfhi(yl.y)};
                acc = __builtin_amdgcn_mfma_f32_16x16x32_bf16(af[0], __builtin_bit_cast(bf16x8, Zg[(ni * 2 + 0) * 64 + lane]), acc, 0, 0, 0);
                acc = __builtin_amdgcn_mfma_f32_16x16x32_bf16(af[1], __builtin_bit_cast(bf16x8, Zg[(ni * 2 + 1) * 64 + lane]), acc, 0, 0, 0);
                y[ni] += acc;
            }
        }
#pragma unroll
        for (int e = 0; e < 4; ++e) {
            const int t = (c - 4) * 64 + 16 * w + 4 * fq + e, g = t + CTX;
            float s = y[0][e] + y[1][e] + y[2][e] + y[3][e];
            s += __shfl_xor(s, 1, 64); s += __shfl_xor(s, 2, 64); s += __shfl_xor(s, 4, 64); s += __shfl_xor(s, 8, 64);
            const float mean = s * (1.f / 64.f);
            float q = 0.f;
#pragma unroll
            for (int ni = 0; ni < 4; ++ni) { const float d = y[ni][e] - mean; q += d * d; }
            q += __shfl_xor(q, 1, 64); q += __shfl_xor(q, 2, 64); q += __shfl_xor(q, 4, 64); q += __shfl_xor(q, 8, 64);
            const float rs = rsqrtf(q * (1.f / 64.f) + 64e-5f);
            const float bon = dot[((size_t)g * 8 + h) * 2] + dot[((size_t)g * 8 + h) * 2 + 1];
#pragma unroll
            for (int ni = 0; ni < 4; ++ni) {
                const int cch = h * 64 + 16 * ni + fr;
                const float vv = bf2f(((const bf16_t*)(p.ws + OFF_V))[(size_t)t * DR + cch]), gg = bf2f(((const bf16_t*)(p.ws + OFF_G))[(size_t)t * DR + cch]);
                const float o = ((y[ni][e] - mean) * rs * p.gn_w[cch] + p.gn_b[cch] + bon * vv) * gg;
                const unsigned pk = pack2(o, 0.f);
                mix[(size_t)t * D + cch] = (bf16_t)(pk & 0xffffu);
            }
        }
    }
}

struct EpiX2 { float* o; const float* x; const float* gt; const float* rowtab; const float* coltab; int row0, col0;
    DI void operator()(int r, int c, const f32x4& a, const f32x4& b, const f32x4&, const f32x4&) const {
        const int t = row0 + r, d = col0 + c;
        const float* pt = d < 512 ? rowtab + (t >> 6) * 512 + d : coltab + (t & 63) * 512 + (d - 512);
#pragma unroll
        for (int hf = 0; hf < 2; ++hf) {
            const f32x4 xv = *(const f32x4*)(x + (size_t)t * D + d + 4 * hf), pv = *(const f32x4*)(pt + 4 * hf), gv = *(const f32x4*)(gt + d + 4 * hf);
            *(f32x4*)(o + (size_t)t * D + d + 4 * hf) = xv + pv + gv * (hf ? b : a);
        } } };
DI void phase_g2(const Params& p, int bid, int nblk, char* lds) {
    const bf16_t* mix = (const bf16_t*)(p.ws + OFF_MIX);
    const XcdOrder ord(bid, nblk, 64 * 8);
    for (int i = 0, q; (q = ord.item(i)) >= 0; ++i) {
        int tm, tn; tile_rc(q, 64, 8, tm, tn);
        PlainA al{mix + (size_t)tm * 256 * D, D};
        EpiX2 e{(float*)(p.ws + OFF_X2), p.x, (const float*)(p.ws + OFF_MODX) + 2048, (const float*)(p.ws + OFF_ROWTAB), (const float*)(p.ws + OFF_COLTAB), tm * 256, tn * 128};
        gemm256<1>(al, p.w_out + tn * 128, nullptr, D, D, lds, e);
    }
}

DI float router_w(const Params& p, int k, int n) { return n < 4 ? p.w_rg[k * 4 + n] : (n < 36 ? p.w_re[k * 32 + (n - 4)] : 0.f); }
DI void phase_router_prep(const Params& p, int bid, int nblk) {
    const float* modx = (const float*)(p.ws + OFF_MODX);
    float* wp = (float*)(p.ws + OFF_WP); float* b2 = (float*)(p.ws + OFF_B2);
    for (int idx = bid * 256 + threadIdx.x; idx < 64 * 4 * 3 * 64; idx += nblk * 256) {
        const int ln = idx & 63, r = idx >> 6, nt = r % 3, me = r / 3, e = me & 3, m = me >> 2;
        const int k = 16 * m + 4 * (ln >> 4) + e, n = 16 * nt + (ln & 15);
        wp[idx] = p.norm2_g[k] * (1.f + modx[4096 + k]) * router_w(p, k, n);
    }
    const int lane = threadIdx.x & 63, wv = bid * 4 + (threadIdx.x >> 6);
    if (wv < 36) {
        float sacc = 0.f;
        for (int k = lane; k < D; k += 64) sacc += modx[3072 + k] * router_w(p, k, wv);
        sacc = wave_sum(sacc);
        if (lane == 0) b2[wv] = sacc + (wv < 4 ? p.b_rg[wv] : p.b_re[wv - 4]);
    }
}

DI void phase_router(const Params& p, int bid, int nblk, char* lds, bool dry = false) {
    const int lane = threadIdx.x & 63, wid = threadIdx.x >> 6, tr = lane & 15, kq = lane >> 4;
    const float* x2 = (const float*)(p.ws + OFF_X2); const float* modx = (const float*)(p.ws + OFF_MODX);
    const float* wp = (const float*)(p.ws + OFF_WP); const float* b2 = (const float*)(p.ws + OFF_B2);
    bf16_t* h2 = (bf16_t*)(p.ws + OFF_H2); int* cnt = (int*)(p.ws + OFF_CNT); float* gate = (float*)(p.ws + OFF_GATE); int* list = (int*)(p.ws + OFF_LIST);
    float* slog = (float*)lds + wid * (16 * 49);
    for (int task = bid * 4 + wid; task < S / 16; task += nblk * 4) {
        const int t0 = task * 16;
        const float* xr = x2 + (size_t)(t0 + tr) * D + 4 * kq;
        f32x4 acc[3];
#pragma unroll
        for (int i = 0; i < 3; ++i) acc[i] = (f32x4){0, 0, 0, 0};
        float ss = 0.f;
#pragma unroll 4
        for (int m = 0; m < 64; ++m) {
            const f32x4 xv = *(const f32x4*)(xr + 16 * m);
            ss += xv[0] * xv[0] + xv[1] * xv[1] + xv[2] * xv[2] + xv[3] * xv[3];
#pragma unroll
            for (int e = 0; e < 4; ++e)
#pragma unroll
                for (int nt = 0; nt < 3; ++nt) acc[nt] = __builtin_amdgcn_mfma_f32_16x16x4f32(xv[e], wp[((m * 4 + e) * 3 + nt) * 64 + lane], acc[nt], 0, 0, 0);
        }
        ss += __shfl_xor(ss, 16, 64); ss += __shfl_xor(ss, 32, 64);
        const float rstd = rsqrtf(ss * (1.f / 1024.f) + 1e-6f);
#pragma unroll
        for (int nt = 0; nt < 3; ++nt)
#pragma unroll
            for (int r = 0; r < 4; ++r) slog[(4 * kq + r) * 49 + 16 * nt + tr] = acc[nt][r];
        asm volatile("s_waitcnt lgkmcnt(0)" ::: "memory"); __builtin_amdgcn_wave_barrier();
        if (lane < 16) {
            const int t = t0 + lane;
            const float* lg = slog + lane * 49;
            const float l0 = rstd * lg[0] + b2[0], l1 = rstd * lg[1] + b2[1], l2 = rstd * lg[2] + b2[2], l3 = rstd * lg[3] + b2[3];
            int grp = 0; float mx = l0;
            if (l1 > mx) { mx = l1; grp = 1; }
            if (l2 > mx) { mx = l2; grp = 2; }
            if (l3 > mx) { mx = l3; grp = 3; }
            const float den = __expf(l0 - mx) + __expf(l1 - mx) + __expf(l2 - mx) + __expf(l3 - mx);
            const float pgrp = 1.f / den;
            int i1 = 0, i2 = -1; float v1 = -3.0e38f, v2 = -3.0e38f;
            for (int n = 0; n < 8; ++n) {
                const float sv = rstd * lg[4 + grp * 8 + n] + b2[4 + grp * 8 + n];
                if (sv > v1) { v2 = v1; i2 = i1; v1 = sv; i1 = n; } else if (sv > v2) { v2 = sv; i2 = n; }
            }
            const float e2 = __expf(v2 - v1), g1 = pgrp / (1.f + e2), g2v = pgrp * e2 / (1.f + e2);
            const int ea = grp * 8 + i1, eb = grp * 8 + i2;
            if (!dry) {
                const int pa = atomicAdd(&cnt[ea], 1), pb = atomicAdd(&cnt[eb], 1);
                list[ea * LCAP + pa] = t * 2; list[eb * LCAP + pb] = t * 2 + 1;
            }
            gate[t * 2] = g1; gate[t * 2 + 1] = g2v;
        }
        for (int r = 0; r < 16; ++r) {
            const float rs = __shfl(rstd, r, 64);
            const float* src = x2 + (size_t)(t0 + r) * D;
#pragma unroll
            for (int i = 0; i < 4; ++i) {
                const int d = (i * 64 + lane) * 4;
                const f32x4 v = *(const f32x4*)(src + d), gg = *(const f32x4*)(p.norm2_g + d), sh = *(const f32x4*)(modx + 3072 + d), sc = *(const f32x4*)(modx + 4096 + d);
                f32x4 hv;
#pragma unroll
                for (int j = 0; j < 4; ++j) hv[j] = (v[j] * rs * gg[j]) * (1.f + sc[j]) + sh[j];
                u32x2 pk = {pack2(hv[0], hv[1]), pack2(hv[2], hv[3])};
                *(u32x2*)(h2 + (size_t)(t0 + r) * D + d) = pk;
            }
        }
        __builtin_amdgcn_wave_barrier();
    }
}

DI void moe_tiles(const int* cnt, int* tstart  ) {
    if (threadIdx.x == 0) { int acc = 0; for (int e = 0; e < NE; ++e) { tstart[e] = acc; acc += (cnt[e] + 255) >> 8; } tstart[NE] = acc; }
    __syncthreads();
}
struct EpiHid { bf16_t* o; DI void operator()(int r, int c, const f32x4& g0, const f32x4& g1, const f32x4& u0, const f32x4& u1) const {
    f32x4 h0, h1;
#pragma unroll
    for (int j = 0; j < 4; ++j) { h0[j] = g0[j] * sigmoidf_(g0[j]) * u0[j]; h1[j] = g1[j] * sigmoidf_(g1[j]) * u1[j]; }
    *(u32x4*)(o + (size_t)r * DE + c) = pack8v(h0, h1); } };
DI void phase_g3(const Params& p, int bid, int nblk, char* lds) {
    int* tstart = (int*)(lds + GEMM_LDS);
    const int* cnt = (const int*)(p.ws + OFF_CNT); const int* list = (const int*)(p.ws + OFF_LIST);
    const bf16_t* h2 = (const bf16_t*)(p.ws + OFF_H2); bf16_t* hid = (bf16_t*)(p.ws + OFF_HID);
    moe_tiles(cnt, tstart);
    const int ntiles = tstart[NE];
    const XcdOrder ord(bid, nblk, ntiles * 8);
    for (int i = 0, item; (item = ord.item(i)) >= 0; ++i) {
        const int ti = item >> 3, cj = item & 7;
        int e = 0; while (e < NE - 1 && tstart[e + 1] <= ti) ++e;
        const int lt = ti - tstart[e], ne = cnt[e];
        GatherA al;
#pragma unroll
        for (int i = 0; i < 8; ++i) { const int row = (threadIdx.x + 256 * i) >> 3, pos = lt * 256 + row; const int tok = pos < ne ? (list[e * LCAP + pos] >> 1) : 0; al.rp[i] = h2 + (size_t)tok * D; }
        EpiHid epi{hid + (size_t)ti * 256 * DE + cj * 64};
        gemm256<2>(al, p.w_gate + (size_t)e * D * DE + cj * 64, p.w_up + (size_t)e * D * DE + cj * 64, DE, D, lds, epi);
    }
}
struct EpiDown { bf16_t* ybuf; const int* lst; const float* gate; int nvalid; int col0;
    DI void operator()(int r, int c, const f32x4& a, const f32x4& b, const f32x4&, const f32x4&) const {
        if (r >= nvalid) return; const int slot = lst[r]; const float g = gate[slot];
        *(u32x4*)(ybuf + (size_t)slot * D + col0 + c) = pack8v(a * g, b * g); } };
DI void phase_g4(const Params& p, int bid, int nblk, char* lds) {
    int* tstart = (int*)(lds + GEMM_LDS);
    const int* cnt = (const int*)(p.ws + OFF_CNT); const int* list = (const int*)(p.ws + OFF_LIST);
    const bf16_t* hid = (const bf16_t*)(p.ws + OFF_HID);
    moe_tiles(cnt, tstart);
    const int ntiles = tstart[NE];
    const XcdOrder ord(bid, nblk, ntiles * 8);
    for (int i = 0, item; (item = ord.item(i)) >= 0; ++i) {
        const int ti = item >> 3, cj = item & 7;
        int e = 0; while (e < NE - 1 && tstart[e + 1] <= ti) ++e;
        const int lt = ti - tstart[e], ne = cnt[e];
        PlainA al{hid + (size_t)ti * 256 * DE, DE};
        EpiDown epi{(bf16_t*)(p.ws + OFF_YBUF), list + e * LCAP + lt * 256, (const float*)(p.ws + OFF_GATE), ne - lt * 256, cj * 128};
        gemm256<1>(al, p.w_down + (size_t)e * DE * D + cj * 128, nullptr, D, DE, lds, epi);
    }
}

DI void phase_final(const Params& p, int bid, int nblk) {
    const int lane = threadIdx.x & 63, wid = threadIdx.x >> 6;
    const float* x2 = (const float*)(p.ws + OFF_X2); const float* gt = (const float*)(p.ws + OFF_MODX) + 5120; const bf16_t* yb = (const bf16_t*)(p.ws + OFF_YBUF);
    for (int t = bid * 4 + wid; t < S; t += nblk * 4) {
        f32x4 v[4]; float ss = 0.f;
#pragma unroll
        for (int i = 0; i < 4; ++i) {
            const int d = (i * 64 + lane) * 4;
            v[i] = *(const f32x4*)(x2 + (size_t)t * D + d);
            const u32x2 a = *(const u32x2*)(yb + (size_t)(2 * t) * D + d), b = *(const u32x2*)(yb + (size_t)(2 * t + 1) * D + d);
            const f32x4 g = *(const f32x4*)(gt + d);
            v[i][0] += g[0] * (bflo(a.x) + bflo(b.x)); v[i][1] += g[1] * (bfhi(a.x) + bfhi(b.x));
            v[i][2] += g[2] * (bflo(a.y) + bflo(b.y)); v[i][3] += g[3] * (bfhi(a.y) + bfhi(b.y));
            ss += v[i][0] * v[i][0] + v[i][1] * v[i][1] + v[i][2] * v[i][2] + v[i][3] * v[i][3];
        }
        ss = wave_sum(ss);
        const float rstd = rsqrtf(ss * (1.f / 1024.f) + 1e-6f);
#pragma unroll
        for (int i = 0; i < 4; ++i) {
            const int d = (i * 64 + lane) * 4; const f32x4 fg = *(const f32x4*)(p.final_g + d); f32x4 o;
#pragma unroll
            for (int j = 0; j < 4; ++j) o[j] = v[i][j] * rstd * fg[j];
            *(f32x4*)(p.out + (size_t)t * D + d) = o;
        }
    }
}

#define XB_TMO      128
#define XB_XCNT(j)  (256  + 64 * (j))
#define XB_XSUB(j)  (1280 + 64 * (j))
#define XB_XGEN(j)  (2304 + 64 * (j))
#define XB_TOP      3328
#define XB_TOPGEN   3392
#define XCD_BAR_WORDS 3456
#define XB_SPIN_CAP (1u << 18)
DI unsigned xb_ld(unsigned* p) { return __hip_atomic_load(p, __ATOMIC_RELAXED, __HIP_MEMORY_SCOPE_AGENT); }
DI unsigned xb_add(unsigned* p, unsigned v) { return __hip_atomic_fetch_add(p, v, __ATOMIC_RELAXED, __HIP_MEMORY_SCOPE_AGENT); }
DI unsigned xb_xcc_id() { return (unsigned)__builtin_amdgcn_s_getreg((3 << 11) | 20) & 0xFu; }
#define XB_SPIN(cond, bar) do { unsigned _sp = 0; while (cond) { __builtin_amdgcn_s_sleep(1); \
    if ((++_sp & 255u) == 0u) { if (xb_ld(&(bar)[XB_TMO])) break; if (_sp > XB_SPIN_CAP) { atomicAdd(&(bar)[XB_TMO], 1u); break; } } } } while (0)
struct XcdBarrier { unsigned* bar; unsigned x; volatile LAS unsigned* st; };
DI XcdBarrier xcd_barrier_post(unsigned* bar, volatile LAS unsigned* st) {
    XcdBarrier b; b.bar = bar; b.x = xb_xcc_id(); b.st = st;
    if (threadIdx.x == 0) (void)xb_add(&bar[XB_XCNT(b.x)], 1u);
    return b;
}
DI void xcd_barrier_complete(unsigned* bar, unsigned x, unsigned& nloc, unsigned& nx) {
    const unsigned G = gridDim.x * gridDim.y * gridDim.z;
    unsigned sum, cnt, mine, sp = 0u;
    for (;;) {
        sum = 0u; cnt = 0u; mine = 0u;
#pragma unroll
        for (unsigned j = 0; j < 16; ++j) { const unsigned c = xb_ld(&bar[XB_XCNT(j)]); sum += c; cnt += (c > 0u) ? 1u : 0u; mine = (j == x) ? c : mine; }
        if (sum == G) break;
        __builtin_amdgcn_s_sleep(1);
        if ((++sp & 255u) == 0u) { if (xb_ld(&bar[XB_TMO])) break; if (sp > XB_SPIN_CAP) { atomicAdd(&bar[XB_TMO], 1u); break; } }
    }
    nloc = mine > 0u ? mine : 1u; nx = cnt > 0u ? cnt : 1u;
}
DI void xcd_barrier(const XcdBarrier& b) {
    asm volatile("s_waitcnt vmcnt(0)" ::: "memory");
    __syncthreads();
    if (threadIdx.x == 0) {
        unsigned* bar = b.bar;
        __builtin_amdgcn_s_waitcnt(0);
        unsigned nloc = b.st[0], nx = b.st[1];
        if (nloc == 0u) { xcd_barrier_complete(bar, b.x, nloc, nx); b.st[0] = nloc; b.st[1] = nx; }
        const unsigned old = xb_add(&bar[XB_XSUB(b.x)], 1u);
        const unsigned gen = old / nloc;
        if (old + 1u == (gen + 1u) * nloc) {
            __builtin_amdgcn_fence(__ATOMIC_RELEASE, "agent");
            asm volatile("s_waitcnt vmcnt(0)" ::: "memory");
            const unsigned og = xb_add(&bar[XB_TOP], 1u);
            const unsigned tg = og / nx;
            if (og + 1u == (tg + 1u) * nx) xb_add(&bar[XB_TOPGEN], 1u);
            else XB_SPIN(xb_ld(&bar[XB_TOPGEN]) == tg, bar);
            __builtin_amdgcn_fence(__ATOMIC_ACQUIRE, "agent");
            xb_add(&bar[XB_XGEN(b.x)], 1u);
            asm volatile("s_waitcnt vmcnt(0)" ::: "memory");
        } else {
            XB_SPIN(xb_ld(&bar[XB_XGEN(b.x)]) == gen, bar);
            __builtin_amdgcn_fence(__ATOMIC_ACQUIRE, "agent");
            asm volatile("s_waitcnt vmcnt(0)" ::: "memory");
        }
    }
    __syncthreads();
}

#ifndef PROBE
#define PROBE 0
#endif
constexpr int MEGA_LDS = SCANA_LDS > (GEMM_LDS + 256) ? SCANA_LDS : (GEMM_LDS + 256);
__global__ void __launch_bounds__(256) k_mega(Params p) {
    extern __shared__ __attribute__((aligned(16))) char lds[];
    const int bid = blockIdx.x, nblk = gridDim.x;
    volatile LAS unsigned* st = (volatile LAS unsigned*)(lds + MEGA_LDS);
    if (threadIdx.x < 4) st[threadIdx.x] = 0u;
    __syncthreads();
    const XcdBarrier gb = xcd_barrier_post((unsigned*)(p.ws + OFF_BAR), st);
#define GSYNC() xcd_barrier(gb)
    phase_p0(p, bid, nblk, lds); GSYNC();
    if (PROBE == 1) { phase_p0(p, bid, nblk, lds); GSYNC(); }
    phase_xn(p, bid, nblk); phase_router_prep(p, bid, nblk); GSYNC();
    if (PROBE == 2) { phase_xn(p, bid, nblk); GSYNC(); }
    phase_g1(p, bid, nblk, lds); GSYNC();
    if (PROBE == 3) { phase_g1(p, bid, nblk, lds); GSYNC(); }
    if (PROBE == 30) { phase_g1_probe<0>(p, bid, nblk, lds); GSYNC(); }
    if (PROBE == 31) { phase_g1_probe<1>(p, bid, nblk, lds); GSYNC(); }
    if (PROBE == 32) { phase_g1_probe<2>(p, bid, nblk, lds); GSYNC(); }
    if (PROBE == 33) { phase_mfma_rate(p, 5120); GSYNC(); }
    if (PROBE == 34) { phase_mfma_rate32(p, 2560); GSYNC(); }
    phase_pool(p, bid, nblk);
    phase_scanA(p, bid, nblk, lds); GSYNC();
    if (PROBE == 4) { phase_scanA(p, bid, nblk, lds); GSYNC(); }
    if (PROBE == 41) { phase_scanA<1>(p, bid, nblk, lds); GSYNC(); }
    if (PROBE == 42) { phase_scanA<2>(p, bid, nblk, lds); GSYNC(); }
    if (PROBE == 12) { phase_pool(p, bid, nblk); GSYNC(); }
    if (bid < 16) phase_chain(p, bid); else phase_poolgemm(p, bid - 16, nblk - 16, lds);
    GSYNC();
    if (PROBE == 5) { if (bid < 16) phase_chain(p, bid); GSYNC(); }
    if (PROBE == 13) { if (bid >= 16) phase_poolgemm(p, bid - 16, nblk - 16, lds); GSYNC(); }
    phase_scanC(p, bid, nblk); GSYNC();
    if (PROBE == 6) { phase_scanC(p, bid, nblk); GSYNC(); }
    phase_g2(p, bid, nblk, lds); GSYNC();
    if (PROBE == 7) { phase_g2(p, bid, nblk, lds); GSYNC(); }
    if (PROBE == 8) { phase_router(p, bid, nblk, lds, true); GSYNC(); }
    phase_router(p, bid, nblk, lds); GSYNC();
    phase_g3(p, bid, nblk, lds); GSYNC();
    if (PROBE == 9) { phase_g3(p, bid, nblk, lds); GSYNC(); }
    phase_g4(p, bid, nblk, lds); GSYNC();
    if (PROBE == 10) { phase_g4(p, bid, nblk, lds); GSYNC(); }
    if (PROBE == 11) { phase_final(p, bid, nblk); GSYNC(); }
    phase_final(p, bid, nblk);
}

extern "C" void kernel_launch(void* const* d_in, const int* in_sizes, int n_in, void* d_out, int out_size, void* d_ws, size_t ws_size, hipStream_t stream) {
    if (ws_size < WS_NEED) { fprintf(stderr, "workspace too small: %zu < %zu\n", ws_size, (size_t)WS_NEED); return; }
    Params p{};
    const float** f = (const float**)&p;
    for (int i = 0; i < 36; ++i) f[i] = (const float*)d_in[i];
    p.out = (float*)d_out; p.ws = (char*)d_ws;
    static int grid_blocks = 0;
    if (!grid_blocks) {
        (void)hipFuncSetAttribute((const void*)k_mega, hipFuncAttributeMaxDynamicSharedMemorySize, MEGA_LDS + 16);
        int dev = 0, cus = 0, per_cu = 0;
        (void)hipGetDevice(&dev);
        (void)hipDeviceGetAttribute(&cus, hipDeviceAttributeMultiprocessorCount, dev);
        (void)hipOccupancyMaxActiveBlocksPerMultiprocessor(&per_cu, k_mega, 256, MEGA_LDS + 16);
        if (per_cu > 1) per_cu = 1;
        grid_blocks = cus * per_cu;
    }
    (void)hipMemsetAsync((char*)d_ws + OFF_BAR, 0, 16384, stream);
    void* args[] = {&p};
    hipError_t e = hipLaunchCooperativeKernel((const void*)k_mega, dim3(grid_blocks), dim3(256), args, MEGA_LDS + 16, stream);
    if (e != hipSuccess) fprintf(stderr, "cooperative launch failed: %s (grid %d)\n", hipGetErrorString(e), grid_blocks);
}
```

```cpp
#include <hip/hip_runtime.h>
#include <stdint.h>
#include <stdio.h>
#include <hip/hip_cooperative_groups.h>
namespace cg = cooperative_groups;

#define DI __device__ __forceinline__
typedef unsigned short bf16_t;
typedef short bf16x8 __attribute__((ext_vector_type(8)));
typedef short s16x4 __attribute__((ext_vector_type(4)));
typedef float f32x4 __attribute__((ext_vector_type(4)));
typedef float f32x2 __attribute__((ext_vector_type(2)));
typedef __bf16 bf16x2_t __attribute__((ext_vector_type(2)));
typedef unsigned u32x4 __attribute__((ext_vector_type(4)));
typedef unsigned u32x2 __attribute__((ext_vector_type(2)));
#define LAS __attribute__((address_space(3)))

constexpr int D = 1024, S = 16384, CTX = 256, NT = S + CTX, DIN = 2432, DSH = 1920, DR = 512;
constexpr int C_WLF = 1536, C_WLB = 1600, C_ALF = 1664, C_ALB = 1728, C_GL = 1792, C_POOL = 1920;
constexpr int NE = 32, DE = 512, LCAP = 32768;
constexpr float DECAY_SCALE = 0.6065306597f;

constexpr int NCH = NT / 64;
constexpr size_t SZ_U = (size_t)NT * DIN * 2;
constexpr size_t SZ_CH = (size_t)16 * NCH * 8192;
constexpr size_t OFF_U = 0;
constexpr size_t OFF_XN = OFF_U + SZ_U;
constexpr size_t OFF_P = OFF_XN;
constexpr size_t OFF_Q = OFF_P + SZ_CH;
constexpr size_t OFF_WYT = OFF_Q + SZ_CH;
constexpr size_t OFF_YL = OFF_WYT + (size_t)256 * 16 * 8192;
constexpr size_t OFF_V = OFF_YL + (size_t)256 * 16 * 8192;
constexpr size_t OFF_G = OFF_V + (size_t)S * DR * 2;
constexpr size_t OFF_MIX = OFF_G + (size_t)S * DR * 2;
constexpr size_t OFF_SMALL = OFF_MIX + (size_t)S * D * 2;
constexpr size_t OFF_MODX = OFF_SMALL, OFF_MODC = OFF_MODX + 6144 * 4;
constexpr size_t OFF_ROWTAB = OFF_MODC + 6144 * 4, OFF_COLTAB = OFF_ROWTAB + 256 * 512 * 4;
constexpr size_t OFF_CNT = OFF_COLTAB + 64 * 512 * 4;
constexpr size_t OFF_GATE = OFF_CNT + 256;
constexpr size_t OFF_LIST = OFF_GATE + (size_t)S * 2 * 4;
constexpr size_t OFF_DOT = OFF_LIST + (size_t)NE * LCAP * 4;
constexpr size_t OFF_WP = OFF_DOT + (size_t)NT * 16 * 4;
constexpr size_t OFF_B2 = OFF_WP + 64 * 4 * 3 * 64 * 4;
constexpr size_t OFF_BAR = OFF_B2 + 256;
constexpr size_t OFF_WINB = OFF_BAR + 16384;
constexpr size_t OFF_WOUTB = OFF_WINB + (size_t)D * DIN * 2;
constexpr size_t WS_NEED = OFF_WOUTB + (size_t)D * D * 2;
constexpr size_t OFF_Z = OFF_U;
constexpr size_t OFF_X2 = OFF_P;
constexpr size_t OFF_YBUF = OFF_WYT;
constexpr size_t OFF_H2 = OFF_U;
constexpr size_t OFF_HID = OFF_U + SZ_CH;

struct Params {
    const float *x, *c, *ctx, *c_ctx, *norm1_g, *w_mod, *b_mod, *w_in, *mu, *w0_f, *w2_f, *w0_b, *w2_b, *a0_f, *a2_f, *a0_b, *a2_b,
        *g2, *k_k, *k_a, *r_k_f, *r_k_b, *gn_w, *gn_b, *w_pool, *pool_scale, *w_out, *norm2_g, *w_rg, *b_rg, *w_re, *b_re,
        *w_gate, *w_up, *w_down, *final_g;
    float* out;
    char* ws;
};

DI unsigned pack2(float lo, float hi) { f32x2 v = {lo, hi}; bf16x2_t b = __builtin_convertvector(v, bf16x2_t); return __builtin_bit_cast(unsigned, b); }
DI float bf2f(bf16_t h) { return __uint_as_float(((unsigned)h) << 16); }
DI float bflo(unsigned u) { return __uint_as_float(u << 16); }
DI float bfhi(unsigned u) { return __uint_as_float(u & 0xffff0000u); }
DI void unpack8(const u32x4& p, float* f) { f[0] = bflo(p.x); f[1] = bfhi(p.x); f[2] = bflo(p.y); f[3] = bfhi(p.y); f[4] = bflo(p.z); f[5] = bfhi(p.z); f[6] = bflo(p.w); f[7] = bfhi(p.w); }
DI u32x4 pack8(const float* f) { u32x4 p; p.x = pack2(f[0], f[1]); p.y = pack2(f[2], f[3]); p.z = pack2(f[4], f[5]); p.w = pack2(f[6], f[7]); return p; }
DI float sigmoidf_(float x) { return 1.f / (1.f + __expf(-x)); }
DI float wave_sum(float v) {
#pragma unroll
    for (int o = 32; o > 0; o >>= 1) v += __shfl_xor(v, o, 64);
    return v;
}
DI f32x4 wave_sum4(f32x4 v) {
#pragma unroll
    for (int o = 32; o > 0; o >>= 1) { v[0] += __shfl_xor(v[0], o, 64); v[1] += __shfl_xor(v[1], o, 64); v[2] += __shfl_xor(v[2], o, 64); v[3] += __shfl_xor(v[3], o, 64); }
    return v;
}
typedef float f32x16 __attribute__((ext_vector_type(16)));
DI f32x16 zero16() { f32x16 z; for (int i = 0; i < 16; ++i) z[i] = 0.f; return z; }
DI s16x4 tr16(const bf16_t* a) { return __builtin_amdgcn_ds_read_tr16_b64_v4i16((LAS s16x4*)a); }
DI float pos_val(const float* rowtab, const float* coltab, int t, int d) { return d < 512 ? rowtab[(t >> 6) * 512 + d] : coltab[(t & 63) * 512 + (d - 512)]; }

DI void phase_p0(const Params& p, int bid, int nblk, char* lds) {
    const int tid = threadIdx.x;
    float* modx = (float*)(p.ws + OFF_MODX); float* modc = (float*)(p.ws + OFF_MODC);
    float* red = (float*)lds;
    for (int item = bid; item < 96; item += nblk) {
        const int col0 = item * 64, cg = tid & 15, kg = tid >> 4;
        f32x4 ax = {0, 0, 0, 0}, ac = {0, 0, 0, 0};
        for (int kk = 0; kk < 64; ++kk) {
            const int k = kg * 64 + kk;
            const float cv = p.c[k], cc = p.c_ctx[k];
            const float sx = cv * sigmoidf_(cv), sc = cc * sigmoidf_(cc);
            const f32x4 w = *(const f32x4*)(p.w_mod + (size_t)k * 6144 + col0 + cg * 4);
            ax += w * sx; ac += w * sc;
        }
        __syncthreads();
#pragma unroll
        for (int j = 0; j < 4; ++j) { red[(kg * 64 + cg * 4 + j) * 2] = ax[j]; red[(kg * 64 + cg * 4 + j) * 2 + 1] = ac[j]; }
        __syncthreads();
        if (tid < 128) {
            const int col = tid & 63, which = tid >> 6;
            float s = 0.f;
            for (int g = 0; g < 16; ++g) s += red[(g * 64 + col) * 2 + which];
            s += p.b_mod[col0 + col];
            (which ? modc : modx)[col0 + col] = s;
        }
    }
    float* rowtab = (float*)(p.ws + OFF_ROWTAB); float* coltab = (float*)(p.ws + OFF_COLTAB);
    for (int i = bid * 256 + tid; i < (256 + 64) * 256; i += nblk * 256) {
        const int pos = i >> 8, f = i & 255;
        const float freq = powf(10000.f, -(float)f / 256.f);
        if (pos < 256) { const float a = (float)pos * freq; rowtab[pos * 512 + f] = sinf(a); rowtab[pos * 512 + 256 + f] = cosf(a); }
        else { const int cp = pos - 256; const float a = (float)cp * freq; coltab[cp * 512 + f] = sinf(a); coltab[cp * 512 + 256 + f] = cosf(a); }
    }
    if (bid == 0 && tid < 64) ((int*)(p.ws + OFF_CNT))[tid] = 0;
    for (int pass = 0; pass < 2; ++pass) {
        const float* src = pass ? p.w_out : p.w_in; const int nc = pass ? D : DIN; bf16_t* dst = (bf16_t*)(p.ws + (pass ? OFF_WOUTB : OFF_WINB));
        const int n8 = nc >> 3;
        for (int idx = bid * 256 + tid; idx < D * n8; idx += nblk * 256) {
            const int k = idx / n8, g8 = idx - k * n8, blk = g8 >> 2, q = g8 & 3;
            const f32x4 lo = *(const f32x4*)(src + (size_t)k * nc + blk * 32 + 4 * q), hi = *(const f32x4*)(src + (size_t)k * nc + blk * 32 + 16 + 4 * q);
            *(u32x4*)(dst + (size_t)k * nc + blk * 32 + 8 * q) = (u32x4){pack2(lo[0], lo[1]), pack2(lo[2], lo[3]), pack2(hi[0], hi[1]), pack2(hi[2], hi[3])};
        }
    }
}

DI void phase_xn(const Params& p, int bid, int nblk) {
    const int lane = threadIdx.x & 63, wid = threadIdx.x >> 6;
    const float* modx = (const float*)(p.ws + OFF_MODX); const float* modc = (const float*)(p.ws + OFF_MODC);
    const float* rowtab = (const float*)(p.ws + OFF_ROWTAB); const float* coltab = (const float*)(p.ws + OFF_COLTAB);
    bf16_t* xn = (bf16_t*)(p.ws + OFF_XN);
    for (int g = bid * 4 + wid; g < NT; g += nblk * 4) {
        const bool isctx = g < CTX; const int t = g - CTX;
        const float* src = isctx ? p.ctx + (size_t)g * D : p.x + (size_t)t * D;
        const float* md = isctx ? modc : modx;
        f32x4 v[4]; float ss = 0.f;
#pragma unroll
        for (int i = 0; i < 4; ++i) {
            const int d = (i * 64 + lane) * 4;
            v[i] = *(const f32x4*)(src + d);
            if (!isctx) v[i] += *(const f32x4*)(d < 512 ? rowtab + (t >> 6) * 512 + d : coltab + (t & 63) * 512 + (d - 512));
            ss += v[i][0] * v[i][0] + v[i][1] * v[i][1] + v[i][2] * v[i][2] + v[i][3] * v[i][3];
        }
        ss = wave_sum(ss);
        const float rstd = rsqrtf(ss * (1.f / 1024.f) + 1e-6f);
#pragma unroll
        for (int i = 0; i < 4; ++i) {
            const int d = (i * 64 + lane) * 4;
            const f32x4 gg = *(const f32x4*)(p.norm1_g + d), sh = *(const f32x4*)(md + d), sc = *(const f32x4*)(md + 1024 + d);
            f32x4 o;
#pragma unroll
            for (int j = 0; j < 4; ++j) o[j] = (v[i][j] * rstd * gg[j]) * (1.f + sc[j]) + sh[j];
            u32x2 pk = {pack2(o[0], o[1]), pack2(o[2], o[3])};
            *(u32x2*)(xn + (size_t)g * D + d) = pk;
        }
    }
}

constexpr int GA_SZ = 256 * 128, GB_SZ = 18432, GBUF_SZ = GA_SZ + GB_SZ;
constexpr int GEMM_LDS = 3 * GBUF_SZ;
DI void glds16(const void* gsrc, char* ldst) { __builtin_amdgcn_global_load_lds((const unsigned*)gsrc, (LAS unsigned*)ldst, 16, 0, 0); }
template <int NB, bool BGLDS, class AL, class EPI>
DI void gemm256(const AL& al, const void* __restrict__ Bv0, const void* __restrict__ Bv1, int ldb, int K, char* lds, EPI& epi) {
    static_assert(!(BGLDS && NB == 2), "bf16 LDS-DMA path is for a single B");
    constexpr int NBLK = NB == 1 ? 2 : 1;
    constexpr int WN = 32 * NBLK;
    constexpr int BP = NB == 1 ? 136 : 72;
    const int tid = threadIdx.x, lane = tid & 63, wid = tid >> 6, wr = wid >> 1, wc = wid & 1, r32 = lane & 31, hh = lane >> 5, gi = lane >> 4, i16 = lane & 15;
    const float* B0 = (const float*)Bv0; const float* B1 = (const float*)Bv1; const bf16_t* Bb = (const bf16_t*)Bv0;
    f32x16 acc0[4][NBLK], acc1[4][NBLK];
#pragma unroll
    for (int m = 0; m < 4; ++m)
#pragma unroll
        for (int n = 0; n < NBLK; ++n) { acc0[m][n] = zero16(); acc1[m][n] = zero16(); }
    f32x4 rb0[NB == 1 ? 8 : 4], rb1[4];
    const int T = K >> 6;
    const bf16_t* arow[8];
#pragma unroll
    for (int i = 0; i < 8; ++i) { const int row = (4 * i + wid) * 8 + (lane >> 3); arow[i] = al.rowptr(i, row) + (((lane & 7) ^ ((row >> 1) & 7)) << 3); }
    int bsrc[4];
#pragma unroll
    for (int i = 0; i < 4; ++i) { const int k = (4 * i + wid) * 4 + (lane >> 4), p16 = lane & 15; bsrc[i] = k * ldb + ((((p16 >> 1) ^ (k & 7)) << 1) + (p16 & 1)) * 8; }
    const int a_base = (wr * 128 + r32) * 128, a_sw = (r32 >> 1) & 7;
    const int b_off = (8 * (gi >> 1) + (i16 >> 2)) * BP + wc * WN + 16 * (gi & 1) + 4 * (i16 & 3);
#define G_DMA(buf, t_) do { char* dA_ = lds + (buf) * GBUF_SZ + wid * 1024 + lane * 16; \
        _Pragma("unroll") for (int i = 0; i < 8; ++i) glds16(arow[i] + (t_) * 64, dA_ + i * 4096); \
        if (BGLDS) { char* dB_ = lds + (buf) * GBUF_SZ + GA_SZ + wid * 1024 + lane * 16; \
            _Pragma("unroll") for (int i = 0; i < 4; ++i) glds16(Bb + (size_t)(t_) * 64 * ldb + bsrc[i], dB_ + i * 4096); } } while (0)
#define G_LOADB(t_) do { const int k0_ = (t_) * 64; \
        if (NB == 1) { _Pragma("unroll") for (int i = 0; i < 8; ++i) { const int c = tid + 256 * i, kr = c >> 5, n4 = c & 31; rb0[i] = *(const f32x4*)(B0 + (size_t)(k0_ + kr) * ldb + n4 * 4); } } \
        else { _Pragma("unroll") for (int i = 0; i < 4; ++i) { const int c = tid + 256 * i, kr = c >> 4, n4 = c & 15; rb0[i] = *(const f32x4*)(B0 + (size_t)(k0_ + kr) * ldb + n4 * 4); rb1[i] = *(const f32x4*)(B1 + (size_t)(k0_ + kr) * ldb + n4 * 4); } } } while (0)
#define G_WRITEB(buf) do { bf16_t* sB0_ = (bf16_t*)(lds + (buf) * GBUF_SZ + GA_SZ); bf16_t* sB1_ = sB0_ + 64 * 72; \
        if (NB == 1) { _Pragma("unroll") for (int i = 0; i < 8; ++i) { const int c = tid + 256 * i, kr = c >> 5, n4 = c & 31, slot = (n4 >> 3) * 32 + 8 * (n4 & 3) + 4 * ((n4 >> 2) & 1); \
            u32x2 pk = {pack2(rb0[i][0], rb0[i][1]), pack2(rb0[i][2], rb0[i][3])}; *(u32x2*)(sB0_ + kr * BP + slot) = pk; } } \
        else { _Pragma("unroll") for (int i = 0; i < 4; ++i) { const int c = tid + 256 * i, kr = c >> 4, n4 = c & 15, slot = (n4 >> 3) * 32 + 8 * (n4 & 3) + 4 * ((n4 >> 2) & 1); \
            u32x2 pk = {pack2(rb0[i][0], rb0[i][1]), pack2(rb0[i][2], rb0[i][3])}; *(u32x2*)(sB0_ + kr * BP + slot) = pk; \
            u32x2 pk1 = {pack2(rb1[i][0], rb1[i][1]), pack2(rb1[i][2], rb1[i][3])}; *(u32x2*)(sB1_ + kr * BP + slot) = pk1; } } } while (0)
#define G_READ(buf, kh, AF, BF0, BF1) do { const char* sA_ = lds + (buf) * GBUF_SZ; const bf16_t* sB0_ = (const bf16_t*)(lds + (buf) * GBUF_SZ + GA_SZ); const bf16_t* sB1_ = sB0_ + 64 * 72; \
        _Pragma("unroll") for (int ks = 0; ks < 2; ++ks) { const int k0_ = (kh) * 32 + ks * 16; \
            _Pragma("unroll") for (int n = 0; n < NBLK; ++n) { \
                if (BGLDS) { const int kk_ = k0_ + 8 * (gi >> 1) + (i16 >> 2), gr_ = (wc * WN + n * 32) / 16 + (gi & 1); \
                    const char* q0_ = (const char*)sB0_ + kk_ * 256 + ((gr_ ^ (kk_ & 7)) << 5) + 8 * (i16 & 3); const char* q1_ = (const char*)sB0_ + (kk_ + 4) * 256 + ((gr_ ^ ((kk_ + 4) & 7)) << 5) + 8 * (i16 & 3); \
                    s16x4 lo = tr16((const bf16_t*)q0_), hi = tr16((const bf16_t*)q1_); BF0[ks][n] = __builtin_shufflevector(lo, hi, 0, 1, 2, 3, 4, 5, 6, 7); } \
                else { const int off = b_off + k0_ * BP + n * 32; \
                    s16x4 lo = tr16(sB0_ + off), hi = tr16(sB0_ + off + 4 * BP); BF0[ks][n] = __builtin_shufflevector(lo, hi, 0, 1, 2, 3, 4, 5, 6, 7); \
                    if (NB == 2) { s16x4 lo1 = tr16(sB1_ + off), hi1 = tr16(sB1_ + off + 4 * BP); BF1[ks][n] = __builtin_shufflevector(lo1, hi1, 0, 1, 2, 3, 4, 5, 6, 7); } } } \
            _Pragma("unroll") for (int m = 0; m < 4; ++m) AF[ks][m] = *(const bf16x8*)(sA_ + a_base + m * 4096 + ((((kh) * 4 + ks * 2 + hh) ^ a_sw) << 4)); } } while (0)
#define G_MFMA(AF, BF0, BF1) do { \
        _Pragma("unroll") for (int ks = 0; ks < 2; ++ks) _Pragma("unroll") for (int m = 0; m < 4; ++m) _Pragma("unroll") for (int n = 0; n < NBLK; ++n) { \
            acc0[m][n] = __builtin_amdgcn_mfma_f32_32x32x16_bf16(BF0[ks][n], AF[ks][m], acc0[m][n], 0, 0, 0); \
            if (NB == 2) acc1[m][n] = __builtin_amdgcn_mfma_f32_32x32x16_bf16(BF1[ks][n], AF[ks][m], acc1[m][n], 0, 0, 0); } } while (0)
    bf16x8 afA[2][4], bfA0[2][NBLK], bfA1[2][NBLK], afB[2][4], bfB0[2][NBLK], bfB1[2][NBLK];
    if (BGLDS) {
        G_DMA(0, 0);
        if (T > 1) G_DMA(1, 1);
        int b0 = 0, b1 = 1, b2 = 2;
#pragma unroll 1
        for (int t = 0; t < T; ++t) {
            if (t + 1 < T) asm volatile("s_waitcnt vmcnt(12)" ::: "memory"); else asm volatile("s_waitcnt vmcnt(0)" ::: "memory");
            __builtin_amdgcn_s_barrier();
            __builtin_amdgcn_sched_barrier(0);
            if (t + 2 < T) G_DMA(b2, t + 2);
            G_READ(b0, 0, afA, bfA0, bfA1);
            __builtin_amdgcn_sched_barrier(0);
            G_MFMA(afA, bfA0, bfA1);
            G_READ(b0, 1, afB, bfB0, bfB1);
#pragma unroll
            for (int i = 0; i < 16; ++i) { __builtin_amdgcn_sched_group_barrier(0x008, 1, 0); __builtin_amdgcn_sched_group_barrier(0x100, 1, 0); }
            __builtin_amdgcn_sched_barrier(0);
            G_MFMA(afB, bfB0, bfB1);
            __builtin_amdgcn_sched_barrier(0);
            const int tb = b0; b0 = b1; b1 = b2; b2 = tb;
        }
    } else {
    G_DMA(0, 0);
    G_LOADB(0); G_WRITEB(0);
#pragma unroll 1
    for (int t = 0; t < T; ++t) {
        const int buf = t & 1;
        asm volatile("s_waitcnt vmcnt(0)" ::: "memory");
        __syncthreads();
        if (t + 1 < T) { G_DMA(buf ^ 1, t + 1); G_LOADB(t + 1); }
        G_READ(buf, 0, afA, bfA0, bfA1);
        __builtin_amdgcn_sched_barrier(0);
        G_MFMA(afA, bfA0, bfA1);
        G_READ(buf, 1, afB, bfB0, bfB1);
#pragma unroll
        for (int i = 0; i < 16; ++i) { __builtin_amdgcn_sched_group_barrier(0x008, 1, 0); __builtin_amdgcn_sched_group_barrier(0x100, 1, 0); }
        __builtin_amdgcn_sched_barrier(0);
        G_MFMA(afB, bfB0, bfB1);
        G_WRITEB(buf ^ 1);
#pragma unroll
        for (int i = 0; i < 16; ++i) { __builtin_amdgcn_sched_group_barrier(0x008, 1, 0); __builtin_amdgcn_sched_group_barrier(0x002, 4, 0); __builtin_amdgcn_sched_group_barrier(0x200, 1, 0); }
        __builtin_amdgcn_sched_barrier(0);
    }
    }
#undef G_DMA
#undef G_LOADB
#undef G_WRITEB
#undef G_READ
#undef G_MFMA
#pragma unroll
    for (int m = 0; m < 4; ++m)
#pragma unroll
        for (int n = 0; n < NBLK; ++n) epi(wr * 128 + m * 32 + r32, wc * WN + n * 32 + 16 * hh, acc0[m][n], acc1[m][n]);
    __syncthreads();
}

struct PlainA {
    const bf16_t* base; int lda;
    DI const bf16_t* rowptr(int, int row) const { return base + (size_t)row * lda; }
};
struct GatherA {
    const bf16_t* rp[8];
    DI const bf16_t* rowptr(int i, int) const { return rp[i]; }
};

struct XcdOrder {
    int base, lim, j, bpx;
    DI XcdOrder(int bid, int nblk, int total) {
        if ((nblk & 7) == 0) { const int x = bid & 7, per = (total + 7) >> 3; bpx = nblk >> 3; j = bid >> 3; base = x * per; lim = base + per < total ? base + per : total; }
        else { bpx = nblk; j = bid; base = 0; lim = total; }
    }
    DI int item(int i) const { const int q = base + i * bpx + j; return q < lim ? q : -1; }
};
DI void tile_rc(int q, int nrow, int ncol, int& r, int& c) {
    const int per_sr = 8 * ncol, sr = q / per_sr, rem = q - sr * per_sr, rows = (nrow - sr * 8) < 8 ? (nrow - sr * 8) : 8;
    c = rem / rows; r = sr * 8 + rem - c * rows;
}

DI u32x4 pack8v(const f32x4& a, const f32x4& b) { return (u32x4){pack2(a[0], a[1]), pack2(a[2], a[3]), pack2(b[0], b[1]), pack2(b[2], b[3])}; }
DI u32x4 pack8q(const f32x16& a, int q) { return (u32x4){pack2(a[8 * q], a[8 * q + 1]), pack2(a[8 * q + 2], a[8 * q + 3]), pack2(a[8 * q + 4], a[8 * q + 5]), pack2(a[8 * q + 6], a[8 * q + 7])}; }
struct EpiStoreBf16 { bf16_t* o; int ldo; DI void operator()(int r, int c, const f32x16& a, const f32x16&) const { *(u32x4*)(o + (size_t)r * ldo + c) = pack8q(a, 0); *(u32x4*)(o + (size_t)r * ldo + c + 8) = pack8q(a, 1); } };
DI void phase_mfma_rate(const Params& p, int n_mfma) {
    f32x4 acc[32];
#pragma unroll
    for (int i = 0; i < 32; ++i) acc[i] = (f32x4){0, 0, 0, 0};
    bf16x8 a = __builtin_bit_cast(bf16x8, *(const u32x4*)(p.ws + OFF_XN + threadIdx.x * 16)), b = __builtin_bit_cast(bf16x8, *(const u32x4*)(p.ws + OFF_XN + 8192 + threadIdx.x * 16));
#pragma unroll 1
    for (int it = 0; it < n_mfma; it += 32) {
#pragma unroll
        for (int i = 0; i < 32; ++i) acc[i] = __builtin_amdgcn_mfma_f32_16x16x32_bf16(a, b, acc[i], 0, 0, 0);
    }
    f32x4 sacc = acc[0];
#pragma unroll
    for (int i = 1; i < 32; ++i) sacc += acc[i];
    asm volatile("" :: "v"(sacc));
}
DI void phase_mfma_rate32(const Params& p, int n_mfma) {
    f32x16 acc[8];
#pragma unroll
    for (int i = 0; i < 8; ++i) acc[i] = zero16();
    bf16x8 a = __builtin_bit_cast(bf16x8, *(const u32x4*)(p.ws + OFF_XN + threadIdx.x * 16)), b = __builtin_bit_cast(bf16x8, *(const u32x4*)(p.ws + OFF_XN + 8192 + threadIdx.x * 16));
#pragma unroll 1
    for (int it = 0; it < n_mfma; it += 8) {
#pragma unroll
        for (int i = 0; i < 8; ++i) acc[i] = __builtin_amdgcn_mfma_f32_32x32x16_bf16(a, b, acc[i], 0, 0, 0);
    }
    f32x16 sacc = acc[0];
#pragma unroll
    for (int i = 1; i < 8; ++i) sacc += acc[i];
    asm volatile("" :: "v"(sacc));
}
DI void phase_g1(const Params& p, int bid, int nblk, char* lds) {
    const bf16_t* xn = (const bf16_t*)(p.ws + OFF_XN); bf16_t* u = (bf16_t*)(p.ws + OFF_U);
    const XcdOrder ord(bid, nblk, 65 * 19);
    for (int i = 0, q; (q = ord.item(i)) >= 0; ++i) {
        int tm, tn; tile_rc(q, 65, 19, tm, tn);
        PlainA al{xn + (size_t)tm * 256 * D, D};
        EpiStoreBf16 epi{u + (size_t)tm * 256 * DIN + tn * 128, DIN};
        gemm256<1, true>(al, (const bf16_t*)(p.ws + OFF_WINB) + tn * 128, nullptr, DIN, D, lds, epi);
    }
}

DI void phase_pool(const Params& p, int bid, int nblk) {
    const bf16_t* u = (const bf16_t*)(p.ws + OFF_U) + (size_t)CTX * DIN + C_POOL;
    bf16_t* mix = (bf16_t*)(p.ws + OFF_MIX);
    for (int item = bid * 256 + threadIdx.x; item < (S / 16) * 64; item += nblk * 256) {
        const int cg = item & 63, run = item >> 6, t0 = run * 16, gi = cg >> 4, win = 2 << gi, hw = win >> 1;
        const bf16_t* uc = u + cg * 8;
        float sum[8];
#pragma unroll
        for (int j = 0; j < 8; ++j) sum[j] = 0.f;
        int lo = t0 - hw, hi = t0 - hw + win; lo = lo < 0 ? 0 : lo; hi = hi > S ? S : hi;
        for (int tt = lo; tt < hi; ++tt) { float q[8]; unpack8(*(const u32x4*)(uc + (size_t)tt * DIN), q);
#pragma unroll
            for (int j = 0; j < 8; ++j) sum[j] += q[j]; }
        for (int k = 0; k < 16; ++k) {
            const int t = t0 + k;
            float cv[8], o[8]; unpack8(*(const u32x4*)(uc + (size_t)t * DIN), cv);
            const float inv = 1.f / (float)(hi - lo);
#pragma unroll
            for (int j = 0; j < 8; ++j) o[j] = sum[j] * inv - cv[j];
            *(u32x4*)(mix + (size_t)t * D + cg * 8) = pack8(o);
            const int nlo = t + 1 - hw, nhi = t + 1 - hw + win;
            if (nhi <= S) { float q[8]; unpack8(*(const u32x4*)(uc + (size_t)(nhi - 1) * DIN), q);
#pragma unroll
                for (int j = 0; j < 8; ++j) sum[j] += q[j]; hi = nhi; }
            if (nlo > 0) { float q[8]; unpack8(*(const u32x4*)(uc + (size_t)(nlo - 1) * DIN), q);
#pragma unroll
                for (int j = 0; j < 8; ++j) sum[j] -= q[j]; lo = nlo; }
        }
    }
}
struct EpiPool { bf16_t* o; const float* sc; DI void operator()(int r, int c, const f32x16& a, const f32x16&) const {
    f32x16 v = a;
#pragma unroll
    for (int q = 0; q < 4; ++q) { const f32x4 s4 = *(const f32x4*)(sc + c + 4 * q); v[4 * q] *= s4[0]; v[4 * q + 1] *= s4[1]; v[4 * q + 2] *= s4[2]; v[4 * q + 3] *= s4[3]; }
    *(u32x4*)(o + (size_t)r * D + c) = pack8q(v, 0); *(u32x4*)(o + (size_t)r * D + c + 8) = pack8q(v, 1); } };
DI void phase_poolgemm(const Params& p, int bid, int nblk, char* lds) {
    if (nblk <= 0) return;
    for (int it = bid; it < 4 * 64; it += nblk) {
        const int gi = it >> 6, tm = it & 63;
        const bf16_t* mix = (const bf16_t*)(p.ws + OFF_MIX);
        PlainA al{mix + (size_t)tm * 256 * D + gi * 128, D};
        EpiPool e{(bf16_t*)(p.ws + OFF_MIX) + (size_t)tm * 256 * D + 512 + gi * 128, p.pool_scale + gi * 128};
        int kk = 128; asm volatile("" : "+s"(kk));
        gemm256<1, false>(al, p.w_pool + (size_t)gi * 128 * 128, nullptr, 128, kk, lds, e);
    }
}

constexpr int MP = 72, MSZ = 64 * MP;
constexpr int FP = 68;
constexpr int SCANA_LDS = 14 * MSZ * 2 + 2048;
template <bool KS> DI bf16x8 frag32(const bf16_t* base, int x0, int s, int lane) {
    if (!KS) return *(const bf16x8*)(base + (x0 + (lane & 31)) * MP + 16 * s + 8 * (lane >> 5));
    const int gi = lane >> 4, i = lane & 15;
    const bf16_t* a = base + (16 * s + 8 * (gi >> 1) + (i >> 2)) * MP + x0 + 16 * (gi & 1) + 4 * (i & 3);
    s16x4 lo = tr16(a), hi = tr16(a + 4 * MP);
    return __builtin_shufflevector(lo, hi, 0, 1, 2, 3, 4, 5, 6, 7);
}
template <bool XKS, bool YKS> DI f32x16 mm32(const bf16_t* X, int x0, const bf16_t* Y, int y0, f32x16 acc, int lane) {
#pragma unroll
    for (int s = 0; s < 4; ++s) acc = __builtin_amdgcn_mfma_f32_32x32x16_bf16(frag32<XKS>(X, x0, s, lane), frag32<YKS>(Y, y0, s, lane), acc, 0, 0, 0);
    return acc;
}
template <class F> DI void store_acc(bf16_t* out, int x0, int y0, const f32x16& acc, int lane, F f) {
    const int y = y0 + (lane & 31), hh = lane >> 5;
#pragma unroll
    for (int q = 0; q < 4; ++q) {
        const int x = x0 + 8 * q + 4 * hh;
        u32x2 pk = {pack2(f(acc[4 * q], x, y), f(acc[4 * q + 1], x + 1, y)), pack2(f(acc[4 * q + 2], x + 2, y), f(acc[4 * q + 3], x + 3, y))};
        *(u32x2*)(out + y * MP + x) = pk;
    }
}
DI unsigned rot16(unsigned x) { return (x >> 16) | (x << 16); }

DI int chain_pos(int c, int dir) { return dir == 0 ? c : (c < 4 ? 3 - c : NCH + 3 - c); }

template <int STOP = 0> DI void phase_scanA(const Params& p, int bid, int nblk, char* lds) {
    const int tid = threadIdx.x, lane = tid & 63, w = tid >> 6, xq = 32 * (w & 1), yq = 32 * (w >> 1);
    bf16_t* M = (bf16_t*)lds;
    bf16_t *sAT = M, *sBT = M + MSZ, *sKT = M + 2 * MSZ, *sRT = M + 3 * MSZ, *sVT = M + 4 * MSZ;
    float* fGC = (float*)(lds + 14 * MSZ * 2);
    float* fSeg = fGC + 64;
    float* fLogw = (float*)(M + 12 * MSZ);
    float* fA = (float*)(M + 10 * MSZ);
    const bf16_t* u = (const bf16_t*)(p.ws + OFF_U);
    for (int inst = bid; inst < NCH * 16; inst += nblk) {
        const int c = inst >> 4, h = (inst >> 1) & 7, dir = inst & 1;
        const bool latent = c >= 4, want_g = latent && dir == 0;
        const float* w2 = dir ? p.w2_b : p.w2_f; const float* a2 = dir ? p.a2_b : p.a2_f;
        const float* w0 = dir ? p.w0_b : p.w0_f; const float* a0 = dir ? p.a0_b : p.a0_f;
        const float* rkd = dir ? p.r_k_b : p.r_k_f;
        const int cwl = dir ? C_WLB : C_WLF, cal = dir ? C_ALB : C_ALF;
        const int ch = tid & 7;
        float fr_[2][8], fk_[2][8], fv_[2][8];
        const int cols5[5] = {h * 64 + ch * 8, 512 + h * 64 + ch * 8, 1024 + h * 64 + ch * 8, cwl + ch * 8, cal + ch * 8};
        auto shift8 = [&](const u32x4* r3, int col, float mp, float mn, float* o) {
            float cc[8], pv[8], nx[8];
            unpack8(r3[0], cc); unpack8(r3[1], pv); unpack8(r3[2], nx);
            const f32x4 m0 = *(const f32x4*)(p.mu + col), m1 = *(const f32x4*)(p.mu + col + 4);
#pragma unroll
            for (int j = 0; j < 8; ++j) { const float m = j < 4 ? m0[j & 3] : m1[j & 3]; o[j] = cc[j] + m * ((mp * pv[j] + mn * nx[j]) - cc[j]); }
        };
#pragma unroll
        for (int i = 0; i < 2; ++i) {
            const int tau = (tid >> 3) + 32 * i, g = dir ? c * 64 + 63 - tau : c * 64 + tau;
            const bool hasp = (g != 0) && (g != CTX), hasn = (g != CTX - 1) && (g != NT - 1);
            const float mp = hasp ? 0.5f : 0.f, mn = hasn ? 0.5f : 0.f;
            const bf16_t* rc = u + (size_t)g * DIN; const bf16_t* rp = hasp ? rc - DIN : rc; const bf16_t* rn = hasn ? rc + DIN : rc;
            u32x4 raw[5][3], rawg[2][3]; f32x4 wl[8];
#pragma unroll
            for (int q = 0; q < 5; ++q) { raw[q][0] = *(const u32x4*)(rc + cols5[q]); raw[q][1] = *(const u32x4*)(rp + cols5[q]); raw[q][2] = *(const u32x4*)(rn + cols5[q]); }
            if (want_g) {
#pragma unroll
                for (int half = 0; half < 2; ++half) { const int col = C_GL + half * 64 + ch * 8;
                    rawg[half][0] = *(const u32x4*)(rc + col); rawg[half][1] = *(const u32x4*)(rp + col); rawg[half][2] = *(const u32x4*)(rn + col); }
            }
            if (i == 0) {
#pragma unroll
                for (int q = 0; q < 4; ++q) { const int idx = tid + 256 * q, kr = idx >> 4, n4 = idx & 15;
                    wl[q] = *(const f32x4*)(w2 + (size_t)kr * DR + h * 64 + n4 * 4); wl[4 + q] = *(const f32x4*)(a2 + (size_t)kr * DR + h * 64 + n4 * 4); }
            } else if (want_g) {
#pragma unroll
                for (int q = 0; q < 8; ++q) { const int idx = tid + 256 * q, kr = idx >> 4, n4 = idx & 15; wl[q] = *(const f32x4*)(p.g2 + (size_t)kr * DR + h * 64 + n4 * 4); }
            }
            shift8(raw[0], cols5[0], mp, mn, fr_[i]); shift8(raw[1], cols5[1], mp, mn, fk_[i]); shift8(raw[2], cols5[2], mp, mn, fv_[i]);
            float t8[8];
            shift8(raw[3], cols5[3], mp, mn, t8);
#pragma unroll
            for (int j = 0; j < 8; ++j) { const float e2 = __expf(2.f * t8[j]); t8[j] = 1.f - __fdividef(2.f, e2 + 1.f); }
            *(u32x4*)(M + 5 * MSZ + tau * MP + ch * 8) = pack8(t8);
            shift8(raw[4], cols5[4], mp, mn, t8);
            *(u32x4*)(M + 6 * MSZ + tau * MP + ch * 8) = pack8(t8);
            if (want_g) {
#pragma unroll
                for (int half = 0; half < 2; ++half) {
                    shift8(rawg[half], C_GL + half * 64 + ch * 8, mp, mn, t8);
#pragma unroll
                    for (int j = 0; j < 8; ++j) t8[j] = sigmoidf_(t8[j]);
                    *(u32x4*)(M + half * MSZ + tau * MP + ch * 8) = pack8(t8);
                }
            }
            if (i == 0) {
#pragma unroll
                for (int q = 0; q < 4; ++q) { const int idx = tid + 256 * q, kr = idx >> 4, n4 = idx & 15;
                    u32x2 pa = {pack2(wl[q][0], wl[q][1]), pack2(wl[q][2], wl[q][3])}, pb = {pack2(wl[4 + q][0], wl[4 + q][1]), pack2(wl[4 + q][2], wl[4 + q][3])};
                    *(u32x2*)(M + 7 * MSZ + kr * MP + n4 * 4) = pa; *(u32x2*)(M + 8 * MSZ + kr * MP + n4 * 4) = pb; }
            } else if (want_g) {
#pragma unroll
                for (int q = 0; q < 8; ++q) { const int idx = tid + 256 * q, kr = idx >> 4, n4 = idx & 15;
                    u32x2 pa = {pack2(wl[q][0], wl[q][1]), pack2(wl[q][2], wl[q][3])};
                    *(u32x2*)(M + (2 + (kr >> 6)) * MSZ + (kr & 63) * MP + n4 * 4) = pa; }
            }
        }
        __syncthreads();
        {
            f32x16 accW = mm32<true, false>(M + 7 * MSZ, xq, M + 5 * MSZ, yq, zero16(), lane);
            f32x16 accA = mm32<true, false>(M + 8 * MSZ, xq, M + 6 * MSZ, yq, zero16(), lane);
            const int y = yq + (lane & 31), hh = lane >> 5;
#pragma unroll
            for (int q = 0; q < 4; ++q) {
                const int x = xq + 8 * q + 4 * hh;
                f32x4 lw, av; const f32x4 w0v = *(const f32x4*)(w0 + h * 64 + x), a0v = *(const f32x4*)(a0 + h * 64 + x);
#pragma unroll
                for (int e = 0; e < 4; ++e) { lw[e] = -DECAY_SCALE * sigmoidf_(w0v[e] + accW[4 * q + e]); av[e] = sigmoidf_(a0v[e] + accA[4 * q + e]); }
                *(f32x4*)(fLogw + y * FP + x) = lw; *(f32x4*)(fA + y * FP + x) = av;
            }
        }
        if (want_g) {
            f32x16 accG = mm32<true, false>(M + 2 * MSZ, xq, M, yq, zero16(), lane);
            accG = mm32<true, false>(M + 3 * MSZ, xq, M + MSZ, yq, accG, lane);
            const int y = yq + (lane & 31), hh = lane >> 5, t = c * 64 + y - CTX;
#pragma unroll
            for (int q = 0; q < 4; ++q) {
                const int x = xq + 8 * q + 4 * hh;
                u32x2 pk = {pack2(accG[4 * q], accG[4 * q + 1]), pack2(accG[4 * q + 2], accG[4 * q + 3])};
                *(u32x2*)((bf16_t*)(p.ws + OFF_G) + (size_t)t * DR + h * 64 + x) = pk;
            }
        }
        __syncthreads();
        {
            const int n = tid & 63, qq = tid >> 6; float run = 0.f;
            for (int t = 16 * qq; t < 16 * qq + 16; ++t) { run += fLogw[t * FP + n]; fLogw[t * FP + n] = run; }
            fSeg[qq * 64 + n] = run;
        }
        __syncthreads();
        {
            const int n = tid & 63, qq = tid >> 6; float off = 0.f;
            for (int q2 = 0; q2 < qq; ++q2) off += fSeg[q2 * 64 + n];
            if (qq) for (int t = 16 * qq; t < 16 * qq + 16; ++t) fLogw[t * FP + n] += off;
        }
        __syncthreads();
#pragma unroll
        for (int i = 0; i < 2; ++i) {
            const int tau = (tid >> 3) + 32 * i, g = dir ? c * 64 + 63 - tau : c * 64 + tau;
            float oa[8], ob[8], ok[8], orr[8], kkv[8], kd[8];
            float ss = 0.f, dsum = 0.f;
            const int c8 = h * 64 + ch * 8;
            float kkp[8], kap[8], rkp[8];
            { const f32x4 a0_ = *(const f32x4*)(p.k_k + c8), a1_ = *(const f32x4*)(p.k_k + c8 + 4), b0_ = *(const f32x4*)(p.k_a + c8), b1_ = *(const f32x4*)(p.k_a + c8 + 4), c0_ = *(const f32x4*)(rkd + c8), c1_ = *(const f32x4*)(rkd + c8 + 4);
#pragma unroll
              for (int j = 0; j < 4; ++j) { kkp[j] = a0_[j]; kkp[4 + j] = a1_[j]; kap[j] = b0_[j]; kap[4 + j] = b1_[j]; rkp[j] = c0_[j]; rkp[4 + j] = c1_[j]; } }
#pragma unroll
            for (int j = 0; j < 8; ++j) { kkv[j] = fk_[i][j] * kkp[j]; ss += kkv[j] * kkv[j]; }
            ss += __shfl_xor(ss, 1, 64); ss += __shfl_xor(ss, 2, 64); ss += __shfl_xor(ss, 4, 64);
            const float inv = 1.f / fmaxf(sqrtf(ss), 1e-12f);
#pragma unroll
            for (int j = 0; j < 8; ++j) {
                const int jj = ch * 8 + j;
                const float cum = fLogw[tau * FP + jj], cprev = tau ? fLogw[(tau - 1) * FP + jj] : 0.f, av = fA[tau * FP + jj];
                const float gam = __expf(cum), gprev = __expf(cprev), ginv = __expf(-cum);
                const float kkn = kkv[j] * inv;
                kd[j] = fk_[i][j] * (1.f + (av - 1.f) * kap[j]);
                oa[j] = -kkn * gprev; ob[j] = kkn * av * ginv; ok[j] = kd[j] * ginv; orr[j] = fr_[i][j] * gam;
                dsum += fr_[i][j] * kd[j] * rkp[j];
                if (tau == 63) fGC[jj] = gam;
            }
            dsum += __shfl_xor(dsum, 1, 64); dsum += __shfl_xor(dsum, 2, 64); dsum += __shfl_xor(dsum, 4, 64);
            if (ch == 0) ((float*)(p.ws + OFF_DOT))[((size_t)g * 8 + h) * 2 + dir] = dsum;
            *(u32x4*)(sAT + tau * MP + ch * 8) = pack8(oa); *(u32x4*)(sBT + tau * MP + ch * 8) = pack8(ob);
            *(u32x4*)(sKT + tau * MP + ch * 8) = pack8(ok); *(u32x4*)(sRT + tau * MP + ch * 8) = pack8(orr);
            const u32x4 pv8 = pack8(fv_[i]);
            *(u32x4*)(sVT + tau * MP + ch * 8) = pv8;
            if (want_g) *(u32x4*)((bf16_t*)(p.ws + OFF_V) + (size_t)(g - CTX) * DR + h * 64 + ch * 8) = pv8;
        }
        __syncthreads();
        if (STOP == 1) continue;
        {
            f32x16 acc = mm32<false, false>(sAT, xq, sBT, yq, zero16(), lane);
            store_acc(M + 5 * MSZ, xq, yq, acc, lane, [](float v, int x, int y) { return y < x ? v : 0.f; });
            store_acc(M + 7 * MSZ, xq, yq, acc, lane, [](float v, int x, int y) { return y < x ? v : (y == x ? 1.f : 0.f); });
            acc = mm32<false, false>(sAT, xq, sKT, yq, zero16(), lane);
            store_acc(M + 9 * MSZ, xq, yq, acc, lane, [](float v, int x, int y) { return y < x ? v : 0.f; });
            acc = mm32<false, false>(sRT, xq, sBT, yq, zero16(), lane);
            store_acc(M + 10 * MSZ, xq, yq, acc, lane, [](float v, int x, int y) { return y <= x ? v : 0.f; });
            acc = mm32<false, false>(sRT, xq, sKT, yq, zero16(), lane);
            store_acc(M + 11 * MSZ, xq, yq, acc, lane, [](float v, int x, int y) { return y <= x ? v : 0.f; });
        }
        __syncthreads();
        int xs = 5, xo = 6, ts = 7, to = 8;
        {
            f32x16 acc = mm32<true, false>(M + xs * MSZ, xq, M + xs * MSZ, yq, zero16(), lane);
            store_acc(M + xo * MSZ, xq, yq, acc, lane, [](float v, int, int) { return v; });
            int t_ = xs; xs = xo; xo = t_;
        }
        __syncthreads();
        for (int k = 0; k < 5; ++k) {
            const bf16_t* Told = M + ts * MSZ;
            f32x16 acc = mm32<true, false>(M + xs * MSZ, xq, Told, yq, zero16(), lane);
            store_acc(M + to * MSZ, xq, yq, acc, lane, [Told](float v, int x, int y) { return v + bf2f(Told[y * MP + x]); });
            if (k < 4) {
                acc = mm32<true, false>(M + xs * MSZ, xq, M + xs * MSZ, yq, zero16(), lane);
                store_acc(M + xo * MSZ, xq, yq, acc, lane, [](float v, int, int) { return v; });
            }
            int t_ = xs; xs = xo; xo = t_; t_ = ts; ts = to; to = t_;
            __syncthreads();
        }
        if (STOP == 2) continue;
        const bf16_t* sT = M + ts * MSZ;
        {
            f32x16 acc = mm32<true, true>(sT, xq, sAT, yq, zero16(), lane);
            store_acc(M + 12 * MSZ, xq, yq, acc, lane, [](float v, int, int) { return v; });
            acc = mm32<true, false>(sT, xq, M + 9 * MSZ, yq, zero16(), lane);
            store_acc(M + 13 * MSZ, xq, yq, acc, lane, [](float v, int, int) { return v; });
        }
        __syncthreads();
        {
            const bf16_t *sAbar = M + 12 * MSZ, *sG = M + 13 * MSZ, *sABR = M + 10 * MSZ, *sAKR = M + 11 * MSZ;
            f32x16 acc = mm32<false, true>(sAbar, xq, sBT, yq, zero16(), lane);
            store_acc(M + 5 * MSZ, xq, yq, acc, lane, [fGC](float v, int x, int y) { return ((x == y ? 1.f : 0.f) + v) * fGC[y]; });
            acc = mm32<false, true>(sAbar, xq, sABR, yq, zero16(), lane);
            store_acc(M + 6 * MSZ, xq, yq, acc, lane, [sRT](float v, int x, int y) { return v + bf2f(sRT[y * MP + x]); });
            acc = mm32<true, false>(sBT, xq, sG, yq, zero16(), lane);
            store_acc(M + 7 * MSZ, xq, yq, acc, lane, [sKT, fGC](float v, int x, int y) { return (v + bf2f(sKT[y * MP + x])) * fGC[x]; });
            acc = mm32<true, false>(sABR, xq, sG, yq, zero16(), lane);
            store_acc(M + 9 * MSZ, xq, yq, acc, lane, [sAKR](float v, int x, int y) { return v + bf2f(sAKR[y * MP + x]); });
        }
        __syncthreads();
        const int chain = dir * 8 + h, npos = chain_pos(c, dir);
        {
            u32x4* Pg = (u32x4*)(p.ws + OFF_P) + ((size_t)chain * NCH + npos) * 512;
#pragma unroll
            for (int i = 0; i < 2; ++i) {
                const int item = tid + 256 * i, ln = item & 63, as = item >> 6, a = as >> 1, s2 = as & 1, fr = ln & 15, fq = ln >> 4;
                const bf16_t* src = M + 5 * MSZ + (16 * a + fr) * MP + 32 * s2 + 4 * fq;
                const u32x2 lo = *(const u32x2*)src, hi = *(const u32x2*)(src + 16);
                Pg[as * 64 + ln] = (u32x4){lo.x, lo.y, hi.x, hi.y};
            }
            if (latent) {
                u32x4* Wg = (u32x4*)(p.ws + OFF_WYT) + ((size_t)((c - 4) * 8 + h) * 2 + dir) * 512;
#pragma unroll
                for (int i = 0; i < 2; ++i) { const int item = tid + 256 * i, row = item >> 3, ck = item & 7; Wg[item] = *(const u32x4*)(M + 6 * MSZ + row * MP + ck * 8); }
            }
        }
        {
            f32x16 acc = mm32<true, true>(M + 7 * MSZ, xq, sVT, yq, zero16(), lane);
            store_acc(M + 12 * MSZ, xq, yq, acc, lane, [](float v, int, int) { return v; });
            acc = mm32<true, true>(M + 9 * MSZ, xq, sVT, yq, zero16(), lane);
            store_acc(M + 13 * MSZ, xq, yq, acc, lane, [](float v, int, int) { return v; });
        }
        __syncthreads();
        {
            u32x2* Qg = (u32x2*)(p.ws + OFF_Q) + ((size_t)chain * NCH + npos) * 1024;
#pragma unroll
            for (int i = 0; i < 4; ++i) {
                const int item = tid + 256 * i, ln = item & 63, wa = item >> 6, wi = wa >> 2, a = wa & 3, fr = ln & 15, fq = ln >> 4;
                Qg[item] = *(const u32x2*)(M + 12 * MSZ + (16 * wi + fr) * MP + 16 * a + 4 * fq);
            }
            if (latent) {
                u32x2* Yg = (u32x2*)(p.ws + OFF_YL) + ((size_t)((c - 4) * 8 + h) * 2 + dir) * 1024;
#pragma unroll
                for (int i = 0; i < 4; ++i) {
                    const int item = tid + 256 * i, ln = item & 63, wn = item >> 6, wt = wn >> 2, ni = wn & 3, fr = ln & 15, fq = ln >> 4;
                    const bf16_t* row = M + 13 * MSZ + (16 * ni + fr) * MP;
                    u32x2 v;
                    if (dir == 0) v = *(const u32x2*)(row + 16 * wt + 4 * fq);
                    else { const u32x2 r2 = *(const u32x2*)(row + 60 - 16 * wt - 4 * fq); v = (u32x2){rot16(r2.y), rot16(r2.x)}; }
                    Yg[item] = v;
                }
            }
        }
        __syncthreads();
    }
}

DI void phase_chain(const Params& p, int chain) {
    const int lane = threadIdx.x & 63, w = threadIdx.x >> 6;
    const u32x4* Pg = (const u32x4*)(p.ws + OFF_P) + (size_t)chain * NCH * 512;
    const u32x2* Qg = (const u32x2*)(p.ws + OFF_Q) + (size_t)chain * NCH * 1024;
    u32x4* Zg = (u32x4*)(p.ws + OFF_Z) + (size_t)chain * NCH * 512;
    f32x4 acc[4];
#pragma unroll
    for (int a = 0; a < 4; ++a) acc[a] = (f32x4){0, 0, 0, 0};
    constexpr int CPF = 4;
    u32x4 pf[CPF][8]; u32x2 qf[CPF][4];
#pragma unroll
    for (int st = 0; st < CPF; ++st) {
#pragma unroll
        for (int i = 0; i < 8; ++i) pf[st][i] = Pg[(size_t)st * 512 + i * 64 + lane];
#pragma unroll
        for (int a = 0; a < 4; ++a) qf[st][a] = Qg[(size_t)st * 1024 + (w * 4 + a) * 64 + lane];
    }
    for (int nb = 0; nb < NCH; nb += CPF) {
#pragma unroll
        for (int st = 0; st < CPF; ++st) {
            const int n = nb + st;
            u32x4 pc[8]; u32x2 qc[4];
#pragma unroll
            for (int i = 0; i < 8; ++i) pc[i] = pf[st][i];
#pragma unroll
            for (int a = 0; a < 4; ++a) qc[a] = qf[st][a];
            if (n + CPF < NCH) {
#pragma unroll
                for (int i = 0; i < 8; ++i) pf[st][i] = Pg[(size_t)(n + CPF) * 512 + i * 64 + lane];
#pragma unroll
                for (int a = 0; a < 4; ++a) qf[st][a] = Qg[(size_t)(n + CPF) * 1024 + (w * 4 + a) * 64 + lane];
            }
            u32x4 z0 = {pack2(acc[0][0], acc[0][1]), pack2(acc[0][2], acc[0][3]), pack2(acc[1][0], acc[1][1]), pack2(acc[1][2], acc[1][3])};
            u32x4 z1 = {pack2(acc[2][0], acc[2][1]), pack2(acc[2][2], acc[2][3]), pack2(acc[3][0], acc[3][1]), pack2(acc[3][2], acc[3][3])};
            Zg[((size_t)n * 4 + w) * 128 + lane] = z0; Zg[((size_t)n * 4 + w) * 128 + 64 + lane] = z1;
            const bf16x8 zb0 = __builtin_bit_cast(bf16x8, z0), zb1 = __builtin_bit_cast(bf16x8, z1);
#pragma unroll
            for (int a = 0; a < 4; ++a) {
                f32x4 ini = {bflo(qc[a].x), bfhi(qc[a].x), bflo(qc[a].y), bfhi(qc[a].y)};
                ini = __builtin_amdgcn_mfma_f32_16x16x32_bf16(__builtin_bit_cast(bf16x8, pc[2 * a]), zb0, ini, 0, 0, 0);
                acc[a] = __builtin_amdgcn_mfma_f32_16x16x32_bf16(__builtin_bit_cast(bf16x8, pc[2 * a + 1]), zb1, ini, 0, 0, 0);
            }
        }
    }
}

DI void phase_scanC(const Params& p, int bid, int nblk, char* lds) {
    const int lane = threadIdx.x & 63, w = threadIdx.x >> 6, fr = lane & 15, fq = lane >> 4;
    bf16_t* mix = (bf16_t*)(p.ws + OFF_MIX);
    const float* dot = (const float*)(p.ws + OFF_DOT);
    for (int unit = bid; unit < 256 * 8; unit += nblk) {
        const int c = 4 + (unit >> 3), h = unit & 7;
        f32x4 y[4];
#pragma unroll
        for (int ni = 0; ni < 4; ++ni) y[ni] = (f32x4){0, 0, 0, 0};
#pragma unroll
        for (int dir = 0; dir < 2; ++dir) {
            const int chain = dir * 8 + h, npos = chain_pos(c, dir);
            const u32x4* Zg = (const u32x4*)(p.ws + OFF_Z) + ((size_t)chain * NCH + npos) * 512;
            const bf16_t* Wg = (const bf16_t*)(p.ws + OFF_WYT) + ((size_t)((c - 4) * 8 + h) * 2 + dir) * 4096;
            const u32x2* Yg = (const u32x2*)(p.ws + OFF_YL) + ((size_t)((c - 4) * 8 + h) * 2 + dir) * 1024;
            const int rho = 16 * w + fr, row = dir ? 63 - rho : rho;
            bf16x8 af[2];
#pragma unroll
            for (int s2 = 0; s2 < 2; ++s2) {
                const u32x2 lo = *(const u32x2*)(Wg + row * 64 + 32 * s2 + 4 * fq), hi = *(const u32x2*)(Wg + row * 64 + 32 * s2 + 16 + 4 * fq);
                af[s2] = __builtin_bit_cast(bf16x8, (u32x4){lo.x, lo.y, hi.x, hi.y});
            }
#pragma unroll
            for (int ni = 0; ni < 4; ++ni) {
                const u32x2 yl = Yg[(w * 4 + ni) * 64 + lane];
                f32x4 acc = {bflo(yl.x), bfhi(yl.x), bflo(yl.y), bfhi(yl.y)};
                acc = __builtin_amdgcn_mfma_f32_16x16x32_bf16(af[0], __builtin_bit_cast(bf16x8, Zg[(ni * 2 + 0) * 64 + lane]), acc, 0, 0, 0);
                acc = __builtin_amdgcn_mfma_f32_16x16x32_bf16(af[1], __builtin_bit_cast(bf16x8, Zg[(ni * 2 + 1) * 64 + lane]), acc, 0, 0, 0);
                y[ni] += acc;
            }
        }
        float* ty = (float*)lds + w * (16 * 68);
#pragma unroll
        for (int ni = 0; ni < 4; ++ni)
#pragma unroll
            for (int e = 0; e < 4; ++e) ty[(4 * fq + e) * 68 + 16 * ni + fr] = y[ni][e];
        asm volatile("s_waitcnt lgkmcnt(0)" ::: "memory"); __builtin_amdgcn_wave_barrier();
        {
            const int tl = lane >> 2, seg = lane & 3, t = (c - 4) * 64 + 16 * w + tl, g = t + CTX, cch = h * 64 + 16 * seg;
            float yv[16];
#pragma unroll
            for (int q = 0; q < 4; ++q) { const f32x4 v4 = *(const f32x4*)(ty + tl * 68 + 16 * seg + 4 * q); yv[4 * q] = v4[0]; yv[4 * q + 1] = v4[1]; yv[4 * q + 2] = v4[2]; yv[4 * q + 3] = v4[3]; }
            float sm = 0.f;
#pragma unroll
            for (int j = 0; j < 16; ++j) sm += yv[j];
            sm += __shfl_xor(sm, 1, 64); sm += __shfl_xor(sm, 2, 64);
            const float mean = sm * (1.f / 64.f);
            float q2 = 0.f;
#pragma unroll
            for (int j = 0; j < 16; ++j) { const float d = yv[j] - mean; q2 += d * d; }
            q2 += __shfl_xor(q2, 1, 64); q2 += __shfl_xor(q2, 2, 64);
            const float rs = rsqrtf(q2 * (1.f / 64.f) + 64e-5f);
            const float bon = dot[((size_t)g * 8 + h) * 2] + dot[((size_t)g * 8 + h) * 2 + 1];
            float vv[16], gg[16], o[16];
            unpack8(*(const u32x4*)((const bf16_t*)(p.ws + OFF_V) + (size_t)t * DR + cch), vv); unpack8(*(const u32x4*)((const bf16_t*)(p.ws + OFF_V) + (size_t)t * DR + cch + 8), vv + 8);
            unpack8(*(const u32x4*)((const bf16_t*)(p.ws + OFF_G) + (size_t)t * DR + cch), gg); unpack8(*(const u32x4*)((const bf16_t*)(p.ws + OFF_G) + (size_t)t * DR + cch + 8), gg + 8);
#pragma unroll
            for (int q = 0; q < 4; ++q) {
                const f32x4 gw = *(const f32x4*)(p.gn_w + cch + 4 * q), gb = *(const f32x4*)(p.gn_b + cch + 4 * q);
#pragma unroll
                for (int j = 0; j < 4; ++j) o[4 * q + j] = ((yv[4 * q + j] - mean) * rs * gw[j] + gb[j] + bon * vv[4 * q + j]) * gg[4 * q + j];
            }
            *(u32x4*)(mix + (size_t)t * D + cch) = pack8(o); *(u32x4*)(mix + (size_t)t * D + cch + 8) = pack8(o + 8);
        }
        __builtin_amdgcn_wave_barrier();
    }
}

struct EpiX2 { float* o; const float* x; const float* gt; const float* rowtab; const float* coltab; int row0, col0;
    DI void operator()(int r, int c, const f32x16& a, const f32x16&) const {
        const int t = row0 + r, d = col0 + c;
        const float* pt = d < 512 ? rowtab + (t >> 6) * 512 + d : coltab + (t & 63) * 512 + (d - 512);
#pragma unroll
        for (int q = 0; q < 4; ++q) {
            const f32x4 xv = *(const f32x4*)(x + (size_t)t * D + d + 4 * q), pv = *(const f32x4*)(pt + 4 * q), gv = *(const f32x4*)(gt + d + 4 * q);
            const f32x4 av = {a[4 * q], a[4 * q + 1], a[4 * q + 2], a[4 * q + 3]};
            *(f32x4*)(o + (size_t)t * D + d + 4 * q) = xv + pv + gv * av;
        } } };
DI void phase_g2(const Params& p, int bid, int nblk, char* lds) {
    const bf16_t* mix = (const bf16_t*)(p.ws + OFF_MIX);
    const XcdOrder ord(bid, nblk, 64 * 8);
    for (int i = 0, q; (q = ord.item(i)) >= 0; ++i) {
        int tm, tn; tile_rc(q, 64, 8, tm, tn);
        PlainA al{mix + (size_t)tm * 256 * D, D};
        EpiX2 e{(float*)(p.ws + OFF_X2), p.x, (const float*)(p.ws + OFF_MODX) + 2048, (const float*)(p.ws + OFF_ROWTAB), (const float*)(p.ws + OFF_COLTAB), tm * 256, tn * 128};
        gemm256<1, true>(al, (const bf16_t*)(p.ws + OFF_WOUTB) + tn * 128, nullptr, D, D, lds, e);
    }
}

DI float router_w(const Params& p, int k, int n) { return n < 4 ? p.w_rg[k * 4 + n] : (n < 36 ? p.w_re[k * 32 + (n - 4)] : 0.f); }
DI void phase_router_prep(const Params& p, int bid, int nblk) {
    const float* modx = (const float*)(p.ws + OFF_MODX);
    float* wp = (float*)(p.ws + OFF_WP); float* b2 = (float*)(p.ws + OFF_B2);
    for (int idx = bid * 256 + threadIdx.x; idx < 64 * 4 * 3 * 64; idx += nblk * 256) {
        const int ln = idx & 63, r = idx >> 6, nt = r % 3, me = r / 3, e = me & 3, m = me >> 2;
        const int k = 16 * m + 4 * (ln >> 4) + e, n = 16 * nt + (ln & 15);
        wp[idx] = p.norm2_g[k] * (1.f + modx[4096 + k]) * router_w(p, k, n);
    }
    const int lane = threadIdx.x & 63, wv = bid * 4 + (threadIdx.x >> 6);
    if (wv < 36) {
        float sacc = 0.f;
        for (int k = lane; k < D; k += 64) sacc += modx[3072 + k] * router_w(p, k, wv);
        sacc = wave_sum(sacc);
        if (lane == 0) b2[wv] = sacc + (wv < 4 ? p.b_rg[wv] : p.b_re[wv - 4]);
    }
}

DI void phase_router(const Params& p, int bid, int nblk, char* lds, bool dry = false) {
    const int lane = threadIdx.x & 63, wid = threadIdx.x >> 6, tr = lane & 15, kq = lane >> 4;
    const float* x2 = (const float*)(p.ws + OFF_X2); const float* modx = (const float*)(p.ws + OFF_MODX);
    const float* wp = (const float*)(p.ws + OFF_WP); const float* b2 = (const float*)(p.ws + OFF_B2);
    bf16_t* h2 = (bf16_t*)(p.ws + OFF_H2); int* cnt = (int*)(p.ws + OFF_CNT); float* gate = (float*)(p.ws + OFF_GATE); int* list = (int*)(p.ws + OFF_LIST);
    float* slog = (float*)lds + wid * (16 * 49);
    for (int task = bid * 4 + wid; task < S / 16; task += nblk * 4) {
        const int t0 = task * 16;
        const float* xr = x2 + (size_t)(t0 + tr) * D + 4 * kq;
        f32x4 acc[3];
#pragma unroll
        for (int i = 0; i < 3; ++i) acc[i] = (f32x4){0, 0, 0, 0};
        float ss = 0.f;
#pragma unroll 4
        for (int m = 0; m < 64; ++m) {
            const f32x4 xv = *(const f32x4*)(xr + 16 * m);
            ss += xv[0] * xv[0] + xv[1] * xv[1] + xv[2] * xv[2] + xv[3] * xv[3];
#pragma unroll
            for (int e = 0; e < 4; ++e)
#pragma unroll
                for (int nt = 0; nt < 3; ++nt) acc[nt] = __builtin_amdgcn_mfma_f32_16x16x4f32(xv[e], wp[((m * 4 + e) * 3 + nt) * 64 + lane], acc[nt], 0, 0, 0);
        }
        ss += __shfl_xor(ss, 16, 64); ss += __shfl_xor(ss, 32, 64);
        const float rstd = rsqrtf(ss * (1.f / 1024.f) + 1e-6f);
#pragma unroll
        for (int nt = 0; nt < 3; ++nt)
#pragma unroll
            for (int r = 0; r < 4; ++r) slog[(4 * kq + r) * 49 + 16 * nt + tr] = acc[nt][r];
        asm volatile("s_waitcnt lgkmcnt(0)" ::: "memory"); __builtin_amdgcn_wave_barrier();
        if (lane < 16) {
            const int t = t0 + lane;
            const float* lg = slog + lane * 49;
            const float l0 = rstd * lg[0] + b2[0], l1 = rstd * lg[1] + b2[1], l2 = rstd * lg[2] + b2[2], l3 = rstd * lg[3] + b2[3];
            int grp = 0; float mx = l0;
            if (l1 > mx) { mx = l1; grp = 1; }
            if (l2 > mx) { mx = l2; grp = 2; }
            if (l3 > mx) { mx = l3; grp = 3; }
            const float den = __expf(l0 - mx) + __expf(l1 - mx) + __expf(l2 - mx) + __expf(l3 - mx);
            const float pgrp = 1.f / den;
            int i1 = 0, i2 = -1; float v1 = -3.0e38f, v2 = -3.0e38f;
            for (int n = 0; n < 8; ++n) {
                const float sv = rstd * lg[4 + grp * 8 + n] + b2[4 + grp * 8 + n];
                if (sv > v1) { v2 = v1; i2 = i1; v1 = sv; i1 = n; } else if (sv > v2) { v2 = sv; i2 = n; }
            }
            const float e2 = __expf(v2 - v1), g1 = pgrp / (1.f + e2), g2v = pgrp * e2 / (1.f + e2);
            const int ea = grp * 8 + i1, eb = grp * 8 + i2;
            if (!dry) {
                const int pa = atomicAdd(&cnt[ea], 1), pb = atomicAdd(&cnt[eb], 1);
                list[ea * LCAP + pa] = t * 2; list[eb * LCAP + pb] = t * 2 + 1;
            }
            gate[t * 2] = g1; gate[t * 2 + 1] = g2v;
        }
        for (int r = 0; r < 16; ++r) {
            const float rs = __shfl(rstd, r, 64);
            const float* src = x2 + (size_t)(t0 + r) * D;
#pragma unroll
            for (int i = 0; i < 4; ++i) {
                const int d = (i * 64 + lane) * 4;
                const f32x4 v = *(const f32x4*)(src + d), gg = *(const f32x4*)(p.norm2_g + d), sh = *(const f32x4*)(modx + 3072 + d), sc = *(const f32x4*)(modx + 4096 + d);
                f32x4 hv;
#pragma unroll
                for (int j = 0; j < 4; ++j) hv[j] = (v[j] * rs * gg[j]) * (1.f + sc[j]) + sh[j];
                u32x2 pk = {pack2(hv[0], hv[1]), pack2(hv[2], hv[3])};
                *(u32x2*)(h2 + (size_t)(t0 + r) * D + d) = pk;
            }
        }
        __builtin_amdgcn_wave_barrier();
    }
}

DI void moe_tiles(const int* cnt, int* tstart  ) {
    if (threadIdx.x == 0) { int acc = 0; for (int e = 0; e < NE; ++e) { tstart[e] = acc; acc += (cnt[e] + 255) >> 8; } tstart[NE] = acc; }
    __syncthreads();
}
struct EpiHid { bf16_t* o; DI void operator()(int r, int c, const f32x16& g, const f32x16& u) const {
    f32x16 h;
#pragma unroll
    for (int j = 0; j < 16; ++j) h[j] = g[j] * sigmoidf_(g[j]) * u[j];
    *(u32x4*)(o + (size_t)r * DE + c) = pack8q(h, 0); *(u32x4*)(o + (size_t)r * DE + c + 8) = pack8q(h, 1); } };
DI void phase_g3(const Params& p, int bid, int nblk, char* lds) {
    int* tstart = (int*)(lds + GEMM_LDS);
    const int* cnt = (const int*)(p.ws + OFF_CNT); const int* list = (const int*)(p.ws + OFF_LIST);
    const bf16_t* h2 = (const bf16_t*)(p.ws + OFF_H2); bf16_t* hid = (bf16_t*)(p.ws + OFF_HID);
    moe_tiles(cnt, tstart);
    const int ntiles = tstart[NE];
    const XcdOrder ord(bid, nblk, ntiles * 8);
    for (int i = 0, item; (item = ord.item(i)) >= 0; ++i) {
        const int ti = item >> 3, cj = item & 7;
        int e = 0; while (e < NE - 1 && tstart[e + 1] <= ti) ++e;
        const int lt = ti - tstart[e], ne = cnt[e];
        GatherA al;
#pragma unroll
        for (int i = 0; i < 8; ++i) { const int row = (4 * i + (threadIdx.x >> 6)) * 8 + ((threadIdx.x & 63) >> 3), pos = lt * 256 + row; const int tok = pos < ne ? (list[e * LCAP + pos] >> 1) : 0; al.rp[i] = h2 + (size_t)tok * D; }
        EpiHid epi{hid + (size_t)ti * 256 * DE + cj * 64};
        gemm256<2, false>(al, p.w_gate + (size_t)e * D * DE + cj * 64, p.w_up + (size_t)e * D * DE + cj * 64, DE, D, lds, epi);
    }
}
struct EpiDown { bf16_t* ybuf; const int* lst; const float* gate; int nvalid; int col0;
    DI void operator()(int r, int c, const f32x16& a, const f32x16&) const {
        if (r >= nvalid) return; const int slot = lst[r]; const float g = gate[slot];
        const f32x16 v = a * g;
        *(u32x4*)(ybuf + (size_t)slot * D + col0 + c) = pack8q(v, 0); *(u32x4*)(ybuf + (size_t)slot * D + col0 + c + 8) = pack8q(v, 1); } };
DI void phase_g4(const Params& p, int bid, int nblk, char* lds) {
    int* tstart = (int*)(lds + GEMM_LDS);
    const int* cnt = (const int*)(p.ws + OFF_CNT); const int* list = (const int*)(p.ws + OFF_LIST);
    const bf16_t* hid = (const bf16_t*)(p.ws + OFF_HID);
    moe_tiles(cnt, tstart);
    const int ntiles = tstart[NE];
    const XcdOrder ord(bid, nblk, ntiles * 8);
    for (int i = 0, item; (item = ord.item(i)) >= 0; ++i) {
        const int ti = item >> 3, cj = item & 7;
        int e = 0; while (e < NE - 1 && tstart[e + 1] <= ti) ++e;
        const int lt = ti - tstart[e], ne = cnt[e];
        PlainA al{hid + (size_t)ti * 256 * DE, DE};
        EpiDown epi{(bf16_t*)(p.ws + OFF_YBUF), list + e * LCAP + lt * 256, (const float*)(p.ws + OFF_GATE), ne - lt * 256, cj * 128};
        gemm256<1, false>(al, p.w_down + (size_t)e * DE * D + cj * 128, nullptr, D, DE, lds, epi);
    }
}

DI void phase_final(const Params& p, int bid, int nblk) {
    const int lane = threadIdx.x & 63, wid = threadIdx.x >> 6;
    const float* x2 = (const float*)(p.ws + OFF_X2); const float* gt = (const float*)(p.ws + OFF_MODX) + 5120; const bf16_t* yb = (const bf16_t*)(p.ws + OFF_YBUF);
    for (int t = bid * 4 + wid; t < S; t += nblk * 4) {
        f32x4 v[4]; float ss = 0.f;
#pragma unroll
        for (int i = 0; i < 4; ++i) {
            const int d = (i * 64 + lane) * 4;
            v[i] = *(const f32x4*)(x2 + (size_t)t * D + d);
            const u32x2 a = *(const u32x2*)(yb + (size_t)(2 * t) * D + d), b = *(const u32x2*)(yb + (size_t)(2 * t + 1) * D + d);
            const f32x4 g = *(const f32x4*)(gt + d);
            v[i][0] += g[0] * (bflo(a.x) + bflo(b.x)); v[i][1] += g[1] * (bfhi(a.x) + bfhi(b.x));
            v[i][2] += g[2] * (bflo(a.y) + bflo(b.y)); v[i][3] += g[3] * (bfhi(a.y) + bfhi(b.y));
            ss += v[i][0] * v[i][0] + v[i][1] * v[i][1] + v[i][2] * v[i][2] + v[i][3] * v[i][3];
        }
        ss = wave_sum(ss);
        const float rstd = rsqrtf(ss * (1.f / 1024.f) + 1e-6f);
#pragma unroll
        for (int i = 0; i < 4; ++i) {
            const int d = (i * 64 + lane) * 4; const f32x4 fg = *(const f32x4*)(p.final_g + d); f32x4 o;
#pragma unroll
            for (int j = 0; j < 4; ++j) o[j] = v[i][j] * rstd * fg[j];
            *(f32x4*)(p.out + (size_t)t * D + d) = o;
        }
    }
}

#define XB_TMO      128
#define XB_XCNT(j)  (256  + 64 * (j))
#define XB_XSUB(j)  (1280 + 64 * (j))
#define XB_XGEN(j)  (2304 + 64 * (j))
#define XB_TOP      3328
#define XB_TOPGEN   3392
#define XCD_BAR_WORDS 3456
#define XB_SPIN_CAP (1u << 18)
DI unsigned xb_ld(unsigned* p) { return __hip_atomic_load(p, __ATOMIC_RELAXED, __HIP_MEMORY_SCOPE_AGENT); }
DI unsigned xb_add(unsigned* p, unsigned v) { return __hip_atomic_fetch_add(p, v, __ATOMIC_RELAXED, __HIP_MEMORY_SCOPE_AGENT); }
DI unsigned xb_xcc_id() { return (unsigned)__builtin_amdgcn_s_getreg((3 << 11) | 20) & 0xFu; }
#define XB_SPIN(cond, bar) do { unsigned _sp = 0; while (cond) { __builtin_amdgcn_s_sleep(1); \
    if ((++_sp & 255u) == 0u) { if (xb_ld(&(bar)[XB_TMO])) break; if (_sp > XB_SPIN_CAP) { atomicAdd(&(bar)[XB_TMO], 1u); break; } } } } while (0)
struct XcdBarrier { unsigned* bar; unsigned x; volatile LAS unsigned* st; };
DI XcdBarrier xcd_barrier_post(unsigned* bar, volatile LAS unsigned* st) {
    XcdBarrier b; b.bar = bar; b.x = xb_xcc_id(); b.st = st;
    if (threadIdx.x == 0) (void)xb_add(&bar[XB_XCNT(b.x)], 1u);
    return b;
}
DI void xcd_barrier_complete(unsigned* bar, unsigned x, unsigned& nloc, unsigned& nx) {
    const unsigned G = gridDim.x * gridDim.y * gridDim.z;
    unsigned sum, cnt, mine, sp = 0u;
    for (;;) {
        sum = 0u; cnt = 0u; mine = 0u;
#pragma unroll
        for (unsigned j = 0; j < 16; ++j) { const unsigned c = xb_ld(&bar[XB_XCNT(j)]); sum += c; cnt += (c > 0u) ? 1u : 0u; mine = (j == x) ? c : mine; }
        if (sum == G) break;
        __builtin_amdgcn_s_sleep(1);
        if ((++sp & 255u) == 0u) { if (xb_ld(&bar[XB_TMO])) break; if (sp > XB_SPIN_CAP) { atomicAdd(&bar[XB_TMO], 1u); break; } }
    }
    nloc = mine > 0u ? mine : 1u; nx = cnt > 0u ? cnt : 1u;
}
DI void xcd_barrier(const XcdBarrier& b) {
    asm volatile("s_waitcnt vmcnt(0)" ::: "memory");
    __syncthreads();
    if (threadIdx.x == 0) {
        unsigned* bar = b.bar;
        __builtin_amdgcn_s_waitcnt(0);
        unsigned nloc = b.st[0], nx = b.st[1];
        if (nloc == 0u) { xcd_barrier_complete(bar, b.x, nloc, nx); b.st[0] = nloc; b.st[1] = nx; }
        const unsigned old = xb_add(&bar[XB_XSUB(b.x)], 1u);
        const unsigned gen = old / nloc;
        if (old + 1u == (gen + 1u) * nloc) {
            __builtin_amdgcn_fence(__ATOMIC_RELEASE, "agent");
            asm volatile("s_waitcnt vmcnt(0)" ::: "memory");
            const unsigned og = xb_add(&bar[XB_TOP], 1u);
            const unsigned tg = og / nx;
            if (og + 1u == (tg + 1u) * nx) xb_add(&bar[XB_TOPGEN], 1u);
            else XB_SPIN(xb_ld(&bar[XB_TOPGEN]) == tg, bar);
            __builtin_amdgcn_fence(__ATOMIC_ACQUIRE, "agent");
            xb_add(&bar[XB_XGEN(b.x)], 1u);
            asm volatile("s_waitcnt vmcnt(0)" ::: "memory");
        } else {
            XB_SPIN(xb_ld(&bar[XB_XGEN(b.x)]) == gen, bar);
            __builtin_amdgcn_fence(__ATOMIC_ACQUIRE, "agent");
            asm volatile("s_waitcnt vmcnt(0)" ::: "memory");
        }
    }
    __syncthreads();
}

#ifndef PROBE
#define PROBE 0
#endif
constexpr int MEGA_LDS = SCANA_LDS > (GEMM_LDS + 256) ? SCANA_LDS : (GEMM_LDS + 256);
__global__ void __launch_bounds__(256) k_mega(Params p) {
    extern __shared__ __attribute__((aligned(16))) char lds[];
    const int bid = blockIdx.x, nblk = gridDim.x;
    volatile LAS unsigned* st = (volatile LAS unsigned*)(lds + MEGA_LDS);
    if (threadIdx.x < 4) st[threadIdx.x] = 0u;
    __syncthreads();
    const XcdBarrier gb = xcd_barrier_post((unsigned*)(p.ws + OFF_BAR), st);
#define GSYNC() xcd_barrier(gb)
    phase_p0(p, bid, nblk, lds); GSYNC();
    if (PROBE == 1) { phase_p0(p, bid, nblk, lds); GSYNC(); }
    phase_xn(p, bid, nblk); phase_router_prep(p, bid, nblk); GSYNC();
    if (PROBE == 2) { phase_xn(p, bid, nblk); GSYNC(); }
    phase_g1(p, bid, nblk, lds); GSYNC();
    if (PROBE == 3) { phase_g1(p, bid, nblk, lds); GSYNC(); }
    if (PROBE == 33) { phase_mfma_rate(p, 5120); GSYNC(); }
    if (PROBE == 34) { phase_mfma_rate32(p, 2560); GSYNC(); }
    phase_pool(p, bid, nblk);
    phase_scanA(p, bid, nblk, lds); GSYNC();
    if (PROBE == 4) { phase_scanA(p, bid, nblk, lds); GSYNC(); }
    if (PROBE == 41) { phase_scanA<1>(p, bid, nblk, lds); GSYNC(); }
    if (PROBE == 42) { phase_scanA<2>(p, bid, nblk, lds); GSYNC(); }
    if (PROBE == 12) { phase_pool(p, bid, nblk); GSYNC(); }
    if (bid < 16) phase_chain(p, bid); else phase_poolgemm(p, bid - 16, nblk - 16, lds);
    GSYNC();
    if (PROBE == 5) { if (bid < 16) phase_chain(p, bid); GSYNC(); }
    if (PROBE == 13) { if (bid >= 16) phase_poolgemm(p, bid - 16, nblk - 16, lds); GSYNC(); }
    phase_scanC(p, bid, nblk, lds); GSYNC();
    if (PROBE == 6) { phase_scanC(p, bid, nblk, lds); GSYNC(); }
    phase_g2(p, bid, nblk, lds); GSYNC();
    if (PROBE == 7) { phase_g2(p, bid, nblk, lds); GSYNC(); }
    if (PROBE == 8) { phase_router(p, bid, nblk, lds, true); GSYNC(); }
    phase_router(p, bid, nblk, lds); GSYNC();
    phase_g3(p, bid, nblk, lds); GSYNC();
    if (PROBE == 9) { phase_g3(p, bid, nblk, lds); GSYNC(); }
    phase_g4(p, bid, nblk, lds); GSYNC();
    if (PROBE == 10) { phase_g4(p, bid, nblk, lds); GSYNC(); }
    if (PROBE == 11) { phase_final(p, bid, nblk); GSYNC(); }
    phase_final(p, bid, nblk);
}

extern "C" void kernel_launch(void* const* d_in, const int* in_sizes, int n_in, void* d_out, int out_size, void* d_ws, size_t ws_size, hipStream_t stream) {
    if (ws_size < WS_NEED) { fprintf(stderr, "workspace too small: %zu < %zu\n", ws_size, (size_t)WS_NEED); return; }
    Params p{};
    const float** f = (const float**)&p;
    for (int i = 0; i < 36; ++i) f[i] = (const float*)d_in[i];
    p.out = (float*)d_out; p.ws = (char*)d_ws;
    static int grid_blocks = 0;
    if (!grid_blocks) {
        (void)hipFuncSetAttribute((const void*)k_mega, hipFuncAttributeMaxDynamicSharedMemorySize, MEGA_LDS + 16);
        int dev = 0, cus = 0, per_cu = 0;
        (void)hipGetDevice(&dev);
        (void)hipDeviceGetAttribute(&cus, hipDeviceAttributeMultiprocessorCount, dev);
        (void)hipOccupancyMaxActiveBlocksPerMultiprocessor(&per_cu, k_mega, 256, MEGA_LDS + 16);
        if (per_cu > 1) per_cu = 1;
        grid_blocks = cus * per_cu;
    }
    (void)hipMemsetAsync((char*)d_ws + OFF_BAR, 0, 16384, stream);
    void* args[] = {&p};
    hipError_t e = hipLaunchCooperativeKernel((const void*)k_mega, dim3(grid_blocks), dim3(256), args, MEGA_LDS + 16, stream);
    if (e != hipSuccess) fprintf(stderr, "cooperative launch failed: %s (grid %d)\n", hipGetErrorString(e), grid_blocks);
}
```

```cpp
#include <hip/hip_runtime.h>
#include <stdint.h>
#include <stdio.h>
#include <hip/hip_cooperative_groups.h>
namespace cg = cooperative_groups;

#define DI __device__ __forceinline__
typedef unsigned short bf16_t;
typedef short bf16x8 __attribute__((ext_vector_type(8)));
typedef short s16x4 __attribute__((ext_vector_type(4)));
typedef float f32x4 __attribute__((ext_vector_type(4)));
typedef float f32x2 __attribute__((ext_vector_type(2)));
typedef __bf16 bf16x2_t __attribute__((ext_vector_type(2)));
typedef unsigned u32x4 __attribute__((ext_vector_type(4)));
typedef unsigned u32x2 __attribute__((ext_vector_type(2)));
#define LAS __attribute__((address_space(3)))

constexpr int D = 1024, S = 16384, CTX = 256, NT = S + CTX, DIN = 2432, DSH = 1920, DR = 512;
constexpr int C_WLF = 1536, C_WLB = 1600, C_ALF = 1664, C_ALB = 1728, C_GL = 1792, C_POOL = 1920;
constexpr int NE = 32, DE = 512, LCAP = 32768;
constexpr float DECAY_SCALE = 0.6065306597f;

constexpr int NCH = NT / 64;
constexpr size_t SZ_U = (size_t)NT * DIN * 2;
constexpr size_t SZ_CH = (size_t)16 * NCH * 8192;
constexpr size_t OFF_U = 0;
constexpr size_t OFF_XN = OFF_U + SZ_U;
constexpr size_t OFF_P = OFF_XN;
constexpr size_t OFF_Q = OFF_P + SZ_CH;
constexpr size_t OFF_WYT = OFF_Q + SZ_CH;
constexpr size_t OFF_YL = OFF_WYT + (size_t)256 * 16 * 8192;
constexpr size_t OFF_V = OFF_YL + (size_t)256 * 16 * 8192;
constexpr size_t OFF_G = OFF_V + (size_t)S * DR * 2;
constexpr size_t OFF_MIX = OFF_G + (size_t)S * DR * 2;
constexpr size_t OFF_SMALL = OFF_MIX + (size_t)S * D * 2;
constexpr size_t OFF_MODX = OFF_SMALL, OFF_MODC = OFF_MODX + 6144 * 4;
constexpr size_t OFF_ROWTAB = OFF_MODC + 6144 * 4, OFF_COLTAB = OFF_ROWTAB + 256 * 512 * 4;
constexpr size_t OFF_CNT = OFF_COLTAB + 64 * 512 * 4;
constexpr size_t OFF_GATE = OFF_CNT + 256;
constexpr size_t OFF_LIST = OFF_GATE + (size_t)S * 2 * 4;
constexpr size_t OFF_DOT = OFF_LIST + (size_t)NE * LCAP * 4;
constexpr size_t OFF_WP = OFF_DOT + (size_t)NT * 16 * 4;
constexpr size_t OFF_B2 = OFF_WP + 64 * 4 * 3 * 64 * 4;
constexpr size_t OFF_BAR = OFF_B2 + 256;
constexpr size_t OFF_WINB = OFF_BAR + 16384;
constexpr size_t OFF_WOUTB = OFF_WINB + (size_t)D * DIN * 2;
constexpr size_t WS_NEED = OFF_WOUTB + (size_t)D * D * 2;
constexpr size_t OFF_Z = OFF_U;
constexpr size_t OFF_X2 = OFF_P;
constexpr size_t OFF_YBUF = OFF_WYT;
constexpr size_t OFF_H2 = OFF_U;
constexpr size_t OFF_HID = OFF_U + SZ_CH;
constexpr size_t OFF_CP = OFF_U + SZ_CH;
constexpr size_t OFF_CQ = OFF_CP + 256 * 8192;
constexpr size_t OFF_ZG = OFF_CQ + 256 * 16384;

struct Params {
    const float *x, *c, *ctx, *c_ctx, *norm1_g, *w_mod, *b_mod, *w_in, *mu, *w0_f, *w2_f, *w0_b, *w2_b, *a0_f, *a2_f, *a0_b, *a2_b,
        *g2, *k_k, *k_a, *r_k_f, *r_k_b, *gn_w, *gn_b, *w_pool, *pool_scale, *w_out, *norm2_g, *w_rg, *b_rg, *w_re, *b_re,
        *w_gate, *w_up, *w_down, *final_g;
    float* out;
    char* ws;
};

DI unsigned pack2(float lo, float hi) { f32x2 v = {lo, hi}; bf16x2_t b = __builtin_convertvector(v, bf16x2_t); return __builtin_bit_cast(unsigned, b); }
DI float bf2f(bf16_t h) { return __uint_as_float(((unsigned)h) << 16); }
DI float bflo(unsigned u) { return __uint_as_float(u << 16); }
DI float bfhi(unsigned u) { return __uint_as_float(u & 0xffff0000u); }
DI void unpack8(const u32x4& p, float* f) { f[0] = bflo(p.x); f[1] = bfhi(p.x); f[2] = bflo(p.y); f[3] = bfhi(p.y); f[4] = bflo(p.z); f[5] = bfhi(p.z); f[6] = bflo(p.w); f[7] = bfhi(p.w); }
DI u32x4 pack8(const float* f) { u32x4 p; p.x = pack2(f[0], f[1]); p.y = pack2(f[2], f[3]); p.z = pack2(f[4], f[5]); p.w = pack2(f[6], f[7]); return p; }
DI float sigmoidf_(float x) { return 1.f / (1.f + __expf(-x)); }
DI float wave_sum(float v) {
#pragma unroll
    for (int o = 32; o > 0; o >>= 1) v += __shfl_xor(v, o, 64);
    return v;
}
DI f32x4 wave_sum4(f32x4 v) {
#pragma unroll
    for (int o = 32; o > 0; o >>= 1) { v[0] += __shfl_xor(v[0], o, 64); v[1] += __shfl_xor(v[1], o, 64); v[2] += __shfl_xor(v[2], o, 64); v[3] += __shfl_xor(v[3], o, 64); }
    return v;
}
typedef float f32x16 __attribute__((ext_vector_type(16)));
DI f32x16 zero16() { f32x16 z; for (int i = 0; i < 16; ++i) z[i] = 0.f; return z; }
DI s16x4 tr16(const bf16_t* a) { return __builtin_amdgcn_ds_read_tr16_b64_v4i16((LAS s16x4*)a); }
DI float pos_val(const float* rowtab, const float* coltab, int t, int d) { return d < 512 ? rowtab[(t >> 6) * 512 + d] : coltab[(t & 63) * 512 + (d - 512)]; }

DI void phase_p0(const Params& p, int bid, int nblk, char* lds) {
    const int tid = threadIdx.x;
    float* modx = (float*)(p.ws + OFF_MODX); float* modc = (float*)(p.ws + OFF_MODC);
    float* red = (float*)lds;
    for (int item = bid; item < 96; item += nblk) {
        const int col0 = item * 64, cg = tid & 15, kg = tid >> 4;
        f32x4 ax = {0, 0, 0, 0}, ac = {0, 0, 0, 0};
        for (int kk = 0; kk < 64; ++kk) {
            const int k = kg * 64 + kk;
            const float cv = p.c[k], cc = p.c_ctx[k];
            const float sx = cv * sigmoidf_(cv), sc = cc * sigmoidf_(cc);
            const f32x4 w = *(const f32x4*)(p.w_mod + (size_t)k * 6144 + col0 + cg * 4);
            ax += w * sx; ac += w * sc;
        }
        __syncthreads();
#pragma unroll
        for (int j = 0; j < 4; ++j) { red[(kg * 64 + cg * 4 + j) * 2] = ax[j]; red[(kg * 64 + cg * 4 + j) * 2 + 1] = ac[j]; }
        __syncthreads();
        if (tid < 128) {
            const int col = tid & 63, which = tid >> 6;
            float s = 0.f;
            for (int g = 0; g < 16; ++g) s += red[(g * 64 + col) * 2 + which];
            s += p.b_mod[col0 + col];
            (which ? modc : modx)[col0 + col] = s;
        }
    }
    float* rowtab = (float*)(p.ws + OFF_ROWTAB); float* coltab = (float*)(p.ws + OFF_COLTAB);
    for (int i = bid * 256 + tid; i < (256 + 64) * 256; i += nblk * 256) {
        const int pos = i >> 8, f = i & 255;
        const float freq = powf(10000.f, -(float)f / 256.f);
        if (pos < 256) { const float a = (float)pos * freq; rowtab[pos * 512 + f] = sinf(a); rowtab[pos * 512 + 256 + f] = cosf(a); }
        else { const int cp = pos - 256; const float a = (float)cp * freq; coltab[cp * 512 + f] = sinf(a); coltab[cp * 512 + 256 + f] = cosf(a); }
    }
    if (bid == 0 && tid < 64) ((int*)(p.ws + OFF_CNT))[tid] = 0;
    for (int pass = 0; pass < 2; ++pass) {
        const float* src = pass ? p.w_out : p.w_in; const int nc = pass ? D : DIN; bf16_t* dst = (bf16_t*)(p.ws + (pass ? OFF_WOUTB : OFF_WINB));
        const int n8 = nc >> 3;
        for (int idx = bid * 256 + tid; idx < D * n8; idx += nblk * 256) {
            const int k = idx / n8, g8 = idx - k * n8, blk = g8 >> 2, q = g8 & 3;
            const f32x4 lo = *(const f32x4*)(src + (size_t)k * nc + blk * 32 + 4 * q), hi = *(const f32x4*)(src + (size_t)k * nc + blk * 32 + 16 + 4 * q);
            *(u32x4*)(dst + (size_t)k * nc + blk * 32 + 8 * q) = (u32x4){pack2(lo[0], lo[1]), pack2(lo[2], lo[3]), pack2(hi[0], hi[1]), pack2(hi[2], hi[3])};
        }
    }
}

DI void phase_xn(const Params& p, int bid, int nblk) {
    const int lane = threadIdx.x & 63, wid = threadIdx.x >> 6;
    const float* modx = (const float*)(p.ws + OFF_MODX); const float* modc = (const float*)(p.ws + OFF_MODC);
    const float* rowtab = (const float*)(p.ws + OFF_ROWTAB); const float* coltab = (const float*)(p.ws + OFF_COLTAB);
    bf16_t* xn = (bf16_t*)(p.ws + OFF_XN);
    for (int g = bid * 4 + wid; g < NT; g += nblk * 4) {
        const bool isctx = g < CTX; const int t = g - CTX;
        const float* src = isctx ? p.ctx + (size_t)g * D : p.x + (size_t)t * D;
        const float* md = isctx ? modc : modx;
        f32x4 v[4]; float ss = 0.f;
#pragma unroll
        for (int i = 0; i < 4; ++i) {
            const int d = (i * 64 + lane) * 4;
            v[i] = *(const f32x4*)(src + d);
            if (!isctx) v[i] += *(const f32x4*)(d < 512 ? rowtab + (t >> 6) * 512 + d : coltab + (t & 63) * 512 + (d - 512));
            ss += v[i][0] * v[i][0] + v[i][1] * v[i][1] + v[i][2] * v[i][2] + v[i][3] * v[i][3];
        }
        ss = wave_sum(ss);
        const float rstd = rsqrtf(ss * (1.f / 1024.f) + 1e-6f);
#pragma unroll
        for (int i = 0; i < 4; ++i) {
            const int d = (i * 64 + lane) * 4;
            const f32x4 gg = *(const f32x4*)(p.norm1_g + d), sh = *(const f32x4*)(md + d), sc = *(const f32x4*)(md + 1024 + d);
            f32x4 o;
#pragma unroll
            for (int j = 0; j < 4; ++j) o[j] = (v[i][j] * rstd * gg[j]) * (1.f + sc[j]) + sh[j];
            u32x2 pk = {pack2(o[0], o[1]), pack2(o[2], o[3])};
            *(u32x2*)(xn + (size_t)g * D + d) = pk;
        }
    }
}

constexpr int GA_SZ = 256 * 128, GB_SZ = 18432, GBUF_SZ = GA_SZ + GB_SZ;
constexpr int GEMM_LDS = 3 * GBUF_SZ;
DI void glds16(const void* gsrc, char* ldst) { __builtin_amdgcn_global_load_lds((const unsigned*)gsrc, (LAS unsigned*)ldst, 16, 0, 0); }
template <int NB, bool BGLDS, class AL, class EPI>
DI void gemm256(const AL& al, const void* __restrict__ Bv0, const void* __restrict__ Bv1, int ldb, int K, char* lds, EPI& epi) {
    static_assert(!(BGLDS && NB == 2), "bf16 LDS-DMA path is for a single B");
    constexpr int NBLK = NB == 1 ? 2 : 1;
    constexpr int WN = 32 * NBLK;
    constexpr int BP = NB == 1 ? 136 : 72;
    const int tid = threadIdx.x, lane = tid & 63, wid = tid >> 6, wr = wid >> 1, wc = wid & 1, r32 = lane & 31, hh = lane >> 5, gi = lane >> 4, i16 = lane & 15;
    const float* B0 = (const float*)Bv0; const float* B1 = (const float*)Bv1; const bf16_t* Bb = (const bf16_t*)Bv0;
    f32x16 acc0[4][NBLK], acc1[4][NBLK];
#pragma unroll
    for (int m = 0; m < 4; ++m)
#pragma unroll
        for (int n = 0; n < NBLK; ++n) { acc0[m][n] = zero16(); acc1[m][n] = zero16(); }
    f32x4 rb0[NB == 1 ? 8 : 4], rb1[4];
    const int T = K >> 6;
    const bf16_t* arow[8];
#pragma unroll
    for (int i = 0; i < 8; ++i) { const int row = (4 * i + wid) * 8 + (lane >> 3); arow[i] = al.rowptr(i, row) + (((lane & 7) ^ ((row >> 1) & 7)) << 3); }
    int bsrc[4];
#pragma unroll
    for (int i = 0; i < 4; ++i) { const int k = (4 * i + wid) * 4 + (lane >> 4), p16 = lane & 15; bsrc[i] = k * ldb + ((((p16 >> 1) ^ (k & 7)) << 1) + (p16 & 1)) * 8; }
    const int a_base = (wr * 128 + r32) * 128, a_sw = (r32 >> 1) & 7;
    const int b_off = (8 * (gi >> 1) + (i16 >> 2)) * BP + wc * WN + 16 * (gi & 1) + 4 * (i16 & 3);
#define G_DMA(buf, t_) do { char* dA_ = lds + (buf) * GBUF_SZ + wid * 1024 + lane * 16; \
        _Pragma("unroll") for (int i = 0; i < 8; ++i) glds16(arow[i] + (t_) * 64, dA_ + i * 4096); \
        if (BGLDS) { char* dB_ = lds + (buf) * GBUF_SZ + GA_SZ + wid * 1024 + lane * 16; \
            _Pragma("unroll") for (int i = 0; i < 4; ++i) glds16(Bb + (size_t)(t_) * 64 * ldb + bsrc[i], dB_ + i * 4096); } } while (0)
#define G_LOADB(t_) do { const int k0_ = (t_) * 64; \
        if (NB == 1) { _Pragma("unroll") for (int i = 0; i < 8; ++i) { const int c = tid + 256 * i, kr = c >> 5, n4 = c & 31; rb0[i] = *(const f32x4*)(B0 + (size_t)(k0_ + kr) * ldb + n4 * 4); } } \
        else { _Pragma("unroll") for (int i = 0; i < 4; ++i) { const int c = tid + 256 * i, kr = c >> 4, n4 = c & 15; rb0[i] = *(const f32x4*)(B0 + (size_t)(k0_ + kr) * ldb + n4 * 4); rb1[i] = *(const f32x4*)(B1 + (size_t)(k0_ + kr) * ldb + n4 * 4); } } } while (0)
#define G_WRITEB(buf) do { bf16_t* sB0_ = (bf16_t*)(lds + (buf) * GBUF_SZ + GA_SZ); bf16_t* sB1_ = sB0_ + 64 * 72; \
        if (NB == 1) { _Pragma("unroll") for (int i = 0; i < 8; ++i) { const int c = tid + 256 * i, kr = c >> 5, n4 = c & 31, slot = (n4 >> 3) * 32 + 8 * (n4 & 3) + 4 * ((n4 >> 2) & 1); \
            u32x2 pk = {pack2(rb0[i][0], rb0[i][1]), pack2(rb0[i][2], rb0[i][3])}; *(u32x2*)(sB0_ + kr * BP + slot) = pk; } } \
        else { _Pragma("unroll") for (int i = 0; i < 4; ++i) { const int c = tid + 256 * i, kr = c >> 4, n4 = c & 15, slot = (n4 >> 3) * 32 + 8 * (n4 & 3) + 4 * ((n4 >> 2) & 1); \
            u32x2 pk = {pack2(rb0[i][0], rb0[i][1]), pack2(rb0[i][2], rb0[i][3])}; *(u32x2*)(sB0_ + kr * BP + slot) = pk; \
            u32x2 pk1 = {pack2(rb1[i][0], rb1[i][1]), pack2(rb1[i][2], rb1[i][3])}; *(u32x2*)(sB1_ + kr * BP + slot) = pk1; } } } while (0)
#define G_READ(buf, kh, AF, BF0, BF1) do { const char* sA_ = lds + (buf) * GBUF_SZ; const bf16_t* sB0_ = (const bf16_t*)(lds + (buf) * GBUF_SZ + GA_SZ); const bf16_t* sB1_ = sB0_ + 64 * 72; \
        _Pragma("unroll") for (int ks = 0; ks < 2; ++ks) { const int k0_ = (kh) * 32 + ks * 16; \
            _Pragma("unroll") for (int n = 0; n < NBLK; ++n) { \
                if (BGLDS) { const int kk_ = k0_ + 8 * (gi >> 1) + (i16 >> 2), gr_ = (wc * WN + n * 32) / 16 + (gi & 1); \
                    const char* q0_ = (const char*)sB0_ + kk_ * 256 + ((gr_ ^ (kk_ & 7)) << 5) + 8 * (i16 & 3); const char* q1_ = (const char*)sB0_ + (kk_ + 4) * 256 + ((gr_ ^ ((kk_ + 4) & 7)) << 5) + 8 * (i16 & 3); \
                    s16x4 lo = tr16((const bf16_t*)q0_), hi = tr16((const bf16_t*)q1_); BF0[ks][n] = __builtin_shufflevector(lo, hi, 0, 1, 2, 3, 4, 5, 6, 7); } \
                else { const int off = b_off + k0_ * BP + n * 32; \
                    s16x4 lo = tr16(sB0_ + off), hi = tr16(sB0_ + off + 4 * BP); BF0[ks][n] = __builtin_shufflevector(lo, hi, 0, 1, 2, 3, 4, 5, 6, 7); \
                    if (NB == 2) { s16x4 lo1 = tr16(sB1_ + off), hi1 = tr16(sB1_ + off + 4 * BP); BF1[ks][n] = __builtin_shufflevector(lo1, hi1, 0, 1, 2, 3, 4, 5, 6, 7); } } } \
            _Pragma("unroll") for (int m = 0; m < 4; ++m) AF[ks][m] = *(const bf16x8*)(sA_ + a_base + m * 4096 + ((((kh) * 4 + ks * 2 + hh) ^ a_sw) << 4)); } } while (0)
#define G_MFMA(AF, BF0, BF1) do { \
        _Pragma("unroll") for (int ks = 0; ks < 2; ++ks) _Pragma("unroll") for (int m = 0; m < 4; ++m) _Pragma("unroll") for (int n = 0; n < NBLK; ++n) { \
            acc0[m][n] = __builtin_amdgcn_mfma_f32_32x32x16_bf16(BF0[ks][n], AF[ks][m], acc0[m][n], 0, 0, 0); \
            if (NB == 2) acc1[m][n] = __builtin_amdgcn_mfma_f32_32x32x16_bf16(BF1[ks][n], AF[ks][m], acc1[m][n], 0, 0, 0); } } while (0)
    bf16x8 afA[2][4], bfA0[2][NBLK], bfA1[2][NBLK], afB[2][4], bfB0[2][NBLK], bfB1[2][NBLK];
    if (BGLDS) {
        G_DMA(0, 0);
        if (T > 1) G_DMA(1, 1);
        int b0 = 0, b1 = 1, b2 = 2;
#pragma unroll 1
        for (int t = 0; t < T; ++t) {
            if (t + 1 < T) asm volatile("s_waitcnt vmcnt(12)" ::: "memory"); else asm volatile("s_waitcnt vmcnt(0)" ::: "memory");
            __builtin_amdgcn_s_barrier();
            __builtin_amdgcn_sched_barrier(0);
            if (t + 2 < T) G_DMA(b2, t + 2);
            G_READ(b0, 0, afA, bfA0, bfA1);
            __builtin_amdgcn_sched_barrier(0);
            G_MFMA(afA, bfA0, bfA1);
            G_READ(b0, 1, afB, bfB0, bfB1);
#pragma unroll
            for (int i = 0; i < 16; ++i) { __builtin_amdgcn_sched_group_barrier(0x008, 1, 0); __builtin_amdgcn_sched_group_barrier(0x100, 1, 0); }
            __builtin_amdgcn_sched_barrier(0);
            G_MFMA(afB, bfB0, bfB1);
            __builtin_amdgcn_sched_barrier(0);
            const int tb = b0; b0 = b1; b1 = b2; b2 = tb;
        }
    } else {
    G_DMA(0, 0);
    G_LOADB(0); G_WRITEB(0);
#pragma unroll 1
    for (int t = 0; t < T; ++t) {
        const int buf = t & 1;
        asm volatile("s_waitcnt vmcnt(0)" ::: "memory");
        __syncthreads();
        if (t + 1 < T) { G_DMA(buf ^ 1, t + 1); G_LOADB(t + 1); }
        G_READ(buf, 0, afA, bfA0, bfA1);
        __builtin_amdgcn_sched_barrier(0);
        G_MFMA(afA, bfA0, bfA1);
        G_READ(buf, 1, afB, bfB0, bfB1);
#pragma unroll
        for (int i = 0; i < 16; ++i) { __builtin_amdgcn_sched_group_barrier(0x008, 1, 0); __builtin_amdgcn_sched_group_barrier(0x100, 1, 0); }
        __builtin_amdgcn_sched_barrier(0);
        G_MFMA(afB, bfB0, bfB1);
        G_WRITEB(buf ^ 1);
#pragma unroll
        for (int i = 0; i < 16; ++i) { __builtin_amdgcn_sched_group_barrier(0x008, 1, 0); __builtin_amdgcn_sched_group_barrier(0x002, 4, 0); __builtin_amdgcn_sched_group_barrier(0x200, 1, 0); }
        __builtin_amdgcn_sched_barrier(0);
    }
    }
#undef G_DMA
#undef G_LOADB
#undef G_WRITEB
#undef G_READ
#undef G_MFMA
#pragma unroll
    for (int m = 0; m < 4; ++m)
#pragma unroll
        for (int n = 0; n < NBLK; ++n) epi(wr * 128 + m * 32 + r32, wc * WN + n * 32 + 16 * hh, acc0[m][n], acc1[m][n]);
    __syncthreads();
}

struct PlainA {
    const bf16_t* base; int lda;
    DI const bf16_t* rowptr(int, int row) const { return base + (size_t)row * lda; }
};
struct GatherA {
    const bf16_t* rp[8];
    DI const bf16_t* rowptr(int i, int) const { return rp[i]; }
};

struct XcdOrder {
    int base, lim, j, bpx;
    DI XcdOrder(int bid, int nblk, int total) {
        if ((nblk & 7) == 0) { const int x = bid & 7, per = (total + 7) >> 3; bpx = nblk >> 3; j = bid >> 3; base = x * per; lim = base + per < total ? base + per : total; }
        else { bpx = nblk; j = bid; base = 0; lim = total; }
    }
    DI int item(int i) const { const int q = base + i * bpx + j; return q < lim ? q : -1; }
};
DI void tile_rc(int q, int nrow, int ncol, int& r, int& c) {
    const int per_sr = 8 * ncol, sr = q / per_sr, rem = q - sr * per_sr, rows = (nrow - sr * 8) < 8 ? (nrow - sr * 8) : 8;
    c = rem / rows; r = sr * 8 + rem - c * rows;
}

DI u32x4 pack8v(const f32x4& a, const f32x4& b) { return (u32x4){pack2(a[0], a[1]), pack2(a[2], a[3]), pack2(b[0], b[1]), pack2(b[2], b[3])}; }
DI u32x4 pack8q(const f32x16& a, int q) { return (u32x4){pack2(a[8 * q], a[8 * q + 1]), pack2(a[8 * q + 2], a[8 * q + 3]), pack2(a[8 * q + 4], a[8 * q + 5]), pack2(a[8 * q + 6], a[8 * q + 7])}; }
struct EpiStoreBf16 { bf16_t* o; int ldo; DI void operator()(int r, int c, const f32x16& a, const f32x16&) const { *(u32x4*)(o + (size_t)r * ldo + c) = pack8q(a, 0); *(u32x4*)(o + (size_t)r * ldo + c + 8) = pack8q(a, 1); } };
DI void phase_mfma_rate(const Params& p, int n_mfma) {
    f32x4 acc[32];
#pragma unroll
    for (int i = 0; i < 32; ++i) acc[i] = (f32x4){0, 0, 0, 0};
    bf16x8 a = __builtin_bit_cast(bf16x8, *(const u32x4*)(p.ws + OFF_XN + threadIdx.x * 16)), b = __builtin_bit_cast(bf16x8, *(const u32x4*)(p.ws + OFF_XN + 8192 + threadIdx.x * 16));
#pragma unroll 1
    for (int it = 0; it < n_mfma; it += 32) {
#pragma unroll
        for (int i = 0; i < 32; ++i) acc[i] = __builtin_amdgcn_mfma_f32_16x16x32_bf16(a, b, acc[i], 0, 0, 0);
    }
    f32x4 sacc = acc[0];
#pragma unroll
    for (int i = 1; i < 32; ++i) sacc += acc[i];
    asm volatile("" :: "v"(sacc));
}
DI void phase_mfma_rate32(const Params& p, int n_mfma) {
    f32x16 acc[8];
#pragma unroll
    for (int i = 0; i < 8; ++i) acc[i] = zero16();
    bf16x8 a = __builtin_bit_cast(bf16x8, *(const u32x4*)(p.ws + OFF_XN + threadIdx.x * 16)), b = __builtin_bit_cast(bf16x8, *(const u32x4*)(p.ws + OFF_XN + 8192 + threadIdx.x * 16));
#pragma unroll 1
    for (int it = 0; it < n_mfma; it += 8) {
#pragma unroll
        for (int i = 0; i < 8; ++i) acc[i] = __builtin_amdgcn_mfma_f32_32x32x16_bf16(a, b, acc[i], 0, 0, 0);
    }
    f32x16 sacc = acc[0];
#pragma unroll
    for (int i = 1; i < 8; ++i) sacc += acc[i];
    asm volatile("" :: "v"(sacc));
}
DI void phase_g1(const Params& p, int bid, int nblk, char* lds) {
    const bf16_t* xn = (const bf16_t*)(p.ws + OFF_XN); bf16_t* u = (bf16_t*)(p.ws + OFF_U);
    const XcdOrder ord(bid, nblk, 65 * 19);
    for (int i = 0, q; (q = ord.item(i)) >= 0; ++i) {
        int tm, tn; tile_rc(q, 65, 19, tm, tn);
        PlainA al{xn + (size_t)tm * 256 * D, D};
        EpiStoreBf16 epi{u + (size_t)tm * 256 * DIN + tn * 128, DIN};
        gemm256<1, true>(al, (const bf16_t*)(p.ws + OFF_WINB) + tn * 128, nullptr, DIN, D, lds, epi);
    }
}

DI void phase_pool(const Params& p, int bid, int nblk) {
    const bf16_t* u = (const bf16_t*)(p.ws + OFF_U) + (size_t)CTX * DIN + C_POOL;
    bf16_t* mix = (bf16_t*)(p.ws + OFF_MIX);
    for (int item = bid * 256 + threadIdx.x; item < (S / 16) * 64; item += nblk * 256) {
        const int cg = item & 63, run = item >> 6, t0 = run * 16, gi = cg >> 4, win = 2 << gi, hw = win >> 1;
        const bf16_t* uc = u + cg * 8;
        float sum[8];
#pragma unroll
        for (int j = 0; j < 8; ++j) sum[j] = 0.f;
        int lo = t0 - hw, hi = t0 - hw + win; lo = lo < 0 ? 0 : lo; hi = hi > S ? S : hi;
        for (int tt = lo; tt < hi; ++tt) { float q[8]; unpack8(*(const u32x4*)(uc + (size_t)tt * DIN), q);
#pragma unroll
            for (int j = 0; j < 8; ++j) sum[j] += q[j]; }
        for (int k = 0; k < 16; ++k) {
            const int t = t0 + k;
            float cv[8], o[8]; unpack8(*(const u32x4*)(uc + (size_t)t * DIN), cv);
            const float inv = 1.f / (float)(hi - lo);
#pragma unroll
            for (int j = 0; j < 8; ++j) o[j] = sum[j] * inv - cv[j];
            *(u32x4*)(mix + (size_t)t * D + cg * 8) = pack8(o);
            const int nlo = t + 1 - hw, nhi = t + 1 - hw + win;
            if (nhi <= S) { float q[8]; unpack8(*(const u32x4*)(uc + (size_t)(nhi - 1) * DIN), q);
#pragma unroll
                for (int j = 0; j < 8; ++j) sum[j] += q[j]; hi = nhi; }
            if (nlo > 0) { float q[8]; unpack8(*(const u32x4*)(uc + (size_t)(nlo - 1) * DIN), q);
#pragma unroll
                for (int j = 0; j < 8; ++j) sum[j] -= q[j]; lo = nlo; }
        }
    }
}
struct EpiPool { bf16_t* o; const float* sc; DI void operator()(int r, int c, const f32x16& a, const f32x16&) const {
    f32x16 v = a;
#pragma unroll
    for (int q = 0; q < 4; ++q) { const f32x4 s4 = *(const f32x4*)(sc + c + 4 * q); v[4 * q] *= s4[0]; v[4 * q + 1] *= s4[1]; v[4 * q + 2] *= s4[2]; v[4 * q + 3] *= s4[3]; }
    *(u32x4*)(o + (size_t)r * D + c) = pack8q(v, 0); *(u32x4*)(o + (size_t)r * D + c + 8) = pack8q(v, 1); } };
DI void phase_poolgemm(const Params& p, int bid, int nblk, char* lds) {
    if (nblk <= 0) return;
    for (int it = bid; it < 4 * 64; it += nblk) {
        const int gi = it >> 6, tm = it & 63;
        const bf16_t* mix = (const bf16_t*)(p.ws + OFF_MIX);
        PlainA al{mix + (size_t)tm * 256 * D + gi * 128, D};
        EpiPool e{(bf16_t*)(p.ws + OFF_MIX) + (size_t)tm * 256 * D + 512 + gi * 128, p.pool_scale + gi * 128};
        int kk = 128; asm volatile("" : "+s"(kk));
        gemm256<1, false>(al, p.w_pool + (size_t)gi * 128 * 128, nullptr, 128, kk, lds, e);
    }
}

constexpr int MP = 72, MSZ = 64 * MP;
constexpr int FP = 68;
constexpr int SCANA_LDS = 14 * MSZ * 2 + 2048;
template <bool KS> DI bf16x8 frag32(const bf16_t* base, int x0, int s, int lane) {
    if (!KS) return *(const bf16x8*)(base + (x0 + (lane & 31)) * MP + 16 * s + 8 * (lane >> 5));
    const int gi = lane >> 4, i = lane & 15;
    const bf16_t* a = base + (16 * s + 8 * (gi >> 1) + (i >> 2)) * MP + x0 + 16 * (gi & 1) + 4 * (i & 3);
    s16x4 lo = tr16(a), hi = tr16(a + 4 * MP);
    return __builtin_shufflevector(lo, hi, 0, 1, 2, 3, 4, 5, 6, 7);
}
template <bool XKS, bool YKS> DI f32x16 mm32(const bf16_t* X, int x0, const bf16_t* Y, int y0, f32x16 acc, int lane) {
#pragma unroll
    for (int s = 0; s < 4; ++s) acc = __builtin_amdgcn_mfma_f32_32x32x16_bf16(frag32<XKS>(X, x0, s, lane), frag32<YKS>(Y, y0, s, lane), acc, 0, 0, 0);
    return acc;
}
template <class F> DI void store_acc(bf16_t* out, int x0, int y0, const f32x16& acc, int lane, F f) {
    const int y = y0 + (lane & 31), hh = lane >> 5;
#pragma unroll
    for (int q = 0; q < 4; ++q) {
        const int x = x0 + 8 * q + 4 * hh;
        u32x2 pk = {pack2(f(acc[4 * q], x, y), f(acc[4 * q + 1], x + 1, y)), pack2(f(acc[4 * q + 2], x + 2, y), f(acc[4 * q + 3], x + 3, y))};
        *(u32x2*)(out + y * MP + x) = pk;
    }
}
DI unsigned rot16(unsigned x) { return (x >> 16) | (x << 16); }

DI int chain_pos(int c, int dir) { return dir == 0 ? c : (c < 4 ? 3 - c : NCH + 3 - c); }

template <int STOP = 0> DI void phase_scanA(const Params& p, int bid, int nblk, char* lds) {
    const int tid = threadIdx.x, lane = tid & 63, w = tid >> 6, xq = 32 * (w & 1), yq = 32 * (w >> 1);
    bf16_t* M = (bf16_t*)lds;
    bf16_t *sAT = M, *sBT = M + MSZ, *sKT = M + 2 * MSZ, *sRT = M + 3 * MSZ, *sVT = M + 4 * MSZ;
    float* fGC = (float*)(lds + 14 * MSZ * 2);
    float* fSeg = fGC + 64;
    float* fLogw = (float*)(M + 12 * MSZ);
    float* fA = (float*)(M + 10 * MSZ);
    const bf16_t* u = (const bf16_t*)(p.ws + OFF_U);
    for (int inst = bid; inst < NCH * 16; inst += nblk) {
        const int c = inst >> 4, h = (inst >> 1) & 7, dir = inst & 1;
        const bool latent = c >= 4, want_g = latent && dir == 0;
        const float* w2 = dir ? p.w2_b : p.w2_f; const float* a2 = dir ? p.a2_b : p.a2_f;
        const float* w0 = dir ? p.w0_b : p.w0_f; const float* a0 = dir ? p.a0_b : p.a0_f;
        const float* rkd = dir ? p.r_k_b : p.r_k_f;
        const int cwl = dir ? C_WLB : C_WLF, cal = dir ? C_ALB : C_ALF;
        const int ch = tid & 7;
        float fr_[2][8], fk_[2][8], fv_[2][8];
        const int cols5[5] = {h * 64 + ch * 8, 512 + h * 64 + ch * 8, 1024 + h * 64 + ch * 8, cwl + ch * 8, cal + ch * 8};
        auto shift8 = [&](const u32x4* r3, int col, float mp, float mn, float* o) {
            float cc[8], pv[8], nx[8];
            unpack8(r3[0], cc); unpack8(r3[1], pv); unpack8(r3[2], nx);
            const f32x4 m0 = *(const f32x4*)(p.mu + col), m1 = *(const f32x4*)(p.mu + col + 4);
#pragma unroll
            for (int j = 0; j < 8; ++j) { const float m = j < 4 ? m0[j & 3] : m1[j & 3]; o[j] = cc[j] + m * ((mp * pv[j] + mn * nx[j]) - cc[j]); }
        };
#pragma unroll
        for (int i = 0; i < 2; ++i) {
            const int tau = (tid >> 3) + 32 * i, g = dir ? c * 64 + 63 - tau : c * 64 + tau;
            const bool hasp = (g != 0) && (g != CTX), hasn = (g != CTX - 1) && (g != NT - 1);
            const float mp = hasp ? 0.5f : 0.f, mn = hasn ? 0.5f : 0.f;
            const bf16_t* rc = u + (size_t)g * DIN; const bf16_t* rp = hasp ? rc - DIN : rc; const bf16_t* rn = hasn ? rc + DIN : rc;
            u32x4 raw[5][3], rawg[2][3]; f32x4 wl[8];
#pragma unroll
            for (int q = 0; q < 5; ++q) { raw[q][0] = *(const u32x4*)(rc + cols5[q]); raw[q][1] = *(const u32x4*)(rp + cols5[q]); raw[q][2] = *(const u32x4*)(rn + cols5[q]); }
            if (want_g) {
#pragma unroll
                for (int half = 0; half < 2; ++half) { const int col = C_GL + half * 64 + ch * 8;
                    rawg[half][0] = *(const u32x4*)(rc + col); rawg[half][1] = *(const u32x4*)(rp + col); rawg[half][2] = *(const u32x4*)(rn + col); }
            }
            if (i == 0) {
#pragma unroll
                for (int q = 0; q < 4; ++q) { const int idx = tid + 256 * q, kr = idx >> 4, n4 = idx & 15;
                    wl[q] = *(const f32x4*)(w2 + (size_t)kr * DR + h * 64 + n4 * 4); wl[4 + q] = *(const f32x4*)(a2 + (size_t)kr * DR + h * 64 + n4 * 4); }
            } else if (want_g) {
#pragma unroll
                for (int q = 0; q < 8; ++q) { const int idx = tid + 256 * q, kr = idx >> 4, n4 = idx & 15; wl[q] = *(const f32x4*)(p.g2 + (size_t)kr * DR + h * 64 + n4 * 4); }
            }
            shift8(raw[0], cols5[0], mp, mn, fr_[i]); shift8(raw[1], cols5[1], mp, mn, fk_[i]); shift8(raw[2], cols5[2], mp, mn, fv_[i]);
            float t8[8];
            shift8(raw[3], cols5[3], mp, mn, t8);
#pragma unroll
            for (int j = 0; j < 8; ++j) { const float e2 = __expf(2.f * t8[j]); t8[j] = 1.f - __fdividef(2.f, e2 + 1.f); }
            *(u32x4*)(M + 5 * MSZ + tau * MP + ch * 8) = pack8(t8);
            shift8(raw[4], cols5[4], mp, mn, t8);
            *(u32x4*)(M + 6 * MSZ + tau * MP + ch * 8) = pack8(t8);
            if (want_g) {
#pragma unroll
                for (int half = 0; half < 2; ++half) {
                    shift8(rawg[half], C_GL + half * 64 + ch * 8, mp, mn, t8);
#pragma unroll
                    for (int j = 0; j < 8; ++j) t8[j] = sigmoidf_(t8[j]);
                    *(u32x4*)(M + half * MSZ + tau * MP + ch * 8) = pack8(t8);
                }
            }
            if (i == 0) {
#pragma unroll
                for (int q = 0; q < 4; ++q) { const int idx = tid + 256 * q, kr = idx >> 4, n4 = idx & 15;
                    u32x2 pa = {pack2(wl[q][0], wl[q][1]), pack2(wl[q][2], wl[q][3])}, pb = {pack2(wl[4 + q][0], wl[4 + q][1]), pack2(wl[4 + q][2], wl[4 + q][3])};
                    *(u32x2*)(M + 7 * MSZ + kr * MP + n4 * 4) = pa; *(u32x2*)(M + 8 * MSZ + kr * MP + n4 * 4) = pb; }
            } else if (want_g) {
#pragma unroll
                for (int q = 0; q < 8; ++q) { const int idx = tid + 256 * q, kr = idx >> 4, n4 = idx & 15;
                    u32x2 pa = {pack2(wl[q][0], wl[q][1]), pack2(wl[q][2], wl[q][3])};
                    *(u32x2*)(M + (2 + (kr >> 6)) * MSZ + (kr & 63) * MP + n4 * 4) = pa; }
            }
        }
        __syncthreads();
        {
            f32x16 accW = mm32<true, false>(M + 7 * MSZ, xq, M + 5 * MSZ, yq, zero16(), lane);
            f32x16 accA = mm32<true, false>(M + 8 * MSZ, xq, M + 6 * MSZ, yq, zero16(), lane);
            const int y = yq + (lane & 31), hh = lane >> 5;
#pragma unroll
            for (int q = 0; q < 4; ++q) {
                const int x = xq + 8 * q + 4 * hh;
                f32x4 lw, av; const f32x4 w0v = *(const f32x4*)(w0 + h * 64 + x), a0v = *(const f32x4*)(a0 + h * 64 + x);
#pragma unroll
                for (int e = 0; e < 4; ++e) { lw[e] = -DECAY_SCALE * sigmoidf_(w0v[e] + accW[4 * q + e]); av[e] = sigmoidf_(a0v[e] + accA[4 * q + e]); }
                *(f32x4*)(fLogw + y * FP + x) = lw; *(f32x4*)(fA + y * FP + x) = av;
            }
        }
        if (want_g) {
            f32x16 accG = mm32<true, false>(M + 2 * MSZ, xq, M, yq, zero16(), lane);
            accG = mm32<true, false>(M + 3 * MSZ, xq, M + MSZ, yq, accG, lane);
            const int y = yq + (lane & 31), hh = lane >> 5, t = c * 64 + y - CTX;
#pragma unroll
            for (int q = 0; q < 4; ++q) {
                const int x = xq + 8 * q + 4 * hh;
                u32x2 pk = {pack2(accG[4 * q], accG[4 * q + 1]), pack2(accG[4 * q + 2], accG[4 * q + 3])};
                *(u32x2*)((bf16_t*)(p.ws + OFF_G) + (size_t)t * DR + h * 64 + x) = pk;
            }
        }
        __syncthreads();
        {
            const int n = tid & 63, qq = tid >> 6; float run = 0.f;
            for (int t = 16 * qq; t < 16 * qq + 16; ++t) { run += fLogw[t * FP + n]; fLogw[t * FP + n] = run; }
            fSeg[qq * 64 + n] = run;
        }
        __syncthreads();
        {
            const int n = tid & 63, qq = tid >> 6; float off = 0.f;
            for (int q2 = 0; q2 < qq; ++q2) off += fSeg[q2 * 64 + n];
            if (qq) for (int t = 16 * qq; t < 16 * qq + 16; ++t) fLogw[t * FP + n] += off;
        }
        __syncthreads();
#pragma unroll
        for (int i = 0; i < 2; ++i) {
            const int tau = (tid >> 3) + 32 * i, g = dir ? c * 64 + 63 - tau : c * 64 + tau;
            float oa[8], ob[8], ok[8], orr[8], kkv[8], kd[8];
            float ss = 0.f, dsum = 0.f;
            const int c8 = h * 64 + ch * 8;
            float kkp[8], kap[8], rkp[8];
            { const f32x4 a0_ = *(const f32x4*)(p.k_k + c8), a1_ = *(const f32x4*)(p.k_k + c8 + 4), b0_ = *(const f32x4*)(p.k_a + c8), b1_ = *(const f32x4*)(p.k_a + c8 + 4), c0_ = *(const f32x4*)(rkd + c8), c1_ = *(const f32x4*)(rkd + c8 + 4);
#pragma unroll
              for (int j = 0; j < 4; ++j) { kkp[j] = a0_[j]; kkp[4 + j] = a1_[j]; kap[j] = b0_[j]; kap[4 + j] = b1_[j]; rkp[j] = c0_[j]; rkp[4 + j] = c1_[j]; } }
#pragma unroll
            for (int j = 0; j < 8; ++j) { kkv[j] = fk_[i][j] * kkp[j]; ss += kkv[j] * kkv[j]; }
            ss += __shfl_xor(ss, 1, 64); ss += __shfl_xor(ss, 2, 64); ss += __shfl_xor(ss, 4, 64);
            const float inv = 1.f / fmaxf(sqrtf(ss), 1e-12f);
#pragma unroll
            for (int j = 0; j < 8; ++j) {
                const int jj = ch * 8 + j;
                const float cum = fLogw[tau * FP + jj], cprev = tau ? fLogw[(tau - 1) * FP + jj] : 0.f, av = fA[tau * FP + jj];
                const float gam = __expf(cum), gprev = __expf(cprev), ginv = __expf(-cum);
                const float kkn = kkv[j] * inv;
                kd[j] = fk_[i][j] * (1.f + (av - 1.f) * kap[j]);
                oa[j] = -kkn * gprev; ob[j] = kkn * av * ginv; ok[j] = kd[j] * ginv; orr[j] = fr_[i][j] * gam;
                dsum += fr_[i][j] * kd[j] * rkp[j];
                if (tau == 63) fGC[jj] = gam;
            }
            dsum += __shfl_xor(dsum, 1, 64); dsum += __shfl_xor(dsum, 2, 64); dsum += __shfl_xor(dsum, 4, 64);
            if (ch == 0) ((float*)(p.ws + OFF_DOT))[((size_t)g * 8 + h) * 2 + dir] = dsum;
            *(u32x4*)(sAT + tau * MP + ch * 8) = pack8(oa); *(u32x4*)(sBT + tau * MP + ch * 8) = pack8(ob);
            *(u32x4*)(sKT + tau * MP + ch * 8) = pack8(ok); *(u32x4*)(sRT + tau * MP + ch * 8) = pack8(orr);
            const u32x4 pv8 = pack8(fv_[i]);
            *(u32x4*)(sVT + tau * MP + ch * 8) = pv8;
            if (want_g) *(u32x4*)((bf16_t*)(p.ws + OFF_V) + (size_t)(g - CTX) * DR + h * 64 + ch * 8) = pv8;
        }
        __syncthreads();
        if (STOP == 1) continue;
        {
            f32x16 acc = mm32<false, false>(sAT, xq, sBT, yq, zero16(), lane);
            store_acc(M + 5 * MSZ, xq, yq, acc, lane, [](float v, int x, int y) { return y < x ? v : 0.f; });
            store_acc(M + 7 * MSZ, xq, yq, acc, lane, [](float v, int x, int y) { return y < x ? v : (y == x ? 1.f : 0.f); });
            acc = mm32<false, false>(sAT, xq, sKT, yq, zero16(), lane);
            store_acc(M + 9 * MSZ, xq, yq, acc, lane, [](float v, int x, int y) { return y < x ? v : 0.f; });
            acc = mm32<false, false>(sRT, xq, sBT, yq, zero16(), lane);
            store_acc(M + 10 * MSZ, xq, yq, acc, lane, [](float v, int x, int y) { return y <= x ? v : 0.f; });
            acc = mm32<false, false>(sRT, xq, sKT, yq, zero16(), lane);
            store_acc(M + 11 * MSZ, xq, yq, acc, lane, [](float v, int x, int y) { return y <= x ? v : 0.f; });
        }
        __syncthreads();
        int xs = 5, xo = 6, ts = 7, to = 8;
        {
            f32x16 acc = mm32<true, false>(M + xs * MSZ, xq, M + xs * MSZ, yq, zero16(), lane);
            store_acc(M + xo * MSZ, xq, yq, acc, lane, [](float v, int, int) { return v; });
            int t_ = xs; xs = xo; xo = t_;
        }
        __syncthreads();
        for (int k = 0; k < 5; ++k) {
            const bf16_t* Told = M + ts * MSZ;
            f32x16 acc = mm32<true, false>(M + xs * MSZ, xq, Told, yq, zero16(), lane);
            store_acc(M + to * MSZ, xq, yq, acc, lane, [Told](float v, int x, int y) { return v + bf2f(Told[y * MP + x]); });
            if (k < 4) {
                acc = mm32<true, false>(M + xs * MSZ, xq, M + xs * MSZ, yq, zero16(), lane);
                store_acc(M + xo * MSZ, xq, yq, acc, lane, [](float v, int, int) { return v; });
            }
            int t_ = xs; xs = xo; xo = t_; t_ = ts; ts = to; to = t_;
            __syncthreads();
        }
        if (STOP == 2) continue;
        const bf16_t* sT = M + ts * MSZ;
        {
            f32x16 acc = mm32<true, true>(sT, xq, sAT, yq, zero16(), lane);
            store_acc(M + 12 * MSZ, xq, yq, acc, lane, [](float v, int, int) { return v; });
            acc = mm32<true, false>(sT, xq, M + 9 * MSZ, yq, zero16(), lane);
            store_acc(M + 13 * MSZ, xq, yq, acc, lane, [](float v, int, int) { return v; });
        }
        __syncthreads();
        {
            const bf16_t *sAbar = M + 12 * MSZ, *sG = M + 13 * MSZ, *sABR = M + 10 * MSZ, *sAKR = M + 11 * MSZ;
            f32x16 acc = mm32<false, true>(sAbar, xq, sBT, yq, zero16(), lane);
            store_acc(M + 5 * MSZ, xq, yq, acc, lane, [fGC](float v, int x, int y) { return ((x == y ? 1.f : 0.f) + v) * fGC[y]; });
            acc = mm32<false, true>(sAbar, xq, sABR, yq, zero16(), lane);
            store_acc(M + 6 * MSZ, xq, yq, acc, lane, [sRT](float v, int x, int y) { return v + bf2f(sRT[y * MP + x]); });
            acc = mm32<true, false>(sBT, xq, sG, yq, zero16(), lane);
            store_acc(M + 7 * MSZ, xq, yq, acc, lane, [sKT, fGC](float v, int x, int y) { return (v + bf2f(sKT[y * MP + x])) * fGC[x]; });
            acc = mm32<true, false>(sABR, xq, sG, yq, zero16(), lane);
            store_acc(M + 9 * MSZ, xq, yq, acc, lane, [sAKR](float v, int x, int y) { return v + bf2f(sAKR[y * MP + x]); });
        }
        __syncthreads();
        const int chain = dir * 8 + h, npos = chain_pos(c, dir);
        {
            u32x4* Pg = (u32x4*)(p.ws + OFF_P) + ((size_t)chain * NCH + npos) * 512;
#pragma unroll
            for (int i = 0; i < 2; ++i) {
                const int item = tid + 256 * i, ln = item & 63, as = item >> 6, a = as >> 1, s2 = as & 1, fr = ln & 15, fq = ln >> 4;
                const bf16_t* src = M + 5 * MSZ + (16 * a + fr) * MP + 32 * s2 + 4 * fq;
                const u32x2 lo = *(const u32x2*)src, hi = *(const u32x2*)(src + 16);
                Pg[as * 64 + ln] = (u32x4){lo.x, lo.y, hi.x, hi.y};
            }
            if (latent) {
                u32x4* Wg = (u32x4*)(p.ws + OFF_WYT) + ((size_t)((c - 4) * 8 + h) * 2 + dir) * 512;
#pragma unroll
                for (int i = 0; i < 2; ++i) { const int item = tid + 256 * i, row = item >> 3, ck = item & 7; Wg[item] = *(const u32x4*)(M + 6 * MSZ + row * MP + ck * 8); }
            }
        }
        {
            f32x16 acc = mm32<true, true>(M + 7 * MSZ, xq, sVT, yq, zero16(), lane);
            store_acc(M + 12 * MSZ, xq, yq, acc, lane, [](float v, int, int) { return v; });
            acc = mm32<true, true>(M + 9 * MSZ, xq, sVT, yq, zero16(), lane);
            store_acc(M + 13 * MSZ, xq, yq, acc, lane, [](float v, int, int) { return v; });
        }
        __syncthreads();
        {
            u32x2* Qg = (u32x2*)(p.ws + OFF_Q) + ((size_t)chain * NCH + npos) * 1024;
#pragma unroll
            for (int i = 0; i < 4; ++i) {
                const int item = tid + 256 * i, ln = item & 63, wa = item >> 6, wi = wa >> 2, a = wa & 3, fr = ln & 15, fq = ln >> 4;
                Qg[item] = *(const u32x2*)(M + 12 * MSZ + (16 * wi + fr) * MP + 16 * a + 4 * fq);
            }
            if (latent) {
                u32x2* Yg = (u32x2*)(p.ws + OFF_YL) + ((size_t)((c - 4) * 8 + h) * 2 + dir) * 1024;
#pragma unroll
                for (int i = 0; i < 4; ++i) {
                    const int item = tid + 256 * i, ln = item & 63, wn = item >> 6, wt = wn >> 2, ni = wn & 3, fr = ln & 15, fq = ln >> 4;
                    const bf16_t* row = M + 13 * MSZ + (16 * ni + fr) * MP;
                    u32x2 v;
                    if (dir == 0) v = *(const u32x2*)(row + 16 * wt + 4 * fq);
                    else { const u32x2 r2 = *(const u32x2*)(row + 60 - 16 * wt - 4 * fq); v = (u32x2){rot16(r2.y), rot16(r2.x)}; }
                    Yg[item] = v;
                }
            }
        }
        __syncthreads();
    }
}

DI int grp_start(int g) { return g * 16 + (g < 4 ? g : 4); }
constexpr int CPF = 4;
DI u32x4 packz(const f32x4& a, const f32x4& b) { return (u32x4){pack2(a[0], a[1]), pack2(a[2], a[3]), pack2(b[0], b[1]), pack2(b[2], b[3])}; }
template <int PASS> DI void chain_run(const Params& p, int chain, int g) {
    const int lane = threadIdx.x & 63, w = threadIdx.x >> 6, fr = lane & 15, fq = lane >> 4;
    const int n0 = grp_start(g), n1 = grp_start(g + 1);
    const u32x4* Pg = (const u32x4*)(p.ws + OFF_P) + (size_t)chain * NCH * 512;
    const u32x2* Qg = (const u32x2*)(p.ws + OFF_Q) + (size_t)chain * NCH * 1024;
    u32x4* Zg = (u32x4*)(p.ws + OFF_Z) + (size_t)chain * NCH * 512;
    f32x4* ZG = (f32x4*)(p.ws + OFF_ZG) + ((size_t)(chain * 16 + g) * 4 + w) * 256;
    f32x4 acc[4], accp[4];
#pragma unroll
    for (int a = 0; a < 4; ++a) {
        if (PASS == 3) acc[a] = ZG[a * 64 + lane]; else acc[a] = (f32x4){0, 0, 0, 0};
#pragma unroll
        for (int e = 0; e < 4; ++e) accp[a][e] = (16 * a + 4 * fq + e == 16 * w + fr) ? 1.f : 0.f;
    }
    u32x4 pf[CPF][8]; u32x2 qf[CPF][4];
#pragma unroll
    for (int st = 0; st < CPF; ++st) if (n0 + st < n1) {
#pragma unroll
        for (int i = 0; i < 8; ++i) pf[st][i] = Pg[(size_t)(n0 + st) * 512 + i * 64 + lane];
#pragma unroll
        for (int a = 0; a < 4; ++a) qf[st][a] = Qg[(size_t)(n0 + st) * 1024 + (w * 4 + a) * 64 + lane];
    }
    for (int nb = n0; nb < n1; nb += CPF) {
#pragma unroll
        for (int st = 0; st < CPF; ++st) {
            const int n = nb + st;
            if (n < n1) {
                u32x4 pc[8]; u32x2 qc[4];
#pragma unroll
                for (int i = 0; i < 8; ++i) pc[i] = pf[st][i];
#pragma unroll
                for (int a = 0; a < 4; ++a) qc[a] = qf[st][a];
                if (n + CPF < n1) {
#pragma unroll
                    for (int i = 0; i < 8; ++i) pf[st][i] = Pg[(size_t)(n + CPF) * 512 + i * 64 + lane];
#pragma unroll
                    for (int a = 0; a < 4; ++a) qf[st][a] = Qg[(size_t)(n + CPF) * 1024 + (w * 4 + a) * 64 + lane];
                }
                const u32x4 z0 = packz(acc[0], acc[1]), z1 = packz(acc[2], acc[3]);
                if (PASS == 3) { Zg[((size_t)n * 4 + w) * 128 + lane] = z0; Zg[((size_t)n * 4 + w) * 128 + 64 + lane] = z1; }
                const bf16x8 zb0 = __builtin_bit_cast(bf16x8, z0), zb1 = __builtin_bit_cast(bf16x8, z1);
#pragma unroll
                for (int a = 0; a < 4; ++a) {
                    f32x4 ini = {bflo(qc[a].x), bfhi(qc[a].x), bflo(qc[a].y), bfhi(qc[a].y)};
                    ini = __builtin_amdgcn_mfma_f32_16x16x32_bf16(__builtin_bit_cast(bf16x8, pc[2 * a]), zb0, ini, 0, 0, 0);
                    acc[a] = __builtin_amdgcn_mfma_f32_16x16x32_bf16(__builtin_bit_cast(bf16x8, pc[2 * a + 1]), zb1, ini, 0, 0, 0);
                }
                if (PASS == 1) {
                    const bf16x8 yb0 = __builtin_bit_cast(bf16x8, packz(accp[0], accp[1])), yb1 = __builtin_bit_cast(bf16x8, packz(accp[2], accp[3]));
#pragma unroll
                    for (int a = 0; a < 4; ++a) {
                        f32x4 t4 = __builtin_amdgcn_mfma_f32_16x16x32_bf16(__builtin_bit_cast(bf16x8, pc[2 * a]), yb0, (f32x4){0, 0, 0, 0}, 0, 0, 0);
                        accp[a] = __builtin_amdgcn_mfma_f32_16x16x32_bf16(__builtin_bit_cast(bf16x8, pc[2 * a + 1]), yb1, t4, 0, 0, 0);
                    }
                }
            }
        }
    }
    if (PASS == 1) {
        f32x4* CQ = (f32x4*)(p.ws + OFF_CQ) + ((size_t)(chain * 16 + g) * 4 + w) * 256;
        bf16_t* CP = (bf16_t*)(p.ws + OFF_CP) + (size_t)(chain * 16 + g) * 4096;
#pragma unroll
        for (int a = 0; a < 4; ++a) {
            CQ[a * 64 + lane] = acc[a];
#pragma unroll
            for (int e = 0; e < 4; ++e) CP[(16 * a + 4 * fq + e) * 64 + 16 * w + fr] = (bf16_t)(pack2(accp[a][e], 0.f) & 0xffffu);
        }
    }
}
DI void chain_groups(const Params& p, int chain) {
    const int lane = threadIdx.x & 63, w = threadIdx.x >> 6, fr = lane & 15, fq = lane >> 4;
    f32x4 acc[4];
#pragma unroll
    for (int a = 0; a < 4; ++a) acc[a] = (f32x4){0, 0, 0, 0};
    u32x4 pf[CPF][8]; f32x4 qf[CPF][4];
    auto load = [&](int st, int g) {
        const bf16_t* CP = (const bf16_t*)(p.ws + OFF_CP) + (size_t)(chain * 16 + g) * 4096;
        const f32x4* CQ = (const f32x4*)(p.ws + OFF_CQ) + ((size_t)(chain * 16 + g) * 4 + w) * 256;
#pragma unroll
        for (int i = 0; i < 8; ++i) { const int a = i >> 1, s2 = i & 1; const bf16_t* src = CP + (16 * a + fr) * 64 + 32 * s2 + 4 * fq;
            const u32x2 lo = *(const u32x2*)src, hi = *(const u32x2*)(src + 16); pf[st][i] = (u32x4){lo.x, lo.y, hi.x, hi.y}; }
#pragma unroll
        for (int a = 0; a < 4; ++a) qf[st][a] = CQ[a * 64 + lane];
    };
#pragma unroll
    for (int st = 0; st < CPF; ++st) load(st, st);
    for (int gb = 0; gb < 16; gb += CPF) {
#pragma unroll
        for (int st = 0; st < CPF; ++st) {
            const int g = gb + st;
            u32x4 pc[8]; f32x4 qc[4];
#pragma unroll
            for (int i = 0; i < 8; ++i) pc[i] = pf[st][i];
#pragma unroll
            for (int a = 0; a < 4; ++a) qc[a] = qf[st][a];
            if (g + CPF < 16) load(st, g + CPF);
            f32x4* ZG = (f32x4*)(p.ws + OFF_ZG) + ((size_t)(chain * 16 + g) * 4 + w) * 256;
#pragma unroll
            for (int a = 0; a < 4; ++a) ZG[a * 64 + lane] = acc[a];
            const bf16x8 zb0 = __builtin_bit_cast(bf16x8, packz(acc[0], acc[1])), zb1 = __builtin_bit_cast(bf16x8, packz(acc[2], acc[3]));
#pragma unroll
            for (int a = 0; a < 4; ++a) {
                f32x4 ini = __builtin_amdgcn_mfma_f32_16x16x32_bf16(__builtin_bit_cast(bf16x8, pc[2 * a]), zb0, qc[a], 0, 0, 0);
                acc[a] = __builtin_amdgcn_mfma_f32_16x16x32_bf16(__builtin_bit_cast(bf16x8, pc[2 * a + 1]), zb1, ini, 0, 0, 0);
            }
        }
    }
}

DI void phase_scanC(const Params& p, int bid, int nblk, char* lds) {
    const int lane = threadIdx.x & 63, w = threadIdx.x >> 6, fr = lane & 15, fq = lane >> 4;
    bf16_t* mix = (bf16_t*)(p.ws + OFF_MIX);
    const float* dot = (const float*)(p.ws + OFF_DOT);
    for (int unit = bid; unit < 256 * 8; unit += nblk) {
        const int c = 4 + (unit >> 3), h = unit & 7;
        f32x4 y[4];
#pragma unroll
        for (int ni = 0; ni < 4; ++ni) y[ni] = (f32x4){0, 0, 0, 0};
#pragma unroll
        for (int dir = 0; dir < 2; ++dir) {
            const int chain = dir * 8 + h, npos = chain_pos(c, dir);
            const u32x4* Zg = (const u32x4*)(p.ws + OFF_Z) + ((size_t)chain * NCH + npos) * 512;
            const bf16_t* Wg = (const bf16_t*)(p.ws + OFF_WYT) + ((size_t)((c - 4) * 8 + h) * 2 + dir) * 4096;
            const u32x2* Yg = (const u32x2*)(p.ws + OFF_YL) + ((size_t)((c - 4) * 8 + h) * 2 + dir) * 1024;
            const int rho = 16 * w + fr, row = dir ? 63 - rho : rho;
            bf16x8 af[2];
#pragma unroll
            for (int s2 = 0; s2 < 2; ++s2) {
                const u32x2 lo = *(const u32x2*)(Wg + row * 64 + 32 * s2 + 4 * fq), hi = *(const u32x2*)(Wg + row * 64 + 32 * s2 + 16 + 4 * fq);
                af[s2] = __builtin_bit_cast(bf16x8, (u32x4){lo.x, lo.y, hi.x, hi.y});
            }
#pragma unroll
            for (int ni = 0; ni < 4; ++ni) {
                const u32x2 yl = Yg[(w * 4 + ni) * 64 + lane];
                f32x4 acc = {bflo(yl.x), bfhi(yl.x), bflo(yl.y), bfhi(yl.y)};
                acc = __builtin_amdgcn_mfma_f32_16x16x32_bf16(af[0], __builtin_bit_cast(bf16x8, Zg[(ni * 2 + 0) * 64 + lane]), acc, 0, 0, 0);
                acc = __builtin_amdgcn_mfma_f32_16x16x32_bf16(af[1], __builtin_bit_cast(bf16x8, Zg[(ni * 2 + 1) * 64 + lane]), acc, 0, 0, 0);
                y[ni] += acc;
            }
        }
        float* ty = (float*)lds + w * (16 * 68);
#pragma unroll
        for (int ni = 0; ni < 4; ++ni)
#pragma unroll
            for (int e = 0; e < 4; ++e) ty[(4 * fq + e) * 68 + 16 * ni + fr] = y[ni][e];
        asm volatile("s_waitcnt lgkmcnt(0)" ::: "memory"); __builtin_amdgcn_wave_barrier();
        {
            const int tl = lane >> 2, seg = lane & 3, t = (c - 4) * 64 + 16 * w + tl, g = t + CTX, cch = h * 64 + 16 * seg;
            float yv[16];
#pragma unroll
            for (int q = 0; q < 4; ++q) { const f32x4 v4 = *(const f32x4*)(ty + tl * 68 + 16 * seg + 4 * q); yv[4 * q] = v4[0]; yv[4 * q + 1] = v4[1]; yv[4 * q + 2] = v4[2]; yv[4 * q + 3] = v4[3]; }
            float sm = 0.f;
#pragma unroll
            for (int j = 0; j < 16; ++j) sm += yv[j];
            sm += __shfl_xor(sm, 1, 64); sm += __shfl_xor(sm, 2, 64);
            const float mean = sm * (1.f / 64.f);
            float q2 = 0.f;
#pragma unroll
            for (int j = 0; j < 16; ++j) { const float d = yv[j] - mean; q2 += d * d; }
            q2 += __shfl_xor(q2, 1, 64); q2 += __shfl_xor(q2, 2, 64);
            const float rs = rsqrtf(q2 * (1.f / 64.f) + 64e-5f);
            const float bon = dot[((size_t)g * 8 + h) * 2] + dot[((size_t)g * 8 + h) * 2 + 1];
            float vv[16], gg[16], o[16];
            unpack8(*(const u32x4*)((const bf16_t*)(p.ws + OFF_V) + (size_t)t * DR + cch), vv); unpack8(*(const u32x4*)((const bf16_t*)(p.ws + OFF_V) + (size_t)t * DR + cch + 8), vv + 8);
            unpack8(*(const u32x4*)((const bf16_t*)(p.ws + OFF_G) + (size_t)t * DR + cch), gg); unpack8(*(const u32x4*)((const bf16_t*)(p.ws + OFF_G) + (size_t)t * DR + cch + 8), gg + 8);
#pragma unroll
            for (int q = 0; q < 4; ++q) {
                const f32x4 gw = *(const f32x4*)(p.gn_w + cch + 4 * q), gb = *(const f32x4*)(p.gn_b + cch + 4 * q);
#pragma unroll
                for (int j = 0; j < 4; ++j) o[4 * q + j] = ((yv[4 * q + j] - mean) * rs * gw[j] + gb[j] + bon * vv[4 * q + j]) * gg[4 * q + j];
            }
            *(u32x4*)(mix + (size_t)t * D + cch) = pack8(o); *(u32x4*)(mix + (size_t)t * D + cch + 8) = pack8(o + 8);
        }
        __builtin_amdgcn_wave_barrier();
    }
}

struct EpiX2 { float* o; const float* x; const float* gt; const float* rowtab; const float* coltab; int row0, col0;
    DI void operator()(int r, int c, const f32x16& a, const f32x16&) const {
        const int t = row0 + r, d = col0 + c;
        const float* pt = d < 512 ? rowtab + (t >> 6) * 512 + d : coltab + (t & 63) * 512 + (d - 512);
#pragma unroll
        for (int q = 0; q < 4; ++q) {
            const f32x4 xv = *(const f32x4*)(x + (size_t)t * D + d + 4 * q), pv = *(const f32x4*)(pt + 4 * q), gv = *(const f32x4*)(gt + d + 4 * q);
            const f32x4 av = {a[4 * q], a[4 * q + 1], a[4 * q + 2], a[4 * q + 3]};
            *(f32x4*)(o + (size_t)t * D + d + 4 * q) = xv + pv + gv * av;
        } } };
DI void phase_g2(const Params& p, int bid, int nblk, char* lds) {
    const bf16_t* mix = (const bf16_t*)(p.ws + OFF_MIX);
    const XcdOrder ord(bid, nblk, 64 * 8);
    for (int i = 0, q; (q = ord.item(i)) >= 0; ++i) {
        int tm, tn; tile_rc(q, 64, 8, tm, tn);
        PlainA al{mix + (size_t)tm * 256 * D, D};
        EpiX2 e{(float*)(p.ws + OFF_X2), p.x, (const float*)(p.ws + OFF_MODX) + 2048, (const float*)(p.ws + OFF_ROWTAB), (const float*)(p.ws + OFF_COLTAB), tm * 256, tn * 128};
        gemm256<1, true>(al, (const bf16_t*)(p.ws + OFF_WOUTB) + tn * 128, nullptr, D, D, lds, e);
    }
}

DI float router_w(const Params& p, int k, int n) { return n < 4 ? p.w_rg[k * 4 + n] : (n < 36 ? p.w_re[k * 32 + (n - 4)] : 0.f); }
DI void phase_router_prep(const Params& p, int bid, int nblk) {
    const float* modx = (const float*)(p.ws + OFF_MODX);
    float* wp = (float*)(p.ws + OFF_WP); float* b2 = (float*)(p.ws + OFF_B2);
    for (int idx = bid * 256 + threadIdx.x; idx < 64 * 4 * 3 * 64; idx += nblk * 256) {
        const int ln = idx & 63, r = idx >> 6, nt = r % 3, me = r / 3, e = me & 3, m = me >> 2;
        const int k = 16 * m + 4 * (ln >> 4) + e, n = 16 * nt + (ln & 15);
        wp[idx] = p.norm2_g[k] * (1.f + modx[4096 + k]) * router_w(p, k, n);
    }
    const int lane = threadIdx.x & 63, wv = bid * 4 + (threadIdx.x >> 6);
    if (wv < 36) {
        float sacc = 0.f;
        for (int k = lane; k < D; k += 64) sacc += modx[3072 + k] * router_w(p, k, wv);
        sacc = wave_sum(sacc);
        if (lane == 0) b2[wv] = sacc + (wv < 4 ? p.b_rg[wv] : p.b_re[wv - 4]);
    }
}

DI void phase_router(const Params& p, int bid, int nblk, char* lds, bool dry = false) {
    const int lane = threadIdx.x & 63, wid = threadIdx.x >> 6, tr = lane & 15, kq = lane >> 4;
    const float* x2 = (const float*)(p.ws + OFF_X2); const float* modx = (const float*)(p.ws + OFF_MODX);
    const float* wp = (const float*)(p.ws + OFF_WP); const float* b2 = (const float*)(p.ws + OFF_B2);
    bf16_t* h2 = (bf16_t*)(p.ws + OFF_H2); int* cnt = (int*)(p.ws + OFF_CNT); float* gate = (float*)(p.ws + OFF_GATE); int* list = (int*)(p.ws + OFF_LIST);
    float* slog = (float*)lds + wid * (16 * 49);
    for (int task = bid * 4 + wid; task < S / 16; task += nblk * 4) {
        const int t0 = task * 16;
        const float* xr = x2 + (size_t)(t0 + tr) * D + 4 * kq;
        f32x4 acc[3];
#pragma unroll
        for (int i = 0; i < 3; ++i) acc[i] = (f32x4){0, 0, 0, 0};
        float ss = 0.f;
#pragma unroll 4
        for (int m = 0; m < 64; ++m) {
            const f32x4 xv = *(const f32x4*)(xr + 16 * m);
            ss += xv[0] * xv[0] + xv[1] * xv[1] + xv[2] * xv[2] + xv[3] * xv[3];
#pragma unroll
            for (int e = 0; e < 4; ++e)
#pragma unroll
                for (int nt = 0; nt < 3; ++nt) acc[nt] = __builtin_amdgcn_mfma_f32_16x16x4f32(xv[e], wp[((m * 4 + e) * 3 + nt) * 64 + lane], acc[nt], 0, 0, 0);
        }
        ss += __shfl_xor(ss, 16, 64); ss += __shfl_xor(ss, 32, 64);
        const float rstd = rsqrtf(ss * (1.f / 1024.f) + 1e-6f);
#pragma unroll
        for (int nt = 0; nt < 3; ++nt)
#pragma unroll
            for (int r = 0; r < 4; ++r) slog[(4 * kq + r) * 49 + 16 * nt + tr] = acc[nt][r];
        asm volatile("s_waitcnt lgkmcnt(0)" ::: "memory"); __builtin_amdgcn_wave_barrier();
        if (lane < 16) {
            const int t = t0 + lane;
            const float* lg = slog + lane * 49;
            const float l0 = rstd * lg[0] + b2[0], l1 = rstd * lg[1] + b2[1], l2 = rstd * lg[2] + b2[2], l3 = rstd * lg[3] + b2[3];
            int grp = 0; float mx = l0;
            if (l1 > mx) { mx = l1; grp = 1; }
            if (l2 > mx) { mx = l2; grp = 2; }
            if (l3 > mx) { mx = l3; grp = 3; }
            const float den = __expf(l0 - mx) + __expf(l1 - mx) + __expf(l2 - mx) + __expf(l3 - mx);
            const float pgrp = 1.f / den;
            int i1 = 0, i2 = -1; float v1 = -3.0e38f, v2 = -3.0e38f;
            for (int n = 0; n < 8; ++n) {
                const float sv = rstd * lg[4 + grp * 8 + n] + b2[4 + grp * 8 + n];
                if (sv > v1) { v2 = v1; i2 = i1; v1 = sv; i1 = n; } else if (sv > v2) { v2 = sv; i2 = n; }
            }
            const float e2 = __expf(v2 - v1), g1 = pgrp / (1.f + e2), g2v = pgrp * e2 / (1.f + e2);
            const int ea = grp * 8 + i1, eb = grp * 8 + i2;
            if (!dry) {
                const int pa = atomicAdd(&cnt[ea], 1), pb = atomicAdd(&cnt[eb], 1);
                list[ea * LCAP + pa] = t * 2; list[eb * LCAP + pb] = t * 2 + 1;
            }
            gate[t * 2] = g1; gate[t * 2 + 1] = g2v;
        }
        for (int r = 0; r < 16; ++r) {
            const float rs = __shfl(rstd, r, 64);
            const float* src = x2 + (size_t)(t0 + r) * D;
#pragma unroll
            for (int i = 0; i < 4; ++i) {
                const int d = (i * 64 + lane) * 4;
                const f32x4 v = *(const f32x4*)(src + d), gg = *(const f32x4*)(p.norm2_g + d), sh = *(const f32x4*)(modx + 3072 + d), sc = *(const f32x4*)(modx + 4096 + d);
                f32x4 hv;
#pragma unroll
                for (int j = 0; j < 4; ++j) hv[j] = (v[j] * rs * gg[j]) * (1.f + sc[j]) + sh[j];
                u32x2 pk = {pack2(hv[0], hv[1]), pack2(hv[2], hv[3])};
                *(u32x2*)(h2 + (size_t)(t0 + r) * D + d) = pk;
            }
        }
        __builtin_amdgcn_wave_barrier();
    }
}

DI void moe_tiles(const int* cnt, int* tstart  ) {
    if (threadIdx.x == 0) { int acc = 0; for (int e = 0; e < NE; ++e) { tstart[e] = acc; acc += (cnt[e] + 255) >> 8; } tstart[NE] = acc; }
    __syncthreads();
}
struct EpiHid { bf16_t* o; DI void operator()(int r, int c, const f32x16& g, const f32x16& u) const {
    f32x16 h;
#pragma unroll
    for (int j = 0; j < 16; ++j) h[j] = g[j] * sigmoidf_(g[j]) * u[j];
    *(u32x4*)(o + (size_t)r * DE + c) = pack8q(h, 0); *(u32x4*)(o + (size_t)r * DE + c + 8) = pack8q(h, 1); } };
DI void phase_g3(const Params& p, int bid, int nblk, char* lds) {
    int* tstart = (int*)(lds + GEMM_LDS);
    const int* cnt = (const int*)(p.ws + OFF_CNT); const int* list = (const int*)(p.ws + OFF_LIST);
    const bf16_t* h2 = (const bf16_t*)(p.ws + OFF_H2); bf16_t* hid = (bf16_t*)(p.ws + OFF_HID);
    moe_tiles(cnt, tstart);
    const int ntiles = tstart[NE];
    const XcdOrder ord(bid, nblk, ntiles * 8);
    for (int i = 0, item; (item = ord.item(i)) >= 0; ++i) {
        const int ti = item >> 3, cj = item & 7;
        int e = 0; while (e < NE - 1 && tstart[e + 1] <= ti) ++e;
        const int lt = ti - tstart[e], ne = cnt[e];
        GatherA al;
#pragma unroll
        for (int i = 0; i < 8; ++i) { const int row = (4 * i + (threadIdx.x >> 6)) * 8 + ((threadIdx.x & 63) >> 3), pos = lt * 256 + row; const int tok = pos < ne ? (list[e * LCAP + pos] >> 1) : 0; al.rp[i] = h2 + (size_t)tok * D; }
        EpiHid epi{hid + (size_t)ti * 256 * DE + cj * 64};
        gemm256<2, false>(al, p.w_gate + (size_t)e * D * DE + cj * 64, p.w_up + (size_t)e * D * DE + cj * 64, DE, D, lds, epi);
    }
}
struct EpiDown { bf16_t* ybuf; const int* lst; const float* gate; int nvalid; int col0;
    DI void operator()(int r, int c, const f32x16& a, const f32x16&) const {
        if (r >= nvalid) return; const int slot = lst[r]; const float g = gate[slot];
        const f32x16 v = a * g;
        *(u32x4*)(ybuf + (size_t)slot * D + col0 + c) = pack8q(v, 0); *(u32x4*)(ybuf + (size_t)slot * D + col0 + c + 8) = pack8q(v, 1); } };
DI void phase_g4(const Params& p, int bid, int nblk, char* lds) {
    int* tstart = (int*)(lds + GEMM_LDS);
    const int* cnt = (const int*)(p.ws + OFF_CNT); const int* list = (const int*)(p.ws + OFF_LIST);
    const bf16_t* hid = (const bf16_t*)(p.ws + OFF_HID);
    moe_tiles(cnt, tstart);
    const int ntiles = tstart[NE];
    const XcdOrder ord(bid, nblk, ntiles * 8);
    for (int i = 0, item; (item = ord.item(i)) >= 0; ++i) {
        const int ti = item >> 3, cj = item & 7;
        int e = 0; while (e < NE - 1 && tstart[e + 1] <= ti) ++e;
        const int lt = ti - tstart[e], ne = cnt[e];
        PlainA al{hid + (size_t)ti * 256 * DE, DE};
        EpiDown epi{(bf16_t*)(p.ws + OFF_YBUF), list + e * LCAP + lt * 256, (const float*)(p.ws + OFF_GATE), ne - lt * 256, cj * 128};
        gemm256<1, false>(al, p.w_down + (size_t)e * DE * D + cj * 128, nullptr, D, DE, lds, epi);
    }
}

DI void phase_final(const Params& p, int bid, int nblk) {
    const int lane = threadIdx.x & 63, wid = threadIdx.x >> 6;
    const float* x2 = (const float*)(p.ws + OFF_X2); const float* gt = (const float*)(p.ws + OFF_MODX) + 5120; const bf16_t* yb = (const bf16_t*)(p.ws + OFF_YBUF);
    for (int t = bid * 4 + wid; t < S; t += nblk * 4) {
        f32x4 v[4]; float ss = 0.f;
#pragma unroll
        for (int i = 0; i < 4; ++i) {
            const int d = (i * 64 + lane) * 4;
            v[i] = *(const f32x4*)(x2 + (size_t)t * D + d);
            const u32x2 a = *(const u32x2*)(yb + (size_t)(2 * t) * D + d), b = *(const u32x2*)(yb + (size_t)(2 * t + 1) * D + d);
            const f32x4 g = *(const f32x4*)(gt + d);
            v[i][0] += g[0] * (bflo(a.x) + bflo(b.x)); v[i][1] += g[1] * (bfhi(a.x) + bfhi(b.x));
            v[i][2] += g[2] * (bflo(a.y) + bflo(b.y)); v[i][3] += g[3] * (bfhi(a.y) + bfhi(b.y));
            ss += v[i][0] * v[i][0] + v[i][1] * v[i][1] + v[i][2] * v[i][2] + v[i][3] * v[i][3];
        }
        ss = wave_sum(ss);
        const float rstd = rsqrtf(ss * (1.f / 1024.f) + 1e-6f);
#pragma unroll
        for (int i = 0; i < 4; ++i) {
            const int d = (i * 64 + lane) * 4; const f32x4 fg = *(const f32x4*)(p.final_g + d); f32x4 o;
#pragma unroll
            for (int j = 0; j < 4; ++j) o[j] = v[i][j] * rstd * fg[j];
            *(f32x4*)(p.out + (size_t)t * D + d) = o;
        }
    }
}

#define XB_TMO      128
#define XB_XCNT(j)  (256  + 64 * (j))
#define XB_XSUB(j)  (1280 + 64 * (j))
#define XB_XGEN(j)  (2304 + 64 * (j))
#define XB_TOP      3328
#define XB_TOPGEN   3392
#define XCD_BAR_WORDS 3456
#define XB_SPIN_CAP (1u << 18)
DI unsigned xb_ld(unsigned* p) { return __hip_atomic_load(p, __ATOMIC_RELAXED, __HIP_MEMORY_SCOPE_AGENT); }
DI unsigned xb_add(unsigned* p, unsigned v) { return __hip_atomic_fetch_add(p, v, __ATOMIC_RELAXED, __HIP_MEMORY_SCOPE_AGENT); }
DI unsigned xb_xcc_id() { return (unsigned)__builtin_amdgcn_s_getreg((3 << 11) | 20) & 0xFu; }
#define XB_SPIN(cond, bar) do { unsigned _sp = 0; while (cond) { __builtin_amdgcn_s_sleep(1); \
    if ((++_sp & 255u) == 0u) { if (xb_ld(&(bar)[XB_TMO])) break; if (_sp > XB_SPIN_CAP) { atomicAdd(&(bar)[XB_TMO], 1u); break; } } } } while (0)
struct XcdBarrier { unsigned* bar; unsigned x; volatile LAS unsigned* st; };
DI XcdBarrier xcd_barrier_post(unsigned* bar, volatile LAS unsigned* st) {
    XcdBarrier b; b.bar = bar; b.x = xb_xcc_id(); b.st = st;
    if (threadIdx.x == 0) (void)xb_add(&bar[XB_XCNT(b.x)], 1u);
    return b;
}
DI void xcd_barrier_complete(unsigned* bar, unsigned x, unsigned& nloc, unsigned& nx) {
    const unsigned G = gridDim.x * gridDim.y * gridDim.z;
    unsigned sum, cnt, mine, sp = 0u;
    for (;;) {
        sum = 0u; cnt = 0u; mine = 0u;
#pragma unroll
        for (unsigned j = 0; j < 16; ++j) { const unsigned c = xb_ld(&bar[XB_XCNT(j)]); sum += c; cnt += (c > 0u) ? 1u : 0u; mine = (j == x) ? c : mine; }
        if (sum == G) break;
        __builtin_amdgcn_s_sleep(1);
        if ((++sp & 255u) == 0u) { if (xb_ld(&bar[XB_TMO])) break; if (sp > XB_SPIN_CAP) { atomicAdd(&bar[XB_TMO], 1u); break; } }
    }
    nloc = mine > 0u ? mine : 1u; nx = cnt > 0u ? cnt : 1u;
}
DI void xcd_barrier(const XcdBarrier& b) {
    asm volatile("s_waitcnt vmcnt(0)" ::: "memory");
    __syncthreads();
    if (threadIdx.x == 0) {
        unsigned* bar = b.bar;
        __builtin_amdgcn_s_waitcnt(0);
        unsigned nloc = b.st[0], nx = b.st[1];
        if (nloc == 0u) { xcd_barrier_complete(bar, b.x, nloc, nx); b.st[0] = nloc; b.st[1] = nx; }
        const unsigned old = xb_add(&bar[XB_XSUB(b.x)], 1u);
        const unsigned gen = old / nloc;
        if (old + 1u == (gen + 1u) * nloc) {
            __builtin_amdgcn_fence(__ATOMIC_RELEASE, "agent");
            asm volatile("s_waitcnt vmcnt(0)" ::: "memory");
            const unsigned og = xb_add(&bar[XB_TOP], 1u);
            const unsigned tg = og / nx;
            if (og + 1u == (tg + 1u) * nx) xb_add(&bar[XB_TOPGEN], 1u);
            else XB_SPIN(xb_ld(&bar[XB_TOPGEN]) == tg, bar);
            __builtin_amdgcn_fence(__ATOMIC_ACQUIRE, "agent");
            xb_add(&bar[XB_XGEN(b.x)], 1u);
            asm volatile("s_waitcnt vmcnt(0)" ::: "memory");
        } else {
            XB_SPIN(xb_ld(&bar[XB_XGEN(b.x)]) == gen, bar);
            __builtin_amdgcn_fence(__ATOMIC_ACQUIRE, "agent");
            asm volatile("s_waitcnt vmcnt(0)" ::: "memory");
        }
    }
    __syncthreads();
}

#ifndef PROBE
#define PROBE 0
#endif
constexpr int MEGA_LDS = SCANA_LDS > (GEMM_LDS + 256) ? SCANA_LDS : (GEMM_LDS + 256);
__global__ void __launch_bounds__(256) k_mega(Params p) {
    extern __shared__ __attribute__((aligned(16))) char lds[];
    const int bid = blockIdx.x, nblk = gridDim.x;
    volatile LAS unsigned* st = (volatile LAS unsigned*)(lds + MEGA_LDS);
    if (threadIdx.x < 4) st[threadIdx.x] = 0u;
    __syncthreads();
    const XcdBarrier gb = xcd_barrier_post((unsigned*)(p.ws + OFF_BAR), st);
#define GSYNC() xcd_barrier(gb)
    phase_p0(p, bid, nblk, lds); GSYNC();
    if (PROBE == 1) { phase_p0(p, bid, nblk, lds); GSYNC(); }
    phase_xn(p, bid, nblk); phase_router_prep(p, bid, nblk); GSYNC();
    if (PROBE == 2) { phase_xn(p, bid, nblk); GSYNC(); }
    phase_g1(p, bid, nblk, lds); GSYNC();
    if (PROBE == 3) { phase_g1(p, bid, nblk, lds); GSYNC(); }
    if (PROBE == 33) { phase_mfma_rate(p, 5120); GSYNC(); }
    if (PROBE == 34) { phase_mfma_rate32(p, 2560); GSYNC(); }
    phase_pool(p, bid, nblk);
    phase_scanA(p, bid, nblk, lds); GSYNC();
    if (PROBE == 4) { phase_scanA(p, bid, nblk, lds); GSYNC(); }
    if (PROBE == 41) { phase_scanA<1>(p, bid, nblk, lds); GSYNC(); }
    if (PROBE == 42) { phase_scanA<2>(p, bid, nblk, lds); GSYNC(); }
    if (PROBE == 12) { phase_pool(p, bid, nblk); GSYNC(); }
    for (int it = bid; it < 256; it += nblk) chain_run<1>(p, it >> 4, it & 15);
    GSYNC();
    if (bid < 16) chain_groups(p, bid); else phase_poolgemm(p, bid - 16, nblk - 16, lds);
    GSYNC();
    for (int it = bid; it < 256; it += nblk) chain_run<3>(p, it >> 4, it & 15);
    GSYNC();
    phase_scanC(p, bid, nblk, lds); GSYNC();
    if (PROBE == 6) { phase_scanC(p, bid, nblk, lds); GSYNC(); }
    phase_g2(p, bid, nblk, lds); GSYNC();
    if (PROBE == 7) { phase_g2(p, bid, nblk, lds); GSYNC(); }
    if (PROBE == 8) { phase_router(p, bid, nblk, lds, true); GSYNC(); }
    phase_router(p, bid, nblk, lds); GSYNC();
    phase_g3(p, bid, nblk, lds); GSYNC();
    if (PROBE == 9) { phase_g3(p, bid, nblk, lds); GSYNC(); }
    phase_g4(p, bid, nblk, lds); GSYNC();
    if (PROBE == 10) { phase_g4(p, bid, nblk, lds); GSYNC(); }
    if (PROBE == 11) { phase_final(p, bid, nblk); GSYNC(); }
    phase_final(p, bid, nblk);
}

extern "C" void kernel_launch(void* const* d_in, const int* in_sizes, int n_in, void* d_out, int out_size, void* d_ws, size_t ws_size, hipStream_t stream) {
    if (ws_size < WS_NEED) { fprintf(stderr, "workspace too small: %zu < %zu\n", ws_size, (size_t)WS_NEED); return; }
    Params p{};
    const float** f = (const float**)&p;
    for (int i = 0; i < 36; ++i) f[i] = (const float*)d_in[i];
    p.out = (float*)d_out; p.ws = (char*)d_ws;
    static int grid_blocks = 0;
    if (!grid_blocks) {
        (void)hipFuncSetAttribute((const void*)k_mega, hipFuncAttributeMaxDynamicSharedMemorySize, MEGA_LDS + 16);
        int dev = 0, cus = 0, per_cu = 0;
        (void)hipGetDevice(&dev);
        (void)hipDeviceGetAttribute(&cus, hipDeviceAttributeMultiprocessorCount, dev);
        (void)hipOccupancyMaxActiveBlocksPerMultiprocessor(&per_cu, k_mega, 256, MEGA_LDS + 16);
        if (per_cu > 1) per_cu = 1;
        grid_blocks = cus * per_cu;
    }
    (void)hipMemsetAsync((char*)d_ws + OFF_BAR, 0, 16384, stream);
    void* args[] = {&p};
    hipError_t e = hipLaunchCooperativeKernel((const void*)k_mega, dim3(grid_blocks), dim3(256), args, MEGA_LDS + 16, stream);
    if (e != hipSuccess) fprintf(stderr, "cooperative launch failed: %s (grid %d)\n", hipGetErrorString(e), grid_blocks);
}
```

```cpp
#include <hip/hip_runtime.h>
#include <stdint.h>
#include <stdio.h>
#include <hip/hip_cooperative_groups.h>
namespace cg = cooperative_groups;

#define DI __device__ __forceinline__
typedef unsigned short bf16_t;
typedef short bf16x8 __attribute__((ext_vector_type(8)));
typedef short s16x4 __attribute__((ext_vector_type(4)));
typedef float f32x4 __attribute__((ext_vector_type(4)));
typedef float f32x2 __attribute__((ext_vector_type(2)));
typedef __bf16 bf16x2_t __attribute__((ext_vector_type(2)));
typedef unsigned u32x4 __attribute__((ext_vector_type(4)));
typedef unsigned u32x2 __attribute__((ext_vector_type(2)));
#define LAS __attribute__((address_space(3)))

constexpr int D = 1024, S = 16384, CTX = 256, NT = S + CTX, DIN = 2432, DSH = 1920, DR = 512;
constexpr int C_WLF = 1536, C_WLB = 1600, C_ALF = 1664, C_ALB = 1728, C_GL = 1792, C_POOL = 1920;
constexpr int NE = 32, DE = 512, LCAP = 32768;
constexpr float DECAY_SCALE = 0.6065306597f;

constexpr int NCH = NT / 64;
constexpr size_t SZ_U = (size_t)NT * DIN * 2;
constexpr size_t SZ_CH = (size_t)16 * NCH * 8192;
constexpr size_t OFF_U = 0;
constexpr size_t OFF_XN = OFF_U + SZ_U;
constexpr size_t OFF_P = OFF_XN;
constexpr size_t OFF_Q = OFF_P + SZ_CH;
constexpr size_t OFF_WYT = OFF_Q + SZ_CH;
constexpr size_t OFF_YL = OFF_WYT + (size_t)256 * 16 * 8192;
constexpr size_t OFF_V = OFF_YL + (size_t)256 * 16 * 8192;
constexpr size_t OFF_G = OFF_V + (size_t)S * DR * 2;
constexpr size_t OFF_MIX = OFF_G + (size_t)S * DR * 2;
constexpr size_t OFF_SMALL = OFF_MIX + (size_t)S * D * 2;
constexpr size_t OFF_MODX = OFF_SMALL, OFF_MODC = OFF_MODX + 6144 * 4;
constexpr size_t OFF_ROWTAB = OFF_MODC + 6144 * 4, OFF_COLTAB = OFF_ROWTAB + 256 * 512 * 4;
constexpr size_t OFF_CNT = OFF_COLTAB + 64 * 512 * 4;
constexpr size_t OFF_GATE = OFF_CNT + 256;
constexpr size_t OFF_LIST = OFF_GATE + (size_t)S * 2 * 4;
constexpr size_t OFF_DOT = OFF_LIST + (size_t)NE * LCAP * 4;
constexpr size_t OFF_WP = OFF_DOT + (size_t)NT * 16 * 4;
constexpr size_t OFF_B2 = OFF_WP + 64 * 4 * 3 * 64 * 4;
constexpr size_t OFF_BAR = OFF_B2 + 256;
constexpr size_t OFF_WINB = OFF_BAR + 16384;
constexpr size_t OFF_WOUTB = OFF_WINB + (size_t)D * DIN * 2;
constexpr size_t WS_NEED = OFF_WOUTB + (size_t)D * D * 2;
constexpr size_t OFF_Z = OFF_U;
constexpr size_t OFF_X2 = OFF_P;
constexpr size_t OFF_YBUF = OFF_WYT;
constexpr size_t OFF_H2 = OFF_U;
constexpr size_t OFF_HID = OFF_U + SZ_CH;
constexpr size_t OFF_CP = OFF_U + SZ_CH;
constexpr size_t OFF_CQ = OFF_CP + 256 * 8192;
constexpr size_t OFF_ZG = OFF_CQ + 256 * 16384;

struct Params {
    const float *x, *c, *ctx, *c_ctx, *norm1_g, *w_mod, *b_mod, *w_in, *mu, *w0_f, *w2_f, *w0_b, *w2_b, *a0_f, *a2_f, *a0_b, *a2_b,
        *g2, *k_k, *k_a, *r_k_f, *r_k_b, *gn_w, *gn_b, *w_pool, *pool_scale, *w_out, *norm2_g, *w_rg, *b_rg, *w_re, *b_re,
        *w_gate, *w_up, *w_down, *final_g;
    float* out;
    char* ws;
};

DI unsigned pack2(float lo, float hi) { f32x2 v = {lo, hi}; bf16x2_t b = __builtin_convertvector(v, bf16x2_t); return __builtin_bit_cast(unsigned, b); }
DI float bf2f(bf16_t h) { return __uint_as_float(((unsigned)h) << 16); }
DI float bflo(unsigned u) { return __uint_as_float(u << 16); }
DI float bfhi(unsigned u) { return __uint_as_float(u & 0xffff0000u); }
DI void unpack8(const u32x4& p, float* f) { f[0] = bflo(p.x); f[1] = bfhi(p.x); f[2] = bflo(p.y); f[3] = bfhi(p.y); f[4] = bflo(p.z); f[5] = bfhi(p.z); f[6] = bflo(p.w); f[7] = bfhi(p.w); }
DI u32x4 pack8(const float* f) { u32x4 p; p.x = pack2(f[0], f[1]); p.y = pack2(f[2], f[3]); p.z = pack2(f[4], f[5]); p.w = pack2(f[6], f[7]); return p; }
DI float sigmoidf_(float x) { return 1.f / (1.f + __expf(-x)); }
DI float wave_sum(float v) {
#pragma unroll
    for (int o = 32; o > 0; o >>= 1) v += __shfl_xor(v, o, 64);
    return v;
}
DI f32x4 wave_sum4(f32x4 v) {
#pragma unroll
    for (int o = 32; o > 0; o >>= 1) { v[0] += __shfl_xor(v[0], o, 64); v[1] += __shfl_xor(v[1], o, 64); v[2] += __shfl_xor(v[2], o, 64); v[3] += __shfl_xor(v[3], o, 64); }
    return v;
}
typedef float f32x16 __attribute__((ext_vector_type(16)));
DI f32x16 zero16() { f32x16 z; for (int i = 0; i < 16; ++i) z[i] = 0.f; return z; }
DI s16x4 tr16(const bf16_t* a) { return __builtin_amdgcn_ds_read_tr16_b64_v4i16((LAS s16x4*)a); }
DI float pos_val(const float* rowtab, const float* coltab, int t, int d) { return d < 512 ? rowtab[(t >> 6) * 512 + d] : coltab[(t & 63) * 512 + (d - 512)]; }

DI void phase_p0(const Params& p, int bid, int nblk, char* lds) {
    const int tid = threadIdx.x;
    float* modx = (float*)(p.ws + OFF_MODX); float* modc = (float*)(p.ws + OFF_MODC);
    float* red = (float*)lds;
    for (int item = bid; item < 96; item += nblk) {
        const int col0 = item * 64, cg = tid & 15, kg = tid >> 4;
        f32x4 ax = {0, 0, 0, 0}, ac = {0, 0, 0, 0};
        for (int kk = 0; kk < 64; ++kk) {
            const int k = kg * 64 + kk;
            const float cv = p.c[k], cc = p.c_ctx[k];
            const float sx = cv * sigmoidf_(cv), sc = cc * sigmoidf_(cc);
            const f32x4 w = *(const f32x4*)(p.w_mod + (size_t)k * 6144 + col0 + cg * 4);
            ax += w * sx; ac += w * sc;
        }
        __syncthreads();
#pragma unroll
        for (int j = 0; j < 4; ++j) { red[(kg * 64 + cg * 4 + j) * 2] = ax[j]; red[(kg * 64 + cg * 4 + j) * 2 + 1] = ac[j]; }
        __syncthreads();
        if (tid < 128) {
            const int col = tid & 63, which = tid >> 6;
            float s = 0.f;
            for (int g = 0; g < 16; ++g) s += red[(g * 64 + col) * 2 + which];
            s += p.b_mod[col0 + col];
            (which ? modc : modx)[col0 + col] = s;
        }
    }
    float* rowtab = (float*)(p.ws + OFF_ROWTAB); float* coltab = (float*)(p.ws + OFF_COLTAB);
    for (int i = bid * 256 + tid; i < (256 + 64) * 256; i += nblk * 256) {
        const int pos = i >> 8, f = i & 255;
        const float freq = powf(10000.f, -(float)f / 256.f);
        if (pos < 256) { const float a = (float)pos * freq; rowtab[pos * 512 + f] = sinf(a); rowtab[pos * 512 + 256 + f] = cosf(a); }
        else { const int cp = pos - 256; const float a = (float)cp * freq; coltab[cp * 512 + f] = sinf(a); coltab[cp * 512 + 256 + f] = cosf(a); }
    }
    if (bid == 0 && tid < 64) ((int*)(p.ws + OFF_CNT))[tid] = 0;
    for (int pass = 0; pass < 2; ++pass) {
        const float* src = pass ? p.w_out : p.w_in; const int nc = pass ? D : DIN; bf16_t* dst = (bf16_t*)(p.ws + (pass ? OFF_WOUTB : OFF_WINB));
        const int n8 = nc >> 3;
        for (int idx = bid * 256 + tid; idx < D * n8; idx += nblk * 256) {
            const int k = idx / n8, g8 = idx - k * n8, blk = g8 >> 2, q = g8 & 3;
            const f32x4 lo = *(const f32x4*)(src + (size_t)k * nc + blk * 32 + 4 * q), hi = *(const f32x4*)(src + (size_t)k * nc + blk * 32 + 16 + 4 * q);
            *(u32x4*)(dst + (size_t)k * nc + blk * 32 + 8 * q) = (u32x4){pack2(lo[0], lo[1]), pack2(lo[2], lo[3]), pack2(hi[0], hi[1]), pack2(hi[2], hi[3])};
        }
    }
}

DI void phase_xn(const Params& p, int bid, int nblk) {
    const int lane = threadIdx.x & 63, wid = threadIdx.x >> 6;
    const float* modx = (const float*)(p.ws + OFF_MODX); const float* modc = (const float*)(p.ws + OFF_MODC);
    const float* rowtab = (const float*)(p.ws + OFF_ROWTAB); const float* coltab = (const float*)(p.ws + OFF_COLTAB);
    bf16_t* xn = (bf16_t*)(p.ws + OFF_XN);
    for (int gp = bid * 4 + wid; gp < NT / 2; gp += nblk * 4) {
        const int g0 = 2 * gp; const bool isctx = g0 < CTX;
        const float* md = isctx ? modc : modx;
        f32x4 v[2][4]; float ss[2] = {0.f, 0.f};
#pragma unroll
        for (int r = 0; r < 2; ++r)
#pragma unroll
            for (int i = 0; i < 4; ++i) {
                const int g = g0 + r, t = g - CTX, d = (i * 64 + lane) * 4;
                const float* src = isctx ? p.ctx + (size_t)g * D : p.x + (size_t)t * D;
                v[r][i] = *(const f32x4*)(src + d);
                if (!isctx) v[r][i] += *(const f32x4*)(d < 512 ? rowtab + (t >> 6) * 512 + d : coltab + (t & 63) * 512 + (d - 512));
                ss[r] += v[r][i][0] * v[r][i][0] + v[r][i][1] * v[r][i][1] + v[r][i][2] * v[r][i][2] + v[r][i][3] * v[r][i][3];
            }
#pragma unroll
        for (int r = 0; r < 2; ++r) {
            const float rstd = rsqrtf(wave_sum(ss[r]) * (1.f / 1024.f) + 1e-6f);
#pragma unroll
            for (int i = 0; i < 4; ++i) {
                const int d = (i * 64 + lane) * 4;
                const f32x4 gg = *(const f32x4*)(p.norm1_g + d), sh = *(const f32x4*)(md + d), sc = *(const f32x4*)(md + 1024 + d);
                f32x4 o;
#pragma unroll
                for (int j = 0; j < 4; ++j) o[j] = (v[r][i][j] * rstd * gg[j]) * (1.f + sc[j]) + sh[j];
                u32x2 pk = {pack2(o[0], o[1]), pack2(o[2], o[3])};
                *(u32x2*)(xn + (size_t)(g0 + r) * D + d) = pk;
            }
        }
    }
}

constexpr int GA_SZ = 256 * 128, GB_SZ = 18432, GBUF_SZ = GA_SZ + GB_SZ;
constexpr int GEMM_LDS = 3 * GBUF_SZ;
DI void glds16(const void* gsrc, char* ldst) { __builtin_amdgcn_global_load_lds((const unsigned*)gsrc, (LAS unsigned*)ldst, 16, 0, 0); }
template <int NB, bool BGLDS, class AL, class EPI>
DI void gemm256(const AL& al, const void* __restrict__ Bv0, const void* __restrict__ Bv1, int ldb, int K, char* lds, EPI& epi) {
    static_assert(!(BGLDS && NB == 2), "bf16 LDS-DMA path is for a single B");
    constexpr int NBLK = NB == 1 ? 2 : 1;
    constexpr int WN = 32 * NBLK;
    constexpr int BP = NB == 1 ? 136 : 72;
    const int tid = threadIdx.x, lane = tid & 63, wid = tid >> 6, wr = wid >> 1, wc = wid & 1, r32 = lane & 31, hh = lane >> 5, gi = lane >> 4, i16 = lane & 15;
    const float* B0 = (const float*)Bv0; const float* B1 = (const float*)Bv1; const bf16_t* Bb = (const bf16_t*)Bv0;
    f32x16 acc0[4][NBLK], acc1[4][NBLK];
#pragma unroll
    for (int m = 0; m < 4; ++m)
#pragma unroll
        for (int n = 0; n < NBLK; ++n) { acc0[m][n] = zero16(); acc1[m][n] = zero16(); }
    f32x4 rb0[NB == 1 ? 8 : 4], rb1[4];
    const int T = K >> 6;
    const bf16_t* arow[8];
#pragma unroll
    for (int i = 0; i < 8; ++i) { const int row = (4 * i + wid) * 8 + (lane >> 3); arow[i] = al.rowptr(i, row) + (((lane & 7) ^ ((row >> 1) & 7)) << 3); }
    int bsrc[4];
#pragma unroll
    for (int i = 0; i < 4; ++i) { const int k = (4 * i + wid) * 4 + (lane >> 4), p16 = lane & 15; bsrc[i] = k * ldb + ((((p16 >> 1) ^ (k & 7)) << 1) + (p16 & 1)) * 8; }
    const int a_base = (wr * 128 + r32) * 128, a_sw = (r32 >> 1) & 7;
    const int b_off = (8 * (gi >> 1) + (i16 >> 2)) * BP + wc * WN + 16 * (gi & 1) + 4 * (i16 & 3);
#define G_DMA(buf, t_) do { char* dA_ = lds + (buf) * GBUF_SZ + wid * 1024 + lane * 16; \
        _Pragma("unroll") for (int i = 0; i < 8; ++i) glds16(arow[i] + (t_) * 64, dA_ + i * 4096); \
        if (BGLDS) { char* dB_ = lds + (buf) * GBUF_SZ + GA_SZ + wid * 1024 + lane * 16; \
            _Pragma("unroll") for (int i = 0; i < 4; ++i) glds16(Bb + (size_t)(t_) * 64 * ldb + bsrc[i], dB_ + i * 4096); } } while (0)
#define G_LOADB(t_) do { const int k0_ = (t_) * 64; \
        if (NB == 1) { _Pragma("unroll") for (int i = 0; i < 8; ++i) { const int c = tid + 256 * i, kr = c >> 5, n4 = c & 31; rb0[i] = *(const f32x4*)(B0 + (size_t)(k0_ + kr) * ldb + n4 * 4); } } \
        else { _Pragma("unroll") for (int i = 0; i < 4; ++i) { const int c = tid + 256 * i, kr = c >> 4, n4 = c & 15; rb0[i] = *(const f32x4*)(B0 + (size_t)(k0_ + kr) * ldb + n4 * 4); rb1[i] = *(const f32x4*)(B1 + (size_t)(k0_ + kr) * ldb + n4 * 4); } } } while (0)
#define G_WRITEB(buf) do { bf16_t* sB0_ = (bf16_t*)(lds + (buf) * GBUF_SZ + GA_SZ); bf16_t* sB1_ = sB0_ + 64 * 72; \
        if (NB == 1) { _Pragma("unroll") for (int i = 0; i < 8; ++i) { const int c = tid + 256 * i, kr = c >> 5, n4 = c & 31, slot = (n4 >> 3) * 32 + 8 * (n4 & 3) + 4 * ((n4 >> 2) & 1); \
            u32x2 pk = {pack2(rb0[i][0], rb0[i][1]), pack2(rb0[i][2], rb0[i][3])}; *(u32x2*)(sB0_ + kr * BP + slot) = pk; } } \
        else { _Pragma("unroll") for (int i = 0; i < 4; ++i) { const int c = tid + 256 * i, kr = c >> 4, n4 = c & 15, slot = (n4 >> 3) * 32 + 8 * (n4 & 3) + 4 * ((n4 >> 2) & 1); \
            u32x2 pk = {pack2(rb0[i][0], rb0[i][1]), pack2(rb0[i][2], rb0[i][3])}; *(u32x2*)(sB0_ + kr * BP + slot) = pk; \
            u32x2 pk1 = {pack2(rb1[i][0], rb1[i][1]), pack2(rb1[i][2], rb1[i][3])}; *(u32x2*)(sB1_ + kr * BP + slot) = pk1; } } } while (0)
#define G_READ(buf, kh, AF, BF0, BF1) do { const char* sA_ = lds + (buf) * GBUF_SZ; const bf16_t* sB0_ = (const bf16_t*)(lds + (buf) * GBUF_SZ + GA_SZ); const bf16_t* sB1_ = sB0_ + 64 * 72; \
        _Pragma("unroll") for (int ks = 0; ks < 2; ++ks) { const int k0_ = (kh) * 32 + ks * 16; \
            _Pragma("unroll") for (int n = 0; n < NBLK; ++n) { \
                if (BGLDS) { const int kk_ = k0_ + 8 * (gi >> 1) + (i16 >> 2), gr_ = (wc * WN + n * 32) / 16 + (gi & 1); \
                    const char* q0_ = (const char*)sB0_ + kk_ * 256 + ((gr_ ^ (kk_ & 7)) << 5) + 8 * (i16 & 3); const char* q1_ = (const char*)sB0_ + (kk_ + 4) * 256 + ((gr_ ^ ((kk_ + 4) & 7)) << 5) + 8 * (i16 & 3); \
                    s16x4 lo = tr16((const bf16_t*)q0_), hi = tr16((const bf16_t*)q1_); BF0[ks][n] = __builtin_shufflevector(lo, hi, 0, 1, 2, 3, 4, 5, 6, 7); } \
                else { const int off = b_off + k0_ * BP + n * 32; \
                    s16x4 lo = tr16(sB0_ + off), hi = tr16(sB0_ + off + 4 * BP); BF0[ks][n] = __builtin_shufflevector(lo, hi, 0, 1, 2, 3, 4, 5, 6, 7); \
                    if (NB == 2) { s16x4 lo1 = tr16(sB1_ + off), hi1 = tr16(sB1_ + off + 4 * BP); BF1[ks][n] = __builtin_shufflevector(lo1, hi1, 0, 1, 2, 3, 4, 5, 6, 7); } } } \
            _Pragma("unroll") for (int m = 0; m < 4; ++m) AF[ks][m] = *(const bf16x8*)(sA_ + a_base + m * 4096 + ((((kh) * 4 + ks * 2 + hh) ^ a_sw) << 4)); } } while (0)
#define G_MFMA(AF, BF0, BF1) do { \
        _Pragma("unroll") for (int ks = 0; ks < 2; ++ks) _Pragma("unroll") for (int m = 0; m < 4; ++m) _Pragma("unroll") for (int n = 0; n < NBLK; ++n) { \
            acc0[m][n] = __builtin_amdgcn_mfma_f32_32x32x16_bf16(BF0[ks][n], AF[ks][m], acc0[m][n], 0, 0, 0); \
            if (NB == 2) acc1[m][n] = __builtin_amdgcn_mfma_f32_32x32x16_bf16(BF1[ks][n], AF[ks][m], acc1[m][n], 0, 0, 0); } } while (0)
    bf16x8 afA[2][4], bfA0[2][NBLK], bfA1[2][NBLK], afB[2][4], bfB0[2][NBLK], bfB1[2][NBLK];
    if (BGLDS) {
        G_DMA(0, 0);
        if (T > 1) G_DMA(1, 1);
        int b0 = 0, b1 = 1, b2 = 2;
#pragma unroll 1
        for (int t = 0; t < T; ++t) {
            if (t + 1 < T) asm volatile("s_waitcnt vmcnt(12)" ::: "memory"); else asm volatile("s_waitcnt vmcnt(0)" ::: "memory");
            __builtin_amdgcn_s_barrier();
            __builtin_amdgcn_sched_barrier(0);
            if (t + 2 < T) G_DMA(b2, t + 2);
            G_READ(b0, 0, afA, bfA0, bfA1);
            __builtin_amdgcn_sched_barrier(0);
            G_MFMA(afA, bfA0, bfA1);
            G_READ(b0, 1, afB, bfB0, bfB1);
#pragma unroll
            for (int i = 0; i < 16; ++i) { __builtin_amdgcn_sched_group_barrier(0x008, 1, 0); __builtin_amdgcn_sched_group_barrier(0x100, 1, 0); }
            __builtin_amdgcn_sched_barrier(0);
            G_MFMA(afB, bfB0, bfB1);
            __builtin_amdgcn_sched_barrier(0);
            const int tb = b0; b0 = b1; b1 = b2; b2 = tb;
        }
    } else {
    G_DMA(0, 0);
    G_LOADB(0); G_WRITEB(0);
#pragma unroll 1
    for (int t = 0; t < T; ++t) {
        const int buf = t & 1;
        asm volatile("s_waitcnt vmcnt(0)" ::: "memory");
        __syncthreads();
        if (t + 1 < T) { G_DMA(buf ^ 1, t + 1); G_LOADB(t + 1); }
        G_READ(buf, 0, afA, bfA0, bfA1);
        __builtin_amdgcn_sched_barrier(0);
        G_MFMA(afA, bfA0, bfA1);
        G_READ(buf, 1, afB, bfB0, bfB1);
#pragma unroll
        for (int i = 0; i < 16; ++i) { __builtin_amdgcn_sched_group_barrier(0x008, 1, 0); __builtin_amdgcn_sched_group_barrier(0x100, 1, 0); }
        __builtin_amdgcn_sched_barrier(0);
        G_MFMA(afB, bfB0, bfB1);
        G_WRITEB(buf ^ 1);
#pragma unroll
        for (int i = 0; i < 16; ++i) { __builtin_amdgcn_sched_group_barrier(0x008, 1, 0); __builtin_amdgcn_sched_group_barrier(0x002, 4, 0); __builtin_amdgcn_sched_group_barrier(0x200, 1, 0); }
        __builtin_amdgcn_sched_barrier(0);
    }
    }
#undef G_DMA
#undef G_LOADB
#undef G_WRITEB
#undef G_READ
#undef G_MFMA
#pragma unroll
    for (int m = 0; m < 4; ++m)
#pragma unroll
        for (int n = 0; n < NBLK; ++n) epi(wr * 128 + m * 32 + r32, wc * WN + n * 32 + 16 * hh, acc0[m][n], acc1[m][n]);
    __syncthreads();
}

struct PlainA {
    const bf16_t* base; int lda;
    DI const bf16_t* rowptr(int, int row) const { return base + (size_t)row * lda; }
};
struct GatherA {
    const bf16_t* rp[8];
    DI const bf16_t* rowptr(int i, int) const { return rp[i]; }
};

struct XcdOrder {
    int base, lim, j, bpx;
    DI XcdOrder(int bid, int nblk, int total) {
        if ((nblk & 7) == 0) { const int x = bid & 7, per = (total + 7) >> 3; bpx = nblk >> 3; j = bid >> 3; base = x * per; lim = base + per < total ? base + per : total; }
        else { bpx = nblk; j = bid; base = 0; lim = total; }
    }
    DI int item(int i) const { const int q = base + i * bpx + j; return q < lim ? q : -1; }
};
DI void tile_rc(int q, int nrow, int ncol, int& r, int& c) {
    const int per_sr = 8 * ncol, sr = q / per_sr, rem = q - sr * per_sr, rows = (nrow - sr * 8) < 8 ? (nrow - sr * 8) : 8;
    c = rem / rows; r = sr * 8 + rem - c * rows;
}

DI u32x4 pack8v(const f32x4& a, const f32x4& b) { return (u32x4){pack2(a[0], a[1]), pack2(a[2], a[3]), pack2(b[0], b[1]), pack2(b[2], b[3])}; }
DI u32x4 pack8q(const f32x16& a, int q) { return (u32x4){pack2(a[8 * q], a[8 * q + 1]), pack2(a[8 * q + 2], a[8 * q + 3]), pack2(a[8 * q + 4], a[8 * q + 5]), pack2(a[8 * q + 6], a[8 * q + 7])}; }
struct EpiStoreBf16 { bf16_t* o; int ldo; DI void operator()(int r, int c, const f32x16& a, const f32x16&) const { *(u32x4*)(o + (size_t)r * ldo + c) = pack8q(a, 0); *(u32x4*)(o + (size_t)r * ldo + c + 8) = pack8q(a, 1); } };
DI void phase_mfma_rate(const Params& p, int n_mfma) {
    f32x4 acc[32];
#pragma unroll
    for (int i = 0; i < 32; ++i) acc[i] = (f32x4){0, 0, 0, 0};
    bf16x8 a = __builtin_bit_cast(bf16x8, *(const u32x4*)(p.ws + OFF_XN + threadIdx.x * 16)), b = __builtin_bit_cast(bf16x8, *(const u32x4*)(p.ws + OFF_XN + 8192 + threadIdx.x * 16));
#pragma unroll 1
    for (int it = 0; it < n_mfma; it += 32) {
#pragma unroll
        for (int i = 0; i < 32; ++i) acc[i] = __builtin_amdgcn_mfma_f32_16x16x32_bf16(a, b, acc[i], 0, 0, 0);
    }
    f32x4 sacc = acc[0];
#pragma unroll
    for (int i = 1; i < 32; ++i) sacc += acc[i];
    asm volatile("" :: "v"(sacc));
}
DI void phase_mfma_rate32(const Params& p, int n_mfma) {
    f32x16 acc[8];
#pragma unroll
    for (int i = 0; i < 8; ++i) acc[i] = zero16();
    bf16x8 a = __builtin_bit_cast(bf16x8, *(const u32x4*)(p.ws + OFF_XN + threadIdx.x * 16)), b = __builtin_bit_cast(bf16x8, *(const u32x4*)(p.ws + OFF_XN + 8192 + threadIdx.x * 16));
#pragma unroll 1
    for (int it = 0; it < n_mfma; it += 8) {
#pragma unroll
        for (int i = 0; i < 8; ++i) acc[i] = __builtin_amdgcn_mfma_f32_32x32x16_bf16(a, b, acc[i], 0, 0, 0);
    }
    f32x16 sacc = acc[0];
#pragma unroll
    for (int i = 1; i < 8; ++i) sacc += acc[i];
    asm volatile("" :: "v"(sacc));
}
DI void phase_g1(const Params& p, int bid, int nblk, char* lds) {
    const bf16_t* xn = (const bf16_t*)(p.ws + OFF_XN); bf16_t* u = (bf16_t*)(p.ws + OFF_U);
    const XcdOrder ord(bid, nblk, 65 * 19);
    for (int i = 0, q; (q = ord.item(i)) >= 0; ++i) {
        int tm, tn; tile_rc(q, 65, 19, tm, tn);
        PlainA al{xn + (size_t)tm * 256 * D, D};
        EpiStoreBf16 epi{u + (size_t)tm * 256 * DIN + tn * 128, DIN};
        gemm256<1, true>(al, (const bf16_t*)(p.ws + OFF_WINB) + tn * 128, nullptr, DIN, D, lds, epi);
    }
}

DI void phase_pool(const Params& p, int bid, int nblk) {
    const bf16_t* u = (const bf16_t*)(p.ws + OFF_U) + (size_t)CTX * DIN + C_POOL;
    bf16_t* mix = (bf16_t*)(p.ws + OFF_MIX);
    for (int item = bid * 256 + threadIdx.x; item < (S / 16) * 64; item += nblk * 256) {
        const int cg = item & 63, run = item >> 6, t0 = run * 16, gi = cg >> 4, win = 2 << gi, hw = win >> 1;
        const bf16_t* uc = u + cg * 8;
        float sum[8];
#pragma unroll
        for (int j = 0; j < 8; ++j) sum[j] = 0.f;
        int lo = t0 - hw, hi = t0 - hw + win; lo = lo < 0 ? 0 : lo; hi = hi > S ? S : hi;
        for (int tt = lo; tt < hi; ++tt) { float q[8]; unpack8(*(const u32x4*)(uc + (size_t)tt * DIN), q);
#pragma unroll
            for (int j = 0; j < 8; ++j) sum[j] += q[j]; }
        for (int k = 0; k < 16; ++k) {
            const int t = t0 + k;
            float cv[8], o[8]; unpack8(*(const u32x4*)(uc + (size_t)t * DIN), cv);
            const float inv = 1.f / (float)(hi - lo);
#pragma unroll
            for (int j = 0; j < 8; ++j) o[j] = sum[j] * inv - cv[j];
            *(u32x4*)(mix + (size_t)t * D + cg * 8) = pack8(o);
            const int nlo = t + 1 - hw, nhi = t + 1 - hw + win;
            if (nhi <= S) { float q[8]; unpack8(*(const u32x4*)(uc + (size_t)(nhi - 1) * DIN), q);
#pragma unroll
                for (int j = 0; j < 8; ++j) sum[j] += q[j]; hi = nhi; }
            if (nlo > 0) { float q[8]; unpack8(*(const u32x4*)(uc + (size_t)(nlo - 1) * DIN), q);
#pragma unroll
                for (int j = 0; j < 8; ++j) sum[j] -= q[j]; lo = nlo; }
        }
    }
}
struct EpiPool { bf16_t* o; const float* sc; DI void operator()(int r, int c, const f32x16& a, const f32x16&) const {
    f32x16 v = a;
#pragma unroll
    for (int q = 0; q < 4; ++q) { const f32x4 s4 = *(const f32x4*)(sc + c + 4 * q); v[4 * q] *= s4[0]; v[4 * q + 1] *= s4[1]; v[4 * q + 2] *= s4[2]; v[4 * q + 3] *= s4[3]; }
    *(u32x4*)(o + (size_t)r * D + c) = pack8q(v, 0); *(u32x4*)(o + (size_t)r * D + c + 8) = pack8q(v, 1); } };
DI void phase_poolgemm(const Params& p, int bid, int nblk, char* lds) {
    if (nblk <= 0) return;
    for (int it = bid; it < 4 * 64; it += nblk) {
        const int gi = it >> 6, tm = it & 63;
        const bf16_t* mix = (const bf16_t*)(p.ws + OFF_MIX);
        PlainA al{mix + (size_t)tm * 256 * D + gi * 128, D};
        EpiPool e{(bf16_t*)(p.ws + OFF_MIX) + (size_t)tm * 256 * D + 512 + gi * 128, p.pool_scale + gi * 128};
        int kk = 128; asm volatile("" : "+s"(kk));
        gemm256<1, false>(al, p.w_pool + (size_t)gi * 128 * 128, nullptr, 128, kk, lds, e);
    }
}

constexpr int MP = 72, MSZ = 64 * MP;
constexpr int FP = 68;
constexpr int SCANA_LDS = 14 * MSZ * 2 + 2048;
template <bool KS> DI bf16x8 frag32(const bf16_t* base, int x0, int s, int lane) {
    if (!KS) return *(const bf16x8*)(base + (x0 + (lane & 31)) * MP + 16 * s + 8 * (lane >> 5));
    const int gi = lane >> 4, i = lane & 15;
    const bf16_t* a = base + (16 * s + 8 * (gi >> 1) + (i >> 2)) * MP + x0 + 16 * (gi & 1) + 4 * (i & 3);
    s16x4 lo = tr16(a), hi = tr16(a + 4 * MP);
    return __builtin_shufflevector(lo, hi, 0, 1, 2, 3, 4, 5, 6, 7);
}
template <bool XKS, bool YKS> DI f32x16 mm32(const bf16_t* X, int x0, const bf16_t* Y, int y0, f32x16 acc, int lane) {
#pragma unroll
    for (int s = 0; s < 4; ++s) acc = __builtin_amdgcn_mfma_f32_32x32x16_bf16(frag32<XKS>(X, x0, s, lane), frag32<YKS>(Y, y0, s, lane), acc, 0, 0, 0);
    return acc;
}
template <class F> DI void store_acc(bf16_t* out, int x0, int y0, const f32x16& acc, int lane, F f) {
    const int y = y0 + (lane & 31), hh = lane >> 5;
#pragma unroll
    for (int q = 0; q < 4; ++q) {
        const int x = x0 + 8 * q + 4 * hh;
        u32x2 pk = {pack2(f(acc[4 * q], x, y), f(acc[4 * q + 1], x + 1, y)), pack2(f(acc[4 * q + 2], x + 2, y), f(acc[4 * q + 3], x + 3, y))};
        *(u32x2*)(out + y * MP + x) = pk;
    }
}
DI unsigned rot16(unsigned x) { return (x >> 16) | (x << 16); }

DI int chain_pos(int c, int dir) { return dir == 0 ? c : (c < 4 ? 3 - c : NCH + 3 - c); }

template <int STOP = 0> DI void phase_scanA(const Params& p, int bid, int nblk, char* lds) {
    const int tid = threadIdx.x, lane = tid & 63, w = tid >> 6, xq = 32 * (w & 1), yq = 32 * (w >> 1);
    bf16_t* M = (bf16_t*)lds;
    bf16_t *sAT = M, *sBT = M + MSZ, *sKT = M + 2 * MSZ, *sRT = M + 3 * MSZ, *sVT = M + 4 * MSZ;
    float* fGC = (float*)(lds + 14 * MSZ * 2);
    float* fSeg = fGC + 64;
    float* fLogw = (float*)(M + 12 * MSZ);
    float* fA = (float*)(M + 10 * MSZ);
    const bf16_t* u = (const bf16_t*)(p.ws + OFF_U);
    for (int inst = bid; inst < NCH * 16; inst += nblk) {
        const int c = inst >> 4, h = (inst >> 1) & 7, dir = inst & 1;
        const bool latent = c >= 4, want_g = latent && dir == 0;
        const float* w2 = dir ? p.w2_b : p.w2_f; const float* a2 = dir ? p.a2_b : p.a2_f;
        const float* w0 = dir ? p.w0_b : p.w0_f; const float* a0 = dir ? p.a0_b : p.a0_f;
        const float* rkd = dir ? p.r_k_b : p.r_k_f;
        const int cwl = dir ? C_WLB : C_WLF, cal = dir ? C_ALB : C_ALF;
        const int ch = tid & 7;
        float fr_[2][8], fk_[2][8], fv_[2][8];
        const int cols5[5] = {h * 64 + ch * 8, 512 + h * 64 + ch * 8, 1024 + h * 64 + ch * 8, cwl + ch * 8, cal + ch * 8};
        auto shift8 = [&](const u32x4* r3, int col, float mp, float mn, float* o) {
            float cc[8], pv[8], nx[8];
            unpack8(r3[0], cc); unpack8(r3[1], pv); unpack8(r3[2], nx);
            const f32x4 m0 = *(const f32x4*)(p.mu + col), m1 = *(const f32x4*)(p.mu + col + 4);
#pragma unroll
            for (int j = 0; j < 8; ++j) { const float m = j < 4 ? m0[j & 3] : m1[j & 3]; o[j] = cc[j] + m * ((mp * pv[j] + mn * nx[j]) - cc[j]); }
        };
#pragma unroll
        for (int i = 0; i < 2; ++i) {
            const int tau = (tid >> 3) + 32 * i, g = dir ? c * 64 + 63 - tau : c * 64 + tau;
            const bool hasp = (g != 0) && (g != CTX), hasn = (g != CTX - 1) && (g != NT - 1);
            const float mp = hasp ? 0.5f : 0.f, mn = hasn ? 0.5f : 0.f;
            const bf16_t* rc = u + (size_t)g * DIN; const bf16_t* rp = hasp ? rc - DIN : rc; const bf16_t* rn = hasn ? rc + DIN : rc;
            u32x4 raw[5][3], rawg[2][3]; f32x4 wl[8];
#pragma unroll
            for (int q = 0; q < 5; ++q) { raw[q][0] = *(const u32x4*)(rc + cols5[q]); raw[q][1] = *(const u32x4*)(rp + cols5[q]); raw[q][2] = *(const u32x4*)(rn + cols5[q]); }
            if (want_g) {
#pragma unroll
                for (int half = 0; half < 2; ++half) { const int col = C_GL + half * 64 + ch * 8;
                    rawg[half][0] = *(const u32x4*)(rc + col); rawg[half][1] = *(const u32x4*)(rp + col); rawg[half][2] = *(const u32x4*)(rn + col); }
            }
            if (i == 0) {
#pragma unroll
                for (int q = 0; q < 4; ++q) { const int idx = tid + 256 * q, kr = idx >> 4, n4 = idx & 15;
                    wl[q] = *(const f32x4*)(w2 + (size_t)kr * DR + h * 64 + n4 * 4); wl[4 + q] = *(const f32x4*)(a2 + (size_t)kr * DR + h * 64 + n4 * 4); }
            } else if (want_g) {
#pragma unroll
                for (int q = 0; q < 8; ++q) { const int idx = tid + 256 * q, kr = idx >> 4, n4 = idx & 15; wl[q] = *(const f32x4*)(p.g2 + (size_t)kr * DR + h * 64 + n4 * 4); }
            }
            shift8(raw[0], cols5[0], mp, mn, fr_[i]); shift8(raw[1], cols5[1], mp, mn, fk_[i]); shift8(raw[2], cols5[2], mp, mn, fv_[i]);
            float t8[8];
            shift8(raw[3], cols5[3], mp, mn, t8);
#pragma unroll
            for (int j = 0; j < 8; ++j) { const float e2 = __expf(2.f * t8[j]); t8[j] = 1.f - __fdividef(2.f, e2 + 1.f); }
            *(u32x4*)(M + 5 * MSZ + tau * MP + ch * 8) = pack8(t8);
            shift8(raw[4], cols5[4], mp, mn, t8);
            *(u32x4*)(M + 6 * MSZ + tau * MP + ch * 8) = pack8(t8);
            if (want_g) {
#pragma unroll
                for (int half = 0; half < 2; ++half) {
                    shift8(rawg[half], C_GL + half * 64 + ch * 8, mp, mn, t8);
#pragma unroll
                    for (int j = 0; j < 8; ++j) t8[j] = sigmoidf_(t8[j]);
                    *(u32x4*)(M + half * MSZ + tau * MP + ch * 8) = pack8(t8);
                }
            }
            if (i == 0) {
#pragma unroll
                for (int q = 0; q < 4; ++q) { const int idx = tid + 256 * q, kr = idx >> 4, n4 = idx & 15;
                    u32x2 pa = {pack2(wl[q][0], wl[q][1]), pack2(wl[q][2], wl[q][3])}, pb = {pack2(wl[4 + q][0], wl[4 + q][1]), pack2(wl[4 + q][2], wl[4 + q][3])};
                    *(u32x2*)(M + 7 * MSZ + kr * MP + n4 * 4) = pa; *(u32x2*)(M + 8 * MSZ + kr * MP + n4 * 4) = pb; }
            } else if (want_g) {
#pragma unroll
                for (int q = 0; q < 8; ++q) { const int idx = tid + 256 * q, kr = idx >> 4, n4 = idx & 15;
                    u32x2 pa = {pack2(wl[q][0], wl[q][1]), pack2(wl[q][2], wl[q][3])};
                    *(u32x2*)(M + (2 + (kr >> 6)) * MSZ + (kr & 63) * MP + n4 * 4) = pa; }
            }
        }
        __syncthreads();
        {
            f32x16 accW = mm32<true, false>(M + 7 * MSZ, xq, M + 5 * MSZ, yq, zero16(), lane);
            f32x16 accA = mm32<true, false>(M + 8 * MSZ, xq, M + 6 * MSZ, yq, zero16(), lane);
            const int y = yq + (lane & 31), hh = lane >> 5;
#pragma unroll
            for (int q = 0; q < 4; ++q) {
                const int x = xq + 8 * q + 4 * hh;
                f32x4 lw, av; const f32x4 w0v = *(const f32x4*)(w0 + h * 64 + x), a0v = *(const f32x4*)(a0 + h * 64 + x);
#pragma unroll
                for (int e = 0; e < 4; ++e) {
                    av[e] = sigmoidf_(a0v[e] + accA[4 * q + e]);
                    float v = -DECAY_SCALE * sigmoidf_(w0v[e] + accW[4 * q + e]);
                    v += __builtin_bit_cast(float, __builtin_amdgcn_update_dpp(0, __builtin_bit_cast(int, v), 0x111, 0xf, 0xf, false));
                    v += __builtin_bit_cast(float, __builtin_amdgcn_update_dpp(0, __builtin_bit_cast(int, v), 0x112, 0xf, 0xf, false));
                    v += __builtin_bit_cast(float, __builtin_amdgcn_update_dpp(0, __builtin_bit_cast(int, v), 0x114, 0xf, 0xf, false));
                    v += __builtin_bit_cast(float, __builtin_amdgcn_update_dpp(0, __builtin_bit_cast(int, v), 0x118, 0xf, 0xf, false));
                    v += __builtin_bit_cast(float, __builtin_amdgcn_update_dpp(0, __builtin_bit_cast(int, v), 0x142, 0xa, 0xf, false));
                    lw[e] = v;
                }
                *(f32x4*)(fLogw + y * FP + x) = lw; *(f32x4*)(fA + y * FP + x) = av;
                if (yq == 0 && (lane & 31) == 31) *(f32x4*)(fSeg + x) = lw;
            }
        }
        if (want_g) {
            f32x16 accG = mm32<true, false>(M + 2 * MSZ, xq, M, yq, zero16(), lane);
            accG = mm32<true, false>(M + 3 * MSZ, xq, M + MSZ, yq, accG, lane);
            const int y = yq + (lane & 31), hh = lane >> 5, t = c * 64 + y - CTX;
#pragma unroll
            for (int q = 0; q < 4; ++q) {
                const int x = xq + 8 * q + 4 * hh;
                u32x2 pk = {pack2(accG[4 * q], accG[4 * q + 1]), pack2(accG[4 * q + 2], accG[4 * q + 3])};
                *(u32x2*)((bf16_t*)(p.ws + OFF_G) + (size_t)t * DR + h * 64 + x) = pk;
            }
        }
        __syncthreads();
#pragma unroll
        for (int i = 0; i < 2; ++i) {
            const int tau = (tid >> 3) + 32 * i, g = dir ? c * 64 + 63 - tau : c * 64 + tau;
            float oa[8], ob[8], ok[8], orr[8], kkv[8], kd[8];
            float ss = 0.f, dsum = 0.f;
            const int c8 = h * 64 + ch * 8;
            float kkp[8], kap[8], rkp[8];
            { const f32x4 a0_ = *(const f32x4*)(p.k_k + c8), a1_ = *(const f32x4*)(p.k_k + c8 + 4), b0_ = *(const f32x4*)(p.k_a + c8), b1_ = *(const f32x4*)(p.k_a + c8 + 4), c0_ = *(const f32x4*)(rkd + c8), c1_ = *(const f32x4*)(rkd + c8 + 4);
#pragma unroll
              for (int j = 0; j < 4; ++j) { kkp[j] = a0_[j]; kkp[4 + j] = a1_[j]; kap[j] = b0_[j]; kap[4 + j] = b1_[j]; rkp[j] = c0_[j]; rkp[4 + j] = c1_[j]; } }
#pragma unroll
            for (int j = 0; j < 8; ++j) { kkv[j] = fk_[i][j] * kkp[j]; ss += kkv[j] * kkv[j]; }
            ss += __shfl_xor(ss, 1, 64); ss += __shfl_xor(ss, 2, 64); ss += __shfl_xor(ss, 4, 64);
            const float inv = 1.f / fmaxf(sqrtf(ss), 1e-12f);
#pragma unroll
            for (int j = 0; j < 8; ++j) {
                const int jj = ch * 8 + j;
                const float seg = fSeg[jj];
                const float cum = fLogw[tau * FP + jj] + (tau >= 32 ? seg : 0.f), cprev = tau ? fLogw[(tau - 1) * FP + jj] + (tau > 32 ? seg : 0.f) : 0.f, av = fA[tau * FP + jj];
                const float gam = __expf(cum), gprev = __expf(cprev), ginv = __expf(-cum);
                const float kkn = kkv[j] * inv;
                kd[j] = fk_[i][j] * (1.f + (av - 1.f) * kap[j]);
                oa[j] = -kkn * gprev; ob[j] = kkn * av * ginv; ok[j] = kd[j] * ginv; orr[j] = fr_[i][j] * gam;
                dsum += fr_[i][j] * kd[j] * rkp[j];
                if (tau == 63) fGC[jj] = gam;
            }
            dsum += __shfl_xor(dsum, 1, 64); dsum += __shfl_xor(dsum, 2, 64); dsum += __shfl_xor(dsum, 4, 64);
            if (ch == 0) ((float*)(p.ws + OFF_DOT))[((size_t)g * 8 + h) * 2 + dir] = dsum;
            *(u32x4*)(sAT + tau * MP + ch * 8) = pack8(oa); *(u32x4*)(sBT + tau * MP + ch * 8) = pack8(ob);
            *(u32x4*)(sKT + tau * MP + ch * 8) = pack8(ok); *(u32x4*)(sRT + tau * MP + ch * 8) = pack8(orr);
            const u32x4 pv8 = pack8(fv_[i]);
            *(u32x4*)(sVT + tau * MP + ch * 8) = pv8;
            if (want_g) *(u32x4*)((bf16_t*)(p.ws + OFF_V) + (size_t)(g - CTX) * DR + h * 64 + ch * 8) = pv8;
        }
        __syncthreads();
        if (STOP == 1) continue;
        {
            f32x16 acc = mm32<false, false>(sAT, xq, sBT, yq, zero16(), lane);
            store_acc(M + 5 * MSZ, xq, yq, acc, lane, [](float v, int x, int y) { return y < x ? v : 0.f; });
            store_acc(M + 7 * MSZ, xq, yq, acc, lane, [](float v, int x, int y) { return y < x ? v : (y == x ? 1.f : 0.f); });
            acc = mm32<false, false>(sAT, xq, sKT, yq, zero16(), lane);
            store_acc(M + 9 * MSZ, xq, yq, acc, lane, [](float v, int x, int y) { return y < x ? v : 0.f; });
            acc = mm32<false, false>(sRT, xq, sBT, yq, zero16(), lane);
            store_acc(M + 10 * MSZ, xq, yq, acc, lane, [](float v, int x, int y) { return y <= x ? v : 0.f; });
            acc = mm32<false, false>(sRT, xq, sKT, yq, zero16(), lane);
            store_acc(M + 11 * MSZ, xq, yq, acc, lane, [](float v, int x, int y) { return y <= x ? v : 0.f; });
        }
        __syncthreads();
        int xs = 5, xo = 6, ts = 7, to = 8;
        {
            f32x16 acc = mm32<true, false>(M + xs * MSZ, xq, M + xs * MSZ, yq, zero16(), lane);
            store_acc(M + xo * MSZ, xq, yq, acc, lane, [](float v, int, int) { return v; });
            int t_ = xs; xs = xo; xo = t_;
        }
        __syncthreads();
        for (int k = 0; k < 5; ++k) {
            const bf16_t* Told = M + ts * MSZ;
            f32x16 acc = mm32<true, false>(M + xs * MSZ, xq, Told, yq, zero16(), lane);
            store_acc(M + to * MSZ, xq, yq, acc, lane, [Told](float v, int x, int y) { return v + bf2f(Told[y * MP + x]); });
            if (k < 4) {
                acc = mm32<true, false>(M + xs * MSZ, xq, M + xs * MSZ, yq, zero16(), lane);
                store_acc(M + xo * MSZ, xq, yq, acc, lane, [](float v, int, int) { return v; });
            }
            int t_ = xs; xs = xo; xo = t_; t_ = ts; ts = to; to = t_;
            __syncthreads();
        }
        if (STOP == 2) continue;
        const bf16_t* sT = M + ts * MSZ;
        {
            f32x16 acc = mm32<true, true>(sT, xq, sAT, yq, zero16(), lane);
            store_acc(M + 12 * MSZ, xq, yq, acc, lane, [](float v, int, int) { return v; });
            acc = mm32<true, false>(sT, xq, M + 9 * MSZ, yq, zero16(), lane);
            store_acc(M + 13 * MSZ, xq, yq, acc, lane, [](float v, int, int) { return v; });
        }
        __syncthreads();
        {
            const bf16_t *sAbar = M + 12 * MSZ, *sG = M + 13 * MSZ, *sABR = M + 10 * MSZ, *sAKR = M + 11 * MSZ;
            f32x16 acc = mm32<false, true>(sAbar, xq, sBT, yq, zero16(), lane);
            store_acc(M + 5 * MSZ, xq, yq, acc, lane, [fGC](float v, int x, int y) { return ((x == y ? 1.f : 0.f) + v) * fGC[y]; });
            acc = mm32<false, true>(sAbar, xq, sABR, yq, zero16(), lane);
            store_acc(M + 6 * MSZ, xq, yq, acc, lane, [sRT](float v, int x, int y) { return v + bf2f(sRT[y * MP + x]); });
            acc = mm32<true, false>(sBT, xq, sG, yq, zero16(), lane);
            store_acc(M + 7 * MSZ, xq, yq, acc, lane, [sKT, fGC](float v, int x, int y) { return (v + bf2f(sKT[y * MP + x])) * fGC[x]; });
            acc = mm32<true, false>(sABR, xq, sG, yq, zero16(), lane);
            store_acc(M + 9 * MSZ, xq, yq, acc, lane, [sAKR](float v, int x, int y) { return v + bf2f(sAKR[y * MP + x]); });
        }
        __syncthreads();
        const int chain = dir * 8 + h, npos = chain_pos(c, dir);
        {
            u32x4* Pg = (u32x4*)(p.ws + OFF_P) + ((size_t)chain * NCH + npos) * 512;
#pragma unroll
            for (int i = 0; i < 2; ++i) {
                const int item = tid + 256 * i, ln = item & 63, as = item >> 6, a = as >> 1, s2 = as & 1, fr = ln & 15, fq = ln >> 4;
                const bf16_t* src = M + 5 * MSZ + (16 * a + fr) * MP + 32 * s2 + 4 * fq;
                const u32x2 lo = *(const u32x2*)src, hi = *(const u32x2*)(src + 16);
                Pg[as * 64 + ln] = (u32x4){lo.x, lo.y, hi.x, hi.y};
            }
            if (latent) {
                u32x4* Wg = (u32x4*)(p.ws + OFF_WYT) + ((size_t)((c - 4) * 8 + h) * 2 + dir) * 512;
#pragma unroll
                for (int i = 0; i < 2; ++i) { const int item = tid + 256 * i, row = item >> 3, ck = item & 7; Wg[item] = *(const u32x4*)(M + 6 * MSZ + row * MP + ck * 8); }
            }
        }
        {
            f32x16 acc = mm32<true, true>(M + 7 * MSZ, xq, sVT, yq, zero16(), lane);
            store_acc(M + 12 * MSZ, xq, yq, acc, lane, [](float v, int, int) { return v; });
            acc = mm32<true, true>(M + 9 * MSZ, xq, sVT, yq, zero16(), lane);
            store_acc(M + 13 * MSZ, xq, yq, acc, lane, [](float v, int, int) { return v; });
        }
        __syncthreads();
        {
            u32x2* Qg = (u32x2*)(p.ws + OFF_Q) + ((size_t)chain * NCH + npos) * 1024;
#pragma unroll
            for (int i = 0; i < 4; ++i) {
                const int item = tid + 256 * i, ln = item & 63, wa = item >> 6, wi = wa >> 2, a = wa & 3, fr = ln & 15, fq = ln >> 4;
                Qg[item] = *(const u32x2*)(M + 12 * MSZ + (16 * wi + fr) * MP + 16 * a + 4 * fq);
            }
            if (latent) {
                u32x2* Yg = (u32x2*)(p.ws + OFF_YL) + ((size_t)((c - 4) * 8 + h) * 2 + dir) * 1024;
#pragma unroll
                for (int i = 0; i < 4; ++i) {
                    const int item = tid + 256 * i, ln = item & 63, wn = item >> 6, wt = wn >> 2, ni = wn & 3, fr = ln & 15, fq = ln >> 4;
                    const bf16_t* row = M + 13 * MSZ + (16 * ni + fr) * MP;
                    u32x2 v;
                    if (dir == 0) v = *(const u32x2*)(row + 16 * wt + 4 * fq);
                    else { const u32x2 r2 = *(const u32x2*)(row + 60 - 16 * wt - 4 * fq); v = (u32x2){rot16(r2.y), rot16(r2.x)}; }
                    Yg[item] = v;
                }
            }
        }
        __syncthreads();
    }
}

DI int grp_start(int g) { return g * 16 + (g < 4 ? g : 4); }
constexpr int CPF = 4;
DI u32x4 packz(const f32x4& a, const f32x4& b) { return (u32x4){pack2(a[0], a[1]), pack2(a[2], a[3]), pack2(b[0], b[1]), pack2(b[2], b[3])}; }
template <int PASS> DI void chain_run(const Params& p, int chain, int g) {
    const int lane = threadIdx.x & 63, w = threadIdx.x >> 6, fr = lane & 15, fq = lane >> 4;
    const int n0 = grp_start(g), n1 = grp_start(g + 1);
    const u32x4* Pg = (const u32x4*)(p.ws + OFF_P) + (size_t)chain * NCH * 512;
    const u32x2* Qg = (const u32x2*)(p.ws + OFF_Q) + (size_t)chain * NCH * 1024;
    u32x4* Zg = (u32x4*)(p.ws + OFF_Z) + (size_t)chain * NCH * 512;
    f32x4* ZG = (f32x4*)(p.ws + OFF_ZG) + ((size_t)(chain * 16 + g) * 4 + w) * 256;
    f32x4 acc[4], accp[4];
#pragma unroll
    for (int a = 0; a < 4; ++a) {
        if (PASS == 3) acc[a] = ZG[a * 64 + lane]; else acc[a] = (f32x4){0, 0, 0, 0};
#pragma unroll
        for (int e = 0; e < 4; ++e) accp[a][e] = (16 * a + 4 * fq + e == 16 * w + fr) ? 1.f : 0.f;
    }
    u32x4 pf[CPF][8]; u32x2 qf[CPF][4];
#pragma unroll
    for (int st = 0; st < CPF; ++st) if (n0 + st < n1) {
#pragma unroll
        for (int i = 0; i < 8; ++i) pf[st][i] = Pg[(size_t)(n0 + st) * 512 + i * 64 + lane];
#pragma unroll
        for (int a = 0; a < 4; ++a) qf[st][a] = Qg[(size_t)(n0 + st) * 1024 + (w * 4 + a) * 64 + lane];
    }
    for (int nb = n0; nb < n1; nb += CPF) {
#pragma unroll
        for (int st = 0; st < CPF; ++st) {
            const int n = nb + st;
            if (n < n1) {
                u32x4 pc[8]; u32x2 qc[4];
#pragma unroll
                for (int i = 0; i < 8; ++i) pc[i] = pf[st][i];
#pragma unroll
                for (int a = 0; a < 4; ++a) qc[a] = qf[st][a];
                if (n + CPF < n1) {
#pragma unroll
                    for (int i = 0; i < 8; ++i) pf[st][i] = Pg[(size_t)(n + CPF) * 512 + i * 64 + lane];
#pragma unroll
                    for (int a = 0; a < 4; ++a) qf[st][a] = Qg[(size_t)(n + CPF) * 1024 + (w * 4 + a) * 64 + lane];
                }
                const u32x4 z0 = packz(acc[0], acc[1]), z1 = packz(acc[2], acc[3]);
                if (PASS == 3) { Zg[((size_t)n * 4 + w) * 128 + lane] = z0; Zg[((size_t)n * 4 + w) * 128 + 64 + lane] = z1; }
                const bf16x8 zb0 = __builtin_bit_cast(bf16x8, z0), zb1 = __builtin_bit_cast(bf16x8, z1);
#pragma unroll
                for (int a = 0; a < 4; ++a) {
                    f32x4 ini = {bflo(qc[a].x), bfhi(qc[a].x), bflo(qc[a].y), bfhi(qc[a].y)};
                    ini = __builtin_amdgcn_mfma_f32_16x16x32_bf16(__builtin_bit_cast(bf16x8, pc[2 * a]), zb0, ini, 0, 0, 0);
                    acc[a] = __builtin_amdgcn_mfma_f32_16x16x32_bf16(__builtin_bit_cast(bf16x8, pc[2 * a + 1]), zb1, ini, 0, 0, 0);
                }
                if (PASS == 1) {
                    const bf16x8 yb0 = __builtin_bit_cast(bf16x8, packz(accp[0], accp[1])), yb1 = __builtin_bit_cast(bf16x8, packz(accp[2], accp[3]));
#pragma unroll
                    for (int a = 0; a < 4; ++a) {
                        f32x4 t4 = __builtin_amdgcn_mfma_f32_16x16x32_bf16(__builtin_bit_cast(bf16x8, pc[2 * a]), yb0, (f32x4){0, 0, 0, 0}, 0, 0, 0);
                        accp[a] = __builtin_amdgcn_mfma_f32_16x16x32_bf16(__builtin_bit_cast(bf16x8, pc[2 * a + 1]), yb1, t4, 0, 0, 0);
                    }
                }
            }
        }
    }
    if (PASS == 1) {
        f32x4* CQ = (f32x4*)(p.ws + OFF_CQ) + ((size_t)(chain * 16 + g) * 4 + w) * 256;
        bf16_t* CP = (bf16_t*)(p.ws + OFF_CP) + (size_t)(chain * 16 + g) * 4096;
#pragma unroll
        for (int a = 0; a < 4; ++a) {
            CQ[a * 64 + lane] = acc[a];
#pragma unroll
            for (int e = 0; e < 4; ++e) CP[(16 * a + 4 * fq + e) * 64 + 16 * w + fr] = (bf16_t)(pack2(accp[a][e], 0.f) & 0xffffu);
        }
    }
}
DI void chain_groups(const Params& p, int chain) {
    const int lane = threadIdx.x & 63, w = threadIdx.x >> 6, fr = lane & 15, fq = lane >> 4;
    f32x4 acc[4];
#pragma unroll
    for (int a = 0; a < 4; ++a) acc[a] = (f32x4){0, 0, 0, 0};
    u32x4 pf[CPF][8]; f32x4 qf[CPF][4];
    auto load = [&](int st, int g) {
        const bf16_t* CP = (const bf16_t*)(p.ws + OFF_CP) + (size_t)(chain * 16 + g) * 4096;
        const f32x4* CQ = (const f32x4*)(p.ws + OFF_CQ) + ((size_t)(chain * 16 + g) * 4 + w) * 256;
#pragma unroll
        for (int i = 0; i < 8; ++i) { const int a = i >> 1, s2 = i & 1; const bf16_t* src = CP + (16 * a + fr) * 64 + 32 * s2 + 4 * fq;
            const u32x2 lo = *(const u32x2*)src, hi = *(const u32x2*)(src + 16); pf[st][i] = (u32x4){lo.x, lo.y, hi.x, hi.y}; }
#pragma unroll
        for (int a = 0; a < 4; ++a) qf[st][a] = CQ[a * 64 + lane];
    };
#pragma unroll
    for (int st = 0; st < CPF; ++st) load(st, st);
    for (int gb = 0; gb < 16; gb += CPF) {
#pragma unroll
        for (int st = 0; st < CPF; ++st) {
            const int g = gb + st;
            u32x4 pc[8]; f32x4 qc[4];
#pragma unroll
            for (int i = 0; i < 8; ++i) pc[i] = pf[st][i];
#pragma unroll
            for (int a = 0; a < 4; ++a) qc[a] = qf[st][a];
            if (g + CPF < 16) load(st, g + CPF);
            f32x4* ZG = (f32x4*)(p.ws + OFF_ZG) + ((size_t)(chain * 16 + g) * 4 + w) * 256;
#pragma unroll
            for (int a = 0; a < 4; ++a) ZG[a * 64 + lane] = acc[a];
            const bf16x8 zb0 = __builtin_bit_cast(bf16x8, packz(acc[0], acc[1])), zb1 = __builtin_bit_cast(bf16x8, packz(acc[2], acc[3]));
#pragma unroll
            for (int a = 0; a < 4; ++a) {
                f32x4 ini = __builtin_amdgcn_mfma_f32_16x16x32_bf16(__builtin_bit_cast(bf16x8, pc[2 * a]), zb0, qc[a], 0, 0, 0);
                acc[a] = __builtin_amdgcn_mfma_f32_16x16x32_bf16(__builtin_bit_cast(bf16x8, pc[2 * a + 1]), zb1, ini, 0, 0, 0);
            }
        }
    }
}

DI void phase_scanC(const Params& p, int bid, int nblk, char* lds) {
    const int lane = threadIdx.x & 63, w = threadIdx.x >> 6, fr = lane & 15, fq = lane >> 4;
    bf16_t* mix = (bf16_t*)(p.ws + OFF_MIX);
    const float* dot = (const float*)(p.ws + OFF_DOT);
    for (int unit = bid; unit < 256 * 8; unit += nblk) {
        const int c = 4 + (unit >> 3), h = unit & 7;
        f32x4 y[4];
#pragma unroll
        for (int ni = 0; ni < 4; ++ni) y[ni] = (f32x4){0, 0, 0, 0};
#pragma unroll
        for (int dir = 0; dir < 2; ++dir) {
            const int chain = dir * 8 + h, npos = chain_pos(c, dir);
            const u32x4* Zg = (const u32x4*)(p.ws + OFF_Z) + ((size_t)chain * NCH + npos) * 512;
            const bf16_t* Wg = (const bf16_t*)(p.ws + OFF_WYT) + ((size_t)((c - 4) * 8 + h) * 2 + dir) * 4096;
            const u32x2* Yg = (const u32x2*)(p.ws + OFF_YL) + ((size_t)((c - 4) * 8 + h) * 2 + dir) * 1024;
            const int rho = 16 * w + fr, row = dir ? 63 - rho : rho;
            bf16x8 af[2];
#pragma unroll
            for (int s2 = 0; s2 < 2; ++s2) {
                const u32x2 lo = *(const u32x2*)(Wg + row * 64 + 32 * s2 + 4 * fq), hi = *(const u32x2*)(Wg + row * 64 + 32 * s2 + 16 + 4 * fq);
                af[s2] = __builtin_bit_cast(bf16x8, (u32x4){lo.x, lo.y, hi.x, hi.y});
            }
#pragma unroll
            for (int ni = 0; ni < 4; ++ni) {
                const u32x2 yl = Yg[(w * 4 + ni) * 64 + lane];
                f32x4 acc = {bflo(yl.x), bfhi(yl.x), bflo(yl.y), bfhi(yl.y)};
                acc = __builtin_amdgcn_mfma_f32_16x16x32_bf16(af[0], __builtin_bit_cast(bf16x8, Zg[(ni * 2 + 0) * 64 + lane]), acc, 0, 0, 0);
                acc = __builtin_amdgcn_mfma_f32_16x16x32_bf16(af[1], __builtin_bit_cast(bf16x8, Zg[(ni * 2 + 1) * 64 + lane]), acc, 0, 0, 0);
                y[ni] += acc;
            }
        }
        float* ty = (float*)lds + w * (16 * 68);
#pragma unroll
        for (int ni = 0; ni < 4; ++ni)
#pragma unroll
            for (int e = 0; e < 4; ++e) ty[(4 * fq + e) * 68 + 16 * ni + fr] = y[ni][e];
        asm volatile("s_waitcnt lgkmcnt(0)" ::: "memory"); __builtin_amdgcn_wave_barrier();
        {
            const int tl = lane >> 2, seg = lane & 3, t = (c - 4) * 64 + 16 * w + tl, g = t + CTX, cch = h * 64 + 16 * seg;
            float yv[16];
#pragma unroll
            for (int q = 0; q < 4; ++q) { const f32x4 v4 = *(const f32x4*)(ty + tl * 68 + 16 * seg + 4 * q); yv[4 * q] = v4[0]; yv[4 * q + 1] = v4[1]; yv[4 * q + 2] = v4[2]; yv[4 * q + 3] = v4[3]; }
            float sm = 0.f;
#pragma unroll
            for (int j = 0; j < 16; ++j) sm += yv[j];
            sm += __shfl_xor(sm, 1, 64); sm += __shfl_xor(sm, 2, 64);
            const float mean = sm * (1.f / 64.f);
            float q2 = 0.f;
#pragma unroll
            for (int j = 0; j < 16; ++j) { const float d = yv[j] - mean; q2 += d * d; }
            q2 += __shfl_xor(q2, 1, 64); q2 += __shfl_xor(q2, 2, 64);
            const float rs = rsqrtf(q2 * (1.f / 64.f) + 64e-5f);
            const float bon = dot[((size_t)g * 8 + h) * 2] + dot[((size_t)g * 8 + h) * 2 + 1];
            float vv[16], gg[16], o[16];
            unpack8(*(const u32x4*)((const bf16_t*)(p.ws + OFF_V) + (size_t)t * DR + cch), vv); unpack8(*(const u32x4*)((const bf16_t*)(p.ws + OFF_V) + (size_t)t * DR + cch + 8), vv + 8);
            unpack8(*(const u32x4*)((const bf16_t*)(p.ws + OFF_G) + (size_t)t * DR + cch), gg); unpack8(*(const u32x4*)((const bf16_t*)(p.ws + OFF_G) + (size_t)t * DR + cch + 8), gg + 8);
#pragma unroll
            for (int q = 0; q < 4; ++q) {
                const f32x4 gw = *(const f32x4*)(p.gn_w + cch + 4 * q), gb = *(const f32x4*)(p.gn_b + cch + 4 * q);
#pragma unroll
                for (int j = 0; j < 4; ++j) o[4 * q + j] = ((yv[4 * q + j] - mean) * rs * gw[j] + gb[j] + bon * vv[4 * q + j]) * gg[4 * q + j];
            }
            *(u32x4*)(mix + (size_t)t * D + cch) = pack8(o); *(u32x4*)(mix + (size_t)t * D + cch + 8) = pack8(o + 8);
        }
        __builtin_amdgcn_wave_barrier();
    }
}

struct EpiX2 { float* o; const float* x; const float* gt; const float* rowtab; const float* coltab; int row0, col0;
    DI void operator()(int r, int c, const f32x16& a, const f32x16&) const {
        const int t = row0 + r, d = col0 + c;
        const float* pt = d < 512 ? rowtab + (t >> 6) * 512 + d : coltab + (t & 63) * 512 + (d - 512);
#pragma unroll
        for (int q = 0; q < 4; ++q) {
            const f32x4 xv = *(const f32x4*)(x + (size_t)t * D + d + 4 * q), pv = *(const f32x4*)(pt + 4 * q), gv = *(const f32x4*)(gt + d + 4 * q);
            const f32x4 av = {a[4 * q], a[4 * q + 1], a[4 * q + 2], a[4 * q + 3]};
            *(f32x4*)(o + (size_t)t * D + d + 4 * q) = xv + pv + gv * av;
        } } };
DI void phase_g2(const Params& p, int bid, int nblk, char* lds) {
    const bf16_t* mix = (const bf16_t*)(p.ws + OFF_MIX);
    const XcdOrder ord(bid, nblk, 64 * 8);
    for (int i = 0, q; (q = ord.item(i)) >= 0; ++i) {
        int tm, tn; tile_rc(q, 64, 8, tm, tn);
        PlainA al{mix + (size_t)tm * 256 * D, D};
        EpiX2 e{(float*)(p.ws + OFF_X2), p.x, (const float*)(p.ws + OFF_MODX) + 2048, (const float*)(p.ws + OFF_ROWTAB), (const float*)(p.ws + OFF_COLTAB), tm * 256, tn * 128};
        gemm256<1, true>(al, (const bf16_t*)(p.ws + OFF_WOUTB) + tn * 128, nullptr, D, D, lds, e);
    }
}

DI float router_w(const Params& p, int k, int n) { return n < 4 ? p.w_rg[k * 4 + n] : (n < 36 ? p.w_re[k * 32 + (n - 4)] : 0.f); }
DI void phase_router_prep(const Params& p, int bid, int nblk) {
    const float* modx = (const float*)(p.ws + OFF_MODX);
    float* wp = (float*)(p.ws + OFF_WP); float* b2 = (float*)(p.ws + OFF_B2);
    for (int idx = bid * 256 + threadIdx.x; idx < 64 * 4 * 3 * 64; idx += nblk * 256) {
        const int ln = idx & 63, r = idx >> 6, nt = r % 3, me = r / 3, e = me & 3, m = me >> 2;
        const int k = 16 * m + 4 * (ln >> 4) + e, n = 16 * nt + (ln & 15);
        wp[idx] = p.norm2_g[k] * (1.f + modx[4096 + k]) * router_w(p, k, n);
    }
    const int lane = threadIdx.x & 63, wv = bid * 4 + (threadIdx.x >> 6);
    if (wv < 36) {
        float sacc = 0.f;
        for (int k = lane; k < D; k += 64) sacc += modx[3072 + k] * router_w(p, k, wv);
        sacc = wave_sum(sacc);
        if (lane == 0) b2[wv] = sacc + (wv < 4 ? p.b_rg[wv] : p.b_re[wv - 4]);
    }
}

DI void phase_router(const Params& p, int bid, int nblk, char* lds, bool dry = false) {
    const int lane = threadIdx.x & 63, wid = threadIdx.x >> 6, tr = lane & 15, kq = lane >> 4;
    const float* x2 = (const float*)(p.ws + OFF_X2); const float* modx = (const float*)(p.ws + OFF_MODX);
    const float* wp = (const float*)(p.ws + OFF_WP); const float* b2 = (const float*)(p.ws + OFF_B2);
    bf16_t* h2 = (bf16_t*)(p.ws + OFF_H2); int* cnt = (int*)(p.ws + OFF_CNT); float* gate = (float*)(p.ws + OFF_GATE); int* list = (int*)(p.ws + OFF_LIST);
    float* slog = (float*)lds + wid * (16 * 49);
    for (int task = bid * 4 + wid; task < S / 16; task += nblk * 4) {
        const int t0 = task * 16;
        const float* xr = x2 + (size_t)(t0 + tr) * D + 4 * kq;
        f32x4 acc[3];
#pragma unroll
        for (int i = 0; i < 3; ++i) acc[i] = (f32x4){0, 0, 0, 0};
        float ss = 0.f;
#pragma unroll 4
        for (int m = 0; m < 64; ++m) {
            const f32x4 xv = *(const f32x4*)(xr + 16 * m);
            ss += xv[0] * xv[0] + xv[1] * xv[1] + xv[2] * xv[2] + xv[3] * xv[3];
#pragma unroll
            for (int e = 0; e < 4; ++e)
#pragma unroll
                for (int nt = 0; nt < 3; ++nt) acc[nt] = __builtin_amdgcn_mfma_f32_16x16x4f32(xv[e], wp[((m * 4 + e) * 3 + nt) * 64 + lane], acc[nt], 0, 0, 0);
        }
        ss += __shfl_xor(ss, 16, 64); ss += __shfl_xor(ss, 32, 64);
        const float rstd = rsqrtf(ss * (1.f / 1024.f) + 1e-6f);
#pragma unroll
        for (int nt = 0; nt < 3; ++nt)
#pragma unroll
            for (int r = 0; r < 4; ++r) slog[(4 * kq + r) * 49 + 16 * nt + tr] = acc[nt][r];
        asm volatile("s_waitcnt lgkmcnt(0)" ::: "memory"); __builtin_amdgcn_wave_barrier();
        if (lane < 16) {
            const int t = t0 + lane;
            const float* lg = slog + lane * 49;
            const float l0 = rstd * lg[0] + b2[0], l1 = rstd * lg[1] + b2[1], l2 = rstd * lg[2] + b2[2], l3 = rstd * lg[3] + b2[3];
            int grp = 0; float mx = l0;
            if (l1 > mx) { mx = l1; grp = 1; }
            if (l2 > mx) { mx = l2; grp = 2; }
            if (l3 > mx) { mx = l3; grp = 3; }
            const float den = __expf(l0 - mx) + __expf(l1 - mx) + __expf(l2 - mx) + __expf(l3 - mx);
            const float pgrp = 1.f / den;
            int i1 = 0, i2 = -1; float v1 = -3.0e38f, v2 = -3.0e38f;
            for (int n = 0; n < 8; ++n) {
                const float sv = rstd * lg[4 + grp * 8 + n] + b2[4 + grp * 8 + n];
                if (sv > v1) { v2 = v1; i2 = i1; v1 = sv; i1 = n; } else if (sv > v2) { v2 = sv; i2 = n; }
            }
            const float e2 = __expf(v2 - v1), g1 = pgrp / (1.f + e2), g2v = pgrp * e2 / (1.f + e2);
            const int ea = grp * 8 + i1, eb = grp * 8 + i2;
            if (!dry) {
                const int pa = atomicAdd(&cnt[ea], 1), pb = atomicAdd(&cnt[eb], 1);
                list[ea * LCAP + pa] = t * 2; list[eb * LCAP + pb] = t * 2 + 1;
            }
            gate[t * 2] = g1; gate[t * 2 + 1] = g2v;
        }
        for (int r = 0; r < 16; ++r) {
            const float rs = __shfl(rstd, r, 64);
            const float* src = x2 + (size_t)(t0 + r) * D;
#pragma unroll
            for (int i = 0; i < 4; ++i) {
                const int d = (i * 64 + lane) * 4;
                const f32x4 v = *(const f32x4*)(src + d), gg = *(const f32x4*)(p.norm2_g + d), sh = *(const f32x4*)(modx + 3072 + d), sc = *(const f32x4*)(modx + 4096 + d);
                f32x4 hv;
#pragma unroll
                for (int j = 0; j < 4; ++j) hv[j] = (v[j] * rs * gg[j]) * (1.f + sc[j]) + sh[j];
                u32x2 pk = {pack2(hv[0], hv[1]), pack2(hv[2], hv[3])};
                *(u32x2*)(h2 + (size_t)(t0 + r) * D + d) = pk;
            }
        }
        __builtin_amdgcn_wave_barrier();
    }
}

DI void moe_tiles(const int* cnt, int* tstart  ) {
    if (threadIdx.x == 0) { int acc = 0; for (int e = 0; e < NE; ++e) { tstart[e] = acc; acc += (cnt[e] + 255) >> 8; } tstart[NE] = acc; }
    __syncthreads();
}
struct EpiHid { bf16_t* o; DI void operator()(int r, int c, const f32x16& g, const f32x16& u) const {
    f32x16 h;
#pragma unroll
    for (int j = 0; j < 16; ++j) h[j] = g[j] * sigmoidf_(g[j]) * u[j];
    *(u32x4*)(o + (size_t)r * DE + c) = pack8q(h, 0); *(u32x4*)(o + (size_t)r * DE + c + 8) = pack8q(h, 1); } };
DI void phase_g3(const Params& p, int bid, int nblk, char* lds) {
    int* tstart = (int*)(lds + GEMM_LDS);
    const int* cnt = (const int*)(p.ws + OFF_CNT); const int* list = (const int*)(p.ws + OFF_LIST);
    const bf16_t* h2 = (const bf16_t*)(p.ws + OFF_H2); bf16_t* hid = (bf16_t*)(p.ws + OFF_HID);
    moe_tiles(cnt, tstart);
    const int ntiles = tstart[NE];
    const XcdOrder ord(bid, nblk, ntiles * 8);
    for (int i = 0, item; (item = ord.item(i)) >= 0; ++i) {
        const int ti = item >> 3, cj = item & 7;
        int e = 0; while (e < NE - 1 && tstart[e + 1] <= ti) ++e;
        const int lt = ti - tstart[e], ne = cnt[e];
        GatherA al;
#pragma unroll
        for (int i = 0; i < 8; ++i) { const int row = (4 * i + (threadIdx.x >> 6)) * 8 + ((threadIdx.x & 63) >> 3), pos = lt * 256 + row; const int tok = pos < ne ? (list[e * LCAP + pos] >> 1) : 0; al.rp[i] = h2 + (size_t)tok * D; }
        EpiHid epi{hid + (size_t)ti * 256 * DE + cj * 64};
        gemm256<2, false>(al, p.w_gate + (size_t)e * D * DE + cj * 64, p.w_up + (size_t)e * D * DE + cj * 64, DE, D, lds, epi);
    }
}
struct EpiDown { bf16_t* ybuf; const int* lst; const float* gate; int nvalid; int col0;
    DI void operator()(int r, int c, const f32x16& a, const f32x16&) const {
        if (r >= nvalid) return; const int slot = lst[r]; const float g = gate[slot];
        const f32x16 v = a * g;
        *(u32x4*)(ybuf + (size_t)slot * D + col0 + c) = pack8q(v, 0); *(u32x4*)(ybuf + (size_t)slot * D + col0 + c + 8) = pack8q(v, 1); } };
DI void phase_g4(const Params& p, int bid, int nblk, char* lds) {
    int* tstart = (int*)(lds + GEMM_LDS);
    const int* cnt = (const int*)(p.ws + OFF_CNT); const int* list = (const int*)(p.ws + OFF_LIST);
    const bf16_t* hid = (const bf16_t*)(p.ws + OFF_HID);
    moe_tiles(cnt, tstart);
    const int ntiles = tstart[NE];
    const XcdOrder ord(bid, nblk, ntiles * 8);
    for (int i = 0, item; (item = ord.item(i)) >= 0; ++i) {
        const int ti = item >> 3, cj = item & 7;
        int e = 0; while (e < NE - 1 && tstart[e + 1] <= ti) ++e;
        const int lt = ti - tstart[e], ne = cnt[e];
        PlainA al{hid + (size_t)ti * 256 * DE, DE};
        EpiDown epi{(bf16_t*)(p.ws + OFF_YBUF), list + e * LCAP + lt * 256, (const float*)(p.ws + OFF_GATE), ne - lt * 256, cj * 128};
        gemm256<1, false>(al, p.w_down + (size_t)e * DE * D + cj * 128, nullptr, D, DE, lds, epi);
    }
}

DI void phase_final(const Params& p, int bid, int nblk) {
    const int lane = threadIdx.x & 63, wid = threadIdx.x >> 6;
    const float* x2 = (const float*)(p.ws + OFF_X2); const float* gt = (const float*)(p.ws + OFF_MODX) + 5120; const bf16_t* yb = (const bf16_t*)(p.ws + OFF_YBUF);
    for (int tp = bid * 4 + wid; tp < S / 2; tp += nblk * 4) {
        f32x4 v[2][4]; float ss[2] = {0.f, 0.f};
        u32x2 ya[2][4], ybv[2][4];
#pragma unroll
        for (int r = 0; r < 2; ++r)
#pragma unroll
            for (int i = 0; i < 4; ++i) {
                const int t = 2 * tp + r, d = (i * 64 + lane) * 4;
                v[r][i] = *(const f32x4*)(x2 + (size_t)t * D + d);
                ya[r][i] = *(const u32x2*)(yb + (size_t)(2 * t) * D + d); ybv[r][i] = *(const u32x2*)(yb + (size_t)(2 * t + 1) * D + d);
            }
#pragma unroll
        for (int r = 0; r < 2; ++r)
#pragma unroll
            for (int i = 0; i < 4; ++i) {
                const int d = (i * 64 + lane) * 4; const f32x4 g = *(const f32x4*)(gt + d); const u32x2 a = ya[r][i], b = ybv[r][i];
                v[r][i][0] += g[0] * (bflo(a.x) + bflo(b.x)); v[r][i][1] += g[1] * (bfhi(a.x) + bfhi(b.x));
                v[r][i][2] += g[2] * (bflo(a.y) + bflo(b.y)); v[r][i][3] += g[3] * (bfhi(a.y) + bfhi(b.y));
                ss[r] += v[r][i][0] * v[r][i][0] + v[r][i][1] * v[r][i][1] + v[r][i][2] * v[r][i][2] + v[r][i][3] * v[r][i][3];
            }
#pragma unroll
        for (int r = 0; r < 2; ++r) {
            const float rstd = rsqrtf(wave_sum(ss[r]) * (1.f / 1024.f) + 1e-6f);
#pragma unroll
            for (int i = 0; i < 4; ++i) {
                const int d = (i * 64 + lane) * 4; const f32x4 fg = *(const f32x4*)(p.final_g + d); f32x4 o;
#pragma unroll
                for (int j = 0; j < 4; ++j) o[j] = v[r][i][j] * rstd * fg[j];
                *(f32x4*)(p.out + (size_t)(2 * tp + r) * D + d) = o;
            }
        }
    }
}

#define XB_TMO      128
#define XB_XCNT(j)  (256  + 64 * (j))
#define XB_XSUB(j)  (1280 + 64 * (j))
#define XB_XGEN(j)  (2304 + 64 * (j))
#define XB_TOP      3328
#define XB_TOPGEN   3392
#define XCD_BAR_WORDS 3456
#define XB_SPIN_CAP (1u << 18)
DI unsigned xb_ld(unsigned* p) { return __hip_atomic_load(p, __ATOMIC_RELAXED, __HIP_MEMORY_SCOPE_AGENT); }
DI unsigned xb_add(unsigned* p, unsigned v) { return __hip_atomic_fetch_add(p, v, __ATOMIC_RELAXED, __HIP_MEMORY_SCOPE_AGENT); }
DI unsigned xb_xcc_id() { return (unsigned)__builtin_amdgcn_s_getreg((3 << 11) | 20) & 0xFu; }
#define XB_SPIN(cond, bar) do { unsigned _sp = 0; while (cond) { __builtin_amdgcn_s_sleep(1); \
    if ((++_sp & 255u) == 0u) { if (xb_ld(&(bar)[XB_TMO])) break; if (_sp > XB_SPIN_CAP) { atomicAdd(&(bar)[XB_TMO], 1u); break; } } } } while (0)
struct XcdBarrier { unsigned* bar; unsigned x; volatile LAS unsigned* st; };
DI XcdBarrier xcd_barrier_post(unsigned* bar, volatile LAS unsigned* st) {
    XcdBarrier b; b.bar = bar; b.x = xb_xcc_id(); b.st = st;
    if (threadIdx.x == 0) (void)xb_add(&bar[XB_XCNT(b.x)], 1u);
    return b;
}
DI void xcd_barrier_complete(unsigned* bar, unsigned x, unsigned& nloc, unsigned& nx) {
    const unsigned G = gridDim.x * gridDim.y * gridDim.z;
    unsigned sum, cnt, mine, sp = 0u;
    for (;;) {
        sum = 0u; cnt = 0u; mine = 0u;
#pragma unroll
        for (unsigned j = 0; j < 16; ++j) { const unsigned c = xb_ld(&bar[XB_XCNT(j)]); sum += c; cnt += (c > 0u) ? 1u : 0u; mine = (j == x) ? c : mine; }
        if (sum == G) break;
        __builtin_amdgcn_s_sleep(1);
        if ((++sp & 255u) == 0u) { if (xb_ld(&bar[XB_TMO])) break; if (sp > XB_SPIN_CAP) { atomicAdd(&bar[XB_TMO], 1u); break; } }
    }
    nloc = mine > 0u ? mine : 1u; nx = cnt > 0u ? cnt : 1u;
}
DI void xcd_barrier(const XcdBarrier& b) {
    asm volatile("s_waitcnt vmcnt(0)" ::: "memory");
    __syncthreads();
    if (threadIdx.x == 0) {
        unsigned* bar = b.bar;
        __builtin_amdgcn_s_waitcnt(0);
        unsigned nloc = b.st[0], nx = b.st[1];
        if (nloc == 0u) { xcd_barrier_complete(bar, b.x, nloc, nx); b.st[0] = nloc; b.st[1] = nx; }
        const unsigned old = xb_add(&bar[XB_XSUB(b.x)], 1u);
        const unsigned gen = old / nloc;
        if (old + 1u == (gen + 1u) * nloc) {
            __builtin_amdgcn_fence(__ATOMIC_RELEASE, "agent");
            asm volatile("s_waitcnt vmcnt(0)" ::: "memory");
            const unsigned og = xb_add(&bar[XB_TOP], 1u);
            const unsigned tg = og / nx;
            if (og + 1u == (tg + 1u) * nx) xb_add(&bar[XB_TOPGEN], 1u);
            else XB_SPIN(xb_ld(&bar[XB_TOPGEN]) == tg, bar);
            __builtin_amdgcn_fence(__ATOMIC_ACQUIRE, "agent");
            xb_add(&bar[XB_XGEN(b.x)], 1u);
            asm volatile("s_waitcnt vmcnt(0)" ::: "memory");
        } else {
            XB_SPIN(xb_ld(&bar[XB_XGEN(b.x)]) == gen, bar);
            __builtin_amdgcn_fence(__ATOMIC_ACQUIRE, "agent");
            asm volatile("s_waitcnt vmcnt(0)" ::: "memory");
        }
    }
    __syncthreads();
}

#ifndef PROBE
#define PROBE 0
#endif
constexpr int MEGA_LDS = SCANA_LDS > (GEMM_LDS + 256) ? SCANA_LDS : (GEMM_LDS + 256);
__global__ void __launch_bounds__(256) k_mega(Params p) {
    extern __shared__ __attribute__((aligned(16))) char lds[];
    const int bid = blockIdx.x, nblk = gridDim.x;
    volatile LAS unsigned* st = (volatile LAS unsigned*)(lds + MEGA_LDS);
    if (threadIdx.x < 4) st[threadIdx.x] = 0u;
    __syncthreads();
    const XcdBarrier gb = xcd_barrier_post((unsigned*)(p.ws + OFF_BAR), st);
#define GSYNC() xcd_barrier(gb)
    phase_p0(p, bid, nblk, lds); GSYNC();
    if (PROBE == 1) { phase_p0(p, bid, nblk, lds); GSYNC(); }
    phase_xn(p, bid, nblk); phase_router_prep(p, bid, nblk); GSYNC();
    if (PROBE == 2) { phase_xn(p, bid, nblk); GSYNC(); }
    phase_g1(p, bid, nblk, lds); GSYNC();
    if (PROBE == 3) { phase_g1(p, bid, nblk, lds); GSYNC(); }
    if (PROBE == 33) { phase_mfma_rate(p, 5120); GSYNC(); }
    if (PROBE == 34) { phase_mfma_rate32(p, 2560); GSYNC(); }
    phase_pool(p, bid, nblk);
    phase_scanA(p, bid, nblk, lds); GSYNC();
    if (PROBE == 4) { phase_scanA(p, bid, nblk, lds); GSYNC(); }
    if (PROBE == 41) { phase_scanA<1>(p, bid, nblk, lds); GSYNC(); }
    if (PROBE == 42) { phase_scanA<2>(p, bid, nblk, lds); GSYNC(); }
    if (PROBE == 12) { phase_pool(p, bid, nblk); GSYNC(); }
    for (int it = bid; it < 256; it += nblk) chain_run<1>(p, it >> 4, it & 15);
    GSYNC();
    if (bid < 16) chain_groups(p, bid); else phase_poolgemm(p, bid - 16, nblk - 16, lds);
    GSYNC();
    for (int it = bid; it < 256; it += nblk) chain_run<3>(p, it >> 4, it & 15);
    GSYNC();
    phase_scanC(p, bid, nblk, lds); GSYNC();
    if (PROBE == 6) { phase_scanC(p, bid, nblk, lds); GSYNC(); }
    phase_g2(p, bid, nblk, lds); GSYNC();
    if (PROBE == 7) { phase_g2(p, bid, nblk, lds); GSYNC(); }
    if (PROBE == 8) { phase_router(p, bid, nblk, lds, true); GSYNC(); }
    phase_router(p, bid, nblk, lds); GSYNC();
    phase_g3(p, bid, nblk, lds); GSYNC();
    if (PROBE == 9) { phase_g3(p, bid, nblk, lds); GSYNC(); }
    phase_g4(p, bid, nblk, lds); GSYNC();
    if (PROBE == 10) { phase_g4(p, bid, nblk, lds); GSYNC(); }
    if (PROBE == 11) { phase_final(p, bid, nblk); GSYNC(); }
    phase_final(p, bid, nblk);
}

extern "C" void kernel_launch(void* const* d_in, const int* in_sizes, int n_in, void* d_out, int out_size, void* d_ws, size_t ws_size, hipStream_t stream) {
    if (ws_size < WS_NEED) { fprintf(stderr, "workspace too small: %zu < %zu\n", ws_size, (size_t)WS_NEED); return; }
    Params p{};
    const float** f = (const float**)&p;
    for (int i = 0; i < 36; ++i) f[i] = (const float*)d_in[i];
    p.out = (float*)d_out; p.ws = (char*)d_ws;
    static int grid_blocks = 0;
    if (!grid_blocks) {
        (void)hipFuncSetAttribute((const void*)k_mega, hipFuncAttributeMaxDynamicSharedMemorySize, MEGA_LDS + 16);
        int dev = 0, cus = 0, per_cu = 0;
        (void)hipGetDevice(&dev);
        (void)hipDeviceGetAttribute(&cus, hipDeviceAttributeMultiprocessorCount, dev);
        (void)hipOccupancyMaxActiveBlocksPerMultiprocessor(&per_cu, k_mega, 256, MEGA_LDS + 16);
        if (per_cu > 1) per_cu = 1;
        grid_blocks = cus * per_cu;
    }
    (void)hipMemsetAsync((char*)d_ws + OFF_BAR, 0, 16384, stream);
    void* args[] = {&p};
    hipError_t e = hipLaunchCooperativeKernel((const void*)k_mega, dim3(grid_blocks), dim3(256), args, MEGA_LDS + 16, stream);
    if (e != hipSuccess) fprintf(stderr, "cooperative launch failed: %s (grid %d)\n", hipGetErrorString(e), grid_blocks);
}
```

```cpp
#include <hip/hip_runtime.h>
#include <stdint.h>
#include <stdio.h>
#include <hip/hip_cooperative_groups.h>
namespace cg = cooperative_groups;

#define DI __device__ __forceinline__
typedef unsigned short bf16_t;
typedef short bf16x8 __attribute__((ext_vector_type(8)));
typedef short s16x4 __attribute__((ext_vector_type(4)));
typedef float f32x4 __attribute__((ext_vector_type(4)));
typedef float f32x2 __attribute__((ext_vector_type(2)));
typedef __bf16 bf16x2_t __attribute__((ext_vector_type(2)));
typedef unsigned u32x4 __attribute__((ext_vector_type(4)));
typedef unsigned u32x2 __attribute__((ext_vector_type(2)));
#define LAS __attribute__((address_space(3)))

constexpr int D = 1024, S = 16384, CTX = 256, NT = S + CTX, DIN = 2432, DSH = 1920, DR = 512;
constexpr int C_WLF = 1536, C_WLB = 1600, C_ALF = 1664, C_ALB = 1728, C_GL = 1792, C_POOL = 1920;
constexpr int NE = 32, DE = 512, LCAP = 32768;
constexpr float DECAY_SCALE = 0.6065306597f;
constexpr int NTH = 512, NWV = 8;

constexpr int NCH = NT / 64;
constexpr size_t SZ_U = (size_t)NT * DIN * 2;
constexpr size_t SZ_CH = (size_t)16 * NCH * 8192;
constexpr size_t OFF_U = 0;
constexpr size_t OFF_XN = OFF_U + SZ_U;
constexpr size_t OFF_P = OFF_XN;
constexpr size_t OFF_Q = OFF_P + SZ_CH;
constexpr size_t OFF_WYT = OFF_Q + SZ_CH;
constexpr size_t OFF_YL = OFF_WYT + (size_t)256 * 16 * 8192;
constexpr size_t OFF_V = OFF_YL + (size_t)256 * 16 * 8192;
constexpr size_t OFF_G = OFF_V + (size_t)S * DR * 2;
constexpr size_t OFF_MIX = OFF_G + (size_t)S * DR * 2;
constexpr size_t OFF_SMALL = OFF_MIX + (size_t)S * D * 2;
constexpr size_t OFF_MODX = OFF_SMALL, OFF_MODC = OFF_MODX + 6144 * 4;
constexpr size_t OFF_ROWTAB = OFF_MODC + 6144 * 4, OFF_COLTAB = OFF_ROWTAB + 256 * 512 * 4;
constexpr size_t OFF_CNT = OFF_COLTAB + 64 * 512 * 4;
constexpr size_t OFF_GATE = OFF_CNT + 256;
constexpr size_t OFF_LIST = OFF_GATE + (size_t)S * 2 * 4;
constexpr size_t OFF_DOT = OFF_LIST + (size_t)NE * LCAP * 4;
constexpr size_t OFF_WP = OFF_DOT + (size_t)NT * 16 * 4;
constexpr size_t OFF_B2 = OFF_WP + 64 * 4 * 3 * 64 * 4;
constexpr size_t OFF_BAR = OFF_B2 + 256;
constexpr size_t OFF_WINB = OFF_BAR + 16384;
constexpr size_t OFF_WOUTB = OFF_WINB + (size_t)D * DIN * 2;
constexpr size_t WS_NEED = OFF_WOUTB + (size_t)D * D * 2;
constexpr size_t OFF_Z = OFF_U;
constexpr size_t OFF_X2 = OFF_P;
constexpr size_t OFF_YBUF = OFF_WYT;
constexpr size_t OFF_H2 = OFF_U;
constexpr size_t OFF_HID = OFF_U + SZ_CH;
constexpr size_t OFF_CP = OFF_U + SZ_CH;
constexpr size_t OFF_CQ = OFF_CP + 256 * 8192;
constexpr size_t OFF_ZG = OFF_CQ + 256 * 16384;

struct Params {
    const float *x, *c, *ctx, *c_ctx, *norm1_g, *w_mod, *b_mod, *w_in, *mu, *w0_f, *w2_f, *w0_b, *w2_b, *a0_f, *a2_f, *a0_b, *a2_b,
        *g2, *k_k, *k_a, *r_k_f, *r_k_b, *gn_w, *gn_b, *w_pool, *pool_scale, *w_out, *norm2_g, *w_rg, *b_rg, *w_re, *b_re,
        *w_gate, *w_up, *w_down, *final_g;
    float* out;
    char* ws;
};

DI unsigned pack2(float lo, float hi) { f32x2 v = {lo, hi}; bf16x2_t b = __builtin_convertvector(v, bf16x2_t); return __builtin_bit_cast(unsigned, b); }
DI float bf2f(bf16_t h) { return __uint_as_float(((unsigned)h) << 16); }
DI float bflo(unsigned u) { return __uint_as_float(u << 16); }
DI float bfhi(unsigned u) { return __uint_as_float(u & 0xffff0000u); }
DI void unpack8(const u32x4& p, float* f) { f[0] = bflo(p.x); f[1] = bfhi(p.x); f[2] = bflo(p.y); f[3] = bfhi(p.y); f[4] = bflo(p.z); f[5] = bfhi(p.z); f[6] = bflo(p.w); f[7] = bfhi(p.w); }
DI u32x4 pack8(const float* f) { u32x4 p; p.x = pack2(f[0], f[1]); p.y = pack2(f[2], f[3]); p.z = pack2(f[4], f[5]); p.w = pack2(f[6], f[7]); return p; }
DI float sigmoidf_(float x) { return 1.f / (1.f + __expf(-x)); }
DI float wave_sum(float v) {
#pragma unroll
    for (int o = 32; o > 0; o >>= 1) v += __shfl_xor(v, o, 64);
    return v;
}
DI f32x4 wave_sum4(f32x4 v) {
#pragma unroll
    for (int o = 32; o > 0; o >>= 1) { v[0] += __shfl_xor(v[0], o, 64); v[1] += __shfl_xor(v[1], o, 64); v[2] += __shfl_xor(v[2], o, 64); v[3] += __shfl_xor(v[3], o, 64); }
    return v;
}
typedef float f32x16 __attribute__((ext_vector_type(16)));
DI f32x16 zero16() { f32x16 z; for (int i = 0; i < 16; ++i) z[i] = 0.f; return z; }
DI s16x4 tr16(const bf16_t* a) { return __builtin_amdgcn_ds_read_tr16_b64_v4i16((LAS s16x4*)a); }
DI float pos_val(const float* rowtab, const float* coltab, int t, int d) { return d < 512 ? rowtab[(t >> 6) * 512 + d] : coltab[(t & 63) * 512 + (d - 512)]; }

DI void phase_p0(const Params& p, int bid, int nblk, char* lds) {
    const int tid = threadIdx.x;
    float* modx = (float*)(p.ws + OFF_MODX); float* modc = (float*)(p.ws + OFF_MODC);
    float* red = (float*)lds;
    for (int item = bid; item < 96; item += nblk) {
        const int col0 = item * 64, cg = tid & 15, kg = tid >> 4;
        f32x4 ax = {0, 0, 0, 0}, ac = {0, 0, 0, 0};
        for (int kk = 0; kk < 32; ++kk) {
            const int k = kg * 32 + kk;
            const float cv = p.c[k], cc = p.c_ctx[k];
            const float sx = cv * sigmoidf_(cv), sc = cc * sigmoidf_(cc);
            const f32x4 w = *(const f32x4*)(p.w_mod + (size_t)k * 6144 + col0 + cg * 4);
            ax += w * sx; ac += w * sc;
        }
        __syncthreads();
#pragma unroll
        for (int j = 0; j < 4; ++j) { red[(kg * 64 + cg * 4 + j) * 2] = ax[j]; red[(kg * 64 + cg * 4 + j) * 2 + 1] = ac[j]; }
        __syncthreads();
        if (tid < 128) {
            const int col = tid & 63, which = tid >> 6;
            float s = 0.f;
            for (int g = 0; g < 32; ++g) s += red[(g * 64 + col) * 2 + which];
            s += p.b_mod[col0 + col];
            (which ? modc : modx)[col0 + col] = s;
        }
    }
    float* rowtab = (float*)(p.ws + OFF_ROWTAB); float* coltab = (float*)(p.ws + OFF_COLTAB);
    for (int i = bid * NTH + tid; i < (256 + 64) * 256; i += nblk * NTH) {
        const int pos = i >> 8, f = i & 255;
        const float freq = powf(10000.f, -(float)f / 256.f);
        if (pos < 256) { const float a = (float)pos * freq; rowtab[pos * 512 + f] = sinf(a); rowtab[pos * 512 + 256 + f] = cosf(a); }
        else { const int cp = pos - 256; const float a = (float)cp * freq; coltab[cp * 512 + f] = sinf(a); coltab[cp * 512 + 256 + f] = cosf(a); }
    }
    if (bid == 0 && tid < 64) ((int*)(p.ws + OFF_CNT))[tid] = 0;
    for (int pass = 0; pass < 2; ++pass) {
        const float* src = pass ? p.w_out : p.w_in; const int nc = pass ? D : DIN; bf16_t* dst = (bf16_t*)(p.ws + (pass ? OFF_WOUTB : OFF_WINB));
        const int n8 = nc >> 3;
        for (int idx = bid * NTH + tid; idx < D * n8; idx += nblk * NTH) {
            const int k = idx / n8, g8 = idx - k * n8, blk = g8 >> 2, q = g8 & 3;
            const f32x4 lo = *(const f32x4*)(src + (size_t)k * nc + blk * 32 + 4 * q), hi = *(const f32x4*)(src + (size_t)k * nc + blk * 32 + 16 + 4 * q);
            *(u32x4*)(dst + (size_t)k * nc + blk * 32 + 8 * q) = (u32x4){pack2(lo[0], lo[1]), pack2(lo[2], lo[3]), pack2(hi[0], hi[1]), pack2(hi[2], hi[3])};
        }
    }
}

DI void phase_xn(const Params& p, int bid, int nblk) {
    const int lane = threadIdx.x & 63, wid = threadIdx.x >> 6;
    const float* modx = (const float*)(p.ws + OFF_MODX); const float* modc = (const float*)(p.ws + OFF_MODC);
    const float* rowtab = (const float*)(p.ws + OFF_ROWTAB); const float* coltab = (const float*)(p.ws + OFF_COLTAB);
    bf16_t* xn = (bf16_t*)(p.ws + OFF_XN);
    for (int gp = bid * NWV + wid; gp < NT / 2; gp += nblk * NWV) {
        const int g0 = 2 * gp; const bool isctx = g0 < CTX;
        const float* md = isctx ? modc : modx;
        f32x4 v[2][4]; float ss[2] = {0.f, 0.f};
#pragma unroll
        for (int r = 0; r < 2; ++r)
#pragma unroll
            for (int i = 0; i < 4; ++i) {
                const int g = g0 + r, t = g - CTX, d = (i * 64 + lane) * 4;
                const float* src = isctx ? p.ctx + (size_t)g * D : p.x + (size_t)t * D;
                v[r][i] = *(const f32x4*)(src + d);
                if (!isctx) v[r][i] += *(const f32x4*)(d < 512 ? rowtab + (t >> 6) * 512 + d : coltab + (t & 63) * 512 + (d - 512));
                ss[r] += v[r][i][0] * v[r][i][0] + v[r][i][1] * v[r][i][1] + v[r][i][2] * v[r][i][2] + v[r][i][3] * v[r][i][3];
            }
#pragma unroll
        for (int r = 0; r < 2; ++r) {
            const float rstd = rsqrtf(wave_sum(ss[r]) * (1.f / 1024.f) + 1e-6f);
#pragma unroll
            for (int i = 0; i < 4; ++i) {
                const int d = (i * 64 + lane) * 4;
                const f32x4 gg = *(const f32x4*)(p.norm1_g + d), sh = *(const f32x4*)(md + d), sc = *(const f32x4*)(md + 1024 + d);
                f32x4 o;
#pragma unroll
                for (int j = 0; j < 4; ++j) o[j] = (v[r][i][j] * rstd * gg[j]) * (1.f + sc[j]) + sh[j];
                u32x2 pk = {pack2(o[0], o[1]), pack2(o[2], o[3])};
                *(u32x2*)(xn + (size_t)(g0 + r) * D + d) = pk;
            }
        }
    }
}

constexpr int GA_SZ = 256 * 128, GB_SZ = 34816, GBUF_SZ = GA_SZ + GB_SZ;
constexpr int GEMM_LDS = 2 * GBUF_SZ;
DI void glds16(const void* gsrc, char* ldst) { __builtin_amdgcn_global_load_lds((const unsigned*)gsrc, (LAS unsigned*)ldst, 16, 0, 0); }
template <int NB, bool BGLDS, int NBLK, class AL, class EPI>
DI void gemm8(const AL& al, const void* __restrict__ Bv0, const void* __restrict__ Bv1, int ldb, int K, char* lds, EPI& epi) {
    static_assert(!(BGLDS && NB == 2) && !(NB == 2 && NBLK == 2), "unsupported combination");
    constexpr int WN = 32 * NBLK, BN = 4 * WN;
    constexpr int RB = BN * 2;
    constexpr int BP = BN + 8;
    constexpr int NF4 = BN / 4;
    constexpr int NLD = (64 * NF4) / NTH;
    constexpr int NPB = (64 * RB) / (1024 * NWV);
    int tid = threadIdx.x; asm volatile("" : "+v"(tid));
    const int lane = tid & 63, wid = __builtin_amdgcn_readfirstlane(tid >> 6), wr = wid >> 2, wc = wid & 3, r32 = lane & 31, hh = lane >> 5, gi = lane >> 4, i16 = lane & 15;
    const float* B0 = (const float*)Bv0; const float* B1 = (const float*)Bv1; const bf16_t* Bb = (const bf16_t*)Bv0;
    f32x16 acc0[4][NBLK], acc1[4][NBLK];
#pragma unroll
    for (int m = 0; m < 4; ++m)
#pragma unroll
        for (int n = 0; n < NBLK; ++n) { acc0[m][n] = zero16(); acc1[m][n] = zero16(); }
    f32x4 rb0[NLD], rb1[NLD];
    const int T = K >> 6;
    const bf16_t* arow[4];
#pragma unroll
    for (int i = 0; i < 4; ++i) { const int row = (8 * i + wid) * 8 + (lane >> 3); arow[i] = al.rowptr(i, row) + (((lane & 7) ^ ((row >> 1) & 7)) << 3); }
    int bsrc[NPB];
#pragma unroll
    for (int i = 0; i < NPB; ++i) { const int k = (8 * i + wid) * (1024 / RB) + lane / (RB / 16), pp = lane % (RB / 16); bsrc[i] = k * ldb + ((((pp >> 1) ^ (k & 7)) << 1) + (pp & 1)) * 8; }
    const int a_base = (wr * 128 + r32) * 128, a_sw = (r32 >> 1) & 7;
    const int b_off = (8 * (gi >> 1) + (i16 >> 2)) * BP + wc * WN + 16 * (gi & 1) + 4 * (i16 & 3);
#define G_DMA(buf, t_) do { char* dA_ = lds + (buf) * GBUF_SZ + wid * 1024 + lane * 16; \
        _Pragma("unroll") for (int i = 0; i < 4; ++i) glds16(arow[i] + (t_) * 64, dA_ + i * 8192); \
        if (BGLDS) { char* dB_ = lds + (buf) * GBUF_SZ + GA_SZ + wid * 1024 + lane * 16; \
            _Pragma("unroll") for (int i = 0; i < NPB; ++i) glds16(Bb + (size_t)(t_) * 64 * ldb + bsrc[i], dB_ + i * 8192); } } while (0)
#define G_LOADB(t_) do { const int k0_ = (t_) * 64; \
        _Pragma("unroll") for (int i = 0; i < NLD; ++i) { const int c = tid + NTH * i, kr = c / NF4, n4 = c % NF4; rb0[i] = *(const f32x4*)(B0 + (size_t)(k0_ + kr) * ldb + n4 * 4); \
            if (NB == 2) rb1[i] = *(const f32x4*)(B1 + (size_t)(k0_ + kr) * ldb + n4 * 4); } } while (0)
#define G_WRITEB(buf) do { bf16_t* sB0_ = (bf16_t*)(lds + (buf) * GBUF_SZ + GA_SZ); bf16_t* sB1_ = sB0_ + 64 * BP; \
        _Pragma("unroll") for (int i = 0; i < NLD; ++i) { const int c = tid + NTH * i, kr = c / NF4, n4 = c % NF4, slot = (n4 >> 3) * 32 + 8 * (n4 & 3) + 4 * ((n4 >> 2) & 1); \
            u32x2 pk = {pack2(rb0[i][0], rb0[i][1]), pack2(rb0[i][2], rb0[i][3])}; *(u32x2*)(sB0_ + kr * BP + slot) = pk; \
            if (NB == 2) { u32x2 pk1 = {pack2(rb1[i][0], rb1[i][1]), pack2(rb1[i][2], rb1[i][3])}; *(u32x2*)(sB1_ + kr * BP + slot) = pk1; } } } while (0)
#define G_READ(buf, ks, AF, BF0, BF1) do { const char* sA_ = lds + (buf) * GBUF_SZ; const bf16_t* sB0_ = (const bf16_t*)(lds + (buf) * GBUF_SZ + GA_SZ); const bf16_t* sB1_ = sB0_ + 64 * BP; const int k0_ = (ks) * 16; \
        _Pragma("unroll") for (int n = 0; n < NBLK; ++n) { \
            if (BGLDS) { const int kk_ = k0_ + 8 * (gi >> 1) + (i16 >> 2), gr_ = (wc * WN + n * 32) / 16 + (gi & 1); \
                const char* q0_ = (const char*)sB0_ + kk_ * RB + ((gr_ ^ (kk_ & 7)) << 5) + 8 * (i16 & 3); const char* q1_ = (const char*)sB0_ + (kk_ + 4) * RB + ((gr_ ^ ((kk_ + 4) & 7)) << 5) + 8 * (i16 & 3); \
                s16x4 lo = tr16((const bf16_t*)q0_), hi = tr16((const bf16_t*)q1_); BF0[n] = __builtin_shufflevector(lo, hi, 0, 1, 2, 3, 4, 5, 6, 7); } \
            else { const int off = b_off + k0_ * BP + n * 32; \
                s16x4 lo = tr16(sB0_ + off), hi = tr16(sB0_ + off + 4 * BP); BF0[n] = __builtin_shufflevector(lo, hi, 0, 1, 2, 3, 4, 5, 6, 7); \
                if (NB == 2) { s16x4 lo1 = tr16(sB1_ + off), hi1 = tr16(sB1_ + off + 4 * BP); BF1[n] = __builtin_shufflevector(lo1, hi1, 0, 1, 2, 3, 4, 5, 6, 7); } } } \
        _Pragma("unroll") for (int m = 0; m < 4; ++m) AF[m] = *(const bf16x8*)(sA_ + a_base + m * 4096 + ((((ks) * 2 + hh) ^ a_sw) << 4)); } while (0)
#define G_MFMA(AF, BF0, BF1) do { \
        _Pragma("unroll") for (int m = 0; m < 4; ++m) _Pragma("unroll") for (int n = 0; n < NBLK; ++n) { \
            acc0[m][n] = __builtin_amdgcn_mfma_f32_32x32x16_bf16(BF0[n], AF[m], acc0[m][n], 0, 0, 0); \
            if (NB == 2) acc1[m][n] = __builtin_amdgcn_mfma_f32_32x32x16_bf16(BF1[n], AF[m], acc1[m][n], 0, 0, 0); } } while (0)
#define G_MIX(nm) do { _Pragma("unroll") for (int i = 0; i < (nm); ++i) { __builtin_amdgcn_sched_group_barrier(0x008, 1, 0); __builtin_amdgcn_sched_group_barrier(0x100, 1, 0); } } while (0)
    constexpr int NMF = 4 * NBLK * NB;
    bf16x8 afA[4], bfA0[NBLK], bfA1[NBLK], afB[4], bfB0[NBLK], bfB1[NBLK];
    G_DMA(0, 0);
    if (!BGLDS) { G_LOADB(0); G_WRITEB(0); }
#pragma unroll 1
    for (int t = 0; t < T; ++t) {
        const int buf = t & 1;
        asm volatile("s_waitcnt vmcnt(0)" ::: "memory");
        __syncthreads();
        if (t + 1 < T) { G_DMA(buf ^ 1, t + 1); if (!BGLDS) G_LOADB(t + 1); }
        if (BGLDS) {
            G_READ(buf, 0, afA, bfA0, bfA1);
            __builtin_amdgcn_sched_barrier(0);
            G_MFMA(afA, bfA0, bfA1); G_READ(buf, 1, afB, bfB0, bfB1); G_MIX(NMF);
            __builtin_amdgcn_sched_barrier(0);
            G_MFMA(afB, bfB0, bfB1); G_READ(buf, 2, afA, bfA0, bfA1); G_MIX(NMF);
            __builtin_amdgcn_sched_barrier(0);
            G_MFMA(afA, bfA0, bfA1); G_READ(buf, 3, afB, bfB0, bfB1); G_MIX(NMF);
            __builtin_amdgcn_sched_barrier(0);
            G_MFMA(afB, bfB0, bfB1);
        } else {
            __builtin_amdgcn_sched_barrier(0);
            G_READ(buf, 0, afA, bfA0, bfA1); G_MFMA(afA, bfA0, bfA1);
            G_READ(buf, 1, afA, bfA0, bfA1); G_MFMA(afA, bfA0, bfA1);
            G_READ(buf, 2, afA, bfA0, bfA1); G_MFMA(afA, bfA0, bfA1);
            __builtin_amdgcn_sched_barrier(0);
            G_READ(buf, 3, afA, bfA0, bfA1); G_MFMA(afA, bfA0, bfA1);
            G_WRITEB(buf ^ 1);
        }
        __builtin_amdgcn_sched_barrier(0);
    }
#undef G_DMA
#undef G_LOADB
#undef G_WRITEB
#undef G_READ
#undef G_MFMA
#undef G_MIX
#pragma unroll
    for (int m = 0; m < 4; ++m)
#pragma unroll
        for (int n = 0; n < NBLK; ++n) epi(wr * 128 + m * 32 + r32, wc * WN + n * 32 + 16 * hh, acc0[m][n], acc1[m][n]);
    __syncthreads();
}

struct PlainA {
    const bf16_t* base; int lda;
    DI const bf16_t* rowptr(int, int row) const { return base + (size_t)row * lda; }
};
struct GatherA {
    const bf16_t* rp[4];
    DI const bf16_t* rowptr(int i, int) const { return rp[i]; }
};

struct XcdOrder {
    int base, lim, j, bpx;
    DI XcdOrder(int bid, int nblk, int total) {
        if ((nblk & 7) == 0) { const int x = bid & 7, per = (total + 7) >> 3; bpx = nblk >> 3; j = bid >> 3; base = x * per; lim = base + per < total ? base + per : total; }
        else { bpx = nblk; j = bid; base = 0; lim = total; }
    }
    DI int item(int i) const { const int q = base + i * bpx + j; return q < lim ? q : -1; }
};
DI void tile_rc(int q, int nrow, int ncol, int& r, int& c) {
    const int per_sr = 8 * ncol, sr = q / per_sr, rem = q - sr * per_sr, rows = (nrow - sr * 8) < 8 ? (nrow - sr * 8) : 8;
    c = rem / rows; r = sr * 8 + rem - c * rows;
}

DI u32x4 pack8v(const f32x4& a, const f32x4& b) { return (u32x4){pack2(a[0], a[1]), pack2(a[2], a[3]), pack2(b[0], b[1]), pack2(b[2], b[3])}; }
DI u32x4 pack8q(const f32x16& a, int q) { return (u32x4){pack2(a[8 * q], a[8 * q + 1]), pack2(a[8 * q + 2], a[8 * q + 3]), pack2(a[8 * q + 4], a[8 * q + 5]), pack2(a[8 * q + 6], a[8 * q + 7])}; }
struct EpiStoreBf16 { bf16_t* o; int ldo; DI void operator()(int r, int c, const f32x16& a, const f32x16&) const { *(u32x4*)(o + (size_t)r * ldo + c) = pack8q(a, 0); *(u32x4*)(o + (size_t)r * ldo + c + 8) = pack8q(a, 1); } };
DI void phase_g1(const Params& p, int bid, int nblk, char* lds) {
    const bf16_t* xn = (const bf16_t*)(p.ws + OFF_XN); bf16_t* u = (bf16_t*)(p.ws + OFF_U);
    const bf16_t* wb = (const bf16_t*)(p.ws + OFF_WINB);
    const XcdOrder ord(bid, nblk, 65 * 9);
    for (int i = 0, q; (q = ord.item(i)) >= 0; ++i) {
        int tm, tn; tile_rc(q, 65, 9, tm, tn);
        PlainA al{xn + (size_t)tm * 256 * D, D};
        EpiStoreBf16 epi{u + (size_t)tm * 256 * DIN + tn * 256, DIN};
        gemm8<1, true, 2>(al, wb + tn * 256, nullptr, DIN, D, lds, epi);
    }
    for (int tm = nblk - 1 - bid; tm < 65; tm += nblk) {
        PlainA al{xn + (size_t)tm * 256 * D, D};
        EpiStoreBf16 epi{u + (size_t)tm * 256 * DIN + 9 * 256, DIN};
        gemm8<1, true, 1>(al, wb + 9 * 256, nullptr, DIN, D, lds, epi);
    }
}

DI void phase_pool(const Params& p, int bid, int nblk) {
    const bf16_t* u = (const bf16_t*)(p.ws + OFF_U) + (size_t)CTX * DIN + C_POOL;
    bf16_t* mix = (bf16_t*)(p.ws + OFF_MIX);
    for (int item = bid * NTH + threadIdx.x; item < (S / 16) * 64; item += nblk * NTH) {
        const int cg = item & 63, run = item >> 6, t0 = run * 16, gi = cg >> 4, win = 2 << gi, hw = win >> 1;
        const bf16_t* uc = u + cg * 8;
        float sum[8];
#pragma unroll
        for (int j = 0; j < 8; ++j) sum[j] = 0.f;
        int lo = t0 - hw, hi = t0 - hw + win; lo = lo < 0 ? 0 : lo; hi = hi > S ? S : hi;
        for (int tt = lo; tt < hi; ++tt) { float q[8]; unpack8(*(const u32x4*)(uc + (size_t)tt * DIN), q);
#pragma unroll
            for (int j = 0; j < 8; ++j) sum[j] += q[j]; }
        for (int k = 0; k < 16; ++k) {
            const int t = t0 + k;
            float cv[8], o[8]; unpack8(*(const u32x4*)(uc + (size_t)t * DIN), cv);
            const float inv = 1.f / (float)(hi - lo);
#pragma unroll
            for (int j = 0; j < 8; ++j) o[j] = sum[j] * inv - cv[j];
            *(u32x4*)(mix + (size_t)t * D + cg * 8) = pack8(o);
            const int nlo = t + 1 - hw, nhi = t + 1 - hw + win;
            if (nhi <= S) { float q[8]; unpack8(*(const u32x4*)(uc + (size_t)(nhi - 1) * DIN), q);
#pragma unroll
                for (int j = 0; j < 8; ++j) sum[j] += q[j]; hi = nhi; }
            if (nlo > 0) { float q[8]; unpack8(*(const u32x4*)(uc + (size_t)(nlo - 1) * DIN), q);
#pragma unroll
                for (int j = 0; j < 8; ++j) sum[j] -= q[j]; lo = nlo; }
        }
    }
}
struct EpiPool { bf16_t* o; const float* sc; DI void operator()(int r, int c, const f32x16& a, const f32x16&) const {
    f32x16 v = a;
#pragma unroll
    for (int q = 0; q < 4; ++q) { const f32x4 s4 = *(const f32x4*)(sc + c + 4 * q); v[4 * q] *= s4[0]; v[4 * q + 1] *= s4[1]; v[4 * q + 2] *= s4[2]; v[4 * q + 3] *= s4[3]; }
    *(u32x4*)(o + (size_t)r * D + c) = pack8q(v, 0); *(u32x4*)(o + (size_t)r * D + c + 8) = pack8q(v, 1); } };
DI void phase_poolgemm(const Params& p, int bid, int nblk, char* lds) {
    if (nblk <= 0) return;
    for (int it = bid; it < 4 * 64; it += nblk) {
        const int gi = it >> 6, tm = it & 63;
        const bf16_t* mix = (const bf16_t*)(p.ws + OFF_MIX);
        PlainA al{mix + (size_t)tm * 256 * D + gi * 128, D};
        EpiPool e{(bf16_t*)(p.ws + OFF_MIX) + (size_t)tm * 256 * D + 512 + gi * 128, p.pool_scale + gi * 128};
        int kk = 128; asm volatile("" : "+s"(kk));
        gemm8<1, false, 1>(al, p.w_pool + (size_t)gi * 128 * 128, nullptr, 128, kk, lds, e);
    }
}

constexpr int MP = 72, MSZ = 64 * MP;
constexpr int FP = 68;
constexpr int SCANA_LDS = 14 * MSZ * 2 + 2048;
template <bool KS> DI bf16x8 frag32(const bf16_t* base, int x0, int s, int lane) {
    if (!KS) return *(const bf16x8*)(base + (x0 + (lane & 31)) * MP + 16 * s + 8 * (lane >> 5));
    const int gi = lane >> 4, i = lane & 15;
    const bf16_t* a = base + (16 * s + 8 * (gi >> 1) + (i >> 2)) * MP + x0 + 16 * (gi & 1) + 4 * (i & 3);
    s16x4 lo = tr16(a), hi = tr16(a + 4 * MP);
    return __builtin_shufflevector(lo, hi, 0, 1, 2, 3, 4, 5, 6, 7);
}
template <bool XKS, bool YKS> DI f32x16 mm32(const bf16_t* X, int x0, const bf16_t* Y, int y0, f32x16 acc, int lane) {
#pragma unroll
    for (int s = 0; s < 4; ++s) acc = __builtin_amdgcn_mfma_f32_32x32x16_bf16(frag32<XKS>(X, x0, s, lane), frag32<YKS>(Y, y0, s, lane), acc, 0, 0, 0);
    return acc;
}
template <class F> DI void store_acc(bf16_t* out, int x0, int y0, const f32x16& acc, int lane, F f) {
    const int y = y0 + (lane & 31), hh = lane >> 5;
#pragma unroll
    for (int q = 0; q < 4; ++q) {
        const int x = x0 + 8 * q + 4 * hh;
        u32x2 pk = {pack2(f(acc[4 * q], x, y), f(acc[4 * q + 1], x + 1, y)), pack2(f(acc[4 * q + 2], x + 2, y), f(acc[4 * q + 3], x + 3, y))};
        *(u32x2*)(out + y * MP + x) = pk;
    }
}
DI unsigned rot16(unsigned x) { return (x >> 16) | (x << 16); }

DI int chain_pos(int c, int dir) { return dir == 0 ? c : (c < 4 ? 3 - c : NCH + 3 - c); }

DI void phase_scanA(const Params& p, int bid, int nblk, char* lds) {
    const int tid = threadIdx.x, lane0 = tid & 63, w = tid >> 6, grp = w >> 2;
    bf16_t* M = (bf16_t*)lds;
    bf16_t *sAT = M, *sBT = M + MSZ, *sKT = M + 2 * MSZ, *sRT = M + 3 * MSZ, *sVT = M + 4 * MSZ;
    float* fGC = (float*)(lds + 14 * MSZ * 2);
    float* fSeg = fGC + 64;
    float* fLogw = (float*)(M + 12 * MSZ);
    float* fA = (float*)(M + 10 * MSZ);
    const bf16_t* u = (const bf16_t*)(p.ws + OFF_U);
    for (int inst = bid; inst < NCH * 16; inst += nblk) {
        int lane = lane0; asm volatile("" : "+v"(lane));
        const int xq = 32 * (w & 1), yq = 32 * ((w >> 1) & 1);
        const int c = inst >> 4, h = (inst >> 1) & 7, dir = inst & 1;
        const bool latent = c >= 4, want_g = latent && dir == 0;
        const float* w2 = dir ? p.w2_b : p.w2_f; const float* a2 = dir ? p.a2_b : p.a2_f;
        const float* w0 = dir ? p.w0_b : p.w0_f; const float* a0 = dir ? p.a0_b : p.a0_f;
        const float* rkd = dir ? p.r_k_b : p.r_k_f;
        const int cwl = dir ? C_WLB : C_WLF, cal = dir ? C_ALB : C_ALF;
        const int ch = tid & 7, tau = tid >> 3, g = dir ? c * 64 + 63 - tau : c * 64 + tau;
        float fr_[8], fk_[8], fv_[8];
        {
            const int cols5[5] = {h * 64 + ch * 8, 512 + h * 64 + ch * 8, 1024 + h * 64 + ch * 8, cwl + ch * 8, cal + ch * 8};
            const bool hasp = (g != 0) && (g != CTX), hasn = (g != CTX - 1) && (g != NT - 1);
            const float mp = hasp ? 0.5f : 0.f, mn = hasn ? 0.5f : 0.f;
            const bf16_t* rc = u + (size_t)g * DIN; const bf16_t* rp = hasp ? rc - DIN : rc; const bf16_t* rn = hasn ? rc + DIN : rc;
            u32x4 raw[5][3]; f32x4 wl[4];
#pragma unroll
            for (int q = 0; q < 5; ++q) { raw[q][0] = *(const u32x4*)(rc + cols5[q]); raw[q][1] = *(const u32x4*)(rp + cols5[q]); raw[q][2] = *(const u32x4*)(rn + cols5[q]); }
#pragma unroll
            for (int q = 0; q < 2; ++q) { const int idx = tid + NTH * q, kr = idx >> 4, n4 = idx & 15;
                wl[q] = *(const f32x4*)(w2 + (size_t)kr * DR + h * 64 + n4 * 4); wl[2 + q] = *(const f32x4*)(a2 + (size_t)kr * DR + h * 64 + n4 * 4); }
            auto shift8 = [&](const u32x4* r3, int col, float* o) {
                float cc[8], pv[8], nx[8];
                unpack8(r3[0], cc); unpack8(r3[1], pv); unpack8(r3[2], nx);
                const f32x4 m0 = *(const f32x4*)(p.mu + col), m1 = *(const f32x4*)(p.mu + col + 4);
#pragma unroll
                for (int j = 0; j < 8; ++j) { const float m = j < 4 ? m0[j & 3] : m1[j & 3]; o[j] = cc[j] + m * ((mp * pv[j] + mn * nx[j]) - cc[j]); }
            };
            shift8(raw[0], cols5[0], fr_); shift8(raw[1], cols5[1], fk_); shift8(raw[2], cols5[2], fv_);
            float t8[8];
            shift8(raw[3], cols5[3], t8);
#pragma unroll
            for (int j = 0; j < 8; ++j) { const float e2 = __expf(2.f * t8[j]); t8[j] = 1.f - __fdividef(2.f, e2 + 1.f); }
            *(u32x4*)(M + 5 * MSZ + tau * MP + ch * 8) = pack8(t8);
            shift8(raw[4], cols5[4], t8);
            *(u32x4*)(M + 6 * MSZ + tau * MP + ch * 8) = pack8(t8);
            if (want_g) {
                u32x4 rawg[2][3]; f32x4 wg2[4];
#pragma unroll
                for (int half = 0; half < 2; ++half) { const int col = C_GL + half * 64 + ch * 8;
                    rawg[half][0] = *(const u32x4*)(rc + col); rawg[half][1] = *(const u32x4*)(rp + col); rawg[half][2] = *(const u32x4*)(rn + col); }
#pragma unroll
                for (int q = 0; q < 4; ++q) { const int idx = tid + NTH * q, kr = idx >> 4, n4 = idx & 15; wg2[q] = *(const f32x4*)(p.g2 + (size_t)kr * DR + h * 64 + n4 * 4); }
#pragma unroll
                for (int half = 0; half < 2; ++half) {
                    shift8(rawg[half], C_GL + half * 64 + ch * 8, t8);
#pragma unroll
                    for (int j = 0; j < 8; ++j) t8[j] = sigmoidf_(t8[j]);
                    *(u32x4*)(M + half * MSZ + tau * MP + ch * 8) = pack8(t8);
                }
#pragma unroll
                for (int q = 0; q < 4; ++q) { const int idx = tid + NTH * q, kr = idx >> 4, n4 = idx & 15;
                    u32x2 pa = {pack2(wg2[q][0], wg2[q][1]), pack2(wg2[q][2], wg2[q][3])};
                    *(u32x2*)(M + (2 + (kr >> 6)) * MSZ + (kr & 63) * MP + n4 * 4) = pa; }
            }
#pragma unroll
            for (int q = 0; q < 2; ++q) { const int idx = tid + NTH * q, kr = idx >> 4, n4 = idx & 15;
                u32x2 pa = {pack2(wl[q][0], wl[q][1]), pack2(wl[q][2], wl[q][3])}, pb = {pack2(wl[2 + q][0], wl[2 + q][1]), pack2(wl[2 + q][2], wl[2 + q][3])};
                *(u32x2*)(M + 7 * MSZ + kr * MP + n4 * 4) = pa; *(u32x2*)(M + 8 * MSZ + kr * MP + n4 * 4) = pb; }
        }
        __syncthreads();
        if (grp == 0) {
            f32x16 accW = mm32<true, false>(M + 7 * MSZ, xq, M + 5 * MSZ, yq, zero16(), lane);
            const int y = yq + (lane & 31), hh = lane >> 5;
#pragma unroll
            for (int q = 0; q < 4; ++q) {
                const int x = xq + 8 * q + 4 * hh;
                f32x4 lw; const f32x4 w0v = *(const f32x4*)(w0 + h * 64 + x);
#pragma unroll
                for (int e = 0; e < 4; ++e) {
                    float v = -DECAY_SCALE * sigmoidf_(w0v[e] + accW[4 * q + e]);
                    v += __builtin_bit_cast(float, __builtin_amdgcn_update_dpp(0, __builtin_bit_cast(int, v), 0x111, 0xf, 0xf, false));
                    v += __builtin_bit_cast(float, __builtin_amdgcn_update_dpp(0, __builtin_bit_cast(int, v), 0x112, 0xf, 0xf, false));
                    v += __builtin_bit_cast(float, __builtin_amdgcn_update_dpp(0, __builtin_bit_cast(int, v), 0x114, 0xf, 0xf, false));
                    v += __builtin_bit_cast(float, __builtin_amdgcn_update_dpp(0, __builtin_bit_cast(int, v), 0x118, 0xf, 0xf, false));
                    v += __builtin_bit_cast(float, __builtin_amdgcn_update_dpp(0, __builtin_bit_cast(int, v), 0x142, 0xa, 0xf, false));
                    lw[e] = v;
                }
                *(f32x4*)(fLogw + y * FP + x) = lw;
                if (yq == 0 && (lane & 31) == 31) *(f32x4*)(fSeg + x) = lw;
            }
        } else {
            f32x16 accA = mm32<true, false>(M + 8 * MSZ, xq, M + 6 * MSZ, yq, zero16(), lane);
            const int y = yq + (lane & 31), hh = lane >> 5;
#pragma unroll
            for (int q = 0; q < 4; ++q) {
                const int x = xq + 8 * q + 4 * hh;
                f32x4 av; const f32x4 a0v = *(const f32x4*)(a0 + h * 64 + x);
#pragma unroll
                for (int e = 0; e < 4; ++e) av[e] = sigmoidf_(a0v[e] + accA[4 * q + e]);
                *(f32x4*)(fA + y * FP + x) = av;
            }
            if (want_g) {
                f32x16 accG = mm32<true, false>(M + 2 * MSZ, xq, M, yq, zero16(), lane);
                accG = mm32<true, false>(M + 3 * MSZ, xq, M + MSZ, yq, accG, lane);
                const int t = c * 64 + y - CTX;
#pragma unroll
                for (int q = 0; q < 4; ++q) {
                    const int x = xq + 8 * q + 4 * hh;
                    u32x2 pk = {pack2(accG[4 * q], accG[4 * q + 1]), pack2(accG[4 * q + 2], accG[4 * q + 3])};
                    *(u32x2*)((bf16_t*)(p.ws + OFF_G) + (size_t)t * DR + h * 64 + x) = pk;
                }
            }
        }
        __syncthreads();
        {
            float oa[8], ob[8], ok[8], orr[8], kkv[8], kd[8];
            float ss = 0.f, dsum = 0.f;
            const int c8 = h * 64 + ch * 8;
            float kkp[8], kap[8], rkp[8];
            { const f32x4 a0_ = *(const f32x4*)(p.k_k + c8), a1_ = *(const f32x4*)(p.k_k + c8 + 4), b0_ = *(const f32x4*)(p.k_a + c8), b1_ = *(const f32x4*)(p.k_a + c8 + 4), c0_ = *(const f32x4*)(rkd + c8), c1_ = *(const f32x4*)(rkd + c8 + 4);
#pragma unroll
              for (int j = 0; j < 4; ++j) { kkp[j] = a0_[j]; kkp[4 + j] = a1_[j]; kap[j] = b0_[j]; kap[4 + j] = b1_[j]; rkp[j] = c0_[j]; rkp[4 + j] = c1_[j]; } }
#pragma unroll
            for (int j = 0; j < 8; ++j) { kkv[j] = fk_[j] * kkp[j]; ss += kkv[j] * kkv[j]; }
            ss += __shfl_xor(ss, 1, 64); ss += __shfl_xor(ss, 2, 64); ss += __shfl_xor(ss, 4, 64);
            const float inv = 1.f / fmaxf(sqrtf(ss), 1e-12f);
#pragma unroll
            for (int j = 0; j < 8; ++j) {
                const int jj = ch * 8 + j;
                const float seg = fSeg[jj];
                const float cum = fLogw[tau * FP + jj] + (tau >= 32 ? seg : 0.f), cprev = tau ? fLogw[(tau - 1) * FP + jj] + (tau > 32 ? seg : 0.f) : 0.f, av = fA[tau * FP + jj];
                const float gam = __expf(cum), gprev = __expf(cprev), ginv = __expf(-cum);
                const float kkn = kkv[j] * inv;
                kd[j] = fk_[j] * (1.f + (av - 1.f) * kap[j]);
                oa[j] = -kkn * gprev; ob[j] = kkn * av * ginv; ok[j] = kd[j] * ginv; orr[j] = fr_[j] * gam;
                dsum += fr_[j] * kd[j] * rkp[j];
                if (tau == 63) fGC[jj] = gam;
            }
            dsum += __shfl_xor(dsum, 1, 64); dsum += __shfl_xor(dsum, 2, 64); dsum += __shfl_xor(dsum, 4, 64);
            if (ch == 0) ((float*)(p.ws + OFF_DOT))[((size_t)g * 8 + h) * 2 + dir] = dsum;
            *(u32x4*)(sAT + tau * MP + ch * 8) = pack8(oa); *(u32x4*)(sBT + tau * MP + ch * 8) = pack8(ob);
            *(u32x4*)(sKT + tau * MP + ch * 8) = pack8(ok); *(u32x4*)(sRT + tau * MP + ch * 8) = pack8(orr);
            const u32x4 pv8 = pack8(fv_);
            *(u32x4*)(sVT + tau * MP + ch * 8) = pv8;
            if (want_g) *(u32x4*)((bf16_t*)(p.ws + OFF_V) + (size_t)(g - CTX) * DR + h * 64 + ch * 8) = pv8;
        }
        __syncthreads();
        if (grp == 0) {
            f32x16 acc = mm32<false, false>(sAT, xq, sBT, yq, zero16(), lane);
            store_acc(M + 5 * MSZ, xq, yq, acc, lane, [](float v, int x, int y) { return y < x ? v : 0.f; });
            store_acc(M + 7 * MSZ, xq, yq, acc, lane, [](float v, int x, int y) { return y < x ? v : (y == x ? 1.f : 0.f); });
            acc = mm32<false, false>(sAT, xq, sKT, yq, zero16(), lane);
            store_acc(M + 9 * MSZ, xq, yq, acc, lane, [](float v, int x, int y) { return y < x ? v : 0.f; });
        } else {
            f32x16 acc = mm32<false, false>(sRT, xq, sBT, yq, zero16(), lane);
            store_acc(M + 10 * MSZ, xq, yq, acc, lane, [](float v, int x, int y) { return y <= x ? v : 0.f; });
            acc = mm32<false, false>(sRT, xq, sKT, yq, zero16(), lane);
            store_acc(M + 11 * MSZ, xq, yq, acc, lane, [](float v, int x, int y) { return y <= x ? v : 0.f; });
        }
        __syncthreads();
        int xs = 5, xo = 6, ts = 7, to = 8;
        if (grp == 1) {
            f32x16 acc = mm32<true, false>(M + xs * MSZ, xq, M + xs * MSZ, yq, zero16(), lane);
            store_acc(M + xo * MSZ, xq, yq, acc, lane, [](float v, int, int) { return v; });
        }
        { int t_ = xs; xs = xo; xo = t_; }
        __syncthreads();
        for (int k = 0; k < 5; ++k) {
            if (grp == 0) {
                const bf16_t* Told = M + ts * MSZ;
                f32x16 acc = mm32<true, false>(M + xs * MSZ, xq, Told, yq, zero16(), lane);
                store_acc(M + to * MSZ, xq, yq, acc, lane, [Told](float v, int x, int y) { return v + bf2f(Told[y * MP + x]); });
            } else if (k < 4) {
                f32x16 acc = mm32<true, false>(M + xs * MSZ, xq, M + xs * MSZ, yq, zero16(), lane);
                store_acc(M + xo * MSZ, xq, yq, acc, lane, [](float v, int, int) { return v; });
            }
            int t_ = xs; xs = xo; xo = t_; t_ = ts; ts = to; to = t_;
            __syncthreads();
        }
        const bf16_t* sT = M + ts * MSZ;
        if (grp == 0) {
            f32x16 acc = mm32<true, true>(sT, xq, sAT, yq, zero16(), lane);
            store_acc(M + 12 * MSZ, xq, yq, acc, lane, [](float v, int, int) { return v; });
        } else {
            f32x16 acc = mm32<true, false>(sT, xq, M + 9 * MSZ, yq, zero16(), lane);
            store_acc(M + 13 * MSZ, xq, yq, acc, lane, [](float v, int, int) { return v; });
        }
        __syncthreads();
        {
            const bf16_t *sAbar = M + 12 * MSZ, *sG = M + 13 * MSZ, *sABR = M + 10 * MSZ, *sAKR = M + 11 * MSZ;
            if (grp == 0) {
                f32x16 acc = mm32<false, true>(sAbar, xq, sBT, yq, zero16(), lane);
                store_acc(M + 5 * MSZ, xq, yq, acc, lane, [fGC](float v, int x, int y) { return ((x == y ? 1.f : 0.f) + v) * fGC[y]; });
                acc = mm32<false, true>(sAbar, xq, sABR, yq, zero16(), lane);
                store_acc(M + 6 * MSZ, xq, yq, acc, lane, [sRT](float v, int x, int y) { return v + bf2f(sRT[y * MP + x]); });
            } else {
                f32x16 acc = mm32<true, false>(sBT, xq, sG, yq, zero16(), lane);
                store_acc(M + 7 * MSZ, xq, yq, acc, lane, [sKT, fGC](float v, int x, int y) { return (v + bf2f(sKT[y * MP + x])) * fGC[x]; });
                acc = mm32<true, false>(sABR, xq, sG, yq, zero16(), lane);
                store_acc(M + 9 * MSZ, xq, yq, acc, lane, [sAKR](float v, int x, int y) { return v + bf2f(sAKR[y * MP + x]); });
            }
        }
        __syncthreads();
        const int chain = dir * 8 + h, npos = chain_pos(c, dir);
        {
            u32x4* Pg = (u32x4*)(p.ws + OFF_P) + ((size_t)chain * NCH + npos) * 512;
            { const int item = tid, ln = item & 63, as = item >> 6, a = as >> 1, s2 = as & 1, fr = ln & 15, fq = ln >> 4;
              const bf16_t* src = M + 5 * MSZ + (16 * a + fr) * MP + 32 * s2 + 4 * fq;
              const u32x2 lo = *(const u32x2*)src, hi = *(const u32x2*)(src + 16);
              Pg[as * 64 + ln] = (u32x4){lo.x, lo.y, hi.x, hi.y}; }
            if (latent) {
                u32x4* Wg = (u32x4*)(p.ws + OFF_WYT) + ((size_t)((c - 4) * 8 + h) * 2 + dir) * 512;
                const int row = tid >> 3, ck = tid & 7; Wg[tid] = *(const u32x4*)(M + 6 * MSZ + row * MP + ck * 8);
            }
        }
        if (grp == 0) {
            f32x16 acc = mm32<true, true>(M + 7 * MSZ, xq, sVT, yq, zero16(), lane);
            store_acc(M + 12 * MSZ, xq, yq, acc, lane, [](float v, int, int) { return v; });
        } else {
            f32x16 acc = mm32<true, true>(M + 9 * MSZ, xq, sVT, yq, zero16(), lane);
            store_acc(M + 13 * MSZ, xq, yq, acc, lane, [](float v, int, int) { return v; });
        }
        __syncthreads();
        {
            u32x2* Qg = (u32x2*)(p.ws + OFF_Q) + ((size_t)chain * NCH + npos) * 1024;
#pragma unroll
            for (int i = 0; i < 2; ++i) {
                const int item = tid + NTH * i, ln = item & 63, wa = item >> 6, wi = wa >> 2, a = wa & 3, fr = ln & 15, fq = ln >> 4;
                Qg[item] = *(const u32x2*)(M + 12 * MSZ + (16 * wi + fr) * MP + 16 * a + 4 * fq);
            }
            if (latent) {
                u32x2* Yg = (u32x2*)(p.ws + OFF_YL) + ((size_t)((c - 4) * 8 + h) * 2 + dir) * 1024;
#pragma unroll
                for (int i = 0; i < 2; ++i) {
                    const int item = tid + NTH * i, ln = item & 63, wn = item >> 6, wt = wn >> 2, ni = wn & 3, fr = ln & 15, fq = ln >> 4;
                    const bf16_t* row = M + 13 * MSZ + (16 * ni + fr) * MP;
                    u32x2 v;
                    if (dir == 0) v = *(const u32x2*)(row + 16 * wt + 4 * fq);
                    else { const u32x2 r2 = *(const u32x2*)(row + 60 - 16 * wt - 4 * fq); v = (u32x2){rot16(r2.y), rot16(r2.x)}; }
                    Yg[item] = v;
                }
            }
        }
        __syncthreads();
    }
}

DI int grp_start(int g) { return g * 16 + (g < 4 ? g : 4); }
DI u32x4 packz(const f32x4& a, const f32x4& b) { return (u32x4){pack2(a[0], a[1]), pack2(a[2], a[3]), pack2(b[0], b[1]), pack2(b[2], b[3])}; }
template <int PASS> DI void chain_run(const Params& p, int chain, int g) {
    constexpr int CPF = PASS == 1 ? 2 : 3;
    const int lane = threadIdx.x & 63, w = threadIdx.x >> 6, fr = lane & 15, fq = lane >> 4;
    const int n0 = grp_start(g), n1 = grp_start(g + 1);
    const u32x4* Pg = (const u32x4*)(p.ws + OFF_P) + (size_t)chain * NCH * 512;
    const u32x2* Qg = (const u32x2*)(p.ws + OFF_Q) + (size_t)chain * NCH * 1024;
    u32x4* Zg = (u32x4*)(p.ws + OFF_Z) + (size_t)chain * NCH * 512;
    f32x4* ZG = (f32x4*)(p.ws + OFF_ZG) + ((size_t)(chain * 16 + g) * 4 + w) * 256;
    f32x4 acc[4], accp[4];
#pragma unroll
    for (int a = 0; a < 4; ++a) {
        if (PASS == 3) acc[a] = ZG[a * 64 + lane]; else acc[a] = (f32x4){0, 0, 0, 0};
#pragma unroll
        for (int e = 0; e < 4; ++e) accp[a][e] = (16 * a + 4 * fq + e == 16 * w + fr) ? 1.f : 0.f;
    }
    u32x4 pf[CPF][8]; u32x2 qf[CPF][4];
#pragma unroll
    for (int st = 0; st < CPF; ++st) if (n0 + st < n1) {
#pragma unroll
        for (int i = 0; i < 8; ++i) pf[st][i] = Pg[(size_t)(n0 + st) * 512 + i * 64 + lane];
#pragma unroll
        for (int a = 0; a < 4; ++a) qf[st][a] = Qg[(size_t)(n0 + st) * 1024 + (w * 4 + a) * 64 + lane];
    }
    for (int nb = n0; nb < n1; nb += CPF) {
#pragma unroll
        for (int st = 0; st < CPF; ++st) {
            const int n = nb + st;
            if (n < n1) {
                u32x4 pc[8]; u32x2 qc[4];
#pragma unroll
                for (int i = 0; i < 8; ++i) pc[i] = pf[st][i];
#pragma unroll
                for (int a = 0; a < 4; ++a) qc[a] = qf[st][a];
                if (n + CPF < n1) {
#pragma unroll
                    for (int i = 0; i < 8; ++i) pf[st][i] = Pg[(size_t)(n + CPF) * 512 + i * 64 + lane];
#pragma unroll
                    for (int a = 0; a < 4; ++a) qf[st][a] = Qg[(size_t)(n + CPF) * 1024 + (w * 4 + a) * 64 + lane];
                }
                const u32x4 z0 = packz(acc[0], acc[1]), z1 = packz(acc[2], acc[3]);
                if (PASS == 3) { Zg[((size_t)n * 4 + w) * 128 + lane] = z0; Zg[((size_t)n * 4 + w) * 128 + 64 + lane] = z1; }
                const bf16x8 zb0 = __builtin_bit_cast(bf16x8, z0), zb1 = __builtin_bit_cast(bf16x8, z1);
#pragma unroll
                for (int a = 0; a < 4; ++a) {
                    f32x4 ini = {bflo(qc[a].x), bfhi(qc[a].x), bflo(qc[a].y), bfhi(qc[a].y)};
                    ini = __builtin_amdgcn_mfma_f32_16x16x32_bf16(__builtin_bit_cast(bf16x8, pc[2 * a]), zb0, ini, 0, 0, 0);
                    acc[a] = __builtin_amdgcn_mfma_f32_16x16x32_bf16(__builtin_bit_cast(bf16x8, pc[2 * a + 1]), zb1, ini, 0, 0, 0);
                }
                if (PASS == 1) {
                    const bf16x8 yb0 = __builtin_bit_cast(bf16x8, packz(accp[0], accp[1])), yb1 = __builtin_bit_cast(bf16x8, packz(accp[2], accp[3]));
#pragma unroll
                    for (int a = 0; a < 4; ++a) {
                        f32x4 t4 = __builtin_amdgcn_mfma_f32_16x16x32_bf16(__builtin_bit_cast(bf16x8, pc[2 * a]), yb0, (f32x4){0, 0, 0, 0}, 0, 0, 0);
                        accp[a] = __builtin_amdgcn_mfma_f32_16x16x32_bf16(__builtin_bit_cast(bf16x8, pc[2 * a + 1]), yb1, t4, 0, 0, 0);
                    }
                }
            }
        }
    }
    if (PASS == 1) {
        f32x4* CQ = (f32x4*)(p.ws + OFF_CQ) + ((size_t)(chain * 16 + g) * 4 + w) * 256;
        bf16_t* CP = (bf16_t*)(p.ws + OFF_CP) + (size_t)(chain * 16 + g) * 4096;
#pragma unroll
        for (int a = 0; a < 4; ++a) {
            CQ[a * 64 + lane] = acc[a];
#pragma unroll
            for (int e = 0; e < 4; ++e) CP[(16 * a + 4 * fq + e) * 64 + 16 * w + fr] = (bf16_t)(pack2(accp[a][e], 0.f) & 0xffffu);
        }
    }
}
DI void chain_groups(const Params& p, int chain) {
    constexpr int CPF = 3;
    const int lane = threadIdx.x & 63, w = threadIdx.x >> 6, fr = lane & 15, fq = lane >> 4;
    f32x4 acc[4];
#pragma unroll
    for (int a = 0; a < 4; ++a) acc[a] = (f32x4){0, 0, 0, 0};
    u32x4 pf[CPF][8]; f32x4 qf[CPF][4];
    auto load = [&](int st, int g) {
        const bf16_t* CP = (const bf16_t*)(p.ws + OFF_CP) + (size_t)(chain * 16 + g) * 4096;
        const f32x4* CQ = (const f32x4*)(p.ws + OFF_CQ) + ((size_t)(chain * 16 + g) * 4 + w) * 256;
#pragma unroll
        for (int i = 0; i < 8; ++i) { const int a = i >> 1, s2 = i & 1; const bf16_t* src = CP + (16 * a + fr) * 64 + 32 * s2 + 4 * fq;
            const u32x2 lo = *(const u32x2*)src, hi = *(const u32x2*)(src + 16); pf[st][i] = (u32x4){lo.x, lo.y, hi.x, hi.y}; }
#pragma unroll
        for (int a = 0; a < 4; ++a) qf[st][a] = CQ[a * 64 + lane];
    };
#pragma unroll
    for (int st = 0; st < CPF; ++st) load(st, st);
    for (int gb = 0; gb < 16; gb += CPF) {
#pragma unroll
        for (int st = 0; st < CPF; ++st) {
            const int g = gb + st;
            if (g >= 16) break;
            u32x4 pc[8]; f32x4 qc[4];
#pragma unroll
            for (int i = 0; i < 8; ++i) pc[i] = pf[st][i];
#pragma unroll
            for (int a = 0; a < 4; ++a) qc[a] = qf[st][a];
            if (g + CPF < 16) load(st, g + CPF);
            f32x4* ZG = (f32x4*)(p.ws + OFF_ZG) + ((size_t)(chain * 16 + g) * 4 + w) * 256;
#pragma unroll
            for (int a = 0; a < 4; ++a) ZG[a * 64 + lane] = acc[a];
            const bf16x8 zb0 = __builtin_bit_cast(bf16x8, packz(acc[0], acc[1])), zb1 = __builtin_bit_cast(bf16x8, packz(acc[2], acc[3]));
#pragma unroll
            for (int a = 0; a < 4; ++a) {
                f32x4 ini = __builtin_amdgcn_mfma_f32_16x16x32_bf16(__builtin_bit_cast(bf16x8, pc[2 * a]), zb0, qc[a], 0, 0, 0);
                acc[a] = __builtin_amdgcn_mfma_f32_16x16x32_bf16(__builtin_bit_cast(bf16x8, pc[2 * a + 1]), zb1, ini, 0, 0, 0);
            }
        }
    }
}

DI void phase_scanC(const Params& p, int bid, int nblk, char* lds) {
    const int lane = threadIdx.x & 63, w8 = threadIdx.x >> 6, w = w8 & 3, fr = lane & 15, fq = lane >> 4;
    bf16_t* mix = (bf16_t*)(p.ws + OFF_MIX);
    const float* dot = (const float*)(p.ws + OFF_DOT);
    for (int unit = bid * 2 + (w8 >> 2); unit < 256 * 8; unit += nblk * 2) {
        const int c = 4 + (unit >> 3), h = unit & 7;
        f32x4 y[4];
#pragma unroll
        for (int ni = 0; ni < 4; ++ni) y[ni] = (f32x4){0, 0, 0, 0};
#pragma unroll
        for (int dir = 0; dir < 2; ++dir) {
            const int chain = dir * 8 + h, npos = chain_pos(c, dir);
            const u32x4* Zg = (const u32x4*)(p.ws + OFF_Z) + ((size_t)chain * NCH + npos) * 512;
            const bf16_t* Wg = (const bf16_t*)(p.ws + OFF_WYT) + ((size_t)((c - 4) * 8 + h) * 2 + dir) * 4096;
            const u32x2* Yg = (const u32x2*)(p.ws + OFF_YL) + ((size_t)((c - 4) * 8 + h) * 2 + dir) * 1024;
            const int rho = 16 * w + fr, row = dir ? 63 - rho : rho;
            bf16x8 af[2];
#pragma unroll
            for (int s2 = 0; s2 < 2; ++s2) {
                const u32x2 lo = *(const u32x2*)(Wg + row * 64 + 32 * s2 + 4 * fq), hi = *(const u32x2*)(Wg + row * 64 + 32 * s2 + 16 + 4 * fq);
                af[s2] = __builtin_bit_cast(bf16x8, (u32x4){lo.x, lo.y, hi.x, hi.y});
            }
#pragma unroll
            for (int ni = 0; ni < 4; ++ni) {
                const u32x2 yl = Yg[(w * 4 + ni) * 64 + lane];
                f32x4 acc = {bflo(yl.x), bfhi(yl.x), bflo(yl.y), bfhi(yl.y)};
                acc = __builtin_amdgcn_mfma_f32_16x16x32_bf16(af[0], __builtin_bit_cast(bf16x8, Zg[(ni * 2 + 0) * 64 + lane]), acc, 0, 0, 0);
                acc = __builtin_amdgcn_mfma_f32_16x16x32_bf16(af[1], __builtin_bit_cast(bf16x8, Zg[(ni * 2 + 1) * 64 + lane]), acc, 0, 0, 0);
                y[ni] += acc;
            }
        }
        float* ty = (float*)lds + w8 * (16 * 68);
#pragma unroll
        for (int ni = 0; ni < 4; ++ni)
#pragma unroll
            for (int e = 0; e < 4; ++e) ty[(4 * fq + e) * 68 + 16 * ni + fr] = y[ni][e];
        asm volatile("s_waitcnt lgkmcnt(0)" ::: "memory"); __builtin_amdgcn_wave_barrier();
        {
            const int tl = lane >> 2, seg = lane & 3, t = (c - 4) * 64 + 16 * w + tl, g = t + CTX, cch = h * 64 + 16 * seg;
            float yv[16];
#pragma unroll
            for (int q = 0; q < 4; ++q) { const f32x4 v4 = *(const f32x4*)(ty + tl * 68 + 16 * seg + 4 * q); yv[4 * q] = v4[0]; yv[4 * q + 1] = v4[1]; yv[4 * q + 2] = v4[2]; yv[4 * q + 3] = v4[3]; }
            float sm = 0.f;
#pragma unroll
            for (int j = 0; j < 16; ++j) sm += yv[j];
            sm += __shfl_xor(sm, 1, 64); sm += __shfl_xor(sm, 2, 64);
            const float mean = sm * (1.f / 64.f);
            float q2 = 0.f;
#pragma unroll
            for (int j = 0; j < 16; ++j) { const float d = yv[j] - mean; q2 += d * d; }
            q2 += __shfl_xor(q2, 1, 64); q2 += __shfl_xor(q2, 2, 64);
            const float rs = rsqrtf(q2 * (1.f / 64.f) + 64e-5f);
            const float bon = dot[((size_t)g * 8 + h) * 2] + dot[((size_t)g * 8 + h) * 2 + 1];
            float vv[16], gg[16], o[16];
            unpack8(*(const u32x4*)((const bf16_t*)(p.ws + OFF_V) + (size_t)t * DR + cch), vv); unpack8(*(const u32x4*)((const bf16_t*)(p.ws + OFF_V) + (size_t)t * DR + cch + 8), vv + 8);
            unpack8(*(const u32x4*)((const bf16_t*)(p.ws + OFF_G) + (size_t)t * DR + cch), gg); unpack8(*(const u32x4*)((const bf16_t*)(p.ws + OFF_G) + (size_t)t * DR + cch + 8), gg + 8);
#pragma unroll
            for (int q = 0; q < 4; ++q) {
                const f32x4 gw = *(const f32x4*)(p.gn_w + cch + 4 * q), gb = *(const f32x4*)(p.gn_b + cch + 4 * q);
#pragma unroll
                for (int j = 0; j < 4; ++j) o[4 * q + j] = ((yv[4 * q + j] - mean) * rs * gw[j] + gb[j] + bon * vv[4 * q + j]) * gg[4 * q + j];
            }
            *(u32x4*)(mix + (size_t)t * D + cch) = pack8(o); *(u32x4*)(mix + (size_t)t * D + cch + 8) = pack8(o + 8);
        }
        __builtin_amdgcn_wave_barrier();
    }
}

struct EpiX2 { float* o; const float* x; const float* gt; const float* rowtab; const float* coltab; int row0, col0;
    DI void operator()(int r, int c, const f32x16& a, const f32x16&) const {
        const int t = row0 + r, d = col0 + c;
        const float* pt = d < 512 ? rowtab + (t >> 6) * 512 + d : coltab + (t & 63) * 512 + (d - 512);
#pragma unroll
        for (int q = 0; q < 4; ++q) {
            const f32x4 xv = *(const f32x4*)(x + (size_t)t * D + d + 4 * q), pv = *(const f32x4*)(pt + 4 * q), gv = *(const f32x4*)(gt + d + 4 * q);
            const f32x4 av = {a[4 * q], a[4 * q + 1], a[4 * q + 2], a[4 * q + 3]};
            *(f32x4*)(o + (size_t)t * D + d + 4 * q) = xv + pv + gv * av;
        } } };
DI void phase_g2(const Params& p, int bid, int nblk, char* lds) {
    const bf16_t* mix = (const bf16_t*)(p.ws + OFF_MIX);
    const XcdOrder ord(bid, nblk, 64 * 4);
    for (int i = 0, q; (q = ord.item(i)) >= 0; ++i) {
        int tm, tn; tile_rc(q, 64, 4, tm, tn);
        PlainA al{mix + (size_t)tm * 256 * D, D};
        EpiX2 e{(float*)(p.ws + OFF_X2), p.x, (const float*)(p.ws + OFF_MODX) + 2048, (const float*)(p.ws + OFF_ROWTAB), (const float*)(p.ws + OFF_COLTAB), tm * 256, tn * 256};
        gemm8<1, true, 2>(al, (const bf16_t*)(p.ws + OFF_WOUTB) + tn * 256, nullptr, D, D, lds, e);
    }
}

DI float router_w(const Params& p, int k, int n) { return n < 4 ? p.w_rg[k * 4 + n] : (n < 36 ? p.w_re[k * 32 + (n - 4)] : 0.f); }
DI void phase_router_prep(const Params& p, int bid, int nblk) {
    const float* modx = (const float*)(p.ws + OFF_MODX);
    float* wp = (float*)(p.ws + OFF_WP); float* b2 = (float*)(p.ws + OFF_B2);
    for (int idx = bid * NTH + threadIdx.x; idx < 64 * 4 * 3 * 64; idx += nblk * NTH) {
        const int ln = idx & 63, r = idx >> 6, nt = r % 3, me = r / 3, e = me & 3, m = me >> 2;
        const int k = 16 * m + 4 * (ln >> 4) + e, n = 16 * nt + (ln & 15);
        wp[idx] = p.norm2_g[k] * (1.f + modx[4096 + k]) * router_w(p, k, n);
    }
    const int lane = threadIdx.x & 63, wv = bid * NWV + (threadIdx.x >> 6);
    if (wv < 36) {
        float sacc = 0.f;
        for (int k = lane; k < D; k += 64) sacc += modx[3072 + k] * router_w(p, k, wv);
        sacc = wave_sum(sacc);
        if (lane == 0) b2[wv] = sacc + (wv < 4 ? p.b_rg[wv] : p.b_re[wv - 4]);
    }
}

DI void phase_router(const Params& p, int bid, int nblk, char* lds, bool dry = false) {
    const int lane = threadIdx.x & 63, wid = threadIdx.x >> 6, tr = lane & 15, kq = lane >> 4;
    const float* x2 = (const float*)(p.ws + OFF_X2); const float* modx = (const float*)(p.ws + OFF_MODX);
    const float* wp = (const float*)(p.ws + OFF_WP); const float* b2 = (const float*)(p.ws + OFF_B2);
    bf16_t* h2 = (bf16_t*)(p.ws + OFF_H2); int* cnt = (int*)(p.ws + OFF_CNT); float* gate = (float*)(p.ws + OFF_GATE); int* list = (int*)(p.ws + OFF_LIST);
    float* slog = (float*)lds + wid * (16 * 49);
    for (int task = bid * NWV + wid; task < S / 16; task += nblk * NWV) {
        const int t0 = task * 16;
        const float* xr = x2 + (size_t)(t0 + tr) * D + 4 * kq;
        f32x4 acc[3];
#pragma unroll
        for (int i = 0; i < 3; ++i) acc[i] = (f32x4){0, 0, 0, 0};
        float ss = 0.f;
#pragma unroll 4
        for (int m = 0; m < 64; ++m) {
            const f32x4 xv = *(const f32x4*)(xr + 16 * m);
            ss += xv[0] * xv[0] + xv[1] * xv[1] + xv[2] * xv[2] + xv[3] * xv[3];
#pragma unroll
            for (int e = 0; e < 4; ++e)
#pragma unroll
                for (int nt = 0; nt < 3; ++nt) acc[nt] = __builtin_amdgcn_mfma_f32_16x16x4f32(xv[e], wp[((m * 4 + e) * 3 + nt) * 64 + lane], acc[nt], 0, 0, 0);
        }
        ss += __shfl_xor(ss, 16, 64); ss += __shfl_xor(ss, 32, 64);
        const float rstd = rsqrtf(ss * (1.f / 1024.f) + 1e-6f);
#pragma unroll
        for (int nt = 0; nt < 3; ++nt)
#pragma unroll
            for (int r = 0; r < 4; ++r) slog[(4 * kq + r) * 49 + 16 * nt + tr] = acc[nt][r];
        asm volatile("s_waitcnt lgkmcnt(0)" ::: "memory"); __builtin_amdgcn_wave_barrier();
        if (lane < 16) {
            const int t = t0 + lane;
            const float* lg = slog + lane * 49;
            const float l0 = rstd * lg[0] + b2[0], l1 = rstd * lg[1] + b2[1], l2 = rstd * lg[2] + b2[2], l3 = rstd * lg[3] + b2[3];
            int grp = 0; float mx = l0;
            if (l1 > mx) { mx = l1; grp = 1; }
            if (l2 > mx) { mx = l2; grp = 2; }
            if (l3 > mx) { mx = l3; grp = 3; }
            const float den = __expf(l0 - mx) + __expf(l1 - mx) + __expf(l2 - mx) + __expf(l3 - mx);
            const float pgrp = 1.f / den;
            int i1 = 0, i2 = -1; float v1 = -3.0e38f, v2 = -3.0e38f;
            for (int n = 0; n < 8; ++n) {
                const float sv = rstd * lg[4 + grp * 8 + n] + b2[4 + grp * 8 + n];
                if (sv > v1) { v2 = v1; i2 = i1; v1 = sv; i1 = n; } else if (sv > v2) { v2 = sv; i2 = n; }
            }
            const float e2 = __expf(v2 - v1), g1 = pgrp / (1.f + e2), g2v = pgrp * e2 / (1.f + e2);
            const int ea = grp * 8 + i1, eb = grp * 8 + i2;
            if (!dry) {
                const int pa = atomicAdd(&cnt[ea], 1), pb = atomicAdd(&cnt[eb], 1);
                list[ea * LCAP + pa] = t * 2; list[eb * LCAP + pb] = t * 2 + 1;
            }
            gate[t * 2] = g1; gate[t * 2 + 1] = g2v;
        }
        for (int r = 0; r < 16; ++r) {
            const float rs = __shfl(rstd, r, 64);
            const float* src = x2 + (size_t)(t0 + r) * D;
#pragma unroll
            for (int i = 0; i < 4; ++i) {
                const int d = (i * 64 + lane) * 4;
                const f32x4 v = *(const f32x4*)(src + d), gg = *(const f32x4*)(p.norm2_g + d), sh = *(const f32x4*)(modx + 3072 + d), sc = *(const f32x4*)(modx + 4096 + d);
                f32x4 hv;
#pragma unroll
                for (int j = 0; j < 4; ++j) hv[j] = (v[j] * rs * gg[j]) * (1.f + sc[j]) + sh[j];
                u32x2 pk = {pack2(hv[0], hv[1]), pack2(hv[2], hv[3])};
                *(u32x2*)(h2 + (size_t)(t0 + r) * D + d) = pk;
            }
        }
        __builtin_amdgcn_wave_barrier();
    }
}

DI void moe_tiles(const int* cnt, int* tstart  ) {
    if (threadIdx.x == 0) { int acc = 0; for (int e = 0; e < NE; ++e) { tstart[e] = acc; acc += (cnt[e] + 255) >> 8; } tstart[NE] = acc; }
    __syncthreads();
}
struct EpiHid { bf16_t* o; DI void operator()(int r, int c, const f32x16& g, const f32x16& u) const {
    f32x16 h;
#pragma unroll
    for (int j = 0; j < 16; ++j) h[j] = g[j] * sigmoidf_(g[j]) * u[j];
    *(u32x4*)(o + (size_t)r * DE + c) = pack8q(h, 0); *(u32x4*)(o + (size_t)r * DE + c + 8) = pack8q(h, 1); } };
DI void phase_g3(const Params& p, int bid, int nblk, char* lds) {
    int* tstart = (int*)(lds + GEMM_LDS);
    const int* cnt = (const int*)(p.ws + OFF_CNT); const int* list = (const int*)(p.ws + OFF_LIST);
    const bf16_t* h2 = (const bf16_t*)(p.ws + OFF_H2); bf16_t* hid = (bf16_t*)(p.ws + OFF_HID);
    moe_tiles(cnt, tstart);
    const int ntiles = tstart[NE];
    const XcdOrder ord(bid, nblk, ntiles * 4);
    for (int i = 0, item; (item = ord.item(i)) >= 0; ++i) {
        const int ti = item >> 2, cj = item & 3;
        int e = 0; while (e < NE - 1 && tstart[e + 1] <= ti) ++e;
        const int lt = ti - tstart[e], ne = cnt[e];
        GatherA al;
#pragma unroll
        for (int i = 0; i < 4; ++i) { const int row = (8 * i + (threadIdx.x >> 6)) * 8 + ((threadIdx.x & 63) >> 3), pos = lt * 256 + row; const int tok = pos < ne ? (list[e * LCAP + pos] >> 1) : 0; al.rp[i] = h2 + (size_t)tok * D; }
        EpiHid epi{hid + (size_t)ti * 256 * DE + cj * 128};
        gemm8<2, false, 1>(al, p.w_gate + (size_t)e * D * DE + cj * 128, p.w_up + (size_t)e * D * DE + cj * 128, DE, D, lds, epi);
    }
}
struct EpiDown { bf16_t* ybuf; const int* lst; const float* gate; int nvalid; int col0;
    DI void operator()(int r, int c, const f32x16& a, const f32x16&) const {
        if (r >= nvalid) return; const int slot = lst[r]; const float g = gate[slot];
        const f32x16 v = a * g;
        *(u32x4*)(ybuf + (size_t)slot * D + col0 + c) = pack8q(v, 0); *(u32x4*)(ybuf + (size_t)slot * D + col0 + c + 8) = pack8q(v, 1); } };
DI void phase_g4(const Params& p, int bid, int nblk, char* lds) {
    int* tstart = (int*)(lds + GEMM_LDS);
    const int* cnt = (const int*)(p.ws + OFF_CNT); const int* list = (const int*)(p.ws + OFF_LIST);
    const bf16_t* hid = (const bf16_t*)(p.ws + OFF_HID);
    moe_tiles(cnt, tstart);
    const int ntiles = tstart[NE];
    const XcdOrder ord(bid, nblk, ntiles * 8);
    for (int i = 0, item; (item = ord.item(i)) >= 0; ++i) {
        const int ti = item >> 3, cj = item & 7;
        int e = 0; while (e < NE - 1 && tstart[e + 1] <= ti) ++e;
        const int lt = ti - tstart[e], ne = cnt[e];
        PlainA al{hid + (size_t)ti * 256 * DE, DE};
        EpiDown epi{(bf16_t*)(p.ws + OFF_YBUF), list + e * LCAP + lt * 256, (const float*)(p.ws + OFF_GATE), ne - lt * 256, cj * 128};
        gemm8<1, false, 1>(al, p.w_down + (size_t)e * DE * D + cj * 128, nullptr, D, DE, lds, epi);
    }
}

DI void phase_final(const Params& p, int bid, int nblk) {
    const int lane = threadIdx.x & 63, wid = threadIdx.x >> 6;
    const float* x2 = (const float*)(p.ws + OFF_X2); const float* gt = (const float*)(p.ws + OFF_MODX) + 5120; const bf16_t* yb = (const bf16_t*)(p.ws + OFF_YBUF);
    for (int tp = bid * NWV + wid; tp < S / 2; tp += nblk * NWV) {
        f32x4 v[2][4]; float ss[2] = {0.f, 0.f};
        u32x2 ya[2][4], ybv[2][4];
#pragma unroll
        for (int r = 0; r < 2; ++r)
#pragma unroll
            for (int i = 0; i < 4; ++i) {
                const int t = 2 * tp + r, d = (i * 64 + lane) * 4;
                v[r][i] = *(const f32x4*)(x2 + (size_t)t * D + d);
                ya[r][i] = *(const u32x2*)(yb + (size_t)(2 * t) * D + d); ybv[r][i] = *(const u32x2*)(yb + (size_t)(2 * t + 1) * D + d);
            }
#pragma unroll
        for (int r = 0; r < 2; ++r)
#pragma unroll
            for (int i = 0; i < 4; ++i) {
                const int d = (i * 64 + lane) * 4; const f32x4 g = *(const f32x4*)(gt + d); const u32x2 a = ya[r][i], b = ybv[r][i];
                v[r][i][0] += g[0] * (bflo(a.x) + bflo(b.x)); v[r][i][1] += g[1] * (bfhi(a.x) + bfhi(b.x));
                v[r][i][2] += g[2] * (bflo(a.y) + bflo(b.y)); v[r][i][3] += g[3] * (bfhi(a.y) + bfhi(b.y));
                ss[r] += v[r][i][0] * v[r][i][0] + v[r][i][1] * v[r][i][1] + v[r][i][2] * v[r][i][2] + v[r][i][3] * v[r][i][3];
            }
#pragma unroll
        for (int r = 0; r < 2; ++r) {
            const float rstd = rsqrtf(wave_sum(ss[r]) * (1.f / 1024.f) + 1e-6f);
#pragma unroll
            for (int i = 0; i < 4; ++i) {
                const int d = (i * 64 + lane) * 4; const f32x4 fg = *(const f32x4*)(p.final_g + d); f32x4 o;
#pragma unroll
                for (int j = 0; j < 4; ++j) o[j] = v[r][i][j] * rstd * fg[j];
                *(f32x4*)(p.out + (size_t)(2 * tp + r) * D + d) = o;
            }
        }
    }
}

#define XB_TMO      128
#define XB_XCNT(j)  (256  + 64 * (j))
#define XB_XSUB(j)  (1280 + 64 * (j))
#define XB_XGEN(j)  (2304 + 64 * (j))
#define XB_TOP      3328
#define XB_TOPGEN   3392
#define XCD_BAR_WORDS 3456
#define XB_SPIN_CAP (1u << 18)
DI unsigned xb_ld(unsigned* p) { return __hip_atomic_load(p, __ATOMIC_RELAXED, __HIP_MEMORY_SCOPE_AGENT); }
DI unsigned xb_add(unsigned* p, unsigned v) { return __hip_atomic_fetch_add(p, v, __ATOMIC_RELAXED, __HIP_MEMORY_SCOPE_AGENT); }
DI unsigned xb_xcc_id() { return (unsigned)__builtin_amdgcn_s_getreg((3 << 11) | 20) & 0xFu; }
#define XB_SPIN(cond, bar) do { unsigned _sp = 0; while (cond) { __builtin_amdgcn_s_sleep(1); \
    if ((++_sp & 255u) == 0u) { if (xb_ld(&(bar)[XB_TMO])) break; if (_sp > XB_SPIN_CAP) { atomicAdd(&(bar)[XB_TMO], 1u); break; } } } } while (0)
struct XcdBarrier { unsigned* bar; unsigned x; volatile LAS unsigned* st; };
DI XcdBarrier xcd_barrier_post(unsigned* bar, volatile LAS unsigned* st) {
    XcdBarrier b; b.bar = bar; b.x = xb_xcc_id(); b.st = st;
    if (threadIdx.x == 0) (void)xb_add(&bar[XB_XCNT(b.x)], 1u);
    return b;
}
DI void xcd_barrier_complete(unsigned* bar, unsigned x, unsigned& nloc, unsigned& nx) {
    const unsigned G = gridDim.x * gridDim.y * gridDim.z;
    unsigned sum, cnt, mine, sp = 0u;
    for (;;) {
        sum = 0u; cnt = 0u; mine = 0u;
#pragma unroll
        for (unsigned j = 0; j < 16; ++j) { const unsigned c = xb_ld(&bar[XB_XCNT(j)]); sum += c; cnt += (c > 0u) ? 1u : 0u; mine = (j == x) ? c : mine; }
        if (sum == G) break;
        __builtin_amdgcn_s_sleep(1);
        if ((++sp & 255u) == 0u) { if (xb_ld(&bar[XB_TMO])) break; if (sp > XB_SPIN_CAP) { atomicAdd(&bar[XB_TMO], 1u); break; } }
    }
    nloc = mine > 0u ? mine : 1u; nx = cnt > 0u ? cnt : 1u;
}
DI void xcd_barrier(const XcdBarrier& b) {
    asm volatile("s_waitcnt vmcnt(0)" ::: "memory");
    __syncthreads();
    if (threadIdx.x == 0) {
        unsigned* bar = b.bar;
        __builtin_amdgcn_s_waitcnt(0);
        unsigned nloc = b.st[0], nx = b.st[1];
        if (nloc == 0u) { xcd_barrier_complete(bar, b.x, nloc, nx); b.st[0] = nloc; b.st[1] = nx; }
        const unsigned old = xb_add(&bar[XB_XSUB(b.x)], 1u);
        const unsigned gen = old / nloc;
        if (old + 1u == (gen + 1u) * nloc) {
            __builtin_amdgcn_fence(__ATOMIC_RELEASE, "agent");
            asm volatile("s_waitcnt vmcnt(0)" ::: "memory");
            const unsigned og = xb_add(&bar[XB_TOP], 1u);
            const unsigned tg = og / nx;
            if (og + 1u == (tg + 1u) * nx) xb_add(&bar[XB_TOPGEN], 1u);
            else XB_SPIN(xb_ld(&bar[XB_TOPGEN]) == tg, bar);
            __builtin_amdgcn_fence(__ATOMIC_ACQUIRE, "agent");
            xb_add(&bar[XB_XGEN(b.x)], 1u);
            asm volatile("s_waitcnt vmcnt(0)" ::: "memory");
        } else {
            XB_SPIN(xb_ld(&bar[XB_XGEN(b.x)]) == gen, bar);
            __builtin_amdgcn_fence(__ATOMIC_ACQUIRE, "agent");
            asm volatile("s_waitcnt vmcnt(0)" ::: "memory");
        }
    }
    __syncthreads();
}

constexpr int MEGA_LDS = SCANA_LDS > (GEMM_LDS + 256) ? SCANA_LDS : (GEMM_LDS + 256);
__global__ void __launch_bounds__(NTH) k_mega(Params p) {
    extern __shared__ __attribute__((aligned(16))) char lds[];
    const int bid = blockIdx.x, nblk = gridDim.x;
    volatile LAS unsigned* st = (volatile LAS unsigned*)(lds + MEGA_LDS);
    if (threadIdx.x < 4) st[threadIdx.x] = 0u;
    __syncthreads();
    const XcdBarrier gb = xcd_barrier_post((unsigned*)(p.ws + OFF_BAR), st);
#define GSYNC() xcd_barrier(gb)
    phase_p0(p, bid, nblk, lds); GSYNC();
    phase_xn(p, bid, nblk); phase_router_prep(p, bid, nblk); GSYNC();
    phase_g1(p, bid, nblk, lds); GSYNC();
    phase_pool(p, bid, nblk);
    phase_scanA(p, bid, nblk, lds); GSYNC();
    if (threadIdx.x < 256) for (int it = bid; it < 256; it += nblk) chain_run<1>(p, it >> 4, it & 15);
    GSYNC();
    if (bid < 16) { if (threadIdx.x < 256) chain_groups(p, bid); } else phase_poolgemm(p, bid - 16, nblk - 16, lds);
    GSYNC();
    if (threadIdx.x < 256) for (int it = bid; it < 256; it += nblk) chain_run<3>(p, it >> 4, it & 15);
    GSYNC();
    phase_scanC(p, bid, nblk, lds); GSYNC();
    phase_g2(p, bid, nblk, lds); GSYNC();
    phase_router(p, bid, nblk, lds); GSYNC();
    phase_g3(p, bid, nblk, lds); GSYNC();
    phase_g4(p, bid, nblk, lds); GSYNC();
    phase_final(p, bid, nblk);
}

extern "C" void kernel_launch(void* const* d_in, const int* in_sizes, int n_in, void* d_out, int out_size, void* d_ws, size_t ws_size, hipStream_t stream) {
    if (ws_size < WS_NEED) { fprintf(stderr, "workspace too small: %zu < %zu\n", ws_size, (size_t)WS_NEED); return; }
    Params p{};
    const float** f = (const float**)&p;
    for (int i = 0; i < 36; ++i) f[i] = (const float*)d_in[i];
    p.out = (float*)d_out; p.ws = (char*)d_ws;
    static int grid_blocks = 0;
    if (!grid_blocks) {
        (void)hipFuncSetAttribute((const void*)k_mega, hipFuncAttributeMaxDynamicSharedMemorySize, MEGA_LDS + 16);
        int dev = 0, cus = 0, per_cu = 0;
        (void)hipGetDevice(&dev);
        (void)hipDeviceGetAttribute(&cus, hipDeviceAttributeMultiprocessorCount, dev);
        (void)hipOccupancyMaxActiveBlocksPerMultiprocessor(&per_cu, k_mega, NTH, MEGA_LDS + 16);
        if (per_cu > 1) per_cu = 1;
        grid_blocks = cus * per_cu;
    }
    (void)hipMemsetAsync((char*)d_ws + OFF_BAR, 0, 16384, stream);
    void* args[] = {&p};
    hipError_t e = hipLaunchCooperativeKernel((const void*)k_mega, dim3(grid_blocks), dim3(NTH), args, MEGA_LDS + 16, stream);
    if (e != hipSuccess) fprintf(stderr, "cooperative launch failed: %s (grid %d)\n", hipGetErrorString(e), grid_blocks);
}
```

```cpp
#include <hip/hip_runtime.h>
#include <stdint.h>
#include <stdio.h>
#include <hip/hip_cooperative_groups.h>
namespace cg = cooperative_groups;

#define DI __device__ __forceinline__
typedef unsigned short bf16_t;
typedef short bf16x8 __attribute__((ext_vector_type(8)));
typedef short s16x4 __attribute__((ext_vector_type(4)));
typedef float f32x4 __attribute__((ext_vector_type(4)));
typedef float f32x2 __attribute__((ext_vector_type(2)));
typedef __bf16 bf16x2_t __attribute__((ext_vector_type(2)));
typedef unsigned u32x4 __attribute__((ext_vector_type(4)));
typedef unsigned u32x2 __attribute__((ext_vector_type(2)));
#define LAS __attribute__((address_space(3)))

constexpr int D = 1024, S = 16384, CTX = 256, NT = S + CTX, DIN = 2432, DSH = 1920, DR = 512;
constexpr int C_WLF = 1536, C_WLB = 1600, C_ALF = 1664, C_ALB = 1728, C_GL = 1792, C_POOL = 1920;
constexpr int NE = 32, DE = 512, LCAP = 32768;
constexpr float DECAY_SCALE = 0.6065306597f;
constexpr int NTH = 512, NWV = 8;

constexpr int NCH = NT / 64;
constexpr size_t SZ_U = (size_t)NT * DIN * 2;
constexpr size_t SZ_CH = (size_t)16 * NCH * 8192;
constexpr size_t OFF_U = 0;
constexpr size_t OFF_XN = OFF_U + SZ_U;
constexpr size_t OFF_P = OFF_XN;
constexpr size_t OFF_Q = OFF_P + SZ_CH;
constexpr size_t OFF_WYT = OFF_Q + SZ_CH;
constexpr size_t OFF_YL = OFF_WYT + (size_t)256 * 16 * 8192;
constexpr size_t OFF_V = OFF_YL + (size_t)256 * 16 * 8192;
constexpr size_t OFF_G = OFF_V + (size_t)S * DR * 2;
constexpr size_t OFF_MIX = OFF_G + (size_t)S * DR * 2;
constexpr size_t OFF_SMALL = OFF_MIX + (size_t)S * D * 2;
constexpr size_t OFF_MODX = OFF_SMALL, OFF_MODC = OFF_MODX + 6144 * 4;
constexpr size_t OFF_ROWTAB = OFF_MODC + 6144 * 4, OFF_COLTAB = OFF_ROWTAB + 256 * 512 * 4;
constexpr size_t OFF_CNT = OFF_COLTAB + 64 * 512 * 4;
constexpr size_t OFF_GATE = OFF_CNT + 256;
constexpr size_t OFF_LIST = OFF_GATE + (size_t)S * 2 * 4;
constexpr size_t OFF_DOT = OFF_LIST + (size_t)NE * LCAP * 4;
constexpr size_t OFF_WP = OFF_DOT + (size_t)NT * 16 * 4;
constexpr size_t OFF_B2 = OFF_WP + 64 * 4 * 3 * 64 * 4;
constexpr size_t OFF_BAR = OFF_B2 + 256;
constexpr size_t OFF_WINB = OFF_BAR + 16384;
constexpr size_t OFF_WOUTB = OFF_WINB + (size_t)D * DIN * 2;
constexpr size_t WS_NEED = OFF_WOUTB + (size_t)D * D * 2;
constexpr size_t OFF_Z = OFF_U;
constexpr size_t OFF_X2 = OFF_P;
constexpr size_t OFF_YBUF = OFF_WYT;
constexpr size_t OFF_H2 = OFF_U;
constexpr size_t OFF_HID = OFF_U + SZ_CH;
constexpr size_t OFF_CP = OFF_U + SZ_CH;
constexpr size_t OFF_CQ = OFF_CP + 256 * 8192;
constexpr size_t OFF_ZG = OFF_CQ + 256 * 16384;

struct Params {
    const float *x, *c, *ctx, *c_ctx, *norm1_g, *w_mod, *b_mod, *w_in, *mu, *w0_f, *w2_f, *w0_b, *w2_b, *a0_f, *a2_f, *a0_b, *a2_b,
        *g2, *k_k, *k_a, *r_k_f, *r_k_b, *gn_w, *gn_b, *w_pool, *pool_scale, *w_out, *norm2_g, *w_rg, *b_rg, *w_re, *b_re,
        *w_gate, *w_up, *w_down, *final_g;
    float* out;
    char* ws;
};

DI unsigned pack2(float lo, float hi) { f32x2 v = {lo, hi}; bf16x2_t b = __builtin_convertvector(v, bf16x2_t); return __builtin_bit_cast(unsigned, b); }
DI float bf2f(bf16_t h) { return __uint_as_float(((unsigned)h) << 16); }
DI float bflo(unsigned u) { return __uint_as_float(u << 16); }
DI float bfhi(unsigned u) { return __uint_as_float(u & 0xffff0000u); }
DI void unpack8(const u32x4& p, float* f) { f[0] = bflo(p.x); f[1] = bfhi(p.x); f[2] = bflo(p.y); f[3] = bfhi(p.y); f[4] = bflo(p.z); f[5] = bfhi(p.z); f[6] = bflo(p.w); f[7] = bfhi(p.w); }
DI u32x4 pack8(const float* f) { u32x4 p; p.x = pack2(f[0], f[1]); p.y = pack2(f[2], f[3]); p.z = pack2(f[4], f[5]); p.w = pack2(f[6], f[7]); return p; }
DI float sigmoidf_(float x) { return 1.f / (1.f + __expf(-x)); }
DI float wave_sum(float v) {
#pragma unroll
    for (int o = 32; o > 0; o >>= 1) v += __shfl_xor(v, o, 64);
    return v;
}
DI f32x4 wave_sum4(f32x4 v) {
#pragma unroll
    for (int o = 32; o > 0; o >>= 1) { v[0] += __shfl_xor(v[0], o, 64); v[1] += __shfl_xor(v[1], o, 64); v[2] += __shfl_xor(v[2], o, 64); v[3] += __shfl_xor(v[3], o, 64); }
    return v;
}
typedef float f32x16 __attribute__((ext_vector_type(16)));
DI f32x16 zero16() { f32x16 z; for (int i = 0; i < 16; ++i) z[i] = 0.f; return z; }
DI s16x4 tr16(const bf16_t* a) { return __builtin_amdgcn_ds_read_tr16_b64_v4i16((LAS s16x4*)a); }
DI float pos_val(const float* rowtab, const float* coltab, int t, int d) { return d < 512 ? rowtab[(t >> 6) * 512 + d] : coltab[(t & 63) * 512 + (d - 512)]; }

DI void phase_p0(const Params& p, int bid, int nblk, char* lds) {
    const int tid = threadIdx.x;
    float* modx = (float*)(p.ws + OFF_MODX); float* modc = (float*)(p.ws + OFF_MODC);
    float* red = (float*)lds;
    for (int item = bid; item < 96; item += nblk) {
        const int col0 = item * 64, cg = tid & 15, kg = tid >> 4;
        f32x4 ax = {0, 0, 0, 0}, ac = {0, 0, 0, 0};
        for (int kk = 0; kk < 32; ++kk) {
            const int k = kg * 32 + kk;
            const float cv = p.c[k], cc = p.c_ctx[k];
            const float sx = cv * sigmoidf_(cv), sc = cc * sigmoidf_(cc);
            const f32x4 w = *(const f32x4*)(p.w_mod + (size_t)k * 6144 + col0 + cg * 4);
            ax += w * sx; ac += w * sc;
        }
        __syncthreads();
#pragma unroll
        for (int j = 0; j < 4; ++j) { red[(kg * 64 + cg * 4 + j) * 2] = ax[j]; red[(kg * 64 + cg * 4 + j) * 2 + 1] = ac[j]; }
        __syncthreads();
        if (tid < 128) {
            const int col = tid & 63, which = tid >> 6;
            float s = 0.f;
            for (int g = 0; g < 32; ++g) s += red[(g * 64 + col) * 2 + which];
            s += p.b_mod[col0 + col];
            (which ? modc : modx)[col0 + col] = s;
        }
    }
    float* rowtab = (float*)(p.ws + OFF_ROWTAB); float* coltab = (float*)(p.ws + OFF_COLTAB);
    for (int i = bid * NTH + tid; i < (256 + 64) * 256; i += nblk * NTH) {
        const int pos = i >> 8, f = i & 255;
        const float freq = powf(10000.f, -(float)f / 256.f);
        if (pos < 256) { const float a = (float)pos * freq; rowtab[pos * 512 + f] = sinf(a); rowtab[pos * 512 + 256 + f] = cosf(a); }
        else { const int cp = pos - 256; const float a = (float)cp * freq; coltab[cp * 512 + f] = sinf(a); coltab[cp * 512 + 256 + f] = cosf(a); }
    }
    if (bid == 0 && tid < 64) ((int*)(p.ws + OFF_CNT))[tid] = 0;
    for (int pass = 0; pass < 2; ++pass) {
        const float* src = pass ? p.w_out : p.w_in; const int nc = pass ? D : DIN; bf16_t* dst = (bf16_t*)(p.ws + (pass ? OFF_WOUTB : OFF_WINB));
        const int n8 = nc >> 3;
        for (int idx = bid * NTH + tid; idx < D * n8; idx += nblk * NTH) {
            const int k = idx / n8, g8 = idx - k * n8, blk = g8 >> 2, q = g8 & 3;
            const f32x4 lo = *(const f32x4*)(src + (size_t)k * nc + blk * 32 + 4 * q), hi = *(const f32x4*)(src + (size_t)k * nc + blk * 32 + 16 + 4 * q);
            *(u32x4*)(dst + (size_t)k * nc + blk * 32 + 8 * q) = (u32x4){pack2(lo[0], lo[1]), pack2(lo[2], lo[3]), pack2(hi[0], hi[1]), pack2(hi[2], hi[3])};
        }
    }
}

DI void phase_xn(const Params& p, int bid, int nblk) {
    const int lane = threadIdx.x & 63, wid = threadIdx.x >> 6;
    const float* modx = (const float*)(p.ws + OFF_MODX); const float* modc = (const float*)(p.ws + OFF_MODC);
    const float* rowtab = (const float*)(p.ws + OFF_ROWTAB); const float* coltab = (const float*)(p.ws + OFF_COLTAB);
    bf16_t* xn = (bf16_t*)(p.ws + OFF_XN);
    for (int gp = bid * NWV + wid; gp < NT / 2; gp += nblk * NWV) {
        const int g0 = 2 * gp; const bool isctx = g0 < CTX;
        const float* md = isctx ? modc : modx;
        f32x4 v[2][4]; float ss[2] = {0.f, 0.f};
#pragma unroll
        for (int r = 0; r < 2; ++r)
#pragma unroll
            for (int i = 0; i < 4; ++i) {
                const int g = g0 + r, t = g - CTX, d = (i * 64 + lane) * 4;
                const float* src = isctx ? p.ctx + (size_t)g * D : p.x + (size_t)t * D;
                v[r][i] = *(const f32x4*)(src + d);
                if (!isctx) v[r][i] += *(const f32x4*)(d < 512 ? rowtab + (t >> 6) * 512 + d : coltab + (t & 63) * 512 + (d - 512));
                ss[r] += v[r][i][0] * v[r][i][0] + v[r][i][1] * v[r][i][1] + v[r][i][2] * v[r][i][2] + v[r][i][3] * v[r][i][3];
            }
#pragma unroll
        for (int r = 0; r < 2; ++r) {
            const float rstd = rsqrtf(wave_sum(ss[r]) * (1.f / 1024.f) + 1e-6f);
#pragma unroll
            for (int i = 0; i < 4; ++i) {
                const int d = (i * 64 + lane) * 4;
                const f32x4 gg = *(const f32x4*)(p.norm1_g + d), sh = *(const f32x4*)(md + d), sc = *(const f32x4*)(md + 1024 + d);
                f32x4 o;
#pragma unroll
                for (int j = 0; j < 4; ++j) o[j] = (v[r][i][j] * rstd * gg[j]) * (1.f + sc[j]) + sh[j];
                u32x2 pk = {pack2(o[0], o[1]), pack2(o[2], o[3])};
                *(u32x2*)(xn + (size_t)(g0 + r) * D + d) = pk;
            }
        }
    }
}

constexpr int GA_SZ = 256 * 128, GB_SZ = 34816, GBUF_SZ = GA_SZ + GB_SZ;
constexpr int GEMM_LDS = 2 * GBUF_SZ;
DI void glds16(const void* gsrc, char* ldst) { __builtin_amdgcn_global_load_lds((const unsigned*)gsrc, (LAS unsigned*)ldst, 16, 0, 0); }
template <int NB, bool BGLDS, int NBLK, class AL, class EPI>
DI void gemm8(const AL& al, const void* __restrict__ Bv0, const void* __restrict__ Bv1, int ldb, int K, char* lds, EPI& epi) {
    static_assert(!(BGLDS && NB == 2) && !(NB == 2 && NBLK == 2), "unsupported combination");
    constexpr int WN = 32 * NBLK, BN = 4 * WN;
    constexpr int RB = BN * 2;
    constexpr int BP = BN + 8;
    constexpr int NF4 = BN / 4;
    constexpr int NLD = (64 * NF4) / NTH;
    constexpr int NPB = (64 * RB) / (1024 * NWV);
    int tid = threadIdx.x; asm volatile("" : "+v"(tid));
    const int lane = tid & 63, wid = __builtin_amdgcn_readfirstlane(tid >> 6), wr = wid >> 2, wc = wid & 3, r32 = lane & 31, hh = lane >> 5, gi = lane >> 4, i16 = lane & 15;
    const float* B0 = (const float*)Bv0; const float* B1 = (const float*)Bv1; const bf16_t* Bb = (const bf16_t*)Bv0;
    f32x16 acc0[4][NBLK], acc1[4][NBLK];
#pragma unroll
    for (int m = 0; m < 4; ++m)
#pragma unroll
        for (int n = 0; n < NBLK; ++n) { acc0[m][n] = zero16(); acc1[m][n] = zero16(); }
    f32x4 rb0[NLD], rb1[NLD];
    const int T = K >> 6;
    const bf16_t* arow[4];
#pragma unroll
    for (int i = 0; i < 4; ++i) { const int row = (8 * i + wid) * 8 + (lane >> 3); arow[i] = al.rowptr(i, row) + (((lane & 7) ^ ((row >> 1) & 7)) << 3); }
    int bsrc[NPB];
#pragma unroll
    for (int i = 0; i < NPB; ++i) { const int k = (8 * i + wid) * (1024 / RB) + lane / (RB / 16), pp = lane % (RB / 16); bsrc[i] = k * ldb + ((((pp >> 1) ^ (k & 7)) << 1) + (pp & 1)) * 8; }
    const int a_base = (wr * 128 + r32) * 128, a_sw = (r32 >> 1) & 7;
    const int b_off = (8 * (gi >> 1) + (i16 >> 2)) * BP + wc * WN + 16 * (gi & 1) + 4 * (i16 & 3);
#define G_DMA(buf, t_) do { char* dA_ = lds + (buf) * GBUF_SZ + wid * 1024 + lane * 16; \
        _Pragma("unroll") for (int i = 0; i < 4; ++i) glds16(arow[i] + (t_) * 64, dA_ + i * 8192); \
        if (BGLDS) { char* dB_ = lds + (buf) * GBUF_SZ + GA_SZ + wid * 1024 + lane * 16; \
            _Pragma("unroll") for (int i = 0; i < NPB; ++i) glds16(Bb + (size_t)(t_) * 64 * ldb + bsrc[i], dB_ + i * 8192); } } while (0)
#define G_LOADB(t_) do { const int k0_ = (t_) * 64; \
        _Pragma("unroll") for (int i = 0; i < NLD; ++i) { const int c = tid + NTH * i, kr = c / NF4, n4 = c % NF4; rb0[i] = *(const f32x4*)(B0 + (size_t)(k0_ + kr) * ldb + n4 * 4); \
            if (NB == 2) rb1[i] = *(const f32x4*)(B1 + (size_t)(k0_ + kr) * ldb + n4 * 4); } } while (0)
#define G_WRITEB(buf) do { bf16_t* sB0_ = (bf16_t*)(lds + (buf) * GBUF_SZ + GA_SZ); bf16_t* sB1_ = sB0_ + 64 * BP; \
        _Pragma("unroll") for (int i = 0; i < NLD; ++i) { const int c = tid + NTH * i, kr = c / NF4, n4 = c % NF4, slot = (n4 >> 3) * 32 + 8 * (n4 & 3) + 4 * ((n4 >> 2) & 1); \
            u32x2 pk = {pack2(rb0[i][0], rb0[i][1]), pack2(rb0[i][2], rb0[i][3])}; *(u32x2*)(sB0_ + kr * BP + slot) = pk; \
            if (NB == 2) { u32x2 pk1 = {pack2(rb1[i][0], rb1[i][1]), pack2(rb1[i][2], rb1[i][3])}; *(u32x2*)(sB1_ + kr * BP + slot) = pk1; } } } while (0)
#define G_READ(buf, ks, AF, BF0, BF1) do { const char* sA_ = lds + (buf) * GBUF_SZ; const bf16_t* sB0_ = (const bf16_t*)(lds + (buf) * GBUF_SZ + GA_SZ); const bf16_t* sB1_ = sB0_ + 64 * BP; const int k0_ = (ks) * 16; \
        _Pragma("unroll") for (int n = 0; n < NBLK; ++n) { \
            if (BGLDS) { const int kk_ = k0_ + 8 * (gi >> 1) + (i16 >> 2), gr_ = (wc * WN + n * 32) / 16 + (gi & 1); \
                const char* q0_ = (const char*)sB0_ + kk_ * RB + ((gr_ ^ (kk_ & 7)) << 5) + 8 * (i16 & 3); const char* q1_ = (const char*)sB0_ + (kk_ + 4) * RB + ((gr_ ^ ((kk_ + 4) & 7)) << 5) + 8 * (i16 & 3); \
                s16x4 lo = tr16((const bf16_t*)q0_), hi = tr16((const bf16_t*)q1_); BF0[n] = __builtin_shufflevector(lo, hi, 0, 1, 2, 3, 4, 5, 6, 7); } \
            else { const int off = b_off + k0_ * BP + n * 32; \
                s16x4 lo = tr16(sB0_ + off), hi = tr16(sB0_ + off + 4 * BP); BF0[n] = __builtin_shufflevector(lo, hi, 0, 1, 2, 3, 4, 5, 6, 7); \
                if (NB == 2) { s16x4 lo1 = tr16(sB1_ + off), hi1 = tr16(sB1_ + off + 4 * BP); BF1[n] = __builtin_shufflevector(lo1, hi1, 0, 1, 2, 3, 4, 5, 6, 7); } } } \
        _Pragma("unroll") for (int m = 0; m < 4; ++m) AF[m] = *(const bf16x8*)(sA_ + a_base + m * 4096 + ((((ks) * 2 + hh) ^ a_sw) << 4)); } while (0)
#define G_MFMA(AF, BF0, BF1) do { \
        _Pragma("unroll") for (int m = 0; m < 4; ++m) _Pragma("unroll") for (int n = 0; n < NBLK; ++n) { \
            acc0[m][n] = __builtin_amdgcn_mfma_f32_32x32x16_bf16(BF0[n], AF[m], acc0[m][n], 0, 0, 0); \
            if (NB == 2) acc1[m][n] = __builtin_amdgcn_mfma_f32_32x32x16_bf16(BF1[n], AF[m], acc1[m][n], 0, 0, 0); } } while (0)
#define G_MIX(nm) do { _Pragma("unroll") for (int i = 0; i < (nm); ++i) { __builtin_amdgcn_sched_group_barrier(0x008, 1, 0); __builtin_amdgcn_sched_group_barrier(0x100, 1, 0); } } while (0)
    constexpr int NMF = 4 * NBLK * NB;
    bf16x8 afA[4], bfA0[NBLK], bfA1[NBLK], afB[4], bfB0[NBLK], bfB1[NBLK];
    G_DMA(0, 0);
    if (!BGLDS) { G_LOADB(0); G_WRITEB(0); }
#pragma unroll 1
    for (int t = 0; t < T; ++t) {
        const int buf = t & 1;
        asm volatile("s_waitcnt vmcnt(0)" ::: "memory");
        __syncthreads();
        if (t + 1 < T) { G_DMA(buf ^ 1, t + 1); if (!BGLDS) G_LOADB(t + 1); }
        if (BGLDS) {
            G_READ(buf, 0, afA, bfA0, bfA1);
            __builtin_amdgcn_sched_barrier(0);
            G_MFMA(afA, bfA0, bfA1); G_READ(buf, 1, afB, bfB0, bfB1); G_MIX(NMF);
            __builtin_amdgcn_sched_barrier(0);
            G_MFMA(afB, bfB0, bfB1); G_READ(buf, 2, afA, bfA0, bfA1); G_MIX(NMF);
            __builtin_amdgcn_sched_barrier(0);
            G_MFMA(afA, bfA0, bfA1); G_READ(buf, 3, afB, bfB0, bfB1); G_MIX(NMF);
            __builtin_amdgcn_sched_barrier(0);
            G_MFMA(afB, bfB0, bfB1);
        } else {
            __builtin_amdgcn_sched_barrier(0);
            G_READ(buf, 0, afA, bfA0, bfA1); G_MFMA(afA, bfA0, bfA1);
            G_READ(buf, 1, afA, bfA0, bfA1); G_MFMA(afA, bfA0, bfA1);
            G_READ(buf, 2, afA, bfA0, bfA1); G_MFMA(afA, bfA0, bfA1);
            __builtin_amdgcn_sched_barrier(0);
            G_READ(buf, 3, afA, bfA0, bfA1); G_MFMA(afA, bfA0, bfA1);
            G_WRITEB(buf ^ 1);
        }
        __builtin_amdgcn_sched_barrier(0);
    }
#undef G_DMA
#undef G_LOADB
#undef G_WRITEB
#undef G_READ
#undef G_MFMA
#undef G_MIX
    __syncthreads();
    float* stg = (float*)lds + wid * (32 * 68);
#pragma unroll
    for (int m = 0; m < 4; ++m) {
#pragma unroll
        for (int n = 0; n < NBLK; ++n) {
            const f32x16 v = epi.pre(acc0[m][n], acc1[m][n]);
#pragma unroll
            for (int q = 0; q < 4; ++q) *(f32x4*)(stg + r32 * 68 + n * 32 + 16 * hh + 4 * q) = (f32x4){v[4 * q], v[4 * q + 1], v[4 * q + 2], v[4 * q + 3]};
        }
        asm volatile("s_waitcnt lgkmcnt(0)" ::: "memory"); __builtin_amdgcn_wave_barrier();
#pragma unroll
        for (int ps = 0; ps < (32 * WN) / 256; ++ps) {
            const int idx = ps * 64 + lane, row = idx / (WN / 4), ck = idx % (WN / 4);
            epi.post(wr * 128 + m * 32 + row, wc * WN + ck * 4, *(const f32x4*)(stg + row * 68 + ck * 4));
        }
        asm volatile("s_waitcnt lgkmcnt(0)" ::: "memory"); __builtin_amdgcn_wave_barrier();
    }
    __syncthreads();
}

struct PlainA {
    const bf16_t* base; int lda;
    DI const bf16_t* rowptr(int, int row) const { return base + (size_t)row * lda; }
};
struct GatherA {
    const bf16_t* rp[4];
    DI const bf16_t* rowptr(int i, int) const { return rp[i]; }
};

struct XcdOrder {
    int base, lim, j, bpx;
    DI XcdOrder(int bid, int nblk, int total) {
        if ((nblk & 7) == 0) { const int x = bid & 7, per = (total + 7) >> 3; bpx = nblk >> 3; j = bid >> 3; base = x * per; lim = base + per < total ? base + per : total; }
        else { bpx = nblk; j = bid; base = 0; lim = total; }
    }
    DI int item(int i) const { const int q = base + i * bpx + j; return q < lim ? q : -1; }
};
DI void tile_rc(int q, int nrow, int ncol, int& r, int& c) {
    const int per_sr = 8 * ncol, sr = q / per_sr, rem = q - sr * per_sr, rows = (nrow - sr * 8) < 8 ? (nrow - sr * 8) : 8;
    c = rem / rows; r = sr * 8 + rem - c * rows;
}

DI u32x4 pack8v(const f32x4& a, const f32x4& b) { return (u32x4){pack2(a[0], a[1]), pack2(a[2], a[3]), pack2(b[0], b[1]), pack2(b[2], b[3])}; }
DI u32x4 pack8q(const f32x16& a, int q) { return (u32x4){pack2(a[8 * q], a[8 * q + 1]), pack2(a[8 * q + 2], a[8 * q + 3]), pack2(a[8 * q + 4], a[8 * q + 5]), pack2(a[8 * q + 6], a[8 * q + 7])}; }
struct EpiStoreBf16 { bf16_t* o; int ldo;
    DI f32x16 pre(const f32x16& a, const f32x16&) const { return a; }
    DI void post(int r, int c, const f32x4& v) const { u32x2 pk = {pack2(v[0], v[1]), pack2(v[2], v[3])}; *(u32x2*)(o + (size_t)r * ldo + c) = pk; } };
DI void phase_g1(const Params& p, int bid, int nblk, char* lds) {
    const bf16_t* xn = (const bf16_t*)(p.ws + OFF_XN); bf16_t* u = (bf16_t*)(p.ws + OFF_U);
    const bf16_t* wb = (const bf16_t*)(p.ws + OFF_WINB);
    const XcdOrder ord(bid, nblk, 65 * 9);
    for (int i = 0, q; (q = ord.item(i)) >= 0; ++i) {
        int tm, tn; tile_rc(q, 65, 9, tm, tn);
        PlainA al{xn + (size_t)tm * 256 * D, D};
        EpiStoreBf16 epi{u + (size_t)tm * 256 * DIN + tn * 256, DIN};
        gemm8<1, true, 2>(al, wb + tn * 256, nullptr, DIN, D, lds, epi);
    }
    for (int tm = nblk - 1 - bid; tm < 65; tm += nblk) {
        PlainA al{xn + (size_t)tm * 256 * D, D};
        EpiStoreBf16 epi{u + (size_t)tm * 256 * DIN + 9 * 256, DIN};
        gemm8<1, true, 1>(al, wb + 9 * 256, nullptr, DIN, D, lds, epi);
    }
}

DI void phase_pool(const Params& p, int bid, int nblk) {
    const bf16_t* u = (const bf16_t*)(p.ws + OFF_U) + (size_t)CTX * DIN + C_POOL;
    bf16_t* mix = (bf16_t*)(p.ws + OFF_MIX);
    for (int item = bid * NTH + threadIdx.x; item < (S / 16) * 64; item += nblk * NTH) {
        const int cg = item & 63, run = item >> 6, t0 = run * 16, gi = cg >> 4, win = 2 << gi, hw = win >> 1;
        const bf16_t* uc = u + cg * 8;
        float sum[8];
#pragma unroll
        for (int j = 0; j < 8; ++j) sum[j] = 0.f;
        int lo = t0 - hw, hi = t0 - hw + win; lo = lo < 0 ? 0 : lo; hi = hi > S ? S : hi;
        for (int tt = lo; tt < hi; ++tt) { float q[8]; unpack8(*(const u32x4*)(uc + (size_t)tt * DIN), q);
#pragma unroll
            for (int j = 0; j < 8; ++j) sum[j] += q[j]; }
        for (int k = 0; k < 16; ++k) {
            const int t = t0 + k;
            float cv[8], o[8]; unpack8(*(const u32x4*)(uc + (size_t)t * DIN), cv);
            const float inv = 1.f / (float)(hi - lo);
#pragma unroll
            for (int j = 0; j < 8; ++j) o[j] = sum[j] * inv - cv[j];
            *(u32x4*)(mix + (size_t)t * D + cg * 8) = pack8(o);
            const int nlo = t + 1 - hw, nhi = t + 1 - hw + win;
            if (nhi <= S) { float q[8]; unpack8(*(const u32x4*)(uc + (size_t)(nhi - 1) * DIN), q);
#pragma unroll
                for (int j = 0; j < 8; ++j) sum[j] += q[j]; hi = nhi; }
            if (nlo > 0) { float q[8]; unpack8(*(const u32x4*)(uc + (size_t)(nlo - 1) * DIN), q);
#pragma unroll
                for (int j = 0; j < 8; ++j) sum[j] -= q[j]; lo = nlo; }
        }
    }
}
struct EpiPool { bf16_t* o; const float* sc;
    DI f32x16 pre(const f32x16& a, const f32x16&) const { return a; }
    DI void post(int r, int c, const f32x4& v) const { const f32x4 s4 = *(const f32x4*)(sc + c); u32x2 pk = {pack2(v[0] * s4[0], v[1] * s4[1]), pack2(v[2] * s4[2], v[3] * s4[3])}; *(u32x2*)(o + (size_t)r * D + c) = pk; } };
DI void phase_poolgemm(const Params& p, int bid, int nblk, char* lds) {
    if (nblk <= 0) return;
    for (int it = bid; it < 4 * 64; it += nblk) {
        const int gi = it >> 6, tm = it & 63;
        const bf16_t* mix = (const bf16_t*)(p.ws + OFF_MIX);
        PlainA al{mix + (size_t)tm * 256 * D + gi * 128, D};
        EpiPool e{(bf16_t*)(p.ws + OFF_MIX) + (size_t)tm * 256 * D + 512 + gi * 128, p.pool_scale + gi * 128};
        int kk = 128; asm volatile("" : "+s"(kk));
        gemm8<1, false, 1>(al, p.w_pool + (size_t)gi * 128 * 128, nullptr, 128, kk, lds, e);
    }
}

constexpr int MP = 72, MSZ = 64 * MP;
constexpr int FP = 68;
constexpr int SCANA_LDS = 14 * MSZ * 2 + 2048;
template <bool KS> DI bf16x8 frag32(const bf16_t* base, int x0, int s, int lane) {
    if (!KS) return *(const bf16x8*)(base + (x0 + (lane & 31)) * MP + 16 * s + 8 * (lane >> 5));
    const int gi = lane >> 4, i = lane & 15;
    const bf16_t* a = base + (16 * s + 8 * (gi >> 1) + (i >> 2)) * MP + x0 + 16 * (gi & 1) + 4 * (i & 3);
    s16x4 lo = tr16(a), hi = tr16(a + 4 * MP);
    return __builtin_shufflevector(lo, hi, 0, 1, 2, 3, 4, 5, 6, 7);
}
template <bool XKS, bool YKS> DI f32x16 mm32(const bf16_t* X, int x0, const bf16_t* Y, int y0, f32x16 acc, int lane) {
#pragma unroll
    for (int s = 0; s < 4; ++s) acc = __builtin_amdgcn_mfma_f32_32x32x16_bf16(frag32<XKS>(X, x0, s, lane), frag32<YKS>(Y, y0, s, lane), acc, 0, 0, 0);
    return acc;
}
template <class F> DI void store_acc(bf16_t* out, int x0, int y0, const f32x16& acc, int lane, F f) {
    const int y = y0 + (lane & 31), hh = lane >> 5;
#pragma unroll
    for (int q = 0; q < 4; ++q) {
        const int x = x0 + 8 * q + 4 * hh;
        u32x2 pk = {pack2(f(acc[4 * q], x, y), f(acc[4 * q + 1], x + 1, y)), pack2(f(acc[4 * q + 2], x + 2, y), f(acc[4 * q + 3], x + 3, y))};
        *(u32x2*)(out + y * MP + x) = pk;
    }
}
DI unsigned rot16(unsigned x) { return (x >> 16) | (x << 16); }

DI int chain_pos(int c, int dir) { return dir == 0 ? c : (c < 4 ? 3 - c : NCH + 3 - c); }

DI void phase_scanA(const Params& p, int bid, int nblk, char* lds) {
    const int tid = threadIdx.x, lane0 = tid & 63, w = tid >> 6, grp = w >> 2;
    bf16_t* M = (bf16_t*)lds;
    bf16_t *sAT = M, *sBT = M + MSZ, *sKT = M + 2 * MSZ, *sRT = M + 3 * MSZ, *sVT = M + 4 * MSZ;
    float* fGC = (float*)(lds + 14 * MSZ * 2);
    float* fSeg = fGC + 64;
    float* fLogw = (float*)(M + 12 * MSZ);
    float* fA = (float*)(M + 10 * MSZ);
    const bf16_t* u = (const bf16_t*)(p.ws + OFF_U);
    for (int inst = bid; inst < NCH * 16; inst += nblk) {
        int lane = lane0; asm volatile("" : "+v"(lane));
        const int xq = 32 * (w & 1), yq = 32 * ((w >> 1) & 1);
        const int c = inst >> 4, h = (inst >> 1) & 7, dir = inst & 1;
        const bool latent = c >= 4, want_g = latent && dir == 0;
        const float* w2 = dir ? p.w2_b : p.w2_f; const float* a2 = dir ? p.a2_b : p.a2_f;
        const float* w0 = dir ? p.w0_b : p.w0_f; const float* a0 = dir ? p.a0_b : p.a0_f;
        const float* rkd = dir ? p.r_k_b : p.r_k_f;
        const int cwl = dir ? C_WLB : C_WLF, cal = dir ? C_ALB : C_ALF;
        const int ch = tid & 7, tau = tid >> 3, g = dir ? c * 64 + 63 - tau : c * 64 + tau;
        float fr_[8], fk_[8], fv_[8];
        {
            const int cols5[5] = {h * 64 + ch * 8, 512 + h * 64 + ch * 8, 1024 + h * 64 + ch * 8, cwl + ch * 8, cal + ch * 8};
            const bool hasp = (g != 0) && (g != CTX), hasn = (g != CTX - 1) && (g != NT - 1);
            const float mp = hasp ? 0.5f : 0.f, mn = hasn ? 0.5f : 0.f;
            const bf16_t* rc = u + (size_t)g * DIN; const bf16_t* rp = hasp ? rc - DIN : rc; const bf16_t* rn = hasn ? rc + DIN : rc;
            u32x4 raw[5][3]; f32x4 wl[4];
#pragma unroll
            for (int q = 0; q < 5; ++q) { raw[q][0] = *(const u32x4*)(rc + cols5[q]); raw[q][1] = *(const u32x4*)(rp + cols5[q]); raw[q][2] = *(const u32x4*)(rn + cols5[q]); }
#pragma unroll
            for (int q = 0; q < 2; ++q) { const int idx = tid + NTH * q, kr = idx >> 4, n4 = idx & 15;
                wl[q] = *(const f32x4*)(w2 + (size_t)kr * DR + h * 64 + n4 * 4); wl[2 + q] = *(const f32x4*)(a2 + (size_t)kr * DR + h * 64 + n4 * 4); }
            auto shift8 = [&](const u32x4* r3, int col, float* o) {
                float cc[8], pv[8], nx[8];
                unpack8(r3[0], cc); unpack8(r3[1], pv); unpack8(r3[2], nx);
                const f32x4 m0 = *(const f32x4*)(p.mu + col), m1 = *(const f32x4*)(p.mu + col + 4);
#pragma unroll
                for (int j = 0; j < 8; ++j) { const float m = j < 4 ? m0[j & 3] : m1[j & 3]; o[j] = cc[j] + m * ((mp * pv[j] + mn * nx[j]) - cc[j]); }
            };
            shift8(raw[0], cols5[0], fr_); shift8(raw[1], cols5[1], fk_); shift8(raw[2], cols5[2], fv_);
            float t8[8];
            shift8(raw[3], cols5[3], t8);
#pragma unroll
            for (int j = 0; j < 8; ++j) { const float e2 = __expf(2.f * t8[j]); t8[j] = 1.f - __fdividef(2.f, e2 + 1.f); }
            *(u32x4*)(M + 5 * MSZ + tau * MP + ch * 8) = pack8(t8);
            shift8(raw[4], cols5[4], t8);
            *(u32x4*)(M + 6 * MSZ + tau * MP + ch * 8) = pack8(t8);
            if (want_g) {
                u32x4 rawg[2][3]; f32x4 wg2[4];
#pragma unroll
                for (int half = 0; half < 2; ++half) { const int col = C_GL + half * 64 + ch * 8;
                    rawg[half][0] = *(const u32x4*)(rc + col); rawg[half][1] = *(const u32x4*)(rp + col); rawg[half][2] = *(const u32x4*)(rn + col); }
#pragma unroll
                for (int q = 0; q < 4; ++q) { const int idx = tid + NTH * q, kr = idx >> 4, n4 = idx & 15; wg2[q] = *(const f32x4*)(p.g2 + (size_t)kr * DR + h * 64 + n4 * 4); }
#pragma unroll
                for (int half = 0; half < 2; ++half) {
                    shift8(rawg[half], C_GL + half * 64 + ch * 8, t8);
#pragma unroll
                    for (int j = 0; j < 8; ++j) t8[j] = sigmoidf_(t8[j]);
                    *(u32x4*)(M + half * MSZ + tau * MP + ch * 8) = pack8(t8);
                }
#pragma unroll
                for (int q = 0; q < 4; ++q) { const int idx = tid + NTH * q, kr = idx >> 4, n4 = idx & 15;
                    u32x2 pa = {pack2(wg2[q][0], wg2[q][1]), pack2(wg2[q][2], wg2[q][3])};
                    *(u32x2*)(M + (2 + (kr >> 6)) * MSZ + (kr & 63) * MP + n4 * 4) = pa; }
            }
#pragma unroll
            for (int q = 0; q < 2; ++q) { const int idx = tid + NTH * q, kr = idx >> 4, n4 = idx & 15;
                u32x2 pa = {pack2(wl[q][0], wl[q][1]), pack2(wl[q][2], wl[q][3])}, pb = {pack2(wl[2 + q][0], wl[2 + q][1]), pack2(wl[2 + q][2], wl[2 + q][3])};
                *(u32x2*)(M + 7 * MSZ + kr * MP + n4 * 4) = pa; *(u32x2*)(M + 8 * MSZ + kr * MP + n4 * 4) = pb; }
        }
        __syncthreads();
        if (grp == 0) {
            f32x16 accW = mm32<true, false>(M + 7 * MSZ, xq, M + 5 * MSZ, yq, zero16(), lane);
            const int y = yq + (lane & 31), hh = lane >> 5;
#pragma unroll
            for (int q = 0; q < 4; ++q) {
                const int x = xq + 8 * q + 4 * hh;
                f32x4 lw; const f32x4 w0v = *(const f32x4*)(w0 + h * 64 + x);
#pragma unroll
                for (int e = 0; e < 4; ++e) {
                    float v = -DECAY_SCALE * sigmoidf_(w0v[e] + accW[4 * q + e]);
                    v += __builtin_bit_cast(float, __builtin_amdgcn_update_dpp(0, __builtin_bit_cast(int, v), 0x111, 0xf, 0xf, false));
                    v += __builtin_bit_cast(float, __builtin_amdgcn_update_dpp(0, __builtin_bit_cast(int, v), 0x112, 0xf, 0xf, false));
                    v += __builtin_bit_cast(float, __builtin_amdgcn_update_dpp(0, __builtin_bit_cast(int, v), 0x114, 0xf, 0xf, false));
                    v += __builtin_bit_cast(float, __builtin_amdgcn_update_dpp(0, __builtin_bit_cast(int, v), 0x118, 0xf, 0xf, false));
                    v += __builtin_bit_cast(float, __builtin_amdgcn_update_dpp(0, __builtin_bit_cast(int, v), 0x142, 0xa, 0xf, false));
                    lw[e] = v;
                }
                *(f32x4*)(fLogw + y * FP + x) = lw;
                if (yq == 0 && (lane & 31) == 31) *(f32x4*)(fSeg + x) = lw;
            }
        } else {
            f32x16 accA = mm32<true, false>(M + 8 * MSZ, xq, M + 6 * MSZ, yq, zero16(), lane);
            const int y = yq + (lane & 31), hh = lane >> 5;
#pragma unroll
            for (int q = 0; q < 4; ++q) {
                const int x = xq + 8 * q + 4 * hh;
                f32x4 av; const f32x4 a0v = *(const f32x4*)(a0 + h * 64 + x);
#pragma unroll
                for (int e = 0; e < 4; ++e) av[e] = sigmoidf_(a0v[e] + accA[4 * q + e]);
                *(f32x4*)(fA + y * FP + x) = av;
            }
            if (want_g) {
                f32x16 accG = mm32<true, false>(M + 2 * MSZ, xq, M, yq, zero16(), lane);
                accG = mm32<true, false>(M + 3 * MSZ, xq, M + MSZ, yq, accG, lane);
                const int t = c * 64 + y - CTX;
#pragma unroll
                for (int q = 0; q < 4; ++q) {
                    const int x = xq + 8 * q + 4 * hh;
                    u32x2 pk = {pack2(accG[4 * q], accG[4 * q + 1]), pack2(accG[4 * q + 2], accG[4 * q + 3])};
                    *(u32x2*)((bf16_t*)(p.ws + OFF_G) + (size_t)t * DR + h * 64 + x) = pk;
                }
            }
        }
        __syncthreads();
        {
            float oa[8], ob[8], ok[8], orr[8], kkv[8], kd[8];
            float ss = 0.f, dsum = 0.f;
            const int c8 = h * 64 + ch * 8;
            float kkp[8], kap[8], rkp[8];
            { const f32x4 a0_ = *(const f32x4*)(p.k_k + c8), a1_ = *(const f32x4*)(p.k_k + c8 + 4), b0_ = *(const f32x4*)(p.k_a + c8), b1_ = *(const f32x4*)(p.k_a + c8 + 4), c0_ = *(const f32x4*)(rkd + c8), c1_ = *(const f32x4*)(rkd + c8 + 4);
#pragma unroll
              for (int j = 0; j < 4; ++j) { kkp[j] = a0_[j]; kkp[4 + j] = a1_[j]; kap[j] = b0_[j]; kap[4 + j] = b1_[j]; rkp[j] = c0_[j]; rkp[4 + j] = c1_[j]; } }
#pragma unroll
            for (int j = 0; j < 8; ++j) { kkv[j] = fk_[j] * kkp[j]; ss += kkv[j] * kkv[j]; }
            ss += __shfl_xor(ss, 1, 64); ss += __shfl_xor(ss, 2, 64); ss += __shfl_xor(ss, 4, 64);
            const float inv = 1.f / fmaxf(sqrtf(ss), 1e-12f);
#pragma unroll
            for (int j = 0; j < 8; ++j) {
                const int jj = ch * 8 + j;
                const float seg = fSeg[jj];
                const float cum = fLogw[tau * FP + jj] + (tau >= 32 ? seg : 0.f), cprev = tau ? fLogw[(tau - 1) * FP + jj] + (tau > 32 ? seg : 0.f) : 0.f, av = fA[tau * FP + jj];
                const float gam = __expf(cum), gprev = __expf(cprev), ginv = __expf(-cum);
                const float kkn = kkv[j] * inv;
                kd[j] = fk_[j] * (1.f + (av - 1.f) * kap[j]);
                oa[j] = -kkn * gprev; ob[j] = kkn * av * ginv; ok[j] = kd[j] * ginv; orr[j] = fr_[j] * gam;
                dsum += fr_[j] * kd[j] * rkp[j];
                if (tau == 63) fGC[jj] = gam;
            }
            dsum += __shfl_xor(dsum, 1, 64); dsum += __shfl_xor(dsum, 2, 64); dsum += __shfl_xor(dsum, 4, 64);
            if (ch == 0) ((float*)(p.ws + OFF_DOT))[((size_t)g * 8 + h) * 2 + dir] = dsum;
            *(u32x4*)(sAT + tau * MP + ch * 8) = pack8(oa); *(u32x4*)(sBT + tau * MP + ch * 8) = pack8(ob);
            *(u32x4*)(sKT + tau * MP + ch * 8) = pack8(ok); *(u32x4*)(sRT + tau * MP + ch * 8) = pack8(orr);
            const u32x4 pv8 = pack8(fv_);
            *(u32x4*)(sVT + tau * MP + ch * 8) = pv8;
            if (want_g) *(u32x4*)((bf16_t*)(p.ws + OFF_V) + (size_t)(g - CTX) * DR + h * 64 + ch * 8) = pv8;
        }
        __syncthreads();
        if (grp == 0) {
            f32x16 acc = mm32<false, false>(sAT, xq, sBT, yq, zero16(), lane);
            store_acc(M + 5 * MSZ, xq, yq, acc, lane, [](float v, int x, int y) { return y < x ? v : 0.f; });
            store_acc(M + 7 * MSZ, xq, yq, acc, lane, [](float v, int x, int y) { return y < x ? v : (y == x ? 1.f : 0.f); });
            acc = mm32<false, false>(sAT, xq, sKT, yq, zero16(), lane);
            store_acc(M + 9 * MSZ, xq, yq, acc, lane, [](float v, int x, int y) { return y < x ? v : 0.f; });
        } else {
            f32x16 acc = mm32<false, false>(sRT, xq, sBT, yq, zero16(), lane);
            store_acc(M + 10 * MSZ, xq, yq, acc, lane, [](float v, int x, int y) { return y <= x ? v : 0.f; });
            acc = mm32<false, false>(sRT, xq, sKT, yq, zero16(), lane);
            store_acc(M + 11 * MSZ, xq, yq, acc, lane, [](float v, int x, int y) { return y <= x ? v : 0.f; });
        }
        __syncthreads();
        int xs = 5, xo = 6, ts = 7, to = 8;
        if (grp == 1) {
            f32x16 acc = mm32<true, false>(M + xs * MSZ, xq, M + xs * MSZ, yq, zero16(), lane);
            store_acc(M + xo * MSZ, xq, yq, acc, lane, [](float v, int, int) { return v; });
        }
        { int t_ = xs; xs = xo; xo = t_; }
        __syncthreads();
        for (int k = 0; k < 5; ++k) {
            if (grp == 0) {
                const bf16_t* Told = M + ts * MSZ;
                f32x16 acc = mm32<true, false>(M + xs * MSZ, xq, Told, yq, zero16(), lane);
                store_acc(M + to * MSZ, xq, yq, acc, lane, [Told](float v, int x, int y) { return v + bf2f(Told[y * MP + x]); });
            } else if (k < 4) {
                f32x16 acc = mm32<true, false>(M + xs * MSZ, xq, M + xs * MSZ, yq, zero16(), lane);
                store_acc(M + xo * MSZ, xq, yq, acc, lane, [](float v, int, int) { return v; });
            }
            int t_ = xs; xs = xo; xo = t_; t_ = ts; ts = to; to = t_;
            __syncthreads();
        }
        const bf16_t* sT = M + ts * MSZ;
        if (grp == 0) {
            f32x16 acc = mm32<true, true>(sT, xq, sAT, yq, zero16(), lane);
            store_acc(M + 12 * MSZ, xq, yq, acc, lane, [](float v, int, int) { return v; });
        } else {
            f32x16 acc = mm32<true, false>(sT, xq, M + 9 * MSZ, yq, zero16(), lane);
            store_acc(M + 13 * MSZ, xq, yq, acc, lane, [](float v, int, int) { return v; });
        }
        __syncthreads();
        {
            const bf16_t *sAbar = M + 12 * MSZ, *sG = M + 13 * MSZ, *sABR = M + 10 * MSZ, *sAKR = M + 11 * MSZ;
            if (grp == 0) {
                f32x16 acc = mm32<false, true>(sAbar, xq, sBT, yq, zero16(), lane);
                store_acc(M + 5 * MSZ, xq, yq, acc, lane, [fGC](float v, int x, int y) { return ((x == y ? 1.f : 0.f) + v) * fGC[y]; });
                acc = mm32<false, true>(sAbar, xq, sABR, yq, zero16(), lane);
                store_acc(M + 6 * MSZ, xq, yq, acc, lane, [sRT](float v, int x, int y) { return v + bf2f(sRT[y * MP + x]); });
            } else {
                f32x16 acc = mm32<true, false>(sBT, xq, sG, yq, zero16(), lane);
                store_acc(M + 7 * MSZ, xq, yq, acc, lane, [sKT, fGC](float v, int x, int y) { return (v + bf2f(sKT[y * MP + x])) * fGC[x]; });
                acc = mm32<true, false>(sABR, xq, sG, yq, zero16(), lane);
                store_acc(M + 9 * MSZ, xq, yq, acc, lane, [sAKR](float v, int x, int y) { return v + bf2f(sAKR[y * MP + x]); });
            }
        }
        __syncthreads();
        const int chain = dir * 8 + h, npos = chain_pos(c, dir);
        {
            u32x4* Pg = (u32x4*)(p.ws + OFF_P) + ((size_t)chain * NCH + npos) * 512;
            { const int item = tid, ln = item & 63, as = item >> 6, a = as >> 1, s2 = as & 1, fr = ln & 15, fq = ln >> 4;
              const bf16_t* src = M + 5 * MSZ + (16 * a + fr) * MP + 32 * s2 + 4 * fq;
              const u32x2 lo = *(const u32x2*)src, hi = *(const u32x2*)(src + 16);
              Pg[as * 64 + ln] = (u32x4){lo.x, lo.y, hi.x, hi.y}; }
            if (latent) {
                u32x4* Wg = (u32x4*)(p.ws + OFF_WYT) + ((size_t)((c - 4) * 8 + h) * 2 + dir) * 512;
                const int row = tid >> 3, ck = tid & 7; Wg[tid] = *(const u32x4*)(M + 6 * MSZ + row * MP + ck * 8);
            }
        }
        if (grp == 0) {
            f32x16 acc = mm32<true, true>(M + 7 * MSZ, xq, sVT, yq, zero16(), lane);
            store_acc(M + 12 * MSZ, xq, yq, acc, lane, [](float v, int, int) { return v; });
        } else {
            f32x16 acc = mm32<true, true>(M + 9 * MSZ, xq, sVT, yq, zero16(), lane);
            store_acc(M + 13 * MSZ, xq, yq, acc, lane, [](float v, int, int) { return v; });
        }
        __syncthreads();
        {
            u32x2* Qg = (u32x2*)(p.ws + OFF_Q) + ((size_t)chain * NCH + npos) * 1024;
#pragma unroll
            for (int i = 0; i < 2; ++i) {
                const int item = tid + NTH * i, ln = item & 63, wa = item >> 6, wi = wa >> 2, a = wa & 3, fr = ln & 15, fq = ln >> 4;
                Qg[item] = *(const u32x2*)(M + 12 * MSZ + (16 * wi + fr) * MP + 16 * a + 4 * fq);
            }
            if (latent) {
                u32x2* Yg = (u32x2*)(p.ws + OFF_YL) + ((size_t)((c - 4) * 8 + h) * 2 + dir) * 1024;
#pragma unroll
                for (int i = 0; i < 2; ++i) {
                    const int item = tid + NTH * i, ln = item & 63, wn = item >> 6, wt = wn >> 2, ni = wn & 3, fr = ln & 15, fq = ln >> 4;
                    const bf16_t* row = M + 13 * MSZ + (16 * ni + fr) * MP;
                    u32x2 v;
                    if (dir == 0) v = *(const u32x2*)(row + 16 * wt + 4 * fq);
                    else { const u32x2 r2 = *(const u32x2*)(row + 60 - 16 * wt - 4 * fq); v = (u32x2){rot16(r2.y), rot16(r2.x)}; }
                    Yg[item] = v;
                }
            }
        }
        __syncthreads();
    }
}

DI int grp_start(int g) { return g * 16 + (g < 4 ? g : 4); }
DI u32x4 packz(const f32x4& a, const f32x4& b) { return (u32x4){pack2(a[0], a[1]), pack2(a[2], a[3]), pack2(b[0], b[1]), pack2(b[2], b[3])}; }
template <int PASS> DI void chain_run(const Params& p, int chain, int g) {
    constexpr int CPF = PASS == 1 ? 2 : 3;
    const int lane = threadIdx.x & 63, w = threadIdx.x >> 6, fr = lane & 15, fq = lane >> 4;
    const int n0 = grp_start(g), n1 = grp_start(g + 1);
    const u32x4* Pg = (const u32x4*)(p.ws + OFF_P) + (size_t)chain * NCH * 512;
    const u32x2* Qg = (const u32x2*)(p.ws + OFF_Q) + (size_t)chain * NCH * 1024;
    u32x4* Zg = (u32x4*)(p.ws + OFF_Z) + (size_t)chain * NCH * 512;
    f32x4* ZG = (f32x4*)(p.ws + OFF_ZG) + ((size_t)(chain * 16 + g) * 4 + w) * 256;
    f32x4 acc[4], accp[4];
#pragma unroll
    for (int a = 0; a < 4; ++a) {
        if (PASS == 3) acc[a] = ZG[a * 64 + lane]; else acc[a] = (f32x4){0, 0, 0, 0};
#pragma unroll
        for (int e = 0; e < 4; ++e) accp[a][e] = (16 * a + 4 * fq + e == 16 * w + fr) ? 1.f : 0.f;
    }
    u32x4 pf[CPF][8]; u32x2 qf[CPF][4];
#pragma unroll
    for (int st = 0; st < CPF; ++st) if (n0 + st < n1) {
#pragma unroll
        for (int i = 0; i < 8; ++i) pf[st][i] = Pg[(size_t)(n0 + st) * 512 + i * 64 + lane];
#pragma unroll
        for (int a = 0; a < 4; ++a) qf[st][a] = Qg[(size_t)(n0 + st) * 1024 + (w * 4 + a) * 64 + lane];
    }
    for (int nb = n0; nb < n1; nb += CPF) {
#pragma unroll
        for (int st = 0; st < CPF; ++st) {
            const int n = nb + st;
            if (n < n1) {
                u32x4 pc[8]; u32x2 qc[4];
#pragma unroll
                for (int i = 0; i < 8; ++i) pc[i] = pf[st][i];
#pragma unroll
                for (int a = 0; a < 4; ++a) qc[a] = qf[st][a];
                if (n + CPF < n1) {
#pragma unroll
                    for (int i = 0; i < 8; ++i) pf[st][i] = Pg[(size_t)(n + CPF) * 512 + i * 64 + lane];
#pragma unroll
                    for (int a = 0; a < 4; ++a) qf[st][a] = Qg[(size_t)(n + CPF) * 1024 + (w * 4 + a) * 64 + lane];
                }
                const u32x4 z0 = packz(acc[0], acc[1]), z1 = packz(acc[2], acc[3]);
                if (PASS == 3) { Zg[((size_t)n * 4 + w) * 128 + lane] = z0; Zg[((size_t)n * 4 + w) * 128 + 64 + lane] = z1; }
                const bf16x8 zb0 = __builtin_bit_cast(bf16x8, z0), zb1 = __builtin_bit_cast(bf16x8, z1);
#pragma unroll
                for (int a = 0; a < 4; ++a) {
                    f32x4 ini = {bflo(qc[a].x), bfhi(qc[a].x), bflo(qc[a].y), bfhi(qc[a].y)};
                    ini = __builtin_amdgcn_mfma_f32_16x16x32_bf16(__builtin_bit_cast(bf16x8, pc[2 * a]), zb0, ini, 0, 0, 0);
                    acc[a] = __builtin_amdgcn_mfma_f32_16x16x32_bf16(__builtin_bit_cast(bf16x8, pc[2 * a + 1]), zb1, ini, 0, 0, 0);
                }
                if (PASS == 1) {
                    const bf16x8 yb0 = __builtin_bit_cast(bf16x8, packz(accp[0], accp[1])), yb1 = __builtin_bit_cast(bf16x8, packz(accp[2], accp[3]));
#pragma unroll
                    for (int a = 0; a < 4; ++a) {
                        f32x4 t4 = __builtin_amdgcn_mfma_f32_16x16x32_bf16(__builtin_bit_cast(bf16x8, pc[2 * a]), yb0, (f32x4){0, 0, 0, 0}, 0, 0, 0);
                        accp[a] = __builtin_amdgcn_mfma_f32_16x16x32_bf16(__builtin_bit_cast(bf16x8, pc[2 * a + 1]), yb1, t4, 0, 0, 0);
                    }
                }
            }
        }
    }
    if (PASS == 1) {
        f32x4* CQ = (f32x4*)(p.ws + OFF_CQ) + ((size_t)(chain * 16 + g) * 4 + w) * 256;
        bf16_t* CP = (bf16_t*)(p.ws + OFF_CP) + (size_t)(chain * 16 + g) * 4096;
#pragma unroll
        for (int a = 0; a < 4; ++a) {
            CQ[a * 64 + lane] = acc[a];
#pragma unroll
            for (int e = 0; e < 4; ++e) CP[(16 * a + 4 * fq + e) * 64 + 16 * w + fr] = (bf16_t)(pack2(accp[a][e], 0.f) & 0xffffu);
        }
    }
}
DI void chain_groups(const Params& p, int chain, char* lds) {
    const int tid = threadIdx.x, lane = tid & 63, w = tid >> 6, fr = lane & 15, fq = lane >> 4;
    {
        const char* src = (const char*)(p.ws + OFF_CP) + (size_t)chain * 16 * 8192;
#pragma unroll
        for (int i = 0; i < 16; ++i) glds16(src + (size_t)(i * NTH + tid) * 16, lds + (i * NTH + tid) * 16);
        asm volatile("s_waitcnt vmcnt(0)" ::: "memory");
        __syncthreads();
    }
    if (w >= 4) return;
    constexpr int QPF = 4;
    f32x4 acc[4], qf[QPF][4];
#pragma unroll
    for (int a = 0; a < 4; ++a) acc[a] = (f32x4){0, 0, 0, 0};
    const f32x4* CQ = (const f32x4*)(p.ws + OFF_CQ) + ((size_t)chain * 16 * 4 + w) * 256;
#pragma unroll
    for (int st = 0; st < QPF; ++st)
#pragma unroll
        for (int a = 0; a < 4; ++a) qf[st][a] = CQ[(size_t)st * 1024 + a * 64 + lane];
    for (int gb = 0; gb < 16; gb += QPF) {
#pragma unroll
        for (int st = 0; st < QPF; ++st) {
            const int g = gb + st;
            f32x4 qc[4];
#pragma unroll
            for (int a = 0; a < 4; ++a) qc[a] = qf[st][a];
            if (g + QPF < 16) {
#pragma unroll
                for (int a = 0; a < 4; ++a) qf[st][a] = CQ[(size_t)(g + QPF) * 1024 + a * 64 + lane];
            }
            f32x4* ZG = (f32x4*)(p.ws + OFF_ZG) + ((size_t)(chain * 16 + g) * 4 + w) * 256;
#pragma unroll
            for (int a = 0; a < 4; ++a) ZG[a * 64 + lane] = acc[a];
            const bf16x8 zb0 = __builtin_bit_cast(bf16x8, packz(acc[0], acc[1])), zb1 = __builtin_bit_cast(bf16x8, packz(acc[2], acc[3]));
            const bf16_t* CP = (const bf16_t*)lds + g * 4096;
#pragma unroll
            for (int a = 0; a < 4; ++a) {
                const bf16_t* s0 = CP + (16 * a + fr) * 64 + 4 * fq;
                const u32x2 l0 = *(const u32x2*)s0, h0 = *(const u32x2*)(s0 + 16), l1 = *(const u32x2*)(s0 + 32), h1 = *(const u32x2*)(s0 + 48);
                f32x4 ini = __builtin_amdgcn_mfma_f32_16x16x32_bf16(__builtin_bit_cast(bf16x8, (u32x4){l0.x, l0.y, h0.x, h0.y}), zb0, qc[a], 0, 0, 0);
                acc[a] = __builtin_amdgcn_mfma_f32_16x16x32_bf16(__builtin_bit_cast(bf16x8, (u32x4){l1.x, l1.y, h1.x, h1.y}), zb1, ini, 0, 0, 0);
            }
        }
    }
}

DI void phase_scanC(const Params& p, int bid, int nblk, char* lds) {
    const int lane = threadIdx.x & 63, w8 = threadIdx.x >> 6, w = w8 & 3, fr = lane & 15, fq = lane >> 4;
    bf16_t* mix = (bf16_t*)(p.ws + OFF_MIX);
    const float* dot = (const float*)(p.ws + OFF_DOT);
    for (int unit = bid * 2 + (w8 >> 2); unit < 256 * 8; unit += nblk * 2) {
        const int c = 4 + (unit >> 3), h = unit & 7;
        f32x4 y[4];
#pragma unroll
        for (int ni = 0; ni < 4; ++ni) y[ni] = (f32x4){0, 0, 0, 0};
#pragma unroll
        for (int dir = 0; dir < 2; ++dir) {
            const int chain = dir * 8 + h, npos = chain_pos(c, dir);
            const u32x4* Zg = (const u32x4*)(p.ws + OFF_Z) + ((size_t)chain * NCH + npos) * 512;
            const bf16_t* Wg = (const bf16_t*)(p.ws + OFF_WYT) + ((size_t)((c - 4) * 8 + h) * 2 + dir) * 4096;
            const u32x2* Yg = (const u32x2*)(p.ws + OFF_YL) + ((size_t)((c - 4) * 8 + h) * 2 + dir) * 1024;
            const int rho = 16 * w + fr, row = dir ? 63 - rho : rho;
            bf16x8 af[2];
#pragma unroll
            for (int s2 = 0; s2 < 2; ++s2) {
                const u32x2 lo = *(const u32x2*)(Wg + row * 64 + 32 * s2 + 4 * fq), hi = *(const u32x2*)(Wg + row * 64 + 32 * s2 + 16 + 4 * fq);
                af[s2] = __builtin_bit_cast(bf16x8, (u32x4){lo.x, lo.y, hi.x, hi.y});
            }
#pragma unroll
            for (int ni = 0; ni < 4; ++ni) {
                const u32x2 yl = Yg[(w * 4 + ni) * 64 + lane];
                f32x4 acc = {bflo(yl.x), bfhi(yl.x), bflo(yl.y), bfhi(yl.y)};
                acc = __builtin_amdgcn_mfma_f32_16x16x32_bf16(af[0], __builtin_bit_cast(bf16x8, Zg[(ni * 2 + 0) * 64 + lane]), acc, 0, 0, 0);
                acc = __builtin_amdgcn_mfma_f32_16x16x32_bf16(af[1], __builtin_bit_cast(bf16x8, Zg[(ni * 2 + 1) * 64 + lane]), acc, 0, 0, 0);
                y[ni] += acc;
            }
        }
        float* ty = (float*)lds + w8 * (16 * 68);
#pragma unroll
        for (int ni = 0; ni < 4; ++ni)
#pragma unroll
            for (int e = 0; e < 4; ++e) ty[(4 * fq + e) * 68 + 16 * ni + fr] = y[ni][e];
        asm volatile("s_waitcnt lgkmcnt(0)" ::: "memory"); __builtin_amdgcn_wave_barrier();
        {
            const int tl = lane >> 2, seg = lane & 3, t = (c - 4) * 64 + 16 * w + tl, g = t + CTX, cch = h * 64 + 16 * seg;
            float yv[16];
#pragma unroll
            for (int q = 0; q < 4; ++q) { const f32x4 v4 = *(const f32x4*)(ty + tl * 68 + 16 * seg + 4 * q); yv[4 * q] = v4[0]; yv[4 * q + 1] = v4[1]; yv[4 * q + 2] = v4[2]; yv[4 * q + 3] = v4[3]; }
            float sm = 0.f;
#pragma unroll
            for (int j = 0; j < 16; ++j) sm += yv[j];
            sm += __shfl_xor(sm, 1, 64); sm += __shfl_xor(sm, 2, 64);
            const float mean = sm * (1.f / 64.f);
            float q2 = 0.f;
#pragma unroll
            for (int j = 0; j < 16; ++j) { const float d = yv[j] - mean; q2 += d * d; }
            q2 += __shfl_xor(q2, 1, 64); q2 += __shfl_xor(q2, 2, 64);
            const float rs = rsqrtf(q2 * (1.f / 64.f) + 64e-5f);
            const float bon = dot[((size_t)g * 8 + h) * 2] + dot[((size_t)g * 8 + h) * 2 + 1];
            float vv[16], gg[16], o[16];
            unpack8(*(const u32x4*)((const bf16_t*)(p.ws + OFF_V) + (size_t)t * DR + cch), vv); unpack8(*(const u32x4*)((const bf16_t*)(p.ws + OFF_V) + (size_t)t * DR + cch + 8), vv + 8);
            unpack8(*(const u32x4*)((const bf16_t*)(p.ws + OFF_G) + (size_t)t * DR + cch), gg); unpack8(*(const u32x4*)((const bf16_t*)(p.ws + OFF_G) + (size_t)t * DR + cch + 8), gg + 8);
#pragma unroll
            for (int q = 0; q < 4; ++q) {
                const f32x4 gw = *(const f32x4*)(p.gn_w + cch + 4 * q), gb = *(const f32x4*)(p.gn_b + cch + 4 * q);
#pragma unroll
                for (int j = 0; j < 4; ++j) o[4 * q + j] = ((yv[4 * q + j] - mean) * rs * gw[j] + gb[j] + bon * vv[4 * q + j]) * gg[4 * q + j];
            }
            *(u32x4*)(mix + (size_t)t * D + cch) = pack8(o); *(u32x4*)(mix + (size_t)t * D + cch + 8) = pack8(o + 8);
        }
        __builtin_amdgcn_wave_barrier();
    }
}

struct EpiX2 { float* o; const float* x; const float* gt; const float* rowtab; const float* coltab; int row0, col0;
    DI f32x16 pre(const f32x16& a, const f32x16&) const { return a; }
    DI void post(int r, int c, const f32x4& v) const {
        const int t = row0 + r, d = col0 + c;
        const float* pt = d < 512 ? rowtab + (t >> 6) * 512 + d : coltab + (t & 63) * 512 + (d - 512);
        const f32x4 xv = *(const f32x4*)(x + (size_t)t * D + d), pv = *(const f32x4*)pt, gv = *(const f32x4*)(gt + d);
        *(f32x4*)(o + (size_t)t * D + d) = xv + pv + gv * v; } };
struct EpiNull { DI f32x16 pre(const f32x16& a, const f32x16&) const { return a; } DI void post(int, int, const f32x4& v) const { asm volatile("" :: "v"(v)); } };
DI void phase_g2_null(const Params& p, int bid, int nblk, char* lds) {
    const bf16_t* mix = (const bf16_t*)(p.ws + OFF_MIX);
    const XcdOrder ord(bid, nblk, 64 * 4);
    for (int i = 0, q; (q = ord.item(i)) >= 0; ++i) {
        int tm, tn; tile_rc(q, 64, 4, tm, tn);
        PlainA al{mix + (size_t)tm * 256 * D, D};
        EpiNull e;
        gemm8<1, true, 2>(al, (const bf16_t*)(p.ws + OFF_WOUTB) + tn * 256, nullptr, D, D, lds, e);
    }
}
DI void phase_g2(const Params& p, int bid, int nblk, char* lds) {
    const bf16_t* mix = (const bf16_t*)(p.ws + OFF_MIX);
    const XcdOrder ord(bid, nblk, 64 * 4);
    for (int i = 0, q; (q = ord.item(i)) >= 0; ++i) {
        int tm, tn; tile_rc(q, 64, 4, tm, tn);
        PlainA al{mix + (size_t)tm * 256 * D, D};
        EpiX2 e{(float*)(p.ws + OFF_X2), p.x, (const float*)(p.ws + OFF_MODX) + 2048, (const float*)(p.ws + OFF_ROWTAB), (const float*)(p.ws + OFF_COLTAB), tm * 256, tn * 256};
        gemm8<1, true, 2>(al, (const bf16_t*)(p.ws + OFF_WOUTB) + tn * 256, nullptr, D, D, lds, e);
    }
}

DI float router_w(const Params& p, int k, int n) { return n < 4 ? p.w_rg[k * 4 + n] : (n < 36 ? p.w_re[k * 32 + (n - 4)] : 0.f); }
DI void phase_router_prep(const Params& p, int bid, int nblk) {
    const float* modx = (const float*)(p.ws + OFF_MODX);
    float* wp = (float*)(p.ws + OFF_WP); float* b2 = (float*)(p.ws + OFF_B2);
    for (int idx = bid * NTH + threadIdx.x; idx < 64 * 4 * 3 * 64; idx += nblk * NTH) {
        const int ln = idx & 63, r = idx >> 6, nt = r % 3, me = r / 3, e = me & 3, m = me >> 2;
        const int k = 16 * m + 4 * (ln >> 4) + e, n = 16 * nt + (ln & 15);
        wp[idx] = p.norm2_g[k] * (1.f + modx[4096 + k]) * router_w(p, k, n);
    }
    const int lane = threadIdx.x & 63, wv = bid * NWV + (threadIdx.x >> 6);
    if (wv < 36) {
        float sacc = 0.f;
        for (int k = lane; k < D; k += 64) sacc += modx[3072 + k] * router_w(p, k, wv);
        sacc = wave_sum(sacc);
        if (lane == 0) b2[wv] = sacc + (wv < 4 ? p.b_rg[wv] : p.b_re[wv - 4]);
    }
}

DI void phase_router(const Params& p, int bid, int nblk, char* lds, bool dry = false) {
    const int lane = threadIdx.x & 63, wid = threadIdx.x >> 6, tr = lane & 15, kq = lane >> 4;
    const float* x2 = (const float*)(p.ws + OFF_X2); const float* modx = (const float*)(p.ws + OFF_MODX);
    const float* wp = (const float*)(p.ws + OFF_WP); const float* b2 = (const float*)(p.ws + OFF_B2);
    bf16_t* h2 = (bf16_t*)(p.ws + OFF_H2); int* cnt = (int*)(p.ws + OFF_CNT); float* gate = (float*)(p.ws + OFF_GATE); int* list = (int*)(p.ws + OFF_LIST);
    float* slog = (float*)lds + wid * (16 * 49);
    for (int task = wid * nblk + bid; task < S / 16; task += nblk * NWV) {
        const int t0 = task * 16;
        const float* xr = x2 + (size_t)(t0 + tr) * D + 4 * kq;
        f32x4 acc[3];
#pragma unroll
        for (int i = 0; i < 3; ++i) acc[i] = (f32x4){0, 0, 0, 0};
        float ss = 0.f;
#pragma unroll 4
        for (int m = 0; m < 64; ++m) {
            const f32x4 xv = *(const f32x4*)(xr + 16 * m);
            ss += xv[0] * xv[0] + xv[1] * xv[1] + xv[2] * xv[2] + xv[3] * xv[3];
#pragma unroll
            for (int e = 0; e < 4; ++e)
#pragma unroll
                for (int nt = 0; nt < 3; ++nt) acc[nt] = __builtin_amdgcn_mfma_f32_16x16x4f32(xv[e], wp[((m * 4 + e) * 3 + nt) * 64 + lane], acc[nt], 0, 0, 0);
        }
        ss += __shfl_xor(ss, 16, 64); ss += __shfl_xor(ss, 32, 64);
        const float rstd = rsqrtf(ss * (1.f / 1024.f) + 1e-6f);
#pragma unroll
        for (int nt = 0; nt < 3; ++nt)
#pragma unroll
            for (int r = 0; r < 4; ++r) slog[(4 * kq + r) * 49 + 16 * nt + tr] = acc[nt][r];
        asm volatile("s_waitcnt lgkmcnt(0)" ::: "memory"); __builtin_amdgcn_wave_barrier();
        if (lane < 16) {
            const int t = t0 + lane;
            const float* lg = slog + lane * 49;
            const float l0 = rstd * lg[0] + b2[0], l1 = rstd * lg[1] + b2[1], l2 = rstd * lg[2] + b2[2], l3 = rstd * lg[3] + b2[3];
            int grp = 0; float mx = l0;
            if (l1 > mx) { mx = l1; grp = 1; }
            if (l2 > mx) { mx = l2; grp = 2; }
            if (l3 > mx) { mx = l3; grp = 3; }
            const float den = __expf(l0 - mx) + __expf(l1 - mx) + __expf(l2 - mx) + __expf(l3 - mx);
            const float pgrp = 1.f / den;
            int i1 = 0, i2 = -1; float v1 = -3.0e38f, v2 = -3.0e38f;
            for (int n = 0; n < 8; ++n) {
                const float sv = rstd * lg[4 + grp * 8 + n] + b2[4 + grp * 8 + n];
                if (sv > v1) { v2 = v1; i2 = i1; v1 = sv; i1 = n; } else if (sv > v2) { v2 = sv; i2 = n; }
            }
            const float e2 = __expf(v2 - v1), g1 = pgrp / (1.f + e2), g2v = pgrp * e2 / (1.f + e2);
            const int ea = grp * 8 + i1, eb = grp * 8 + i2;
            if (!dry) {
                const int pa = atomicAdd(&cnt[ea], 1), pb = atomicAdd(&cnt[eb], 1);
                list[ea * LCAP + pa] = t * 2; list[eb * LCAP + pb] = t * 2 + 1;
            }
            gate[t * 2] = g1; gate[t * 2 + 1] = g2v;
        }
        for (int r = 0; r < 16; ++r) {
            const float rs = __shfl(rstd, r, 64);
            const float* src = x2 + (size_t)(t0 + r) * D;
#pragma unroll
            for (int i = 0; i < 4; ++i) {
                const int d = (i * 64 + lane) * 4;
                const f32x4 v = *(const f32x4*)(src + d), gg = *(const f32x4*)(p.norm2_g + d), sh = *(const f32x4*)(modx + 3072 + d), sc = *(const f32x4*)(modx + 4096 + d);
                f32x4 hv;
#pragma unroll
                for (int j = 0; j < 4; ++j) hv[j] = (v[j] * rs * gg[j]) * (1.f + sc[j]) + sh[j];
                u32x2 pk = {pack2(hv[0], hv[1]), pack2(hv[2], hv[3])};
                *(u32x2*)(h2 + (size_t)(t0 + r) * D + d) = pk;
            }
        }
        __builtin_amdgcn_wave_barrier();
    }
}

DI void moe_tiles(const int* cnt, int* tstart  ) {
    if (threadIdx.x == 0) { int acc = 0; for (int e = 0; e < NE; ++e) { tstart[e] = acc; acc += (cnt[e] + 255) >> 8; } tstart[NE] = acc; }
    __syncthreads();
}
struct EpiHid { bf16_t* o;
    DI f32x16 pre(const f32x16& g, const f32x16& u) const { f32x16 h;
#pragma unroll
        for (int j = 0; j < 16; ++j) h[j] = g[j] * sigmoidf_(g[j]) * u[j];
        return h; }
    DI void post(int r, int c, const f32x4& v) const { u32x2 pk = {pack2(v[0], v[1]), pack2(v[2], v[3])}; *(u32x2*)(o + (size_t)r * DE + c) = pk; } };
DI void phase_g3(const Params& p, int bid, int nblk, char* lds) {
    int* tstart = (int*)(lds + GEMM_LDS);
    const int* cnt = (const int*)(p.ws + OFF_CNT); const int* list = (const int*)(p.ws + OFF_LIST);
    const bf16_t* h2 = (const bf16_t*)(p.ws + OFF_H2); bf16_t* hid = (bf16_t*)(p.ws + OFF_HID);
    moe_tiles(cnt, tstart);
    const int ntiles = tstart[NE];
    const XcdOrder ord(bid, nblk, ntiles * 4);
    for (int i = 0, item; (item = ord.item(i)) >= 0; ++i) {
        const int ti = item >> 2, cj = item & 3;
        int e = 0; while (e < NE - 1 && tstart[e + 1] <= ti) ++e;
        const int lt = ti - tstart[e], ne = cnt[e];
        GatherA al;
#pragma unroll
        for (int i = 0; i < 4; ++i) { const int row = (8 * i + (threadIdx.x >> 6)) * 8 + ((threadIdx.x & 63) >> 3), pos = lt * 256 + row; const int tok = pos < ne ? (list[e * LCAP + pos] >> 1) : 0; al.rp[i] = h2 + (size_t)tok * D; }
        EpiHid epi{hid + (size_t)ti * 256 * DE + cj * 128};
        gemm8<2, false, 1>(al, p.w_gate + (size_t)e * D * DE + cj * 128, p.w_up + (size_t)e * D * DE + cj * 128, DE, D, lds, epi);
    }
}
struct EpiDown { bf16_t* ybuf; const int* lst; const float* gate; int nvalid; int col0;
    DI f32x16 pre(const f32x16& a, const f32x16&) const { return a; }
    DI void post(int r, int c, const f32x4& v) const {
        if (r >= nvalid) return; const int slot = lst[r]; const float g = gate[slot];
        u32x2 pk = {pack2(v[0] * g, v[1] * g), pack2(v[2] * g, v[3] * g)}; *(u32x2*)(ybuf + (size_t)slot * D + col0 + c) = pk; } };
DI void phase_g4(const Params& p, int bid, int nblk, char* lds) {
    int* tstart = (int*)(lds + GEMM_LDS);
    const int* cnt = (const int*)(p.ws + OFF_CNT); const int* list = (const int*)(p.ws + OFF_LIST);
    const bf16_t* hid = (const bf16_t*)(p.ws + OFF_HID);
    moe_tiles(cnt, tstart);
    const int ntiles = tstart[NE];
    const XcdOrder ord(bid, nblk, ntiles * 8);
    for (int i = 0, item; (item = ord.item(i)) >= 0; ++i) {
        const int ti = item >> 3, cj = item & 7;
        int e = 0; while (e < NE - 1 && tstart[e + 1] <= ti) ++e;
        const int lt = ti - tstart[e], ne = cnt[e];
        PlainA al{hid + (size_t)ti * 256 * DE, DE};
        EpiDown epi{(bf16_t*)(p.ws + OFF_YBUF), list + e * LCAP + lt * 256, (const float*)(p.ws + OFF_GATE), ne - lt * 256, cj * 128};
        gemm8<1, false, 1>(al, p.w_down + (size_t)e * DE * D + cj * 128, nullptr, D, DE, lds, epi);
    }
}

DI void phase_final(const Params& p, int bid, int nblk) {
    const int lane = threadIdx.x & 63, wid = threadIdx.x >> 6;
    const float* x2 = (const float*)(p.ws + OFF_X2); const float* gt = (const float*)(p.ws + OFF_MODX) + 5120; const bf16_t* yb = (const bf16_t*)(p.ws + OFF_YBUF);
    for (int tp = bid * NWV + wid; tp < S / 2; tp += nblk * NWV) {
        f32x4 v[2][4]; float ss[2] = {0.f, 0.f};
        u32x2 ya[2][4], ybv[2][4];
#pragma unroll
        for (int r = 0; r < 2; ++r)
#pragma unroll
            for (int i = 0; i < 4; ++i) {
                const int t = 2 * tp + r, d = (i * 64 + lane) * 4;
                v[r][i] = *(const f32x4*)(x2 + (size_t)t * D + d);
                ya[r][i] = *(const u32x2*)(yb + (size_t)(2 * t) * D + d); ybv[r][i] = *(const u32x2*)(yb + (size_t)(2 * t + 1) * D + d);
            }
#pragma unroll
        for (int r = 0; r < 2; ++r)
#pragma unroll
            for (int i = 0; i < 4; ++i) {
                const int d = (i * 64 + lane) * 4; const f32x4 g = *(const f32x4*)(gt + d); const u32x2 a = ya[r][i], b = ybv[r][i];
                v[r][i][0] += g[0] * (bflo(a.x) + bflo(b.x)); v[r][i][1] += g[1] * (bfhi(a.x) + bfhi(b.x));
                v[r][i][2] += g[2] * (bflo(a.y) + bflo(b.y)); v[r][i][3] += g[3] * (bfhi(a.y) + bfhi(b.y));
                ss[r] += v[r][i][0] * v[r][i][0] + v[r][i][1] * v[r][i][1] + v[r][i][2] * v[r][i][2] + v[r][i][3] * v[r][i][3];
            }
#pragma unroll
        for (int r = 0; r < 2; ++r) {
            const float rstd = rsqrtf(wave_sum(ss[r]) * (1.f / 1024.f) + 1e-6f);
#pragma unroll
            for (int i = 0; i < 4; ++i) {
                const int d = (i * 64 + lane) * 4; const f32x4 fg = *(const f32x4*)(p.final_g + d); f32x4 o;
#pragma unroll
                for (int j = 0; j < 4; ++j) o[j] = v[r][i][j] * rstd * fg[j];
                *(f32x4*)(p.out + (size_t)(2 * tp + r) * D + d) = o;
            }
        }
    }
}

#define XB_TMO      128
#define XB_XCNT(j)  (256  + 64 * (j))
#define XB_XSUB(j)  (1280 + 64 * (j))
#define XB_XGEN(j)  (2304 + 64 * (j))
#define XB_TOP      3328
#define XB_TOPGEN   3392
#define XCD_BAR_WORDS 3456
#define XB_SPIN_CAP (1u << 18)
DI unsigned xb_ld(unsigned* p) { return __hip_atomic_load(p, __ATOMIC_RELAXED, __HIP_MEMORY_SCOPE_AGENT); }
DI unsigned xb_add(unsigned* p, unsigned v) { return __hip_atomic_fetch_add(p, v, __ATOMIC_RELAXED, __HIP_MEMORY_SCOPE_AGENT); }
DI unsigned xb_xcc_id() { return (unsigned)__builtin_amdgcn_s_getreg((3 << 11) | 20) & 0xFu; }
#define XB_SPIN(cond, bar) do { unsigned _sp = 0; while (cond) { __builtin_amdgcn_s_sleep(1); \
    if ((++_sp & 255u) == 0u) { if (xb_ld(&(bar)[XB_TMO])) break; if (_sp > XB_SPIN_CAP) { atomicAdd(&(bar)[XB_TMO], 1u); break; } } } } while (0)
struct XcdBarrier { unsigned* bar; unsigned x; volatile LAS unsigned* st; };
DI XcdBarrier xcd_barrier_post(unsigned* bar, volatile LAS unsigned* st) {
    XcdBarrier b; b.bar = bar; b.x = xb_xcc_id(); b.st = st;
    if (threadIdx.x == 0) (void)xb_add(&bar[XB_XCNT(b.x)], 1u);
    return b;
}
DI void xcd_barrier_complete(unsigned* bar, unsigned x, unsigned& nloc, unsigned& nx) {
    const unsigned G = gridDim.x * gridDim.y * gridDim.z;
    unsigned sum, cnt, mine, sp = 0u;
    for (;;) {
        sum = 0u; cnt = 0u; mine = 0u;
#pragma unroll
        for (unsigned j = 0; j < 16; ++j) { const unsigned c = xb_ld(&bar[XB_XCNT(j)]); sum += c; cnt += (c > 0u) ? 1u : 0u; mine = (j == x) ? c : mine; }
        if (sum == G) break;
        __builtin_amdgcn_s_sleep(1);
        if ((++sp & 255u) == 0u) { if (xb_ld(&bar[XB_TMO])) break; if (sp > XB_SPIN_CAP) { atomicAdd(&bar[XB_TMO], 1u); break; } }
    }
    nloc = mine > 0u ? mine : 1u; nx = cnt > 0u ? cnt : 1u;
}
DI void xcd_barrier(const XcdBarrier& b) {
    asm volatile("s_waitcnt vmcnt(0)" ::: "memory");
    __syncthreads();
    if (threadIdx.x == 0) {
        unsigned* bar = b.bar;
        __builtin_amdgcn_s_waitcnt(0);
        unsigned nloc = b.st[0], nx = b.st[1];
        if (nloc == 0u) { xcd_barrier_complete(bar, b.x, nloc, nx); b.st[0] = nloc; b.st[1] = nx; }
        const unsigned old = xb_add(&bar[XB_XSUB(b.x)], 1u);
        const unsigned gen = old / nloc;
        if (old + 1u == (gen + 1u) * nloc) {
            __builtin_amdgcn_fence(__ATOMIC_RELEASE, "agent");
            asm volatile("s_waitcnt vmcnt(0)" ::: "memory");
            const unsigned og = xb_add(&bar[XB_TOP], 1u);
            const unsigned tg = og / nx;
            if (og + 1u == (tg + 1u) * nx) xb_add(&bar[XB_TOPGEN], 1u);
            else XB_SPIN(xb_ld(&bar[XB_TOPGEN]) == tg, bar);
            __builtin_amdgcn_fence(__ATOMIC_ACQUIRE, "agent");
            xb_add(&bar[XB_XGEN(b.x)], 1u);
            asm volatile("s_waitcnt vmcnt(0)" ::: "memory");
        } else {
            XB_SPIN(xb_ld(&bar[XB_XGEN(b.x)]) == gen, bar);
            __builtin_amdgcn_fence(__ATOMIC_ACQUIRE, "agent");
            asm volatile("s_waitcnt vmcnt(0)" ::: "memory");
        }
    }
    __syncthreads();
}

#ifndef PROBE
#define PROBE 0
#endif
constexpr int MEGA_LDS = SCANA_LDS > (GEMM_LDS + 256) ? SCANA_LDS : (GEMM_LDS + 256);
__global__ void __launch_bounds__(NTH) k_mega(Params p) {
    extern __shared__ __attribute__((aligned(16))) char lds[];
    const int bid = blockIdx.x, nblk = gridDim.x;
    volatile LAS unsigned* st = (volatile LAS unsigned*)(lds + MEGA_LDS);
    if (threadIdx.x < 4) st[threadIdx.x] = 0u;
    __syncthreads();
    const XcdBarrier gb = xcd_barrier_post((unsigned*)(p.ws + OFF_BAR), st);
#define GSYNC() xcd_barrier(gb)
    phase_p0(p, bid, nblk, lds); GSYNC();
    phase_xn(p, bid, nblk); phase_router_prep(p, bid, nblk); GSYNC();
    if (PROBE == 2) { phase_xn(p, bid, nblk); GSYNC(); }
    phase_g1(p, bid, nblk, lds); GSYNC();
    if (PROBE == 3) { phase_g1(p, bid, nblk, lds); GSYNC(); }
    phase_pool(p, bid, nblk);
    phase_scanA(p, bid, nblk, lds); GSYNC();
    if (PROBE == 4) { phase_scanA(p, bid, nblk, lds); GSYNC(); }
    if (threadIdx.x < 256) for (int it = bid; it < 256; it += nblk) chain_run<1>(p, it >> 4, it & 15);
    GSYNC();
    if (PROBE == 5) { if (threadIdx.x < 256) for (int it = bid; it < 256; it += nblk) chain_run<1>(p, it >> 4, it & 15); GSYNC(); }
    if (bid < 16) chain_groups(p, bid, lds); else phase_poolgemm(p, bid - 16, nblk - 16, lds);
    GSYNC();
    if (PROBE == 6) { if (bid < 16) chain_groups(p, bid, lds); GSYNC(); }
    if (threadIdx.x < 256) for (int it = bid; it < 256; it += nblk) chain_run<3>(p, it >> 4, it & 15);
    GSYNC();
    if (PROBE == 7) { if (threadIdx.x < 256) for (int it = bid; it < 256; it += nblk) chain_run<3>(p, it >> 4, it & 15); GSYNC(); }
    phase_scanC(p, bid, nblk, lds); GSYNC();
    if (PROBE == 8) { phase_scanC(p, bid, nblk, lds); GSYNC(); }
    phase_g2(p, bid, nblk, lds); GSYNC();
    if (PROBE == 9) { phase_g2(p, bid, nblk, lds); GSYNC(); }
    if (PROBE == 14) { phase_g2_null(p, bid, nblk, lds); GSYNC(); }
    if (PROBE == 10) { phase_router(p, bid, nblk, lds, true); GSYNC(); }
    phase_router(p, bid, nblk, lds); GSYNC();
    phase_g3(p, bid, nblk, lds); GSYNC();
    if (PROBE == 11) { phase_g3(p, bid, nblk, lds); GSYNC(); }
    phase_g4(p, bid, nblk, lds); GSYNC();
    if (PROBE == 12) { phase_g4(p, bid, nblk, lds); GSYNC(); }
    if (PROBE == 13) { phase_final(p, bid, nblk); GSYNC(); }
    phase_final(p, bid, nblk);
}

extern "C" void kernel_launch(void* const* d_in, const int* in_sizes, int n_in, void* d_out, int out_size, void* d_ws, size_t ws_size, hipStream_t stream) {
    if (ws_size < WS_NEED) { fprintf(stderr, "workspace too small: %zu < %zu\n", ws_size, (size_t)WS_NEED); return; }
    Params p{};
    const float** f = (const float**)&p;
    for (int i = 0; i < 36; ++i) f[i] = (const float*)d_in[i];
    p.out = (float*)d_out; p.ws = (char*)d_ws;
    static int grid_blocks = 0;
    if (!grid_blocks) {
        (void)hipFuncSetAttribute((const void*)k_mega, hipFuncAttributeMaxDynamicSharedMemorySize, MEGA_LDS + 16);
        int dev = 0, cus = 0, per_cu = 0;
        (void)hipGetDevice(&dev);
        (void)hipDeviceGetAttribute(&cus, hipDeviceAttributeMultiprocessorCount, dev);
        (void)hipOccupancyMaxActiveBlocksPerMultiprocessor(&per_cu, k_mega, NTH, MEGA_LDS + 16);
        if (per_cu > 1) per_cu = 1;
        grid_blocks = cus * per_cu;
    }
    (void)hipMemsetAsync((char*)d_ws + OFF_BAR, 0, 16384, stream);
    void* args[] = {&p};
    hipError_t e = hipLaunchCooperativeKernel((const void*)k_mega, dim3(grid_blocks), dim3(NTH), args, MEGA_LDS + 16, stream);
    if (e != hipSuccess) fprintf(stderr, "cooperative launch failed: %s (grid %d)\n", hipGetErrorString(e), grid_blocks);
}
```

```cpp
#include <hip/hip_runtime.h>
#include <stdint.h>
#include <stdio.h>
#include <hip/hip_cooperative_groups.h>
namespace cg = cooperative_groups;

#define DI __device__ __forceinline__
typedef unsigned short bf16_t;
typedef short bf16x8 __attribute__((ext_vector_type(8)));
typedef short s16x4 __attribute__((ext_vector_type(4)));
typedef float f32x4 __attribute__((ext_vector_type(4)));
typedef float f32x2 __attribute__((ext_vector_type(2)));
typedef __bf16 bf16x2_t __attribute__((ext_vector_type(2)));
typedef unsigned u32x4 __attribute__((ext_vector_type(4)));
typedef unsigned u32x2 __attribute__((ext_vector_type(2)));
#define LAS __attribute__((address_space(3)))

constexpr int D = 1024, S = 16384, CTX = 256, NT = S + CTX, DIN = 2432, DSH = 1920, DR = 512;
constexpr int C_WLF = 1536, C_WLB = 1600, C_ALF = 1664, C_ALB = 1728, C_GL = 1792, C_POOL = 1920;
constexpr int NE = 32, DE = 512, LCAP = 32768;
constexpr float DECAY_SCALE = 0.6065306597f;
constexpr int NTH = 512, NWV = 8;

constexpr int NCH = NT / 64;
constexpr size_t SZ_U = (size_t)NT * DIN * 2;
constexpr size_t SZ_CH = (size_t)16 * NCH * 8192;
constexpr size_t OFF_U = 0;
constexpr size_t OFF_XN = OFF_U + SZ_U;
constexpr size_t OFF_P = OFF_XN;
constexpr size_t OFF_Q = OFF_P + SZ_CH;
constexpr size_t OFF_WYT = OFF_Q + SZ_CH;
constexpr size_t OFF_YL = OFF_WYT + (size_t)256 * 16 * 8192;
constexpr size_t OFF_V = OFF_YL + (size_t)256 * 16 * 8192;
constexpr size_t OFF_G = OFF_V + (size_t)S * DR * 2;
constexpr size_t OFF_MIX = OFF_G + (size_t)S * DR * 2;
constexpr size_t OFF_SMALL = OFF_MIX + (size_t)S * D * 2;
constexpr size_t OFF_MODX = OFF_SMALL, OFF_MODC = OFF_MODX + 6144 * 4;
constexpr size_t OFF_ROWTAB = OFF_MODC + 6144 * 4, OFF_COLTAB = OFF_ROWTAB + 256 * 512 * 4;
constexpr size_t OFF_CNT = OFF_COLTAB + 64 * 512 * 4;
constexpr size_t OFF_GATE = OFF_CNT + 256;
constexpr size_t OFF_LIST = OFF_GATE + (size_t)S * 2 * 4;
constexpr size_t OFF_DOT = OFF_LIST + (size_t)NE * LCAP * 4;
constexpr size_t OFF_WP = OFF_DOT + (size_t)NT * 16 * 4;
constexpr size_t OFF_B2 = OFF_WP + 64 * 4 * 3 * 64 * 4;
constexpr size_t OFF_BAR = OFF_B2 + 256;
constexpr size_t OFF_WINB = OFF_BAR + 16384;
constexpr size_t OFF_WOUTB = OFF_WINB + (size_t)D * DIN * 2;
constexpr size_t WS_NEED = OFF_WOUTB + (size_t)D * D * 2;
constexpr size_t OFF_Z = OFF_U;
constexpr size_t OFF_X2 = OFF_P;
constexpr size_t OFF_YBUF = OFF_WYT;
constexpr size_t OFF_H2 = OFF_U;
constexpr size_t OFF_HID = OFF_U + SZ_CH;
constexpr size_t OFF_CP = OFF_U + SZ_CH;
constexpr size_t OFF_CQ = OFF_CP + 256 * 8192;
constexpr size_t OFF_ZG = OFF_CQ + 256 * 16384;

struct Params {
    const float *x, *c, *ctx, *c_ctx, *norm1_g, *w_mod, *b_mod, *w_in, *mu, *w0_f, *w2_f, *w0_b, *w2_b, *a0_f, *a2_f, *a0_b, *a2_b,
        *g2, *k_k, *k_a, *r_k_f, *r_k_b, *gn_w, *gn_b, *w_pool, *pool_scale, *w_out, *norm2_g, *w_rg, *b_rg, *w_re, *b_re,
        *w_gate, *w_up, *w_down, *final_g;
    float* out;
    char* ws;
};

DI unsigned pack2(float lo, float hi) { f32x2 v = {lo, hi}; bf16x2_t b = __builtin_convertvector(v, bf16x2_t); return __builtin_bit_cast(unsigned, b); }
DI float bf2f(bf16_t h) { return __uint_as_float(((unsigned)h) << 16); }
DI float bflo(unsigned u) { return __uint_as_float(u << 16); }
DI float bfhi(unsigned u) { return __uint_as_float(u & 0xffff0000u); }
DI void unpack8(const u32x4& p, float* f) { f[0] = bflo(p.x); f[1] = bfhi(p.x); f[2] = bflo(p.y); f[3] = bfhi(p.y); f[4] = bflo(p.z); f[5] = bfhi(p.z); f[6] = bflo(p.w); f[7] = bfhi(p.w); }
DI u32x4 pack8(const float* f) { u32x4 p; p.x = pack2(f[0], f[1]); p.y = pack2(f[2], f[3]); p.z = pack2(f[4], f[5]); p.w = pack2(f[6], f[7]); return p; }
DI float sigmoidf_(float x) { return 1.f / (1.f + __expf(-x)); }
DI float wave_sum(float v) {
#pragma unroll
    for (int o = 32; o > 0; o >>= 1) v += __shfl_xor(v, o, 64);
    return v;
}
DI f32x4 wave_sum4(f32x4 v) {
#pragma unroll
    for (int o = 32; o > 0; o >>= 1) { v[0] += __shfl_xor(v[0], o, 64); v[1] += __shfl_xor(v[1], o, 64); v[2] += __shfl_xor(v[2], o, 64); v[3] += __shfl_xor(v[3], o, 64); }
    return v;
}
typedef float f32x16 __attribute__((ext_vector_type(16)));
DI f32x16 zero16() { f32x16 z; for (int i = 0; i < 16; ++i) z[i] = 0.f; return z; }
DI s16x4 tr16(const bf16_t* a) { return __builtin_amdgcn_ds_read_tr16_b64_v4i16((LAS s16x4*)a); }
DI float pos_val(const float* rowtab, const float* coltab, int t, int d) { return d < 512 ? rowtab[(t >> 6) * 512 + d] : coltab[(t & 63) * 512 + (d - 512)]; }

DI void phase_p0(const Params& p, int bid, int nblk, char* lds) {
    const int tid = threadIdx.x;
    float* modx = (float*)(p.ws + OFF_MODX); float* modc = (float*)(p.ws + OFF_MODC);
    float* red = (float*)lds;
    for (int item = bid; item < 96; item += nblk) {
        const int col0 = item * 64, cg = tid & 15, kg = tid >> 4;
        f32x4 ax = {0, 0, 0, 0}, ac = {0, 0, 0, 0};
        for (int kk = 0; kk < 32; ++kk) {
            const int k = kg * 32 + kk;
            const float cv = p.c[k], cc = p.c_ctx[k];
            const float sx = cv * sigmoidf_(cv), sc = cc * sigmoidf_(cc);
            const f32x4 w = *(const f32x4*)(p.w_mod + (size_t)k * 6144 + col0 + cg * 4);
            ax += w * sx; ac += w * sc;
        }
        __syncthreads();
#pragma unroll
        for (int j = 0; j < 4; ++j) { red[(kg * 64 + cg * 4 + j) * 2] = ax[j]; red[(kg * 64 + cg * 4 + j) * 2 + 1] = ac[j]; }
        __syncthreads();
        if (tid < 128) {
            const int col = tid & 63, which = tid >> 6;
            float s = 0.f;
            for (int g = 0; g < 32; ++g) s += red[(g * 64 + col) * 2 + which];
            s += p.b_mod[col0 + col];
            (which ? modc : modx)[col0 + col] = s;
        }
    }
    float* rowtab = (float*)(p.ws + OFF_ROWTAB); float* coltab = (float*)(p.ws + OFF_COLTAB);
    for (int i = bid * NTH + tid; i < (256 + 64) * 256; i += nblk * NTH) {
        const int pos = i >> 8, f = i & 255;
        const float freq = powf(10000.f, -(float)f / 256.f);
        if (pos < 256) { const float a = (float)pos * freq; rowtab[pos * 512 + f] = sinf(a); rowtab[pos * 512 + 256 + f] = cosf(a); }
        else { const int cp = pos - 256; const float a = (float)cp * freq; coltab[cp * 512 + f] = sinf(a); coltab[cp * 512 + 256 + f] = cosf(a); }
    }
    if (bid == 0 && tid < 64) ((int*)(p.ws + OFF_CNT))[tid] = 0;
    for (int pass = 0; pass < 2; ++pass) {
        const float* src = pass ? p.w_out : p.w_in; const int nc = pass ? D : DIN; bf16_t* dst = (bf16_t*)(p.ws + (pass ? OFF_WOUTB : OFF_WINB));
        const int n8 = nc >> 3;
        for (int idx = bid * NTH + tid; idx < D * n8; idx += nblk * NTH) {
            const int k = idx / n8, g8 = idx - k * n8, blk = g8 >> 2, q = g8 & 3;
            const f32x4 lo = *(const f32x4*)(src + (size_t)k * nc + blk * 32 + 4 * q), hi = *(const f32x4*)(src + (size_t)k * nc + blk * 32 + 16 + 4 * q);
            *(u32x4*)(dst + (size_t)k * nc + blk * 32 + 8 * q) = (u32x4){pack2(lo[0], lo[1]), pack2(lo[2], lo[3]), pack2(hi[0], hi[1]), pack2(hi[2], hi[3])};
        }
    }
}

DI void phase_xn(const Params& p, int bid, int nblk) {
    const int lane = threadIdx.x & 63, wid = threadIdx.x >> 6;
    const float* modx = (const float*)(p.ws + OFF_MODX); const float* modc = (const float*)(p.ws + OFF_MODC);
    const float* rowtab = (const float*)(p.ws + OFF_ROWTAB); const float* coltab = (const float*)(p.ws + OFF_COLTAB);
    bf16_t* xn = (bf16_t*)(p.ws + OFF_XN);
    for (int gp = bid * NWV + wid; gp < NT / 2; gp += nblk * NWV) {
        const int g0 = 2 * gp; const bool isctx = g0 < CTX;
        const float* md = isctx ? modc : modx;
        f32x4 v[2][4]; float ss[2] = {0.f, 0.f};
#pragma unroll
        for (int r = 0; r < 2; ++r)
#pragma unroll
            for (int i = 0; i < 4; ++i) {
                const int g = g0 + r, t = g - CTX, d = (i * 64 + lane) * 4;
                const float* src = isctx ? p.ctx + (size_t)g * D : p.x + (size_t)t * D;
                v[r][i] = *(const f32x4*)(src + d);
                if (!isctx) v[r][i] += *(const f32x4*)(d < 512 ? rowtab + (t >> 6) * 512 + d : coltab + (t & 63) * 512 + (d - 512));
                ss[r] += v[r][i][0] * v[r][i][0] + v[r][i][1] * v[r][i][1] + v[r][i][2] * v[r][i][2] + v[r][i][3] * v[r][i][3];
            }
#pragma unroll
        for (int r = 0; r < 2; ++r) {
            const float rstd = rsqrtf(wave_sum(ss[r]) * (1.f / 1024.f) + 1e-6f);
#pragma unroll
            for (int i = 0; i < 4; ++i) {
                const int d = (i * 64 + lane) * 4;
                const f32x4 gg = *(const f32x4*)(p.norm1_g + d), sh = *(const f32x4*)(md + d), sc = *(const f32x4*)(md + 1024 + d);
                f32x4 o;
#pragma unroll
                for (int j = 0; j < 4; ++j) o[j] = (v[r][i][j] * rstd * gg[j]) * (1.f + sc[j]) + sh[j];
                u32x2 pk = {pack2(o[0], o[1]), pack2(o[2], o[3])};
                *(u32x2*)(xn + (size_t)(g0 + r) * D + d) = pk;
            }
        }
    }
}

constexpr int GA_SZ = 256 * 128, GB_SZ = 34816, GBUF_SZ = GA_SZ + GB_SZ;
constexpr int GEMM_LDS = 2 * GBUF_SZ;
DI void glds16(const void* gsrc, char* ldst) { __builtin_amdgcn_global_load_lds((const unsigned*)gsrc, (LAS unsigned*)ldst, 16, 0, 0); }
template <int NB, bool BGLDS, int NBLK, class AL, class EPI, int MB = 4>
DI void gemm8(const AL& al, const void* __restrict__ Bv0, const void* __restrict__ Bv1, int ldb, int K, char* lds, EPI& epi) {
    static_assert(!(BGLDS && NB == 2) && !(NB == 2 && NBLK == 2), "unsupported combination");
    constexpr int WN = 32 * NBLK, BN = 4 * WN;
    constexpr int RB = BN * 2;
    constexpr int BP = BN + 8;
    constexpr int NF4 = BN / 4;
    constexpr int NLD = (64 * NF4) / NTH;
    constexpr int NPB = (64 * RB) / (1024 * NWV);
    int tid = threadIdx.x; asm volatile("" : "+v"(tid));
    const int lane = tid & 63, wid = __builtin_amdgcn_readfirstlane(tid >> 6), wr = wid >> 2, wc = wid & 3, r32 = lane & 31, hh = lane >> 5, gi = lane >> 4, i16 = lane & 15;
    const float* B0 = (const float*)Bv0; const float* B1 = (const float*)Bv1; const bf16_t* Bb = (const bf16_t*)Bv0;
    f32x16 acc0[MB][NBLK], acc1[MB][NBLK];
#pragma unroll
    for (int m = 0; m < MB; ++m)
#pragma unroll
        for (int n = 0; n < NBLK; ++n) { acc0[m][n] = zero16(); acc1[m][n] = zero16(); }
    f32x4 rb0[NLD], rb1[NLD];
    const int T = K >> 6;
    const bf16_t* arow[MB];
#pragma unroll
    for (int i = 0; i < MB; ++i) { const int row = (8 * i + wid) * 8 + (lane >> 3); arow[i] = al.rowptr(i, row) + (((lane & 7) ^ ((row >> 1) & 7)) << 3); }
    int bsrc[NPB];
#pragma unroll
    for (int i = 0; i < NPB; ++i) { const int k = (8 * i + wid) * (1024 / RB) + lane / (RB / 16), pp = lane % (RB / 16); bsrc[i] = k * ldb + ((((pp >> 1) ^ (k & 7)) << 1) + (pp & 1)) * 8; }
    const int a_base = (wr * (32 * MB) + r32) * 128, a_sw = (r32 >> 1) & 7;
    const int b_off = (8 * (gi >> 1) + (i16 >> 2)) * BP + wc * WN + 16 * (gi & 1) + 4 * (i16 & 3);
#define G_DMA(buf, t_) do { char* dA_ = lds + (buf) * GBUF_SZ + wid * 1024 + lane * 16; \
        _Pragma("unroll") for (int i = 0; i < MB; ++i) glds16(arow[i] + (t_) * 64, dA_ + i * 8192); \
        if (BGLDS) { char* dB_ = lds + (buf) * GBUF_SZ + GA_SZ + wid * 1024 + lane * 16; \
            _Pragma("unroll") for (int i = 0; i < NPB; ++i) glds16(Bb + (size_t)(t_) * 64 * ldb + bsrc[i], dB_ + i * 8192); } } while (0)
#define G_LOADB(t_) do { const int k0_ = (t_) * 64; \
        _Pragma("unroll") for (int i = 0; i < NLD; ++i) { const int c = tid + NTH * i, kr = c / NF4, n4 = c % NF4; rb0[i] = *(const f32x4*)(B0 + (size_t)(k0_ + kr) * ldb + n4 * 4); \
            if (NB == 2) rb1[i] = *(const f32x4*)(B1 + (size_t)(k0_ + kr) * ldb + n4 * 4); } } while (0)
#define G_WRITEB(buf) do { bf16_t* sB0_ = (bf16_t*)(lds + (buf) * GBUF_SZ + GA_SZ); bf16_t* sB1_ = sB0_ + 64 * BP; \
        _Pragma("unroll") for (int i = 0; i < NLD; ++i) { const int c = tid + NTH * i, kr = c / NF4, n4 = c % NF4, slot = (n4 >> 3) * 32 + 8 * (n4 & 3) + 4 * ((n4 >> 2) & 1); \
            u32x2 pk = {pack2(rb0[i][0], rb0[i][1]), pack2(rb0[i][2], rb0[i][3])}; *(u32x2*)(sB0_ + kr * BP + slot) = pk; \
            if (NB == 2) { u32x2 pk1 = {pack2(rb1[i][0], rb1[i][1]), pack2(rb1[i][2], rb1[i][3])}; *(u32x2*)(sB1_ + kr * BP + slot) = pk1; } } } while (0)
#define G_READ(buf, ks, AF, BF0, BF1) do { const char* sA_ = lds + (buf) * GBUF_SZ; const bf16_t* sB0_ = (const bf16_t*)(lds + (buf) * GBUF_SZ + GA_SZ); const bf16_t* sB1_ = sB0_ + 64 * BP; const int k0_ = (ks) * 16; \
        _Pragma("unroll") for (int n = 0; n < NBLK; ++n) { \
            if (BGLDS) { const int kk_ = k0_ + 8 * (gi >> 1) + (i16 >> 2), gr_ = (wc * WN + n * 32) / 16 + (gi & 1); \
                const char* q0_ = (const char*)sB0_ + kk_ * RB + ((gr_ ^ (kk_ & 7)) << 5) + 8 * (i16 & 3); const char* q1_ = (const char*)sB0_ + (kk_ + 4) * RB + ((gr_ ^ ((kk_ + 4) & 7)) << 5) + 8 * (i16 & 3); \
                s16x4 lo = tr16((const bf16_t*)q0_), hi = tr16((const bf16_t*)q1_); BF0[n] = __builtin_shufflevector(lo, hi, 0, 1, 2, 3, 4, 5, 6, 7); } \
            else { const int off = b_off + k0_ * BP + n * 32; \
                s16x4 lo = tr16(sB0_ + off), hi = tr16(sB0_ + off + 4 * BP); BF0[n] = __builtin_shufflevector(lo, hi, 0, 1, 2, 3, 4, 5, 6, 7); \
                if (NB == 2) { s16x4 lo1 = tr16(sB1_ + off), hi1 = tr16(sB1_ + off + 4 * BP); BF1[n] = __builtin_shufflevector(lo1, hi1, 0, 1, 2, 3, 4, 5, 6, 7); } } } \
        _Pragma("unroll") for (int m = 0; m < MB; ++m) AF[m] = *(const bf16x8*)(sA_ + a_base + m * 4096 + ((((ks) * 2 + hh) ^ a_sw) << 4)); } while (0)
#define G_MFMA(AF, BF0, BF1) do { \
        _Pragma("unroll") for (int m = 0; m < MB; ++m) _Pragma("unroll") for (int n = 0; n < NBLK; ++n) { \
            acc0[m][n] = __builtin_amdgcn_mfma_f32_32x32x16_bf16(BF0[n], AF[m], acc0[m][n], 0, 0, 0); \
            if (NB == 2) acc1[m][n] = __builtin_amdgcn_mfma_f32_32x32x16_bf16(BF1[n], AF[m], acc1[m][n], 0, 0, 0); } } while (0)
#define G_MIX(nm) do { _Pragma("unroll") for (int i = 0; i < (nm); ++i) { __builtin_amdgcn_sched_group_barrier(0x008, 1, 0); __builtin_amdgcn_sched_group_barrier(0x100, 1, 0); } } while (0)
    constexpr int NMF = MB * NBLK * NB;
    bf16x8 afA[MB], bfA0[NBLK], bfA1[NBLK], afB[MB], bfB0[NBLK], bfB1[NBLK];
    G_DMA(0, 0);
    if (!BGLDS) { G_LOADB(0); G_WRITEB(0); }
#pragma unroll 1
    for (int t = 0; t < T; ++t) {
        const int buf = t & 1;
        asm volatile("s_waitcnt vmcnt(0)" ::: "memory");
        __syncthreads();
        if (t + 1 < T) { G_DMA(buf ^ 1, t + 1); if (!BGLDS) G_LOADB(t + 1); }
        if (BGLDS) {
            G_READ(buf, 0, afA, bfA0, bfA1);
            __builtin_amdgcn_sched_barrier(0);
            G_MFMA(afA, bfA0, bfA1); G_READ(buf, 1, afB, bfB0, bfB1); G_MIX(NMF);
            __builtin_amdgcn_sched_barrier(0);
            G_MFMA(afB, bfB0, bfB1); G_READ(buf, 2, afA, bfA0, bfA1); G_MIX(NMF);
            __builtin_amdgcn_sched_barrier(0);
            G_MFMA(afA, bfA0, bfA1); G_READ(buf, 3, afB, bfB0, bfB1); G_MIX(NMF);
            __builtin_amdgcn_sched_barrier(0);
            G_MFMA(afB, bfB0, bfB1);
        } else {
            __builtin_amdgcn_sched_barrier(0);
            G_READ(buf, 0, afA, bfA0, bfA1); G_MFMA(afA, bfA0, bfA1);
            G_READ(buf, 1, afA, bfA0, bfA1); G_MFMA(afA, bfA0, bfA1);
            G_READ(buf, 2, afA, bfA0, bfA1); G_MFMA(afA, bfA0, bfA1);
            __builtin_amdgcn_sched_barrier(0);
            G_READ(buf, 3, afA, bfA0, bfA1); G_MFMA(afA, bfA0, bfA1);
            G_WRITEB(buf ^ 1);
        }
        __builtin_amdgcn_sched_barrier(0);
    }
#undef G_DMA
#undef G_LOADB
#undef G_WRITEB
#undef G_READ
#undef G_MFMA
#undef G_MIX
    __syncthreads();
    float* stg = (float*)lds + wid * (32 * 68);
#pragma unroll
    for (int m = 0; m < MB; ++m) {
#pragma unroll
        for (int n = 0; n < NBLK; ++n) {
            const f32x16 v = epi.pre(acc0[m][n], acc1[m][n]);
#pragma unroll
            for (int q = 0; q < 4; ++q) *(f32x4*)(stg + r32 * 68 + n * 32 + 16 * hh + 4 * q) = (f32x4){v[4 * q], v[4 * q + 1], v[4 * q + 2], v[4 * q + 3]};
        }
        asm volatile("s_waitcnt lgkmcnt(0)" ::: "memory"); __builtin_amdgcn_wave_barrier();
#pragma unroll
        for (int ps = 0; ps < (32 * WN) / 256; ++ps) {
            const int idx = ps * 64 + lane, row = idx / (WN / 4), ck = idx % (WN / 4);
            epi.post(wr * (32 * MB) + m * 32 + row, wc * WN + ck * 4, *(const f32x4*)(stg + row * 68 + ck * 4));
        }
        asm volatile("s_waitcnt lgkmcnt(0)" ::: "memory"); __builtin_amdgcn_wave_barrier();
    }
    __syncthreads();
}

struct PlainA {
    const bf16_t* base; int lda;
    DI const bf16_t* rowptr(int, int row) const { return base + (size_t)row * lda; }
};
struct GatherA {
    const bf16_t* rp[4];
    DI const bf16_t* rowptr(int i, int) const { return rp[i]; }
};

struct XcdOrder {
    int base, lim, j, bpx;
    DI XcdOrder(int bid, int nblk, int total) {
        if ((nblk & 7) == 0) { const int x = bid & 7, per = (total + 7) >> 3; bpx = nblk >> 3; j = bid >> 3; base = x * per; lim = base + per < total ? base + per : total; }
        else { bpx = nblk; j = bid; base = 0; lim = total; }
    }
    DI int item(int i) const { const int q = base + i * bpx + j; return q < lim ? q : -1; }
};
DI void tile_rc(int q, int nrow, int ncol, int& r, int& c) {
    const int per_sr = 8 * ncol, sr = q / per_sr, rem = q - sr * per_sr, rows = (nrow - sr * 8) < 8 ? (nrow - sr * 8) : 8;
    c = rem / rows; r = sr * 8 + rem - c * rows;
}

DI u32x4 pack8v(const f32x4& a, const f32x4& b) { return (u32x4){pack2(a[0], a[1]), pack2(a[2], a[3]), pack2(b[0], b[1]), pack2(b[2], b[3])}; }
DI u32x4 pack8q(const f32x16& a, int q) { return (u32x4){pack2(a[8 * q], a[8 * q + 1]), pack2(a[8 * q + 2], a[8 * q + 3]), pack2(a[8 * q + 4], a[8 * q + 5]), pack2(a[8 * q + 6], a[8 * q + 7])}; }
struct EpiStoreBf16 { bf16_t* o; int ldo;
    DI f32x16 pre(const f32x16& a, const f32x16&) const { return a; }
    DI void post(int r, int c, const f32x4& v) const { u32x2 pk = {pack2(v[0], v[1]), pack2(v[2], v[3])}; *(u32x2*)(o + (size_t)r * ldo + c) = pk; } };
DI void phase_g1(const Params& p, int bid, int nblk, char* lds) {
    const bf16_t* xn = (const bf16_t*)(p.ws + OFF_XN); bf16_t* u = (bf16_t*)(p.ws + OFF_U);
    const bf16_t* wb = (const bf16_t*)(p.ws + OFF_WINB);
    const int nwide_all = 65 * 9, nwide = (2 * nblk < nwide_all) ? 2 * nblk : nwide_all;
    const XcdOrder ord(bid, nblk, nwide);
    for (int i = 0, q; (q = ord.item(i)) >= 0; ++i) {
        int tm, tn; tile_rc(q, 65, 9, tm, tn);
        PlainA al{xn + (size_t)tm * 256 * D, D};
        EpiStoreBf16 epi{u + (size_t)tm * 256 * DIN + tn * 256, DIN};
        gemm8<1, true, 2>(al, wb + tn * 256, nullptr, DIN, D, lds, epi);
    }
    const int nhalf = 2 * (nwide_all - nwide) + 65;
    for (int n = bid; n < nhalf; n += nblk) {
        int tm, col;
        if (n < 2 * (nwide_all - nwide)) { int tn; tile_rc(nwide + (n >> 1), 65, 9, tm, tn); col = tn * 256 + (n & 1) * 128; }
        else { tm = n - 2 * (nwide_all - nwide); col = 9 * 256; }
        PlainA al{xn + (size_t)tm * 256 * D, D};
        EpiStoreBf16 epi{u + (size_t)tm * 256 * DIN + col, DIN};
        gemm8<1, true, 1>(al, wb + col, nullptr, DIN, D, lds, epi);
    }
}

DI void phase_pool(const Params& p, int bid, int nblk) {
    const bf16_t* u = (const bf16_t*)(p.ws + OFF_U) + (size_t)CTX * DIN + C_POOL;
    bf16_t* mix = (bf16_t*)(p.ws + OFF_MIX);
    for (int item = bid * NTH + threadIdx.x; item < (S / 8) * 64; item += nblk * NTH) {
        const int cg = item & 63, run = item >> 6, t0 = run * 8, gi = cg >> 4, win = 2 << gi, hw = win >> 1;
        const bf16_t* uc = u + cg * 8;
        float sum[8];
#pragma unroll
        for (int j = 0; j < 8; ++j) sum[j] = 0.f;
        const int lo0 = (t0 - hw) < 0 ? 0 : (t0 - hw), hi0 = (t0 - hw + win) > S ? S : (t0 - hw + win);
#pragma unroll
        for (int r = 0; r < 16; ++r) {
            const int tt = lo0 + r; const bool ok = tt < hi0; const int tc = ok ? tt : lo0;
            float q[8]; unpack8(*(const u32x4*)(uc + (size_t)tc * DIN), q);
            const float wgt = ok ? 1.f : 0.f;
#pragma unroll
            for (int j = 0; j < 8; ++j) sum[j] += wgt * q[j];
        }
        int lo = lo0, hi = hi0;
#pragma unroll
        for (int k = 0; k < 8; ++k) {
            const int t = t0 + k;
            float cv[8], o[8]; unpack8(*(const u32x4*)(uc + (size_t)t * DIN), cv);
            const float inv = 1.f / (float)(hi - lo);
#pragma unroll
            for (int j = 0; j < 8; ++j) o[j] = sum[j] * inv - cv[j];
            *(u32x4*)(mix + (size_t)t * D + cg * 8) = pack8(o);
            const int nlo = t + 1 - hw, nhi = t + 1 - hw + win;
            const bool addr = nhi <= S, subr = nlo > 0;
            float qa[8], qs[8];
            unpack8(*(const u32x4*)(uc + (size_t)(addr ? nhi - 1 : t) * DIN), qa); unpack8(*(const u32x4*)(uc + (size_t)(subr ? nlo - 1 : t) * DIN), qs);
            const float wa = addr ? 1.f : 0.f, wsb = subr ? 1.f : 0.f;
#pragma unroll
            for (int j = 0; j < 8; ++j) sum[j] += wa * qa[j] - wsb * qs[j];
            hi = addr ? nhi : hi; lo = subr ? nlo : lo;
        }
    }
}
struct EpiPool { bf16_t* o; const float* sc;
    DI f32x16 pre(const f32x16& a, const f32x16&) const { return a; }
    DI void post(int r, int c, const f32x4& v) const { const f32x4 s4 = *(const f32x4*)(sc + c); u32x2 pk = {pack2(v[0] * s4[0], v[1] * s4[1]), pack2(v[2] * s4[2], v[3] * s4[3])}; *(u32x2*)(o + (size_t)r * D + c) = pk; } };
DI void phase_poolgemm(const Params& p, int bid, int nblk, char* lds) {
    if (nblk <= 0) return;
    for (int it = bid; it < 4 * 64; it += nblk) {
        const int gi = it >> 6, tm = it & 63;
        const bf16_t* mix = (const bf16_t*)(p.ws + OFF_MIX);
        PlainA al{mix + (size_t)tm * 256 * D + gi * 128, D};
        EpiPool e{(bf16_t*)(p.ws + OFF_MIX) + (size_t)tm * 256 * D + 512 + gi * 128, p.pool_scale + gi * 128};
        int kk = 128; asm volatile("" : "+s"(kk));
        gemm8<1, false, 1>(al, p.w_pool + (size_t)gi * 128 * 128, nullptr, 128, kk, lds, e);
    }
}

constexpr int MP = 72, MSZ = 64 * MP;
constexpr int FP = 68;
constexpr int SCANA_LDS = 14 * MSZ * 2 + 2048;
template <bool KS> DI bf16x8 frag32(const bf16_t* base, int x0, int s, int lane) {
    if (!KS) return *(const bf16x8*)(base + (x0 + (lane & 31)) * MP + 16 * s + 8 * (lane >> 5));
    const int gi = lane >> 4, i = lane & 15;
    const bf16_t* a = base + (16 * s + 8 * (gi >> 1) + (i >> 2)) * MP + x0 + 16 * (gi & 1) + 4 * (i & 3);
    s16x4 lo = tr16(a), hi = tr16(a + 4 * MP);
    return __builtin_shufflevector(lo, hi, 0, 1, 2, 3, 4, 5, 6, 7);
}
template <bool XKS, bool YKS> DI f32x16 mm32(const bf16_t* X, int x0, const bf16_t* Y, int y0, f32x16 acc, int lane) {
#pragma unroll
    for (int s = 0; s < 4; ++s) acc = __builtin_amdgcn_mfma_f32_32x32x16_bf16(frag32<XKS>(X, x0, s, lane), frag32<YKS>(Y, y0, s, lane), acc, 0, 0, 0);
    return acc;
}
template <class F> DI void store_acc(bf16_t* out, int x0, int y0, const f32x16& acc, int lane, F f) {
    const int y = y0 + (lane & 31), hh = lane >> 5;
#pragma unroll
    for (int q = 0; q < 4; ++q) {
        const int x = x0 + 8 * q + 4 * hh;
        u32x2 pk = {pack2(f(acc[4 * q], x, y), f(acc[4 * q + 1], x + 1, y)), pack2(f(acc[4 * q + 2], x + 2, y), f(acc[4 * q + 3], x + 3, y))};
        *(u32x2*)(out + y * MP + x) = pk;
    }
}
DI unsigned rot16(unsigned x) { return (x >> 16) | (x << 16); }

DI int chain_pos(int c, int dir) { return dir == 0 ? c : (c < 4 ? 3 - c : NCH + 3 - c); }

DI void phase_scanA(const Params& p, int bid, int nblk, char* lds) {
    const int tid = threadIdx.x, lane0 = tid & 63, w = tid >> 6, grp = w >> 2;
    bf16_t* M = (bf16_t*)lds;
    bf16_t *sAT = M, *sBT = M + MSZ, *sKT = M + 2 * MSZ, *sRT = M + 3 * MSZ, *sVT = M + 4 * MSZ;
    float* fGC = (float*)(lds + 14 * MSZ * 2);
    float* fSeg = fGC + 64;
    float* fLogw = (float*)(M + 12 * MSZ);
    float* fA = (float*)(M + 10 * MSZ);
    const bf16_t* u = (const bf16_t*)(p.ws + OFF_U);
    for (int inst = bid; inst < NCH * 16; inst += nblk) {
        int lane = lane0; asm volatile("" : "+v"(lane));
        const int xq = 32 * (w & 1), yq = 32 * ((w >> 1) & 1);
        const int c = inst >> 4, h = (inst >> 1) & 7, dir = inst & 1;
        const bool latent = c >= 4, want_g = latent && dir == 0;
        const float* w2 = dir ? p.w2_b : p.w2_f; const float* a2 = dir ? p.a2_b : p.a2_f;
        const float* w0 = dir ? p.w0_b : p.w0_f; const float* a0 = dir ? p.a0_b : p.a0_f;
        const float* rkd = dir ? p.r_k_b : p.r_k_f;
        const int cwl = dir ? C_WLB : C_WLF, cal = dir ? C_ALB : C_ALF;
        const int ch = tid & 7, tau = tid >> 3, g = dir ? c * 64 + 63 - tau : c * 64 + tau;
        float fr_[8], fk_[8], fv_[8];
        {
            const int cols5[5] = {h * 64 + ch * 8, 512 + h * 64 + ch * 8, 1024 + h * 64 + ch * 8, cwl + ch * 8, cal + ch * 8};
            const bool hasp = (g != 0) && (g != CTX), hasn = (g != CTX - 1) && (g != NT - 1);
            const float mp = hasp ? 0.5f : 0.f, mn = hasn ? 0.5f : 0.f;
            const bf16_t* rc = u + (size_t)g * DIN; const bf16_t* rp = hasp ? rc - DIN : rc; const bf16_t* rn = hasn ? rc + DIN : rc;
            u32x4 raw[5][3]; f32x4 wl[4];
#pragma unroll
            for (int q = 0; q < 5; ++q) { raw[q][0] = *(const u32x4*)(rc + cols5[q]); raw[q][1] = *(const u32x4*)(rp + cols5[q]); raw[q][2] = *(const u32x4*)(rn + cols5[q]); }
#pragma unroll
            for (int q = 0; q < 2; ++q) { const int idx = tid + NTH * q, kr = idx >> 4, n4 = idx & 15;
                wl[q] = *(const f32x4*)(w2 + (size_t)kr * DR + h * 64 + n4 * 4); wl[2 + q] = *(const f32x4*)(a2 + (size_t)kr * DR + h * 64 + n4 * 4); }
            auto shift8 = [&](const u32x4* r3, int col, float* o) {
                float cc[8], pv[8], nx[8];
                unpack8(r3[0], cc); unpack8(r3[1], pv); unpack8(r3[2], nx);
                const f32x4 m0 = *(const f32x4*)(p.mu + col), m1 = *(const f32x4*)(p.mu + col + 4);
#pragma unroll
                for (int j = 0; j < 8; ++j) { const float m = j < 4 ? m0[j & 3] : m1[j & 3]; o[j] = cc[j] + m * ((mp * pv[j] + mn * nx[j]) - cc[j]); }
            };
            shift8(raw[0], cols5[0], fr_); shift8(raw[1], cols5[1], fk_); shift8(raw[2], cols5[2], fv_);
            float t8[8];
            shift8(raw[3], cols5[3], t8);
#pragma unroll
            for (int j = 0; j < 8; ++j) { const float e2 = __expf(2.f * t8[j]); t8[j] = 1.f - __fdividef(2.f, e2 + 1.f); }
            *(u32x4*)(M + 5 * MSZ + tau * MP + ch * 8) = pack8(t8);
            shift8(raw[4], cols5[4], t8);
            *(u32x4*)(M + 6 * MSZ + tau * MP + ch * 8) = pack8(t8);
            if (want_g) {
                u32x4 rawg[2][3]; f32x4 wg2[4];
#pragma unroll
                for (int half = 0; half < 2; ++half) { const int col = C_GL + half * 64 + ch * 8;
                    rawg[half][0] = *(const u32x4*)(rc + col); rawg[half][1] = *(const u32x4*)(rp + col); rawg[half][2] = *(const u32x4*)(rn + col); }
#pragma unroll
                for (int q = 0; q < 4; ++q) { const int idx = tid + NTH * q, kr = idx >> 4, n4 = idx & 15; wg2[q] = *(const f32x4*)(p.g2 + (size_t)kr * DR + h * 64 + n4 * 4); }
#pragma unroll
                for (int half = 0; half < 2; ++half) {
                    shift8(rawg[half], C_GL + half * 64 + ch * 8, t8);
#pragma unroll
                    for (int j = 0; j < 8; ++j) t8[j] = sigmoidf_(t8[j]);
                    *(u32x4*)(M + half * MSZ + tau * MP + ch * 8) = pack8(t8);
                }
#pragma unroll
                for (int q = 0; q < 4; ++q) { const int idx = tid + NTH * q, kr = idx >> 4, n4 = idx & 15;
                    u32x2 pa = {pack2(wg2[q][0], wg2[q][1]), pack2(wg2[q][2], wg2[q][3])};
                    *(u32x2*)(M + (2 + (kr >> 6)) * MSZ + (kr & 63) * MP + n4 * 4) = pa; }
            }
#pragma unroll
            for (int q = 0; q < 2; ++q) { const int idx = tid + NTH * q, kr = idx >> 4, n4 = idx & 15;
                u32x2 pa = {pack2(wl[q][0], wl[q][1]), pack2(wl[q][2], wl[q][3])}, pb = {pack2(wl[2 + q][0], wl[2 + q][1]), pack2(wl[2 + q][2], wl[2 + q][3])};
                *(u32x2*)(M + 7 * MSZ + kr * MP + n4 * 4) = pa; *(u32x2*)(M + 8 * MSZ + kr * MP + n4 * 4) = pb; }
        }
        __syncthreads();
        if (grp == 0) {
            f32x16 accW = mm32<true, false>(M + 7 * MSZ, xq, M + 5 * MSZ, yq, zero16(), lane);
            const int y = yq + (lane & 31), hh = lane >> 5;
#pragma unroll
            for (int q = 0; q < 4; ++q) {
                const int x = xq + 8 * q + 4 * hh;
                f32x4 lw; const f32x4 w0v = *(const f32x4*)(w0 + h * 64 + x);
#pragma unroll
                for (int e = 0; e < 4; ++e) {
                    float v = -DECAY_SCALE * sigmoidf_(w0v[e] + accW[4 * q + e]);
                    v += __builtin_bit_cast(float, __builtin_amdgcn_update_dpp(0, __builtin_bit_cast(int, v), 0x111, 0xf, 0xf, false));
                    v += __builtin_bit_cast(float, __builtin_amdgcn_update_dpp(0, __builtin_bit_cast(int, v), 0x112, 0xf, 0xf, false));
                    v += __builtin_bit_cast(float, __builtin_amdgcn_update_dpp(0, __builtin_bit_cast(int, v), 0x114, 0xf, 0xf, false));
                    v += __builtin_bit_cast(float, __builtin_amdgcn_update_dpp(0, __builtin_bit_cast(int, v), 0x118, 0xf, 0xf, false));
                    v += __builtin_bit_cast(float, __builtin_amdgcn_update_dpp(0, __builtin_bit_cast(int, v), 0x142, 0xa, 0xf, false));
                    lw[e] = v;
                }
                *(f32x4*)(fLogw + y * FP + x) = lw;
                if (yq == 0 && (lane & 31) == 31) *(f32x4*)(fSeg + x) = lw;
            }
        } else {
            f32x16 accA = mm32<true, false>(M + 8 * MSZ, xq, M + 6 * MSZ, yq, zero16(), lane);
            const int y = yq + (lane & 31), hh = lane >> 5;
#pragma unroll
            for (int q = 0; q < 4; ++q) {
                const int x = xq + 8 * q + 4 * hh;
                f32x4 av; const f32x4 a0v = *(const f32x4*)(a0 + h * 64 + x);
#pragma unroll
                for (int e = 0; e < 4; ++e) av[e] = sigmoidf_(a0v[e] + accA[4 * q + e]);
                *(f32x4*)(fA + y * FP + x) = av;
            }
            if (want_g) {
                f32x16 accG = mm32<true, false>(M + 2 * MSZ, xq, M, yq, zero16(), lane);
                accG = mm32<true, false>(M + 3 * MSZ, xq, M + MSZ, yq, accG, lane);
                const int t = c * 64 + y - CTX;
#pragma unroll
                for (int q = 0; q < 4; ++q) {
                    const int x = xq + 8 * q + 4 * hh;
                    u32x2 pk = {pack2(accG[4 * q], accG[4 * q + 1]), pack2(accG[4 * q + 2], accG[4 * q + 3])};
                    *(u32x2*)((bf16_t*)(p.ws + OFF_G) + (size_t)t * DR + h * 64 + x) = pk;
                }
            }
        }
        __syncthreads();
        {
            float oa[8], ob[8], ok[8], orr[8], kkv[8], kd[8];
            float ss = 0.f, dsum = 0.f;
            const int c8 = h * 64 + ch * 8;
            float kkp[8], kap[8], rkp[8];
            { const f32x4 a0_ = *(const f32x4*)(p.k_k + c8), a1_ = *(const f32x4*)(p.k_k + c8 + 4), b0_ = *(const f32x4*)(p.k_a + c8), b1_ = *(const f32x4*)(p.k_a + c8 + 4), c0_ = *(const f32x4*)(rkd + c8), c1_ = *(const f32x4*)(rkd + c8 + 4);
#pragma unroll
              for (int j = 0; j < 4; ++j) { kkp[j] = a0_[j]; kkp[4 + j] = a1_[j]; kap[j] = b0_[j]; kap[4 + j] = b1_[j]; rkp[j] = c0_[j]; rkp[4 + j] = c1_[j]; } }
#pragma unroll
            for (int j = 0; j < 8; ++j) { kkv[j] = fk_[j] * kkp[j]; ss += kkv[j] * kkv[j]; }
            ss += __shfl_xor(ss, 1, 64); ss += __shfl_xor(ss, 2, 64); ss += __shfl_xor(ss, 4, 64);
            const float inv = 1.f / fmaxf(sqrtf(ss), 1e-12f);
#pragma unroll
            for (int j = 0; j < 8; ++j) {
                const int jj = ch * 8 + j;
                const float seg = fSeg[jj];
                const float cum = fLogw[tau * FP + jj] + (tau >= 32 ? seg : 0.f), cprev = tau ? fLogw[(tau - 1) * FP + jj] + (tau > 32 ? seg : 0.f) : 0.f, av = fA[tau * FP + jj];
                const float gam = __expf(cum), gprev = __expf(cprev), ginv = __expf(-cum);
                const float kkn = kkv[j] * inv;
                kd[j] = fk_[j] * (1.f + (av - 1.f) * kap[j]);
                oa[j] = -kkn * gprev; ob[j] = kkn * av * ginv; ok[j] = kd[j] * ginv; orr[j] = fr_[j] * gam;
                dsum += fr_[j] * kd[j] * rkp[j];
                if (tau == 63) fGC[jj] = gam;
            }
            dsum += __shfl_xor(dsum, 1, 64); dsum += __shfl_xor(dsum, 2, 64); dsum += __shfl_xor(dsum, 4, 64);
            if (ch == 0) ((float*)(p.ws + OFF_DOT))[((size_t)g * 8 + h) * 2 + dir] = dsum;
            *(u32x4*)(sAT + tau * MP + ch * 8) = pack8(oa); *(u32x4*)(sBT + tau * MP + ch * 8) = pack8(ob);
            *(u32x4*)(sKT + tau * MP + ch * 8) = pack8(ok); *(u32x4*)(sRT + tau * MP + ch * 8) = pack8(orr);
            const u32x4 pv8 = pack8(fv_);
            *(u32x4*)(sVT + tau * MP + ch * 8) = pv8;
            if (want_g) *(u32x4*)((bf16_t*)(p.ws + OFF_V) + (size_t)(g - CTX) * DR + h * 64 + ch * 8) = pv8;
        }
        __syncthreads();
        if (grp == 0) {
            f32x16 acc = mm32<false, false>(sAT, xq, sBT, yq, zero16(), lane);
            store_acc(M + 5 * MSZ, xq, yq, acc, lane, [](float v, int x, int y) { return y < x ? v : 0.f; });
            store_acc(M + 7 * MSZ, xq, yq, acc, lane, [](float v, int x, int y) { return y < x ? v : (y == x ? 1.f : 0.f); });
        } else {
            f32x16 acc = mm32<false, false>(sAT, xq, sKT, yq, zero16(), lane);
            store_acc(M + 9 * MSZ, xq, yq, acc, lane, [](float v, int x, int y) { return y < x ? v : 0.f; });
        }
        __syncthreads();
        int xs = 5, xo = 6, ts = 7, to = 8;
        if (grp == 1) {
            f32x16 acc = mm32<true, false>(M + xs * MSZ, xq, M + xs * MSZ, yq, zero16(), lane);
            store_acc(M + xo * MSZ, xq, yq, acc, lane, [](float v, int, int) { return v; });
        }
        { int t_ = xs; xs = xo; xo = t_; }
        __syncthreads();
        for (int k = 0; k < 5; ++k) {
            if (grp == 0) {
                const bf16_t* Told = M + ts * MSZ;
                f32x16 acc = mm32<true, false>(M + xs * MSZ, xq, Told, yq, zero16(), lane);
                store_acc(M + to * MSZ, xq, yq, acc, lane, [Told](float v, int x, int y) { return v + bf2f(Told[y * MP + x]); });
            } else if (k < 4) {
                f32x16 acc = mm32<true, false>(M + xs * MSZ, xq, M + xs * MSZ, yq, zero16(), lane);
                store_acc(M + xo * MSZ, xq, yq, acc, lane, [](float v, int, int) { return v; });
            } else {
                f32x16 acc = mm32<false, false>(sRT, xq, sBT, yq, zero16(), lane);
                store_acc(M + 10 * MSZ, xq, yq, acc, lane, [](float v, int x, int y) { return y <= x ? v : 0.f; });
                acc = mm32<false, false>(sRT, xq, sKT, yq, zero16(), lane);
                store_acc(M + 11 * MSZ, xq, yq, acc, lane, [](float v, int x, int y) { return y <= x ? v : 0.f; });
            }
            int t_ = xs; xs = xo; xo = t_; t_ = ts; ts = to; to = t_;
            __syncthreads();
        }
        const bf16_t* sT = M + ts * MSZ;
        if (grp == 0) {
            f32x16 acc = mm32<true, true>(sT, xq, sAT, yq, zero16(), lane);
            store_acc(M + 12 * MSZ, xq, yq, acc, lane, [](float v, int, int) { return v; });
        } else {
            f32x16 acc = mm32<true, false>(sT, xq, M + 9 * MSZ, yq, zero16(), lane);
            store_acc(M + 13 * MSZ, xq, yq, acc, lane, [](float v, int, int) { return v; });
        }
        __syncthreads();
        {
            const bf16_t *sAbar = M + 12 * MSZ, *sG = M + 13 * MSZ, *sABR = M + 10 * MSZ, *sAKR = M + 11 * MSZ;
            if (grp == 0) {
                f32x16 acc = mm32<false, true>(sAbar, xq, sBT, yq, zero16(), lane);
                store_acc(M + 5 * MSZ, xq, yq, acc, lane, [fGC](float v, int x, int y) { return ((x == y ? 1.f : 0.f) + v) * fGC[y]; });
                acc = mm32<false, true>(sAbar, xq, sABR, yq, zero16(), lane);
                store_acc(M + 6 * MSZ, xq, yq, acc, lane, [sRT](float v, int x, int y) { return v + bf2f(sRT[y * MP + x]); });
            } else {
                f32x16 acc = mm32<true, false>(sBT, xq, sG, yq, zero16(), lane);
                store_acc(M + 7 * MSZ, xq, yq, acc, lane, [sKT, fGC](float v, int x, int y) { return (v + bf2f(sKT[y * MP + x])) * fGC[x]; });
                acc = mm32<true, false>(sABR, xq, sG, yq, zero16(), lane);
                store_acc(M + 9 * MSZ, xq, yq, acc, lane, [sAKR](float v, int x, int y) { return v + bf2f(sAKR[y * MP + x]); });
            }
        }
        __syncthreads();
        const int chain = dir * 8 + h, npos = chain_pos(c, dir);
        {
            u32x4* Pg = (u32x4*)(p.ws + OFF_P) + ((size_t)chain * NCH + npos) * 512;
            { const int item = tid, ln = item & 63, as = item >> 6, a = as >> 1, s2 = as & 1, fr = ln & 15, fq = ln >> 4;
              const bf16_t* src = M + 5 * MSZ + (16 * a + fr) * MP + 32 * s2 + 4 * fq;
              const u32x2 lo = *(const u32x2*)src, hi = *(const u32x2*)(src + 16);
              Pg[as * 64 + ln] = (u32x4){lo.x, lo.y, hi.x, hi.y}; }
            if (latent) {
                u32x4* Wg = (u32x4*)(p.ws + OFF_WYT) + ((size_t)((c - 4) * 8 + h) * 2 + dir) * 512;
                const int row = tid >> 3, ck = tid & 7; Wg[tid] = *(const u32x4*)(M + 6 * MSZ + row * MP + ck * 8);
            }
        }
        if (grp == 0) {
            f32x16 acc = mm32<true, true>(M + 7 * MSZ, xq, sVT, yq, zero16(), lane);
            store_acc(M + 12 * MSZ, xq, yq, acc, lane, [](float v, int, int) { return v; });
        } else {
            f32x16 acc = mm32<true, true>(M + 9 * MSZ, xq, sVT, yq, zero16(), lane);
            store_acc(M + 13 * MSZ, xq, yq, acc, lane, [](float v, int, int) { return v; });
        }
        __syncthreads();
        {
            u32x2* Qg = (u32x2*)(p.ws + OFF_Q) + ((size_t)chain * NCH + npos) * 1024;
#pragma unroll
            for (int i = 0; i < 2; ++i) {
                const int item = tid + NTH * i, ln = item & 63, wa = item >> 6, wi = wa >> 2, a = wa & 3, fr = ln & 15, fq = ln >> 4;
                Qg[item] = *(const u32x2*)(M + 12 * MSZ + (16 * wi + fr) * MP + 16 * a + 4 * fq);
            }
            if (latent) {
                u32x2* Yg = (u32x2*)(p.ws + OFF_YL) + ((size_t)((c - 4) * 8 + h) * 2 + dir) * 1024;
#pragma unroll
                for (int i = 0; i < 2; ++i) {
                    const int item = tid + NTH * i, ln = item & 63, wn = item >> 6, wt = wn >> 2, ni = wn & 3, fr = ln & 15, fq = ln >> 4;
                    const bf16_t* row = M + 13 * MSZ + (16 * ni + fr) * MP;
                    u32x2 v;
                    if (dir == 0) v = *(const u32x2*)(row + 16 * wt + 4 * fq);
                    else { const u32x2 r2 = *(const u32x2*)(row + 60 - 16 * wt - 4 * fq); v = (u32x2){rot16(r2.y), rot16(r2.x)}; }
                    Yg[item] = v;
                }
            }
        }
        __syncthreads();
    }
}

DI int grp_start(int g) { return g * 16 + (g < 4 ? g : 4); }
DI u32x4 packz(const f32x4& a, const f32x4& b) { return (u32x4){pack2(a[0], a[1]), pack2(a[2], a[3]), pack2(b[0], b[1]), pack2(b[2], b[3])}; }
template <int PASS> DI void chain_run(const Params& p, int chain, int g) {
    constexpr int CPF = PASS == 1 ? 2 : 3;
    const int lane = threadIdx.x & 63, w = threadIdx.x >> 6, fr = lane & 15, fq = lane >> 4;
    const int n0 = grp_start(g), n1 = grp_start(g + 1);
    const u32x4* Pg = (const u32x4*)(p.ws + OFF_P) + (size_t)chain * NCH * 512;
    const u32x2* Qg = (const u32x2*)(p.ws + OFF_Q) + (size_t)chain * NCH * 1024;
    u32x4* Zg = (u32x4*)(p.ws + OFF_Z) + (size_t)chain * NCH * 512;
    f32x4* ZG = (f32x4*)(p.ws + OFF_ZG) + ((size_t)(chain * 16 + g) * 4 + w) * 256;
    f32x4 acc[4], accp[4];
#pragma unroll
    for (int a = 0; a < 4; ++a) {
        if (PASS == 3) acc[a] = ZG[a * 64 + lane]; else acc[a] = (f32x4){0, 0, 0, 0};
#pragma unroll
        for (int e = 0; e < 4; ++e) accp[a][e] = (16 * a + 4 * fq + e == 16 * w + fr) ? 1.f : 0.f;
    }
    u32x4 pf[CPF][8]; u32x2 qf[CPF][4];
#pragma unroll
    for (int st = 0; st < CPF; ++st) if (n0 + st < n1) {
#pragma unroll
        for (int i = 0; i < 8; ++i) pf[st][i] = Pg[(size_t)(n0 + st) * 512 + i * 64 + lane];
#pragma unroll
        for (int a = 0; a < 4; ++a) qf[st][a] = Qg[(size_t)(n0 + st) * 1024 + (w * 4 + a) * 64 + lane];
    }
    for (int nb = n0; nb < n1; nb += CPF) {
#pragma unroll
        for (int st = 0; st < CPF; ++st) {
            const int n = nb + st;
            if (n < n1) {
                u32x4 pc[8]; u32x2 qc[4];
#pragma unroll
                for (int i = 0; i < 8; ++i) pc[i] = pf[st][i];
#pragma unroll
                for (int a = 0; a < 4; ++a) qc[a] = qf[st][a];
                if (n + CPF < n1) {
#pragma unroll
                    for (int i = 0; i < 8; ++i) pf[st][i] = Pg[(size_t)(n + CPF) * 512 + i * 64 + lane];
#pragma unroll
                    for (int a = 0; a < 4; ++a) qf[st][a] = Qg[(size_t)(n + CPF) * 1024 + (w * 4 + a) * 64 + lane];
                }
                const u32x4 z0 = packz(acc[0], acc[1]), z1 = packz(acc[2], acc[3]);
                if (PASS == 3) { Zg[((size_t)n * 4 + w) * 128 + lane] = z0; Zg[((size_t)n * 4 + w) * 128 + 64 + lane] = z1; }
                const bf16x8 zb0 = __builtin_bit_cast(bf16x8, z0), zb1 = __builtin_bit_cast(bf16x8, z1);
#pragma unroll
                for (int a = 0; a < 4; ++a) {
                    f32x4 ini = {bflo(qc[a].x), bfhi(qc[a].x), bflo(qc[a].y), bfhi(qc[a].y)};
                    ini = __builtin_amdgcn_mfma_f32_16x16x32_bf16(__builtin_bit_cast(bf16x8, pc[2 * a]), zb0, ini, 0, 0, 0);
                    acc[a] = __builtin_amdgcn_mfma_f32_16x16x32_bf16(__builtin_bit_cast(bf16x8, pc[2 * a + 1]), zb1, ini, 0, 0, 0);
                }
                if (PASS == 1) {
                    const bf16x8 yb0 = __builtin_bit_cast(bf16x8, packz(accp[0], accp[1])), yb1 = __builtin_bit_cast(bf16x8, packz(accp[2], accp[3]));
#pragma unroll
                    for (int a = 0; a < 4; ++a) {
                        f32x4 t4 = __builtin_amdgcn_mfma_f32_16x16x32_bf16(__builtin_bit_cast(bf16x8, pc[2 * a]), yb0, (f32x4){0, 0, 0, 0}, 0, 0, 0);
                        accp[a] = __builtin_amdgcn_mfma_f32_16x16x32_bf16(__builtin_bit_cast(bf16x8, pc[2 * a + 1]), yb1, t4, 0, 0, 0);
                    }
                }
            }
        }
    }
    if (PASS == 1) {
        f32x4* CQ = (f32x4*)(p.ws + OFF_CQ) + ((size_t)(chain * 16 + g) * 4 + w) * 256;
        bf16_t* CP = (bf16_t*)(p.ws + OFF_CP) + (size_t)(chain * 16 + g) * 4096;
#pragma unroll
        for (int a = 0; a < 4; ++a) {
            CQ[a * 64 + lane] = acc[a];
#pragma unroll
            for (int e = 0; e < 4; ++e) CP[(16 * a + 4 * fq + e) * 64 + 16 * w + fr] = (bf16_t)(pack2(accp[a][e], 0.f) & 0xffffu);
        }
    }
}
DI void chain_groups(const Params& p, int chain, char* lds) {
    const int tid = threadIdx.x, lane = tid & 63, w = tid >> 6, fr = lane & 15, fq = lane >> 4;
    {
        const char* src = (const char*)(p.ws + OFF_CP) + (size_t)chain * 16 * 8192;
#pragma unroll
        for (int i = 0; i < 16; ++i) glds16(src + (size_t)(i * NTH + tid) * 16, lds + (i * NTH + tid) * 16);
        asm volatile("s_waitcnt vmcnt(0)" ::: "memory");
        __syncthreads();
    }
    if (w >= 4) return;
    constexpr int QPF = 4;
    f32x4 acc[4], qf[QPF][4];
#pragma unroll
    for (int a = 0; a < 4; ++a) acc[a] = (f32x4){0, 0, 0, 0};
    const f32x4* CQ = (const f32x4*)(p.ws + OFF_CQ) + ((size_t)chain * 16 * 4 + w) * 256;
#pragma unroll
    for (int st = 0; st < QPF; ++st)
#pragma unroll
        for (int a = 0; a < 4; ++a) qf[st][a] = CQ[(size_t)st * 1024 + a * 64 + lane];
    for (int gb = 0; gb < 16; gb += QPF) {
#pragma unroll
        for (int st = 0; st < QPF; ++st) {
            const int g = gb + st;
            f32x4 qc[4];
#pragma unroll
            for (int a = 0; a < 4; ++a) qc[a] = qf[st][a];
            if (g + QPF < 16) {
#pragma unroll
                for (int a = 0; a < 4; ++a) qf[st][a] = CQ[(size_t)(g + QPF) * 1024 + a * 64 + lane];
            }
            f32x4* ZG = (f32x4*)(p.ws + OFF_ZG) + ((size_t)(chain * 16 + g) * 4 + w) * 256;
#pragma unroll
            for (int a = 0; a < 4; ++a) ZG[a * 64 + lane] = acc[a];
            const bf16x8 zb0 = __builtin_bit_cast(bf16x8, packz(acc[0], acc[1])), zb1 = __builtin_bit_cast(bf16x8, packz(acc[2], acc[3]));
            const bf16_t* CP = (const bf16_t*)lds + g * 4096;
#pragma unroll
            for (int a = 0; a < 4; ++a) {
                const bf16_t* s0 = CP + (16 * a + fr) * 64 + 4 * fq;
                const u32x2 l0 = *(const u32x2*)s0, h0 = *(const u32x2*)(s0 + 16), l1 = *(const u32x2*)(s0 + 32), h1 = *(const u32x2*)(s0 + 48);
                f32x4 ini = __builtin_amdgcn_mfma_f32_16x16x32_bf16(__builtin_bit_cast(bf16x8, (u32x4){l0.x, l0.y, h0.x, h0.y}), zb0, qc[a], 0, 0, 0);
                acc[a] = __builtin_amdgcn_mfma_f32_16x16x32_bf16(__builtin_bit_cast(bf16x8, (u32x4){l1.x, l1.y, h1.x, h1.y}), zb1, ini, 0, 0, 0);
            }
        }
    }
}

DI void phase_scanC(const Params& p, int bid, int nblk, char* lds) {
    const int lane = threadIdx.x & 63, w8 = threadIdx.x >> 6, w = w8 & 3, fr = lane & 15, fq = lane >> 4;
    bf16_t* mix = (bf16_t*)(p.ws + OFF_MIX);
    const float* dot = (const float*)(p.ws + OFF_DOT);
    for (int unit = bid * 2 + (w8 >> 2); unit < 256 * 8; unit += nblk * 2) {
        const int c = 4 + (unit >> 3), h = unit & 7;
        f32x4 y[4];
#pragma unroll
        for (int ni = 0; ni < 4; ++ni) y[ni] = (f32x4){0, 0, 0, 0};
#pragma unroll
        for (int dir = 0; dir < 2; ++dir) {
            const int chain = dir * 8 + h, npos = chain_pos(c, dir);
            const u32x4* Zg = (const u32x4*)(p.ws + OFF_Z) + ((size_t)chain * NCH + npos) * 512;
            const bf16_t* Wg = (const bf16_t*)(p.ws + OFF_WYT) + ((size_t)((c - 4) * 8 + h) * 2 + dir) * 4096;
            const u32x2* Yg = (const u32x2*)(p.ws + OFF_YL) + ((size_t)((c - 4) * 8 + h) * 2 + dir) * 1024;
            const int rho = 16 * w + fr, row = dir ? 63 - rho : rho;
            bf16x8 af[2];
#pragma unroll
            for (int s2 = 0; s2 < 2; ++s2) {
                const u32x2 lo = *(const u32x2*)(Wg + row * 64 + 32 * s2 + 4 * fq), hi = *(const u32x2*)(Wg + row * 64 + 32 * s2 + 16 + 4 * fq);
                af[s2] = __builtin_bit_cast(bf16x8, (u32x4){lo.x, lo.y, hi.x, hi.y});
            }
#pragma unroll
            for (int ni = 0; ni < 4; ++ni) {
                const u32x2 yl = Yg[(w * 4 + ni) * 64 + lane];
                f32x4 acc = {bflo(yl.x), bfhi(yl.x), bflo(yl.y), bfhi(yl.y)};
                acc = __builtin_amdgcn_mfma_f32_16x16x32_bf16(af[0], __builtin_bit_cast(bf16x8, Zg[(ni * 2 + 0) * 64 + lane]), acc, 0, 0, 0);
                acc = __builtin_amdgcn_mfma_f32_16x16x32_bf16(af[1], __builtin_bit_cast(bf16x8, Zg[(ni * 2 + 1) * 64 + lane]), acc, 0, 0, 0);
                y[ni] += acc;
            }
        }
        float* ty = (float*)lds + w8 * (16 * 68);
#pragma unroll
        for (int ni = 0; ni < 4; ++ni)
#pragma unroll
            for (int e = 0; e < 4; ++e) ty[(4 * fq + e) * 68 + 16 * ni + fr] = y[ni][e];
        asm volatile("s_waitcnt lgkmcnt(0)" ::: "memory"); __builtin_amdgcn_wave_barrier();
        {
            const int tl = lane >> 2, seg = lane & 3, t = (c - 4) * 64 + 16 * w + tl, g = t + CTX, cch = h * 64 + 16 * seg;
            float yv[16];
#pragma unroll
            for (int q = 0; q < 4; ++q) { const f32x4 v4 = *(const f32x4*)(ty + tl * 68 + 16 * seg + 4 * q); yv[4 * q] = v4[0]; yv[4 * q + 1] = v4[1]; yv[4 * q + 2] = v4[2]; yv[4 * q + 3] = v4[3]; }
            float sm = 0.f;
#pragma unroll
            for (int j = 0; j < 16; ++j) sm += yv[j];
            sm += __shfl_xor(sm, 1, 64); sm += __shfl_xor(sm, 2, 64);
            const float mean = sm * (1.f / 64.f);
            float q2 = 0.f;
#pragma unroll
            for (int j = 0; j < 16; ++j) { const float d = yv[j] - mean; q2 += d * d; }
            q2 += __shfl_xor(q2, 1, 64); q2 += __shfl_xor(q2, 2, 64);
            const float rs = rsqrtf(q2 * (1.f / 64.f) + 64e-5f);
            const float bon = dot[((size_t)g * 8 + h) * 2] + dot[((size_t)g * 8 + h) * 2 + 1];
            float vv[16], gg[16], o[16];
            unpack8(*(const u32x4*)((const bf16_t*)(p.ws + OFF_V) + (size_t)t * DR + cch), vv); unpack8(*(const u32x4*)((const bf16_t*)(p.ws + OFF_V) + (size_t)t * DR + cch + 8), vv + 8);
            unpack8(*(const u32x4*)((const bf16_t*)(p.ws + OFF_G) + (size_t)t * DR + cch), gg); unpack8(*(const u32x4*)((const bf16_t*)(p.ws + OFF_G) + (size_t)t * DR + cch + 8), gg + 8);
#pragma unroll
            for (int q = 0; q < 4; ++q) {
                const f32x4 gw = *(const f32x4*)(p.gn_w + cch + 4 * q), gb = *(const f32x4*)(p.gn_b + cch + 4 * q);
#pragma unroll
                for (int j = 0; j < 4; ++j) o[4 * q + j] = ((yv[4 * q + j] - mean) * rs * gw[j] + gb[j] + bon * vv[4 * q + j]) * gg[4 * q + j];
            }
            *(u32x4*)(mix + (size_t)t * D + cch) = pack8(o); *(u32x4*)(mix + (size_t)t * D + cch + 8) = pack8(o + 8);
        }
        __builtin_amdgcn_wave_barrier();
    }
}

struct EpiX2 { float* o; const float* x; const float* gt; const float* rowtab; const float* coltab; int row0, col0;
    DI f32x16 pre(const f32x16& a, const f32x16&) const { return a; }
    DI void post(int r, int c, const f32x4& v) const {
        const int t = row0 + r, d = col0 + c;
        const float* pt = d < 512 ? rowtab + (t >> 6) * 512 + d : coltab + (t & 63) * 512 + (d - 512);
        const f32x4 xv = *(const f32x4*)(x + (size_t)t * D + d), pv = *(const f32x4*)pt, gv = *(const f32x4*)(gt + d);
        *(f32x4*)(o + (size_t)t * D + d) = xv + pv + gv * v; } };
struct EpiNull { DI f32x16 pre(const f32x16& a, const f32x16&) const { return a; } DI void post(int, int, const f32x4& v) const { asm volatile("" :: "v"(v)); } };
DI void phase_g2_null(const Params& p, int bid, int nblk, char* lds) {
    const bf16_t* mix = (const bf16_t*)(p.ws + OFF_MIX);
    const XcdOrder ord(bid, nblk, 64 * 4);
    for (int i = 0, q; (q = ord.item(i)) >= 0; ++i) {
        int tm, tn; tile_rc(q, 64, 4, tm, tn);
        PlainA al{mix + (size_t)tm * 256 * D, D};
        EpiNull e;
        gemm8<1, true, 2>(al, (const bf16_t*)(p.ws + OFF_WOUTB) + tn * 256, nullptr, D, D, lds, e);
    }
}
DI void phase_g2(const Params& p, int bid, int nblk, char* lds) {
    const bf16_t* mix = (const bf16_t*)(p.ws + OFF_MIX);
    const XcdOrder ord(bid, nblk, 64 * 4);
    for (int i = 0, q; (q = ord.item(i)) >= 0; ++i) {
        int tm, tn; tile_rc(q, 64, 4, tm, tn);
        PlainA al{mix + (size_t)tm * 256 * D, D};
        EpiX2 e{(float*)(p.ws + OFF_X2), p.x, (const float*)(p.ws + OFF_MODX) + 2048, (const float*)(p.ws + OFF_ROWTAB), (const float*)(p.ws + OFF_COLTAB), tm * 256, tn * 256};
        gemm8<1, true, 2>(al, (const bf16_t*)(p.ws + OFF_WOUTB) + tn * 256, nullptr, D, D, lds, e);
    }
}

DI float router_w(const Params& p, int k, int n) { return n < 4 ? p.w_rg[k * 4 + n] : (n < 36 ? p.w_re[k * 32 + (n - 4)] : 0.f); }
DI void phase_router_prep(const Params& p, int bid, int nblk) {
    const float* modx = (const float*)(p.ws + OFF_MODX);
    float* wp = (float*)(p.ws + OFF_WP); float* b2 = (float*)(p.ws + OFF_B2);
    for (int idx = bid * NTH + threadIdx.x; idx < 64 * 4 * 3 * 64; idx += nblk * NTH) {
        const int ln = idx & 63, r = idx >> 6, nt = r % 3, me = r / 3, e = me & 3, m = me >> 2;
        const int k = 16 * m + 4 * (ln >> 4) + e, n = 16 * nt + (ln & 15);
        wp[idx] = p.norm2_g[k] * (1.f + modx[4096 + k]) * router_w(p, k, n);
    }
    const int lane = threadIdx.x & 63, wv = bid * NWV + (threadIdx.x >> 6);
    if (wv < 36) {
        float sacc = 0.f;
        for (int k = lane; k < D; k += 64) sacc += modx[3072 + k] * router_w(p, k, wv);
        sacc = wave_sum(sacc);
        if (lane == 0) b2[wv] = sacc + (wv < 4 ? p.b_rg[wv] : p.b_re[wv - 4]);
    }
}

DI void phase_router(const Params& p, int bid, int nblk, char* lds, bool dry = false) {
    const int lane = threadIdx.x & 63, wid = threadIdx.x >> 6, tr = lane & 15, kq = lane >> 4;
    const float* x2 = (const float*)(p.ws + OFF_X2); const float* modx = (const float*)(p.ws + OFF_MODX);
    const float* wp = (const float*)(p.ws + OFF_WP); const float* b2 = (const float*)(p.ws + OFF_B2);
    bf16_t* h2 = (bf16_t*)(p.ws + OFF_H2); int* cnt = (int*)(p.ws + OFF_CNT); float* gate = (float*)(p.ws + OFF_GATE); int* list = (int*)(p.ws + OFF_LIST);
    float* slog = (float*)lds + wid * (16 * 49);
    for (int task = wid * nblk + bid; task < S / 16; task += nblk * NWV) {
        const int t0 = task * 16;
        const float* xr = x2 + (size_t)(t0 + tr) * D + 4 * kq;
        f32x4 acc[3];
#pragma unroll
        for (int i = 0; i < 3; ++i) acc[i] = (f32x4){0, 0, 0, 0};
        float ss = 0.f;
#pragma unroll 4
        for (int m = 0; m < 64; ++m) {
            const f32x4 xv = *(const f32x4*)(xr + 16 * m);
            ss += xv[0] * xv[0] + xv[1] * xv[1] + xv[2] * xv[2] + xv[3] * xv[3];
#pragma unroll
            for (int e = 0; e < 4; ++e)
#pragma unroll
                for (int nt = 0; nt < 3; ++nt) acc[nt] = __builtin_amdgcn_mfma_f32_16x16x4f32(xv[e], wp[((m * 4 + e) * 3 + nt) * 64 + lane], acc[nt], 0, 0, 0);
        }
        ss += __shfl_xor(ss, 16, 64); ss += __shfl_xor(ss, 32, 64);
        const float rstd = rsqrtf(ss * (1.f / 1024.f) + 1e-6f);
#pragma unroll
        for (int nt = 0; nt < 3; ++nt)
#pragma unroll
            for (int r = 0; r < 4; ++r) slog[(4 * kq + r) * 49 + 16 * nt + tr] = acc[nt][r];
        asm volatile("s_waitcnt lgkmcnt(0)" ::: "memory"); __builtin_amdgcn_wave_barrier();
        if (lane < 16) {
            const int t = t0 + lane;
            const float* lg = slog + lane * 49;
            const float l0 = rstd * lg[0] + b2[0], l1 = rstd * lg[1] + b2[1], l2 = rstd * lg[2] + b2[2], l3 = rstd * lg[3] + b2[3];
            int grp = 0; float mx = l0;
            if (l1 > mx) { mx = l1; grp = 1; }
            if (l2 > mx) { mx = l2; grp = 2; }
            if (l3 > mx) { mx = l3; grp = 3; }
            const float den = __expf(l0 - mx) + __expf(l1 - mx) + __expf(l2 - mx) + __expf(l3 - mx);
            const float pgrp = 1.f / den;
            int i1 = 0, i2 = -1; float v1 = -3.0e38f, v2 = -3.0e38f;
            for (int n = 0; n < 8; ++n) {
                const float sv = rstd * lg[4 + grp * 8 + n] + b2[4 + grp * 8 + n];
                if (sv > v1) { v2 = v1; i2 = i1; v1 = sv; i1 = n; } else if (sv > v2) { v2 = sv; i2 = n; }
            }
            const float e2 = __expf(v2 - v1), g1 = pgrp / (1.f + e2), g2v = pgrp * e2 / (1.f + e2);
            const int ea = grp * 8 + i1, eb = grp * 8 + i2;
            if (!dry) {
                const int pa = atomicAdd(&cnt[ea], 1), pb = atomicAdd(&cnt[eb], 1);
                list[ea * LCAP + pa] = t * 2; list[eb * LCAP + pb] = t * 2 + 1;
            }
            gate[t * 2] = g1; gate[t * 2 + 1] = g2v;
        }
        for (int r = 0; r < 16; ++r) {
            const float rs = __shfl(rstd, r, 64);
            const float* src = x2 + (size_t)(t0 + r) * D;
#pragma unroll
            for (int i = 0; i < 4; ++i) {
                const int d = (i * 64 + lane) * 4;
                const f32x4 v = *(const f32x4*)(src + d), gg = *(const f32x4*)(p.norm2_g + d), sh = *(const f32x4*)(modx + 3072 + d), sc = *(const f32x4*)(modx + 4096 + d);
                f32x4 hv;
#pragma unroll
                for (int j = 0; j < 4; ++j) hv[j] = (v[j] * rs * gg[j]) * (1.f + sc[j]) + sh[j];
                u32x2 pk = {pack2(hv[0], hv[1]), pack2(hv[2], hv[3])};
                *(u32x2*)(h2 + (size_t)(t0 + r) * D + d) = pk;
            }
        }
        __builtin_amdgcn_wave_barrier();
    }
}

DI void moe_tiles(const int* cnt, int* tstart  ) {
    if (threadIdx.x == 0) { int acc = 0; for (int e = 0; e < NE; ++e) { tstart[e] = acc; acc += (cnt[e] + 255) >> 8; } tstart[NE] = acc; }
    __syncthreads();
}
struct EpiHid { bf16_t* o;
    DI f32x16 pre(const f32x16& g, const f32x16& u) const { f32x16 h;
#pragma unroll
        for (int j = 0; j < 16; ++j) h[j] = g[j] * sigmoidf_(g[j]) * u[j];
        return h; }
    DI void post(int r, int c, const f32x4& v) const { u32x2 pk = {pack2(v[0], v[1]), pack2(v[2], v[3])}; *(u32x2*)(o + (size_t)r * DE + c) = pk; } };
DI void phase_g3(const Params& p, int bid, int nblk, char* lds) {
    int* tstart = (int*)(lds + GEMM_LDS);
    const int* cnt = (const int*)(p.ws + OFF_CNT); const int* list = (const int*)(p.ws + OFF_LIST);
    const bf16_t* h2 = (const bf16_t*)(p.ws + OFF_H2); bf16_t* hid = (bf16_t*)(p.ws + OFF_HID);
    moe_tiles(cnt, tstart);
    const int ntiles = tstart[NE];
    const int nitems = ntiles * 4, nfull = (nitems / nblk) * nblk, nhalf = 2 * (nitems - nfull);
    const XcdOrder ord(bid, nblk, nfull);
    for (int i = 0, item; (item = ord.item(i)) >= 0; ++i) {
        const int ti = item >> 2, cj = item & 3;
        int e = 0; while (e < NE - 1 && tstart[e + 1] <= ti) ++e;
        const int lt = ti - tstart[e], ne = cnt[e];
        GatherA al;
#pragma unroll
        for (int i2 = 0; i2 < 4; ++i2) { const int row = (8 * i2 + (threadIdx.x >> 6)) * 8 + ((threadIdx.x & 63) >> 3), pos = lt * 256 + row; const int tok = pos < ne ? (list[e * LCAP + pos] >> 1) : 0; al.rp[i2] = h2 + (size_t)tok * D; }
        EpiHid epi{hid + (size_t)ti * 256 * DE + cj * 128};
        gemm8<2, false, 1>(al, p.w_gate + (size_t)e * D * DE + cj * 128, p.w_up + (size_t)e * D * DE + cj * 128, DE, D, lds, epi);
    }
    for (int n = bid; n < nhalf; n += nblk) {
        const int item = nfull + (n >> 1), hf = n & 1, ti = item >> 2, cj = item & 3;
        int e = 0; while (e < NE - 1 && tstart[e + 1] <= ti) ++e;
        const int lt = ti - tstart[e], ne = cnt[e];
        GatherA al;
#pragma unroll
        for (int i2 = 0; i2 < 2; ++i2) { const int row = hf * 128 + (8 * i2 + (threadIdx.x >> 6)) * 8 + ((threadIdx.x & 63) >> 3), pos = lt * 256 + row; const int tok = pos < ne ? (list[e * LCAP + pos] >> 1) : 0; al.rp[i2] = h2 + (size_t)tok * D; }
        al.rp[2] = al.rp[0]; al.rp[3] = al.rp[1];
        EpiHid epi{hid + ((size_t)ti * 256 + hf * 128) * DE + cj * 128};
        gemm8<2, false, 1, GatherA, EpiHid, 2>(al, p.w_gate + (size_t)e * D * DE + cj * 128, p.w_up + (size_t)e * D * DE + cj * 128, DE, D, lds, epi);
    }
}
struct EpiDown { bf16_t* ybuf; const int* lst; const float* gate; int nvalid; int col0;
    DI f32x16 pre(const f32x16& a, const f32x16&) const { return a; }
    DI void post(int r, int c, const f32x4& v) const {
        if (r >= nvalid) return; const int slot = lst[r]; const float g = gate[slot];
        u32x2 pk = {pack2(v[0] * g, v[1] * g), pack2(v[2] * g, v[3] * g)}; *(u32x2*)(ybuf + (size_t)slot * D + col0 + c) = pk; } };
DI void phase_g4(const Params& p, int bid, int nblk, char* lds) {
    int* tstart = (int*)(lds + GEMM_LDS);
    const int* cnt = (const int*)(p.ws + OFF_CNT); const int* list = (const int*)(p.ws + OFF_LIST);
    const bf16_t* hid = (const bf16_t*)(p.ws + OFF_HID);
    moe_tiles(cnt, tstart);
    const int ntiles = tstart[NE];
    const XcdOrder ord(bid, nblk, ntiles * 8);
    for (int i = 0, item; (item = ord.item(i)) >= 0; ++i) {
        const int ti = item >> 3, cj = item & 7;
        int e = 0; while (e < NE - 1 && tstart[e + 1] <= ti) ++e;
        const int lt = ti - tstart[e], ne = cnt[e];
        PlainA al{hid + (size_t)ti * 256 * DE, DE};
        EpiDown epi{(bf16_t*)(p.ws + OFF_YBUF), list + e * LCAP + lt * 256, (const float*)(p.ws + OFF_GATE), ne - lt * 256, cj * 128};
        gemm8<1, false, 1>(al, p.w_down + (size_t)e * DE * D + cj * 128, nullptr, D, DE, lds, epi);
    }
}

DI void phase_final(const Params& p, int bid, int nblk) {
    const int lane = threadIdx.x & 63, wid = threadIdx.x >> 6;
    const float* x2 = (const float*)(p.ws + OFF_X2); const float* gt = (const float*)(p.ws + OFF_MODX) + 5120; const bf16_t* yb = (const bf16_t*)(p.ws + OFF_YBUF);
    for (int tp = bid * NWV + wid; tp < S / 2; tp += nblk * NWV) {
        f32x4 v[2][4]; float ss[2] = {0.f, 0.f};
        u32x2 ya[2][4], ybv[2][4];
#pragma unroll
        for (int r = 0; r < 2; ++r)
#pragma unroll
            for (int i = 0; i < 4; ++i) {
                const int t = 2 * tp + r, d = (i * 64 + lane) * 4;
                v[r][i] = *(const f32x4*)(x2 + (size_t)t * D + d);
                ya[r][i] = *(const u32x2*)(yb + (size_t)(2 * t) * D + d); ybv[r][i] = *(const u32x2*)(yb + (size_t)(2 * t + 1) * D + d);
            }
#pragma unroll
        for (int r = 0; r < 2; ++r)
#pragma unroll
            for (int i = 0; i < 4; ++i) {
                const int d = (i * 64 + lane) * 4; const f32x4 g = *(const f32x4*)(gt + d); const u32x2 a = ya[r][i], b = ybv[r][i];
                v[r][i][0] += g[0] * (bflo(a.x) + bflo(b.x)); v[r][i][1] += g[1] * (bfhi(a.x) + bfhi(b.x));
                v[r][i][2] += g[2] * (bflo(a.y) + bflo(b.y)); v[r][i][3] += g[3] * (bfhi(a.y) + bfhi(b.y));
                ss[r] += v[r][i][0] * v[r][i][0] + v[r][i][1] * v[r][i][1] + v[r][i][2] * v[r][i][2] + v[r][i][3] * v[r][i][3];
            }
#pragma unroll
        for (int r = 0; r < 2; ++r) {
            const float rstd = rsqrtf(wave_sum(ss[r]) * (1.f / 1024.f) + 1e-6f);
#pragma unroll
            for (int i = 0; i < 4; ++i) {
                const int d = (i * 64 + lane) * 4; const f32x4 fg = *(const f32x4*)(p.final_g + d); f32x4 o;
#pragma unroll
                for (int j = 0; j < 4; ++j) o[j] = v[r][i][j] * rstd * fg[j];
                *(f32x4*)(p.out + (size_t)(2 * tp + r) * D + d) = o;
            }
        }
    }
}

#define XB_TMO      128
#define XB_XCNT(j)  (256  + 64 * (j))
#define XB_XSUB(j)  (1280 + 64 * (j))
#define XB_XGEN(j)  (2304 + 64 * (j))
#define XB_TOP      3328
#define XB_TOPGEN   3392
#define XCD_BAR_WORDS 3456
#define XB_SPIN_CAP (1u << 18)
DI unsigned xb_ld(unsigned* p) { return __hip_atomic_load(p, __ATOMIC_RELAXED, __HIP_MEMORY_SCOPE_AGENT); }
DI unsigned xb_add(unsigned* p, unsigned v) { return __hip_atomic_fetch_add(p, v, __ATOMIC_RELAXED, __HIP_MEMORY_SCOPE_AGENT); }
DI unsigned xb_xcc_id() { return (unsigned)__builtin_amdgcn_s_getreg((3 << 11) | 20) & 0xFu; }
#define XB_SPIN(cond, bar) do { unsigned _sp = 0; while (cond) { __builtin_amdgcn_s_sleep(1); \
    if ((++_sp & 255u) == 0u) { if (xb_ld(&(bar)[XB_TMO])) break; if (_sp > XB_SPIN_CAP) { atomicAdd(&(bar)[XB_TMO], 1u); break; } } } } while (0)
struct XcdBarrier { unsigned* bar; unsigned x; volatile LAS unsigned* st; };
DI XcdBarrier xcd_barrier_post(unsigned* bar, volatile LAS unsigned* st) {
    XcdBarrier b; b.bar = bar; b.x = xb_xcc_id(); b.st = st;
    if (threadIdx.x == 0) (void)xb_add(&bar[XB_XCNT(b.x)], 1u);
    return b;
}
DI void xcd_barrier_complete(unsigned* bar, unsigned x, unsigned& nloc, unsigned& nx) {
    const unsigned G = gridDim.x * gridDim.y * gridDim.z;
    unsigned sum, cnt, mine, sp = 0u;
    for (;;) {
        sum = 0u; cnt = 0u; mine = 0u;
#pragma unroll
        for (unsigned j = 0; j < 16; ++j) { const unsigned c = xb_ld(&bar[XB_XCNT(j)]); sum += c; cnt += (c > 0u) ? 1u : 0u; mine = (j == x) ? c : mine; }
        if (sum == G) break;
        __builtin_amdgcn_s_sleep(1);
        if ((++sp & 255u) == 0u) { if (xb_ld(&bar[XB_TMO])) break; if (sp > XB_SPIN_CAP) { atomicAdd(&bar[XB_TMO], 1u); break; } }
    }
    nloc = mine > 0u ? mine : 1u; nx = cnt > 0u ? cnt : 1u;
}
DI void xcd_barrier(const XcdBarrier& b) {
    asm volatile("s_waitcnt vmcnt(0)" ::: "memory");
    __syncthreads();
    if (threadIdx.x == 0) {
        unsigned* bar = b.bar;
        __builtin_amdgcn_s_waitcnt(0);
        unsigned nloc = b.st[0], nx = b.st[1];
        if (nloc == 0u) { xcd_barrier_complete(bar, b.x, nloc, nx); b.st[0] = nloc; b.st[1] = nx; }
        const unsigned old = xb_add(&bar[XB_XSUB(b.x)], 1u);
        const unsigned gen = old / nloc;
        if (old + 1u == (gen + 1u) * nloc) {
            __builtin_amdgcn_fence(__ATOMIC_RELEASE, "agent");
            asm volatile("s_waitcnt vmcnt(0)" ::: "memory");
            const unsigned og = xb_add(&bar[XB_TOP], 1u);
            const unsigned tg = og / nx;
            if (og + 1u == (tg + 1u) * nx) xb_add(&bar[XB_TOPGEN], 1u);
            else XB_SPIN(xb_ld(&bar[XB_TOPGEN]) == tg, bar);
            __builtin_amdgcn_fence(__ATOMIC_ACQUIRE, "agent");
            xb_add(&bar[XB_XGEN(b.x)], 1u);
            asm volatile("s_waitcnt vmcnt(0)" ::: "memory");
        } else {
            XB_SPIN(xb_ld(&bar[XB_XGEN(b.x)]) == gen, bar);
            __builtin_amdgcn_fence(__ATOMIC_ACQUIRE, "agent");
            asm volatile("s_waitcnt vmcnt(0)" ::: "memory");
        }
    }
    __syncthreads();
}

#ifndef PROBE
#define PROBE 0
#endif
constexpr int MEGA_LDS = SCANA_LDS > (GEMM_LDS + 256) ? SCANA_LDS : (GEMM_LDS + 256);
__global__ void __launch_bounds__(NTH) k_mega(Params p) {
    extern __shared__ __attribute__((aligned(16))) char lds[];
    const int bid = blockIdx.x, nblk = gridDim.x;
    volatile LAS unsigned* st = (volatile LAS unsigned*)(lds + MEGA_LDS);
    if (threadIdx.x < 4) st[threadIdx.x] = 0u;
    __syncthreads();
    const XcdBarrier gb = xcd_barrier_post((unsigned*)(p.ws + OFF_BAR), st);
#define GSYNC() xcd_barrier(gb)
    phase_p0(p, bid, nblk, lds); GSYNC();
    if (PROBE == 1) { phase_p0(p, bid, nblk, lds); GSYNC(); }
    phase_xn(p, bid, nblk); phase_router_prep(p, bid, nblk); GSYNC();
    if (PROBE == 2) { phase_xn(p, bid, nblk); GSYNC(); }
    phase_g1(p, bid, nblk, lds); GSYNC();
    if (PROBE == 3) { phase_g1(p, bid, nblk, lds); GSYNC(); }
    phase_pool(p, bid, nblk);
    phase_scanA(p, bid, nblk, lds); GSYNC();
    if (PROBE == 4) { phase_scanA(p, bid, nblk, lds); GSYNC(); }
    if (PROBE == 15) { phase_pool(p, bid, nblk); GSYNC(); }
    if (PROBE == 16) { GSYNC(); GSYNC(); GSYNC(); GSYNC(); }
    if (threadIdx.x < 256) for (int it = bid; it < 256; it += nblk) chain_run<1>(p, it >> 4, it & 15);
    GSYNC();
    if (PROBE == 5) { if (threadIdx.x < 256) for (int it = bid; it < 256; it += nblk) chain_run<1>(p, it >> 4, it & 15); GSYNC(); }
    if (bid < 16) chain_groups(p, bid, lds); else phase_poolgemm(p, bid - 16, nblk - 16, lds);
    GSYNC();
    if (PROBE == 6) { if (bid < 16) chain_groups(p, bid, lds); GSYNC(); }
    if (threadIdx.x < 256) for (int it = bid; it < 256; it += nblk) chain_run<3>(p, it >> 4, it & 15);
    GSYNC();
    if (PROBE == 7) { if (threadIdx.x < 256) for (int it = bid; it < 256; it += nblk) chain_run<3>(p, it >> 4, it & 15); GSYNC(); }
    phase_scanC(p, bid, nblk, lds); GSYNC();
    if (PROBE == 8) { phase_scanC(p, bid, nblk, lds); GSYNC(); }
    phase_g2(p, bid, nblk, lds); GSYNC();
    if (PROBE == 9) { phase_g2(p, bid, nblk, lds); GSYNC(); }
    if (PROBE == 14) { phase_g2_null(p, bid, nblk, lds); GSYNC(); }
    if (PROBE == 10) { phase_router(p, bid, nblk, lds, true); GSYNC(); }
    phase_router(p, bid, nblk, lds); GSYNC();
    phase_g3(p, bid, nblk, lds); GSYNC();
    if (PROBE == 11) { phase_g3(p, bid, nblk, lds); GSYNC(); }
    phase_g4(p, bid, nblk, lds); GSYNC();
    if (PROBE == 12) { phase_g4(p, bid, nblk, lds); GSYNC(); }
    if (PROBE == 13) { phase_final(p, bid, nblk); GSYNC(); }
    phase_final(p, bid, nblk);
}

extern "C" void kernel_launch(void* const* d_in, const int* in_sizes, int n_in, void* d_out, int out_size, void* d_ws, size_t ws_size, hipStream_t stream) {
    if (ws_size < WS_NEED) { fprintf(stderr, "workspace too small: %zu < %zu\n", ws_size, (size_t)WS_NEED); return; }
    Params p{};
    const float** f = (const float**)&p;
    for (int i = 0; i < 36; ++i) f[i] = (const float*)d_in[i];
    p.out = (float*)d_out; p.ws = (char*)d_ws;
    static int grid_blocks = 0;
    if (!grid_blocks) {
        (void)hipFuncSetAttribute((const void*)k_mega, hipFuncAttributeMaxDynamicSharedMemorySize, MEGA_LDS + 16);
        int dev = 0, cus = 0, per_cu = 0;
        (void)hipGetDevice(&dev);
        (void)hipDeviceGetAttribute(&cus, hipDeviceAttributeMultiprocessorCount, dev);
        (void)hipOccupancyMaxActiveBlocksPerMultiprocessor(&per_cu, k_mega, NTH, MEGA_LDS + 16);
        if (per_cu > 1) per_cu = 1;
        grid_blocks = cus * per_cu;
    }
    (void)hipMemsetAsync((char*)d_ws + OFF_BAR, 0, 16384, stream);
    void* args[] = {&p};
    hipError_t e = hipLaunchCooperativeKernel((const void*)k_mega, dim3(grid_blocks), dim3(NTH), args, MEGA_LDS + 16, stream);
    if (e != hipSuccess) fprintf(stderr, "cooperative launch failed: %s (grid %d)\n", hipGetErrorString(e), grid_blocks);
}
```

```cpp
#include <hip/hip_runtime.h>
#include <stdint.h>
#include <stdio.h>
#include <hip/hip_cooperative_groups.h>
namespace cg = cooperative_groups;

#define DI __device__ __forceinline__
typedef unsigned short bf16_t;
typedef short bf16x8 __attribute__((ext_vector_type(8)));
typedef short s16x4 __attribute__((ext_vector_type(4)));
typedef float f32x4 __attribute__((ext_vector_type(4)));
typedef float f32x2 __attribute__((ext_vector_type(2)));
typedef __bf16 bf16x2_t __attribute__((ext_vector_type(2)));
typedef unsigned u32x4 __attribute__((ext_vector_type(4)));
typedef unsigned u32x2 __attribute__((ext_vector_type(2)));
#define LAS __attribute__((address_space(3)))

constexpr int D = 1024, S = 16384, CTX = 256, NT = S + CTX, DIN = 2432, DSH = 1920, DR = 512;
constexpr int C_WLF = 1536, C_WLB = 1600, C_ALF = 1664, C_ALB = 1728, C_GL = 1792, C_POOL = 1920;
constexpr int NE = 32, DE = 512, LCAP = 32768;
constexpr float DECAY_SCALE = 0.6065306597f;
constexpr int NTH = 512, NWV = 8;

constexpr int NCH = NT / 64;
constexpr size_t SZ_U = (size_t)NT * DIN * 2;
constexpr size_t SZ_CH = (size_t)16 * NCH * 8192;
constexpr size_t OFF_U = 0;
constexpr size_t OFF_XN = OFF_U + SZ_U;
constexpr size_t OFF_P = OFF_XN;
constexpr size_t OFF_Q = OFF_P + SZ_CH;
constexpr size_t OFF_WYT = OFF_Q + SZ_CH;
constexpr size_t OFF_YL = OFF_WYT + (size_t)256 * 16 * 8192;
constexpr size_t OFF_V = OFF_YL + (size_t)256 * 16 * 8192;
constexpr size_t OFF_G = OFF_V + (size_t)S * DR * 2;
constexpr size_t OFF_MIX = OFF_G + (size_t)S * DR * 2;
constexpr size_t OFF_SMALL = OFF_MIX + (size_t)S * D * 2;
constexpr size_t OFF_MODX = OFF_SMALL, OFF_MODC = OFF_MODX + 6144 * 4;
constexpr size_t OFF_ROWTAB = OFF_MODC + 6144 * 4, OFF_COLTAB = OFF_ROWTAB + 256 * 512 * 4;
constexpr size_t OFF_CNT = OFF_COLTAB + 64 * 512 * 4;
constexpr size_t OFF_GATE = OFF_CNT + 256;
constexpr size_t OFF_LIST = OFF_GATE + (size_t)S * 2 * 4;
constexpr size_t OFF_DOT = OFF_LIST + (size_t)NE * LCAP * 4;
constexpr size_t OFF_WP = OFF_DOT + (size_t)NT * 16 * 4;
constexpr size_t OFF_B2 = OFF_WP + 64 * 4 * 3 * 64 * 4;
constexpr size_t OFF_BAR = OFF_B2 + 256;
constexpr size_t OFF_WINB = OFF_BAR + 16384;
constexpr size_t OFF_WOUTB = OFF_WINB + (size_t)D * DIN * 2;
constexpr size_t WS_NEED = OFF_WOUTB + (size_t)D * D * 2;
constexpr size_t OFF_Z = OFF_U;
constexpr size_t OFF_X2 = OFF_P;
constexpr size_t OFF_YBUF = OFF_WYT;
constexpr size_t OFF_H2 = OFF_U;
constexpr size_t OFF_HID = OFF_U + SZ_CH;
constexpr size_t OFF_CP = OFF_U + SZ_CH;
constexpr size_t OFF_CQ = OFF_CP + 256 * 8192;
constexpr size_t OFF_ZG = OFF_CQ + 256 * 16384;

struct Params {
    const float *x, *c, *ctx, *c_ctx, *norm1_g, *w_mod, *b_mod, *w_in, *mu, *w0_f, *w2_f, *w0_b, *w2_b, *a0_f, *a2_f, *a0_b, *a2_b,
        *g2, *k_k, *k_a, *r_k_f, *r_k_b, *gn_w, *gn_b, *w_pool, *pool_scale, *w_out, *norm2_g, *w_rg, *b_rg, *w_re, *b_re,
        *w_gate, *w_up, *w_down, *final_g;
    float* out;
    char* ws;
};

DI unsigned pack2(float lo, float hi) { f32x2 v = {lo, hi}; bf16x2_t b = __builtin_convertvector(v, bf16x2_t); return __builtin_bit_cast(unsigned, b); }
DI float bf2f(bf16_t h) { return __uint_as_float(((unsigned)h) << 16); }
DI float bflo(unsigned u) { return __uint_as_float(u << 16); }
DI float bfhi(unsigned u) { return __uint_as_float(u & 0xffff0000u); }
DI void unpack8(const u32x4& p, float* f) { f[0] = bflo(p.x); f[1] = bfhi(p.x); f[2] = bflo(p.y); f[3] = bfhi(p.y); f[4] = bflo(p.z); f[5] = bfhi(p.z); f[6] = bflo(p.w); f[7] = bfhi(p.w); }
DI u32x4 pack8(const float* f) { u32x4 p; p.x = pack2(f[0], f[1]); p.y = pack2(f[2], f[3]); p.z = pack2(f[4], f[5]); p.w = pack2(f[6], f[7]); return p; }
DI float sigmoidf_(float x) { return 1.f / (1.f + __expf(-x)); }
DI float wave_sum(float v) {
#pragma unroll
    for (int o = 32; o > 0; o >>= 1) v += __shfl_xor(v, o, 64);
    return v;
}
DI f32x4 wave_sum4(f32x4 v) {
#pragma unroll
    for (int o = 32; o > 0; o >>= 1) { v[0] += __shfl_xor(v[0], o, 64); v[1] += __shfl_xor(v[1], o, 64); v[2] += __shfl_xor(v[2], o, 64); v[3] += __shfl_xor(v[3], o, 64); }
    return v;
}
typedef float f32x16 __attribute__((ext_vector_type(16)));
DI f32x16 zero16() { f32x16 z; for (int i = 0; i < 16; ++i) z[i] = 0.f; return z; }
DI s16x4 tr16(const bf16_t* a) { return __builtin_amdgcn_ds_read_tr16_b64_v4i16((LAS s16x4*)a); }
DI float pos_val(const float* rowtab, const float* coltab, int t, int d) { return d < 512 ? rowtab[(t >> 6) * 512 + d] : coltab[(t & 63) * 512 + (d - 512)]; }

DI void phase_p0(const Params& p, int bid, int nblk, char* lds) {
    const int tid = threadIdx.x;
    float* modx = (float*)(p.ws + OFF_MODX); float* modc = (float*)(p.ws + OFF_MODC);
    float* red = (float*)lds;
    for (int item = bid; item < 96; item += nblk) {
        const int col0 = item * 64, cg = tid & 15, kg = tid >> 4;
        f32x4 ax = {0, 0, 0, 0}, ac = {0, 0, 0, 0};
        for (int kk = 0; kk < 32; ++kk) {
            const int k = kg * 32 + kk;
            const float cv = p.c[k], cc = p.c_ctx[k];
            const float sx = cv * sigmoidf_(cv), sc = cc * sigmoidf_(cc);
            const f32x4 w = *(const f32x4*)(p.w_mod + (size_t)k * 6144 + col0 + cg * 4);
            ax += w * sx; ac += w * sc;
        }
        __syncthreads();
#pragma unroll
        for (int j = 0; j < 4; ++j) { red[(kg * 64 + cg * 4 + j) * 2] = ax[j]; red[(kg * 64 + cg * 4 + j) * 2 + 1] = ac[j]; }
        __syncthreads();
        if (tid < 128) {
            const int col = tid & 63, which = tid >> 6;
            float s = 0.f;
            for (int g = 0; g < 32; ++g) s += red[(g * 64 + col) * 2 + which];
            s += p.b_mod[col0 + col];
            (which ? modc : modx)[col0 + col] = s;
        }
    }
    float* rowtab = (float*)(p.ws + OFF_ROWTAB); float* coltab = (float*)(p.ws + OFF_COLTAB);
    for (int i = bid * NTH + tid; i < (256 + 64) * 256; i += nblk * NTH) {
        const int pos = i >> 8, f = i & 255;
        const float freq = powf(10000.f, -(float)f / 256.f);
        if (pos < 256) { const float a = (float)pos * freq; rowtab[pos * 512 + f] = sinf(a); rowtab[pos * 512 + 256 + f] = cosf(a); }
        else { const int cp = pos - 256; const float a = (float)cp * freq; coltab[cp * 512 + f] = sinf(a); coltab[cp * 512 + 256 + f] = cosf(a); }
    }
    if (bid == 0 && tid < 64) ((int*)(p.ws + OFF_CNT))[tid] = 0;
    for (int pass = 0; pass < 2; ++pass) {
        const float* src = pass ? p.w_out : p.w_in; const int nc = pass ? D : DIN; bf16_t* dst = (bf16_t*)(p.ws + (pass ? OFF_WOUTB : OFF_WINB));
        const int n8 = nc >> 3;
        for (int idx = bid * NTH + tid; idx < D * n8; idx += nblk * NTH) {
            const int k = idx / n8, g8 = idx - k * n8, blk = g8 >> 2, q = g8 & 3;
            const f32x4 lo = *(const f32x4*)(src + (size_t)k * nc + blk * 32 + 4 * q), hi = *(const f32x4*)(src + (size_t)k * nc + blk * 32 + 16 + 4 * q);
            *(u32x4*)(dst + (size_t)k * nc + blk * 32 + 8 * q) = (u32x4){pack2(lo[0], lo[1]), pack2(lo[2], lo[3]), pack2(hi[0], hi[1]), pack2(hi[2], hi[3])};
        }
    }
}

DI void phase_xn(const Params& p, int bid, int nblk) {
    const int lane = threadIdx.x & 63, wid = threadIdx.x >> 6;
    const float* modx = (const float*)(p.ws + OFF_MODX); const float* modc = (const float*)(p.ws + OFF_MODC);
    const float* rowtab = (const float*)(p.ws + OFF_ROWTAB); const float* coltab = (const float*)(p.ws + OFF_COLTAB);
    bf16_t* xn = (bf16_t*)(p.ws + OFF_XN);
    for (int gp = bid * NWV + wid; gp < NT / 2; gp += nblk * NWV) {
        const int g0 = 2 * gp; const bool isctx = g0 < CTX;
        const float* md = isctx ? modc : modx;
        f32x4 v[2][4]; float ss[2] = {0.f, 0.f};
#pragma unroll
        for (int r = 0; r < 2; ++r)
#pragma unroll
            for (int i = 0; i < 4; ++i) {
                const int g = g0 + r, t = g - CTX, d = (i * 64 + lane) * 4;
                const float* src = isctx ? p.ctx + (size_t)g * D : p.x + (size_t)t * D;
                v[r][i] = *(const f32x4*)(src + d);
                if (!isctx) v[r][i] += *(const f32x4*)(d < 512 ? rowtab + (t >> 6) * 512 + d : coltab + (t & 63) * 512 + (d - 512));
                ss[r] += v[r][i][0] * v[r][i][0] + v[r][i][1] * v[r][i][1] + v[r][i][2] * v[r][i][2] + v[r][i][3] * v[r][i][3];
            }
#pragma unroll
        for (int r = 0; r < 2; ++r) {
            const float rstd = rsqrtf(wave_sum(ss[r]) * (1.f / 1024.f) + 1e-6f);
#pragma unroll
            for (int i = 0; i < 4; ++i) {
                const int d = (i * 64 + lane) * 4;
                const f32x4 gg = *(const f32x4*)(p.norm1_g + d), sh = *(const f32x4*)(md + d), sc = *(const f32x4*)(md + 1024 + d);
                f32x4 o;
#pragma unroll
                for (int j = 0; j < 4; ++j) o[j] = (v[r][i][j] * rstd * gg[j]) * (1.f + sc[j]) + sh[j];
                u32x2 pk = {pack2(o[0], o[1]), pack2(o[2], o[3])};
                *(u32x2*)(xn + (size_t)(g0 + r) * D + d) = pk;
            }
        }
    }
}

constexpr int GA_SZ = 256 * 128, GB_SZ = 34816, GBUF_SZ = GA_SZ + GB_SZ;
constexpr int GEMM_LDS = 2 * GBUF_SZ;
DI void glds16(const void* gsrc, char* ldst) { __builtin_amdgcn_global_load_lds((const unsigned*)gsrc, (LAS unsigned*)ldst, 16, 0, 0); }
template <int NB, bool BGLDS, int NBLK, class AL, class EPI, int MB = 4>
DI void gemm8(const AL& al, const void* __restrict__ Bv0, const void* __restrict__ Bv1, int ldb, int K, char* lds, EPI& epi) {
    static_assert(!(BGLDS && NB == 2) && !(NB == 2 && NBLK == 2), "unsupported combination");
    constexpr int WN = 32 * NBLK, BN = 4 * WN;
    constexpr int RB = BN * 2;
    constexpr int BP = BN + 8;
    constexpr int NF4 = BN / 4;
    constexpr int NLD = (64 * NF4) / NTH;
    constexpr int NPB = (64 * RB) / (1024 * NWV);
    int tid = threadIdx.x; asm volatile("" : "+v"(tid));
    const int lane = tid & 63, wid = __builtin_amdgcn_readfirstlane(tid >> 6), wr = wid >> 2, wc = wid & 3, r32 = lane & 31, hh = lane >> 5, gi = lane >> 4, i16 = lane & 15;
    const float* B0 = (const float*)Bv0; const float* B1 = (const float*)Bv1; const bf16_t* Bb = (const bf16_t*)Bv0;
    f32x16 acc0[MB][NBLK], acc1[MB][NBLK];
#pragma unroll
    for (int m = 0; m < MB; ++m)
#pragma unroll
        for (int n = 0; n < NBLK; ++n) { acc0[m][n] = zero16(); acc1[m][n] = zero16(); }
    f32x4 rb0[NLD], rb1[NLD];
    const int T = K >> 6;
    const bf16_t* arow[MB];
#pragma unroll
    for (int i = 0; i < MB; ++i) { const int row = (8 * i + wid) * 8 + (lane >> 3); arow[i] = al.rowptr(i, row) + (((lane & 7) ^ ((row >> 1) & 7)) << 3); }
    int bsrc[NPB];
#pragma unroll
    for (int i = 0; i < NPB; ++i) { const int k = (8 * i + wid) * (1024 / RB) + lane / (RB / 16), pp = lane % (RB / 16); bsrc[i] = k * ldb + ((((pp >> 1) ^ (k & 7)) << 1) + (pp & 1)) * 8; }
    const int a_base = (wr * (32 * MB) + r32) * 128, a_sw = (r32 >> 1) & 7;
    const int b_off = (8 * (gi >> 1) + (i16 >> 2)) * BP + wc * WN + 16 * (gi & 1) + 4 * (i16 & 3);
#define G_DMA(buf, t_) do { char* dA_ = lds + (buf) * GBUF_SZ + wid * 1024 + lane * 16; \
        _Pragma("unroll") for (int i = 0; i < MB; ++i) glds16(arow[i] + (t_) * 64, dA_ + i * 8192); \
        if (BGLDS) { char* dB_ = lds + (buf) * GBUF_SZ + GA_SZ + wid * 1024 + lane * 16; \
            _Pragma("unroll") for (int i = 0; i < NPB; ++i) glds16(Bb + (size_t)(t_) * 64 * ldb + bsrc[i], dB_ + i * 8192); } } while (0)
#define G_LOADB(t_) do { const int k0_ = (t_) * 64; \
        _Pragma("unroll") for (int i = 0; i < NLD; ++i) { const int c = tid + NTH * i, kr = c / NF4, n4 = c % NF4; rb0[i] = *(const f32x4*)(B0 + (size_t)(k0_ + kr) * ldb + n4 * 4); \
            if (NB == 2) rb1[i] = *(const f32x4*)(B1 + (size_t)(k0_ + kr) * ldb + n4 * 4); } } while (0)
#define G_WRITEB(buf) do { bf16_t* sB0_ = (bf16_t*)(lds + (buf) * GBUF_SZ + GA_SZ); bf16_t* sB1_ = sB0_ + 64 * BP; \
        _Pragma("unroll") for (int i = 0; i < NLD; ++i) { const int c = tid + NTH * i, kr = c / NF4, n4 = c % NF4, slot = (n4 >> 3) * 32 + 8 * (n4 & 3) + 4 * ((n4 >> 2) & 1); \
            u32x2 pk = {pack2(rb0[i][0], rb0[i][1]), pack2(rb0[i][2], rb0[i][3])}; *(u32x2*)(sB0_ + kr * BP + slot) = pk; \
            if (NB == 2) { u32x2 pk1 = {pack2(rb1[i][0], rb1[i][1]), pack2(rb1[i][2], rb1[i][3])}; *(u32x2*)(sB1_ + kr * BP + slot) = pk1; } } } while (0)
#define G_READ(buf, ks, AF, BF0, BF1) do { const char* sA_ = lds + (buf) * GBUF_SZ; const bf16_t* sB0_ = (const bf16_t*)(lds + (buf) * GBUF_SZ + GA_SZ); const bf16_t* sB1_ = sB0_ + 64 * BP; const int k0_ = (ks) * 16; \
        _Pragma("unroll") for (int n = 0; n < NBLK; ++n) { \
            if (BGLDS) { const int kk_ = k0_ + 8 * (gi >> 1) + (i16 >> 2), gr_ = (wc * WN + n * 32) / 16 + (gi & 1); \
                const char* q0_ = (const char*)sB0_ + kk_ * RB + ((gr_ ^ (kk_ & 7)) << 5) + 8 * (i16 & 3); const char* q1_ = (const char*)sB0_ + (kk_ + 4) * RB + ((gr_ ^ ((kk_ + 4) & 7)) << 5) + 8 * (i16 & 3); \
                s16x4 lo = tr16((const bf16_t*)q0_), hi = tr16((const bf16_t*)q1_); BF0[n] = __builtin_shufflevector(lo, hi, 0, 1, 2, 3, 4, 5, 6, 7); } \
            else { const int off = b_off + k0_ * BP + n * 32; \
                s16x4 lo = tr16(sB0_ + off), hi = tr16(sB0_ + off + 4 * BP); BF0[n] = __builtin_shufflevector(lo, hi, 0, 1, 2, 3, 4, 5, 6, 7); \
                if (NB == 2) { s16x4 lo1 = tr16(sB1_ + off), hi1 = tr16(sB1_ + off + 4 * BP); BF1[n] = __builtin_shufflevector(lo1, hi1, 0, 1, 2, 3, 4, 5, 6, 7); } } } \
        _Pragma("unroll") for (int m = 0; m < MB; ++m) AF[m] = *(const bf16x8*)(sA_ + a_base + m * 4096 + ((((ks) * 2 + hh) ^ a_sw) << 4)); } while (0)
#define G_MFMA(AF, BF0, BF1) do { \
        _Pragma("unroll") for (int m = 0; m < MB; ++m) _Pragma("unroll") for (int n = 0; n < NBLK; ++n) { \
            acc0[m][n] = __builtin_amdgcn_mfma_f32_32x32x16_bf16(BF0[n], AF[m], acc0[m][n], 0, 0, 0); \
            if (NB == 2) acc1[m][n] = __builtin_amdgcn_mfma_f32_32x32x16_bf16(BF1[n], AF[m], acc1[m][n], 0, 0, 0); } } while (0)
#define G_MIX(nm) do { _Pragma("unroll") for (int i = 0; i < (nm); ++i) { __builtin_amdgcn_sched_group_barrier(0x008, 1, 0); __builtin_amdgcn_sched_group_barrier(0x100, 1, 0); } } while (0)
    constexpr int NMF = MB * NBLK * NB;
    bf16x8 afA[MB], bfA0[NBLK], bfA1[NBLK], afB[MB], bfB0[NBLK], bfB1[NBLK];
    G_DMA(0, 0);
    if (!BGLDS) { G_LOADB(0); G_WRITEB(0); }
#pragma unroll 1
    for (int t = 0; t < T; ++t) {
        const int buf = t & 1;
        asm volatile("s_waitcnt vmcnt(0)" ::: "memory");
        __syncthreads();
        if (t + 1 < T) { G_DMA(buf ^ 1, t + 1); if (!BGLDS) G_LOADB(t + 1); }
        if (BGLDS) {
            G_READ(buf, 0, afA, bfA0, bfA1);
            __builtin_amdgcn_sched_barrier(0);
            G_MFMA(afA, bfA0, bfA1); G_READ(buf, 1, afB, bfB0, bfB1); G_MIX(NMF);
            __builtin_amdgcn_sched_barrier(0);
            G_MFMA(afB, bfB0, bfB1); G_READ(buf, 2, afA, bfA0, bfA1); G_MIX(NMF);
            __builtin_amdgcn_sched_barrier(0);
            G_MFMA(afA, bfA0, bfA1); G_READ(buf, 3, afB, bfB0, bfB1); G_MIX(NMF);
            __builtin_amdgcn_sched_barrier(0);
            G_MFMA(afB, bfB0, bfB1);
        } else {
            __builtin_amdgcn_sched_barrier(0);
            G_READ(buf, 0, afA, bfA0, bfA1); G_MFMA(afA, bfA0, bfA1);
            G_READ(buf, 1, afA, bfA0, bfA1); G_MFMA(afA, bfA0, bfA1);
            G_READ(buf, 2, afA, bfA0, bfA1); G_MFMA(afA, bfA0, bfA1);
            __builtin_amdgcn_sched_barrier(0);
            G_READ(buf, 3, afA, bfA0, bfA1); G_MFMA(afA, bfA0, bfA1);
            G_WRITEB(buf ^ 1);
        }
        __builtin_amdgcn_sched_barrier(0);
    }
#undef G_DMA
#undef G_LOADB
#undef G_WRITEB
#undef G_READ
#undef G_MFMA
#undef G_MIX
    __syncthreads();
    float* stg = (float*)lds + wid * (32 * 68);
#pragma unroll
    for (int m = 0; m < MB; ++m) {
#pragma unroll
        for (int n = 0; n < NBLK; ++n) {
            const f32x16 v = epi.pre(acc0[m][n], acc1[m][n]);
#pragma unroll
            for (int q = 0; q < 4; ++q) *(f32x4*)(stg + r32 * 68 + n * 32 + 16 * hh + 4 * q) = (f32x4){v[4 * q], v[4 * q + 1], v[4 * q + 2], v[4 * q + 3]};
        }
        asm volatile("s_waitcnt lgkmcnt(0)" ::: "memory"); __builtin_amdgcn_wave_barrier();
#pragma unroll
        for (int ps = 0; ps < (32 * WN) / 256; ++ps) {
            const int idx = ps * 64 + lane, row = idx / (WN / 4), ck = idx % (WN / 4);
            epi.post(wr * (32 * MB) + m * 32 + row, wc * WN + ck * 4, *(const f32x4*)(stg + row * 68 + ck * 4));
        }
        asm volatile("s_waitcnt lgkmcnt(0)" ::: "memory"); __builtin_amdgcn_wave_barrier();
    }
    __syncthreads();
}

struct PlainA {
    const bf16_t* base; int lda;
    DI const bf16_t* rowptr(int, int row) const { return base + (size_t)row * lda; }
};
struct GatherA {
    const bf16_t* rp[4];
    DI const bf16_t* rowptr(int i, int) const { return rp[i]; }
};

struct XcdOrder {
    int base, lim, j, bpx;
    DI XcdOrder(int bid, int nblk, int total) {
        if ((nblk & 7) == 0) { const int x = bid & 7, per = (total + 7) >> 3; bpx = nblk >> 3; j = bid >> 3; base = x * per; lim = base + per < total ? base + per : total; }
        else { bpx = nblk; j = bid; base = 0; lim = total; }
    }
    DI int item(int i) const { const int q = base + i * bpx + j; return q < lim ? q : -1; }
};
DI void tile_rc(int q, int nrow, int ncol, int& r, int& c) {
    const int per_sr = 8 * ncol, sr = q / per_sr, rem = q - sr * per_sr, rows = (nrow - sr * 8) < 8 ? (nrow - sr * 8) : 8;
    c = rem / rows; r = sr * 8 + rem - c * rows;
}

DI u32x4 pack8v(const f32x4& a, const f32x4& b) { return (u32x4){pack2(a[0], a[1]), pack2(a[2], a[3]), pack2(b[0], b[1]), pack2(b[2], b[3])}; }
DI u32x4 pack8q(const f32x16& a, int q) { return (u32x4){pack2(a[8 * q], a[8 * q + 1]), pack2(a[8 * q + 2], a[8 * q + 3]), pack2(a[8 * q + 4], a[8 * q + 5]), pack2(a[8 * q + 6], a[8 * q + 7])}; }
struct EpiStoreBf16 { bf16_t* o; int ldo;
    DI f32x16 pre(const f32x16& a, const f32x16&) const { return a; }
    DI void post(int r, int c, const f32x4& v) const { u32x2 pk = {pack2(v[0], v[1]), pack2(v[2], v[3])}; *(u32x2*)(o + (size_t)r * ldo + c) = pk; } };
DI void phase_g1(const Params& p, int bid, int nblk, char* lds) {
    const bf16_t* xn = (const bf16_t*)(p.ws + OFF_XN); bf16_t* u = (bf16_t*)(p.ws + OFF_U);
    const bf16_t* wb = (const bf16_t*)(p.ws + OFF_WINB);
    const int nwide_all = 65 * 9, nwide = (2 * nblk < nwide_all) ? 2 * nblk : nwide_all;
    const XcdOrder ord(bid, nblk, nwide);
    for (int i = 0, q; (q = ord.item(i)) >= 0; ++i) {
        int tm, tn; tile_rc(q, 65, 9, tm, tn);
        PlainA al{xn + (size_t)tm * 256 * D, D};
        EpiStoreBf16 epi{u + (size_t)tm * 256 * DIN + tn * 256, DIN};
        gemm8<1, true, 2>(al, wb + tn * 256, nullptr, DIN, D, lds, epi);
    }
    const int nhalf = 2 * (nwide_all - nwide) + 65;
    for (int n = bid; n < nhalf; n += nblk) {
        int tm, col;
        if (n < 2 * (nwide_all - nwide)) { int tn; tile_rc(nwide + (n >> 1), 65, 9, tm, tn); col = tn * 256 + (n & 1) * 128; }
        else { tm = n - 2 * (nwide_all - nwide); col = 9 * 256; }
        PlainA al{xn + (size_t)tm * 256 * D, D};
        EpiStoreBf16 epi{u + (size_t)tm * 256 * DIN + col, DIN};
        gemm8<1, true, 1>(al, wb + col, nullptr, DIN, D, lds, epi);
    }
}

DI void phase_pool(const Params& p, int bid, int nblk) {
    const bf16_t* u = (const bf16_t*)(p.ws + OFF_U) + (size_t)CTX * DIN + C_POOL;
    bf16_t* mix = (bf16_t*)(p.ws + OFF_MIX);
    for (int item = bid * NTH + threadIdx.x; item < (S / 8) * 64; item += nblk * NTH) {
        const int cg = item & 63, run = item >> 6, t0 = run * 8, gi = cg >> 4, win = 2 << gi, hw = win >> 1;
        const bf16_t* uc = u + cg * 8;
        float sum[8];
#pragma unroll
        for (int j = 0; j < 8; ++j) sum[j] = 0.f;
        const int lo0 = (t0 - hw) < 0 ? 0 : (t0 - hw), hi0 = (t0 - hw + win) > S ? S : (t0 - hw + win);
#pragma unroll
        for (int r = 0; r < 16; ++r) {
            const int tt = lo0 + r; const bool ok = tt < hi0; const int tc = ok ? tt : lo0;
            float q[8]; unpack8(*(const u32x4*)(uc + (size_t)tc * DIN), q);
            const float wgt = ok ? 1.f : 0.f;
#pragma unroll
            for (int j = 0; j < 8; ++j) sum[j] += wgt * q[j];
        }
        int lo = lo0, hi = hi0;
#pragma unroll
        for (int k = 0; k < 8; ++k) {
            const int t = t0 + k;
            float cv[8], o[8]; unpack8(*(const u32x4*)(uc + (size_t)t * DIN), cv);
            const float inv = 1.f / (float)(hi - lo);
#pragma unroll
            for (int j = 0; j < 8; ++j) o[j] = sum[j] * inv - cv[j];
            *(u32x4*)(mix + (size_t)t * D + cg * 8) = pack8(o);
            const int nlo = t + 1 - hw, nhi = t + 1 - hw + win;
            const bool addr = nhi <= S, subr = nlo > 0;
            float qa[8], qs[8];
            unpack8(*(const u32x4*)(uc + (size_t)(addr ? nhi - 1 : t) * DIN), qa); unpack8(*(const u32x4*)(uc + (size_t)(subr ? nlo - 1 : t) * DIN), qs);
            const float wa = addr ? 1.f : 0.f, wsb = subr ? 1.f : 0.f;
#pragma unroll
            for (int j = 0; j < 8; ++j) sum[j] += wa * qa[j] - wsb * qs[j];
            hi = addr ? nhi : hi; lo = subr ? nlo : lo;
        }
    }
}
struct EpiPool { bf16_t* o; const float* sc;
    DI f32x16 pre(const f32x16& a, const f32x16&) const { return a; }
    DI void post(int r, int c, const f32x4& v) const { const f32x4 s4 = *(const f32x4*)(sc + c); u32x2 pk = {pack2(v[0] * s4[0], v[1] * s4[1]), pack2(v[2] * s4[2], v[3] * s4[3])}; *(u32x2*)(o + (size_t)r * D + c) = pk; } };
DI void phase_poolgemm(const Params& p, int bid, int nblk, char* lds) {
    if (nblk <= 0) return;
    for (int it = bid; it < 4 * 64; it += nblk) {
        const int gi = it >> 6, tm = it & 63;
        const bf16_t* mix = (const bf16_t*)(p.ws + OFF_MIX);
        PlainA al{mix + (size_t)tm * 256 * D + gi * 128, D};
        EpiPool e{(bf16_t*)(p.ws + OFF_MIX) + (size_t)tm * 256 * D + 512 + gi * 128, p.pool_scale + gi * 128};
        int kk = 128; asm volatile("" : "+s"(kk));
        gemm8<1, false, 1>(al, p.w_pool + (size_t)gi * 128 * 128, nullptr, 128, kk, lds, e);
    }
}

constexpr int MP = 72, MSZ = 64 * MP;
constexpr int FP = 68;
constexpr int SCANA_LDS = 14 * MSZ * 2 + 2048;
template <bool KS> DI bf16x8 frag32(const bf16_t* base, int x0, int s, int lane) {
    if (!KS) return *(const bf16x8*)(base + (x0 + (lane & 31)) * MP + 16 * s + 8 * (lane >> 5));
    const int gi = lane >> 4, i = lane & 15;
    const bf16_t* a = base + (16 * s + 8 * (gi >> 1) + (i >> 2)) * MP + x0 + 16 * (gi & 1) + 4 * (i & 3);
    s16x4 lo = tr16(a), hi = tr16(a + 4 * MP);
    return __builtin_shufflevector(lo, hi, 0, 1, 2, 3, 4, 5, 6, 7);
}
template <bool XKS, bool YKS> DI f32x16 mm32(const bf16_t* X, int x0, const bf16_t* Y, int y0, f32x16 acc, int lane) {
#pragma unroll
    for (int s = 0; s < 4; ++s) acc = __builtin_amdgcn_mfma_f32_32x32x16_bf16(frag32<XKS>(X, x0, s, lane), frag32<YKS>(Y, y0, s, lane), acc, 0, 0, 0);
    return acc;
}
template <class F> DI void store_acc(bf16_t* out, int x0, int y0, const f32x16& acc, int lane, F f) {
    const int y = y0 + (lane & 31), hh = lane >> 5;
#pragma unroll
    for (int q = 0; q < 4; ++q) {
        const int x = x0 + 8 * q + 4 * hh;
        u32x2 pk = {pack2(f(acc[4 * q], x, y), f(acc[4 * q + 1], x + 1, y)), pack2(f(acc[4 * q + 2], x + 2, y), f(acc[4 * q + 3], x + 3, y))};
        *(u32x2*)(out + y * MP + x) = pk;
    }
}
DI unsigned rot16(unsigned x) { return (x >> 16) | (x << 16); }

DI int chain_pos(int c, int dir) { return dir == 0 ? c : (c < 4 ? 3 - c : NCH + 3 - c); }

DI void phase_scanA(const Params& p, int bid, int nblk, char* lds) {
    const int tid = threadIdx.x, lane0 = tid & 63, w = tid >> 6, grp = w >> 2;
    bf16_t* M = (bf16_t*)lds;
    bf16_t *sAT = M, *sBT = M + MSZ, *sKT = M + 2 * MSZ, *sRT = M + 3 * MSZ, *sVT = M + 4 * MSZ;
    float* fGC = (float*)(lds + 14 * MSZ * 2);
    float* fSeg = fGC + 64;
    float* fLogw = (float*)(M + 12 * MSZ);
    float* fA = (float*)(M + 10 * MSZ);
    const bf16_t* u = (const bf16_t*)(p.ws + OFF_U);
    u32x4 raw[3][3];
#define SCANA_ISSUE(inst_) do { const int c_ = (inst_) >> 4, h_ = ((inst_) >> 1) & 7, d_ = (inst_) & 1, ch_ = tid & 7, tau_ = tid >> 3, g_ = d_ ? c_ * 64 + 63 - tau_ : c_ * 64 + tau_; \
        const bool hp_ = (g_ != 0) && (g_ != CTX), hn_ = (g_ != CTX - 1) && (g_ != NT - 1); \
        const bf16_t* rc_ = u + (size_t)g_ * DIN; const bf16_t* rp_ = hp_ ? rc_ - DIN : rc_; const bf16_t* rn_ = hn_ ? rc_ + DIN : rc_; \
        const int cl_[5] = {h_ * 64 + ch_ * 8, 512 + h_ * 64 + ch_ * 8, 1024 + h_ * 64 + ch_ * 8, (d_ ? C_WLB : C_WLF) + ch_ * 8, (d_ ? C_ALB : C_ALF) + ch_ * 8}; \
        _Pragma("unroll") for (int q = 0; q < 3; ++q) { raw[q][0] = *(const u32x4*)(rc_ + cl_[q]); raw[q][1] = *(const u32x4*)(rp_ + cl_[q]); raw[q][2] = *(const u32x4*)(rn_ + cl_[q]); } } while (0)
    if (bid < NCH * 16) SCANA_ISSUE(bid);
    for (int inst = bid; inst < NCH * 16; inst += nblk) {
        int lane = lane0; asm volatile("" : "+v"(lane));
        const int xq = 32 * (w & 1), yq = 32 * ((w >> 1) & 1);
        const int c = inst >> 4, h = (inst >> 1) & 7, dir = inst & 1;
        const bool latent = c >= 4, want_g = latent && dir == 0;
        const float* w2 = dir ? p.w2_b : p.w2_f; const float* a2 = dir ? p.a2_b : p.a2_f;
        const float* w0 = dir ? p.w0_b : p.w0_f; const float* a0 = dir ? p.a0_b : p.a0_f;
        const float* rkd = dir ? p.r_k_b : p.r_k_f;
        const int cwl = dir ? C_WLB : C_WLF, cal = dir ? C_ALB : C_ALF;
        const int ch = tid & 7, tau = tid >> 3, g = dir ? c * 64 + 63 - tau : c * 64 + tau;
        float fr_[8], fk_[8], fv_[8];
        {
            const int cols5[5] = {h * 64 + ch * 8, 512 + h * 64 + ch * 8, 1024 + h * 64 + ch * 8, cwl + ch * 8, cal + ch * 8};
            const bool hasp = (g != 0) && (g != CTX), hasn = (g != CTX - 1) && (g != NT - 1);
            const float mp = hasp ? 0.5f : 0.f, mn = hasn ? 0.5f : 0.f;
            const bf16_t* rc = u + (size_t)g * DIN; const bf16_t* rp = hasp ? rc - DIN : rc; const bf16_t* rn = hasn ? rc + DIN : rc;
            u32x4 raw3[3], raw4[3];
            raw3[0] = *(const u32x4*)(rc + cols5[3]); raw3[1] = *(const u32x4*)(rp + cols5[3]); raw3[2] = *(const u32x4*)(rn + cols5[3]);
            raw4[0] = *(const u32x4*)(rc + cols5[4]); raw4[1] = *(const u32x4*)(rp + cols5[4]); raw4[2] = *(const u32x4*)(rn + cols5[4]);
            auto shift8 = [&](const u32x4* r3, int col, float* o) {
                float cc[8], pv[8], nx[8];
                unpack8(r3[0], cc); unpack8(r3[1], pv); unpack8(r3[2], nx);
                const f32x4 m0 = *(const f32x4*)(p.mu + col), m1 = *(const f32x4*)(p.mu + col + 4);
#pragma unroll
                for (int j = 0; j < 8; ++j) { const float m = j < 4 ? m0[j & 3] : m1[j & 3]; o[j] = cc[j] + m * ((mp * pv[j] + mn * nx[j]) - cc[j]); }
            };
            shift8(raw[0], cols5[0], fr_); shift8(raw[1], cols5[1], fk_); shift8(raw[2], cols5[2], fv_);
            f32x4 wl[4];
#pragma unroll
            for (int q = 0; q < 2; ++q) { const int idx = tid + NTH * q, kr = idx >> 4, n4 = idx & 15;
                wl[q] = *(const f32x4*)(w2 + (size_t)kr * DR + h * 64 + n4 * 4); wl[2 + q] = *(const f32x4*)(a2 + (size_t)kr * DR + h * 64 + n4 * 4); }
            float t8[8];
            shift8(raw3, cols5[3], t8);
#pragma unroll
            for (int j = 0; j < 8; ++j) { const float e2 = __expf(2.f * t8[j]); t8[j] = 1.f - __fdividef(2.f, e2 + 1.f); }
            *(u32x4*)(M + 5 * MSZ + tau * MP + ch * 8) = pack8(t8);
            shift8(raw4, cols5[4], t8);
            *(u32x4*)(M + 6 * MSZ + tau * MP + ch * 8) = pack8(t8);
            if (want_g) {
                u32x4 rawg[2][3]; f32x4 wg2[4];
#pragma unroll
                for (int half = 0; half < 2; ++half) { const int col = C_GL + half * 64 + ch * 8;
                    rawg[half][0] = *(const u32x4*)(rc + col); rawg[half][1] = *(const u32x4*)(rp + col); rawg[half][2] = *(const u32x4*)(rn + col); }
#pragma unroll
                for (int q = 0; q < 4; ++q) { const int idx = tid + NTH * q, kr = idx >> 4, n4 = idx & 15; wg2[q] = *(const f32x4*)(p.g2 + (size_t)kr * DR + h * 64 + n4 * 4); }
#pragma unroll
                for (int half = 0; half < 2; ++half) {
                    shift8(rawg[half], C_GL + half * 64 + ch * 8, t8);
#pragma unroll
                    for (int j = 0; j < 8; ++j) t8[j] = sigmoidf_(t8[j]);
                    *(u32x4*)(M + half * MSZ + tau * MP + ch * 8) = pack8(t8);
                }
#pragma unroll
                for (int q = 0; q < 4; ++q) { const int idx = tid + NTH * q, kr = idx >> 4, n4 = idx & 15;
                    u32x2 pa = {pack2(wg2[q][0], wg2[q][1]), pack2(wg2[q][2], wg2[q][3])};
                    *(u32x2*)(M + (2 + (kr >> 6)) * MSZ + (kr & 63) * MP + n4 * 4) = pa; }
            }
#pragma unroll
            for (int q = 0; q < 2; ++q) { const int idx = tid + NTH * q, kr = idx >> 4, n4 = idx & 15;
                u32x2 pa = {pack2(wl[q][0], wl[q][1]), pack2(wl[q][2], wl[q][3])}, pb = {pack2(wl[2 + q][0], wl[2 + q][1]), pack2(wl[2 + q][2], wl[2 + q][3])};
                *(u32x2*)(M + 7 * MSZ + kr * MP + n4 * 4) = pa; *(u32x2*)(M + 8 * MSZ + kr * MP + n4 * 4) = pb; }
        }
        __syncthreads();
        if (grp == 0) {
            f32x16 accW = mm32<true, false>(M + 7 * MSZ, xq, M + 5 * MSZ, yq, zero16(), lane);
            const int y = yq + (lane & 31), hh = lane >> 5;
#pragma unroll
            for (int q = 0; q < 4; ++q) {
                const int x = xq + 8 * q + 4 * hh;
                f32x4 lw; const f32x4 w0v = *(const f32x4*)(w0 + h * 64 + x);
#pragma unroll
                for (int e = 0; e < 4; ++e) {
                    float v = -DECAY_SCALE * sigmoidf_(w0v[e] + accW[4 * q + e]);
                    v += __builtin_bit_cast(float, __builtin_amdgcn_update_dpp(0, __builtin_bit_cast(int, v), 0x111, 0xf, 0xf, false));
                    v += __builtin_bit_cast(float, __builtin_amdgcn_update_dpp(0, __builtin_bit_cast(int, v), 0x112, 0xf, 0xf, false));
                    v += __builtin_bit_cast(float, __builtin_amdgcn_update_dpp(0, __builtin_bit_cast(int, v), 0x114, 0xf, 0xf, false));
                    v += __builtin_bit_cast(float, __builtin_amdgcn_update_dpp(0, __builtin_bit_cast(int, v), 0x118, 0xf, 0xf, false));
                    v += __builtin_bit_cast(float, __builtin_amdgcn_update_dpp(0, __builtin_bit_cast(int, v), 0x142, 0xa, 0xf, false));
                    lw[e] = v;
                }
                *(f32x4*)(fLogw + y * FP + x) = lw;
                if (yq == 0 && (lane & 31) == 31) *(f32x4*)(fSeg + x) = lw;
            }
        } else {
            f32x16 accA = mm32<true, false>(M + 8 * MSZ, xq, M + 6 * MSZ, yq, zero16(), lane);
            const int y = yq + (lane & 31), hh = lane >> 5;
#pragma unroll
            for (int q = 0; q < 4; ++q) {
                const int x = xq + 8 * q + 4 * hh;
                f32x4 av; const f32x4 a0v = *(const f32x4*)(a0 + h * 64 + x);
#pragma unroll
                for (int e = 0; e < 4; ++e) av[e] = sigmoidf_(a0v[e] + accA[4 * q + e]);
                *(f32x4*)(fA + y * FP + x) = av;
            }
            if (want_g) {
                f32x16 accG = mm32<true, false>(M + 2 * MSZ, xq, M, yq, zero16(), lane);
                accG = mm32<true, false>(M + 3 * MSZ, xq, M + MSZ, yq, accG, lane);
                const int t = c * 64 + y - CTX;
#pragma unroll
                for (int q = 0; q < 4; ++q) {
                    const int x = xq + 8 * q + 4 * hh;
                    u32x2 pk = {pack2(accG[4 * q], accG[4 * q + 1]), pack2(accG[4 * q + 2], accG[4 * q + 3])};
                    *(u32x2*)((bf16_t*)(p.ws + OFF_G) + (size_t)t * DR + h * 64 + x) = pk;
                }
            }
        }
        __syncthreads();
        {
            float oa[8], ob[8], ok[8], orr[8], kkv[8], kd[8];
            float ss = 0.f, dsum = 0.f;
            const int c8 = h * 64 + ch * 8;
            float kkp[8], kap[8], rkp[8];
            { const f32x4 a0_ = *(const f32x4*)(p.k_k + c8), a1_ = *(const f32x4*)(p.k_k + c8 + 4), b0_ = *(const f32x4*)(p.k_a + c8), b1_ = *(const f32x4*)(p.k_a + c8 + 4), c0_ = *(const f32x4*)(rkd + c8), c1_ = *(const f32x4*)(rkd + c8 + 4);
#pragma unroll
              for (int j = 0; j < 4; ++j) { kkp[j] = a0_[j]; kkp[4 + j] = a1_[j]; kap[j] = b0_[j]; kap[4 + j] = b1_[j]; rkp[j] = c0_[j]; rkp[4 + j] = c1_[j]; } }
#pragma unroll
            for (int j = 0; j < 8; ++j) { kkv[j] = fk_[j] * kkp[j]; ss += kkv[j] * kkv[j]; }
            ss += __shfl_xor(ss, 1, 64); ss += __shfl_xor(ss, 2, 64); ss += __shfl_xor(ss, 4, 64);
            const float inv = 1.f / fmaxf(sqrtf(ss), 1e-12f);
#pragma unroll
            for (int j = 0; j < 8; ++j) {
                const int jj = ch * 8 + j;
                const float seg = fSeg[jj];
                const float cum = fLogw[tau * FP + jj] + (tau >= 32 ? seg : 0.f), cprev = tau ? fLogw[(tau - 1) * FP + jj] + (tau > 32 ? seg : 0.f) : 0.f, av = fA[tau * FP + jj];
                const float gam = __expf(cum), gprev = __expf(cprev), ginv = __expf(-cum);
                const float kkn = kkv[j] * inv;
                kd[j] = fk_[j] * (1.f + (av - 1.f) * kap[j]);
                oa[j] = -kkn * gprev; ob[j] = kkn * av * ginv; ok[j] = kd[j] * ginv; orr[j] = fr_[j] * gam;
                dsum += fr_[j] * kd[j] * rkp[j];
                if (tau == 63) fGC[jj] = gam;
            }
            dsum += __shfl_xor(dsum, 1, 64); dsum += __shfl_xor(dsum, 2, 64); dsum += __shfl_xor(dsum, 4, 64);
            if (ch == 0) ((float*)(p.ws + OFF_DOT))[((size_t)g * 8 + h) * 2 + dir] = dsum;
            *(u32x4*)(sAT + tau * MP + ch * 8) = pack8(oa); *(u32x4*)(sBT + tau * MP + ch * 8) = pack8(ob);
            *(u32x4*)(sKT + tau * MP + ch * 8) = pack8(ok); *(u32x4*)(sRT + tau * MP + ch * 8) = pack8(orr);
            const u32x4 pv8 = pack8(fv_);
            *(u32x4*)(sVT + tau * MP + ch * 8) = pv8;
            if (want_g) *(u32x4*)((bf16_t*)(p.ws + OFF_V) + (size_t)(g - CTX) * DR + h * 64 + ch * 8) = pv8;
        }
        __syncthreads();
        if (grp == 0) {
            f32x16 acc = mm32<false, false>(sAT, xq, sBT, yq, zero16(), lane);
            store_acc(M + 5 * MSZ, xq, yq, acc, lane, [](float v, int x, int y) { return y < x ? v : 0.f; });
            store_acc(M + 7 * MSZ, xq, yq, acc, lane, [](float v, int x, int y) { return y < x ? v : (y == x ? 1.f : 0.f); });
        } else {
            f32x16 acc = mm32<false, false>(sAT, xq, sKT, yq, zero16(), lane);
            store_acc(M + 9 * MSZ, xq, yq, acc, lane, [](float v, int x, int y) { return y < x ? v : 0.f; });
        }
        __syncthreads();
        int xs = 5, xo = 6, ts = 7, to = 8;
        if (grp == 1) {
            f32x16 acc = mm32<true, false>(M + xs * MSZ, xq, M + xs * MSZ, yq, zero16(), lane);
            store_acc(M + xo * MSZ, xq, yq, acc, lane, [](float v, int, int) { return v; });
        }
        { int t_ = xs; xs = xo; xo = t_; }
        __syncthreads();
        for (int k = 0; k < 5; ++k) {
            if (grp == 0) {
                const bf16_t* Told = M + ts * MSZ;
                f32x16 acc = mm32<true, false>(M + xs * MSZ, xq, Told, yq, zero16(), lane);
                store_acc(M + to * MSZ, xq, yq, acc, lane, [Told](float v, int x, int y) { return v + bf2f(Told[y * MP + x]); });
            } else if (k < 4) {
                f32x16 acc = mm32<true, false>(M + xs * MSZ, xq, M + xs * MSZ, yq, zero16(), lane);
                store_acc(M + xo * MSZ, xq, yq, acc, lane, [](float v, int, int) { return v; });
            } else {
                f32x16 acc = mm32<false, false>(sRT, xq, sBT, yq, zero16(), lane);
                store_acc(M + 10 * MSZ, xq, yq, acc, lane, [](float v, int x, int y) { return y <= x ? v : 0.f; });
                acc = mm32<false, false>(sRT, xq, sKT, yq, zero16(), lane);
                store_acc(M + 11 * MSZ, xq, yq, acc, lane, [](float v, int x, int y) { return y <= x ? v : 0.f; });
            }
            int t_ = xs; xs = xo; xo = t_; t_ = ts; ts = to; to = t_;
            __syncthreads();
        }
        const bf16_t* sT = M + ts * MSZ;
        if (grp == 0) {
            f32x16 acc = mm32<true, true>(sT, xq, sAT, yq, zero16(), lane);
            store_acc(M + 12 * MSZ, xq, yq, acc, lane, [](float v, int, int) { return v; });
        } else {
            f32x16 acc = mm32<true, false>(sT, xq, M + 9 * MSZ, yq, zero16(), lane);
            store_acc(M + 13 * MSZ, xq, yq, acc, lane, [](float v, int, int) { return v; });
        }
        __syncthreads();
        {
            const bf16_t *sAbar = M + 12 * MSZ, *sG = M + 13 * MSZ, *sABR = M + 10 * MSZ, *sAKR = M + 11 * MSZ;
            if (grp == 0) {
                f32x16 acc = mm32<false, true>(sAbar, xq, sBT, yq, zero16(), lane);
                store_acc(M + 5 * MSZ, xq, yq, acc, lane, [fGC](float v, int x, int y) { return ((x == y ? 1.f : 0.f) + v) * fGC[y]; });
                acc = mm32<false, true>(sAbar, xq, sABR, yq, zero16(), lane);
                store_acc(M + 6 * MSZ, xq, yq, acc, lane, [sRT](float v, int x, int y) { return v + bf2f(sRT[y * MP + x]); });
            } else {
                f32x16 acc = mm32<true, false>(sBT, xq, sG, yq, zero16(), lane);
                store_acc(M + 7 * MSZ, xq, yq, acc, lane, [sKT, fGC](float v, int x, int y) { return (v + bf2f(sKT[y * MP + x])) * fGC[x]; });
                acc = mm32<true, false>(sABR, xq, sG, yq, zero16(), lane);
                store_acc(M + 9 * MSZ, xq, yq, acc, lane, [sAKR](float v, int x, int y) { return v + bf2f(sAKR[y * MP + x]); });
            }
        }
        __syncthreads();
        const int chain = dir * 8 + h, npos = chain_pos(c, dir);
        {
            u32x4* Pg = (u32x4*)(p.ws + OFF_P) + ((size_t)chain * NCH + npos) * 512;
            { const int item = tid, ln = item & 63, as = item >> 6, a = as >> 1, s2 = as & 1, fr = ln & 15, fq = ln >> 4;
              const bf16_t* src = M + 5 * MSZ + (16 * a + fr) * MP + 32 * s2 + 4 * fq;
              const u32x2 lo = *(const u32x2*)src, hi = *(const u32x2*)(src + 16);
              Pg[as * 64 + ln] = (u32x4){lo.x, lo.y, hi.x, hi.y}; }
            if (latent) {
                u32x4* Wg = (u32x4*)(p.ws + OFF_WYT) + ((size_t)((c - 4) * 8 + h) * 2 + dir) * 512;
                const int row = tid >> 3, ck = tid & 7; Wg[tid] = *(const u32x4*)(M + 6 * MSZ + row * MP + ck * 8);
            }
        }
        if (grp == 0) {
            f32x16 acc = mm32<true, true>(M + 7 * MSZ, xq, sVT, yq, zero16(), lane);
            store_acc(M + 12 * MSZ, xq, yq, acc, lane, [](float v, int, int) { return v; });
        } else {
            f32x16 acc = mm32<true, true>(M + 9 * MSZ, xq, sVT, yq, zero16(), lane);
            store_acc(M + 13 * MSZ, xq, yq, acc, lane, [](float v, int, int) { return v; });
        }
        __syncthreads();
        if (inst + nblk < NCH * 16) SCANA_ISSUE(inst + nblk);
        {
            u32x2* Qg = (u32x2*)(p.ws + OFF_Q) + ((size_t)chain * NCH + npos) * 1024;
#pragma unroll
            for (int i = 0; i < 2; ++i) {
                const int item = tid + NTH * i, ln = item & 63, wa = item >> 6, wi = wa >> 2, a = wa & 3, fr = ln & 15, fq = ln >> 4;
                Qg[item] = *(const u32x2*)(M + 12 * MSZ + (16 * wi + fr) * MP + 16 * a + 4 * fq);
            }
            if (latent) {
                u32x2* Yg = (u32x2*)(p.ws + OFF_YL) + ((size_t)((c - 4) * 8 + h) * 2 + dir) * 1024;
#pragma unroll
                for (int i = 0; i < 2; ++i) {
                    const int item = tid + NTH * i, ln = item & 63, wn = item >> 6, wt = wn >> 2, ni = wn & 3, fr = ln & 15, fq = ln >> 4;
                    const bf16_t* row = M + 13 * MSZ + (16 * ni + fr) * MP;
                    u32x2 v;
                    if (dir == 0) v = *(const u32x2*)(row + 16 * wt + 4 * fq);
                    else { const u32x2 r2 = *(const u32x2*)(row + 60 - 16 * wt - 4 * fq); v = (u32x2){rot16(r2.y), rot16(r2.x)}; }
                    Yg[item] = v;
                }
            }
        }
        __syncthreads();
    }
}

#undef SCANA_ISSUE
DI int grp_start(int g) { return g * 16 + (g < 4 ? g : 4); }
DI u32x4 packz(const f32x4& a, const f32x4& b) { return (u32x4){pack2(a[0], a[1]), pack2(a[2], a[3]), pack2(b[0], b[1]), pack2(b[2], b[3])}; }
template <int PASS> DI void chain_run(const Params& p, int chain, int g) {
    constexpr int CPF = PASS == 1 ? 2 : 3;
    const int lane = threadIdx.x & 63, w = threadIdx.x >> 6, fr = lane & 15, fq = lane >> 4;
    const int n0 = grp_start(g), n1 = grp_start(g + 1);
    const u32x4* Pg = (const u32x4*)(p.ws + OFF_P) + (size_t)chain * NCH * 512;
    const u32x2* Qg = (const u32x2*)(p.ws + OFF_Q) + (size_t)chain * NCH * 1024;
    u32x4* Zg = (u32x4*)(p.ws + OFF_Z) + (size_t)chain * NCH * 512;
    f32x4* ZG = (f32x4*)(p.ws + OFF_ZG) + ((size_t)(chain * 16 + g) * 4 + w) * 256;
    f32x4 acc[4], accp[4];
#pragma unroll
    for (int a = 0; a < 4; ++a) {
        if (PASS == 3) acc[a] = ZG[a * 64 + lane]; else acc[a] = (f32x4){0, 0, 0, 0};
#pragma unroll
        for (int e = 0; e < 4; ++e) accp[a][e] = (16 * a + 4 * fq + e == 16 * w + fr) ? 1.f : 0.f;
    }
    u32x4 pf[CPF][8]; u32x2 qf[CPF][4];
#pragma unroll
    for (int st = 0; st < CPF; ++st) if (n0 + st < n1) {
#pragma unroll
        for (int i = 0; i < 8; ++i) pf[st][i] = Pg[(size_t)(n0 + st) * 512 + i * 64 + lane];
#pragma unroll
        for (int a = 0; a < 4; ++a) qf[st][a] = Qg[(size_t)(n0 + st) * 1024 + (w * 4 + a) * 64 + lane];
    }
    for (int nb = n0; nb < n1; nb += CPF) {
#pragma unroll
        for (int st = 0; st < CPF; ++st) {
            const int n = nb + st;
            if (n < n1) {
                u32x4 pc[8]; u32x2 qc[4];
#pragma unroll
                for (int i = 0; i < 8; ++i) pc[i] = pf[st][i];
#pragma unroll
                for (int a = 0; a < 4; ++a) qc[a] = qf[st][a];
                if (n + CPF < n1) {
#pragma unroll
                    for (int i = 0; i < 8; ++i) pf[st][i] = Pg[(size_t)(n + CPF) * 512 + i * 64 + lane];
#pragma unroll
                    for (int a = 0; a < 4; ++a) qf[st][a] = Qg[(size_t)(n + CPF) * 1024 + (w * 4 + a) * 64 + lane];
                }
                const u32x4 z0 = packz(acc[0], acc[1]), z1 = packz(acc[2], acc[3]);
                if (PASS == 3) { Zg[((size_t)n * 4 + w) * 128 + lane] = z0; Zg[((size_t)n * 4 + w) * 128 + 64 + lane] = z1; }
                const bf16x8 zb0 = __builtin_bit_cast(bf16x8, z0), zb1 = __builtin_bit_cast(bf16x8, z1);
#pragma unroll
                for (int a = 0; a < 4; ++a) {
                    f32x4 ini = {bflo(qc[a].x), bfhi(qc[a].x), bflo(qc[a].y), bfhi(qc[a].y)};
                    ini = __builtin_amdgcn_mfma_f32_16x16x32_bf16(__builtin_bit_cast(bf16x8, pc[2 * a]), zb0, ini, 0, 0, 0);
                    acc[a] = __builtin_amdgcn_mfma_f32_16x16x32_bf16(__builtin_bit_cast(bf16x8, pc[2 * a + 1]), zb1, ini, 0, 0, 0);
                }
                if (PASS == 1) {
                    const bf16x8 yb0 = __builtin_bit_cast(bf16x8, packz(accp[0], accp[1])), yb1 = __builtin_bit_cast(bf16x8, packz(accp[2], accp[3]));
#pragma unroll
                    for (int a = 0; a < 4; ++a) {
                        f32x4 t4 = __builtin_amdgcn_mfma_f32_16x16x32_bf16(__builtin_bit_cast(bf16x8, pc[2 * a]), yb0, (f32x4){0, 0, 0, 0}, 0, 0, 0);
                        accp[a] = __builtin_amdgcn_mfma_f32_16x16x32_bf16(__builtin_bit_cast(bf16x8, pc[2 * a + 1]), yb1, t4, 0, 0, 0);
                    }
                }
            }
        }
    }
    if (PASS == 1) {
        f32x4* CQ = (f32x4*)(p.ws + OFF_CQ) + ((size_t)(chain * 16 + g) * 4 + w) * 256;
        bf16_t* CP = (bf16_t*)(p.ws + OFF_CP) + (size_t)(chain * 16 + g) * 4096;
#pragma unroll
        for (int a = 0; a < 4; ++a) {
            CQ[a * 64 + lane] = acc[a];
#pragma unroll
            for (int e = 0; e < 4; ++e) CP[(16 * a + 4 * fq + e) * 64 + 16 * w + fr] = (bf16_t)(pack2(accp[a][e], 0.f) & 0xffffu);
        }
    }
}
DI void chain_groups(const Params& p, int chain, char* lds) {
    const int tid = threadIdx.x, lane = tid & 63, w = tid >> 6, fr = lane & 15, fq = lane >> 4;
    {
        const char* src = (const char*)(p.ws + OFF_CP) + (size_t)chain * 16 * 8192;
#pragma unroll
        for (int i = 0; i < 16; ++i) glds16(src + (size_t)(i * NTH + tid) * 16, lds + (i * NTH + tid) * 16);
        asm volatile("s_waitcnt vmcnt(0)" ::: "memory");
        __syncthreads();
    }
    if (w >= 4) return;
    constexpr int QPF = 4;
    f32x4 acc[4], qf[QPF][4];
#pragma unroll
    for (int a = 0; a < 4; ++a) acc[a] = (f32x4){0, 0, 0, 0};
    const f32x4* CQ = (const f32x4*)(p.ws + OFF_CQ) + ((size_t)chain * 16 * 4 + w) * 256;
#pragma unroll
    for (int st = 0; st < QPF; ++st)
#pragma unroll
        for (int a = 0; a < 4; ++a) qf[st][a] = CQ[(size_t)st * 1024 + a * 64 + lane];
    for (int gb = 0; gb < 16; gb += QPF) {
#pragma unroll
        for (int st = 0; st < QPF; ++st) {
            const int g = gb + st;
            f32x4 qc[4];
#pragma unroll
            for (int a = 0; a < 4; ++a) qc[a] = qf[st][a];
            if (g + QPF < 16) {
#pragma unroll
                for (int a = 0; a < 4; ++a) qf[st][a] = CQ[(size_t)(g + QPF) * 1024 + a * 64 + lane];
            }
            f32x4* ZG = (f32x4*)(p.ws + OFF_ZG) + ((size_t)(chain * 16 + g) * 4 + w) * 256;
#pragma unroll
            for (int a = 0; a < 4; ++a) ZG[a * 64 + lane] = acc[a];
            const bf16x8 zb0 = __builtin_bit_cast(bf16x8, packz(acc[0], acc[1])), zb1 = __builtin_bit_cast(bf16x8, packz(acc[2], acc[3]));
            const bf16_t* CP = (const bf16_t*)lds + g * 4096;
#pragma unroll
            for (int a = 0; a < 4; ++a) {
                const bf16_t* s0 = CP + (16 * a + fr) * 64 + 4 * fq;
                const u32x2 l0 = *(const u32x2*)s0, h0 = *(const u32x2*)(s0 + 16), l1 = *(const u32x2*)(s0 + 32), h1 = *(const u32x2*)(s0 + 48);
                f32x4 ini = __builtin_amdgcn_mfma_f32_16x16x32_bf16(__builtin_bit_cast(bf16x8, (u32x4){l0.x, l0.y, h0.x, h0.y}), zb0, qc[a], 0, 0, 0);
                acc[a] = __builtin_amdgcn_mfma_f32_16x16x32_bf16(__builtin_bit_cast(bf16x8, (u32x4){l1.x, l1.y, h1.x, h1.y}), zb1, ini, 0, 0, 0);
            }
        }
    }
}

DI void phase_scanC(const Params& p, int bid, int nblk, char* lds) {
    const int lane = threadIdx.x & 63, w8 = threadIdx.x >> 6, w = w8 & 3, fr = lane & 15, fq = lane >> 4;
    bf16_t* mix = (bf16_t*)(p.ws + OFF_MIX);
    const float* dot = (const float*)(p.ws + OFF_DOT);
    for (int unit = bid * 2 + (w8 >> 2); unit < 256 * 8; unit += nblk * 2) {
        const int c = 4 + (unit >> 3), h = unit & 7;
        f32x4 y[4];
#pragma unroll
        for (int ni = 0; ni < 4; ++ni) y[ni] = (f32x4){0, 0, 0, 0};
#pragma unroll
        for (int dir = 0; dir < 2; ++dir) {
            const int chain = dir * 8 + h, npos = chain_pos(c, dir);
            const u32x4* Zg = (const u32x4*)(p.ws + OFF_Z) + ((size_t)chain * NCH + npos) * 512;
            const bf16_t* Wg = (const bf16_t*)(p.ws + OFF_WYT) + ((size_t)((c - 4) * 8 + h) * 2 + dir) * 4096;
            const u32x2* Yg = (const u32x2*)(p.ws + OFF_YL) + ((size_t)((c - 4) * 8 + h) * 2 + dir) * 1024;
            const int rho = 16 * w + fr, row = dir ? 63 - rho : rho;
            bf16x8 af[2];
#pragma unroll
            for (int s2 = 0; s2 < 2; ++s2) {
                const u32x2 lo = *(const u32x2*)(Wg + row * 64 + 32 * s2 + 4 * fq), hi = *(const u32x2*)(Wg + row * 64 + 32 * s2 + 16 + 4 * fq);
                af[s2] = __builtin_bit_cast(bf16x8, (u32x4){lo.x, lo.y, hi.x, hi.y});
            }
#pragma unroll
            for (int ni = 0; ni < 4; ++ni) {
                const u32x2 yl = Yg[(w * 4 + ni) * 64 + lane];
                f32x4 acc = {bflo(yl.x), bfhi(yl.x), bflo(yl.y), bfhi(yl.y)};
                acc = __builtin_amdgcn_mfma_f32_16x16x32_bf16(af[0], __builtin_bit_cast(bf16x8, Zg[(ni * 2 + 0) * 64 + lane]), acc, 0, 0, 0);
                acc = __builtin_amdgcn_mfma_f32_16x16x32_bf16(af[1], __builtin_bit_cast(bf16x8, Zg[(ni * 2 + 1) * 64 + lane]), acc, 0, 0, 0);
                y[ni] += acc;
            }
        }
        float* ty = (float*)lds + w8 * (16 * 68);
#pragma unroll
        for (int ni = 0; ni < 4; ++ni)
#pragma unroll
            for (int e = 0; e < 4; ++e) ty[(4 * fq + e) * 68 + 16 * ni + fr] = y[ni][e];
        asm volatile("s_waitcnt lgkmcnt(0)" ::: "memory"); __builtin_amdgcn_wave_barrier();
        {
            const int tl = lane >> 2, seg = lane & 3, t = (c - 4) * 64 + 16 * w + tl, g = t + CTX, cch = h * 64 + 16 * seg;
            float yv[16];
#pragma unroll
            for (int q = 0; q < 4; ++q) { const f32x4 v4 = *(const f32x4*)(ty + tl * 68 + 16 * seg + 4 * q); yv[4 * q] = v4[0]; yv[4 * q + 1] = v4[1]; yv[4 * q + 2] = v4[2]; yv[4 * q + 3] = v4[3]; }
            float sm = 0.f;
#pragma unroll
            for (int j = 0; j < 16; ++j) sm += yv[j];
            sm += __shfl_xor(sm, 1, 64); sm += __shfl_xor(sm, 2, 64);
            const float mean = sm * (1.f / 64.f);
            float q2 = 0.f;
#pragma unroll
            for (int j = 0; j < 16; ++j) { const float d = yv[j] - mean; q2 += d * d; }
            q2 += __shfl_xor(q2, 1, 64); q2 += __shfl_xor(q2, 2, 64);
            const float rs = rsqrtf(q2 * (1.f / 64.f) + 64e-5f);
            const float bon = dot[((size_t)g * 8 + h) * 2] + dot[((size_t)g * 8 + h) * 2 + 1];
            float vv[16], gg[16], o[16];
            unpack8(*(const u32x4*)((const bf16_t*)(p.ws + OFF_V) + (size_t)t * DR + cch), vv); unpack8(*(const u32x4*)((const bf16_t*)(p.ws + OFF_V) + (size_t)t * DR + cch + 8), vv + 8);
            unpack8(*(const u32x4*)((const bf16_t*)(p.ws + OFF_G) + (size_t)t * DR + cch), gg); unpack8(*(const u32x4*)((const bf16_t*)(p.ws + OFF_G) + (size_t)t * DR + cch + 8), gg + 8);
#pragma unroll
            for (int q = 0; q < 4; ++q) {
                const f32x4 gw = *(const f32x4*)(p.gn_w + cch + 4 * q), gb = *(const f32x4*)(p.gn_b + cch + 4 * q);
#pragma unroll
                for (int j = 0; j < 4; ++j) o[4 * q + j] = ((yv[4 * q + j] - mean) * rs * gw[j] + gb[j] + bon * vv[4 * q + j]) * gg[4 * q + j];
            }
            *(u32x4*)(mix + (size_t)t * D + cch) = pack8(o); *(u32x4*)(mix + (size_t)t * D + cch + 8) = pack8(o + 8);
        }
        __builtin_amdgcn_wave_barrier();
    }
}

struct EpiX2 { float* o; const float* x; const float* gt; const float* rowtab; const float* coltab; int row0, col0;
    DI f32x16 pre(const f32x16& a, const f32x16&) const { return a; }
    DI void post(int r, int c, const f32x4& v) const {
        const int t = row0 + r, d = col0 + c;
        const float* pt = d < 512 ? rowtab + (t >> 6) * 512 + d : coltab + (t & 63) * 512 + (d - 512);
        const f32x4 xv = *(const f32x4*)(x + (size_t)t * D + d), pv = *(const f32x4*)pt, gv = *(const f32x4*)(gt + d);
        *(f32x4*)(o + (size_t)t * D + d) = xv + pv + gv * v; } };
struct EpiNull { DI f32x16 pre(const f32x16& a, const f32x16&) const { return a; } DI void post(int, int, const f32x4& v) const { asm volatile("" :: "v"(v)); } };
DI void phase_g2_null(const Params& p, int bid, int nblk, char* lds) {
    const bf16_t* mix = (const bf16_t*)(p.ws + OFF_MIX);
    const XcdOrder ord(bid, nblk, 64 * 4);
    for (int i = 0, q; (q = ord.item(i)) >= 0; ++i) {
        int tm, tn; tile_rc(q, 64, 4, tm, tn);
        PlainA al{mix + (size_t)tm * 256 * D, D};
        EpiNull e;
        gemm8<1, true, 2>(al, (const bf16_t*)(p.ws + OFF_WOUTB) + tn * 256, nullptr, D, D, lds, e);
    }
}
DI void phase_g2(const Params& p, int bid, int nblk, char* lds) {
    const bf16_t* mix = (const bf16_t*)(p.ws + OFF_MIX);
    const XcdOrder ord(bid, nblk, 64 * 4);
    for (int i = 0, q; (q = ord.item(i)) >= 0; ++i) {
        int tm, tn; tile_rc(q, 64, 4, tm, tn);
        PlainA al{mix + (size_t)tm * 256 * D, D};
        EpiX2 e{(float*)(p.ws + OFF_X2), p.x, (const float*)(p.ws + OFF_MODX) + 2048, (const float*)(p.ws + OFF_ROWTAB), (const float*)(p.ws + OFF_COLTAB), tm * 256, tn * 256};
        gemm8<1, true, 2>(al, (const bf16_t*)(p.ws + OFF_WOUTB) + tn * 256, nullptr, D, D, lds, e);
    }
}

DI float router_w(const Params& p, int k, int n) { return n < 4 ? p.w_rg[k * 4 + n] : (n < 36 ? p.w_re[k * 32 + (n - 4)] : 0.f); }
DI void phase_router_prep(const Params& p, int bid, int nblk) {
    const float* modx = (const float*)(p.ws + OFF_MODX);
    float* wp = (float*)(p.ws + OFF_WP); float* b2 = (float*)(p.ws + OFF_B2);
    for (int idx = bid * NTH + threadIdx.x; idx < 64 * 4 * 3 * 64; idx += nblk * NTH) {
        const int ln = idx & 63, r = idx >> 6, nt = r % 3, me = r / 3, e = me & 3, m = me >> 2;
        const int k = 16 * m + 4 * (ln >> 4) + e, n = 16 * nt + (ln & 15);
        wp[idx] = p.norm2_g[k] * (1.f + modx[4096 + k]) * router_w(p, k, n);
    }
    const int lane = threadIdx.x & 63, wv = bid * NWV + (threadIdx.x >> 6);
    if (wv < 36) {
        float sacc = 0.f;
        for (int k = lane; k < D; k += 64) sacc += modx[3072 + k] * router_w(p, k, wv);
        sacc = wave_sum(sacc);
        if (lane == 0) b2[wv] = sacc + (wv < 4 ? p.b_rg[wv] : p.b_re[wv - 4]);
    }
}

DI void phase_router(const Params& p, int bid, int nblk, char* lds, bool dry = false) {
    const int lane = threadIdx.x & 63, wid = threadIdx.x >> 6, tr = lane & 15, kq = lane >> 4;
    const float* x2 = (const float*)(p.ws + OFF_X2); const float* modx = (const float*)(p.ws + OFF_MODX);
    const float* wp = (const float*)(p.ws + OFF_WP); const float* b2 = (const float*)(p.ws + OFF_B2);
    bf16_t* h2 = (bf16_t*)(p.ws + OFF_H2); int* cnt = (int*)(p.ws + OFF_CNT); float* gate = (float*)(p.ws + OFF_GATE); int* list = (int*)(p.ws + OFF_LIST);
    float* slog = (float*)lds + wid * (16 * 49);
    for (int task = wid * nblk + bid; task < S / 16; task += nblk * NWV) {
        const int t0 = task * 16;
        const float* xr = x2 + (size_t)(t0 + tr) * D + 4 * kq;
        f32x4 acc[3];
#pragma unroll
        for (int i = 0; i < 3; ++i) acc[i] = (f32x4){0, 0, 0, 0};
        float ss = 0.f;
#pragma unroll 4
        for (int m = 0; m < 64; ++m) {
            const f32x4 xv = *(const f32x4*)(xr + 16 * m);
            ss += xv[0] * xv[0] + xv[1] * xv[1] + xv[2] * xv[2] + xv[3] * xv[3];
#pragma unroll
            for (int e = 0; e < 4; ++e)
#pragma unroll
                for (int nt = 0; nt < 3; ++nt) acc[nt] = __builtin_amdgcn_mfma_f32_16x16x4f32(xv[e], wp[((m * 4 + e) * 3 + nt) * 64 + lane], acc[nt], 0, 0, 0);
        }
        ss += __shfl_xor(ss, 16, 64); ss += __shfl_xor(ss, 32, 64);
        const float rstd = rsqrtf(ss * (1.f / 1024.f) + 1e-6f);
#pragma unroll
        for (int nt = 0; nt < 3; ++nt)
#pragma unroll
            for (int r = 0; r < 4; ++r) slog[(4 * kq + r) * 49 + 16 * nt + tr] = acc[nt][r];
        asm volatile("s_waitcnt lgkmcnt(0)" ::: "memory"); __builtin_amdgcn_wave_barrier();
        if (lane < 16) {
            const int t = t0 + lane;
            const float* lg = slog + lane * 49;
            const float l0 = rstd * lg[0] + b2[0], l1 = rstd * lg[1] + b2[1], l2 = rstd * lg[2] + b2[2], l3 = rstd * lg[3] + b2[3];
            int grp = 0; float mx = l0;
            if (l1 > mx) { mx = l1; grp = 1; }
            if (l2 > mx) { mx = l2; grp = 2; }
            if (l3 > mx) { mx = l3; grp = 3; }
            const float den = __expf(l0 - mx) + __expf(l1 - mx) + __expf(l2 - mx) + __expf(l3 - mx);
            const float pgrp = 1.f / den;
            int i1 = 0, i2 = -1; float v1 = -3.0e38f, v2 = -3.0e38f;
            for (int n = 0; n < 8; ++n) {
                const float sv = rstd * lg[4 + grp * 8 + n] + b2[4 + grp * 8 + n];
                if (sv > v1) { v2 = v1; i2 = i1; v1 = sv; i1 = n; } else if (sv > v2) { v2 = sv; i2 = n; }
            }
            const float e2 = __expf(v2 - v1), g1 = pgrp / (1.f + e2), g2v = pgrp * e2 / (1.f + e2);
            const int ea = grp * 8 + i1, eb = grp * 8 + i2;
            if (!dry) {
                const int pa = atomicAdd(&cnt[ea], 1), pb = atomicAdd(&cnt[eb], 1);
                list[ea * LCAP + pa] = t * 2; list[eb * LCAP + pb] = t * 2 + 1;
            }
            gate[t * 2] = g1; gate[t * 2 + 1] = g2v;
        }
        for (int r = 0; r < 16; ++r) {
            const float rs = __shfl(rstd, r, 64);
            const float* src = x2 + (size_t)(t0 + r) * D;
#pragma unroll
            for (int i = 0; i < 4; ++i) {
                const int d = (i * 64 + lane) * 4;
                const f32x4 v = *(const f32x4*)(src + d), gg = *(const f32x4*)(p.norm2_g + d), sh = *(const f32x4*)(modx + 3072 + d), sc = *(const f32x4*)(modx + 4096 + d);
                f32x4 hv;
#pragma unroll
                for (int j = 0; j < 4; ++j) hv[j] = (v[j] * rs * gg[j]) * (1.f + sc[j]) + sh[j];
                u32x2 pk = {pack2(hv[0], hv[1]), pack2(hv[2], hv[3])};
                *(u32x2*)(h2 + (size_t)(t0 + r) * D + d) = pk;
            }
        }
        __builtin_amdgcn_wave_barrier();
    }
}

DI void moe_tiles(const int* cnt, int* tstart  ) {
    if (threadIdx.x == 0) { int acc = 0; for (int e = 0; e < NE; ++e) { tstart[e] = acc; acc += (cnt[e] + 255) >> 8; } tstart[NE] = acc; }
    __syncthreads();
}
struct EpiHid { bf16_t* o;
    DI f32x16 pre(const f32x16& g, const f32x16& u) const { f32x16 h;
#pragma unroll
        for (int j = 0; j < 16; ++j) h[j] = g[j] * sigmoidf_(g[j]) * u[j];
        return h; }
    DI void post(int r, int c, const f32x4& v) const { u32x2 pk = {pack2(v[0], v[1]), pack2(v[2], v[3])}; *(u32x2*)(o + (size_t)r * DE + c) = pk; } };
DI void phase_g3(const Params& p, int bid, int nblk, char* lds) {
    int* tstart = (int*)(lds + GEMM_LDS);
    const int* cnt = (const int*)(p.ws + OFF_CNT); const int* list = (const int*)(p.ws + OFF_LIST);
    const bf16_t* h2 = (const bf16_t*)(p.ws + OFF_H2); bf16_t* hid = (bf16_t*)(p.ws + OFF_HID);
    moe_tiles(cnt, tstart);
    const int ntiles = tstart[NE];
    const int nitems = ntiles * 4, nfull = (nitems / nblk) * nblk, nhalf = 2 * (nitems - nfull);
    const XcdOrder ord(bid, nblk, nfull);
    for (int i = 0, item; (item = ord.item(i)) >= 0; ++i) {
        const int ti = item >> 2, cj = item & 3;
        int e = 0; while (e < NE - 1 && tstart[e + 1] <= ti) ++e;
        const int lt = ti - tstart[e], ne = cnt[e];
        GatherA al;
#pragma unroll
        for (int i2 = 0; i2 < 4; ++i2) { const int row = (8 * i2 + (threadIdx.x >> 6)) * 8 + ((threadIdx.x & 63) >> 3), pos = lt * 256 + row; const int tok = pos < ne ? (list[e * LCAP + pos] >> 1) : 0; al.rp[i2] = h2 + (size_t)tok * D; }
        EpiHid epi{hid + (size_t)ti * 256 * DE + cj * 128};
        gemm8<2, false, 1>(al, p.w_gate + (size_t)e * D * DE + cj * 128, p.w_up + (size_t)e * D * DE + cj * 128, DE, D, lds, epi);
    }
    for (int n = bid; n < nhalf; n += nblk) {
        const int item = nfull + (n >> 1), hf = n & 1, ti = item >> 2, cj = item & 3;
        int e = 0; while (e < NE - 1 && tstart[e + 1] <= ti) ++e;
        const int lt = ti - tstart[e], ne = cnt[e];
        GatherA al;
#pragma unroll
        for (int i2 = 0; i2 < 2; ++i2) { const int row = hf * 128 + (8 * i2 + (threadIdx.x >> 6)) * 8 + ((threadIdx.x & 63) >> 3), pos = lt * 256 + row; const int tok = pos < ne ? (list[e * LCAP + pos] >> 1) : 0; al.rp[i2] = h2 + (size_t)tok * D; }
        al.rp[2] = al.rp[0]; al.rp[3] = al.rp[1];
        EpiHid epi{hid + ((size_t)ti * 256 + hf * 128) * DE + cj * 128};
        gemm8<2, false, 1, GatherA, EpiHid, 2>(al, p.w_gate + (size_t)e * D * DE + cj * 128, p.w_up + (size_t)e * D * DE + cj * 128, DE, D, lds, epi);
    }
}
struct EpiDown { bf16_t* ybuf; const int* lst; const float* gate; int nvalid; int col0;
    DI f32x16 pre(const f32x16& a, const f32x16&) const { return a; }
    DI void post(int r, int c, const f32x4& v) const {
        if (r >= nvalid) return; const int slot = lst[r]; const float g = gate[slot];
        u32x2 pk = {pack2(v[0] * g, v[1] * g), pack2(v[2] * g, v[3] * g)}; *(u32x2*)(ybuf + (size_t)slot * D + col0 + c) = pk; } };
DI void phase_g4(const Params& p, int bid, int nblk, char* lds) {
    int* tstart = (int*)(lds + GEMM_LDS);
    const int* cnt = (const int*)(p.ws + OFF_CNT); const int* list = (const int*)(p.ws + OFF_LIST);
    const bf16_t* hid = (const bf16_t*)(p.ws + OFF_HID);
    moe_tiles(cnt, tstart);
    const int ntiles = tstart[NE];
    const XcdOrder ord(bid, nblk, ntiles * 8);
    for (int i = 0, item; (item = ord.item(i)) >= 0; ++i) {
        const int ti = item >> 3, cj = item & 7;
        int e = 0; while (e < NE - 1 && tstart[e + 1] <= ti) ++e;
        const int lt = ti - tstart[e], ne = cnt[e];
        PlainA al{hid + (size_t)ti * 256 * DE, DE};
        EpiDown epi{(bf16_t*)(p.ws + OFF_YBUF), list + e * LCAP + lt * 256, (const float*)(p.ws + OFF_GATE), ne - lt * 256, cj * 128};
        gemm8<1, false, 1>(al, p.w_down + (size_t)e * DE * D + cj * 128, nullptr, D, DE, lds, epi);
    }
}

DI void phase_final(const Params& p, int bid, int nblk) {
    const int lane = threadIdx.x & 63, wid = threadIdx.x >> 6;
    const float* x2 = (const float*)(p.ws + OFF_X2); const float* gt = (const float*)(p.ws + OFF_MODX) + 5120; const bf16_t* yb = (const bf16_t*)(p.ws + OFF_YBUF);
    for (int tp = bid * NWV + wid; tp < S / 2; tp += nblk * NWV) {
        f32x4 v[2][4]; float ss[2] = {0.f, 0.f};
        u32x2 ya[2][4], ybv[2][4];
#pragma unroll
        for (int r = 0; r < 2; ++r)
#pragma unroll
            for (int i = 0; i < 4; ++i) {
                const int t = 2 * tp + r, d = (i * 64 + lane) * 4;
                v[r][i] = *(const f32x4*)(x2 + (size_t)t * D + d);
                ya[r][i] = *(const u32x2*)(yb + (size_t)(2 * t) * D + d); ybv[r][i] = *(const u32x2*)(yb + (size_t)(2 * t + 1) * D + d);
            }
#pragma unroll
        for (int r = 0; r < 2; ++r)
#pragma unroll
            for (int i = 0; i < 4; ++i) {
                const int d = (i * 64 + lane) * 4; const f32x4 g = *(const f32x4*)(gt + d); const u32x2 a = ya[r][i], b = ybv[r][i];
                v[r][i][0] += g[0] * (bflo(a.x) + bflo(b.x)); v[r][i][1] += g[1] * (bfhi(a.x) + bfhi(b.x));
                v[r][i][2] += g[2] * (bflo(a.y) + bflo(b.y)); v[r][i][3] += g[3] * (bfhi(a.y) + bfhi(b.y));
                ss[r] += v[r][i][0] * v[r][i][0] + v[r][i][1] * v[r][i][1] + v[r][i][2] * v[r][i][2] + v[r][i][3] * v[r][i][3];
            }
#pragma unroll
        for (int r = 0; r < 2; ++r) {
            const float rstd = rsqrtf(wave_sum(ss[r]) * (1.f / 1024.f) + 1e-6f);
#pragma unroll
            for (int i = 0; i < 4; ++i) {
                const int d = (i * 64 + lane) * 4; const f32x4 fg = *(const f32x4*)(p.final_g + d); f32x4 o;
#pragma unroll
                for (int j = 0; j < 4; ++j) o[j] = v[r][i][j] * rstd * fg[j];
                *(f32x4*)(p.out + (size_t)(2 * tp + r) * D + d) = o;
            }
        }
    }
}

#define XB_TMO      128
#define XB_XCNT(j)  (256  + 64 * (j))
#define XB_XSUB(j)  (1280 + 64 * (j))
#define XB_XGEN(j)  (2304 + 64 * (j))
#define XB_TOP      3328
#define XB_TOPGEN   3392
#define XCD_BAR_WORDS 3456
#define XB_SPIN_CAP (1u << 18)
DI unsigned xb_ld(unsigned* p) { return __hip_atomic_load(p, __ATOMIC_RELAXED, __HIP_MEMORY_SCOPE_AGENT); }
DI unsigned xb_add(unsigned* p, unsigned v) { return __hip_atomic_fetch_add(p, v, __ATOMIC_RELAXED, __HIP_MEMORY_SCOPE_AGENT); }
DI unsigned xb_xcc_id() { return (unsigned)__builtin_amdgcn_s_getreg((3 << 11) | 20) & 0xFu; }
#define XB_SPIN(cond, bar) do { unsigned _sp = 0; while (cond) { __builtin_amdgcn_s_sleep(1); \
    if ((++_sp & 255u) == 0u) { if (xb_ld(&(bar)[XB_TMO])) break; if (_sp > XB_SPIN_CAP) { atomicAdd(&(bar)[XB_TMO], 1u); break; } } } } while (0)
struct XcdBarrier { unsigned* bar; unsigned x; volatile LAS unsigned* st; };
DI XcdBarrier xcd_barrier_post(unsigned* bar, volatile LAS unsigned* st) {
    XcdBarrier b; b.bar = bar; b.x = xb_xcc_id(); b.st = st;
    if (threadIdx.x == 0) (void)xb_add(&bar[XB_XCNT(b.x)], 1u);
    return b;
}
DI void xcd_barrier_complete(unsigned* bar, unsigned x, unsigned& nloc, unsigned& nx) {
    const unsigned G = gridDim.x * gridDim.y * gridDim.z;
    unsigned sum, cnt, mine, sp = 0u;
    for (;;) {
        sum = 0u; cnt = 0u; mine = 0u;
#pragma unroll
        for (unsigned j = 0; j < 16; ++j) { const unsigned c = xb_ld(&bar[XB_XCNT(j)]); sum += c; cnt += (c > 0u) ? 1u : 0u; mine = (j == x) ? c : mine; }
        if (sum == G) break;
        __builtin_amdgcn_s_sleep(1);
        if ((++sp & 255u) == 0u) { if (xb_ld(&bar[XB_TMO])) break; if (sp > XB_SPIN_CAP) { atomicAdd(&bar[XB_TMO], 1u); break; } }
    }
    nloc = mine > 0u ? mine : 1u; nx = cnt > 0u ? cnt : 1u;
}
DI void xcd_barrier(const XcdBarrier& b) {
    asm volatile("s_waitcnt vmcnt(0)" ::: "memory");
    __syncthreads();
    if (threadIdx.x == 0) {
        unsigned* bar = b.bar;
        __builtin_amdgcn_s_waitcnt(0);
        unsigned nloc = b.st[0], nx = b.st[1];
        if (nloc == 0u) { xcd_barrier_complete(bar, b.x, nloc, nx); b.st[0] = nloc; b.st[1] = nx; }
        const unsigned old = xb_add(&bar[XB_XSUB(b.x)], 1u);
        const unsigned gen = old / nloc;
        if (old + 1u == (gen + 1u) * nloc) {
            __builtin_amdgcn_fence(__ATOMIC_RELEASE, "agent");
            asm volatile("s_waitcnt vmcnt(0)" ::: "memory");
            const unsigned og = xb_add(&bar[XB_TOP], 1u);
            const unsigned tg = og / nx;
            if (og + 1u == (tg + 1u) * nx) xb_add(&bar[XB_TOPGEN], 1u);
            else XB_SPIN(xb_ld(&bar[XB_TOPGEN]) == tg, bar);
            __builtin_amdgcn_fence(__ATOMIC_ACQUIRE, "agent");
            xb_add(&bar[XB_XGEN(b.x)], 1u);
            asm volatile("s_waitcnt vmcnt(0)" ::: "memory");
        } else {
            XB_SPIN(xb_ld(&bar[XB_XGEN(b.x)]) == gen, bar);
            __builtin_amdgcn_fence(__ATOMIC_ACQUIRE, "agent");
            asm volatile("s_waitcnt vmcnt(0)" ::: "memory");
        }
    }
    __syncthreads();
}

#ifndef PROBE
#define PROBE 0
#endif
constexpr int MEGA_LDS = SCANA_LDS > (GEMM_LDS + 256) ? SCANA_LDS : (GEMM_LDS + 256);
__global__ void __launch_bounds__(NTH) k_mega(Params p) {
    extern __shared__ __attribute__((aligned(16))) char lds[];
    const int bid = blockIdx.x, nblk = gridDim.x;
    volatile LAS unsigned* st = (volatile LAS unsigned*)(lds + MEGA_LDS);
    if (threadIdx.x < 4) st[threadIdx.x] = 0u;
    __syncthreads();
    const XcdBarrier gb = xcd_barrier_post((unsigned*)(p.ws + OFF_BAR), st);
#define GSYNC() xcd_barrier(gb)
    phase_p0(p, bid, nblk, lds); GSYNC();
    if (PROBE == 1) { phase_p0(p, bid, nblk, lds); GSYNC(); }
    phase_xn(p, bid, nblk); phase_router_prep(p, bid, nblk); GSYNC();
    if (PROBE == 2) { phase_xn(p, bid, nblk); GSYNC(); }
    phase_g1(p, bid, nblk, lds); GSYNC();
    if (PROBE == 3) { phase_g1(p, bid, nblk, lds); GSYNC(); }
    phase_pool(p, bid, nblk);
    phase_scanA(p, bid, nblk, lds); GSYNC();
    if (PROBE == 4) { phase_scanA(p, bid, nblk, lds); GSYNC(); }
    if (PROBE == 15) { phase_pool(p, bid, nblk); GSYNC(); }
    if (PROBE == 16) { GSYNC(); GSYNC(); GSYNC(); GSYNC(); }
    if (threadIdx.x < 256) for (int it = bid; it < 256; it += nblk) chain_run<1>(p, it >> 4, it & 15);
    GSYNC();
    if (PROBE == 5) { if (threadIdx.x < 256) for (int it = bid; it < 256; it += nblk) chain_run<1>(p, it >> 4, it & 15); GSYNC(); }
    if (bid < 16) chain_groups(p, bid, lds); else phase_poolgemm(p, bid - 16, nblk - 16, lds);
    GSYNC();
    if (PROBE == 6) { if (bid < 16) chain_groups(p, bid, lds); GSYNC(); }
    if (threadIdx.x < 256) for (int it = bid; it < 256; it += nblk) chain_run<3>(p, it >> 4, it & 15);
    GSYNC();
    if (PROBE == 7) { if (threadIdx.x < 256) for (int it = bid; it < 256; it += nblk) chain_run<3>(p, it >> 4, it & 15); GSYNC(); }
    phase_scanC(p, bid, nblk, lds); GSYNC();
    if (PROBE == 8) { phase_scanC(p, bid, nblk, lds); GSYNC(); }
    phase_g2(p, bid, nblk, lds); GSYNC();
    if (PROBE == 9) { phase_g2(p, bid, nblk, lds); GSYNC(); }
    if (PROBE == 14) { phase_g2_null(p, bid, nblk, lds); GSYNC(); }
    if (PROBE == 10) { phase_router(p, bid, nblk, lds, true); GSYNC(); }
    phase_router(p, bid, nblk, lds); GSYNC();
    phase_g3(p, bid, nblk, lds); GSYNC();
    if (PROBE == 11) { phase_g3(p, bid, nblk, lds); GSYNC(); }
    phase_g4(p, bid, nblk, lds); GSYNC();
    if (PROBE == 12) { phase_g4(p, bid, nblk, lds); GSYNC(); }
    if (PROBE == 13) { phase_final(p, bid, nblk); GSYNC(); }
    phase_final(p, bid, nblk);
}

extern "C" void kernel_launch(void* const* d_in, const int* in_sizes, int n_in, void* d_out, int out_size, void* d_ws, size_t ws_size, hipStream_t stream) {
    if (ws_size < WS_NEED) { fprintf(stderr, "workspace too small: %zu < %zu\n", ws_size, (size_t)WS_NEED); return; }
    Params p{};
    const float** f = (const float**)&p;
    for (int i = 0; i < 36; ++i) f[i] = (const float*)d_in[i];
    p.out = (float*)d_out; p.ws = (char*)d_ws;
    static int grid_blocks = 0;
    if (!grid_blocks) {
        (void)hipFuncSetAttribute((const void*)k_mega, hipFuncAttributeMaxDynamicSharedMemorySize, MEGA_LDS + 16);
        int dev = 0, cus = 0, per_cu = 0;
        (void)hipGetDevice(&dev);
        (void)hipDeviceGetAttribute(&cus, hipDeviceAttributeMultiprocessorCount, dev);
        (void)hipOccupancyMaxActiveBlocksPerMultiprocessor(&per_cu, k_mega, NTH, MEGA_LDS + 16);
        if (per_cu > 1) per_cu = 1;
        grid_blocks = cus * per_cu;
    }
    (void)hipMemsetAsync((char*)d_ws + OFF_BAR, 0, 16384, stream);
    void* args[] = {&p};
    hipError_t e = hipLaunchCooperativeKernel((const void*)k_mega, dim3(grid_blocks), dim3(NTH), args, MEGA_LDS + 16, stream);
    if (e != hipSuccess) fprintf(stderr, "cooperative launch failed: %s (grid %d)\n", hipGetErrorString(e), grid_blocks);
}
```

```cpp
#include <hip/hip_runtime.h>
#include <stdint.h>
#include <stdio.h>
#include <hip/hip_cooperative_groups.h>
namespace cg = cooperative_groups;

#define DI __device__ __forceinline__
typedef unsigned short bf16_t;
typedef short bf16x8 __attribute__((ext_vector_type(8)));
typedef short s16x4 __attribute__((ext_vector_type(4)));
typedef float f32x4 __attribute__((ext_vector_type(4)));
typedef float f32x2 __attribute__((ext_vector_type(2)));
typedef __bf16 bf16x2_t __attribute__((ext_vector_type(2)));
typedef unsigned u32x4 __attribute__((ext_vector_type(4)));
typedef unsigned u32x2 __attribute__((ext_vector_type(2)));
#define LAS __attribute__((address_space(3)))

constexpr int D = 1024, S = 16384, CTX = 256, NT = S + CTX, DIN = 2432, DSH = 1920, DR = 512;
constexpr int C_WLF = 1536, C_WLB = 1600, C_ALF = 1664, C_ALB = 1728, C_GL = 1792, C_POOL = 1920;
constexpr int NE = 32, DE = 512, LCAP = 32768;
constexpr float DECAY_SCALE = 0.6065306597f;
constexpr int NTH = 512, NWV = 8;

constexpr int NCH = NT / 64;
constexpr size_t SZ_U = (size_t)NT * DIN * 2;
constexpr size_t SZ_CH = (size_t)16 * NCH * 8192;
constexpr size_t OFF_U = 0;
constexpr size_t OFF_XN = OFF_U + SZ_U;
constexpr size_t OFF_P = OFF_XN;
constexpr size_t OFF_Q = OFF_P + SZ_CH;
constexpr size_t OFF_WYT = OFF_Q + SZ_CH;
constexpr size_t OFF_YL = OFF_WYT + (size_t)256 * 16 * 8192;
constexpr size_t OFF_V = OFF_YL + (size_t)256 * 16 * 8192;
constexpr size_t OFF_G = OFF_V + (size_t)S * DR * 2;
constexpr size_t OFF_MIX = OFF_G + (size_t)S * DR * 2;
constexpr size_t OFF_SMALL = OFF_MIX + (size_t)S * D * 2;
constexpr size_t OFF_MODX = OFF_SMALL, OFF_MODC = OFF_MODX + 6144 * 4;
constexpr size_t OFF_ROWTAB = OFF_MODC + 6144 * 4, OFF_COLTAB = OFF_ROWTAB + 256 * 512 * 4;
constexpr size_t OFF_CNT = OFF_COLTAB + 64 * 512 * 4;
constexpr size_t OFF_GATE = OFF_CNT + 256;
constexpr size_t OFF_LIST = OFF_GATE + (size_t)S * 2 * 4;
constexpr size_t OFF_DOT = OFF_LIST + (size_t)NE * LCAP * 4;
constexpr size_t OFF_WP = OFF_DOT + (size_t)NT * 16 * 4;
constexpr size_t OFF_B2 = OFF_WP + 64 * 4 * 3 * 64 * 4;
constexpr size_t OFF_BAR = OFF_B2 + 256;
constexpr size_t OFF_WINB = OFF_BAR + 16384;
constexpr size_t OFF_WOUTB = OFF_WINB + (size_t)D * DIN * 2;
constexpr size_t WS_NEED = OFF_WOUTB + (size_t)D * D * 2;
constexpr size_t OFF_Z = OFF_U;
constexpr size_t OFF_X2 = OFF_P;
constexpr size_t OFF_YBUF = OFF_WYT;
constexpr size_t OFF_H2 = OFF_U;
constexpr size_t OFF_HID = OFF_U + SZ_CH;
constexpr size_t OFF_CP = OFF_U + SZ_CH;
constexpr size_t OFF_CQ = OFF_CP + 256 * 8192;
constexpr size_t OFF_ZG = OFF_CQ + 256 * 16384;

struct Params {
    const float *x, *c, *ctx, *c_ctx, *norm1_g, *w_mod, *b_mod, *w_in, *mu, *w0_f, *w2_f, *w0_b, *w2_b, *a0_f, *a2_f, *a0_b, *a2_b,
        *g2, *k_k, *k_a, *r_k_f, *r_k_b, *gn_w, *gn_b, *w_pool, *pool_scale, *w_out, *norm2_g, *w_rg, *b_rg, *w_re, *b_re,
        *w_gate, *w_up, *w_down, *final_g;
    float* out;
    char* ws;
};

DI unsigned pack2(float lo, float hi) { f32x2 v = {lo, hi}; bf16x2_t b = __builtin_convertvector(v, bf16x2_t); return __builtin_bit_cast(unsigned, b); }
DI float bf2f(bf16_t h) { return __uint_as_float(((unsigned)h) << 16); }
DI float bflo(unsigned u) { return __uint_as_float(u << 16); }
DI float bfhi(unsigned u) { return __uint_as_float(u & 0xffff0000u); }
DI void unpack8(const u32x4& p, float* f) { f[0] = bflo(p.x); f[1] = bfhi(p.x); f[2] = bflo(p.y); f[3] = bfhi(p.y); f[4] = bflo(p.z); f[5] = bfhi(p.z); f[6] = bflo(p.w); f[7] = bfhi(p.w); }
DI u32x4 pack8(const float* f) { u32x4 p; p.x = pack2(f[0], f[1]); p.y = pack2(f[2], f[3]); p.z = pack2(f[4], f[5]); p.w = pack2(f[6], f[7]); return p; }
DI float sigmoidf_(float x) { return 1.f / (1.f + __expf(-x)); }
DI float wave_sum(float v) {
#pragma unroll
    for (int o = 32; o > 0; o >>= 1) v += __shfl_xor(v, o, 64);
    return v;
}
DI f32x4 wave_sum4(f32x4 v) {
#pragma unroll
    for (int o = 32; o > 0; o >>= 1) { v[0] += __shfl_xor(v[0], o, 64); v[1] += __shfl_xor(v[1], o, 64); v[2] += __shfl_xor(v[2], o, 64); v[3] += __shfl_xor(v[3], o, 64); }
    return v;
}
typedef float f32x16 __attribute__((ext_vector_type(16)));
DI f32x16 zero16() { f32x16 z; for (int i = 0; i < 16; ++i) z[i] = 0.f; return z; }
DI s16x4 tr16(const bf16_t* a) { return __builtin_amdgcn_ds_read_tr16_b64_v4i16((LAS s16x4*)a); }
DI float pos_val(const float* rowtab, const float* coltab, int t, int d) { return d < 512 ? rowtab[(t >> 6) * 512 + d] : coltab[(t & 63) * 512 + (d - 512)]; }

DI void phase_p0(const Params& p, int bid, int nblk, char* lds) {
    const int tid = threadIdx.x;
    float* modx = (float*)(p.ws + OFF_MODX); float* modc = (float*)(p.ws + OFF_MODC);
    float* red = (float*)lds;
    for (int item = bid; item < 96; item += nblk) {
        const int col0 = item * 64, cg = tid & 15, kg = tid >> 4;
        f32x4 ax = {0, 0, 0, 0}, ac = {0, 0, 0, 0};
        for (int kk = 0; kk < 32; ++kk) {
            const int k = kg * 32 + kk;
            const float cv = p.c[k], cc = p.c_ctx[k];
            const float sx = cv * sigmoidf_(cv), sc = cc * sigmoidf_(cc);
            const f32x4 w = *(const f32x4*)(p.w_mod + (size_t)k * 6144 + col0 + cg * 4);
            ax += w * sx; ac += w * sc;
        }
        __syncthreads();
#pragma unroll
        for (int j = 0; j < 4; ++j) { red[(kg * 64 + cg * 4 + j) * 2] = ax[j]; red[(kg * 64 + cg * 4 + j) * 2 + 1] = ac[j]; }
        __syncthreads();
        if (tid < 128) {
            const int col = tid & 63, which = tid >> 6;
            float s = 0.f;
            for (int g = 0; g < 32; ++g) s += red[(g * 64 + col) * 2 + which];
            s += p.b_mod[col0 + col];
            (which ? modc : modx)[col0 + col] = s;
        }
    }
    float* rowtab = (float*)(p.ws + OFF_ROWTAB); float* coltab = (float*)(p.ws + OFF_COLTAB);
    for (int i = bid * NTH + tid; i < (256 + 64) * 256; i += nblk * NTH) {
        const int pos = i >> 8, f = i & 255;
        const float freq = powf(10000.f, -(float)f / 256.f);
        if (pos < 256) { const float a = (float)pos * freq; rowtab[pos * 512 + f] = sinf(a); rowtab[pos * 512 + 256 + f] = cosf(a); }
        else { const int cp = pos - 256; const float a = (float)cp * freq; coltab[cp * 512 + f] = sinf(a); coltab[cp * 512 + 256 + f] = cosf(a); }
    }
    if (bid == 0 && tid < 64) ((int*)(p.ws + OFF_CNT))[tid] = 0;
    for (int pass = 0; pass < 2; ++pass) {
        const float* src = pass ? p.w_out : p.w_in; const int nc = pass ? D : DIN; bf16_t* dst = (bf16_t*)(p.ws + (pass ? OFF_WOUTB : OFF_WINB));
        const int n8 = nc >> 3;
        for (int idx = bid * NTH + tid; idx < D * n8; idx += nblk * NTH) {
            const int k = idx / n8, g8 = idx - k * n8, blk = g8 >> 2, q = g8 & 3;
            const f32x4 lo = *(const f32x4*)(src + (size_t)k * nc + blk * 32 + 4 * q), hi = *(const f32x4*)(src + (size_t)k * nc + blk * 32 + 16 + 4 * q);
            *(u32x4*)(dst + (size_t)k * nc + blk * 32 + 8 * q) = (u32x4){pack2(lo[0], lo[1]), pack2(lo[2], lo[3]), pack2(hi[0], hi[1]), pack2(hi[2], hi[3])};
        }
    }
}

DI void phase_xn(const Params& p, int bid, int nblk) {
    const int lane = threadIdx.x & 63, wid = threadIdx.x >> 6;
    const float* modx = (const float*)(p.ws + OFF_MODX); const float* modc = (const float*)(p.ws + OFF_MODC);
    const float* rowtab = (const float*)(p.ws + OFF_ROWTAB); const float* coltab = (const float*)(p.ws + OFF_COLTAB);
    bf16_t* xn = (bf16_t*)(p.ws + OFF_XN);
    for (int gp = bid * NWV + wid; gp < NT / 2; gp += nblk * NWV) {
        const int g0 = 2 * gp; const bool isctx = g0 < CTX;
        const float* md = isctx ? modc : modx;
        f32x4 v[2][4]; float ss[2] = {0.f, 0.f};
#pragma unroll
        for (int r = 0; r < 2; ++r)
#pragma unroll
            for (int i = 0; i < 4; ++i) {
                const int g = g0 + r, t = g - CTX, d = (i * 64 + lane) * 4;
                const float* src = isctx ? p.ctx + (size_t)g * D : p.x + (size_t)t * D;
                v[r][i] = *(const f32x4*)(src + d);
                if (!isctx) v[r][i] += *(const f32x4*)(d < 512 ? rowtab + (t >> 6) * 512 + d : coltab + (t & 63) * 512 + (d - 512));
                ss[r] += v[r][i][0] * v[r][i][0] + v[r][i][1] * v[r][i][1] + v[r][i][2] * v[r][i][2] + v[r][i][3] * v[r][i][3];
            }
#pragma unroll
        for (int r = 0; r < 2; ++r) {
            const float rstd = rsqrtf(wave_sum(ss[r]) * (1.f / 1024.f) + 1e-6f);
#pragma unroll
            for (int i = 0; i < 4; ++i) {
                const int d = (i * 64 + lane) * 4;
                const f32x4 gg = *(const f32x4*)(p.norm1_g + d), sh = *(const f32x4*)(md + d), sc = *(const f32x4*)(md + 1024 + d);
                f32x4 o;
#pragma unroll
                for (int j = 0; j < 4; ++j) o[j] = (v[r][i][j] * rstd * gg[j]) * (1.f + sc[j]) + sh[j];
                u32x2 pk = {pack2(o[0], o[1]), pack2(o[2], o[3])};
                *(u32x2*)(xn + (size_t)(g0 + r) * D + d) = pk;
            }
        }
    }
}

constexpr int GA_SZ = 256 * 128, GB_SZ = 34816, GBUF_SZ = GA_SZ + GB_SZ;
constexpr int GEMM_LDS = 2 * GBUF_SZ;
DI void glds16(const void* gsrc, char* ldst) { __builtin_amdgcn_global_load_lds((const unsigned*)gsrc, (LAS unsigned*)ldst, 16, 0, 0); }
template <int NB, bool BGLDS, int NBLK, class AL, class EPI, int MB = 4>
DI void gemm8(const AL& al, const void* __restrict__ Bv0, const void* __restrict__ Bv1, int ldb, int K, char* lds, EPI& epi) {
    static_assert(!(BGLDS && NB == 2) && !(NB == 2 && NBLK == 2), "unsupported combination");
    constexpr int WN = 32 * NBLK, BN = 4 * WN;
    constexpr int RB = BN * 2;
    constexpr int BP = BN + 8;
    constexpr int NF4 = BN / 4;
    constexpr int NLD = (64 * NF4) / NTH;
    constexpr int NPB = (64 * RB) / (1024 * NWV);
    int tid = threadIdx.x; asm volatile("" : "+v"(tid));
    const int lane = tid & 63, wid = __builtin_amdgcn_readfirstlane(tid >> 6), wr = wid >> 2, wc = wid & 3, r32 = lane & 31, hh = lane >> 5, gi = lane >> 4, i16 = lane & 15;
    const float* B0 = (const float*)Bv0; const float* B1 = (const float*)Bv1; const bf16_t* Bb = (const bf16_t*)Bv0;
    f32x16 acc0[MB][NBLK], acc1[MB][NBLK];
#pragma unroll
    for (int m = 0; m < MB; ++m)
#pragma unroll
        for (int n = 0; n < NBLK; ++n) { acc0[m][n] = zero16(); acc1[m][n] = zero16(); }
    f32x4 rb0[NLD], rb1[NLD];
    const int T = K >> 6;
    const bf16_t* arow[MB];
#pragma unroll
    for (int i = 0; i < MB; ++i) { const int row = (8 * i + wid) * 8 + (lane >> 3); arow[i] = al.rowptr(i, row) + (((lane & 7) ^ ((row >> 1) & 7)) << 3); }
    int bsrc[NPB];
#pragma unroll
    for (int i = 0; i < NPB; ++i) { const int k = (8 * i + wid) * (1024 / RB) + lane / (RB / 16), pp = lane % (RB / 16); bsrc[i] = k * ldb + ((((pp >> 1) ^ (k & 7)) << 1) + (pp & 1)) * 8; }
    const int a_base = (wr * (32 * MB) + r32) * 128, a_sw = (r32 >> 1) & 7;
    const int b_off = (8 * (gi >> 1) + (i16 >> 2)) * BP + wc * WN + 16 * (gi & 1) + 4 * (i16 & 3);
#define G_DMA(buf, t_) do { char* dA_ = lds + (buf) * GBUF_SZ + wid * 1024 + lane * 16; \
        _Pragma("unroll") for (int i = 0; i < MB; ++i) glds16(arow[i] + (t_) * 64, dA_ + i * 8192); \
        if (BGLDS) { char* dB_ = lds + (buf) * GBUF_SZ + GA_SZ + wid * 1024 + lane * 16; \
            _Pragma("unroll") for (int i = 0; i < NPB; ++i) glds16(Bb + (size_t)(t_) * 64 * ldb + bsrc[i], dB_ + i * 8192); } } while (0)
#define G_LOADB(t_) do { const int k0_ = (t_) * 64; \
        _Pragma("unroll") for (int i = 0; i < NLD; ++i) { const int c = tid + NTH * i, kr = c / NF4, n4 = c % NF4; rb0[i] = *(const f32x4*)(B0 + (size_t)(k0_ + kr) * ldb + n4 * 4); \
            if (NB == 2) rb1[i] = *(const f32x4*)(B1 + (size_t)(k0_ + kr) * ldb + n4 * 4); } } while (0)
#define G_WRITEB(buf) do { bf16_t* sB0_ = (bf16_t*)(lds + (buf) * GBUF_SZ + GA_SZ); bf16_t* sB1_ = sB0_ + 64 * BP; \
        _Pragma("unroll") for (int i = 0; i < NLD; ++i) { const int c = tid + NTH * i, kr = c / NF4, n4 = c % NF4, slot = (n4 >> 3) * 32 + 8 * (n4 & 3) + 4 * ((n4 >> 2) & 1); \
            u32x2 pk = {pack2(rb0[i][0], rb0[i][1]), pack2(rb0[i][2], rb0[i][3])}; *(u32x2*)(sB0_ + kr * BP + slot) = pk; \
            if (NB == 2) { u32x2 pk1 = {pack2(rb1[i][0], rb1[i][1]), pack2(rb1[i][2], rb1[i][3])}; *(u32x2*)(sB1_ + kr * BP + slot) = pk1; } } } while (0)
#define G_READ(buf, ks, AF, BF0, BF1) do { const char* sA_ = lds + (buf) * GBUF_SZ; const bf16_t* sB0_ = (const bf16_t*)(lds + (buf) * GBUF_SZ + GA_SZ); const bf16_t* sB1_ = sB0_ + 64 * BP; const int k0_ = (ks) * 16; \
        _Pragma("unroll") for (int n = 0; n < NBLK; ++n) { \
            if (BGLDS) { const int kk_ = k0_ + 8 * (gi >> 1) + (i16 >> 2), gr_ = (wc * WN + n * 32) / 16 + (gi & 1); \
                const char* q0_ = (const char*)sB0_ + kk_ * RB + ((gr_ ^ (kk_ & 7)) << 5) + 8 * (i16 & 3); const char* q1_ = (const char*)sB0_ + (kk_ + 4) * RB + ((gr_ ^ ((kk_ + 4) & 7)) << 5) + 8 * (i16 & 3); \
                s16x4 lo = tr16((const bf16_t*)q0_), hi = tr16((const bf16_t*)q1_); BF0[n] = __builtin_shufflevector(lo, hi, 0, 1, 2, 3, 4, 5, 6, 7); } \
            else { const int off = b_off + k0_ * BP + n * 32; \
                s16x4 lo = tr16(sB0_ + off), hi = tr16(sB0_ + off + 4 * BP); BF0[n] = __builtin_shufflevector(lo, hi, 0, 1, 2, 3, 4, 5, 6, 7); \
                if (NB == 2) { s16x4 lo1 = tr16(sB1_ + off), hi1 = tr16(sB1_ + off + 4 * BP); BF1[n] = __builtin_shufflevector(lo1, hi1, 0, 1, 2, 3, 4, 5, 6, 7); } } } \
        _Pragma("unroll") for (int m = 0; m < MB; ++m) AF[m] = *(const bf16x8*)(sA_ + a_base + m * 4096 + ((((ks) * 2 + hh) ^ a_sw) << 4)); } while (0)
#define G_MFMA(AF, BF0, BF1) do { \
        _Pragma("unroll") for (int m = 0; m < MB; ++m) _Pragma("unroll") for (int n = 0; n < NBLK; ++n) { \
            acc0[m][n] = __builtin_amdgcn_mfma_f32_32x32x16_bf16(BF0[n], AF[m], acc0[m][n], 0, 0, 0); \
            if (NB == 2) acc1[m][n] = __builtin_amdgcn_mfma_f32_32x32x16_bf16(BF1[n], AF[m], acc1[m][n], 0, 0, 0); } } while (0)
#define G_MIX(nm) do { _Pragma("unroll") for (int i = 0; i < (nm); ++i) { __builtin_amdgcn_sched_group_barrier(0x008, 1, 0); __builtin_amdgcn_sched_group_barrier(0x100, 1, 0); } } while (0)
    constexpr int NMF = MB * NBLK * NB;
    bf16x8 afA[MB], bfA0[NBLK], bfA1[NBLK], afB[MB], bfB0[NBLK], bfB1[NBLK];
    G_DMA(0, 0);
    if (!BGLDS) { G_LOADB(0); G_WRITEB(0); }
#pragma unroll 1
    for (int t = 0; t < T; ++t) {
        const int buf = t & 1;
        asm volatile("s_waitcnt vmcnt(0)" ::: "memory");
        __syncthreads();
        if (t + 1 < T) { G_DMA(buf ^ 1, t + 1); if (!BGLDS) G_LOADB(t + 1); }
        if (BGLDS) {
            G_READ(buf, 0, afA, bfA0, bfA1);
            __builtin_amdgcn_sched_barrier(0);
            G_MFMA(afA, bfA0, bfA1); G_READ(buf, 1, afB, bfB0, bfB1); G_MIX(NMF);
            __builtin_amdgcn_sched_barrier(0);
            G_MFMA(afB, bfB0, bfB1); G_READ(buf, 2, afA, bfA0, bfA1); G_MIX(NMF);
            __builtin_amdgcn_sched_barrier(0);
            G_MFMA(afA, bfA0, bfA1); G_READ(buf, 3, afB, bfB0, bfB1); G_MIX(NMF);
            __builtin_amdgcn_sched_barrier(0);
            G_MFMA(afB, bfB0, bfB1);
        } else {
            __builtin_amdgcn_sched_barrier(0);
            G_READ(buf, 0, afA, bfA0, bfA1); G_MFMA(afA, bfA0, bfA1);
            G_READ(buf, 1, afA, bfA0, bfA1); G_MFMA(afA, bfA0, bfA1);
            G_READ(buf, 2, afA, bfA0, bfA1); G_MFMA(afA, bfA0, bfA1);
            __builtin_amdgcn_sched_barrier(0);
            G_READ(buf, 3, afA, bfA0, bfA1); G_MFMA(afA, bfA0, bfA1);
            G_WRITEB(buf ^ 1);
        }
        __builtin_amdgcn_sched_barrier(0);
    }
#undef G_DMA
#undef G_LOADB
#undef G_WRITEB
#undef G_READ
#undef G_MFMA
#undef G_MIX
    __syncthreads();
    float* stg = (float*)lds + wid * (32 * 68);
#pragma unroll
    for (int m = 0; m < MB; ++m) {
#pragma unroll
        for (int n = 0; n < NBLK; ++n) {
            const f32x16 v = epi.pre(acc0[m][n], acc1[m][n]);
#pragma unroll
            for (int q = 0; q < 4; ++q) *(f32x4*)(stg + r32 * 68 + n * 32 + 16 * hh + 4 * q) = (f32x4){v[4 * q], v[4 * q + 1], v[4 * q + 2], v[4 * q + 3]};
        }
        asm volatile("s_waitcnt lgkmcnt(0)" ::: "memory"); __builtin_amdgcn_wave_barrier();
#pragma unroll
        for (int ps = 0; ps < (32 * WN) / 256; ++ps) {
            const int idx = ps * 64 + lane, row = idx / (WN / 4), ck = idx % (WN / 4);
            epi.post(wr * (32 * MB) + m * 32 + row, wc * WN + ck * 4, *(const f32x4*)(stg + row * 68 + ck * 4));
        }
        asm volatile("s_waitcnt lgkmcnt(0)" ::: "memory"); __builtin_amdgcn_wave_barrier();
    }
    __syncthreads();
}

struct PlainA {
    const bf16_t* base; int lda;
    DI const bf16_t* rowptr(int, int row) const { return base + (size_t)row * lda; }
};
struct GatherA {
    const bf16_t* rp[4];
    DI const bf16_t* rowptr(int i, int) const { return rp[i]; }
};

struct XcdOrder {
    int base, lim, j, bpx;
    DI XcdOrder(int bid, int nblk, int total) {
        if ((nblk & 7) == 0) { const int x = bid & 7, per = (total + 7) >> 3; bpx = nblk >> 3; j = bid >> 3; base = x * per; lim = base + per < total ? base + per : total; }
        else { bpx = nblk; j = bid; base = 0; lim = total; }
    }
    DI int item(int i) const { const int q = base + i * bpx + j; return q < lim ? q : -1; }
};
DI void tile_rc(int q, int nrow, int ncol, int& r, int& c) {
    const int per_sr = 8 * ncol, sr = q / per_sr, rem = q - sr * per_sr, rows = (nrow - sr * 8) < 8 ? (nrow - sr * 8) : 8;
    c = rem / rows; r = sr * 8 + rem - c * rows;
}

DI u32x4 pack8v(const f32x4& a, const f32x4& b) { return (u32x4){pack2(a[0], a[1]), pack2(a[2], a[3]), pack2(b[0], b[1]), pack2(b[2], b[3])}; }
DI u32x4 pack8q(const f32x16& a, int q) { return (u32x4){pack2(a[8 * q], a[8 * q + 1]), pack2(a[8 * q + 2], a[8 * q + 3]), pack2(a[8 * q + 4], a[8 * q + 5]), pack2(a[8 * q + 6], a[8 * q + 7])}; }
struct EpiStoreBf16 { bf16_t* o; int ldo;
    DI f32x16 pre(const f32x16& a, const f32x16&) const { return a; }
    DI void post(int r, int c, const f32x4& v) const { u32x2 pk = {pack2(v[0], v[1]), pack2(v[2], v[3])}; *(u32x2*)(o + (size_t)r * ldo + c) = pk; } };
DI void phase_g1(const Params& p, int bid, int nblk, char* lds) {
    const bf16_t* xn = (const bf16_t*)(p.ws + OFF_XN); bf16_t* u = (bf16_t*)(p.ws + OFF_U);
    const bf16_t* wb = (const bf16_t*)(p.ws + OFF_WINB);
    const int nwide_all = 65 * 9, nwide = (2 * nblk < nwide_all) ? 2 * nblk : nwide_all;
    const XcdOrder ord(bid, nblk, nwide);
    for (int i = 0, q; (q = ord.item(i)) >= 0; ++i) {
        int tm, tn; tile_rc(q, 65, 9, tm, tn);
        PlainA al{xn + (size_t)tm * 256 * D, D};
        EpiStoreBf16 epi{u + (size_t)tm * 256 * DIN + tn * 256, DIN};
        gemm8<1, true, 2>(al, wb + tn * 256, nullptr, DIN, D, lds, epi);
    }
    const int nhalf = 2 * (nwide_all - nwide) + 65;
    for (int n = bid; n < nhalf; n += nblk) {
        int tm, col;
        if (n < 2 * (nwide_all - nwide)) { int tn; tile_rc(nwide + (n >> 1), 65, 9, tm, tn); col = tn * 256 + (n & 1) * 128; }
        else { tm = n - 2 * (nwide_all - nwide); col = 9 * 256; }
        PlainA al{xn + (size_t)tm * 256 * D, D};
        EpiStoreBf16 epi{u + (size_t)tm * 256 * DIN + col, DIN};
        gemm8<1, true, 1>(al, wb + col, nullptr, DIN, D, lds, epi);
    }
}

DI void phase_pool(const Params& p, int bid, int nblk) {
    const bf16_t* u = (const bf16_t*)(p.ws + OFF_U) + (size_t)CTX * DIN + C_POOL;
    bf16_t* mix = (bf16_t*)(p.ws + OFF_MIX);
    for (int item = bid * NTH + threadIdx.x; item < (S / 8) * 64; item += nblk * NTH) {
        const int cg = item & 63, run = item >> 6, t0 = run * 8, gi = cg >> 4, win = 2 << gi, hw = win >> 1;
        const bf16_t* uc = u + cg * 8;
        float sum[8];
#pragma unroll
        for (int j = 0; j < 8; ++j) sum[j] = 0.f;
        const int lo0 = (t0 - hw) < 0 ? 0 : (t0 - hw), hi0 = (t0 - hw + win) > S ? S : (t0 - hw + win);
#pragma unroll
        for (int r = 0; r < 16; ++r) {
            const int tt = lo0 + r; const bool ok = tt < hi0; const int tc = ok ? tt : lo0;
            float q[8]; unpack8(*(const u32x4*)(uc + (size_t)tc * DIN), q);
            const float wgt = ok ? 1.f : 0.f;
#pragma unroll
            for (int j = 0; j < 8; ++j) sum[j] += wgt * q[j];
        }
        int lo = lo0, hi = hi0;
#pragma unroll
        for (int k = 0; k < 8; ++k) {
            const int t = t0 + k;
            float cv[8], o[8]; unpack8(*(const u32x4*)(uc + (size_t)t * DIN), cv);
            const float inv = 1.f / (float)(hi - lo);
#pragma unroll
            for (int j = 0; j < 8; ++j) o[j] = sum[j] * inv - cv[j];
            *(u32x4*)(mix + (size_t)t * D + cg * 8) = pack8(o);
            const int nlo = t + 1 - hw, nhi = t + 1 - hw + win;
            const bool addr = nhi <= S, subr = nlo > 0;
            float qa[8], qs[8];
            unpack8(*(const u32x4*)(uc + (size_t)(addr ? nhi - 1 : t) * DIN), qa); unpack8(*(const u32x4*)(uc + (size_t)(subr ? nlo - 1 : t) * DIN), qs);
            const float wa = addr ? 1.f : 0.f, wsb = subr ? 1.f : 0.f;
#pragma unroll
            for (int j = 0; j < 8; ++j) sum[j] += wa * qa[j] - wsb * qs[j];
            hi = addr ? nhi : hi; lo = subr ? nlo : lo;
        }
    }
}
struct EpiPool { bf16_t* o; const float* sc;
    DI f32x16 pre(const f32x16& a, const f32x16&) const { return a; }
    DI void post(int r, int c, const f32x4& v) const { const f32x4 s4 = *(const f32x4*)(sc + c); u32x2 pk = {pack2(v[0] * s4[0], v[1] * s4[1]), pack2(v[2] * s4[2], v[3] * s4[3])}; *(u32x2*)(o + (size_t)r * D + c) = pk; } };
DI void phase_poolgemm(const Params& p, int bid, int nblk, char* lds) {
    if (nblk <= 0) return;
    for (int it = bid; it < 4 * 64; it += nblk) {
        const int gi = it >> 6, tm = it & 63;
        const bf16_t* mix = (const bf16_t*)(p.ws + OFF_MIX);
        PlainA al{mix + (size_t)tm * 256 * D + gi * 128, D};
        EpiPool e{(bf16_t*)(p.ws + OFF_MIX) + (size_t)tm * 256 * D + 512 + gi * 128, p.pool_scale + gi * 128};
        int kk = 128; asm volatile("" : "+s"(kk));
        gemm8<1, false, 1>(al, p.w_pool + (size_t)gi * 128 * 128, nullptr, 128, kk, lds, e);
    }
}

constexpr int MP = 72, MSZ = 64 * MP;
constexpr int FP = 68;
constexpr int SCANA_LDS = 14 * MSZ * 2 + 4096;
template <bool KS> DI bf16x8 frag32(const bf16_t* base, int x0, int s, int lane) {
    if (!KS) return *(const bf16x8*)(base + (x0 + (lane & 31)) * MP + 16 * s + 8 * (lane >> 5));
    const int gi = lane >> 4, i = lane & 15;
    const bf16_t* a = base + (16 * s + 8 * (gi >> 1) + (i >> 2)) * MP + x0 + 16 * (gi & 1) + 4 * (i & 3);
    s16x4 lo = tr16(a), hi = tr16(a + 4 * MP);
    return __builtin_shufflevector(lo, hi, 0, 1, 2, 3, 4, 5, 6, 7);
}
template <bool XKS, bool YKS> DI f32x16 mm32(const bf16_t* X, int x0, const bf16_t* Y, int y0, f32x16 acc, int lane) {
#pragma unroll
    for (int s = 0; s < 4; ++s) acc = __builtin_amdgcn_mfma_f32_32x32x16_bf16(frag32<XKS>(X, x0, s, lane), frag32<YKS>(Y, y0, s, lane), acc, 0, 0, 0);
    return acc;
}
template <class F> DI void store_acc(bf16_t* out, int x0, int y0, const f32x16& acc, int lane, F f) {
    const int y = y0 + (lane & 31), hh = lane >> 5;
#pragma unroll
    for (int q = 0; q < 4; ++q) {
        const int x = x0 + 8 * q + 4 * hh;
        u32x2 pk = {pack2(f(acc[4 * q], x, y), f(acc[4 * q + 1], x + 1, y)), pack2(f(acc[4 * q + 2], x + 2, y), f(acc[4 * q + 3], x + 3, y))};
        *(u32x2*)(out + y * MP + x) = pk;
    }
}
DI unsigned rot16(unsigned x) { return (x >> 16) | (x << 16); }

DI int chain_pos(int c, int dir) { return dir == 0 ? c : (c < 4 ? 3 - c : NCH + 3 - c); }

DI void phase_scanA(const Params& p, int bid, int nblk, char* lds) {
    const int tid = threadIdx.x, lane0 = tid & 63, w = tid >> 6, grp = w >> 2;
    bf16_t* M = (bf16_t*)lds;
    bf16_t *sAT = M, *sBT = M + MSZ, *sKT = M + 2 * MSZ, *sRT = M + 3 * MSZ, *sVT = M + 4 * MSZ;
    float* fGC = (float*)(lds + 14 * MSZ * 2);
    float* fSeg = fGC + 64;
    float* fTab = fSeg + 64;
    float* fLogw = (float*)(M + 12 * MSZ);
    float* fA = (float*)(M + 10 * MSZ);
    const bf16_t* u = (const bf16_t*)(p.ws + OFF_U);
    u32x4 raw[3][3];
#define SCANA_ISSUE(inst_) do { const int c_ = (inst_) >> 4, h_ = ((inst_) >> 1) & 7, d_ = (inst_) & 1, ch_ = tid & 7, tau_ = tid >> 3, g_ = d_ ? c_ * 64 + 63 - tau_ : c_ * 64 + tau_; \
        const bool hp_ = (g_ != 0) && (g_ != CTX), hn_ = (g_ != CTX - 1) && (g_ != NT - 1); \
        const bf16_t* rc_ = u + (size_t)g_ * DIN; const bf16_t* rp_ = hp_ ? rc_ - DIN : rc_; const bf16_t* rn_ = hn_ ? rc_ + DIN : rc_; \
        const int cl_[5] = {h_ * 64 + ch_ * 8, 512 + h_ * 64 + ch_ * 8, 1024 + h_ * 64 + ch_ * 8, (d_ ? C_WLB : C_WLF) + ch_ * 8, (d_ ? C_ALB : C_ALF) + ch_ * 8}; \
        _Pragma("unroll") for (int q = 0; q < 3; ++q) { raw[q][0] = *(const u32x4*)(rc_ + cl_[q]); raw[q][1] = *(const u32x4*)(rp_ + cl_[q]); raw[q][2] = *(const u32x4*)(rn_ + cl_[q]); } } while (0)
    if (bid < NCH * 16) SCANA_ISSUE(bid);
    int cur_hd = -1;
    for (int inst = bid; inst < NCH * 16; inst += nblk) {
        int lane = lane0; asm volatile("" : "+v"(lane));
        const int xq = 32 * (w & 1), yq = 32 * ((w >> 1) & 1);
        const int c = inst >> 4, h = (inst >> 1) & 7, dir = inst & 1;
        const bool latent = c >= 4, want_g = latent && dir == 0;
        const float* w2 = dir ? p.w2_b : p.w2_f; const float* a2 = dir ? p.a2_b : p.a2_f;
        const float* w0 = dir ? p.w0_b : p.w0_f; const float* a0 = dir ? p.a0_b : p.a0_f;
        const float* rkd = dir ? p.r_k_b : p.r_k_f;
        const int cwl = dir ? C_WLB : C_WLF, cal = dir ? C_ALB : C_ALF;
        const int ch = tid & 7, tau = tid >> 3, g = dir ? c * 64 + 63 - tau : c * 64 + tau;
        if ((inst & 15) != cur_hd) {
            cur_hd = inst & 15;
            for (int i = tid; i < 768; i += NTH) {
                const int grp_ = i >> 6, j_ = i & 63; float v_;
                if (grp_ < 3) v_ = p.mu[grp_ * 512 + h * 64 + j_];
                else if (grp_ == 3) v_ = p.mu[cwl + j_];
                else if (grp_ == 4) v_ = p.mu[cal + j_];
                else if (grp_ < 7) v_ = p.mu[C_GL + (grp_ - 5) * 64 + j_];
                else if (grp_ == 7) v_ = p.k_k[h * 64 + j_];
                else if (grp_ == 8) v_ = p.k_a[h * 64 + j_];
                else if (grp_ == 9) v_ = rkd[h * 64 + j_];
                else if (grp_ == 10) v_ = w0[h * 64 + j_];
                else v_ = a0[h * 64 + j_];
                fTab[i] = v_;
            }
            __syncthreads();
        }
        float fr_[8], fk_[8], fv_[8];
        {
            const int cols5[5] = {h * 64 + ch * 8, 512 + h * 64 + ch * 8, 1024 + h * 64 + ch * 8, cwl + ch * 8, cal + ch * 8};
            const bool hasp = (g != 0) && (g != CTX), hasn = (g != CTX - 1) && (g != NT - 1);
            const float mp = hasp ? 0.5f : 0.f, mn = hasn ? 0.5f : 0.f;
            const bf16_t* rc = u + (size_t)g * DIN; const bf16_t* rp = hasp ? rc - DIN : rc; const bf16_t* rn = hasn ? rc + DIN : rc;
            u32x4 raw3[3], raw4[3];
            raw3[0] = *(const u32x4*)(rc + cols5[3]); raw3[1] = *(const u32x4*)(rp + cols5[3]); raw3[2] = *(const u32x4*)(rn + cols5[3]);
            raw4[0] = *(const u32x4*)(rc + cols5[4]); raw4[1] = *(const u32x4*)(rp + cols5[4]); raw4[2] = *(const u32x4*)(rn + cols5[4]);
            auto shift8 = [&](const u32x4* r3, int tgrp, float* o) {
                float cc[8], pv[8], nx[8];
                unpack8(r3[0], cc); unpack8(r3[1], pv); unpack8(r3[2], nx);
                const f32x4 m0 = *(const f32x4*)(fTab + tgrp * 64 + ch * 8), m1 = *(const f32x4*)(fTab + tgrp * 64 + ch * 8 + 4);
#pragma unroll
                for (int j = 0; j < 8; ++j) { const float m = j < 4 ? m0[j & 3] : m1[j & 3]; o[j] = cc[j] + m * ((mp * pv[j] + mn * nx[j]) - cc[j]); }
            };
            shift8(raw[0], 0, fr_); shift8(raw[1], 1, fk_); shift8(raw[2], 2, fv_);
            f32x4 wl[4];
#pragma unroll
            for (int q = 0; q < 2; ++q) { const int idx = tid + NTH * q, kr = idx >> 4, n4 = idx & 15;
                wl[q] = *(const f32x4*)(w2 + (size_t)kr * DR + h * 64 + n4 * 4); wl[2 + q] = *(const f32x4*)(a2 + (size_t)kr * DR + h * 64 + n4 * 4); }
            float t8[8];
            shift8(raw3, 3, t8);
#pragma unroll
            for (int j = 0; j < 8; ++j) { const float e2 = __expf(2.f * t8[j]); t8[j] = 1.f - __fdividef(2.f, e2 + 1.f); }
            *(u32x4*)(M + 5 * MSZ + tau * MP + ch * 8) = pack8(t8);
            shift8(raw4, 4, t8);
            *(u32x4*)(M + 6 * MSZ + tau * MP + ch * 8) = pack8(t8);
            if (want_g) {
                u32x4 rawg[2][3]; f32x4 wg2[4];
#pragma unroll
                for (int half = 0; half < 2; ++half) { const int col = C_GL + half * 64 + ch * 8;
                    rawg[half][0] = *(const u32x4*)(rc + col); rawg[half][1] = *(const u32x4*)(rp + col); rawg[half][2] = *(const u32x4*)(rn + col); }
#pragma unroll
                for (int q = 0; q < 4; ++q) { const int idx = tid + NTH * q, kr = idx >> 4, n4 = idx & 15; wg2[q] = *(const f32x4*)(p.g2 + (size_t)kr * DR + h * 64 + n4 * 4); }
#pragma unroll
                for (int half = 0; half < 2; ++half) {
                    shift8(rawg[half], 5 + half, t8);
#pragma unroll
                    for (int j = 0; j < 8; ++j) t8[j] = sigmoidf_(t8[j]);
                    *(u32x4*)(M + half * MSZ + tau * MP + ch * 8) = pack8(t8);
                }
#pragma unroll
                for (int q = 0; q < 4; ++q) { const int idx = tid + NTH * q, kr = idx >> 4, n4 = idx & 15;
                    u32x2 pa = {pack2(wg2[q][0], wg2[q][1]), pack2(wg2[q][2], wg2[q][3])};
                    *(u32x2*)(M + (2 + (kr >> 6)) * MSZ + (kr & 63) * MP + n4 * 4) = pa; }
            }
#pragma unroll
            for (int q = 0; q < 2; ++q) { const int idx = tid + NTH * q, kr = idx >> 4, n4 = idx & 15;
                u32x2 pa = {pack2(wl[q][0], wl[q][1]), pack2(wl[q][2], wl[q][3])}, pb = {pack2(wl[2 + q][0], wl[2 + q][1]), pack2(wl[2 + q][2], wl[2 + q][3])};
                *(u32x2*)(M + 7 * MSZ + kr * MP + n4 * 4) = pa; *(u32x2*)(M + 8 * MSZ + kr * MP + n4 * 4) = pb; }
        }
        __syncthreads();
        if (grp == 0) {
            f32x16 accW = mm32<true, false>(M + 7 * MSZ, xq, M + 5 * MSZ, yq, zero16(), lane);
            const int y = yq + (lane & 31), hh = lane >> 5;
#pragma unroll
            for (int q = 0; q < 4; ++q) {
                const int x = xq + 8 * q + 4 * hh;
                f32x4 lw; const f32x4 w0v = *(const f32x4*)(fTab + 10 * 64 + x);
#pragma unroll
                for (int e = 0; e < 4; ++e) {
                    float v = -DECAY_SCALE * sigmoidf_(w0v[e] + accW[4 * q + e]);
                    v += __builtin_bit_cast(float, __builtin_amdgcn_update_dpp(0, __builtin_bit_cast(int, v), 0x111, 0xf, 0xf, false));
                    v += __builtin_bit_cast(float, __builtin_amdgcn_update_dpp(0, __builtin_bit_cast(int, v), 0x112, 0xf, 0xf, false));
                    v += __builtin_bit_cast(float, __builtin_amdgcn_update_dpp(0, __builtin_bit_cast(int, v), 0x114, 0xf, 0xf, false));
                    v += __builtin_bit_cast(float, __builtin_amdgcn_update_dpp(0, __builtin_bit_cast(int, v), 0x118, 0xf, 0xf, false));
                    v += __builtin_bit_cast(float, __builtin_amdgcn_update_dpp(0, __builtin_bit_cast(int, v), 0x142, 0xa, 0xf, false));
                    lw[e] = v;
                }
                *(f32x4*)(fLogw + y * FP + x) = lw;
                if (yq == 0 && (lane & 31) == 31) *(f32x4*)(fSeg + x) = lw;
            }
        } else {
            f32x16 accA = mm32<true, false>(M + 8 * MSZ, xq, M + 6 * MSZ, yq, zero16(), lane);
            const int y = yq + (lane & 31), hh = lane >> 5;
#pragma unroll
            for (int q = 0; q < 4; ++q) {
                const int x = xq + 8 * q + 4 * hh;
                f32x4 av; const f32x4 a0v = *(const f32x4*)(fTab + 11 * 64 + x);
#pragma unroll
                for (int e = 0; e < 4; ++e) av[e] = sigmoidf_(a0v[e] + accA[4 * q + e]);
                *(f32x4*)(fA + y * FP + x) = av;
            }
            if (want_g) {
                f32x16 accG = mm32<true, false>(M + 2 * MSZ, xq, M, yq, zero16(), lane);
                accG = mm32<true, false>(M + 3 * MSZ, xq, M + MSZ, yq, accG, lane);
                const int t = c * 64 + y - CTX;
#pragma unroll
                for (int q = 0; q < 4; ++q) {
                    const int x = xq + 8 * q + 4 * hh;
                    u32x2 pk = {pack2(accG[4 * q], accG[4 * q + 1]), pack2(accG[4 * q + 2], accG[4 * q + 3])};
                    *(u32x2*)((bf16_t*)(p.ws + OFF_G) + (size_t)t * DR + h * 64 + x) = pk;
                }
            }
        }
        __syncthreads();
        {
            float oa[8], ob[8], ok[8], orr[8], kkv[8], kd[8];
            float ss = 0.f, dsum = 0.f;
            float kkp[8], kap[8], rkp[8], cum8[8], prv8[8], av8[8];
#pragma unroll
            for (int hf = 0; hf < 2; ++hf) {
                const int o8 = ch * 8 + 4 * hf;
                const f32x4 a_ = *(const f32x4*)(fTab + 7 * 64 + o8), b_ = *(const f32x4*)(fTab + 8 * 64 + o8), c_ = *(const f32x4*)(fTab + 9 * 64 + o8);
                const f32x4 sg = *(const f32x4*)(fSeg + o8), cu = *(const f32x4*)(fLogw + tau * FP + o8), pr = *(const f32x4*)(fLogw + (tau ? tau - 1 : 0) * FP + o8), aa = *(const f32x4*)(fA + tau * FP + o8);
#pragma unroll
                for (int j = 0; j < 4; ++j) {
                    kkp[4 * hf + j] = a_[j]; kap[4 * hf + j] = b_[j]; rkp[4 * hf + j] = c_[j]; av8[4 * hf + j] = aa[j];
                    cum8[4 * hf + j] = cu[j] + (tau >= 32 ? sg[j] : 0.f); prv8[4 * hf + j] = tau ? pr[j] + (tau > 32 ? sg[j] : 0.f) : 0.f;
                }
            }
#pragma unroll
            for (int j = 0; j < 8; ++j) { kkv[j] = fk_[j] * kkp[j]; ss += kkv[j] * kkv[j]; }
            ss += __shfl_xor(ss, 1, 64); ss += __shfl_xor(ss, 2, 64); ss += __shfl_xor(ss, 4, 64);
            const float inv = 1.f / fmaxf(sqrtf(ss), 1e-12f);
            float gm8[8];
#pragma unroll
            for (int j = 0; j < 8; ++j) {
                const float cum = cum8[j], cprev = prv8[j], av = av8[j];
                const float gam = __expf(cum), gprev = __expf(cprev), ginv = __expf(-cum);
                const float kkn = kkv[j] * inv;
                kd[j] = fk_[j] * (1.f + (av - 1.f) * kap[j]);
                oa[j] = -kkn * gprev; ob[j] = kkn * av * ginv; ok[j] = kd[j] * ginv; orr[j] = fr_[j] * gam;
                dsum += fr_[j] * kd[j] * rkp[j];
                gm8[j] = gam;
            }
            if (tau == 63) { *(f32x4*)(fGC + ch * 8) = (f32x4){gm8[0], gm8[1], gm8[2], gm8[3]}; *(f32x4*)(fGC + ch * 8 + 4) = (f32x4){gm8[4], gm8[5], gm8[6], gm8[7]}; }
            dsum += __shfl_xor(dsum, 1, 64); dsum += __shfl_xor(dsum, 2, 64); dsum += __shfl_xor(dsum, 4, 64);
            if (ch == 0) ((float*)(p.ws + OFF_DOT))[((size_t)g * 8 + h) * 2 + dir] = dsum;
            *(u32x4*)(sAT + tau * MP + ch * 8) = pack8(oa); *(u32x4*)(sBT + tau * MP + ch * 8) = pack8(ob);
            *(u32x4*)(sKT + tau * MP + ch * 8) = pack8(ok); *(u32x4*)(sRT + tau * MP + ch * 8) = pack8(orr);
            const u32x4 pv8 = pack8(fv_);
            *(u32x4*)(sVT + tau * MP + ch * 8) = pv8;
            if (want_g) *(u32x4*)((bf16_t*)(p.ws + OFF_V) + (size_t)(g - CTX) * DR + h * 64 + ch * 8) = pv8;
        }
        __syncthreads();
        if (grp == 0) {
            f32x16 acc = mm32<false, false>(sAT, xq, sBT, yq, zero16(), lane);
            store_acc(M + 5 * MSZ, xq, yq, acc, lane, [](float v, int x, int y) { return y < x ? v : 0.f; });
            store_acc(M + 7 * MSZ, xq, yq, acc, lane, [](float v, int x, int y) { return y < x ? v : (y == x ? 1.f : 0.f); });
        } else {
            f32x16 acc = mm32<false, false>(sAT, xq, sKT, yq, zero16(), lane);
            store_acc(M + 9 * MSZ, xq, yq, acc, lane, [](float v, int x, int y) { return y < x ? v : 0.f; });
        }
        __syncthreads();
        int xs = 5, xo = 6, ts = 7, to = 8;
        if (grp == 1) {
            f32x16 acc = mm32<true, false>(M + xs * MSZ, xq, M + xs * MSZ, yq, zero16(), lane);
            store_acc(M + xo * MSZ, xq, yq, acc, lane, [](float v, int, int) { return v; });
        }
        { int t_ = xs; xs = xo; xo = t_; }
        __syncthreads();
        for (int k = 0; k < 5; ++k) {
            if (grp == 0) {
                const bf16_t* Told = M + ts * MSZ;
                f32x16 acc = mm32<true, false>(M + xs * MSZ, xq, Told, yq, zero16(), lane);
                store_acc(M + to * MSZ, xq, yq, acc, lane, [Told](float v, int x, int y) { return v + bf2f(Told[y * MP + x]); });
            } else if (k < 4) {
                f32x16 acc = mm32<true, false>(M + xs * MSZ, xq, M + xs * MSZ, yq, zero16(), lane);
                store_acc(M + xo * MSZ, xq, yq, acc, lane, [](float v, int, int) { return v; });
            } else {
                f32x16 acc = mm32<false, false>(sRT, xq, sBT, yq, zero16(), lane);
                store_acc(M + 10 * MSZ, xq, yq, acc, lane, [](float v, int x, int y) { return y <= x ? v : 0.f; });
                acc = mm32<false, false>(sRT, xq, sKT, yq, zero16(), lane);
                store_acc(M + 11 * MSZ, xq, yq, acc, lane, [](float v, int x, int y) { return y <= x ? v : 0.f; });
            }
            int t_ = xs; xs = xo; xo = t_; t_ = ts; ts = to; to = t_;
            __syncthreads();
        }
        const bf16_t* sT = M + ts * MSZ;
        if (grp == 0) {
            f32x16 acc = mm32<true, true>(sT, xq, sAT, yq, zero16(), lane);
            store_acc(M + 12 * MSZ, xq, yq, acc, lane, [](float v, int, int) { return v; });
        } else {
            f32x16 acc = mm32<true, false>(sT, xq, M + 9 * MSZ, yq, zero16(), lane);
            store_acc(M + 13 * MSZ, xq, yq, acc, lane, [](float v, int, int) { return v; });
        }
        __syncthreads();
        {
            const bf16_t *sAbar = M + 12 * MSZ, *sG = M + 13 * MSZ, *sABR = M + 10 * MSZ, *sAKR = M + 11 * MSZ;
            if (grp == 0) {
                f32x16 acc = mm32<false, true>(sAbar, xq, sBT, yq, zero16(), lane);
                store_acc(M + 5 * MSZ, xq, yq, acc, lane, [fGC](float v, int x, int y) { return ((x == y ? 1.f : 0.f) + v) * fGC[y]; });
                acc = mm32<false, true>(sAbar, xq, sABR, yq, zero16(), lane);
                store_acc(M + 6 * MSZ, xq, yq, acc, lane, [sRT](float v, int x, int y) { return v + bf2f(sRT[y * MP + x]); });
            } else {
                f32x16 acc = mm32<true, false>(sBT, xq, sG, yq, zero16(), lane);
                store_acc(M + 7 * MSZ, xq, yq, acc, lane, [sKT, fGC](float v, int x, int y) { return (v + bf2f(sKT[y * MP + x])) * fGC[x]; });
                acc = mm32<true, false>(sABR, xq, sG, yq, zero16(), lane);
                store_acc(M + 9 * MSZ, xq, yq, acc, lane, [sAKR](float v, int x, int y) { return v + bf2f(sAKR[y * MP + x]); });
            }
        }
        __syncthreads();
        const int chain = dir * 8 + h, npos = chain_pos(c, dir);
        {
            u32x4* Pg = (u32x4*)(p.ws + OFF_P) + ((size_t)chain * NCH + npos) * 512;
            { const int item = tid, ln = item & 63, as = item >> 6, a = as >> 1, s2 = as & 1, fr = ln & 15, fq = ln >> 4;
              const bf16_t* src = M + 5 * MSZ + (16 * a + fr) * MP + 32 * s2 + 4 * fq;
              const u32x2 lo = *(const u32x2*)src, hi = *(const u32x2*)(src + 16);
              Pg[as * 64 + ln] = (u32x4){lo.x, lo.y, hi.x, hi.y}; }
            if (latent) {
                u32x4* Wg = (u32x4*)(p.ws + OFF_WYT) + ((size_t)((c - 4) * 8 + h) * 2 + dir) * 512;
                const int row = tid >> 3, ck = tid & 7; Wg[tid] = *(const u32x4*)(M + 6 * MSZ + row * MP + ck * 8);
            }
        }
        if (grp == 0) {
            f32x16 acc = mm32<true, true>(M + 7 * MSZ, xq, sVT, yq, zero16(), lane);
            store_acc(M + 12 * MSZ, xq, yq, acc, lane, [](float v, int, int) { return v; });
        } else {
            f32x16 acc = mm32<true, true>(M + 9 * MSZ, xq, sVT, yq, zero16(), lane);
            store_acc(M + 13 * MSZ, xq, yq, acc, lane, [](float v, int, int) { return v; });
        }
        __syncthreads();
        if (inst + nblk < NCH * 16) SCANA_ISSUE(inst + nblk);
        {
            u32x2* Qg = (u32x2*)(p.ws + OFF_Q) + ((size_t)chain * NCH + npos) * 1024;
#pragma unroll
            for (int i = 0; i < 2; ++i) {
                const int item = tid + NTH * i, ln = item & 63, wa = item >> 6, wi = wa >> 2, a = wa & 3, fr = ln & 15, fq = ln >> 4;
                Qg[item] = *(const u32x2*)(M + 12 * MSZ + (16 * wi + fr) * MP + 16 * a + 4 * fq);
            }
            if (latent) {
                u32x2* Yg = (u32x2*)(p.ws + OFF_YL) + ((size_t)((c - 4) * 8 + h) * 2 + dir) * 1024;
#pragma unroll
                for (int i = 0; i < 2; ++i) {
                    const int item = tid + NTH * i, ln = item & 63, wn = item >> 6, wt = wn >> 2, ni = wn & 3, fr = ln & 15, fq = ln >> 4;
                    const bf16_t* row = M + 13 * MSZ + (16 * ni + fr) * MP;
                    u32x2 v;
                    if (dir == 0) v = *(const u32x2*)(row + 16 * wt + 4 * fq);
                    else { const u32x2 r2 = *(const u32x2*)(row + 60 - 16 * wt - 4 * fq); v = (u32x2){rot16(r2.y), rot16(r2.x)}; }
                    Yg[item] = v;
                }
            }
        }
        __syncthreads();
    }
}

#undef SCANA_ISSUE
DI int grp_start(int g) { return g * 16 + (g < 4 ? g : 4); }
DI u32x4 packz(const f32x4& a, const f32x4& b) { return (u32x4){pack2(a[0], a[1]), pack2(a[2], a[3]), pack2(b[0], b[1]), pack2(b[2], b[3])}; }
template <int PASS> DI void chain_run(const Params& p, int chain, int g) {
    constexpr int CPF = PASS == 1 ? 2 : 3;
    const int lane = threadIdx.x & 63, w = threadIdx.x >> 6, fr = lane & 15, fq = lane >> 4;
    const int n0 = grp_start(g), n1 = grp_start(g + 1);
    const u32x4* Pg = (const u32x4*)(p.ws + OFF_P) + (size_t)chain * NCH * 512;
    const u32x2* Qg = (const u32x2*)(p.ws + OFF_Q) + (size_t)chain * NCH * 1024;
    u32x4* Zg = (u32x4*)(p.ws + OFF_Z) + (size_t)chain * NCH * 512;
    f32x4* ZG = (f32x4*)(p.ws + OFF_ZG) + ((size_t)(chain * 16 + g) * 4 + w) * 256;
    f32x4 acc[4], accp[4];
#pragma unroll
    for (int a = 0; a < 4; ++a) {
        if (PASS == 3) acc[a] = ZG[a * 64 + lane]; else acc[a] = (f32x4){0, 0, 0, 0};
#pragma unroll
        for (int e = 0; e < 4; ++e) accp[a][e] = (16 * a + 4 * fq + e == 16 * w + fr) ? 1.f : 0.f;
    }
    u32x4 pf[CPF][8]; u32x2 qf[CPF][4];
#pragma unroll
    for (int st = 0; st < CPF; ++st) if (n0 + st < n1) {
#pragma unroll
        for (int i = 0; i < 8; ++i) pf[st][i] = Pg[(size_t)(n0 + st) * 512 + i * 64 + lane];
#pragma unroll
        for (int a = 0; a < 4; ++a) qf[st][a] = Qg[(size_t)(n0 + st) * 1024 + (w * 4 + a) * 64 + lane];
    }
    for (int nb = n0; nb < n1; nb += CPF) {
#pragma unroll
        for (int st = 0; st < CPF; ++st) {
            const int n = nb + st;
            if (n < n1) {
                u32x4 pc[8]; u32x2 qc[4];
#pragma unroll
                for (int i = 0; i < 8; ++i) pc[i] = pf[st][i];
#pragma unroll
                for (int a = 0; a < 4; ++a) qc[a] = qf[st][a];
                if (n + CPF < n1) {
#pragma unroll
                    for (int i = 0; i < 8; ++i) pf[st][i] = Pg[(size_t)(n + CPF) * 512 + i * 64 + lane];
#pragma unroll
                    for (int a = 0; a < 4; ++a) qf[st][a] = Qg[(size_t)(n + CPF) * 1024 + (w * 4 + a) * 64 + lane];
                }
                const u32x4 z0 = packz(acc[0], acc[1]), z1 = packz(acc[2], acc[3]);
                if (PASS == 3) { Zg[((size_t)n * 4 + w) * 128 + lane] = z0; Zg[((size_t)n * 4 + w) * 128 + 64 + lane] = z1; }
                const bf16x8 zb0 = __builtin_bit_cast(bf16x8, z0), zb1 = __builtin_bit_cast(bf16x8, z1);
#pragma unroll
                for (int a = 0; a < 4; ++a) {
                    f32x4 ini = {bflo(qc[a].x), bfhi(qc[a].x), bflo(qc[a].y), bfhi(qc[a].y)};
                    ini = __builtin_amdgcn_mfma_f32_16x16x32_bf16(__builtin_bit_cast(bf16x8, pc[2 * a]), zb0, ini, 0, 0, 0);
                    acc[a] = __builtin_amdgcn_mfma_f32_16x16x32_bf16(__builtin_bit_cast(bf16x8, pc[2 * a + 1]), zb1, ini, 0, 0, 0);
                }
                if (PASS == 1) {
                    const bf16x8 yb0 = __builtin_bit_cast(bf16x8, packz(accp[0], accp[1])), yb1 = __builtin_bit_cast(bf16x8, packz(accp[2], accp[3]));
#pragma unroll
                    for (int a = 0; a < 4; ++a) {
                        f32x4 t4 = __builtin_amdgcn_mfma_f32_16x16x32_bf16(__builtin_bit_cast(bf16x8, pc[2 * a]), yb0, (f32x4){0, 0, 0, 0}, 0, 0, 0);
                        accp[a] = __builtin_amdgcn_mfma_f32_16x16x32_bf16(__builtin_bit_cast(bf16x8, pc[2 * a + 1]), yb1, t4, 0, 0, 0);
                    }
                }
            }
        }
    }
    if (PASS == 1) {
        f32x4* CQ = (f32x4*)(p.ws + OFF_CQ) + ((size_t)(chain * 16 + g) * 4 + w) * 256;
        bf16_t* CP = (bf16_t*)(p.ws + OFF_CP) + (size_t)(chain * 16 + g) * 4096;
#pragma unroll
        for (int a = 0; a < 4; ++a) {
            CQ[a * 64 + lane] = acc[a];
#pragma unroll
            for (int e = 0; e < 4; ++e) CP[(16 * a + 4 * fq + e) * 64 + 16 * w + fr] = (bf16_t)(pack2(accp[a][e], 0.f) & 0xffffu);
        }
    }
}
DI void chain_groups(const Params& p, int chain, char* lds) {
    const int tid = threadIdx.x, lane = tid & 63, w = tid >> 6, fr = lane & 15, fq = lane >> 4;
    {
        const char* src = (const char*)(p.ws + OFF_CP) + (size_t)chain * 16 * 8192;
#pragma unroll
        for (int i = 0; i < 16; ++i) glds16(src + (size_t)(i * NTH + tid) * 16, lds + (i * NTH + tid) * 16);
        asm volatile("s_waitcnt vmcnt(0)" ::: "memory");
        __syncthreads();
    }
    if (w >= 4) return;
    constexpr int QPF = 4;
    f32x4 acc[4], qf[QPF][4];
#pragma unroll
    for (int a = 0; a < 4; ++a) acc[a] = (f32x4){0, 0, 0, 0};
    const f32x4* CQ = (const f32x4*)(p.ws + OFF_CQ) + ((size_t)chain * 16 * 4 + w) * 256;
#pragma unroll
    for (int st = 0; st < QPF; ++st)
#pragma unroll
        for (int a = 0; a < 4; ++a) qf[st][a] = CQ[(size_t)st * 1024 + a * 64 + lane];
    for (int gb = 0; gb < 16; gb += QPF) {
#pragma unroll
        for (int st = 0; st < QPF; ++st) {
            const int g = gb + st;
            f32x4 qc[4];
#pragma unroll
            for (int a = 0; a < 4; ++a) qc[a] = qf[st][a];
            if (g + QPF < 16) {
#pragma unroll
                for (int a = 0; a < 4; ++a) qf[st][a] = CQ[(size_t)(g + QPF) * 1024 + a * 64 + lane];
            }
            f32x4* ZG = (f32x4*)(p.ws + OFF_ZG) + ((size_t)(chain * 16 + g) * 4 + w) * 256;
#pragma unroll
            for (int a = 0; a < 4; ++a) ZG[a * 64 + lane] = acc[a];
            const bf16x8 zb0 = __builtin_bit_cast(bf16x8, packz(acc[0], acc[1])), zb1 = __builtin_bit_cast(bf16x8, packz(acc[2], acc[3]));
            const bf16_t* CP = (const bf16_t*)lds + g * 4096;
#pragma unroll
            for (int a = 0; a < 4; ++a) {
                const bf16_t* s0 = CP + (16 * a + fr) * 64 + 4 * fq;
                const u32x2 l0 = *(const u32x2*)s0, h0 = *(const u32x2*)(s0 + 16), l1 = *(const u32x2*)(s0 + 32), h1 = *(const u32x2*)(s0 + 48);
                f32x4 ini = __builtin_amdgcn_mfma_f32_16x16x32_bf16(__builtin_bit_cast(bf16x8, (u32x4){l0.x, l0.y, h0.x, h0.y}), zb0, qc[a], 0, 0, 0);
                acc[a] = __builtin_amdgcn_mfma_f32_16x16x32_bf16(__builtin_bit_cast(bf16x8, (u32x4){l1.x, l1.y, h1.x, h1.y}), zb1, ini, 0, 0, 0);
            }
        }
    }
}

DI void phase_scanC(const Params& p, int bid, int nblk, char* lds) {
    const int lane = threadIdx.x & 63, w8 = threadIdx.x >> 6, w = w8 & 3, fr = lane & 15, fq = lane >> 4;
    bf16_t* mix = (bf16_t*)(p.ws + OFF_MIX);
    const float* dot = (const float*)(p.ws + OFF_DOT);
    for (int unit = bid * 2 + (w8 >> 2); unit < 256 * 8; unit += nblk * 2) {
        const int c = 4 + (unit >> 3), h = unit & 7;
        f32x4 y[4];
#pragma unroll
        for (int ni = 0; ni < 4; ++ni) y[ni] = (f32x4){0, 0, 0, 0};
#pragma unroll
        for (int dir = 0; dir < 2; ++dir) {
            const int chain = dir * 8 + h, npos = chain_pos(c, dir);
            const u32x4* Zg = (const u32x4*)(p.ws + OFF_Z) + ((size_t)chain * NCH + npos) * 512;
            const bf16_t* Wg = (const bf16_t*)(p.ws + OFF_WYT) + ((size_t)((c - 4) * 8 + h) * 2 + dir) * 4096;
            const u32x2* Yg = (const u32x2*)(p.ws + OFF_YL) + ((size_t)((c - 4) * 8 + h) * 2 + dir) * 1024;
            const int rho = 16 * w + fr, row = dir ? 63 - rho : rho;
            bf16x8 af[2];
#pragma unroll
            for (int s2 = 0; s2 < 2; ++s2) {
                const u32x2 lo = *(const u32x2*)(Wg + row * 64 + 32 * s2 + 4 * fq), hi = *(const u32x2*)(Wg + row * 64 + 32 * s2 + 16 + 4 * fq);
                af[s2] = __builtin_bit_cast(bf16x8, (u32x4){lo.x, lo.y, hi.x, hi.y});
            }
#pragma unroll
            for (int ni = 0; ni < 4; ++ni) {
                const u32x2 yl = Yg[(w * 4 + ni) * 64 + lane];
                f32x4 acc = {bflo(yl.x), bfhi(yl.x), bflo(yl.y), bfhi(yl.y)};
                acc = __builtin_amdgcn_mfma_f32_16x16x32_bf16(af[0], __builtin_bit_cast(bf16x8, Zg[(ni * 2 + 0) * 64 + lane]), acc, 0, 0, 0);
                acc = __builtin_amdgcn_mfma_f32_16x16x32_bf16(af[1], __builtin_bit_cast(bf16x8, Zg[(ni * 2 + 1) * 64 + lane]), acc, 0, 0, 0);
                y[ni] += acc;
            }
        }
        float* ty = (float*)lds + w8 * (16 * 68);
#pragma unroll
        for (int ni = 0; ni < 4; ++ni)
#pragma unroll
            for (int e = 0; e < 4; ++e) ty[(4 * fq + e) * 68 + 16 * ni + fr] = y[ni][e];
        asm volatile("s_waitcnt lgkmcnt(0)" ::: "memory"); __builtin_amdgcn_wave_barrier();
        {
            const int tl = lane >> 2, seg = lane & 3, t = (c - 4) * 64 + 16 * w + tl, g = t + CTX, cch = h * 64 + 16 * seg;
            float yv[16];
#pragma unroll
            for (int q = 0; q < 4; ++q) { const f32x4 v4 = *(const f32x4*)(ty + tl * 68 + 16 * seg + 4 * q); yv[4 * q] = v4[0]; yv[4 * q + 1] = v4[1]; yv[4 * q + 2] = v4[2]; yv[4 * q + 3] = v4[3]; }
            float sm = 0.f;
#pragma unroll
            for (int j = 0; j < 16; ++j) sm += yv[j];
            sm += __shfl_xor(sm, 1, 64); sm += __shfl_xor(sm, 2, 64);
            const float mean = sm * (1.f / 64.f);
            float q2 = 0.f;
#pragma unroll
            for (int j = 0; j < 16; ++j) { const float d = yv[j] - mean; q2 += d * d; }
            q2 += __shfl_xor(q2, 1, 64); q2 += __shfl_xor(q2, 2, 64);
            const float rs = rsqrtf(q2 * (1.f / 64.f) + 64e-5f);
            const float bon = dot[((size_t)g * 8 + h) * 2] + dot[((size_t)g * 8 + h) * 2 + 1];
            float vv[16], gg[16], o[16];
            unpack8(*(const u32x4*)((const bf16_t*)(p.ws + OFF_V) + (size_t)t * DR + cch), vv); unpack8(*(const u32x4*)((const bf16_t*)(p.ws + OFF_V) + (size_t)t * DR + cch + 8), vv + 8);
            unpack8(*(const u32x4*)((const bf16_t*)(p.ws + OFF_G) + (size_t)t * DR + cch), gg); unpack8(*(const u32x4*)((const bf16_t*)(p.ws + OFF_G) + (size_t)t * DR + cch + 8), gg + 8);
#pragma unroll
            for (int q = 0; q < 4; ++q) {
                const f32x4 gw = *(const f32x4*)(p.gn_w + cch + 4 * q), gb = *(const f32x4*)(p.gn_b + cch + 4 * q);
#pragma unroll
                for (int j = 0; j < 4; ++j) o[4 * q + j] = ((yv[4 * q + j] - mean) * rs * gw[j] + gb[j] + bon * vv[4 * q + j]) * gg[4 * q + j];
            }
            *(u32x4*)(mix + (size_t)t * D + cch) = pack8(o); *(u32x4*)(mix + (size_t)t * D + cch + 8) = pack8(o + 8);
        }
        __builtin_amdgcn_wave_barrier();
    }
}

struct EpiX2 { float* o; const float* x; const float* gt; const float* rowtab; const float* coltab; int row0, col0;
    DI f32x16 pre(const f32x16& a, const f32x16&) const { return a; }
    DI void post(int r, int c, const f32x4& v) const {
        const int t = row0 + r, d = col0 + c;
        const float* pt = d < 512 ? rowtab + (t >> 6) * 512 + d : coltab + (t & 63) * 512 + (d - 512);
        const f32x4 xv = *(const f32x4*)(x + (size_t)t * D + d), pv = *(const f32x4*)pt, gv = *(const f32x4*)(gt + d);
        *(f32x4*)(o + (size_t)t * D + d) = xv + pv + gv * v; } };
struct EpiNull { DI f32x16 pre(const f32x16& a, const f32x16&) const { return a; } DI void post(int, int, const f32x4& v) const { asm volatile("" :: "v"(v)); } };
DI void phase_g2_null(const Params& p, int bid, int nblk, char* lds) {
    const bf16_t* mix = (const bf16_t*)(p.ws + OFF_MIX);
    const XcdOrder ord(bid, nblk, 64 * 4);
    for (int i = 0, q; (q = ord.item(i)) >= 0; ++i) {
        int tm, tn; tile_rc(q, 64, 4, tm, tn);
        PlainA al{mix + (size_t)tm * 256 * D, D};
        EpiNull e;
        gemm8<1, true, 2>(al, (const bf16_t*)(p.ws + OFF_WOUTB) + tn * 256, nullptr, D, D, lds, e);
    }
}
DI void phase_g2(const Params& p, int bid, int nblk, char* lds) {
    const bf16_t* mix = (const bf16_t*)(p.ws + OFF_MIX);
    const XcdOrder ord(bid, nblk, 64 * 4);
    for (int i = 0, q; (q = ord.item(i)) >= 0; ++i) {
        int tm, tn; tile_rc(q, 64, 4, tm, tn);
        PlainA al{mix + (size_t)tm * 256 * D, D};
        EpiX2 e{(float*)(p.ws + OFF_X2), p.x, (const float*)(p.ws + OFF_MODX) + 2048, (const float*)(p.ws + OFF_ROWTAB), (const float*)(p.ws + OFF_COLTAB), tm * 256, tn * 256};
        gemm8<1, true, 2>(al, (const bf16_t*)(p.ws + OFF_WOUTB) + tn * 256, nullptr, D, D, lds, e);
    }
}

DI float router_w(const Params& p, int k, int n) { return n < 4 ? p.w_rg[k * 4 + n] : (n < 36 ? p.w_re[k * 32 + (n - 4)] : 0.f); }
DI void phase_router_prep(const Params& p, int bid, int nblk) {
    const float* modx = (const float*)(p.ws + OFF_MODX);
    float* wp = (float*)(p.ws + OFF_WP); float* b2 = (float*)(p.ws + OFF_B2);
    for (int idx = bid * NTH + threadIdx.x; idx < 64 * 4 * 3 * 64; idx += nblk * NTH) {
        const int ln = idx & 63, r = idx >> 6, nt = r % 3, me = r / 3, e = me & 3, m = me >> 2;
        const int k = 16 * m + 4 * (ln >> 4) + e, n = 16 * nt + (ln & 15);
        wp[idx] = p.norm2_g[k] * (1.f + modx[4096 + k]) * router_w(p, k, n);
    }
    const int lane = threadIdx.x & 63, wv = bid * NWV + (threadIdx.x >> 6);
    if (wv < 36) {
        float sacc = 0.f;
        for (int k = lane; k < D; k += 64) sacc += modx[3072 + k] * router_w(p, k, wv);
        sacc = wave_sum(sacc);
        if (lane == 0) b2[wv] = sacc + (wv < 4 ? p.b_rg[wv] : p.b_re[wv - 4]);
    }
}

DI void phase_router(const Params& p, int bid, int nblk, char* lds, bool dry = false) {
    const int lane = threadIdx.x & 63, wid = threadIdx.x >> 6, tr = lane & 15, kq = lane >> 4;
    const float* x2 = (const float*)(p.ws + OFF_X2); const float* modx = (const float*)(p.ws + OFF_MODX);
    const float* wp = (const float*)(p.ws + OFF_WP); const float* b2 = (const float*)(p.ws + OFF_B2);
    bf16_t* h2 = (bf16_t*)(p.ws + OFF_H2); int* cnt = (int*)(p.ws + OFF_CNT); float* gate = (float*)(p.ws + OFF_GATE); int* list = (int*)(p.ws + OFF_LIST);
    float* slog = (float*)lds + wid * (16 * 49);
    for (int task = wid * nblk + bid; task < S / 16; task += nblk * NWV) {
        const int t0 = task * 16;
        const float* xr = x2 + (size_t)(t0 + tr) * D + 4 * kq;
        f32x4 acc[3];
#pragma unroll
        for (int i = 0; i < 3; ++i) acc[i] = (f32x4){0, 0, 0, 0};
        float ss = 0.f;
#pragma unroll 4
        for (int m = 0; m < 64; ++m) {
            const f32x4 xv = *(const f32x4*)(xr + 16 * m);
            ss += xv[0] * xv[0] + xv[1] * xv[1] + xv[2] * xv[2] + xv[3] * xv[3];
#pragma unroll
            for (int e = 0; e < 4; ++e)
#pragma unroll
                for (int nt = 0; nt < 3; ++nt) acc[nt] = __builtin_amdgcn_mfma_f32_16x16x4f32(xv[e], wp[((m * 4 + e) * 3 + nt) * 64 + lane], acc[nt], 0, 0, 0);
        }
        ss += __shfl_xor(ss, 16, 64); ss += __shfl_xor(ss, 32, 64);
        const float rstd = rsqrtf(ss * (1.f / 1024.f) + 1e-6f);
#pragma unroll
        for (int nt = 0; nt < 3; ++nt)
#pragma unroll
            for (int r = 0; r < 4; ++r) slog[(4 * kq + r) * 49 + 16 * nt + tr] = acc[nt][r];
        asm volatile("s_waitcnt lgkmcnt(0)" ::: "memory"); __builtin_amdgcn_wave_barrier();
        if (lane < 16) {
            const int t = t0 + lane;
            const float* lg = slog + lane * 49;
            const float l0 = rstd * lg[0] + b2[0], l1 = rstd * lg[1] + b2[1], l2 = rstd * lg[2] + b2[2], l3 = rstd * lg[3] + b2[3];
            int grp = 0; float mx = l0;
            if (l1 > mx) { mx = l1; grp = 1; }
            if (l2 > mx) { mx = l2; grp = 2; }
            if (l3 > mx) { mx = l3; grp = 3; }
            const float den = __expf(l0 - mx) + __expf(l1 - mx) + __expf(l2 - mx) + __expf(l3 - mx);
            const float pgrp = 1.f / den;
            int i1 = 0, i2 = -1; float v1 = -3.0e38f, v2 = -3.0e38f;
            for (int n = 0; n < 8; ++n) {
                const float sv = rstd * lg[4 + grp * 8 + n] + b2[4 + grp * 8 + n];
                if (sv > v1) { v2 = v1; i2 = i1; v1 = sv; i1 = n; } else if (sv > v2) { v2 = sv; i2 = n; }
            }
            const float e2 = __expf(v2 - v1), g1 = pgrp / (1.f + e2), g2v = pgrp * e2 / (1.f + e2);
            const int ea = grp * 8 + i1, eb = grp * 8 + i2;
            if (!dry) {
                const int pa = atomicAdd(&cnt[ea], 1), pb = atomicAdd(&cnt[eb], 1);
                list[ea * LCAP + pa] = t * 2; list[eb * LCAP + pb] = t * 2 + 1;
            }
            gate[t * 2] = g1; gate[t * 2 + 1] = g2v;
        }
        for (int r = 0; r < 16; ++r) {
            const float rs = __shfl(rstd, r, 64);
            const float* src = x2 + (size_t)(t0 + r) * D;
#pragma unroll
            for (int i = 0; i < 4; ++i) {
                const int d = (i * 64 + lane) * 4;
                const f32x4 v = *(const f32x4*)(src + d), gg = *(const f32x4*)(p.norm2_g + d), sh = *(const f32x4*)(modx + 3072 + d), sc = *(const f32x4*)(modx + 4096 + d);
                f32x4 hv;
#pragma unroll
                for (int j = 0; j < 4; ++j) hv[j] = (v[j] * rs * gg[j]) * (1.f + sc[j]) + sh[j];
                u32x2 pk = {pack2(hv[0], hv[1]), pack2(hv[2], hv[3])};
                *(u32x2*)(h2 + (size_t)(t0 + r) * D + d) = pk;
            }
        }
        __builtin_amdgcn_wave_barrier();
    }
}

DI void moe_tiles(const int* cnt, int* tstart  ) {
    if (threadIdx.x == 0) { int acc = 0; for (int e = 0; e < NE; ++e) { tstart[e] = acc; acc += (cnt[e] + 255) >> 8; } tstart[NE] = acc; }
    __syncthreads();
}
struct EpiHid { bf16_t* o;
    DI f32x16 pre(const f32x16& g, const f32x16& u) const { f32x16 h;
#pragma unroll
        for (int j = 0; j < 16; ++j) h[j] = g[j] * sigmoidf_(g[j]) * u[j];
        return h; }
    DI void post(int r, int c, const f32x4& v) const { u32x2 pk = {pack2(v[0], v[1]), pack2(v[2], v[3])}; *(u32x2*)(o + (size_t)r * DE + c) = pk; } };
DI void phase_g3(const Params& p, int bid, int nblk, char* lds) {
    int* tstart = (int*)(lds + GEMM_LDS);
    const int* cnt = (const int*)(p.ws + OFF_CNT); const int* list = (const int*)(p.ws + OFF_LIST);
    const bf16_t* h2 = (const bf16_t*)(p.ws + OFF_H2); bf16_t* hid = (bf16_t*)(p.ws + OFF_HID);
    moe_tiles(cnt, tstart);
    const int ntiles = tstart[NE];
    const int nitems = ntiles * 4, nfull = (nitems / nblk) * nblk, nhalf = 2 * (nitems - nfull);
    const XcdOrder ord(bid, nblk, nfull);
    for (int i = 0, item; (item = ord.item(i)) >= 0; ++i) {
        const int ti = item >> 2, cj = item & 3;
        int e = 0; while (e < NE - 1 && tstart[e + 1] <= ti) ++e;
        const int lt = ti - tstart[e], ne = cnt[e];
        GatherA al;
#pragma unroll
        for (int i2 = 0; i2 < 4; ++i2) { const int row = (8 * i2 + (threadIdx.x >> 6)) * 8 + ((threadIdx.x & 63) >> 3), pos = lt * 256 + row; const int tok = pos < ne ? (list[e * LCAP + pos] >> 1) : 0; al.rp[i2] = h2 + (size_t)tok * D; }
        EpiHid epi{hid + (size_t)ti * 256 * DE + cj * 128};
        gemm8<2, false, 1>(al, p.w_gate + (size_t)e * D * DE + cj * 128, p.w_up + (size_t)e * D * DE + cj * 128, DE, D, lds, epi);
    }
    for (int n = bid; n < nhalf; n += nblk) {
        const int item = nfull + (n >> 1), hf = n & 1, ti = item >> 2, cj = item & 3;
        int e = 0; while (e < NE - 1 && tstart[e + 1] <= ti) ++e;
        const int lt = ti - tstart[e], ne = cnt[e];
        GatherA al;
#pragma unroll
        for (int i2 = 0; i2 < 2; ++i2) { const int row = hf * 128 + (8 * i2 + (threadIdx.x >> 6)) * 8 + ((threadIdx.x & 63) >> 3), pos = lt * 256 + row; const int tok = pos < ne ? (list[e * LCAP + pos] >> 1) : 0; al.rp[i2] = h2 + (size_t)tok * D; }
        al.rp[2] = al.rp[0]; al.rp[3] = al.rp[1];
        EpiHid epi{hid + ((size_t)ti * 256 + hf * 128) * DE + cj * 128};
        gemm8<2, false, 1, GatherA, EpiHid, 2>(al, p.w_gate + (size_t)e * D * DE + cj * 128, p.w_up + (size_t)e * D * DE + cj * 128, DE, D, lds, epi);
    }
}
struct EpiDown { bf16_t* ybuf; const int* lst; const float* gate; int nvalid; int col0;
    DI f32x16 pre(const f32x16& a, const f32x16&) const { return a; }
    DI void post(int r, int c, const f32x4& v) const {
        if (r >= nvalid) return; const int slot = lst[r]; const float g = gate[slot];
        u32x2 pk = {pack2(v[0] * g, v[1] * g), pack2(v[2] * g, v[3] * g)}; *(u32x2*)(ybuf + (size_t)slot * D + col0 + c) = pk; } };
DI void phase_g4(const Params& p, int bid, int nblk, char* lds) {
    int* tstart = (int*)(lds + GEMM_LDS);
    const int* cnt = (const int*)(p.ws + OFF_CNT); const int* list = (const int*)(p.ws + OFF_LIST);
    const bf16_t* hid = (const bf16_t*)(p.ws + OFF_HID);
    moe_tiles(cnt, tstart);
    const int ntiles = tstart[NE];
    const XcdOrder ord(bid, nblk, ntiles * 8);
    for (int i = 0, item; (item = ord.item(i)) >= 0; ++i) {
        const int ti = item >> 3, cj = item & 7;
        int e = 0; while (e < NE - 1 && tstart[e + 1] <= ti) ++e;
        const int lt = ti - tstart[e], ne = cnt[e];
        PlainA al{hid + (size_t)ti * 256 * DE, DE};
        EpiDown epi{(bf16_t*)(p.ws + OFF_YBUF), list + e * LCAP + lt * 256, (const float*)(p.ws + OFF_GATE), ne - lt * 256, cj * 128};
        gemm8<1, false, 1>(al, p.w_down + (size_t)e * DE * D + cj * 128, nullptr, D, DE, lds, epi);
    }
}

DI void phase_final(const Params& p, int bid, int nblk) {
    const int lane = threadIdx.x & 63, wid = threadIdx.x >> 6;
    const float* x2 = (const float*)(p.ws + OFF_X2); const float* gt = (const float*)(p.ws + OFF_MODX) + 5120; const bf16_t* yb = (const bf16_t*)(p.ws + OFF_YBUF);
    for (int tp = bid * NWV + wid; tp < S / 2; tp += nblk * NWV) {
        f32x4 v[2][4]; float ss[2] = {0.f, 0.f};
        u32x2 ya[2][4], ybv[2][4];
#pragma unroll
        for (int r = 0; r < 2; ++r)
#pragma unroll
            for (int i = 0; i < 4; ++i) {
                const int t = 2 * tp + r, d = (i * 64 + lane) * 4;
                v[r][i] = *(const f32x4*)(x2 + (size_t)t * D + d);
                ya[r][i] = *(const u32x2*)(yb + (size_t)(2 * t) * D + d); ybv[r][i] = *(const u32x2*)(yb + (size_t)(2 * t + 1) * D + d);
            }
#pragma unroll
        for (int r = 0; r < 2; ++r)
#pragma unroll
            for (int i = 0; i < 4; ++i) {
                const int d = (i * 64 + lane) * 4; const f32x4 g = *(const f32x4*)(gt + d); const u32x2 a = ya[r][i], b = ybv[r][i];
                v[r][i][0] += g[0] * (bflo(a.x) + bflo(b.x)); v[r][i][1] += g[1] * (bfhi(a.x) + bfhi(b.x));
                v[r][i][2] += g[2] * (bflo(a.y) + bflo(b.y)); v[r][i][3] += g[3] * (bfhi(a.y) + bfhi(b.y));
                ss[r] += v[r][i][0] * v[r][i][0] + v[r][i][1] * v[r][i][1] + v[r][i][2] * v[r][i][2] + v[r][i][3] * v[r][i][3];
            }
#pragma unroll
        for (int r = 0; r < 2; ++r) {
            const float rstd = rsqrtf(wave_sum(ss[r]) * (1.f / 1024.f) + 1e-6f);
#pragma unroll
            for (int i = 0; i < 4; ++i) {
                const int d = (i * 64 + lane) * 4; const f32x4 fg = *(const f32x4*)(p.final_g + d); f32x4 o;
#pragma unroll
                for (int j = 0; j < 4; ++j) o[j] = v[r][i][j] * rstd * fg[j];
                *(f32x4*)(p.out + (size_t)(2 * tp + r) * D + d) = o;
            }
        }
    }
}

#define XB_TMO      128
#define XB_XCNT(j)  (256  + 64 * (j))
#define XB_XSUB(j)  (1280 + 64 * (j))
#define XB_XGEN(j)  (2304 + 64 * (j))
#define XB_TOP      3328
#define XB_TOPGEN   3392
#define XCD_BAR_WORDS 3456
#define XB_SPIN_CAP (1u << 18)
DI unsigned xb_ld(unsigned* p) { return __hip_atomic_load(p, __ATOMIC_RELAXED, __HIP_MEMORY_SCOPE_AGENT); }
DI unsigned xb_add(unsigned* p, unsigned v) { return __hip_atomic_fetch_add(p, v, __ATOMIC_RELAXED, __HIP_MEMORY_SCOPE_AGENT); }
DI unsigned xb_xcc_id() { return (unsigned)__builtin_amdgcn_s_getreg((3 << 11) | 20) & 0xFu; }
#define XB_SPIN(cond, bar) do { unsigned _sp = 0; while (cond) { __builtin_amdgcn_s_sleep(1); \
    if ((++_sp & 255u) == 0u) { if (xb_ld(&(bar)[XB_TMO])) break; if (_sp > XB_SPIN_CAP) { atomicAdd(&(bar)[XB_TMO], 1u); break; } } } } while (0)
struct XcdBarrier { unsigned* bar; unsigned x; volatile LAS unsigned* st; };
DI XcdBarrier xcd_barrier_post(unsigned* bar, volatile LAS unsigned* st) {
    XcdBarrier b; b.bar = bar; b.x = xb_xcc_id(); b.st = st;
    if (threadIdx.x == 0) (void)xb_add(&bar[XB_XCNT(b.x)], 1u);
    return b;
}
DI void xcd_barrier_complete(unsigned* bar, unsigned x, unsigned& nloc, unsigned& nx) {
    const unsigned G = gridDim.x * gridDim.y * gridDim.z;
    unsigned sum, cnt, mine, sp = 0u;
    for (;;) {
        sum = 0u; cnt = 0u; mine = 0u;
#pragma unroll
        for (unsigned j = 0; j < 16; ++j) { const unsigned c = xb_ld(&bar[XB_XCNT(j)]); sum += c; cnt += (c > 0u) ? 1u : 0u; mine = (j == x) ? c : mine; }
        if (sum == G) break;
        __builtin_amdgcn_s_sleep(1);
        if ((++sp & 255u) == 0u) { if (xb_ld(&bar[XB_TMO])) break; if (sp > XB_SPIN_CAP) { atomicAdd(&bar[XB_TMO], 1u); break; } }
    }
    nloc = mine > 0u ? mine : 1u; nx = cnt > 0u ? cnt : 1u;
}
DI void xcd_barrier(const XcdBarrier& b) {
    asm volatile("s_waitcnt vmcnt(0)" ::: "memory");
    __syncthreads();
    if (threadIdx.x == 0) {
        unsigned* bar = b.bar;
        __builtin_amdgcn_s_waitcnt(0);
        unsigned nloc = b.st[0], nx = b.st[1];
        if (nloc == 0u) { xcd_barrier_complete(bar, b.x, nloc, nx); b.st[0] = nloc; b.st[1] = nx; }
        const unsigned old = xb_add(&bar[XB_XSUB(b.x)], 1u);
        const unsigned gen = old / nloc;
        if (old + 1u == (gen + 1u) * nloc) {
            __builtin_amdgcn_fence(__ATOMIC_RELEASE, "agent");
            asm volatile("s_waitcnt vmcnt(0)" ::: "memory");
            const unsigned og = xb_add(&bar[XB_TOP], 1u);
            const unsigned tg = og / nx;
            if (og + 1u == (tg + 1u) * nx) xb_add(&bar[XB_TOPGEN], 1u);
            else XB_SPIN(xb_ld(&bar[XB_TOPGEN]) == tg, bar);
            __builtin_amdgcn_fence(__ATOMIC_ACQUIRE, "agent");
            xb_add(&bar[XB_XGEN(b.x)], 1u);
            asm volatile("s_waitcnt vmcnt(0)" ::: "memory");
        } else {
            XB_SPIN(xb_ld(&bar[XB_XGEN(b.x)]) == gen, bar);
            __builtin_amdgcn_fence(__ATOMIC_ACQUIRE, "agent");
            asm volatile("s_waitcnt vmcnt(0)" ::: "memory");
        }
    }
    __syncthreads();
}

#ifndef PROBE
#define PROBE 0
#endif
constexpr int MEGA_LDS = SCANA_LDS > (GEMM_LDS + 256) ? SCANA_LDS : (GEMM_LDS + 256);
__global__ void __launch_bounds__(NTH) k_mega(Params p) {
    extern __shared__ __attribute__((aligned(16))) char lds[];
    const int bid = blockIdx.x, nblk = gridDim.x;
    volatile LAS unsigned* st = (volatile LAS unsigned*)(lds + MEGA_LDS);
    if (threadIdx.x < 4) st[threadIdx.x] = 0u;
    __syncthreads();
    const XcdBarrier gb = xcd_barrier_post((unsigned*)(p.ws + OFF_BAR), st);
#define GSYNC() xcd_barrier(gb)
    phase_p0(p, bid, nblk, lds); GSYNC();
    if (PROBE == 1) { phase_p0(p, bid, nblk, lds); GSYNC(); }
    phase_xn(p, bid, nblk); phase_router_prep(p, bid, nblk); GSYNC();
    if (PROBE == 2) { phase_xn(p, bid, nblk); GSYNC(); }
    phase_g1(p, bid, nblk, lds); GSYNC();
    if (PROBE == 3) { phase_g1(p, bid, nblk, lds); GSYNC(); }
    phase_pool(p, bid, nblk);
    phase_scanA(p, bid, nblk, lds); GSYNC();
    if (PROBE == 4) { phase_scanA(p, bid, nblk, lds); GSYNC(); }
    if (PROBE == 15) { phase_pool(p, bid, nblk); GSYNC(); }
    if (PROBE == 16) { GSYNC(); GSYNC(); GSYNC(); GSYNC(); }
    if (threadIdx.x < 256) for (int it = bid; it < 256; it += nblk) chain_run<1>(p, it >> 4, it & 15);
    GSYNC();
    if (PROBE == 5) { if (threadIdx.x < 256) for (int it = bid; it < 256; it += nblk) chain_run<1>(p, it >> 4, it & 15); GSYNC(); }
    if (bid < 16) chain_groups(p, bid, lds); else phase_poolgemm(p, bid - 16, nblk - 16, lds);
    GSYNC();
    if (PROBE == 6) { if (bid < 16) chain_groups(p, bid, lds); GSYNC(); }
    if (threadIdx.x < 256) for (int it = bid; it < 256; it += nblk) chain_run<3>(p, it >> 4, it & 15);
    GSYNC();
    if (PROBE == 7) { if (threadIdx.x < 256) for (int it = bid; it < 256; it += nblk) chain_run<3>(p, it >> 4, it & 15); GSYNC(); }
    phase_scanC(p, bid, nblk, lds); GSYNC();
    if (PROBE == 8) { phase_scanC(p, bid, nblk, lds); GSYNC(); }
    phase_g2(p, bid, nblk, lds); GSYNC();
    if (PROBE == 9) { phase_g2(p, bid, nblk, lds); GSYNC(); }
    if (PROBE == 14) { phase_g2_null(p, bid, nblk, lds); GSYNC(); }
    if (PROBE == 10) { phase_router(p, bid, nblk, lds, true); GSYNC(); }
    phase_router(p, bid, nblk, lds); GSYNC();
    phase_g3(p, bid, nblk, lds); GSYNC();
    if (PROBE == 11) { phase_g3(p, bid, nblk, lds); GSYNC(); }
    phase_g4(p, bid, nblk, lds); GSYNC();
    if (PROBE == 12) { phase_g4(p, bid, nblk, lds); GSYNC(); }
    if (PROBE == 13) { phase_final(p, bid, nblk); GSYNC(); }
    phase_final(p, bid, nblk);
}

extern "C" void kernel_launch(void* const* d_in, const int* in_sizes, int n_in, void* d_out, int out_size, void* d_ws, size_t ws_size, hipStream_t stream) {
    if (ws_size < WS_NEED) { fprintf(stderr, "workspace too small: %zu < %zu\n", ws_size, (size_t)WS_NEED); return; }
    Params p{};
    const float** f = (const float**)&p;
    for (int i = 0; i < 36; ++i) f[i] = (const float*)d_in[i];
    p.out = (float*)d_out; p.ws = (char*)d_ws;
    static int grid_blocks = 0;
    if (!grid_blocks) {
        (void)hipFuncSetAttribute((const void*)k_mega, hipFuncAttributeMaxDynamicSharedMemorySize, MEGA_LDS + 16);
        int dev = 0, cus = 0, per_cu = 0;
        (void)hipGetDevice(&dev);
        (void)hipDeviceGetAttribute(&cus, hipDeviceAttributeMultiprocessorCount, dev);
        (void)hipOccupancyMaxActiveBlocksPerMultiprocessor(&per_cu, k_mega, NTH, MEGA_LDS + 16);
        if (per_cu > 1) per_cu = 1;
        grid_blocks = cus * per_cu;
    }
    (void)hipMemsetAsync((char*)d_ws + OFF_BAR, 0, 16384, stream);
    void* args[] = {&p};
    hipError_t e = hipLaunchCooperativeKernel((const void*)k_mega, dim3(grid_blocks), dim3(NTH), args, MEGA_LDS + 16, stream);
    if (e != hipSuccess) fprintf(stderr, "cooperative launch failed: %s (grid %d)\n", hipGetErrorString(e), grid_blocks);
}
```

```cpp
#include <hip/hip_runtime.h>
#include <stdint.h>
#include <stdio.h>
#include <hip/hip_cooperative_groups.h>
namespace cg = cooperative_groups;

#define DI __device__ __forceinline__
typedef unsigned short bf16_t;
typedef short bf16x8 __attribute__((ext_vector_type(8)));
typedef short s16x4 __attribute__((ext_vector_type(4)));
typedef float f32x4 __attribute__((ext_vector_type(4)));
typedef float f32x2 __attribute__((ext_vector_type(2)));
typedef __bf16 bf16x2_t __attribute__((ext_vector_type(2)));
typedef unsigned u32x4 __attribute__((ext_vector_type(4)));
typedef unsigned u32x2 __attribute__((ext_vector_type(2)));
#define LAS __attribute__((address_space(3)))

constexpr int D = 1024, S = 16384, CTX = 256, NT = S + CTX, DIN = 2432, DSH = 1920, DR = 512;
constexpr int C_WLF = 1536, C_WLB = 1600, C_ALF = 1664, C_ALB = 1728, C_GL = 1792, C_POOL = 1920;
constexpr int NE = 32, DE = 512, LCAP = 32768;
constexpr float DECAY_SCALE = 0.6065306597f;
constexpr int NTH = 512, NWV = 8;

constexpr int NCH = NT / 64;
constexpr size_t SZ_U = (size_t)NT * DIN * 2;
constexpr size_t SZ_CH = (size_t)16 * NCH * 8192;
constexpr size_t OFF_U = 0;
constexpr size_t OFF_XN = OFF_U + SZ_U;
constexpr size_t OFF_P = OFF_XN;
constexpr size_t OFF_Q = OFF_P + SZ_CH;
constexpr size_t OFF_WYT = OFF_Q + SZ_CH;
constexpr size_t OFF_YL = OFF_WYT + (size_t)256 * 16 * 8192;
constexpr size_t OFF_V = OFF_YL + (size_t)256 * 16 * 8192;
constexpr size_t OFF_G = OFF_V + (size_t)S * DR * 2;
constexpr size_t OFF_MIX = OFF_G + (size_t)S * DR * 2;
constexpr size_t OFF_SMALL = OFF_MIX + (size_t)S * D * 2;
constexpr size_t OFF_MODX = OFF_SMALL, OFF_MODC = OFF_MODX + 6144 * 4;
constexpr size_t OFF_ROWTAB = OFF_MODC + 6144 * 4, OFF_COLTAB = OFF_ROWTAB + 256 * 512 * 4;
constexpr size_t OFF_CNT = OFF_COLTAB + 64 * 512 * 4;
constexpr size_t OFF_GATE = OFF_CNT + 256;
constexpr size_t OFF_LIST = OFF_GATE + (size_t)S * 2 * 4;
constexpr size_t OFF_DOT = OFF_LIST + (size_t)NE * LCAP * 4;
constexpr size_t OFF_WP = OFF_DOT + (size_t)NT * 16 * 4;
constexpr size_t OFF_B2 = OFF_WP + 64 * 4 * 3 * 64 * 4;
constexpr size_t OFF_BAR = OFF_B2 + 256;
constexpr size_t OFF_WINB = OFF_BAR + 16384;
constexpr size_t OFF_WOUTB = OFF_WINB + (size_t)D * DIN * 2;
constexpr size_t WS_NEED = OFF_WOUTB + (size_t)D * D * 2;
constexpr size_t OFF_Z = OFF_U;
constexpr size_t OFF_X2 = OFF_P;
constexpr size_t OFF_YBUF = OFF_WYT;
constexpr size_t OFF_H2 = OFF_U;
constexpr size_t OFF_HID = OFF_U + SZ_CH;
constexpr size_t OFF_CP = OFF_U + SZ_CH;
constexpr size_t OFF_CQ = OFF_CP + 256 * 8192;
constexpr size_t OFF_ZG = OFF_CQ + 256 * 16384;

struct Params {
    const float *x, *c, *ctx, *c_ctx, *norm1_g, *w_mod, *b_mod, *w_in, *mu, *w0_f, *w2_f, *w0_b, *w2_b, *a0_f, *a2_f, *a0_b, *a2_b,
        *g2, *k_k, *k_a, *r_k_f, *r_k_b, *gn_w, *gn_b, *w_pool, *pool_scale, *w_out, *norm2_g, *w_rg, *b_rg, *w_re, *b_re,
        *w_gate, *w_up, *w_down, *final_g;
    float* out;
    char* ws;
};

DI unsigned pack2(float lo, float hi) { f32x2 v = {lo, hi}; bf16x2_t b = __builtin_convertvector(v, bf16x2_t); return __builtin_bit_cast(unsigned, b); }
DI float bf2f(bf16_t h) { return __uint_as_float(((unsigned)h) << 16); }
DI float bflo(unsigned u) { return __uint_as_float(u << 16); }
DI float bfhi(unsigned u) { return __uint_as_float(u & 0xffff0000u); }
DI void unpack8(const u32x4& p, float* f) { f[0] = bflo(p.x); f[1] = bfhi(p.x); f[2] = bflo(p.y); f[3] = bfhi(p.y); f[4] = bflo(p.z); f[5] = bfhi(p.z); f[6] = bflo(p.w); f[7] = bfhi(p.w); }
DI u32x4 pack8(const float* f) { u32x4 p; p.x = pack2(f[0], f[1]); p.y = pack2(f[2], f[3]); p.z = pack2(f[4], f[5]); p.w = pack2(f[6], f[7]); return p; }
DI float sigmoidf_(float x) { return 1.f / (1.f + __expf(-x)); }
DI float wave_sum(float v) {
#pragma unroll
    for (int o = 32; o > 0; o >>= 1) v += __shfl_xor(v, o, 64);
    return v;
}
DI f32x4 wave_sum4(f32x4 v) {
#pragma unroll
    for (int o = 32; o > 0; o >>= 1) { v[0] += __shfl_xor(v[0], o, 64); v[1] += __shfl_xor(v[1], o, 64); v[2] += __shfl_xor(v[2], o, 64); v[3] += __shfl_xor(v[3], o, 64); }
    return v;
}
typedef float f32x16 __attribute__((ext_vector_type(16)));
DI f32x16 zero16() { f32x16 z; for (int i = 0; i < 16; ++i) z[i] = 0.f; return z; }
DI s16x4 tr16(const bf16_t* a) { return __builtin_amdgcn_ds_read_tr16_b64_v4i16((LAS s16x4*)a); }
DI float pos_val(const float* rowtab, const float* coltab, int t, int d) { return d < 512 ? rowtab[(t >> 6) * 512 + d] : coltab[(t & 63) * 512 + (d - 512)]; }

DI void phase_p0(const Params& p, int bid, int nblk, char* lds) {
    const int tid = threadIdx.x;
    float* modx = (float*)(p.ws + OFF_MODX); float* modc = (float*)(p.ws + OFF_MODC);
    float* red = (float*)lds;
    for (int item = bid; item < 192; item += nblk) {
        const int col0 = item * 32, cg = tid & 7, kg = tid >> 3;
        f32x4 ax = {0, 0, 0, 0}, ac = {0, 0, 0, 0};
        f32x4 wv[16];
#pragma unroll
        for (int kk = 0; kk < 16; ++kk) wv[kk] = *(const f32x4*)(p.w_mod + (size_t)(kg * 16 + kk) * 6144 + col0 + cg * 4);
#pragma unroll
        for (int kk = 0; kk < 16; ++kk) {
            const int k = kg * 16 + kk;
            const float cv = p.c[k], cc = p.c_ctx[k];
            const float sx = cv * sigmoidf_(cv), sc = cc * sigmoidf_(cc);
            ax += wv[kk] * sx; ac += wv[kk] * sc;
        }
        __syncthreads();
#pragma unroll
        for (int j = 0; j < 4; ++j) { red[(kg * 32 + cg * 4 + j) * 2] = ax[j]; red[(kg * 32 + cg * 4 + j) * 2 + 1] = ac[j]; }
        __syncthreads();
        if (tid < 64) {
            const int col = tid & 31, which = tid >> 5;
            float sm = 0.f;
            for (int g = 0; g < 64; ++g) sm += red[(g * 32 + col) * 2 + which];
            sm += p.b_mod[col0 + col];
            (which ? modc : modx)[col0 + col] = sm;
        }
    }
    float* rowtab = (float*)(p.ws + OFF_ROWTAB); float* coltab = (float*)(p.ws + OFF_COLTAB);
    for (int i = bid * NTH + tid; i < (256 + 64) * 256; i += nblk * NTH) {
        const int pos = i >> 8, f = i & 255;
        const float freq = powf(10000.f, -(float)f / 256.f);
        if (pos < 256) { const float a = (float)pos * freq; rowtab[pos * 512 + f] = sinf(a); rowtab[pos * 512 + 256 + f] = cosf(a); }
        else { const int cp = pos - 256; const float a = (float)cp * freq; coltab[cp * 512 + f] = sinf(a); coltab[cp * 512 + 256 + f] = cosf(a); }
    }
    if (bid == 0 && tid < 64) ((int*)(p.ws + OFF_CNT))[tid] = 0;
    for (int pass = 0; pass < 2; ++pass) {
        const float* src = pass ? p.w_out : p.w_in; const int nc = pass ? D : DIN; bf16_t* dst = (bf16_t*)(p.ws + (pass ? OFF_WOUTB : OFF_WINB));
        const int n8 = nc >> 3;
        for (int idx = bid * NTH + tid; idx < D * n8; idx += nblk * NTH) {
            const int k = idx / n8, g8 = idx - k * n8, blk = g8 >> 2, q = g8 & 3;
            const f32x4 lo = *(const f32x4*)(src + (size_t)k * nc + blk * 32 + 4 * q), hi = *(const f32x4*)(src + (size_t)k * nc + blk * 32 + 16 + 4 * q);
            *(u32x4*)(dst + (size_t)k * nc + blk * 32 + 8 * q) = (u32x4){pack2(lo[0], lo[1]), pack2(lo[2], lo[3]), pack2(hi[0], hi[1]), pack2(hi[2], hi[3])};
        }
    }
}

DI void phase_xn(const Params& p, int bid, int nblk) {
    const int lane = threadIdx.x & 63, wid = threadIdx.x >> 6;
    const float* modx = (const float*)(p.ws + OFF_MODX); const float* modc = (const float*)(p.ws + OFF_MODC);
    const float* rowtab = (const float*)(p.ws + OFF_ROWTAB); const float* coltab = (const float*)(p.ws + OFF_COLTAB);
    bf16_t* xn = (bf16_t*)(p.ws + OFF_XN);
    for (int gp = bid * NWV + wid; gp < NT / 2; gp += nblk * NWV) {
        const int g0 = 2 * gp; const bool isctx = g0 < CTX;
        const float* md = isctx ? modc : modx;
        f32x4 v[2][4]; float ss[2] = {0.f, 0.f};
#pragma unroll
        for (int r = 0; r < 2; ++r)
#pragma unroll
            for (int i = 0; i < 4; ++i) {
                const int g = g0 + r, t = g - CTX, d = (i * 64 + lane) * 4;
                const float* src = isctx ? p.ctx + (size_t)g * D : p.x + (size_t)t * D;
                v[r][i] = *(const f32x4*)(src + d);
                if (!isctx) v[r][i] += *(const f32x4*)(d < 512 ? rowtab + (t >> 6) * 512 + d : coltab + (t & 63) * 512 + (d - 512));
                ss[r] += v[r][i][0] * v[r][i][0] + v[r][i][1] * v[r][i][1] + v[r][i][2] * v[r][i][2] + v[r][i][3] * v[r][i][3];
            }
#pragma unroll
        for (int r = 0; r < 2; ++r) {
            const float rstd = rsqrtf(wave_sum(ss[r]) * (1.f / 1024.f) + 1e-6f);
#pragma unroll
            for (int i = 0; i < 4; ++i) {
                const int d = (i * 64 + lane) * 4;
                const f32x4 gg = *(const f32x4*)(p.norm1_g + d), sh = *(const f32x4*)(md + d), sc = *(const f32x4*)(md + 1024 + d);
                f32x4 o;
#pragma unroll
                for (int j = 0; j < 4; ++j) o[j] = (v[r][i][j] * rstd * gg[j]) * (1.f + sc[j]) + sh[j];
                u32x2 pk = {pack2(o[0], o[1]), pack2(o[2], o[3])};
                *(u32x2*)(xn + (size_t)(g0 + r) * D + d) = pk;
            }
        }
    }
}

constexpr int GA_SZ = 256 * 128, GB_SZ = 34816, GBUF_SZ = GA_SZ + GB_SZ;
constexpr int GEMM_LDS = 2 * GBUF_SZ;
DI void glds16(const void* gsrc, char* ldst) { __builtin_amdgcn_global_load_lds((const unsigned*)gsrc, (LAS unsigned*)ldst, 16, 0, 0); }
template <int NB, bool BGLDS, int NBLK, class AL, class EPI, int MB = 4>
DI void gemm8(const AL& al, const void* __restrict__ Bv0, const void* __restrict__ Bv1, int ldb, int K, char* lds, EPI& epi) {
    static_assert(!(BGLDS && NB == 2) && !(NB == 2 && NBLK == 2), "unsupported combination");
    constexpr int WN = 32 * NBLK, BN = 4 * WN;
    constexpr int RB = BN * 2;
    constexpr int BP = BN + 8;
    constexpr int NF4 = BN / 4;
    constexpr int NLD = (64 * NF4) / NTH;
    constexpr int NPB = (64 * RB) / (1024 * NWV);
    int tid = threadIdx.x; asm volatile("" : "+v"(tid));
    const int lane = tid & 63, wid = __builtin_amdgcn_readfirstlane(tid >> 6), wr = wid >> 2, wc = wid & 3, r32 = lane & 31, hh = lane >> 5, gi = lane >> 4, i16 = lane & 15;
    const float* B0 = (const float*)Bv0; const float* B1 = (const float*)Bv1; const bf16_t* Bb = (const bf16_t*)Bv0;
    f32x16 acc0[MB][NBLK], acc1[MB][NBLK];
#pragma unroll
    for (int m = 0; m < MB; ++m)
#pragma unroll
        for (int n = 0; n < NBLK; ++n) { acc0[m][n] = zero16(); acc1[m][n] = zero16(); }
    f32x4 rb0[NLD], rb1[NLD];
    const int T = K >> 6;
    const bf16_t* arow[MB];
#pragma unroll
    for (int i = 0; i < MB; ++i) { const int row = (8 * i + wid) * 8 + (lane >> 3); arow[i] = al.rowptr(i, row) + (((lane & 7) ^ ((row >> 1) & 7)) << 3); }
    int bsrc[NPB];
#pragma unroll
    for (int i = 0; i < NPB; ++i) { const int k = (8 * i + wid) * (1024 / RB) + lane / (RB / 16), pp = lane % (RB / 16); bsrc[i] = k * ldb + ((((pp >> 1) ^ (k & 7)) << 1) + (pp & 1)) * 8; }
    const int a_base = (wr * (32 * MB) + r32) * 128, a_sw = (r32 >> 1) & 7;
    const int b_off = (8 * (gi >> 1) + (i16 >> 2)) * BP + wc * WN + 16 * (gi & 1) + 4 * (i16 & 3);
#define G_DMA(buf, t_) do { char* dA_ = lds + (buf) * GBUF_SZ + wid * 1024 + lane * 16; \
        _Pragma("unroll") for (int i = 0; i < MB; ++i) glds16(arow[i] + (t_) * 64, dA_ + i * 8192); \
        if (BGLDS) { char* dB_ = lds + (buf) * GBUF_SZ + GA_SZ + wid * 1024 + lane * 16; \
            _Pragma("unroll") for (int i = 0; i < NPB; ++i) glds16(Bb + (size_t)(t_) * 64 * ldb + bsrc[i], dB_ + i * 8192); } } while (0)
#define G_LOADB(t_) do { const int k0_ = (t_) * 64; \
        _Pragma("unroll") for (int i = 0; i < NLD; ++i) { const int c = tid + NTH * i, kr = c / NF4, n4 = c % NF4; rb0[i] = *(const f32x4*)(B0 + (size_t)(k0_ + kr) * ldb + n4 * 4); \
            if (NB == 2) rb1[i] = *(const f32x4*)(B1 + (size_t)(k0_ + kr) * ldb + n4 * 4); } } while (0)
#define G_WRITEB(buf) do { bf16_t* sB0_ = (bf16_t*)(lds + (buf) * GBUF_SZ + GA_SZ); bf16_t* sB1_ = sB0_ + 64 * BP; \
        _Pragma("unroll") for (int i = 0; i < NLD; ++i) { const int c = tid + NTH * i, kr = c / NF4, n4 = c % NF4, slot = (n4 >> 3) * 32 + 8 * (n4 & 3) + 4 * ((n4 >> 2) & 1); \
            u32x2 pk = {pack2(rb0[i][0], rb0[i][1]), pack2(rb0[i][2], rb0[i][3])}; *(u32x2*)(sB0_ + kr * BP + slot) = pk; \
            if (NB == 2) { u32x2 pk1 = {pack2(rb1[i][0], rb1[i][1]), pack2(rb1[i][2], rb1[i][3])}; *(u32x2*)(sB1_ + kr * BP + slot) = pk1; } } } while (0)
#define G_READ(buf, ks, AF, BF0, BF1) do { const char* sA_ = lds + (buf) * GBUF_SZ; const bf16_t* sB0_ = (const bf16_t*)(lds + (buf) * GBUF_SZ + GA_SZ); const bf16_t* sB1_ = sB0_ + 64 * BP; const int k0_ = (ks) * 16; \
        _Pragma("unroll") for (int n = 0; n < NBLK; ++n) { \
            if (BGLDS) { const int kk_ = k0_ + 8 * (gi >> 1) + (i16 >> 2), gr_ = (wc * WN + n * 32) / 16 + (gi & 1); \
                const char* q0_ = (const char*)sB0_ + kk_ * RB + ((gr_ ^ (kk_ & 7)) << 5) + 8 * (i16 & 3); const char* q1_ = (const char*)sB0_ + (kk_ + 4) * RB + ((gr_ ^ ((kk_ + 4) & 7)) << 5) + 8 * (i16 & 3); \
                s16x4 lo = tr16((const bf16_t*)q0_), hi = tr16((const bf16_t*)q1_); BF0[n] = __builtin_shufflevector(lo, hi, 0, 1, 2, 3, 4, 5, 6, 7); } \
            else { const int off = b_off + k0_ * BP + n * 32; \
                s16x4 lo = tr16(sB0_ + off), hi = tr16(sB0_ + off + 4 * BP); BF0[n] = __builtin_shufflevector(lo, hi, 0, 1, 2, 3, 4, 5, 6, 7); \
                if (NB == 2) { s16x4 lo1 = tr16(sB1_ + off), hi1 = tr16(sB1_ + off + 4 * BP); BF1[n] = __builtin_shufflevector(lo1, hi1, 0, 1, 2, 3, 4, 5, 6, 7); } } } \
        _Pragma("unroll") for (int m = 0; m < MB; ++m) AF[m] = *(const bf16x8*)(sA_ + a_base + m * 4096 + ((((ks) * 2 + hh) ^ a_sw) << 4)); } while (0)
#define G_MFMA(AF, BF0, BF1) do { \
        _Pragma("unroll") for (int m = 0; m < MB; ++m) _Pragma("unroll") for (int n = 0; n < NBLK; ++n) { \
            acc0[m][n] = __builtin_amdgcn_mfma_f32_32x32x16_bf16(BF0[n], AF[m], acc0[m][n], 0, 0, 0); \
            if (NB == 2) acc1[m][n] = __builtin_amdgcn_mfma_f32_32x32x16_bf16(BF1[n], AF[m], acc1[m][n], 0, 0, 0); } } while (0)
#define G_MIX(nm) do { _Pragma("unroll") for (int i = 0; i < (nm); ++i) { __builtin_amdgcn_sched_group_barrier(0x008, 1, 0); __builtin_amdgcn_sched_group_barrier(0x100, 1, 0); } } while (0)
    constexpr int NMF = MB * NBLK * NB;
    bf16x8 afA[MB], bfA0[NBLK], bfA1[NBLK], afB[MB], bfB0[NBLK], bfB1[NBLK];
    G_DMA(0, 0);
    if (!BGLDS) { G_LOADB(0); G_WRITEB(0); }
#pragma unroll 1
    for (int t = 0; t < T; ++t) {
        const int buf = t & 1;
        asm volatile("s_waitcnt vmcnt(0)" ::: "memory");
        __syncthreads();
        if (t + 1 < T) { G_DMA(buf ^ 1, t + 1); if (!BGLDS) G_LOADB(t + 1); }
        if (BGLDS) {
            G_READ(buf, 0, afA, bfA0, bfA1);
            __builtin_amdgcn_sched_barrier(0);
            G_MFMA(afA, bfA0, bfA1); G_READ(buf, 1, afB, bfB0, bfB1); G_MIX(NMF);
            __builtin_amdgcn_sched_barrier(0);
            G_MFMA(afB, bfB0, bfB1); G_READ(buf, 2, afA, bfA0, bfA1); G_MIX(NMF);
            __builtin_amdgcn_sched_barrier(0);
            G_MFMA(afA, bfA0, bfA1); G_READ(buf, 3, afB, bfB0, bfB1); G_MIX(NMF);
            __builtin_amdgcn_sched_barrier(0);
            G_MFMA(afB, bfB0, bfB1);
        } else {
            __builtin_amdgcn_sched_barrier(0);
            G_READ(buf, 0, afA, bfA0, bfA1); G_MFMA(afA, bfA0, bfA1);
            G_READ(buf, 1, afA, bfA0, bfA1); G_MFMA(afA, bfA0, bfA1);
            G_READ(buf, 2, afA, bfA0, bfA1); G_MFMA(afA, bfA0, bfA1);
            __builtin_amdgcn_sched_barrier(0);
            G_READ(buf, 3, afA, bfA0, bfA1); G_MFMA(afA, bfA0, bfA1);
            G_WRITEB(buf ^ 1);
        }
        __builtin_amdgcn_sched_barrier(0);
    }
#undef G_DMA
#undef G_LOADB
#undef G_WRITEB
#undef G_READ
#undef G_MFMA
#undef G_MIX
    __syncthreads();
    float* stg = (float*)lds + wid * (32 * 68);
#pragma unroll
    for (int m = 0; m < MB; ++m) {
#pragma unroll
        for (int n = 0; n < NBLK; ++n) {
            const f32x16 v = epi.pre(acc0[m][n], acc1[m][n]);
#pragma unroll
            for (int q = 0; q < 4; ++q) *(f32x4*)(stg + r32 * 68 + n * 32 + 16 * hh + 4 * q) = (f32x4){v[4 * q], v[4 * q + 1], v[4 * q + 2], v[4 * q + 3]};
        }
        asm volatile("s_waitcnt lgkmcnt(0)" ::: "memory"); __builtin_amdgcn_wave_barrier();
#pragma unroll
        for (int ps = 0; ps < (32 * WN) / 256; ++ps) {
            const int idx = ps * 64 + lane, row = idx / (WN / 4), ck = idx % (WN / 4);
            epi.post(wr * (32 * MB) + m * 32 + row, wc * WN + ck * 4, *(const f32x4*)(stg + row * 68 + ck * 4));
        }
        asm volatile("s_waitcnt lgkmcnt(0)" ::: "memory"); __builtin_amdgcn_wave_barrier();
    }
    __syncthreads();
}

struct PlainA {
    const bf16_t* base; int lda;
    DI const bf16_t* rowptr(int, int row) const { return base + (size_t)row * lda; }
};
struct GatherA {
    const bf16_t* rp[4];
    DI const bf16_t* rowptr(int i, int) const { return rp[i]; }
};

struct XcdOrder {
    int base, lim, j, bpx;
    DI XcdOrder(int bid, int nblk, int total) {
        if ((nblk & 7) == 0) { const int x = bid & 7, per = (total + 7) >> 3; bpx = nblk >> 3; j = bid >> 3; base = x * per; lim = base + per < total ? base + per : total; }
        else { bpx = nblk; j = bid; base = 0; lim = total; }
    }
    DI int item(int i) const { const int q = base + i * bpx + j; return q < lim ? q : -1; }
};
DI void tile_rc(int q, int nrow, int ncol, int& r, int& c) {
    const int per_sr = 8 * ncol, sr = q / per_sr, rem = q - sr * per_sr, rows = (nrow - sr * 8) < 8 ? (nrow - sr * 8) : 8;
    c = rem / rows; r = sr * 8 + rem - c * rows;
}

DI u32x4 pack8v(const f32x4& a, const f32x4& b) { return (u32x4){pack2(a[0], a[1]), pack2(a[2], a[3]), pack2(b[0], b[1]), pack2(b[2], b[3])}; }
DI u32x4 pack8q(const f32x16& a, int q) { return (u32x4){pack2(a[8 * q], a[8 * q + 1]), pack2(a[8 * q + 2], a[8 * q + 3]), pack2(a[8 * q + 4], a[8 * q + 5]), pack2(a[8 * q + 6], a[8 * q + 7])}; }
struct EpiStoreBf16 { bf16_t* o; int ldo;
    DI f32x16 pre(const f32x16& a, const f32x16&) const { return a; }
    DI void post(int r, int c, const f32x4& v) const { u32x2 pk = {pack2(v[0], v[1]), pack2(v[2], v[3])}; *(u32x2*)(o + (size_t)r * ldo + c) = pk; } };
DI void phase_g1(const Params& p, int bid, int nblk, char* lds) {
    const bf16_t* xn = (const bf16_t*)(p.ws + OFF_XN); bf16_t* u = (bf16_t*)(p.ws + OFF_U);
    const bf16_t* wb = (const bf16_t*)(p.ws + OFF_WINB);
    const int nwide_all = 65 * 9, nwide = (2 * nblk < nwide_all) ? 2 * nblk : nwide_all;
    const XcdOrder ord(bid, nblk, nwide);
    for (int i = 0, q; (q = ord.item(i)) >= 0; ++i) {
        int tm, tn; tile_rc(q, 65, 9, tm, tn);
        PlainA al{xn + (size_t)tm * 256 * D, D};
        EpiStoreBf16 epi{u + (size_t)tm * 256 * DIN + tn * 256, DIN};
        gemm8<1, true, 2>(al, wb + tn * 256, nullptr, DIN, D, lds, epi);
    }
    const int nhalf = 2 * (nwide_all - nwide) + 65;
    for (int n = bid; n < nhalf; n += nblk) {
        int tm, col;
        if (n < 2 * (nwide_all - nwide)) { int tn; tile_rc(nwide + (n >> 1), 65, 9, tm, tn); col = tn * 256 + (n & 1) * 128; }
        else { tm = n - 2 * (nwide_all - nwide); col = 9 * 256; }
        PlainA al{xn + (size_t)tm * 256 * D, D};
        EpiStoreBf16 epi{u + (size_t)tm * 256 * DIN + col, DIN};
        gemm8<1, true, 1>(al, wb + col, nullptr, DIN, D, lds, epi);
    }
}

DI void phase_pool(const Params& p, int bid, int nblk) {
    const bf16_t* u = (const bf16_t*)(p.ws + OFF_U) + (size_t)CTX * DIN + C_POOL;
    bf16_t* mix = (bf16_t*)(p.ws + OFF_MIX);
    for (int item = bid * NTH + threadIdx.x; item < (S / 8) * 64; item += nblk * NTH) {
        const int cg = item & 63, run = item >> 6, t0 = run * 8, gi = cg >> 4, win = 2 << gi, hw = win >> 1;
        const bf16_t* uc = u + cg * 8;
        float sum[8];
#pragma unroll
        for (int j = 0; j < 8; ++j) sum[j] = 0.f;
        const int lo0 = (t0 - hw) < 0 ? 0 : (t0 - hw), hi0 = (t0 - hw + win) > S ? S : (t0 - hw + win);
#pragma unroll
        for (int r = 0; r < 16; ++r) {
            const int tt = lo0 + r; const bool ok = tt < hi0; const int tc = ok ? tt : lo0;
            float q[8]; unpack8(*(const u32x4*)(uc + (size_t)tc * DIN), q);
            const float wgt = ok ? 1.f : 0.f;
#pragma unroll
            for (int j = 0; j < 8; ++j) sum[j] += wgt * q[j];
        }
        int lo = lo0, hi = hi0;
#pragma unroll
        for (int k = 0; k < 8; ++k) {
            const int t = t0 + k;
            float cv[8], o[8]; unpack8(*(const u32x4*)(uc + (size_t)t * DIN), cv);
            const float inv = 1.f / (float)(hi - lo);
#pragma unroll
            for (int j = 0; j < 8; ++j) o[j] = sum[j] * inv - cv[j];
            *(u32x4*)(mix + (size_t)t * D + cg * 8) = pack8(o);
            const int nlo = t + 1 - hw, nhi = t + 1 - hw + win;
            const bool addr = nhi <= S, subr = nlo > 0;
            float qa[8], qs[8];
            unpack8(*(const u32x4*)(uc + (size_t)(addr ? nhi - 1 : t) * DIN), qa); unpack8(*(const u32x4*)(uc + (size_t)(subr ? nlo - 1 : t) * DIN), qs);
            const float wa = addr ? 1.f : 0.f, wsb = subr ? 1.f : 0.f;
#pragma unroll
            for (int j = 0; j < 8; ++j) sum[j] += wa * qa[j] - wsb * qs[j];
            hi = addr ? nhi : hi; lo = subr ? nlo : lo;
        }
    }
}
struct EpiPool { bf16_t* o; const float* sc;
    DI f32x16 pre(const f32x16& a, const f32x16&) const { return a; }
    DI void post(int r, int c, const f32x4& v) const { const f32x4 s4 = *(const f32x4*)(sc + c); u32x2 pk = {pack2(v[0] * s4[0], v[1] * s4[1]), pack2(v[2] * s4[2], v[3] * s4[3])}; *(u32x2*)(o + (size_t)r * D + c) = pk; } };
DI void phase_poolgemm(const Params& p, int bid, int nblk, char* lds) {
    if (nblk <= 0) return;
    for (int it = bid; it < 4 * 64; it += nblk) {
        const int gi = it >> 6, tm = it & 63;
        const bf16_t* mix = (const bf16_t*)(p.ws + OFF_MIX);
        PlainA al{mix + (size_t)tm * 256 * D + gi * 128, D};
        EpiPool e{(bf16_t*)(p.ws + OFF_MIX) + (size_t)tm * 256 * D + 512 + gi * 128, p.pool_scale + gi * 128};
        int kk = 128; asm volatile("" : "+s"(kk));
        gemm8<1, false, 1>(al, p.w_pool + (size_t)gi * 128 * 128, nullptr, 128, kk, lds, e);
    }
}

constexpr int MP = 72, MSZ = 64 * MP;
constexpr int FP = 68;
constexpr int SCANA_LDS = 17 * MSZ * 2 + 4096;
template <bool KS> DI bf16x8 frag32(const bf16_t* base, int x0, int s, int lane) {
    if (!KS) return *(const bf16x8*)(base + (x0 + (lane & 31)) * MP + 16 * s + 8 * (lane >> 5));
    const int gi = lane >> 4, i = lane & 15;
    const bf16_t* a = base + (16 * s + 8 * (gi >> 1) + (i >> 2)) * MP + x0 + 16 * (gi & 1) + 4 * (i & 3);
    s16x4 lo = tr16(a), hi = tr16(a + 4 * MP);
    return __builtin_shufflevector(lo, hi, 0, 1, 2, 3, 4, 5, 6, 7);
}
template <bool XKS, bool YKS> DI f32x16 mm32(const bf16_t* X, int x0, const bf16_t* Y, int y0, f32x16 acc, int lane) {
#pragma unroll
    for (int s = 0; s < 4; ++s) acc = __builtin_amdgcn_mfma_f32_32x32x16_bf16(frag32<XKS>(X, x0, s, lane), frag32<YKS>(Y, y0, s, lane), acc, 0, 0, 0);
    return acc;
}
template <class F> DI void store_acc(bf16_t* out, int x0, int y0, const f32x16& acc, int lane, F f) {
    const int y = y0 + (lane & 31), hh = lane >> 5;
#pragma unroll
    for (int q = 0; q < 4; ++q) {
        const int x = x0 + 8 * q + 4 * hh;
        u32x2 pk = {pack2(f(acc[4 * q], x, y), f(acc[4 * q + 1], x + 1, y)), pack2(f(acc[4 * q + 2], x + 2, y), f(acc[4 * q + 3], x + 3, y))};
        *(u32x2*)(out + y * MP + x) = pk;
    }
}
DI unsigned rot16(unsigned x) { return (x >> 16) | (x << 16); }

DI int chain_pos(int c, int dir) { return dir == 0 ? c : (c < 4 ? 3 - c : NCH + 3 - c); }

DI void phase_scanA(const Params& p, int bid, int nblk, char* lds) {
    const int tid = threadIdx.x, lane0 = tid & 63, w = tid >> 6, grp = w >> 2;
    bf16_t* M = (bf16_t*)lds;
    bf16_t *sAT = M, *sBT = M + MSZ, *sKT = M + 2 * MSZ, *sRT = M + 3 * MSZ, *sVT = M + 4 * MSZ;
    float* fGC = (float*)(lds + 17 * MSZ * 2);
    float* fSeg = fGC + 64;
    float* fTab = fSeg + 64;
    float* fLogw = (float*)(M + 12 * MSZ);
    float* fA = (float*)(M + 10 * MSZ);
    const bf16_t* u = (const bf16_t*)(p.ws + OFF_U);
    u32x4 praw[5], prawg[2], phalo;
#define SCANA_ISSUE(inst_) do { const int c_ = (inst_) >> 4, h_ = ((inst_) >> 1) & 7, d_ = (inst_) & 1, ch_ = tid & 7, tau_ = tid >> 3, g_ = d_ ? c_ * 64 + 63 - tau_ : c_ * 64 + tau_; \
        const bool wg_ = c_ >= 4 && d_ == 0; \
        const bf16_t* rc_ = u + (size_t)g_ * DIN; \
        const int cb_[7] = {h_ * 64, 512 + h_ * 64, 1024 + h_ * 64, (d_ ? C_WLB : C_WLF), (d_ ? C_ALB : C_ALF), C_GL, C_GL + 64}; \
        _Pragma("unroll") for (int q = 0; q < 5; ++q) praw[q] = *(const u32x4*)(rc_ + cb_[q] + ch_ * 8); \
        if (wg_) { prawg[0] = *(const u32x4*)(rc_ + cb_[5] + ch_ * 8); prawg[1] = *(const u32x4*)(rc_ + cb_[6] + ch_ * 8); } \
        if (tid < 112) { const int rs_ = tid >= 56, rem_ = tid - rs_ * 56, gq_ = rem_ >> 3, ck_ = rem_ & 7; int gh_ = rs_ ? c_ * 64 + 64 : c_ * 64 - 1; gh_ = gh_ < 0 ? 0 : (gh_ > NT - 1 ? NT - 1 : gh_); \
            int col_ = cb_[0]; col_ = gq_ == 1 ? cb_[1] : col_; col_ = gq_ == 2 ? cb_[2] : col_; col_ = gq_ == 3 ? cb_[3] : col_; col_ = gq_ == 4 ? cb_[4] : col_; col_ = gq_ == 5 ? cb_[5] : col_; col_ = gq_ == 6 ? cb_[6] : col_; \
            phalo = *(const u32x4*)(u + (size_t)gh_ * DIN + col_ + ck_ * 8); } } while (0)
#define XOFF(q) ((q) < 4 ? 10 * (MSZ * 2) + (q) * 8448 : ((q) == 4 ? 9 * (MSZ * 2) : ((q) == 5 ? 4 * (MSZ * 2) : 14 * (MSZ * 2))))
    if (bid < NCH * 16) SCANA_ISSUE(bid);
    int cur_hd = -1;
    for (int inst = bid; inst < NCH * 16; inst += nblk) {
        int lane = lane0; asm volatile("" : "+v"(lane));
        const int xq = 32 * (w & 1), yq = 32 * ((w >> 1) & 1);
        const int c = inst >> 4, h = (inst >> 1) & 7, dir = inst & 1;
        const bool latent = c >= 4, want_g = latent && dir == 0;
        const float* w2 = dir ? p.w2_b : p.w2_f; const float* a2 = dir ? p.a2_b : p.a2_f;
        const float* w0 = dir ? p.w0_b : p.w0_f; const float* a0 = dir ? p.a0_b : p.a0_f;
        const float* rkd = dir ? p.r_k_b : p.r_k_f;
        const int cwl = dir ? C_WLB : C_WLF, cal = dir ? C_ALB : C_ALF;
        const int ch = tid & 7, tau = tid >> 3, g = dir ? c * 64 + 63 - tau : c * 64 + tau;
        if ((inst & 15) != cur_hd) {
            cur_hd = inst & 15;
            for (int i = tid; i < 768; i += NTH) {
                const int grp_ = i >> 6, j_ = i & 63; float v_;
                if (grp_ < 3) v_ = p.mu[grp_ * 512 + h * 64 + j_];
                else if (grp_ == 3) v_ = p.mu[cwl + j_];
                else if (grp_ == 4) v_ = p.mu[cal + j_];
                else if (grp_ < 7) v_ = p.mu[C_GL + (grp_ - 5) * 64 + j_];
                else if (grp_ == 7) v_ = p.k_k[h * 64 + j_];
                else if (grp_ == 8) v_ = p.k_a[h * 64 + j_];
                else if (grp_ == 9) v_ = rkd[h * 64 + j_];
                else if (grp_ == 10) v_ = w0[h * 64 + j_];
                else v_ = a0[h * 64 + j_];
                fTab[i] = v_;
            }
#pragma unroll
            for (int q = 0; q < 2; ++q) { const int idx = tid + NTH * q, kr = idx >> 4, n4 = idx & 15;
                const f32x4 wa = *(const f32x4*)(w2 + (size_t)kr * DR + h * 64 + n4 * 4), wb2 = *(const f32x4*)(a2 + (size_t)kr * DR + h * 64 + n4 * 4);
                u32x2 pa = {pack2(wa[0], wa[1]), pack2(wa[2], wa[3])}, pb = {pack2(wb2[0], wb2[1]), pack2(wb2[2], wb2[3])};
                *(u32x2*)(M + 15 * MSZ + kr * MP + n4 * 4) = pa; *(u32x2*)(M + 16 * MSZ + kr * MP + n4 * 4) = pb; }
            __syncthreads();
        }
        float fr_[8], fk_[8], fv_[8];
        {
            const bool hasp = (g != 0) && (g != CTX), hasn = (g != CTX - 1) && (g != NT - 1);
            const float mp = hasp ? 0.5f : 0.f, mn = hasn ? 0.5f : 0.f;
            const int lc = (dir ? 63 - tau : tau) + 1;
            char* xb = (char*)M;
#pragma unroll
            for (int q = 0; q < 5; ++q) *(u32x4*)(xb + XOFF(q) + lc * 128 + ch * 16) = praw[q];
            if (want_g) { *(u32x4*)(xb + XOFF(5) + lc * 128 + ch * 16) = prawg[0]; *(u32x4*)(xb + XOFF(6) + lc * 128 + ch * 16) = prawg[1]; }
            if (tid < 112) { const int rs = tid >= 56, rem = tid - rs * 56, gq = rem >> 3, ck = rem & 7;
                int xo = XOFF(0); xo = gq == 1 ? XOFF(1) : xo; xo = gq == 2 ? XOFF(2) : xo; xo = gq == 3 ? XOFF(3) : xo; xo = gq == 4 ? XOFF(4) : xo; xo = gq == 5 ? XOFF(5) : xo; xo = gq == 6 ? XOFF(6) : xo;
                if (gq < 5 || want_g) *(u32x4*)(xb + xo + (rs ? 65 : 0) * 128 + ck * 16) = phalo; }
            __syncthreads();
            u32x4 raw[5][3];
#pragma unroll
            for (int q = 0; q < 5; ++q) { const char* sx = xb + XOFF(q) + lc * 128 + ch * 16; raw[q][0] = praw[q]; raw[q][1] = *(const u32x4*)(sx - 128); raw[q][2] = *(const u32x4*)(sx + 128); }
            auto shift8 = [&](const u32x4* r3, int tgrp, float* o) {
                float cc[8], pv[8], nx[8];
                unpack8(r3[0], cc); unpack8(r3[1], pv); unpack8(r3[2], nx);
                const f32x4 m0 = *(const f32x4*)(fTab + tgrp * 64 + ch * 8), m1 = *(const f32x4*)(fTab + tgrp * 64 + ch * 8 + 4);
#pragma unroll
                for (int j = 0; j < 8; ++j) { const float m = j < 4 ? m0[j & 3] : m1[j & 3]; o[j] = cc[j] + m * ((mp * pv[j] + mn * nx[j]) - cc[j]); }
            };
            shift8(raw[0], 0, fr_); shift8(raw[1], 1, fk_); shift8(raw[2], 2, fv_);
            float t8[8];
            shift8(raw[3], 3, t8);
#pragma unroll
            for (int j = 0; j < 8; ++j) { const float e2 = __expf(2.f * t8[j]); t8[j] = 1.f - __fdividef(2.f, e2 + 1.f); }
            *(u32x4*)(M + 5 * MSZ + tau * MP + ch * 8) = pack8(t8);
            shift8(raw[4], 4, t8);
            *(u32x4*)(M + 6 * MSZ + tau * MP + ch * 8) = pack8(t8);
            if (want_g) {
                u32x4 rawg[2][3]; f32x4 wg2[4];
#pragma unroll
                for (int half = 0; half < 2; ++half) { const char* sx = xb + XOFF(5 + half) + lc * 128 + ch * 16; rawg[half][0] = prawg[half]; rawg[half][1] = *(const u32x4*)(sx - 128); rawg[half][2] = *(const u32x4*)(sx + 128); }
#pragma unroll
                for (int q = 0; q < 4; ++q) { const int idx = tid + NTH * q, kr = idx >> 4, n4 = idx & 15; wg2[q] = *(const f32x4*)(p.g2 + (size_t)kr * DR + h * 64 + n4 * 4); }
#pragma unroll
                for (int half = 0; half < 2; ++half) {
                    shift8(rawg[half], 5 + half, t8);
#pragma unroll
                    for (int j = 0; j < 8; ++j) t8[j] = sigmoidf_(t8[j]);
                    *(u32x4*)(M + half * MSZ + tau * MP + ch * 8) = pack8(t8);
                }
#pragma unroll
                for (int q = 0; q < 4; ++q) { const int idx = tid + NTH * q, kr = idx >> 4, n4 = idx & 15;
                    u32x2 pa = {pack2(wg2[q][0], wg2[q][1]), pack2(wg2[q][2], wg2[q][3])};
                    *(u32x2*)(M + (2 + (kr >> 6)) * MSZ + (kr & 63) * MP + n4 * 4) = pa; }
            }
        }
        __syncthreads();
        if (grp == 0) {
            f32x16 accW = mm32<true, false>(M + 15 * MSZ, xq, M + 5 * MSZ, yq, zero16(), lane);
            const int y = yq + (lane & 31), hh = lane >> 5;
#pragma unroll
            for (int q = 0; q < 4; ++q) {
                const int x = xq + 8 * q + 4 * hh;
                f32x4 lw; const f32x4 w0v = *(const f32x4*)(fTab + 10 * 64 + x);
#pragma unroll
                for (int e = 0; e < 4; ++e) {
                    float v = -DECAY_SCALE * sigmoidf_(w0v[e] + accW[4 * q + e]);
                    v += __builtin_bit_cast(float, __builtin_amdgcn_update_dpp(0, __builtin_bit_cast(int, v), 0x111, 0xf, 0xf, false));
                    v += __builtin_bit_cast(float, __builtin_amdgcn_update_dpp(0, __builtin_bit_cast(int, v), 0x112, 0xf, 0xf, false));
                    v += __builtin_bit_cast(float, __builtin_amdgcn_update_dpp(0, __builtin_bit_cast(int, v), 0x114, 0xf, 0xf, false));
                    v += __builtin_bit_cast(float, __builtin_amdgcn_update_dpp(0, __builtin_bit_cast(int, v), 0x118, 0xf, 0xf, false));
                    v += __builtin_bit_cast(float, __builtin_amdgcn_update_dpp(0, __builtin_bit_cast(int, v), 0x142, 0xa, 0xf, false));
                    lw[e] = v;
                }
                *(f32x4*)(fLogw + y * FP + x) = lw;
                if (yq == 0 && (lane & 31) == 31) *(f32x4*)(fSeg + x) = lw;
            }
        } else {
            f32x16 accA = mm32<true, false>(M + 16 * MSZ, xq, M + 6 * MSZ, yq, zero16(), lane);
            const int y = yq + (lane & 31), hh = lane >> 5;
#pragma unroll
            for (int q = 0; q < 4; ++q) {
                const int x = xq + 8 * q + 4 * hh;
                f32x4 av; const f32x4 a0v = *(const f32x4*)(fTab + 11 * 64 + x);
#pragma unroll
                for (int e = 0; e < 4; ++e) av[e] = sigmoidf_(a0v[e] + accA[4 * q + e]);
                *(f32x4*)(fA + y * FP + x) = av;
            }
            if (want_g) {
                f32x16 accG = mm32<true, false>(M + 2 * MSZ, xq, M, yq, zero16(), lane);
                accG = mm32<true, false>(M + 3 * MSZ, xq, M + MSZ, yq, accG, lane);
                const int t = c * 64 + y - CTX;
#pragma unroll
                for (int q = 0; q < 4; ++q) {
                    const int x = xq + 8 * q + 4 * hh;
                    u32x2 pk = {pack2(accG[4 * q], accG[4 * q + 1]), pack2(accG[4 * q + 2], accG[4 * q + 3])};
                    *(u32x2*)((bf16_t*)(p.ws + OFF_G) + (size_t)t * DR + h * 64 + x) = pk;
                }
            }
        }
        __syncthreads();
        {
            float oa[8], ob[8], ok[8], orr[8], kkv[8], kd[8];
            float ss = 0.f, dsum = 0.f;
            float kkp[8], kap[8], rkp[8], cum8[8], prv8[8], av8[8];
#pragma unroll
            for (int hf = 0; hf < 2; ++hf) {
                const int o8 = ch * 8 + 4 * hf;
                const f32x4 a_ = *(const f32x4*)(fTab + 7 * 64 + o8), b_ = *(const f32x4*)(fTab + 8 * 64 + o8), c_ = *(const f32x4*)(fTab + 9 * 64 + o8);
                const f32x4 sg = *(const f32x4*)(fSeg + o8), cu = *(const f32x4*)(fLogw + tau * FP + o8), pr = *(const f32x4*)(fLogw + (tau ? tau - 1 : 0) * FP + o8), aa = *(const f32x4*)(fA + tau * FP + o8);
#pragma unroll
                for (int j = 0; j < 4; ++j) {
                    kkp[4 * hf + j] = a_[j]; kap[4 * hf + j] = b_[j]; rkp[4 * hf + j] = c_[j]; av8[4 * hf + j] = aa[j];
                    cum8[4 * hf + j] = cu[j] + (tau >= 32 ? sg[j] : 0.f); prv8[4 * hf + j] = tau ? pr[j] + (tau > 32 ? sg[j] : 0.f) : 0.f;
                }
            }
#pragma unroll
            for (int j = 0; j < 8; ++j) { kkv[j] = fk_[j] * kkp[j]; ss += kkv[j] * kkv[j]; }
            ss += __shfl_xor(ss, 1, 64); ss += __shfl_xor(ss, 2, 64); ss += __shfl_xor(ss, 4, 64);
            const float inv = 1.f / fmaxf(sqrtf(ss), 1e-12f);
#pragma unroll
            for (int j = 0; j < 8; ++j) {
                const float cum = cum8[j], cprev = prv8[j], av = av8[j];
                const float gam = __expf(cum), gprev = __expf(cprev), ginv = __expf(-cum);
                const float kkn = kkv[j] * inv;
                kd[j] = fk_[j] * (1.f + (av - 1.f) * kap[j]);
                oa[j] = -kkn * gprev; ob[j] = kkn * av * ginv; ok[j] = kd[j] * ginv; orr[j] = fr_[j] * gam;
                dsum += fr_[j] * kd[j] * rkp[j];
                if (tau == 63) fGC[ch * 8 + j] = gam;
            }
            dsum += __shfl_xor(dsum, 1, 64); dsum += __shfl_xor(dsum, 2, 64); dsum += __shfl_xor(dsum, 4, 64);
            if (ch == 0) ((float*)(p.ws + OFF_DOT))[((size_t)g * 8 + h) * 2 + dir] = dsum;
            *(u32x4*)(sAT + tau * MP + ch * 8) = pack8(oa); *(u32x4*)(sBT + tau * MP + ch * 8) = pack8(ob);
            *(u32x4*)(sKT + tau * MP + ch * 8) = pack8(ok); *(u32x4*)(sRT + tau * MP + ch * 8) = pack8(orr);
            const u32x4 pv8 = pack8(fv_);
            *(u32x4*)(sVT + tau * MP + ch * 8) = pv8;
            if (want_g) *(u32x4*)((bf16_t*)(p.ws + OFF_V) + (size_t)(g - CTX) * DR + h * 64 + ch * 8) = pv8;
        }
        __syncthreads();
        if (grp == 0) {
            f32x16 acc = mm32<false, false>(sAT, xq, sBT, yq, zero16(), lane);
            store_acc(M + 5 * MSZ, xq, yq, acc, lane, [](float v, int x, int y) { return y < x ? v : 0.f; });
            store_acc(M + 7 * MSZ, xq, yq, acc, lane, [](float v, int x, int y) { return y < x ? v : (y == x ? 1.f : 0.f); });
        } else {
            f32x16 acc = mm32<false, false>(sAT, xq, sKT, yq, zero16(), lane);
            store_acc(M + 9 * MSZ, xq, yq, acc, lane, [](float v, int x, int y) { return y < x ? v : 0.f; });
        }
        __syncthreads();
        int xs = 5, xo = 6, ts = 7, to = 8;
        if (grp == 1) {
            f32x16 acc = mm32<true, false>(M + xs * MSZ, xq, M + xs * MSZ, yq, zero16(), lane);
            store_acc(M + xo * MSZ, xq, yq, acc, lane, [](float v, int, int) { return v; });
        }
        { int t_ = xs; xs = xo; xo = t_; }
        __syncthreads();
        for (int k = 0; k < 5; ++k) {
            if (grp == 0) {
                const bf16_t* Told = M + ts * MSZ;
                f32x16 acc = mm32<true, false>(M + xs * MSZ, xq, Told, yq, zero16(), lane);
                store_acc(M + to * MSZ, xq, yq, acc, lane, [Told](float v, int x, int y) { return v + bf2f(Told[y * MP + x]); });
            } else if (k < 4) {
                f32x16 acc = mm32<true, false>(M + xs * MSZ, xq, M + xs * MSZ, yq, zero16(), lane);
                store_acc(M + xo * MSZ, xq, yq, acc, lane, [](float v, int, int) { return v; });
            } else {
                f32x16 acc = mm32<false, false>(sRT, xq, sBT, yq, zero16(), lane);
                store_acc(M + 10 * MSZ, xq, yq, acc, lane, [](float v, int x, int y) { return y <= x ? v : 0.f; });
                acc = mm32<false, false>(sRT, xq, sKT, yq, zero16(), lane);
                store_acc(M + 11 * MSZ, xq, yq, acc, lane, [](float v, int x, int y) { return y <= x ? v : 0.f; });
            }
            int t_ = xs; xs = xo; xo = t_; t_ = ts; ts = to; to = t_;
            __syncthreads();
        }
        const bf16_t* sT = M + ts * MSZ;
        if (grp == 0) {
            f32x16 acc = mm32<true, true>(sT, xq, sAT, yq, zero16(), lane);
            store_acc(M + 12 * MSZ, xq, yq, acc, lane, [](float v, int, int) { return v; });
        } else {
            f32x16 acc = mm32<true, false>(sT, xq, M + 9 * MSZ, yq, zero16(), lane);
            store_acc(M + 13 * MSZ, xq, yq, acc, lane, [](float v, int, int) { return v; });
        }
        __syncthreads();
        {
            const bf16_t *sAbar = M + 12 * MSZ, *sG = M + 13 * MSZ, *sABR = M + 10 * MSZ, *sAKR = M + 11 * MSZ;
            if (grp == 0) {
                f32x16 acc = mm32<false, true>(sAbar, xq, sBT, yq, zero16(), lane);
                store_acc(M + 5 * MSZ, xq, yq, acc, lane, [fGC](float v, int x, int y) { return ((x == y ? 1.f : 0.f) + v) * fGC[y]; });
                acc = mm32<false, true>(sAbar, xq, sABR, yq, zero16(), lane);
                store_acc(M + 6 * MSZ, xq, yq, acc, lane, [sRT](float v, int x, int y) { return v + bf2f(sRT[y * MP + x]); });
            } else {
                f32x16 acc = mm32<true, false>(sBT, xq, sG, yq, zero16(), lane);
                store_acc(M + 7 * MSZ, xq, yq, acc, lane, [sKT, fGC](float v, int x, int y) { return (v + bf2f(sKT[y * MP + x])) * fGC[x]; });
                acc = mm32<true, false>(sABR, xq, sG, yq, zero16(), lane);
                store_acc(M + 9 * MSZ, xq, yq, acc, lane, [sAKR](float v, int x, int y) { return v + bf2f(sAKR[y * MP + x]); });
            }
        }
        __syncthreads();
        const int chain = dir * 8 + h, npos = chain_pos(c, dir);
        if (inst + nblk < NCH * 16) SCANA_ISSUE(inst + nblk);
        {
            u32x4* Pg = (u32x4*)(p.ws + OFF_P) + ((size_t)chain * NCH + npos) * 512;
            { const int item = tid, ln = item & 63, as = item >> 6, a = as >> 1, s2 = as & 1, fr = ln & 15, fq = ln >> 4;
              const bf16_t* src = M + 5 * MSZ + (16 * a + fr) * MP + 32 * s2 + 4 * fq;
              const u32x2 lo = *(const u32x2*)src, hi = *(const u32x2*)(src + 16);
              Pg[as * 64 + ln] = (u32x4){lo.x, lo.y, hi.x, hi.y}; }
            if (latent) {
                u32x4* Wg = (u32x4*)(p.ws + OFF_WYT) + ((size_t)((c - 4) * 8 + h) * 2 + dir) * 512;
                const int row = tid >> 3, ck = tid & 7; Wg[tid] = *(const u32x4*)(M + 6 * MSZ + row * MP + ck * 8);
            }
        }
        if (grp == 0) {
            f32x16 acc = mm32<true, true>(M + 7 * MSZ, xq, sVT, yq, zero16(), lane);
            store_acc(M + 12 * MSZ, xq, yq, acc, lane, [](float v, int, int) { return v; });
        } else {
            f32x16 acc = mm32<true, true>(M + 9 * MSZ, xq, sVT, yq, zero16(), lane);
            store_acc(M + 13 * MSZ, xq, yq, acc, lane, [](float v, int, int) { return v; });
        }
        __syncthreads();
        {
            u32x2* Qg = (u32x2*)(p.ws + OFF_Q) + ((size_t)chain * NCH + npos) * 1024;
#pragma unroll
            for (int i = 0; i < 2; ++i) {
                const int item = tid + NTH * i, ln = item & 63, wa = item >> 6, wi = wa >> 2, a = wa & 3, fr = ln & 15, fq = ln >> 4;
                Qg[item] = *(const u32x2*)(M + 12 * MSZ + (16 * wi + fr) * MP + 16 * a + 4 * fq);
            }
            if (latent) {
                u32x2* Yg = (u32x2*)(p.ws + OFF_YL) + ((size_t)((c - 4) * 8 + h) * 2 + dir) * 1024;
#pragma unroll
                for (int i = 0; i < 2; ++i) {
                    const int item = tid + NTH * i, ln = item & 63, wn = item >> 6, wt = wn >> 2, ni = wn & 3, fr = ln & 15, fq = ln >> 4;
                    const bf16_t* row = M + 13 * MSZ + (16 * ni + fr) * MP;
                    u32x2 v;
                    if (dir == 0) v = *(const u32x2*)(row + 16 * wt + 4 * fq);
                    else { const u32x2 r2 = *(const u32x2*)(row + 60 - 16 * wt - 4 * fq); v = (u32x2){rot16(r2.y), rot16(r2.x)}; }
                    Yg[item] = v;
                }
            }
        }
        __syncthreads();
    }
}

#undef SCANA_ISSUE
#undef XOFF
DI int grp_start(int g) { return g * 16 + (g < 4 ? g : 4); }
DI u32x4 packz(const f32x4& a, const f32x4& b) { return (u32x4){pack2(a[0], a[1]), pack2(a[2], a[3]), pack2(b[0], b[1]), pack2(b[2], b[3])}; }
template <int PASS> DI void chain_run(const Params& p, int chain, int g) {
    constexpr int CPF = PASS == 1 ? 2 : 3;
    const int lane = threadIdx.x & 63, w = threadIdx.x >> 6, fr = lane & 15, fq = lane >> 4;
    const int n0 = grp_start(g), n1 = grp_start(g + 1);
    const u32x4* Pg = (const u32x4*)(p.ws + OFF_P) + (size_t)chain * NCH * 512;
    const u32x2* Qg = (const u32x2*)(p.ws + OFF_Q) + (size_t)chain * NCH * 1024;
    u32x4* Zg = (u32x4*)(p.ws + OFF_Z) + (size_t)chain * NCH * 512;
    f32x4* ZG = (f32x4*)(p.ws + OFF_ZG) + ((size_t)(chain * 16 + g) * 4 + w) * 256;
    f32x4 acc[4], accp[4];
#pragma unroll
    for (int a = 0; a < 4; ++a) {
        if (PASS == 3) acc[a] = ZG[a * 64 + lane]; else acc[a] = (f32x4){0, 0, 0, 0};
#pragma unroll
        for (int e = 0; e < 4; ++e) accp[a][e] = (16 * a + 4 * fq + e == 16 * w + fr) ? 1.f : 0.f;
    }
    u32x4 pf[CPF][8]; u32x2 qf[CPF][4];
#pragma unroll
    for (int st = 0; st < CPF; ++st) if (n0 + st < n1) {
#pragma unroll
        for (int i = 0; i < 8; ++i) pf[st][i] = Pg[(size_t)(n0 + st) * 512 + i * 64 + lane];
#pragma unroll
        for (int a = 0; a < 4; ++a) qf[st][a] = Qg[(size_t)(n0 + st) * 1024 + (w * 4 + a) * 64 + lane];
    }
    for (int nb = n0; nb < n1; nb += CPF) {
#pragma unroll
        for (int st = 0; st < CPF; ++st) {
            const int n = nb + st;
            if (n < n1) {
                u32x4 pc[8]; u32x2 qc[4];
#pragma unroll
                for (int i = 0; i < 8; ++i) pc[i] = pf[st][i];
#pragma unroll
                for (int a = 0; a < 4; ++a) qc[a] = qf[st][a];
                if (n + CPF < n1) {
#pragma unroll
                    for (int i = 0; i < 8; ++i) pf[st][i] = Pg[(size_t)(n + CPF) * 512 + i * 64 + lane];
#pragma unroll
                    for (int a = 0; a < 4; ++a) qf[st][a] = Qg[(size_t)(n + CPF) * 1024 + (w * 4 + a) * 64 + lane];
                }
                const u32x4 z0 = packz(acc[0], acc[1]), z1 = packz(acc[2], acc[3]);
                if (PASS == 3) { Zg[((size_t)n * 4 + w) * 128 + lane] = z0; Zg[((size_t)n * 4 + w) * 128 + 64 + lane] = z1; }
                const bf16x8 zb0 = __builtin_bit_cast(bf16x8, z0), zb1 = __builtin_bit_cast(bf16x8, z1);
#pragma unroll
                for (int a = 0; a < 4; ++a) {
                    f32x4 ini = {bflo(qc[a].x), bfhi(qc[a].x), bflo(qc[a].y), bfhi(qc[a].y)};
                    ini = __builtin_amdgcn_mfma_f32_16x16x32_bf16(__builtin_bit_cast(bf16x8, pc[2 * a]), zb0, ini, 0, 0, 0);
                    acc[a] = __builtin_amdgcn_mfma_f32_16x16x32_bf16(__builtin_bit_cast(bf16x8, pc[2 * a + 1]), zb1, ini, 0, 0, 0);
                }
                if (PASS == 1) {
                    const bf16x8 yb0 = __builtin_bit_cast(bf16x8, packz(accp[0], accp[1])), yb1 = __builtin_bit_cast(bf16x8, packz(accp[2], accp[3]));
#pragma unroll
                    for (int a = 0; a < 4; ++a) {
                        f32x4 t4 = __builtin_amdgcn_mfma_f32_16x16x32_bf16(__builtin_bit_cast(bf16x8, pc[2 * a]), yb0, (f32x4){0, 0, 0, 0}, 0, 0, 0);
                        accp[a] = __builtin_amdgcn_mfma_f32_16x16x32_bf16(__builtin_bit_cast(bf16x8, pc[2 * a + 1]), yb1, t4, 0, 0, 0);
                    }
                }
            }
        }
    }
    if (PASS == 1) {
        f32x4* CQ = (f32x4*)(p.ws + OFF_CQ) + ((size_t)(chain * 16 + g) * 4 + w) * 256;
        bf16_t* CP = (bf16_t*)(p.ws + OFF_CP) + (size_t)(chain * 16 + g) * 4096;
#pragma unroll
        for (int a = 0; a < 4; ++a) {
            CQ[a * 64 + lane] = acc[a];
#pragma unroll
            for (int e = 0; e < 4; ++e) CP[(16 * a + 4 * fq + e) * 64 + 16 * w + fr] = (bf16_t)(pack2(accp[a][e], 0.f) & 0xffffu);
        }
    }
}
DI void chain_groups(const Params& p, int chain, char* lds) {
    const int tid = threadIdx.x, lane = tid & 63, w = tid >> 6, fr = lane & 15, fq = lane >> 4;
    {
        const char* src = (const char*)(p.ws + OFF_CP) + (size_t)chain * 16 * 8192;
#pragma unroll
        for (int i = 0; i < 16; ++i) glds16(src + (size_t)(i * NTH + tid) * 16, lds + (i * NTH + tid) * 16);
        asm volatile("s_waitcnt vmcnt(0)" ::: "memory");
        __syncthreads();
    }
    if (w >= 4) return;
    constexpr int QPF = 4;
    f32x4 acc[4], qf[QPF][4];
#pragma unroll
    for (int a = 0; a < 4; ++a) acc[a] = (f32x4){0, 0, 0, 0};
    const f32x4* CQ = (const f32x4*)(p.ws + OFF_CQ) + ((size_t)chain * 16 * 4 + w) * 256;
#pragma unroll
    for (int st = 0; st < QPF; ++st)
#pragma unroll
        for (int a = 0; a < 4; ++a) qf[st][a] = CQ[(size_t)st * 1024 + a * 64 + lane];
    for (int gb = 0; gb < 16; gb += QPF) {
#pragma unroll
        for (int st = 0; st < QPF; ++st) {
            const int g = gb + st;
            f32x4 qc[4];
#pragma unroll
            for (int a = 0; a < 4; ++a) qc[a] = qf[st][a];
            if (g + QPF < 16) {
#pragma unroll
                for (int a = 0; a < 4; ++a) qf[st][a] = CQ[(size_t)(g + QPF) * 1024 + a * 64 + lane];
            }
            f32x4* ZG = (f32x4*)(p.ws + OFF_ZG) + ((size_t)(chain * 16 + g) * 4 + w) * 256;
#pragma unroll
            for (int a = 0; a < 4; ++a) ZG[a * 64 + lane] = acc[a];
            const bf16x8 zb0 = __builtin_bit_cast(bf16x8, packz(acc[0], acc[1])), zb1 = __builtin_bit_cast(bf16x8, packz(acc[2], acc[3]));
            const bf16_t* CP = (const bf16_t*)lds + g * 4096;
#pragma unroll
            for (int a = 0; a < 4; ++a) {
                const bf16_t* s0 = CP + (16 * a + fr) * 64 + 4 * fq;
                const u32x2 l0 = *(const u32x2*)s0, h0 = *(const u32x2*)(s0 + 16), l1 = *(const u32x2*)(s0 + 32), h1 = *(const u32x2*)(s0 + 48);
                f32x4 ini = __builtin_amdgcn_mfma_f32_16x16x32_bf16(__builtin_bit_cast(bf16x8, (u32x4){l0.x, l0.y, h0.x, h0.y}), zb0, qc[a], 0, 0, 0);
                acc[a] = __builtin_amdgcn_mfma_f32_16x16x32_bf16(__builtin_bit_cast(bf16x8, (u32x4){l1.x, l1.y, h1.x, h1.y}), zb1, ini, 0, 0, 0);
            }
        }
    }
}

DI void phase_scanC(const Params& p, int bid, int nblk, char* lds) {
    const int lane = threadIdx.x & 63, w8 = threadIdx.x >> 6, w = w8 & 3, fr = lane & 15, fq = lane >> 4;
    bf16_t* mix = (bf16_t*)(p.ws + OFF_MIX);
    const float* dot = (const float*)(p.ws + OFF_DOT);
    for (int unit = bid * 2 + (w8 >> 2); unit < 256 * 8; unit += nblk * 2) {
        const int c = 4 + (unit >> 3), h = unit & 7;
        f32x4 y[4];
#pragma unroll
        for (int ni = 0; ni < 4; ++ni) y[ni] = (f32x4){0, 0, 0, 0};
#pragma unroll
        for (int dir = 0; dir < 2; ++dir) {
            const int chain = dir * 8 + h, npos = chain_pos(c, dir);
            const u32x4* Zg = (const u32x4*)(p.ws + OFF_Z) + ((size_t)chain * NCH + npos) * 512;
            const bf16_t* Wg = (const bf16_t*)(p.ws + OFF_WYT) + ((size_t)((c - 4) * 8 + h) * 2 + dir) * 4096;
            const u32x2* Yg = (const u32x2*)(p.ws + OFF_YL) + ((size_t)((c - 4) * 8 + h) * 2 + dir) * 1024;
            const int rho = 16 * w + fr, row = dir ? 63 - rho : rho;
            bf16x8 af[2];
#pragma unroll
            for (int s2 = 0; s2 < 2; ++s2) {
                const u32x2 lo = *(const u32x2*)(Wg + row * 64 + 32 * s2 + 4 * fq), hi = *(const u32x2*)(Wg + row * 64 + 32 * s2 + 16 + 4 * fq);
                af[s2] = __builtin_bit_cast(bf16x8, (u32x4){lo.x, lo.y, hi.x, hi.y});
            }
#pragma unroll
            for (int ni = 0; ni < 4; ++ni) {
                const u32x2 yl = Yg[(w * 4 + ni) * 64 + lane];
                f32x4 acc = {bflo(yl.x), bfhi(yl.x), bflo(yl.y), bfhi(yl.y)};
                acc = __builtin_amdgcn_mfma_f32_16x16x32_bf16(af[0], __builtin_bit_cast(bf16x8, Zg[(ni * 2 + 0) * 64 + lane]), acc, 0, 0, 0);
                acc = __builtin_amdgcn_mfma_f32_16x16x32_bf16(af[1], __builtin_bit_cast(bf16x8, Zg[(ni * 2 + 1) * 64 + lane]), acc, 0, 0, 0);
                y[ni] += acc;
            }
        }
        float* ty = (float*)lds + w8 * (16 * 68);
#pragma unroll
        for (int ni = 0; ni < 4; ++ni)
#pragma unroll
            for (int e = 0; e < 4; ++e) ty[(4 * fq + e) * 68 + 16 * ni + fr] = y[ni][e];
        asm volatile("s_waitcnt lgkmcnt(0)" ::: "memory"); __builtin_amdgcn_wave_barrier();
        {
            const int tl = lane >> 2, seg = lane & 3, t = (c - 4) * 64 + 16 * w + tl, g = t + CTX, cch = h * 64 + 16 * seg;
            float yv[16];
#pragma unroll
            for (int q = 0; q < 4; ++q) { const f32x4 v4 = *(const f32x4*)(ty + tl * 68 + 16 * seg + 4 * q); yv[4 * q] = v4[0]; yv[4 * q + 1] = v4[1]; yv[4 * q + 2] = v4[2]; yv[4 * q + 3] = v4[3]; }
            float sm = 0.f;
#pragma unroll
            for (int j = 0; j < 16; ++j) sm += yv[j];
            sm += __shfl_xor(sm, 1, 64); sm += __shfl_xor(sm, 2, 64);
            const float mean = sm * (1.f / 64.f);
            float q2 = 0.f;
#pragma unroll
            for (int j = 0; j < 16; ++j) { const float d = yv[j] - mean; q2 += d * d; }
            q2 += __shfl_xor(q2, 1, 64); q2 += __shfl_xor(q2, 2, 64);
            const float rs = rsqrtf(q2 * (1.f / 64.f) + 64e-5f);
            const float bon = dot[((size_t)g * 8 + h) * 2] + dot[((size_t)g * 8 + h) * 2 + 1];
            float vv[16], gg[16], o[16];
            unpack8(*(const u32x4*)((const bf16_t*)(p.ws + OFF_V) + (size_t)t * DR + cch), vv); unpack8(*(const u32x4*)((const bf16_t*)(p.ws + OFF_V) + (size_t)t * DR + cch + 8), vv + 8);
            unpack8(*(const u32x4*)((const bf16_t*)(p.ws + OFF_G) + (size_t)t * DR + cch), gg); unpack8(*(const u32x4*)((const bf16_t*)(p.ws + OFF_G) + (size_t)t * DR + cch + 8), gg + 8);
#pragma unroll
            for (int q = 0; q < 4; ++q) {
                const f32x4 gw = *(const f32x4*)(p.gn_w + cch + 4 * q), gb = *(const f32x4*)(p.gn_b + cch + 4 * q);
#pragma unroll
                for (int j = 0; j < 4; ++j) o[4 * q + j] = ((yv[4 * q + j] - mean) * rs * gw[j] + gb[j] + bon * vv[4 * q + j]) * gg[4 * q + j];
            }
            *(u32x4*)(mix + (size_t)t * D + cch) = pack8(o); *(u32x4*)(mix + (size_t)t * D + cch + 8) = pack8(o + 8);
        }
        __builtin_amdgcn_wave_barrier();
    }
}

struct EpiX2 { float* o; const float* x; const float* gt; const float* rowtab; const float* coltab; int row0, col0;
    DI f32x16 pre(const f32x16& a, const f32x16&) const { return a; }
    DI void post(int r, int c, const f32x4& v) const {
        const int t = row0 + r, d = col0 + c;
        const float* pt = d < 512 ? rowtab + (t >> 6) * 512 + d : coltab + (t & 63) * 512 + (d - 512);
        const f32x4 xv = *(const f32x4*)(x + (size_t)t * D + d), pv = *(const f32x4*)pt, gv = *(const f32x4*)(gt + d);
        *(f32x4*)(o + (size_t)t * D + d) = xv + pv + gv * v; } };
struct EpiNull { DI f32x16 pre(const f32x16& a, const f32x16&) const { return a; } DI void post(int, int, const f32x4& v) const { asm volatile("" :: "v"(v)); } };
DI void phase_g2_null(const Params& p, int bid, int nblk, char* lds) {
    const bf16_t* mix = (const bf16_t*)(p.ws + OFF_MIX);
    const XcdOrder ord(bid, nblk, 64 * 4);
    for (int i = 0, q; (q = ord.item(i)) >= 0; ++i) {
        int tm, tn; tile_rc(q, 64, 4, tm, tn);
        PlainA al{mix + (size_t)tm * 256 * D, D};
        EpiNull e;
        gemm8<1, true, 2>(al, (const bf16_t*)(p.ws + OFF_WOUTB) + tn * 256, nullptr, D, D, lds, e);
    }
}
DI void phase_g2(const Params& p, int bid, int nblk, char* lds) {
    const bf16_t* mix = (const bf16_t*)(p.ws + OFF_MIX);
    const XcdOrder ord(bid, nblk, 64 * 4);
    for (int i = 0, q; (q = ord.item(i)) >= 0; ++i) {
        int tm, tn; tile_rc(q, 64, 4, tm, tn);
        PlainA al{mix + (size_t)tm * 256 * D, D};
        EpiX2 e{(float*)(p.ws + OFF_X2), p.x, (const float*)(p.ws + OFF_MODX) + 2048, (const float*)(p.ws + OFF_ROWTAB), (const float*)(p.ws + OFF_COLTAB), tm * 256, tn * 256};
        gemm8<1, true, 2>(al, (const bf16_t*)(p.ws + OFF_WOUTB) + tn * 256, nullptr, D, D, lds, e);
    }
}

DI float router_w(const Params& p, int k, int n) { return n < 4 ? p.w_rg[k * 4 + n] : (n < 36 ? p.w_re[k * 32 + (n - 4)] : 0.f); }
DI void phase_router_prep(const Params& p, int bid, int nblk) {
    const float* modx = (const float*)(p.ws + OFF_MODX);
    float* wp = (float*)(p.ws + OFF_WP); float* b2 = (float*)(p.ws + OFF_B2);
    for (int idx = bid * NTH + threadIdx.x; idx < 64 * 4 * 3 * 64; idx += nblk * NTH) {
        const int ln = idx & 63, r = idx >> 6, nt = r % 3, me = r / 3, e = me & 3, m = me >> 2;
        const int k = 16 * m + 4 * (ln >> 4) + e, n = 16 * nt + (ln & 15);
        wp[idx] = p.norm2_g[k] * (1.f + modx[4096 + k]) * router_w(p, k, n);
    }
    const int lane = threadIdx.x & 63, wv = bid * NWV + (threadIdx.x >> 6);
    if (wv < 36) {
        float sacc = 0.f;
        for (int k = lane; k < D; k += 64) sacc += modx[3072 + k] * router_w(p, k, wv);
        sacc = wave_sum(sacc);
        if (lane == 0) b2[wv] = sacc + (wv < 4 ? p.b_rg[wv] : p.b_re[wv - 4]);
    }
}

DI void phase_router(const Params& p, int bid, int nblk, char* lds, bool dry = false) {
    const int lane = threadIdx.x & 63, wid = threadIdx.x >> 6, tr = lane & 15, kq = lane >> 4;
    const float* x2 = (const float*)(p.ws + OFF_X2); const float* modx = (const float*)(p.ws + OFF_MODX);
    const float* wp = (const float*)(p.ws + OFF_WP); const float* b2 = (const float*)(p.ws + OFF_B2);
    bf16_t* h2 = (bf16_t*)(p.ws + OFF_H2); int* cnt = (int*)(p.ws + OFF_CNT); float* gate = (float*)(p.ws + OFF_GATE); int* list = (int*)(p.ws + OFF_LIST);
    float* slog = (float*)lds + wid * (16 * 49);
    for (int task = wid * nblk + bid; task < S / 16; task += nblk * NWV) {
        const int t0 = task * 16;
        const float* xr = x2 + (size_t)(t0 + tr) * D + 4 * kq;
        f32x4 acc[3];
#pragma unroll
        for (int i = 0; i < 3; ++i) acc[i] = (f32x4){0, 0, 0, 0};
        float ss = 0.f;
#pragma unroll 4
        for (int m = 0; m < 64; ++m) {
            const f32x4 xv = *(const f32x4*)(xr + 16 * m);
            ss += xv[0] * xv[0] + xv[1] * xv[1] + xv[2] * xv[2] + xv[3] * xv[3];
#pragma unroll
            for (int e = 0; e < 4; ++e)
#pragma unroll
                for (int nt = 0; nt < 3; ++nt) acc[nt] = __builtin_amdgcn_mfma_f32_16x16x4f32(xv[e], wp[((m * 4 + e) * 3 + nt) * 64 + lane], acc[nt], 0, 0, 0);
        }
        ss += __shfl_xor(ss, 16, 64); ss += __shfl_xor(ss, 32, 64);
        const float rstd = rsqrtf(ss * (1.f / 1024.f) + 1e-6f);
#pragma unroll
        for (int nt = 0; nt < 3; ++nt)
#pragma unroll
            for (int r = 0; r < 4; ++r) slog[(4 * kq + r) * 49 + 16 * nt + tr] = acc[nt][r];
        asm volatile("s_waitcnt lgkmcnt(0)" ::: "memory"); __builtin_amdgcn_wave_barrier();
        if (lane < 16) {
            const int t = t0 + lane;
            const float* lg = slog + lane * 49;
            const float l0 = rstd * lg[0] + b2[0], l1 = rstd * lg[1] + b2[1], l2 = rstd * lg[2] + b2[2], l3 = rstd * lg[3] + b2[3];
            int grp = 0; float mx = l0;
            if (l1 > mx) { mx = l1; grp = 1; }
            if (l2 > mx) { mx = l2; grp = 2; }
            if (l3 > mx) { mx = l3; grp = 3; }
            const float den = __expf(l0 - mx) + __expf(l1 - mx) + __expf(l2 - mx) + __expf(l3 - mx);
            const float pgrp = 1.f / den;
            int i1 = 0, i2 = -1; float v1 = -3.0e38f, v2 = -3.0e38f;
            for (int n = 0; n < 8; ++n) {
                const float sv = rstd * lg[4 + grp * 8 + n] + b2[4 + grp * 8 + n];
                if (sv > v1) { v2 = v1; i2 = i1; v1 = sv; i1 = n; } else if (sv > v2) { v2 = sv; i2 = n; }
            }
            const float e2 = __expf(v2 - v1), g1 = pgrp / (1.f + e2), g2v = pgrp * e2 / (1.f + e2);
            const int ea = grp * 8 + i1, eb = grp * 8 + i2;
            if (!dry) {
                const int pa = atomicAdd(&cnt[ea], 1), pb = atomicAdd(&cnt[eb], 1);
                list[ea * LCAP + pa] = t * 2; list[eb * LCAP + pb] = t * 2 + 1;
            }
            gate[t * 2] = g1; gate[t * 2 + 1] = g2v;
        }
        for (int r = 0; r < 16; ++r) {
            const float rs = __shfl(rstd, r, 64);
            const float* src = x2 + (size_t)(t0 + r) * D;
#pragma unroll
            for (int i = 0; i < 4; ++i) {
                const int d = (i * 64 + lane) * 4;
                const f32x4 v = *(const f32x4*)(src + d), gg = *(const f32x4*)(p.norm2_g + d), sh = *(const f32x4*)(modx + 3072 + d), sc = *(const f32x4*)(modx + 4096 + d);
                f32x4 hv;
#pragma unroll
                for (int j = 0; j < 4; ++j) hv[j] = (v[j] * rs * gg[j]) * (1.f + sc[j]) + sh[j];
                u32x2 pk = {pack2(hv[0], hv[1]), pack2(hv[2], hv[3])};
                *(u32x2*)(h2 + (size_t)(t0 + r) * D + d) = pk;
            }
        }
        __builtin_amdgcn_wave_barrier();
    }
}

DI void moe_tiles(const int* cnt, int* tstart  ) {
    if (threadIdx.x == 0) { int acc = 0; for (int e = 0; e < NE; ++e) { tstart[e] = acc; acc += (cnt[e] + 255) >> 8; } tstart[NE] = acc; }
    __syncthreads();
}
struct EpiHid { bf16_t* o;
    DI f32x16 pre(const f32x16& g, const f32x16& u) const { f32x16 h;
#pragma unroll
        for (int j = 0; j < 16; ++j) h[j] = g[j] * sigmoidf_(g[j]) * u[j];
        return h; }
    DI void post(int r, int c, const f32x4& v) const { u32x2 pk = {pack2(v[0], v[1]), pack2(v[2], v[3])}; *(u32x2*)(o + (size_t)r * DE + c) = pk; } };
DI void phase_g3(const Params& p, int bid, int nblk, char* lds) {
    int* tstart = (int*)(lds + GEMM_LDS);
    const int* cnt = (const int*)(p.ws + OFF_CNT); const int* list = (const int*)(p.ws + OFF_LIST);
    const bf16_t* h2 = (const bf16_t*)(p.ws + OFF_H2); bf16_t* hid = (bf16_t*)(p.ws + OFF_HID);
    moe_tiles(cnt, tstart);
    const int ntiles = tstart[NE];
    const int nitems = ntiles * 4, nfull = (nitems / nblk) * nblk, nhalf = 2 * (nitems - nfull);
    const XcdOrder ord(bid, nblk, nfull);
    for (int i = 0, item; (item = ord.item(i)) >= 0; ++i) {
        const int ti = item >> 2, cj = item & 3;
        int e = 0; while (e < NE - 1 && tstart[e + 1] <= ti) ++e;
        const int lt = ti - tstart[e], ne = cnt[e];
        GatherA al;
#pragma unroll
        for (int i2 = 0; i2 < 4; ++i2) { const int row = (8 * i2 + (threadIdx.x >> 6)) * 8 + ((threadIdx.x & 63) >> 3), pos = lt * 256 + row; const int tok = pos < ne ? (list[e * LCAP + pos] >> 1) : 0; al.rp[i2] = h2 + (size_t)tok * D; }
        EpiHid epi{hid + (size_t)ti * 256 * DE + cj * 128};
        gemm8<2, false, 1>(al, p.w_gate + (size_t)e * D * DE + cj * 128, p.w_up + (size_t)e * D * DE + cj * 128, DE, D, lds, epi);
    }
    for (int n = bid; n < nhalf; n += nblk) {
        const int item = nfull + (n >> 1), hf = n & 1, ti = item >> 2, cj = item & 3;
        int e = 0; while (e < NE - 1 && tstart[e + 1] <= ti) ++e;
        const int lt = ti - tstart[e], ne = cnt[e];
        GatherA al;
#pragma unroll
        for (int i2 = 0; i2 < 2; ++i2) { const int row = hf * 128 + (8 * i2 + (threadIdx.x >> 6)) * 8 + ((threadIdx.x & 63) >> 3), pos = lt * 256 + row; const int tok = pos < ne ? (list[e * LCAP + pos] >> 1) : 0; al.rp[i2] = h2 + (size_t)tok * D; }
        al.rp[2] = al.rp[0]; al.rp[3] = al.rp[1];
        EpiHid epi{hid + ((size_t)ti * 256 + hf * 128) * DE + cj * 128};
        gemm8<2, false, 1, GatherA, EpiHid, 2>(al, p.w_gate + (size_t)e * D * DE + cj * 128, p.w_up + (size_t)e * D * DE + cj * 128, DE, D, lds, epi);
    }
}
struct EpiDown { bf16_t* ybuf; const int* stab; const float* gtab; int col0;
    DI f32x16 pre(const f32x16& a, const f32x16&) const { return a; }
    DI void post(int r, int c, const f32x4& v) const {
        const int slot = stab[r]; if (slot < 0) return; const float g = gtab[r];
        u32x2 pk = {pack2(v[0] * g, v[1] * g), pack2(v[2] * g, v[3] * g)}; *(u32x2*)(ybuf + (size_t)slot * D + col0 + c) = pk; } };
DI void phase_g4(const Params& p, int bid, int nblk, char* lds) {
    int* tstart = (int*)(lds + GEMM_LDS);
    int* stab = (int*)(lds + GEMM_LDS + 256); float* gtab = (float*)(lds + GEMM_LDS + 256 + 1024);
    const int* cnt = (const int*)(p.ws + OFF_CNT); const int* list = (const int*)(p.ws + OFF_LIST); const float* gate = (const float*)(p.ws + OFF_GATE);
    const bf16_t* hid = (const bf16_t*)(p.ws + OFF_HID);
    moe_tiles(cnt, tstart);
    const int ntiles = tstart[NE];
    const XcdOrder ord(bid, nblk, ntiles * 8);
    for (int i = 0, item; (item = ord.item(i)) >= 0; ++i) {
        const int ti = item >> 3, cj = item & 7;
        int e = 0; while (e < NE - 1 && tstart[e + 1] <= ti) ++e;
        const int lt = ti - tstart[e], ne = cnt[e];
        if (threadIdx.x < 256) {
            const int pos = lt * 256 + threadIdx.x; const int slot = pos < ne ? list[e * LCAP + pos] : -1;
            stab[threadIdx.x] = slot; gtab[threadIdx.x] = slot >= 0 ? gate[slot] : 0.f;
        }
        PlainA al{hid + (size_t)ti * 256 * DE, DE};
        EpiDown epi{(bf16_t*)(p.ws + OFF_YBUF), stab, gtab, cj * 128};
        gemm8<1, false, 1>(al, p.w_down + (size_t)e * DE * D + cj * 128, nullptr, D, DE, lds, epi);
    }
}

DI void phase_final(const Params& p, int bid, int nblk) {
    const int lane = threadIdx.x & 63, wid = threadIdx.x >> 6;
    const float* x2 = (const float*)(p.ws + OFF_X2); const float* gt = (const float*)(p.ws + OFF_MODX) + 5120; const bf16_t* yb = (const bf16_t*)(p.ws + OFF_YBUF);
    for (int tp = bid * NWV + wid; tp < S / 2; tp += nblk * NWV) {
        f32x4 v[2][4]; float ss[2] = {0.f, 0.f};
        u32x2 ya[2][4], ybv[2][4];
#pragma unroll
        for (int r = 0; r < 2; ++r)
#pragma unroll
            for (int i = 0; i < 4; ++i) {
                const int t = 2 * tp + r, d = (i * 64 + lane) * 4;
                v[r][i] = *(const f32x4*)(x2 + (size_t)t * D + d);
                ya[r][i] = *(const u32x2*)(yb + (size_t)(2 * t) * D + d); ybv[r][i] = *(const u32x2*)(yb + (size_t)(2 * t + 1) * D + d);
            }
#pragma unroll
        for (int r = 0; r < 2; ++r)
#pragma unroll
            for (int i = 0; i < 4; ++i) {
                const int d = (i * 64 + lane) * 4; const f32x4 g = *(const f32x4*)(gt + d); const u32x2 a = ya[r][i], b = ybv[r][i];
                v[r][i][0] += g[0] * (bflo(a.x) + bflo(b.x)); v[r][i][1] += g[1] * (bfhi(a.x) + bfhi(b.x));
                v[r][i][2] += g[2] * (bflo(a.y) + bflo(b.y)); v[r][i][3] += g[3] * (bfhi(a.y) + bfhi(b.y));
                ss[r] += v[r][i][0] * v[r][i][0] + v[r][i][1] * v[r][i][1] + v[r][i][2] * v[r][i][2] + v[r][i][3] * v[r][i][3];
            }
#pragma unroll
        for (int r = 0; r < 2; ++r) {
            const float rstd = rsqrtf(wave_sum(ss[r]) * (1.f / 1024.f) + 1e-6f);
#pragma unroll
            for (int i = 0; i < 4; ++i) {
                const int d = (i * 64 + lane) * 4; const f32x4 fg = *(const f32x4*)(p.final_g + d); f32x4 o;
#pragma unroll
                for (int j = 0; j < 4; ++j) o[j] = v[r][i][j] * rstd * fg[j];
                *(f32x4*)(p.out + (size_t)(2 * tp + r) * D + d) = o;
            }
        }
    }
}

#define XB_TMO      128
#define XB_XCNT(j)  (256  + 64 * (j))
#define XB_XSUB(j)  (1280 + 64 * (j))
#define XB_XGEN(j)  (2304 + 64 * (j))
#define XB_TOP      3328
#define XB_TOPGEN   3392
#define XCD_BAR_WORDS 3456
#define XB_SPIN_CAP (1u << 18)
DI unsigned xb_ld(unsigned* p) { return __hip_atomic_load(p, __ATOMIC_RELAXED, __HIP_MEMORY_SCOPE_AGENT); }
DI unsigned xb_add(unsigned* p, unsigned v) { return __hip_atomic_fetch_add(p, v, __ATOMIC_RELAXED, __HIP_MEMORY_SCOPE_AGENT); }
DI unsigned xb_xcc_id() { return (unsigned)__builtin_amdgcn_s_getreg((3 << 11) | 20) & 0xFu; }
#define XB_SPIN(cond, bar) do { unsigned _sp = 0; while (cond) { __builtin_amdgcn_s_sleep(1); \
    if ((++_sp & 255u) == 0u) { if (xb_ld(&(bar)[XB_TMO])) break; if (_sp > XB_SPIN_CAP) { atomicAdd(&(bar)[XB_TMO], 1u); break; } } } } while (0)
struct XcdBarrier { unsigned* bar; unsigned x; volatile LAS unsigned* st; };
DI XcdBarrier xcd_barrier_post(unsigned* bar, volatile LAS unsigned* st) {
    XcdBarrier b; b.bar = bar; b.x = xb_xcc_id(); b.st = st;
    if (threadIdx.x == 0) (void)xb_add(&bar[XB_XCNT(b.x)], 1u);
    return b;
}
DI void xcd_barrier_complete(unsigned* bar, unsigned x, unsigned& nloc, unsigned& nx) {
    const unsigned G = gridDim.x * gridDim.y * gridDim.z;
    unsigned sum, cnt, mine, sp = 0u;
    for (;;) {
        sum = 0u; cnt = 0u; mine = 0u;
#pragma unroll
        for (unsigned j = 0; j < 16; ++j) { const unsigned c = xb_ld(&bar[XB_XCNT(j)]); sum += c; cnt += (c > 0u) ? 1u : 0u; mine = (j == x) ? c : mine; }
        if (sum == G) break;
        __builtin_amdgcn_s_sleep(1);
        if ((++sp & 255u) == 0u) { if (xb_ld(&bar[XB_TMO])) break; if (sp > XB_SPIN_CAP) { atomicAdd(&bar[XB_TMO], 1u); break; } }
    }
    nloc = mine > 0u ? mine : 1u; nx = cnt > 0u ? cnt : 1u;
}
DI void xcd_barrier(const XcdBarrier& b) {
    asm volatile("s_waitcnt vmcnt(0)" ::: "memory");
    __syncthreads();
    if (threadIdx.x == 0) {
        unsigned* bar = b.bar;
        __builtin_amdgcn_s_waitcnt(0);
        unsigned nloc = b.st[0], nx = b.st[1];
        if (nloc == 0u) { xcd_barrier_complete(bar, b.x, nloc, nx); b.st[0] = nloc; b.st[1] = nx; }
        const unsigned old = xb_add(&bar[XB_XSUB(b.x)], 1u);
        const unsigned gen = old / nloc;
        if (old + 1u == (gen + 1u) * nloc) {
            __builtin_amdgcn_fence(__ATOMIC_RELEASE, "agent");
            asm volatile("s_waitcnt vmcnt(0)" ::: "memory");
            const unsigned og = xb_add(&bar[XB_TOP], 1u);
            const unsigned tg = og / nx;
            if (og + 1u == (tg + 1u) * nx) xb_add(&bar[XB_TOPGEN], 1u);
            else XB_SPIN(xb_ld(&bar[XB_TOPGEN]) == tg, bar);
            __builtin_amdgcn_fence(__ATOMIC_ACQUIRE, "agent");
            xb_add(&bar[XB_XGEN(b.x)], 1u);
            asm volatile("s_waitcnt vmcnt(0)" ::: "memory");
        } else {
            XB_SPIN(xb_ld(&bar[XB_XGEN(b.x)]) == gen, bar);
            __builtin_amdgcn_fence(__ATOMIC_ACQUIRE, "agent");
            asm volatile("s_waitcnt vmcnt(0)" ::: "memory");
        }
    }
    __syncthreads();
}

#ifndef PROBE
#define PROBE 0
#endif
constexpr int MEGA_LDS = SCANA_LDS > (GEMM_LDS + 256) ? SCANA_LDS : (GEMM_LDS + 256);
__global__ void __launch_bounds__(NTH) k_mega(Params p) {
    extern __shared__ __attribute__((aligned(16))) char lds[];
    const int bid = blockIdx.x, nblk = gridDim.x;
    volatile LAS unsigned* st = (volatile LAS unsigned*)(lds + MEGA_LDS);
    if (threadIdx.x < 4) st[threadIdx.x] = 0u;
    __syncthreads();
    const XcdBarrier gb = xcd_barrier_post((unsigned*)(p.ws + OFF_BAR), st);
#define GSYNC() xcd_barrier(gb)
    phase_p0(p, bid, nblk, lds); GSYNC();
    if (PROBE == 1) { phase_p0(p, bid, nblk, lds); GSYNC(); }
    phase_xn(p, bid, nblk); phase_router_prep(p, bid, nblk); GSYNC();
    if (PROBE == 2) { phase_xn(p, bid, nblk); GSYNC(); }
    phase_g1(p, bid, nblk, lds); GSYNC();
    if (PROBE == 3) { phase_g1(p, bid, nblk, lds); GSYNC(); }
    phase_pool(p, bid, nblk);
    phase_scanA(p, bid, nblk, lds); GSYNC();
    if (PROBE == 4) { phase_scanA(p, bid, nblk, lds); GSYNC(); }
    if (PROBE == 15) { phase_pool(p, bid, nblk); GSYNC(); }
    if (PROBE == 16) { GSYNC(); GSYNC(); GSYNC(); GSYNC(); }
    if (threadIdx.x < 256) for (int it = bid; it < 256; it += nblk) chain_run<1>(p, it >> 4, it & 15);
    GSYNC();
    if (PROBE == 5) { if (threadIdx.x < 256) for (int it = bid; it < 256; it += nblk) chain_run<1>(p, it >> 4, it & 15); GSYNC(); }
    if (bid < 16) chain_groups(p, bid, lds); else phase_poolgemm(p, bid - 16, nblk - 16, lds);
    GSYNC();
    if (PROBE == 6) { if (bid < 16) chain_groups(p, bid, lds); GSYNC(); }
    if (threadIdx.x < 256) for (int it = bid; it < 256; it += nblk) chain_run<3>(p, it >> 4, it & 15);
    GSYNC();
    if (PROBE == 7) { if (threadIdx.x < 256) for (int it = bid; it < 256; it += nblk) chain_run<3>(p, it >> 4, it & 15); GSYNC(); }
    phase_scanC(p, bid, nblk, lds); GSYNC();
    if (PROBE == 8) { phase_scanC(p, bid, nblk, lds); GSYNC(); }
    phase_g2(p, bid, nblk, lds); GSYNC();
    if (PROBE == 9) { phase_g2(p, bid, nblk, lds); GSYNC(); }
    if (PROBE == 14) { phase_g2_null(p, bid, nblk, lds); GSYNC(); }
    if (PROBE == 10) { phase_router(p, bid, nblk, lds, true); GSYNC(); }
    phase_router(p, bid, nblk, lds); GSYNC();
    phase_g3(p, bid, nblk, lds); GSYNC();
    if (PROBE == 11) { phase_g3(p, bid, nblk, lds); GSYNC(); }
    phase_g4(p, bid, nblk, lds); GSYNC();
    if (PROBE == 12) { phase_g4(p, bid, nblk, lds); GSYNC(); }
    if (PROBE == 13) { phase_final(p, bid, nblk); GSYNC(); }
    phase_final(p, bid, nblk);
}

extern "C" void kernel_launch(void* const* d_in, const int* in_sizes, int n_in, void* d_out, int out_size, void* d_ws, size_t ws_size, hipStream_t stream) {
    if (ws_size < WS_NEED) { fprintf(stderr, "workspace too small: %zu < %zu\n", ws_size, (size_t)WS_NEED); return; }
    Params p{};
    const float** f = (const float**)&p;
    for (int i = 0; i < 36; ++i) f[i] = (const float*)d_in[i];
    p.out = (float*)d_out; p.ws = (char*)d_ws;
    static int grid_blocks = 0;
    if (!grid_blocks) {
        (void)hipFuncSetAttribute((const void*)k_mega, hipFuncAttributeMaxDynamicSharedMemorySize, MEGA_LDS + 16);
        int dev = 0, cus = 0, per_cu = 0;
        (void)hipGetDevice(&dev);
        (void)hipDeviceGetAttribute(&cus, hipDeviceAttributeMultiprocessorCount, dev);
        (void)hipOccupancyMaxActiveBlocksPerMultiprocessor(&per_cu, k_mega, NTH, MEGA_LDS + 16);
        if (per_cu > 1) per_cu = 1;
        grid_blocks = cus * per_cu;
    }
    (void)hipMemsetAsync((char*)d_ws + OFF_BAR, 0, 16384, stream);
    void* args[] = {&p};
    hipError_t e = hipLaunchCooperativeKernel((const void*)k_mega, dim3(grid_blocks), dim3(NTH), args, MEGA_LDS + 16, stream);
    if (e != hipSuccess) fprintf(stderr, "cooperative launch failed: %s (grid %d)\n", hipGetErrorString(e), grid_blocks);
}
```

```cpp
#include <hip/hip_runtime.h>
#include <stdint.h>
#include <stdio.h>
#include <hip/hip_cooperative_groups.h>
namespace cg = cooperative_groups;

#define DI __device__ __forceinline__
typedef unsigned short bf16_t;
typedef short bf16x8 __attribute__((ext_vector_type(8)));
typedef short s16x4 __attribute__((ext_vector_type(4)));
typedef float f32x4 __attribute__((ext_vector_type(4)));
typedef float f32x2 __attribute__((ext_vector_type(2)));
typedef __bf16 bf16x2_t __attribute__((ext_vector_type(2)));
typedef unsigned u32x4 __attribute__((ext_vector_type(4)));
typedef unsigned u32x2 __attribute__((ext_vector_type(2)));
#define LAS __attribute__((address_space(3)))
#define GAS_ __attribute__((address_space(1)))

constexpr int D = 1024, S = 16384, CTX = 256, NT = S + CTX, DIN = 2432, DSH = 1920, DR = 512;
constexpr int C_WLF = 1536, C_WLB = 1600, C_ALF = 1664, C_ALB = 1728, C_GL = 1792, C_POOL = 1920;
constexpr int NE = 32, DE = 512, LCAP = 32768;
constexpr float DECAY_SCALE = 0.6065306597f;
constexpr int NTH = 512, NWV = 8;

constexpr int NCH = NT / 64;
constexpr size_t SZ_U = (size_t)NT * DIN * 2;
constexpr size_t SZ_CH = (size_t)16 * NCH * 8192;
constexpr size_t OFF_U = 0;
constexpr size_t OFF_XN = OFF_U + SZ_U;
constexpr size_t OFF_P = OFF_XN;
constexpr size_t OFF_Q = OFF_P + SZ_CH;
constexpr size_t OFF_WYT = OFF_Q + SZ_CH;
constexpr size_t OFF_YL = OFF_WYT + (size_t)256 * 16 * 8192;
constexpr size_t OFF_V = OFF_YL + (size_t)256 * 16 * 8192;
constexpr size_t OFF_G = OFF_V + (size_t)S * DR * 2;
constexpr size_t OFF_MIX = OFF_G + (size_t)S * DR * 2;
constexpr size_t OFF_SMALL = OFF_MIX + (size_t)S * D * 2;
constexpr size_t OFF_MODX = OFF_SMALL, OFF_MODC = OFF_MODX + 6144 * 4;
constexpr size_t OFF_ROWTAB = OFF_MODC + 6144 * 4, OFF_COLTAB = OFF_ROWTAB + 256 * 512 * 4;
constexpr size_t OFF_CNT = OFF_COLTAB + 64 * 512 * 4;
constexpr size_t OFF_GATE = OFF_CNT + 256;
constexpr size_t OFF_LIST = OFF_GATE + (size_t)S * 2 * 4;
constexpr size_t OFF_DOT = OFF_LIST + (size_t)NE * LCAP * 4;
constexpr size_t OFF_WP = OFF_DOT + (size_t)NT * 16 * 4;
constexpr size_t OFF_B2 = OFF_WP + 64 * 4 * 3 * 64 * 4;
constexpr size_t OFF_TCNT = OFF_B2 + 256;
constexpr size_t OFF_BAR = OFF_TCNT + 256 * 256;
constexpr size_t OFF_WINB = OFF_BAR + 16384;
constexpr int DINP = 2560;
constexpr size_t OFF_WOUTB = OFF_WINB + (size_t)D * DINP * 2;
constexpr size_t OFF_WOUTT = OFF_WOUTB + (size_t)D * D * 2;
constexpr size_t WS_NEED = OFF_WOUTT + (size_t)D * D * 2;
constexpr size_t OFF_Z = OFF_U;
constexpr size_t OFF_X2 = OFF_P;
constexpr size_t OFF_YBUF = OFF_WYT;
static_assert((size_t)S * 2 * D * 2 <= 2 * SZ_CH, "expert outputs must fit in the P / Q region");
constexpr size_t OFF_H2 = OFF_U;
constexpr size_t OFF_HID = OFF_V;
constexpr size_t OFF_GLIST = OFF_MIX + (size_t)16 * 1024 * 1024;
constexpr size_t OFF_CP = OFF_WINB;
constexpr size_t OFF_CQ = OFF_LIST;
constexpr size_t OFF_ZG = OFF_U + SZ_CH + 256 * 8192 + 256 * 16384;
constexpr size_t OFF_WDB = OFF_ZG + 256 * 16384;
static_assert(OFF_WDB + (size_t)NE * DE * D * 2 <= OFF_U + SZ_U, "w_down copy must fit in the dead tail of u");

struct Params {
    const float *x, *c, *ctx, *c_ctx, *norm1_g, *w_mod, *b_mod, *w_in, *mu, *w0_f, *w2_f, *w0_b, *w2_b, *a0_f, *a2_f, *a0_b, *a2_b,
        *g2, *k_k, *k_a, *r_k_f, *r_k_b, *gn_w, *gn_b, *w_pool, *pool_scale, *w_out, *norm2_g, *w_rg, *b_rg, *w_re, *b_re,
        *w_gate, *w_up, *w_down, *final_g;
    float* out;
    char* ws;
};

DI unsigned pack2(float lo, float hi) { f32x2 v = {lo, hi}; bf16x2_t b = __builtin_convertvector(v, bf16x2_t); return __builtin_bit_cast(unsigned, b); }
DI float bf2f(bf16_t h) { return __uint_as_float(((unsigned)h) << 16); }
DI float bflo(unsigned u) { return __uint_as_float(u << 16); }
DI float bfhi(unsigned u) { return __uint_as_float(u & 0xffff0000u); }
DI void unpack8(const u32x4& p, float* f) { f[0] = bflo(p.x); f[1] = bfhi(p.x); f[2] = bflo(p.y); f[3] = bfhi(p.y); f[4] = bflo(p.z); f[5] = bfhi(p.z); f[6] = bflo(p.w); f[7] = bfhi(p.w); }
DI u32x4 pack8(const float* f) { u32x4 p; p.x = pack2(f[0], f[1]); p.y = pack2(f[2], f[3]); p.z = pack2(f[4], f[5]); p.w = pack2(f[6], f[7]); return p; }
DI u32x4 pack8v(const f32x4& a, const f32x4& b) { return (u32x4){pack2(a[0], a[1]), pack2(a[2], a[3]), pack2(b[0], b[1]), pack2(b[2], b[3])}; }
DI float sigmoidf_(float x) { return __builtin_amdgcn_rcpf(1.f + __expf(-x)); }
DI float wave_sum(float v) {
#pragma unroll
    for (int o = 32; o > 0; o >>= 1) v += __shfl_xor(v, o, 64);
    return v;
}
DI f32x4 wave_sum4(f32x4 v) {
#pragma unroll
    for (int o = 32; o > 0; o >>= 1) { v[0] += __shfl_xor(v[0], o, 64); v[1] += __shfl_xor(v[1], o, 64); v[2] += __shfl_xor(v[2], o, 64); v[3] += __shfl_xor(v[3], o, 64); }
    return v;
}
typedef float f32x16 __attribute__((ext_vector_type(16)));
DI f32x16 zero16() { f32x16 z; for (int i = 0; i < 16; ++i) z[i] = 0.f; return z; }
DI s16x4 tr16(const bf16_t* a) { return __builtin_amdgcn_ds_read_tr16_b64_v4i16((LAS s16x4*)a); }
DI float pos_val(const float* rowtab, const float* coltab, int t, int d) { return d < 512 ? rowtab[(t >> 6) * 512 + d] : coltab[(t & 63) * 512 + (d - 512)]; }

DI void convert_T(const float* __restrict__ src, bf16_t* __restrict__ dst, int K, int N, int task0, int task1, int wv, int nwv, float* tile);
DI void phase_p0(const Params& p, int bid, int nblk, char* lds) {
    const int tid = threadIdx.x;
    float* modx = (float*)(p.ws + OFF_MODX); float* modc = (float*)(p.ws + OFF_MODC);
    float* red = (float*)lds;
    for (int item = bid; item < 192; item += nblk) {
        const int col0 = item * 32, cg = tid & 7, kg = tid >> 3;
        f32x4 ax = {0, 0, 0, 0}, ac = {0, 0, 0, 0};
        f32x4 wv[16];
#pragma unroll
        for (int kk = 0; kk < 16; ++kk) wv[kk] = __builtin_nontemporal_load((const f32x4*)(p.w_mod + (size_t)(kg * 16 + kk) * 6144 + col0 + cg * 4));
#pragma unroll
        for (int kk = 0; kk < 16; ++kk) {
            const int k = kg * 16 + kk;
            const float cv = p.c[k], cc = p.c_ctx[k];
            const float sx = cv * sigmoidf_(cv), sc = cc * sigmoidf_(cc);
            ax += wv[kk] * sx; ac += wv[kk] * sc;
        }
        __syncthreads();
#pragma unroll
        for (int j = 0; j < 4; ++j) { red[(kg * 32 + cg * 4 + j) * 2] = ax[j]; red[(kg * 32 + cg * 4 + j) * 2 + 1] = ac[j]; }
        __syncthreads();
        if (tid < 64) {
            const int col = tid & 31, which = tid >> 5;
            float sm = 0.f;
            for (int g = 0; g < 64; ++g) sm += red[(g * 32 + col) * 2 + which];
            sm += p.b_mod[col0 + col];
            (which ? modc : modx)[col0 + col] = sm;
        }
    }
    float* rowtab = (float*)(p.ws + OFF_ROWTAB); float* coltab = (float*)(p.ws + OFF_COLTAB);
    for (int i = bid * NTH + tid; i < (256 + 64) * 256; i += nblk * NTH) {
        const int pos = i >> 8, f = i & 255;
        const float freq = powf(10000.f, -(float)f / 256.f);
        if (pos < 256) { const float a = (float)pos * freq; rowtab[pos * 512 + f] = sinf(a); rowtab[pos * 512 + 256 + f] = cosf(a); }
        else { const int cp = pos - 256; const float a = (float)cp * freq; coltab[cp * 512 + f] = sinf(a); coltab[cp * 512 + 256 + f] = cosf(a); }
    }
    if (bid == 0 && tid < 64) ((int*)(p.ws + OFF_CNT))[tid] = 0;
    if (bid == 1 % nblk && tid < 256) ((unsigned*)(p.ws + OFF_TCNT))[64 * tid] = 0u;
    convert_T(p.w_in, (bf16_t*)(p.ws + OFF_WINB), D, DIN, 0, (D / 64) * (DIN / 64), bid * NWV + (tid >> 6), nblk * NWV, (float*)(lds + 16384) + (tid >> 6) * (64 * 66));
    for (int idx = bid * NTH + tid; idx < (DINP - DIN) * (D / 8); idx += nblk * NTH) *(u32x4*)((bf16_t*)(p.ws + OFF_WINB) + (size_t)DIN * D + (size_t)idx * 8) = (u32x4){0u, 0u, 0u, 0u};
    {
        const float* src = p.w_out; const int nc = D; bf16_t* dst = (bf16_t*)(p.ws + OFF_WOUTB);
        const int n8 = nc >> 3;
        for (int idx = bid * NTH + tid; idx < D * n8; idx += nblk * NTH) {
            const int k = idx / n8, g8 = idx - k * n8, blk = g8 >> 2, q = g8 & 3;
            const f32x4 lo = *(const f32x4*)(src + (size_t)k * nc + blk * 32 + 4 * q), hi = *(const f32x4*)(src + (size_t)k * nc + blk * 32 + 16 + 4 * q);
            *(u32x4*)(dst + (size_t)k * nc + blk * 32 + 8 * q) = (u32x4){pack2(lo[0], lo[1]), pack2(lo[2], lo[3]), pack2(hi[0], hi[1]), pack2(hi[2], hi[3])};
        }
    }
    convert_T(p.w_out, (bf16_t*)(p.ws + OFF_WOUTT), D, D, 0, (D / 64) * (D / 64), nblk * NWV - 1 - (bid * NWV + (tid >> 6)), nblk * NWV, (float*)(lds + 16384) + (tid >> 6) * (64 * 66));
}

DI void phase_xn(const Params& p, int bid, int nblk, char* lds) {
    const int lane = threadIdx.x & 63, wid = threadIdx.x >> 6;
    const float* modx = (const float*)(p.ws + OFF_MODX); const float* modc = (const float*)(p.ws + OFF_MODC);
    const float* rowtab = (const float*)(p.ws + OFF_ROWTAB); const float* coltab = (const float*)(p.ws + OFF_COLTAB);
    bf16_t* xn = (bf16_t*)(p.ws + OFF_XN);
    const bool ctl_ok = (nblk & 3) == 0;
    float* ctl = (float*)lds;
    const int cbase = (16 * bid) & 63;
    if (ctl_ok) {
        for (int i = threadIdx.x; i < 16 * 128; i += NTH) { const int row = i >> 7, c4 = i & 127; *(f32x4*)(ctl + row * 512 + c4 * 4) = *(const f32x4*)(coltab + ((cbase + row) & 63) * 512 + c4 * 4); }
        __syncthreads();
    }
    f32x4 hg[4], hsh[4], hsc[4];
#pragma unroll
    for (int i = 0; i < 4; ++i) { const int d = (i * 64 + lane) * 4; hg[i] = *(const f32x4*)(p.norm1_g + d); hsh[i] = *(const f32x4*)(modx + d); hsc[i] = *(const f32x4*)(modx + 1024 + d); }
    for (int gp = bid * NWV + wid; gp < NT / 2; gp += nblk * NWV) {
        const int g0 = 2 * gp; const bool isctx = g0 < CTX;
        f32x4 v[2][4]; float ss[2] = {0.f, 0.f};
#pragma unroll
        for (int r = 0; r < 2; ++r)
#pragma unroll
            for (int i = 0; i < 4; ++i) {
                const int g = g0 + r, t = g - CTX, d = (i * 64 + lane) * 4;
                const float* src = isctx ? p.ctx + (size_t)g * D : p.x + (size_t)t * D;
                v[r][i] = __builtin_nontemporal_load((const f32x4*)(src + d));
            }
        if (!isctx) {
            const int t0 = g0 - CTX;
#pragma unroll
            for (int i = 0; i < 2; ++i) { const f32x4 rt = *(const f32x4*)(rowtab + (t0 >> 6) * 512 + (i * 64 + lane) * 4); v[0][i] += rt; v[1][i] += rt; }
#pragma unroll
            for (int r = 0; r < 2; ++r)
#pragma unroll
                for (int i = 2; i < 4; ++i) { const int t = t0 + r, dc = (i * 64 + lane) * 4 - 512;
                    v[r][i] += ctl_ok ? *(const f32x4*)(ctl + (((t & 63) - cbase) & 63) * 512 + dc) : *(const f32x4*)(coltab + (t & 63) * 512 + dc); }
        }
#pragma unroll
        for (int r = 0; r < 2; ++r)
#pragma unroll
            for (int i = 0; i < 4; ++i) ss[r] += v[r][i][0] * v[r][i][0] + v[r][i][1] * v[r][i][1] + v[r][i][2] * v[r][i][2] + v[r][i][3] * v[r][i][3];
#pragma unroll
        for (int r = 0; r < 2; ++r) {
            const float rstd = rsqrtf(wave_sum(ss[r]) * (1.f / 1024.f) + 1e-6f);
#pragma unroll
            for (int i = 0; i < 4; ++i) {
                const int d = (i * 64 + lane) * 4;
                f32x4 sh = hsh[i], sc = hsc[i];
                if (isctx) { sh = *(const f32x4*)(modc + d); sc = *(const f32x4*)(modc + 1024 + d); }
                f32x4 o;
#pragma unroll
                for (int j = 0; j < 4; ++j) o[j] = (v[r][i][j] * rstd * hg[i][j]) * (1.f + sc[j]) + sh[j];
                u32x2 pk = {pack2(o[0], o[1]), pack2(o[2], o[3])};
                *(u32x2*)(xn + (size_t)(g0 + r) * D + d) = pk;
            }
        }
    }
}

constexpr int GA_SZ = 256 * 128, GB_SZ = 34816, GBUF_SZ = GA_SZ + GB_SZ;
constexpr int GEMM_LDS = 2 * GBUF_SZ;
DI void glds16(const void* gsrc, char* ldst) { __builtin_amdgcn_global_load_lds((const unsigned*)gsrc, (LAS unsigned*)ldst, 16, 0, 0); }
template <class E> struct EpiWide { static constexpr bool value = false; };
struct EpiHid; template <> struct EpiWide<EpiHid> { static constexpr bool value = true; };
template <int NB, bool BGLDS, int NBLK, class AL, class EPI, int MB = 4>
DI void gemm8(const AL& al, const void* __restrict__ Bv0, const void* __restrict__ Bv1, int ldb, int K, char* lds, EPI& epi) {
    static_assert(!(NB == 2 && NBLK == 2), "unsupported combination");
    constexpr int WN = 32 * NBLK, BN = 4 * WN;
    constexpr int RB = BN * 2;
    constexpr int BP = BN + 8;
    constexpr int NF4 = BN / 4;
    constexpr int NLD = (64 * NF4) / NTH;
    constexpr int NPB = (64 * RB) / (1024 * NWV);
    int tid = threadIdx.x; asm volatile("" : "+v"(tid));
    const int lane = tid & 63, wid = __builtin_amdgcn_readfirstlane(tid >> 6), wr = wid >> 2, wc = wid & 3, r32 = lane & 31, hh = lane >> 5, gi = lane >> 4, i16 = lane & 15;
    const float* B0 = (const float*)Bv0; const float* B1 = (const float*)Bv1; const bf16_t* Bb = (const bf16_t*)Bv0; const bf16_t* Bb1 = (const bf16_t*)Bv1;
    f32x16 acc0[MB][NBLK], acc1[MB][NBLK];
#pragma unroll
    for (int m = 0; m < MB; ++m)
#pragma unroll
        for (int n = 0; n < NBLK; ++n) { acc0[m][n] = zero16(); acc1[m][n] = zero16(); }
    f32x4 rb0[NLD], rb1[NLD];
    const int T = K >> 6;
    const bf16_t* arow[MB];
#pragma unroll
    for (int i = 0; i < MB; ++i) { const int row = (8 * i + wid) * 8 + (lane >> 3); arow[i] = al.rowptr(i, row) + (((lane & 7) ^ ((row >> 1) & 7)) << 3); }
    int bsrc[NPB];
#pragma unroll
    for (int i = 0; i < NPB; ++i) { const int k = (8 * i + wid) * (1024 / RB) + lane / (RB / 16), pp = lane % (RB / 16); bsrc[i] = k * ldb + ((((pp >> 1) ^ (k & 7)) << 1) + (pp & 1)) * 8; }
    const int a_base = (wr * (32 * MB) + r32) * 128, a_sw = (r32 >> 1) & 7;
    const int b_off = (8 * (gi >> 1) + (i16 >> 2)) * BP + wc * WN + 16 * (gi & 1) + 4 * (i16 & 3);
#define G_DMA(buf, t_) do { char* dA_ = lds + (buf) * GBUF_SZ + wid * 1024 + lane * 16; \
        _Pragma("unroll") for (int i = 0; i < MB; ++i) glds16(arow[i] + (t_) * 64, dA_ + i * 8192); \
        if (BGLDS) { char* dB_ = lds + (buf) * GBUF_SZ + GA_SZ + wid * 1024 + lane * 16; \
            _Pragma("unroll") for (int i = 0; i < NPB; ++i) { glds16(Bb + (size_t)(t_) * 64 * ldb + bsrc[i], dB_ + i * 8192); \
                if (NB == 2) glds16(Bb1 + (size_t)(t_) * 64 * ldb + bsrc[i], dB_ + 64 * RB + i * 8192); } } } while (0)
#define G_LOADB(t_) do { const int k0_ = (t_) * 64; \
        _Pragma("unroll") for (int i = 0; i < NLD; ++i) { const int c = tid + NTH * i, kr = c / NF4, n4 = c % NF4; rb0[i] = *(const f32x4*)(B0 + (size_t)(k0_ + kr) * ldb + n4 * 4); \
            if (NB == 2) rb1[i] = *(const f32x4*)(B1 + (size_t)(k0_ + kr) * ldb + n4 * 4); } } while (0)
#define G_WRITEB(buf) do { bf16_t* sB0_ = (bf16_t*)(lds + (buf) * GBUF_SZ + GA_SZ); bf16_t* sB1_ = sB0_ + 64 * BP; \
        _Pragma("unroll") for (int i = 0; i < NLD; ++i) { const int c = tid + NTH * i, kr = c / NF4, n4 = c % NF4, slot = (n4 >> 3) * 32 + 8 * (n4 & 3) + 4 * ((n4 >> 2) & 1); \
            u32x2 pk = {pack2(rb0[i][0], rb0[i][1]), pack2(rb0[i][2], rb0[i][3])}; *(u32x2*)(sB0_ + kr * BP + slot) = pk; \
            if (NB == 2) { u32x2 pk1 = {pack2(rb1[i][0], rb1[i][1]), pack2(rb1[i][2], rb1[i][3])}; *(u32x2*)(sB1_ + kr * BP + slot) = pk1; } } } while (0)
#define G_READ(buf, ks, AF, BF0, BF1) do { const char* sA_ = lds + (buf) * GBUF_SZ; const bf16_t* sB0_ = (const bf16_t*)(lds + (buf) * GBUF_SZ + GA_SZ); const bf16_t* sB1_ = sB0_ + 64 * BP; const int k0_ = (ks) * 16; \
        _Pragma("unroll") for (int n = 0; n < NBLK; ++n) { \
            if (BGLDS) { const int kk_ = k0_ + 8 * (gi >> 1) + (i16 >> 2), gr_ = (wc * WN + n * 32) / 16 + (gi & 1); \
                const char* q0_ = (const char*)sB0_ + kk_ * RB + ((gr_ ^ (kk_ & 7)) << 5) + 8 * (i16 & 3); const char* q1_ = (const char*)sB0_ + (kk_ + 4) * RB + ((gr_ ^ ((kk_ + 4) & 7)) << 5) + 8 * (i16 & 3); \
                s16x4 lo = tr16((const bf16_t*)q0_), hi = tr16((const bf16_t*)q1_); BF0[n] = __builtin_shufflevector(lo, hi, 0, 1, 2, 3, 4, 5, 6, 7); \
                if (NB == 2) { s16x4 lo1 = tr16((const bf16_t*)(q0_ + 64 * RB)), hi1 = tr16((const bf16_t*)(q1_ + 64 * RB)); BF1[n] = __builtin_shufflevector(lo1, hi1, 0, 1, 2, 3, 4, 5, 6, 7); } } \
            else { const int off = b_off + k0_ * BP + n * 32; \
                s16x4 lo = tr16(sB0_ + off), hi = tr16(sB0_ + off + 4 * BP); BF0[n] = __builtin_shufflevector(lo, hi, 0, 1, 2, 3, 4, 5, 6, 7); \
                if (NB == 2) { s16x4 lo1 = tr16(sB1_ + off), hi1 = tr16(sB1_ + off + 4 * BP); BF1[n] = __builtin_shufflevector(lo1, hi1, 0, 1, 2, 3, 4, 5, 6, 7); } } } \
        _Pragma("unroll") for (int m = 0; m < MB; ++m) AF[m] = *(const bf16x8*)(sA_ + a_base + m * 4096 + ((((ks) * 2 + hh) ^ a_sw) << 4)); } while (0)
#define G_MFMA(AF, BF0, BF1) do { \
        _Pragma("unroll") for (int m = 0; m < MB; ++m) _Pragma("unroll") for (int n = 0; n < NBLK; ++n) { \
            acc0[m][n] = __builtin_amdgcn_mfma_f32_32x32x16_bf16(BF0[n], AF[m], acc0[m][n], 0, 0, 0); \
            if (NB == 2) acc1[m][n] = __builtin_amdgcn_mfma_f32_32x32x16_bf16(BF1[n], AF[m], acc1[m][n], 0, 0, 0); } } while (0)
#define G_MIX(nm) do { _Pragma("unroll") for (int i = 0; i < (nm); ++i) { __builtin_amdgcn_sched_group_barrier(0x008, 1, 0); __builtin_amdgcn_sched_group_barrier(0x100, 1, 0); } } while (0)
    constexpr int NMF = MB * NBLK * NB;
    bf16x8 afA[MB], bfA0[NBLK], bfA1[NBLK], afB[MB], bfB0[NBLK], bfB1[NBLK];
    G_DMA(0, 0);
    if (!BGLDS) { G_LOADB(0); G_WRITEB(0); }
#pragma unroll 1
    for (int t = 0; t < T; ++t) {
        const int buf = t & 1;
        asm volatile("s_waitcnt vmcnt(0)" ::: "memory");
        __syncthreads();
        if (t + 1 < T) { G_DMA(buf ^ 1, t + 1); if (!BGLDS) G_LOADB(t + 1); }
        if (BGLDS) {
            G_READ(buf, 0, afA, bfA0, bfA1);
            __builtin_amdgcn_sched_barrier(0);
            G_MFMA(afA, bfA0, bfA1); G_READ(buf, 1, afB, bfB0, bfB1); G_MIX(NMF);
            __builtin_amdgcn_sched_barrier(0);
            G_MFMA(afB, bfB0, bfB1); G_READ(buf, 2, afA, bfA0, bfA1); G_MIX(NMF);
            __builtin_amdgcn_sched_barrier(0);
            G_MFMA(afA, bfA0, bfA1); G_READ(buf, 3, afB, bfB0, bfB1); G_MIX(NMF);
            __builtin_amdgcn_sched_barrier(0);
            G_MFMA(afB, bfB0, bfB1);
        } else {
            __builtin_amdgcn_sched_barrier(0);
            G_READ(buf, 0, afA, bfA0, bfA1); G_MFMA(afA, bfA0, bfA1);
            G_READ(buf, 1, afA, bfA0, bfA1); G_MFMA(afA, bfA0, bfA1);
            G_READ(buf, 2, afA, bfA0, bfA1); G_MFMA(afA, bfA0, bfA1);
            __builtin_amdgcn_sched_barrier(0);
            G_READ(buf, 3, afA, bfA0, bfA1); G_MFMA(afA, bfA0, bfA1);
            G_WRITEB(buf ^ 1);
        }
        __builtin_amdgcn_sched_barrier(0);
    }
#undef G_DMA
#undef G_LOADB
#undef G_WRITEB
#undef G_READ
#undef G_MFMA
#undef G_MIX
    __syncthreads();
    float* stg = (float*)lds + wid * (32 * 68);
#pragma unroll
    for (int m = 0; m < MB; ++m) {
#pragma unroll
        for (int n = 0; n < NBLK; ++n) {
            const f32x16 v = epi.pre(acc0[m][n], acc1[m][n]);
#pragma unroll
            for (int q = 0; q < 4; ++q) *(f32x4*)(stg + r32 * 68 + n * 32 + 16 * hh + 4 * q) = (f32x4){v[4 * q], v[4 * q + 1], v[4 * q + 2], v[4 * q + 3]};
        }
        asm volatile("s_waitcnt lgkmcnt(0)" ::: "memory"); __builtin_amdgcn_wave_barrier();
        if constexpr (EpiWide<EPI>::value) {
#pragma unroll
            for (int ps = 0; ps < (32 * WN) / 512; ++ps) {
                const int idx = ps * 64 + lane, row = idx / (WN / 8), ck = idx % (WN / 8);
                epi.post8(wr * (32 * MB) + m * 32 + row, wc * WN + ck * 8, *(const f32x4*)(stg + row * 68 + ck * 8), *(const f32x4*)(stg + row * 68 + ck * 8 + 4));
            }
        } else {
#pragma unroll
        for (int ps = 0; ps < (32 * WN) / 256; ++ps) {
            const int idx = ps * 64 + lane, row = idx / (WN / 4), ck = idx % (WN / 4);
            epi.post(wr * (32 * MB) + m * 32 + row, wc * WN + ck * 4, *(const f32x4*)(stg + row * 68 + ck * 4));
        }
        }
        asm volatile("s_waitcnt lgkmcnt(0)" ::: "memory"); __builtin_amdgcn_wave_barrier();
    }
    __syncthreads();
}

struct PlainA {
    const bf16_t* base; int lda;
    DI const bf16_t* rowptr(int, int row) const { return base + (size_t)row * lda; }
};
struct GatherA {
    const bf16_t* rp[4];
    DI const bf16_t* rowptr(int i, int) const { return rp[i]; }
};

struct XcdOrder {
    int base, lim, j, bpx;
    DI XcdOrder(int bid, int nblk, int total) {
        if ((nblk & 7) == 0) { const int x = bid & 7, per = (total + 7) >> 3; bpx = nblk >> 3; j = bid >> 3; base = x * per; lim = base + per < total ? base + per : total; }
        else { bpx = nblk; j = bid; base = 0; lim = total; }
    }
    DI int item(int i) const { const int q = base + i * bpx + j; return q < lim ? q : -1; }
    DI int rounds() const { const int n = lim - base - j; return n <= 0 ? 0 : (n + bpx - 1) / bpx; }
};
DI void tile_rc(int q, int nrow, int ncol, int& r, int& c) {
    const int per_sr = 8 * ncol, sr = q / per_sr, rem = q - sr * per_sr, rows = (nrow - sr * 8) < 8 ? (nrow - sr * 8) : 8;
    c = rem / rows; r = sr * 8 + rem - c * rows;
}

constexpr int PG_HTB = 128 * 64 * 2, PG_STAGE = 8 * PG_HTB;
DI int pg_lds_byte(int r, int c) { const int st = (r >> 4) * 2 + (c >> 5), rr = r & 15, cc = c & 31, ob = rr * 64 + cc * 2; return st * 1024 + (ob ^ (((ob >> 9) & 1) << 5)); }
DI void pg_stage_rc(int b, int& R, int& C) { const int st = b / 1024, sb = b % 1024, swz = sb ^ (((sb >> 9) & 1) << 5); R = (st >> 1) * 16 + swz / 64; C = (st & 1) * 32 + (swz % 64) / 2; }
DI int pg_perm32(int rho) { const int n = rho >> 4, i = rho & 15; return 8 * (i >> 2) + 4 * n + (i & 3); }
struct PgUnit { int pm, pn, e, pos0, ne; };
struct PgOrder { int total, G, c;
    DI int item(int i) const { const long L = (long)i * G + c; if (L >= total) return -1; const int w = (int)L, q = total >> 3, r = total & 7, xcd = w & 7, off = w >> 3; return (xcd < r ? xcd * (q + 1) : r * (q + 1) + (xcd - r) * q) + off; } };
constexpr int PG_TAB = PG_STAGE + 1024;

template <int MODE, class Sched, class Epi>
DI void gemm_pg(char* ldsg, const int K, const Sched& S, const Epi& E) {
    LAS unsigned char* lds = (LAS unsigned char*)ldsg;
    int tid = threadIdx.x; asm volatile("" : "+v"(tid));
    const int wid = __builtin_amdgcn_readfirstlane(tid >> 6), lane = tid & 63, wr = wid >> 2, wc = wid & 3, fr = lane & 15, fq = lane >> 4;
    const int nt = K >> 6;
    unsigned voffA[2], voffB[2]; int Rr[2];
#pragma unroll
    for (int i = 0; i < 2; ++i) { int R, C; pg_stage_rc(tid * 16 + i * 8192, R, C); const int Rb = Epi::PERM ? ((R & ~31) + pg_perm32(R & 31)) : R;
        voffA[i] = (MODE == 1) ? (unsigned)(C * 2) : (unsigned)(R * K + C) * 2u; voffB[i] = (unsigned)(Rb * K + C) * 2u; Rr[i] = R; }
    const size_t kstep = 128, hstep = (size_t)128 * K * 2;
    const unsigned ldsw = (unsigned)wid * 1024u;
    const int aoff = pg_lds_byte(wr * 64 + fr, fq * 8), boff = pg_lds_byte(wc * 32 + fr, fq * 8);
    LAS int* stab = (LAS int*)(lds + PG_TAB); LAS float* gtab = (LAS float*)(lds + PG_TAB + 2048);
#define PG_SA(b, h) (((b) * 2 + (h)) * PG_HTB)
#define PG_SB(b, h) ((4 + (b) * 2 + (h)) * PG_HTB)
#define PG_GL(src, bufoff, i_) __builtin_amdgcn_global_load_lds((const unsigned*)(src), (LAS unsigned*)(lds + (bufoff) + ldsw + (i_) * 8192), 16, 0, 0)
#define PG_STB(bufoff, gbase) do { _Pragma("unroll") for (int _i = 0; _i < 2; ++_i) PG_GL((const char*)(gbase) + voffB[_i], bufoff, _i); } while (0)
#define PG_STA(bufoff, h, aptr, koff) do { _Pragma("unroll") for (int _i = 0; _i < 2; ++_i) { \
        if (MODE == 1) PG_GL(S.abase() + (size_t)(koff) + goff[h][_i], bufoff, _i); else PG_GL((const char*)(aptr) + (h) * hstep + voffA[_i], bufoff, _i); } } while (0)
#define PG_LDA(dst, b, h) do { _Pragma("unroll") for (int m = 0; m < 4; ++m) _Pragma("unroll") for (int k = 0; k < 2; ++k) dst[m][k] = *(const LAS bf16x8*)(lds + PG_SA(b, h) + aoff + m * 2048 + k * 1024); } while (0)
#define PG_LDB(dst, b, h) do { _Pragma("unroll") for (int n = 0; n < 2; ++n) _Pragma("unroll") for (int k = 0; k < 2; ++k) dst[n][k] = *(const LAS bf16x8*)(lds + PG_SB(b, h) + boff + n * 2048 + k * 1024); } while (0)
#define PG_MMA(ai, bj, At_, Bt_) do { __builtin_amdgcn_s_setprio(1); _Pragma("unroll") for (int m = 0; m < 4; ++m) _Pragma("unroll") for (int n = 0; n < 2; ++n) _Pragma("unroll") for (int k = 0; k < 2; ++k) \
        acc[ai][bj][m][n] = __builtin_amdgcn_mfma_f32_16x16x32_bf16(Bt_[n][k], At_[m][k], acc[ai][bj][m][n], 0, 0, 0); __builtin_amdgcn_s_setprio(0); } while (0)
#define PG_WAIT_V(n) asm volatile("s_waitcnt vmcnt(" #n ")" ::: "memory")
#define PG_WAIT_L(n) asm volatile("s_waitcnt lgkmcnt(" #n ")" ::: "memory")
#define PG_BAR __builtin_amdgcn_s_barrier()
#define PG_SCHED __builtin_amdgcn_sched_barrier(0)
    PgUnit cur, nxt; int ui = 0;
    if (!S.next(0, cur)) return;
    f32x4 acc[2][2][4][2];
#pragma unroll
    for (int a = 0; a < 2; ++a)
#pragma unroll
        for (int b = 0; b < 2; ++b)
#pragma unroll
            for (int m = 0; m < 4; ++m)
#pragma unroll
                for (int n = 0; n < 2; ++n) acc[a][b][m][n] = (f32x4){0.f, 0.f, 0.f, 0.f};
    bf16x8 At[4][2], B0[2][2], B1[2][2];
    unsigned goff[2][2] = {{0u, 0u}, {0u, 0u}}, noff[2][2] = {{0u, 0u}, {0u, 0u}};
    int tslot = -1; float tgate = 0.f;
    const char* cA = (MODE == 1) ? nullptr : S.aptr(cur); const char* cB0 = S.b0(cur); const char* cB1 = S.b1(cur);
    if (MODE == 1) {
#pragma unroll
        for (int h = 0; h < 2; ++h)
#pragma unroll
            for (int i = 0; i < 2; ++i) goff[h][i] = S.rowoff(cur, 128 * h + Rr[i]) + voffA[i];
    }
    if (MODE == 2) { if (tid < 256) { S.rowinfo(cur, tid, tslot, tgate); stab[tid] = tslot; gtab[tid] = tgate; } PG_WAIT_L(0); }
    if (MODE == 2) S.a_ready(cur);
    PG_STB(PG_SB(0, 0), cB0); PG_STA(PG_SA(0, 0), 0, cA, 0); PG_STB(PG_SB(0, 1), cB1); PG_STA(PG_SA(0, 1), 1, cA, 0);
    if (wr == 1) PG_BAR;
    PG_WAIT_V(4); PG_BAR;
    PG_STB(PG_SB(1, 0), cB0 + kstep); PG_STA(PG_SA(1, 0), 0, cA + kstep, kstep); PG_STB(PG_SB(1, 1), cB1 + kstep);
    PG_WAIT_V(6); PG_BAR;
    for (;;) {
        const bool has_next = S.next(ui + 1, nxt);
        const char* nA = (MODE == 1) ? nullptr : (has_next ? S.aptr(nxt) : cA); const char* nB0 = has_next ? S.b0(nxt) : cB0; const char* nB1 = has_next ? S.b1(nxt) : cB1;
        if (MODE == 1) {
#pragma unroll
            for (int h = 0; h < 2; ++h)
#pragma unroll
                for (int i = 0; i < 2; ++i) noff[h][i] = has_next ? S.rowoff(nxt, 128 * h + Rr[i]) + voffA[i] : goff[h][i];
        }
        if (MODE == 2) { if (has_next && tid < 256) S.rowinfo(nxt, tid, tslot, tgate); }
        for (int t = 0; t < nt; t += 2) {
            const bool last = (t == nt - 2);
            const char* a1 = cA + (size_t)(t + 1) * kstep;
            const char* a2 = last ? nA : cA + (size_t)(t + 2) * kstep; const char* b20 = last ? nB0 : cB0 + (size_t)(t + 2) * kstep; const char* b21 = last ? nB1 : cB1 + (size_t)(t + 2) * kstep;
            const char* a3 = a2 + kstep; const char* b30 = b20 + kstep; const char* b31 = b21 + kstep;
            const size_t k1 = (size_t)(t + 1) * kstep, k2 = last ? 0 : (size_t)(t + 2) * kstep, k3 = k2 + kstep;
            if (MODE == 2 && last && has_next) S.a_ready(nxt);
            PG_LDB(B0, 0, 0); PG_SCHED; PG_LDA(At, 0, 0); PG_STA(PG_SA(1, 1), 1, a1, k1);
            PG_WAIT_L(8); PG_BAR; PG_WAIT_L(0); PG_MMA(0, 0, At, B0); PG_BAR; PG_SCHED;
            if (last) {
                if (MODE == 1) { goff[0][0] = noff[0][0]; goff[0][1] = noff[0][1]; goff[1][0] = noff[1][0]; goff[1][1] = noff[1][1]; }
                if (MODE == 2) { if (has_next && tid < 256) { stab[((ui + 1) & 1) * 256 + tid] = tslot; gtab[((ui + 1) & 1) * 256 + tid] = tgate; } }
            }
            PG_LDB(B1, 0, 1); PG_STB(PG_SB(0, 0), b20);
            PG_BAR; PG_WAIT_L(0); PG_MMA(0, 1, At, B1); PG_BAR;
            PG_LDA(At, 0, 1); PG_STA(PG_SA(0, 0), 0, a2, k2);
            PG_BAR; PG_WAIT_L(0); PG_MMA(1, 0, At, B0); PG_BAR; PG_SCHED;
            PG_STB(PG_SB(0, 1), b21);
            PG_WAIT_V(6); PG_BAR; PG_MMA(1, 1, At, B1); PG_BAR;
            PG_LDB(B0, 1, 0); PG_SCHED; PG_LDA(At, 1, 0); PG_STA(PG_SA(0, 1), 1, a2, k2);
            PG_WAIT_L(8); PG_BAR; PG_WAIT_L(0); PG_MMA(0, 0, At, B0); PG_BAR; PG_SCHED;
            PG_LDB(B1, 1, 1); PG_STB(PG_SB(1, 0), b30);
            PG_BAR; PG_WAIT_L(0); PG_MMA(0, 1, At, B1); PG_BAR;
            PG_LDA(At, 1, 1); PG_STA(PG_SA(1, 0), 0, a3, k3);
            PG_BAR; PG_WAIT_L(0); PG_MMA(1, 0, At, B0); PG_BAR; PG_SCHED;
            PG_STB(PG_SB(1, 1), b31);
            PG_WAIT_V(6); PG_BAR; PG_MMA(1, 1, At, B1); PG_BAR;
        }
        if (!(Epi::AFTER && !has_next)) E(acc, cur, wr, wc, fr, fq, stab + (ui & 1) * 256, gtab + (ui & 1) * 256);
        if (MODE == 1) S.done(cur);
        if (!has_next) break;
#pragma unroll
        for (int a = 0; a < 2; ++a)
#pragma unroll
            for (int b = 0; b < 2; ++b)
#pragma unroll
                for (int m = 0; m < 4; ++m)
#pragma unroll
                    for (int n = 0; n < 2; ++n) acc[a][b][m][n] = (f32x4){0.f, 0.f, 0.f, 0.f};
        cur = nxt; cA = nA; cB0 = nB0; cB1 = nB1; ++ui;
    }
    PG_WAIT_V(0);
    if (wr == 0) PG_BAR;
    PG_BAR;
    if constexpr (Epi::AFTER) E.after(acc, cur, wr, wc, fr, fq, ldsg, wid, lane);
#undef PG_SA
#undef PG_SB
#undef PG_GL
#undef PG_STB
#undef PG_STA
#undef PG_LDA
#undef PG_LDB
#undef PG_MMA
#undef PG_WAIT_V
#undef PG_WAIT_L
#undef PG_BAR
#undef PG_SCHED
}

struct SchedDense { const char* A; const char* Bt; int nM, nN, K; PgOrder ord;
    DI bool next(int i, PgUnit& u) const { const int w = ord.item(i); if (w < 0) return false; const int nig = 8 * nN, gid = w / nig, fm = gid * 8, gsz = (nM - fm) < 8 ? (nM - fm) : 8, rem = w - gid * nig;
        u.pn = rem / gsz; u.pm = fm + rem - u.pn * gsz; u.e = 0; u.pos0 = 0; u.ne = 0; return true; }
    DI const char* aptr(const PgUnit& u) const { return A + (size_t)u.pm * 256 * K * 2; }
    DI const char* b0(const PgUnit& u) const { return Bt + (size_t)u.pn * 256 * K * 2; }
    DI const char* b1(const PgUnit& u) const { return Bt + ((size_t)u.pn * 256 + 128) * K * 2; }
    DI const char* abase() const { return A; }
    DI unsigned rowoff(const PgUnit&, int) const { return 0u; }
    DI void rowinfo(const PgUnit&, int, int&, float&) const {}
    DI void a_ready(const PgUnit&) const {}
    DI void done(const PgUnit&) const {}
};


DI u32x4 pack8q(const f32x16& a, int q) { return (u32x4){pack2(a[8 * q], a[8 * q + 1]), pack2(a[8 * q + 2], a[8 * q + 3]), pack2(a[8 * q + 4], a[8 * q + 5]), pack2(a[8 * q + 6], a[8 * q + 7])}; }
struct EpiStoreBf16 { bf16_t* o; int ldo;
    DI f32x16 pre(const f32x16& a, const f32x16&) const { return a; }
    DI void post(int r, int c, const f32x4& v) const { u32x2 pk = {pack2(v[0], v[1]), pack2(v[2], v[3])}; *(u32x2*)(o + (size_t)r * ldo + c) = pk; } };
struct PgEpiU { static constexpr bool PERM = true, AFTER = false; bf16_t* u;
    DI void operator()(const f32x4 (&acc)[2][2][4][2], const PgUnit& un, int wr, int wc, int fr, int fq, const LAS int*, const LAS float*) const {
        const int row0 = un.pm * 256 + wr * 64 + fr, col0 = un.pn * 256 + wc * 32 + 8 * fq;
#pragma unroll
        for (int ai = 0; ai < 2; ++ai)
#pragma unroll
            for (int m = 0; m < 4; ++m) { bf16_t* rowp = u + (size_t)(row0 + ai * 128 + m * 16) * DIN + col0;
#pragma unroll
                for (int bj = 0; bj < 2; ++bj) if (un.pn * 256 + bj * 128 < DIN) *(u32x4*)(rowp + bj * 128) = pack8v(acc[ai][bj][m][0], acc[ai][bj][m][1]); }
    } };
DI void convert_perm(const float* __restrict__ src, bf16_t* __restrict__ dst, int row0, int row1, int ncols, int wkr, int nwkr);
DI void phase_g1(const Params& p, int bid, int nblk, char* lds) {
    const SchedDense S{p.ws + OFF_XN, p.ws + OFF_WINB, NT / 256, DINP / 256, D, PgOrder{(NT / 256) * (DINP / 256), nblk, bid}};
    const PgEpiU E{(bf16_t*)(p.ws + OFF_U)};
    gemm_pg<0>(lds, D, S, E);
    { const int U1 = (NT / 256) * (DINP / 256), R1 = U1 % nblk;
      if (R1 > 0 && bid >= R1) convert_T(p.w_gate, (bf16_t*)p.out, D, DE, 0, 2048, (bid - R1) * NWV + (threadIdx.x >> 6), (nblk - R1) * NWV, (float*)(lds + 16384) + (threadIdx.x >> 6) * (64 * 66)); }
}

DI void phase_pool(const Params& p, int bid, int nblk) {
    const bf16_t* u = (const bf16_t*)(p.ws + OFF_U) + (size_t)CTX * DIN + C_POOL;
    bf16_t* mix = (bf16_t*)(p.ws + OFF_MIX);
    for (int item = bid * NTH + threadIdx.x; item < (S / 8) * 64; item += nblk * NTH) {
        const int cg = item & 63, run = item >> 6, t0 = run * 8, gi = cg >> 4, win = 2 << gi, hw = win >> 1;
        const bf16_t* uc = u + cg * 8;
        float sum[8];
#pragma unroll
        for (int j = 0; j < 8; ++j) sum[j] = 0.f;
        const int lo0 = (t0 - hw) < 0 ? 0 : (t0 - hw), hi0 = (t0 - hw + win) > S ? S : (t0 - hw + win);
#pragma unroll
        for (int r = 0; r < 16; ++r) {
            const int tt = lo0 + r; const bool ok = tt < hi0; const int tc = ok ? tt : lo0;
            float q[8]; unpack8(*(const u32x4*)(uc + (size_t)tc * DIN), q);
            const float wgt = ok ? 1.f : 0.f;
#pragma unroll
            for (int j = 0; j < 8; ++j) sum[j] += wgt * q[j];
        }
        int lo = lo0, hi = hi0;
#pragma unroll
        for (int k = 0; k < 8; ++k) {
            const int t = t0 + k;
            float cv[8], o[8]; unpack8(*(const u32x4*)(uc + (size_t)t * DIN), cv);
            const float inv = __builtin_amdgcn_rcpf((float)(hi - lo));
#pragma unroll
            for (int j = 0; j < 8; ++j) o[j] = sum[j] * inv - cv[j];
            *(u32x4*)(mix + (size_t)t * D + cg * 8) = pack8(o);
            const int nlo = t + 1 - hw, nhi = t + 1 - hw + win;
            const bool addr = nhi <= S, subr = nlo > 0;
            float qa[8], qs[8];
            unpack8(*(const u32x4*)(uc + (size_t)(addr ? nhi - 1 : t) * DIN), qa); unpack8(*(const u32x4*)(uc + (size_t)(subr ? nlo - 1 : t) * DIN), qs);
            const float wa = addr ? 1.f : 0.f, wsb = subr ? 1.f : 0.f;
#pragma unroll
            for (int j = 0; j < 8; ++j) sum[j] += wa * qa[j] - wsb * qs[j];
            hi = addr ? nhi : hi; lo = subr ? nlo : lo;
        }
    }
}
struct EpiPool { bf16_t* o; const float* sc;
    DI f32x16 pre(const f32x16& a, const f32x16&) const { return a; }
    DI void post(int r, int c, const f32x4& v) const { const f32x4 s4 = *(const f32x4*)(sc + c); u32x2 pk = {pack2(v[0] * s4[0], v[1] * s4[1]), pack2(v[2] * s4[2], v[3] * s4[3])}; *(u32x2*)(o + (size_t)r * D + c) = pk; } };
DI void phase_poolgemm(const Params& p, int bid, int nblk, char* lds) {
    if (nblk <= 0) return;
    for (int it = bid; it < 4 * 64; it += nblk) {
        const int gi = it >> 6, tm = it & 63;
        const bf16_t* mix = (const bf16_t*)(p.ws + OFF_MIX);
        PlainA al{mix + (size_t)tm * 256 * D + gi * 128, D};
        EpiPool e{(bf16_t*)(p.ws + OFF_MIX) + (size_t)tm * 256 * D + 512 + gi * 128, p.pool_scale + gi * 128};
        int kk = 128; asm volatile("" : "+s"(kk));
        gemm8<1, false, 1>(al, p.w_pool + (size_t)gi * 128 * 128, nullptr, 128, kk, lds, e);
    }
}

constexpr int MP = 72, MSZ = 64 * MP;
constexpr int FP = 68;
constexpr int SCANA_LDS = 17 * MSZ * 2 + 4096;
template <bool KS> DI bf16x8 frag32(const bf16_t* base, int x0, int s, int lane) {
    if (!KS) return *(const bf16x8*)(base + (x0 + (lane & 31)) * MP + 16 * s + 8 * (lane >> 5));
    const int gi = lane >> 4, i = lane & 15;
    const bf16_t* a = base + (16 * s + 8 * (gi >> 1) + (i >> 2)) * MP + x0 + 16 * (gi & 1) + 4 * (i & 3);
    s16x4 lo = tr16(a), hi = tr16(a + 4 * MP);
    return __builtin_shufflevector(lo, hi, 0, 1, 2, 3, 4, 5, 6, 7);
}
template <bool XKS, bool YKS> DI f32x16 mm32(const bf16_t* X, int x0, const bf16_t* Y, int y0, f32x16 acc, int lane) {
#pragma unroll
    for (int s = 0; s < 4; ++s) acc = __builtin_amdgcn_mfma_f32_32x32x16_bf16(frag32<XKS>(X, x0, s, lane), frag32<YKS>(Y, y0, s, lane), acc, 0, 0, 0);
    return acc;
}
template <class F> DI void store_acc(bf16_t* out, int x0, int y0, const f32x16& acc, int lane, F f) {
    const int y = y0 + (lane & 31), hh = lane >> 5;
#pragma unroll
    for (int q = 0; q < 4; ++q) {
        const int x = x0 + 8 * q + 4 * hh;
        u32x2 pk = {pack2(f(acc[4 * q], x, y), f(acc[4 * q + 1], x + 1, y)), pack2(f(acc[4 * q + 2], x + 2, y), f(acc[4 * q + 3], x + 3, y))};
        *(u32x2*)(out + y * MP + x) = pk;
    }
}
template <class F> DI void store_acc_add(bf16_t* out, const bf16_t* add, int x0, int y0, const f32x16& acc, int lane, F f) {
    const int y = y0 + (lane & 31), hh = lane >> 5;
    u32x2 ad[4];
#pragma unroll
    for (int q = 0; q < 4; ++q) ad[q] = *(const u32x2*)(add + y * MP + x0 + 8 * q + 4 * hh);
#pragma unroll
    for (int q = 0; q < 4; ++q) {
        const int x = x0 + 8 * q + 4 * hh;
        u32x2 pk = {pack2(f(acc[4 * q] + bflo(ad[q].x), x, y), f(acc[4 * q + 1] + bfhi(ad[q].x), x + 1, y)), pack2(f(acc[4 * q + 2] + bflo(ad[q].y), x + 2, y), f(acc[4 * q + 3] + bfhi(ad[q].y), x + 3, y))};
        *(u32x2*)(out + y * MP + x) = pk;
    }
}
DI unsigned rot16(unsigned x) { return (x >> 16) | (x << 16); }

DI int chain_pos(int c, int dir) { return dir == 0 ? c : (c < 4 ? 3 - c : NCH + 3 - c); }
DI int grp_start(int g);

DI void phase_scanA(const Params& p, int bid, int nblk, char* lds) {
    const int tid = threadIdx.x, lane0 = tid & 63, w = tid >> 6, grp = w >> 2;
    bf16_t* M = (bf16_t*)lds;
    bf16_t *sAT = M, *sBT = M + MSZ, *sKT = M + 2 * MSZ, *sRT = M + 3 * MSZ, *sVT = M + 4 * MSZ;
    float* fGC = (float*)(lds + 17 * MSZ * 2);
    float* fSeg = fGC + 64;
    float* fTab = fSeg + 64;
    float* fLogw = (float*)(M + 12 * MSZ);
    float* fA = (float*)(M + 10 * MSZ);
    const bf16_t* u = (const bf16_t*)(p.ws + OFF_U);
    u32x4 praw[5], prawg[2], phalo;
#define SCANA_ISSUE(inst_) do { const int c_ = (inst_) >> 4, h_ = ((inst_) >> 1) & 7, d_ = (inst_) & 1, ch_ = tid & 7, tau_ = tid >> 3, g_ = d_ ? c_ * 64 + 63 - tau_ : c_ * 64 + tau_; \
        const bool wg_ = c_ >= 4 && d_ == 0; \
        const bf16_t* rc_ = u + (size_t)g_ * DIN; \
        const int cb_[7] = {h_ * 64, 512 + h_ * 64, 1024 + h_ * 64, (d_ ? C_WLB : C_WLF), (d_ ? C_ALB : C_ALF), C_GL, C_GL + 64}; \
        _Pragma("unroll") for (int q = 0; q < 5; ++q) praw[q] = *(const u32x4*)(rc_ + cb_[q] + ch_ * 8); \
        if (wg_) { prawg[0] = *(const u32x4*)(rc_ + cb_[5] + ch_ * 8); prawg[1] = *(const u32x4*)(rc_ + cb_[6] + ch_ * 8); } \
        if (tid < 112) { const int rs_ = tid >= 56, rem_ = tid - rs_ * 56, gq_ = rem_ >> 3, ck_ = rem_ & 7; int gh_ = rs_ ? c_ * 64 + 64 : c_ * 64 - 1; gh_ = gh_ < 0 ? 0 : (gh_ > NT - 1 ? NT - 1 : gh_); \
            int col_ = cb_[0]; col_ = gq_ == 1 ? cb_[1] : col_; col_ = gq_ == 2 ? cb_[2] : col_; col_ = gq_ == 3 ? cb_[3] : col_; col_ = gq_ == 4 ? cb_[4] : col_; col_ = gq_ == 5 ? cb_[5] : col_; col_ = gq_ == 6 ? cb_[6] : col_; \
            phalo = *(const u32x4*)(u + (size_t)gh_ * DIN + col_ + ck_ * 8); } } while (0)
#define XOFF(q) ((q) < 4 ? 10 * (MSZ * 2) + (q) * 8448 : ((q) == 4 ? 9 * (MSZ * 2) : ((q) == 5 ? 4 * (MSZ * 2) : 14 * (MSZ * 2))))
    const bool galign = nblk == 256;
    const int hd_ = bid & 15, n0g = grp_start(bid >> 4), n1g = grp_start((bid >> 4) + 1);
    const int ninst = galign ? n1g - n0g : (bid < NCH * 16 ? (NCH * 16 - bid + nblk - 1) / nblk : 0);
#define SCANA_INST(k_) (galign ? (((hd_ & 1) == 0 ? n0g + (k_) : (n0g + (k_) < 4 ? 3 - (n0g + (k_)) : NCH + 3 - (n0g + (k_)))) * 16 + hd_) : bid + (k_) * nblk)
    if (ninst > 0) SCANA_ISSUE(SCANA_INST(0));
    int cur_hd = -1;
    for (int ki = 0; ki < ninst; ++ki) {
        const int inst = SCANA_INST(ki);
        int lane = lane0; asm volatile("" : "+v"(lane));
        const int xq = 32 * (w & 1), yq = 32 * ((w >> 1) & 1);
        const int c = inst >> 4, h = (inst >> 1) & 7, dir = inst & 1;
        const bool latent = c >= 4, want_g = latent && dir == 0;
        const float* w2 = dir ? p.w2_b : p.w2_f; const float* a2 = dir ? p.a2_b : p.a2_f;
        const float* w0 = dir ? p.w0_b : p.w0_f; const float* a0 = dir ? p.a0_b : p.a0_f;
        const float* rkd = dir ? p.r_k_b : p.r_k_f;
        const int cwl = dir ? C_WLB : C_WLF, cal = dir ? C_ALB : C_ALF;
        const int ch = tid & 7, tau = tid >> 3, g = dir ? c * 64 + 63 - tau : c * 64 + tau;
        if ((inst & 15) != cur_hd) {
            cur_hd = inst & 15;
            for (int i = tid; i < 768; i += NTH) {
                const int grp_ = i >> 6, j_ = i & 63; float v_;
                if (grp_ < 3) v_ = p.mu[grp_ * 512 + h * 64 + j_];
                else if (grp_ == 3) v_ = p.mu[cwl + j_];
                else if (grp_ == 4) v_ = p.mu[cal + j_];
                else if (grp_ < 7) v_ = p.mu[C_GL + (grp_ - 5) * 64 + j_];
                else if (grp_ == 7) v_ = p.k_k[h * 64 + j_];
                else if (grp_ == 8) v_ = p.k_a[h * 64 + j_];
                else if (grp_ == 9) v_ = rkd[h * 64 + j_];
                else if (grp_ == 10) v_ = w0[h * 64 + j_];
                else v_ = a0[h * 64 + j_];
                fTab[i] = v_;
            }
#pragma unroll
            for (int q = 0; q < 2; ++q) { const int idx = tid + NTH * q, kr = idx >> 4, n4 = idx & 15;
                const f32x4 wa = *(const f32x4*)(w2 + (size_t)kr * DR + h * 64 + n4 * 4), wb2 = *(const f32x4*)(a2 + (size_t)kr * DR + h * 64 + n4 * 4);
                u32x2 pa = {pack2(wa[0], wa[1]), pack2(wa[2], wa[3])}, pb = {pack2(wb2[0], wb2[1]), pack2(wb2[2], wb2[3])};
                *(u32x2*)(M + 15 * MSZ + kr * MP + n4 * 4) = pa; *(u32x2*)(M + 16 * MSZ + kr * MP + n4 * 4) = pb; }
            __syncthreads();
        }
        float fr_[8], fk_[8], fv_[8];
        {
            const bool hasp = (g != 0) && (g != CTX), hasn = (g != CTX - 1) && (g != NT - 1);
            const float mp = hasp ? 0.5f : 0.f, mn = hasn ? 0.5f : 0.f;
            const int lc = (dir ? 63 - tau : tau) + 1;
            char* xb = (char*)M;
#pragma unroll
            for (int q = 0; q < 5; ++q) *(u32x4*)(xb + XOFF(q) + lc * 128 + ch * 16) = praw[q];
            if (want_g) { *(u32x4*)(xb + XOFF(5) + lc * 128 + ch * 16) = prawg[0]; *(u32x4*)(xb + XOFF(6) + lc * 128 + ch * 16) = prawg[1]; }
            if (tid < 112) { const int rs = tid >= 56, rem = tid - rs * 56, gq = rem >> 3, ck = rem & 7;
                int xo = XOFF(0); xo = gq == 1 ? XOFF(1) : xo; xo = gq == 2 ? XOFF(2) : xo; xo = gq == 3 ? XOFF(3) : xo; xo = gq == 4 ? XOFF(4) : xo; xo = gq == 5 ? XOFF(5) : xo; xo = gq == 6 ? XOFF(6) : xo;
                if (gq < 5 || want_g) *(u32x4*)(xb + xo + (rs ? 65 : 0) * 128 + ck * 16) = phalo; }
            __syncthreads();
            u32x4 raw[5][3];
#pragma unroll
            for (int q = 0; q < 5; ++q) { const char* sx = xb + XOFF(q) + lc * 128 + ch * 16; raw[q][0] = praw[q]; raw[q][1] = *(const u32x4*)(sx - 128); raw[q][2] = *(const u32x4*)(sx + 128); }
            auto shift8 = [&](const u32x4* r3, int tgrp, float* o) {
                float cc[8], pv[8], nx[8];
                unpack8(r3[0], cc); unpack8(r3[1], pv); unpack8(r3[2], nx);
                const f32x4 m0 = *(const f32x4*)(fTab + tgrp * 64 + ch * 8), m1 = *(const f32x4*)(fTab + tgrp * 64 + ch * 8 + 4);
#pragma unroll
                for (int j = 0; j < 8; ++j) { const float m = j < 4 ? m0[j & 3] : m1[j & 3]; o[j] = cc[j] + m * ((mp * pv[j] + mn * nx[j]) - cc[j]); }
            };
            shift8(raw[0], 0, fr_); shift8(raw[1], 1, fk_); shift8(raw[2], 2, fv_);
            float t8[8];
            shift8(raw[3], 3, t8);
#pragma unroll
            for (int j = 0; j < 8; ++j) { const float e2 = __expf(2.f * t8[j]); t8[j] = 1.f - 2.f * __builtin_amdgcn_rcpf(e2 + 1.f); }
            *(u32x4*)(M + 5 * MSZ + tau * MP + ch * 8) = pack8(t8);
            shift8(raw[4], 4, t8);
            *(u32x4*)(M + 6 * MSZ + tau * MP + ch * 8) = pack8(t8);
            if (want_g) {
                u32x4 rawg[2][3]; f32x4 wg2[4];
#pragma unroll
                for (int half = 0; half < 2; ++half) { const char* sx = xb + XOFF(5 + half) + lc * 128 + ch * 16; rawg[half][0] = prawg[half]; rawg[half][1] = *(const u32x4*)(sx - 128); rawg[half][2] = *(const u32x4*)(sx + 128); }
#pragma unroll
                for (int q = 0; q < 4; ++q) { const int idx = tid + NTH * q, kr = idx >> 4, n4 = idx & 15; wg2[q] = *(const f32x4*)(p.g2 + (size_t)kr * DR + h * 64 + n4 * 4); }
#pragma unroll
                for (int half = 0; half < 2; ++half) {
                    shift8(rawg[half], 5 + half, t8);
#pragma unroll
                    for (int j = 0; j < 8; ++j) t8[j] = sigmoidf_(t8[j]);
                    *(u32x4*)(M + half * MSZ + tau * MP + ch * 8) = pack8(t8);
                }
#pragma unroll
                for (int q = 0; q < 4; ++q) { const int idx = tid + NTH * q, kr = idx >> 4, n4 = idx & 15;
                    u32x2 pa = {pack2(wg2[q][0], wg2[q][1]), pack2(wg2[q][2], wg2[q][3])};
                    *(u32x2*)(M + (2 + (kr >> 6)) * MSZ + (kr & 63) * MP + n4 * 4) = pa; }
            }
        }
        __syncthreads();
        if (grp == 0) {
            f32x16 accW = mm32<true, false>(M + 15 * MSZ, xq, M + 5 * MSZ, yq, zero16(), lane);
            const int y = yq + (lane & 31), hh = lane >> 5;
#pragma unroll
            for (int q = 0; q < 4; ++q) {
                const int x = xq + 8 * q + 4 * hh;
                f32x4 lw; const f32x4 w0v = *(const f32x4*)(fTab + 10 * 64 + x);
#pragma unroll
                for (int e = 0; e < 4; ++e) {
                    float v = -DECAY_SCALE * sigmoidf_(w0v[e] + accW[4 * q + e]);
                    v += __builtin_bit_cast(float, __builtin_amdgcn_update_dpp(0, __builtin_bit_cast(int, v), 0x111, 0xf, 0xf, true));
                    v += __builtin_bit_cast(float, __builtin_amdgcn_update_dpp(0, __builtin_bit_cast(int, v), 0x112, 0xf, 0xf, true));
                    v += __builtin_bit_cast(float, __builtin_amdgcn_update_dpp(0, __builtin_bit_cast(int, v), 0x114, 0xf, 0xf, true));
                    v += __builtin_bit_cast(float, __builtin_amdgcn_update_dpp(0, __builtin_bit_cast(int, v), 0x118, 0xf, 0xf, true));
                    v += __builtin_bit_cast(float, __builtin_amdgcn_update_dpp(0, __builtin_bit_cast(int, v), 0x142, 0xa, 0xf, false));
                    lw[e] = v;
                }
                *(f32x4*)(fLogw + y * FP + x) = lw;
                if (yq == 0 && (lane & 31) == 31) *(f32x4*)(fSeg + x) = lw;
            }
        } else {
            f32x16 accA = mm32<true, false>(M + 16 * MSZ, xq, M + 6 * MSZ, yq, zero16(), lane);
            const int y = yq + (lane & 31), hh = lane >> 5;
#pragma unroll
            for (int q = 0; q < 4; ++q) {
                const int x = xq + 8 * q + 4 * hh;
                f32x4 av; const f32x4 a0v = *(const f32x4*)(fTab + 11 * 64 + x);
#pragma unroll
                for (int e = 0; e < 4; ++e) av[e] = sigmoidf_(a0v[e] + accA[4 * q + e]);
                *(f32x4*)(fA + y * FP + x) = av;
            }
            if (want_g) {
                f32x16 accG = mm32<true, false>(M + 2 * MSZ, xq, M, yq, zero16(), lane);
                accG = mm32<true, false>(M + 3 * MSZ, xq, M + MSZ, yq, accG, lane);
                const int t = c * 64 + y - CTX;
#pragma unroll
                for (int q = 0; q < 4; ++q) {
                    const int x = xq + 8 * q + 4 * hh;
                    u32x2 pk = {pack2(accG[4 * q], accG[4 * q + 1]), pack2(accG[4 * q + 2], accG[4 * q + 3])};
                    *(u32x2*)((bf16_t*)(p.ws + OFF_G) + (size_t)t * DR + h * 64 + x) = pk;
                }
            }
        }
        __syncthreads();
        {
            float oa[8], ob[8], ok[8], orr[8], kkv[8], kd[8];
            float ss = 0.f, dsum = 0.f;
            float kkp[8], kap[8], rkp[8], cum8[8], prv8[8], av8[8];
#pragma unroll
            for (int hf = 0; hf < 2; ++hf) {
                const int o8 = ch * 8 + 4 * hf;
                const f32x4 a_ = *(const f32x4*)(fTab + 7 * 64 + o8), b_ = *(const f32x4*)(fTab + 8 * 64 + o8), c_ = *(const f32x4*)(fTab + 9 * 64 + o8);
                const f32x4 sg = *(const f32x4*)(fSeg + o8), cu = *(const f32x4*)(fLogw + tau * FP + o8), pr = *(const f32x4*)(fLogw + (tau ? tau - 1 : 0) * FP + o8), aa = *(const f32x4*)(fA + tau * FP + o8);
#pragma unroll
                for (int j = 0; j < 4; ++j) {
                    kkp[4 * hf + j] = a_[j]; kap[4 * hf + j] = b_[j]; rkp[4 * hf + j] = c_[j]; av8[4 * hf + j] = aa[j];
                    cum8[4 * hf + j] = cu[j] + (tau >= 32 ? sg[j] : 0.f); prv8[4 * hf + j] = tau ? pr[j] + (tau > 32 ? sg[j] : 0.f) : 0.f;
                }
            }
#pragma unroll
            for (int j = 0; j < 8; ++j) { kkv[j] = fk_[j] * kkp[j]; ss += kkv[j] * kkv[j]; }
            ss += __shfl_xor(ss, 1, 64); ss += __shfl_xor(ss, 2, 64); ss += __shfl_xor(ss, 4, 64);
            const float inv = __builtin_amdgcn_rsqf(fmaxf(ss, 1e-24f));
#pragma unroll
            for (int j = 0; j < 8; ++j) {
                const float cum = cum8[j], cprev = prv8[j], av = av8[j];
                const float gam = __expf(cum), gprev = __expf(cprev), ginv = __expf(-cum);
                const float kkn = kkv[j] * inv;
                kd[j] = fk_[j] * (1.f + (av - 1.f) * kap[j]);
                oa[j] = -kkn * gprev; ob[j] = kkn * av * ginv; ok[j] = kd[j] * ginv; orr[j] = fr_[j] * gam;
                dsum += fr_[j] * kd[j] * rkp[j];
                if (tau == 63) fGC[ch * 8 + j] = gam;
            }
            dsum += __shfl_xor(dsum, 1, 64); dsum += __shfl_xor(dsum, 2, 64); dsum += __shfl_xor(dsum, 4, 64);
            if (ch == 0) ((float*)(p.ws + OFF_DOT))[((size_t)g * 8 + h) * 2 + dir] = dsum;
            *(u32x4*)(sAT + tau * MP + ch * 8) = pack8(oa); *(u32x4*)(sBT + tau * MP + ch * 8) = pack8(ob);
            *(u32x4*)(sKT + tau * MP + ch * 8) = pack8(ok); *(u32x4*)(sRT + tau * MP + ch * 8) = pack8(orr);
            const u32x4 pv8 = pack8(fv_);
            *(u32x4*)(sVT + tau * MP + ch * 8) = pv8;
            if (want_g) *(u32x4*)((bf16_t*)(p.ws + OFF_V) + (size_t)(g - CTX) * DR + h * 64 + ch * 8) = pv8;
        }
        __syncthreads();
        f32x16 tacc = zero16();
        if (grp == 0) {
            f32x16 acc = mm32<false, false>(sAT, xq, sBT, yq, zero16(), lane);
            store_acc(M + 5 * MSZ, xq, yq, acc, lane, [](float v, int x, int y) { return y < x ? v : 0.f; });
            { const int y = yq + (lane & 31), hh = lane >> 5;
#pragma unroll
              for (int q = 0; q < 4; ++q)
#pragma unroll
                  for (int e = 0; e < 4; ++e) { const int x = xq + 8 * q + 4 * hh + e; tacc[4 * q + e] = y < x ? acc[4 * q + e] : (y == x ? 1.f : 0.f); } }
            store_acc(M + 7 * MSZ, xq, yq, tacc, lane, [](float v, int, int) { return v; });
        } else {
            f32x16 acc = mm32<false, false>(sAT, xq, sKT, yq, zero16(), lane);
            store_acc(M + 9 * MSZ, xq, yq, acc, lane, [](float v, int x, int y) { return y < x ? v : 0.f; });
        }
        __syncthreads();
        int xs = 5, xo = 6, ts = 7, to = 8;
        if (grp == 1) {
            f32x16 acc = mm32<true, false>(M + xs * MSZ, xq, M + xs * MSZ, yq, zero16(), lane);
            store_acc(M + xo * MSZ, xq, yq, acc, lane, [](float v, int, int) { return v; });
        } else {
            f32x16 acc = mm32<false, false>(sRT, xq, sBT, yq, zero16(), lane);
            store_acc(M + 10 * MSZ, xq, yq, acc, lane, [](float v, int x, int y) { return y <= x ? v : 0.f; });
        }
        { int t_ = xs; xs = xo; xo = t_; }
        __syncthreads();
        for (int k = 0; k < 5; ++k) {
            if (grp == 0) {
                tacc = mm32<true, false>(M + xs * MSZ, xq, M + ts * MSZ, yq, tacc, lane);
                store_acc(M + to * MSZ, xq, yq, tacc, lane, [](float v, int, int) { return v; });
            } else if (k < 4) {
                f32x16 acc = mm32<true, false>(M + xs * MSZ, xq, M + xs * MSZ, yq, zero16(), lane);
                store_acc(M + xo * MSZ, xq, yq, acc, lane, [](float v, int, int) { return v; });
            } else {
                f32x16 acc = mm32<false, false>(sRT, xq, sKT, yq, zero16(), lane);
                store_acc(M + 11 * MSZ, xq, yq, acc, lane, [](float v, int x, int y) { return y <= x ? v : 0.f; });
            }
            int t_ = xs; xs = xo; xo = t_; t_ = ts; ts = to; to = t_;
            __syncthreads();
        }
        const bf16_t* sT = M + ts * MSZ;
        if (grp == 0) {
            f32x16 acc = mm32<true, true>(sT, xq, sAT, yq, zero16(), lane);
            store_acc(M + 12 * MSZ, xq, yq, acc, lane, [](float v, int, int) { return v; });
        } else {
            f32x16 acc = mm32<true, false>(sT, xq, M + 9 * MSZ, yq, zero16(), lane);
            store_acc(M + 13 * MSZ, xq, yq, acc, lane, [](float v, int, int) { return v; });
        }
        __syncthreads();
        {
            const bf16_t *sAbar = M + 12 * MSZ, *sG = M + 13 * MSZ, *sABR = M + 10 * MSZ, *sAKR = M + 11 * MSZ;
            if (grp == 0) {
                f32x16 acc = mm32<false, true>(sAbar, xq, sBT, yq, zero16(), lane);
                store_acc(M + 5 * MSZ, xq, yq, acc, lane, [fGC](float v, int x, int y) { return ((x == y ? 1.f : 0.f) + v) * fGC[y]; });
                acc = mm32<false, true>(sAbar, xq, sABR, yq, zero16(), lane);
                store_acc_add(M + 6 * MSZ, sRT, xq, yq, acc, lane, [](float v, int, int) { return v; });
            } else {
                f32x16 acc = mm32<true, false>(sBT, xq, sG, yq, zero16(), lane);
                store_acc_add(M + 7 * MSZ, sKT, xq, yq, acc, lane, [fGC](float v, int x, int) { return v * fGC[x]; });
                acc = mm32<true, false>(sABR, xq, sG, yq, zero16(), lane);
                store_acc_add(M + 9 * MSZ, sAKR, xq, yq, acc, lane, [](float v, int, int) { return v; });
            }
        }
        __syncthreads();
        const int chain = dir * 8 + h, npos = chain_pos(c, dir);
        if (ki + 1 < ninst) SCANA_ISSUE(SCANA_INST(ki + 1));
        {
            u32x4* Pg = (u32x4*)(p.ws + OFF_P) + ((size_t)chain * NCH + npos) * 512;
            { const int item = tid, ln = item & 63, as = item >> 6, a = as >> 1, s2 = as & 1, fr = ln & 15, fq = ln >> 4;
              const bf16_t* src = M + 5 * MSZ + (16 * a + fr) * MP + 32 * s2 + 4 * fq;
              const u32x2 lo = *(const u32x2*)src, hi = *(const u32x2*)(src + 16);
              Pg[as * 64 + ln] = (u32x4){lo.x, lo.y, hi.x, hi.y}; }
            if (latent) {
                u32x4* Wg = (u32x4*)(p.ws + OFF_WYT) + ((size_t)((c - 4) * 8 + h) * 2 + dir) * 512;
                const int row = tid >> 3, ck = tid & 7; __builtin_nontemporal_store(*(const u32x4*)(M + 6 * MSZ + row * MP + ck * 8), Wg + tid);
            }
        }
        if (grp == 0) {
            f32x16 acc = mm32<true, true>(M + 7 * MSZ, xq, sVT, yq, zero16(), lane);
            store_acc(M + 12 * MSZ, xq, yq, acc, lane, [](float v, int, int) { return v; });
        } else {
            f32x16 acc = mm32<true, true>(M + 9 * MSZ, xq, sVT, yq, zero16(), lane);
            store_acc(M + 13 * MSZ, xq, yq, acc, lane, [](float v, int, int) { return v; });
        }
        __syncthreads();
        {
            u32x2* Qg = (u32x2*)(p.ws + OFF_Q) + ((size_t)chain * NCH + npos) * 1024;
#pragma unroll
            for (int i = 0; i < 2; ++i) {
                const int item = tid + NTH * i, ln = item & 63, wa = item >> 6, wi = wa >> 2, a = wa & 3, fr = ln & 15, fq = ln >> 4;
                Qg[item] = *(const u32x2*)(M + 12 * MSZ + (16 * wi + fr) * MP + 16 * a + 4 * fq);
            }
            if (latent) {
                u32x2* Yg = (u32x2*)(p.ws + OFF_YL) + ((size_t)((c - 4) * 8 + h) * 2 + dir) * 1024;
#pragma unroll
                for (int i = 0; i < 2; ++i) {
                    const int item = tid + NTH * i, ln = item & 63, wn = item >> 6, wt = wn >> 2, ni = wn & 3, fr = ln & 15, fq = ln >> 4;
                    const bf16_t* row = M + 13 * MSZ + (16 * ni + fr) * MP;
                    u32x2 v;
                    if (dir == 0) v = *(const u32x2*)(row + 16 * wt + 4 * fq);
                    else { const u32x2 r2 = *(const u32x2*)(row + 60 - 16 * wt - 4 * fq); v = (u32x2){rot16(r2.y), rot16(r2.x)}; }
                    __builtin_nontemporal_store(v, Yg + item);
                }
            }
        }
        __syncthreads();
    }
}

#undef SCANA_ISSUE
#undef XOFF
DI int grp_start(int g) { return g * 16 + (g < 4 ? g : 4); }
DI u32x4 packz(const f32x4& a, const f32x4& b) { return (u32x4){pack2(a[0], a[1]), pack2(a[2], a[3]), pack2(b[0], b[1]), pack2(b[2], b[3])}; }
template <int PASS> DI void chain_run(const Params& p, int chain, int g) {
    constexpr int CPF = PASS == 1 ? 3 : 4;
    const int lane = threadIdx.x & 63, w = threadIdx.x >> 6, fr = lane & 15, fq = lane >> 4;
    const int n0 = grp_start(g), n1 = grp_start(g + 1);
    const u32x4* Pg = (const u32x4*)(p.ws + OFF_P) + (size_t)chain * NCH * 512;
    const u32x2* Qg = (const u32x2*)(p.ws + OFF_Q) + (size_t)chain * NCH * 1024;
    u32x4* Zg = (u32x4*)(p.ws + OFF_Z) + (size_t)chain * NCH * 512;
    f32x4* ZG = (f32x4*)(p.ws + OFF_ZG) + ((size_t)(chain * 16 + g) * 4 + w) * 256;
    f32x4 acc[4], accp[4];
#pragma unroll
    for (int a = 0; a < 4; ++a) {
        if (PASS == 3) acc[a] = ZG[a * 64 + lane]; else acc[a] = (f32x4){0, 0, 0, 0};
#pragma unroll
        for (int e = 0; e < 4; ++e) accp[a][e] = (16 * a + 4 * fq + e == 16 * w + fr) ? 1.f : 0.f;
    }
    u32x4 pf[CPF][8]; u32x2 qf[CPF][4];
#pragma unroll
    for (int st = 0; st < CPF; ++st) if (n0 + st < n1) {
#pragma unroll
        for (int i = 0; i < 8; ++i) pf[st][i] = Pg[(size_t)(n0 + st) * 512 + i * 64 + lane];
#pragma unroll
        for (int a = 0; a < 4; ++a) qf[st][a] = Qg[(size_t)(n0 + st) * 1024 + (w * 4 + a) * 64 + lane];
    }
    for (int nb = n0; nb < n1; nb += CPF) {
#pragma unroll
        for (int st = 0; st < CPF; ++st) {
            const int n = nb + st;
            if (n < n1) {
                const u32x4 (&pc)[8] = pf[st]; const u32x2 (&qc)[4] = qf[st];
                const u32x4 z0 = packz(acc[0], acc[1]), z1 = packz(acc[2], acc[3]);
                if (PASS == 3) { Zg[((size_t)n * 4 + w) * 128 + lane] = z0; Zg[((size_t)n * 4 + w) * 128 + 64 + lane] = z1; }
                const bf16x8 zb0 = __builtin_bit_cast(bf16x8, z0), zb1 = __builtin_bit_cast(bf16x8, z1);
#pragma unroll
                for (int a = 0; a < 4; ++a) {
                    f32x4 ini = {bflo(qc[a].x), bfhi(qc[a].x), bflo(qc[a].y), bfhi(qc[a].y)};
                    ini = __builtin_amdgcn_mfma_f32_16x16x32_bf16(__builtin_bit_cast(bf16x8, pc[2 * a]), zb0, ini, 0, 0, 0);
                    acc[a] = __builtin_amdgcn_mfma_f32_16x16x32_bf16(__builtin_bit_cast(bf16x8, pc[2 * a + 1]), zb1, ini, 0, 0, 0);
                }
                if (PASS == 1) {
                    const bf16x8 yb0 = __builtin_bit_cast(bf16x8, packz(accp[0], accp[1])), yb1 = __builtin_bit_cast(bf16x8, packz(accp[2], accp[3]));
#pragma unroll
                    for (int a = 0; a < 4; ++a) {
                        f32x4 t4 = __builtin_amdgcn_mfma_f32_16x16x32_bf16(__builtin_bit_cast(bf16x8, pc[2 * a]), yb0, (f32x4){0, 0, 0, 0}, 0, 0, 0);
                        accp[a] = __builtin_amdgcn_mfma_f32_16x16x32_bf16(__builtin_bit_cast(bf16x8, pc[2 * a + 1]), yb1, t4, 0, 0, 0);
                    }
                }
                if (n + CPF < n1) {
#pragma unroll
                    for (int i = 0; i < 8; ++i) pf[st][i] = Pg[(size_t)(n + CPF) * 512 + i * 64 + lane];
#pragma unroll
                    for (int a = 0; a < 4; ++a) qf[st][a] = Qg[(size_t)(n + CPF) * 1024 + (w * 4 + a) * 64 + lane];
                }
            }
        }
    }
    if (PASS == 1) {
        f32x4* CQ = (f32x4*)(p.ws + OFF_CQ) + ((size_t)(chain * 16 + g) * 4 + w) * 256;
        bf16_t* CP = (bf16_t*)(p.ws + OFF_CP) + (size_t)(chain * 16 + g) * 4096;
#pragma unroll
        for (int a = 0; a < 4; ++a) {
            CQ[a * 64 + lane] = acc[a];
#pragma unroll
            for (int e = 0; e < 4; ++e) CP[(16 * a + 4 * fq + e) * 64 + 16 * w + fr] = (bf16_t)(pack2(accp[a][e], 0.f) & 0xffffu);
        }
    }
}
DI void chain_groups(const Params& p, int chain, char* lds) {
    const int tid = threadIdx.x, lane = tid & 63, w = tid >> 6, fr = lane & 15, fq = lane >> 4;
    {
        const char* src = (const char*)(p.ws + OFF_CP) + (size_t)chain * 16 * 8192;
#pragma unroll
        for (int i = 0; i < 16; ++i) glds16(src + (size_t)(i * NTH + tid) * 16, lds + (i * NTH + tid) * 16);
        asm volatile("s_waitcnt vmcnt(0)" ::: "memory");
        __syncthreads();
    }
    if (w >= 4) return;
    constexpr int QPF = 4;
    f32x4 acc[4], qf[QPF][4];
#pragma unroll
    for (int a = 0; a < 4; ++a) acc[a] = (f32x4){0, 0, 0, 0};
    const f32x4* CQ = (const f32x4*)(p.ws + OFF_CQ) + ((size_t)chain * 16 * 4 + w) * 256;
#pragma unroll
    for (int st = 0; st < QPF; ++st)
#pragma unroll
        for (int a = 0; a < 4; ++a) qf[st][a] = CQ[(size_t)st * 1024 + a * 64 + lane];
    for (int gb = 0; gb < 16; gb += QPF) {
#pragma unroll
        for (int st = 0; st < QPF; ++st) {
            const int g = gb + st;
            f32x4 qc[4];
#pragma unroll
            for (int a = 0; a < 4; ++a) qc[a] = qf[st][a];
            if (g + QPF < 16) {
#pragma unroll
                for (int a = 0; a < 4; ++a) qf[st][a] = CQ[(size_t)(g + QPF) * 1024 + a * 64 + lane];
            }
            f32x4* ZG = (f32x4*)(p.ws + OFF_ZG) + ((size_t)(chain * 16 + g) * 4 + w) * 256;
#pragma unroll
            for (int a = 0; a < 4; ++a) ZG[a * 64 + lane] = acc[a];
            const bf16x8 zb0 = __builtin_bit_cast(bf16x8, packz(acc[0], acc[1])), zb1 = __builtin_bit_cast(bf16x8, packz(acc[2], acc[3]));
            const bf16_t* CP = (const bf16_t*)lds + g * 4096;
#pragma unroll
            for (int a = 0; a < 4; ++a) {
                const bf16_t* s0 = CP + (16 * a + fr) * 64 + 4 * fq;
                const u32x2 l0 = *(const u32x2*)s0, h0 = *(const u32x2*)(s0 + 16), l1 = *(const u32x2*)(s0 + 32), h1 = *(const u32x2*)(s0 + 48);
                f32x4 ini = __builtin_amdgcn_mfma_f32_16x16x32_bf16(__builtin_bit_cast(bf16x8, (u32x4){l0.x, l0.y, h0.x, h0.y}), zb0, qc[a], 0, 0, 0);
                acc[a] = __builtin_amdgcn_mfma_f32_16x16x32_bf16(__builtin_bit_cast(bf16x8, (u32x4){l1.x, l1.y, h1.x, h1.y}), zb1, ini, 0, 0, 0);
            }
        }
    }
}

DI void phase_scanC(const Params& p, int bid, int nblk, char* lds) {
    const int lane = threadIdx.x & 63, w8 = threadIdx.x >> 6, w = w8 & 3, fr = lane & 15, fq = lane >> 4;
    bf16_t* mix = (bf16_t*)(p.ws + OFF_MIX);
    const float* dot = (const float*)(p.ws + OFF_DOT);
    for (int unit = bid * 2 + (w8 >> 2); unit < 256 * 8; unit += nblk * 2) {
        const int c = 4 + (unit >> 3), h = unit & 7;
        f32x4 y[4];
#pragma unroll
        for (int ni = 0; ni < 4; ++ni) y[ni] = (f32x4){0, 0, 0, 0};
#pragma unroll
        for (int dir = 0; dir < 2; ++dir) {
            const int chain = dir * 8 + h, npos = chain_pos(c, dir);
            const u32x4* Zg = (const u32x4*)(p.ws + OFF_Z) + ((size_t)chain * NCH + npos) * 512;
            const bf16_t* Wg = (const bf16_t*)(p.ws + OFF_WYT) + ((size_t)((c - 4) * 8 + h) * 2 + dir) * 4096;
            const u32x2* Yg = (const u32x2*)(p.ws + OFF_YL) + ((size_t)((c - 4) * 8 + h) * 2 + dir) * 1024;
            const int rho = 16 * w + fr, row = dir ? 63 - rho : rho;
            bf16x8 af[2];
#pragma unroll
            for (int s2 = 0; s2 < 2; ++s2) {
                const u32x2 lo = *(const u32x2*)(Wg + row * 64 + 32 * s2 + 4 * fq), hi = *(const u32x2*)(Wg + row * 64 + 32 * s2 + 16 + 4 * fq);
                af[s2] = __builtin_bit_cast(bf16x8, (u32x4){lo.x, lo.y, hi.x, hi.y});
            }
#pragma unroll
            for (int ni = 0; ni < 4; ++ni) {
                const u32x2 yl = __builtin_nontemporal_load(Yg + (w * 4 + ni) * 64 + lane);
                f32x4 acc = {bflo(yl.x), bfhi(yl.x), bflo(yl.y), bfhi(yl.y)};
                acc = __builtin_amdgcn_mfma_f32_16x16x32_bf16(af[0], __builtin_bit_cast(bf16x8, __builtin_nontemporal_load(Zg + (ni * 2 + 0) * 64 + lane)), acc, 0, 0, 0);
                acc = __builtin_amdgcn_mfma_f32_16x16x32_bf16(af[1], __builtin_bit_cast(bf16x8, __builtin_nontemporal_load(Zg + (ni * 2 + 1) * 64 + lane)), acc, 0, 0, 0);
                y[ni] += acc;
            }
        }
        float* ty = (float*)lds + w8 * (16 * 68);
#pragma unroll
        for (int ni = 0; ni < 4; ++ni)
#pragma unroll
            for (int e = 0; e < 4; ++e) ty[(4 * fq + e) * 68 + 16 * ni + fr] = y[ni][e];
        asm volatile("s_waitcnt lgkmcnt(0)" ::: "memory"); __builtin_amdgcn_wave_barrier();
        {
            const int tl = lane >> 2, seg = lane & 3, t = (c - 4) * 64 + 16 * w + tl, g = t + CTX, cch = h * 64 + 16 * seg;
            float yv[16];
#pragma unroll
            for (int q = 0; q < 4; ++q) { const f32x4 v4 = *(const f32x4*)(ty + tl * 68 + 16 * seg + 4 * q); yv[4 * q] = v4[0]; yv[4 * q + 1] = v4[1]; yv[4 * q + 2] = v4[2]; yv[4 * q + 3] = v4[3]; }
            float sm = 0.f;
#pragma unroll
            for (int j = 0; j < 16; ++j) sm += yv[j];
            sm += __shfl_xor(sm, 1, 64); sm += __shfl_xor(sm, 2, 64);
            const float mean = sm * (1.f / 64.f);
            float q2 = 0.f;
#pragma unroll
            for (int j = 0; j < 16; ++j) { const float d = yv[j] - mean; q2 += d * d; }
            q2 += __shfl_xor(q2, 1, 64); q2 += __shfl_xor(q2, 2, 64);
            const float rs = rsqrtf(q2 * (1.f / 64.f) + 64e-5f);
            const float bon = dot[((size_t)g * 8 + h) * 2] + dot[((size_t)g * 8 + h) * 2 + 1];
            float vv[16], gg[16], o[16];
            unpack8(*(const u32x4*)((const bf16_t*)(p.ws + OFF_V) + (size_t)t * DR + cch), vv); unpack8(*(const u32x4*)((const bf16_t*)(p.ws + OFF_V) + (size_t)t * DR + cch + 8), vv + 8);
            unpack8(*(const u32x4*)((const bf16_t*)(p.ws + OFF_G) + (size_t)t * DR + cch), gg); unpack8(*(const u32x4*)((const bf16_t*)(p.ws + OFF_G) + (size_t)t * DR + cch + 8), gg + 8);
#pragma unroll
            for (int q = 0; q < 4; ++q) {
                const f32x4 gw = *(const f32x4*)(p.gn_w + cch + 4 * q), gb = *(const f32x4*)(p.gn_b + cch + 4 * q);
#pragma unroll
                for (int j = 0; j < 4; ++j) o[4 * q + j] = ((yv[4 * q + j] - mean) * rs * gw[j] + gb[j] + bon * vv[4 * q + j]) * gg[4 * q + j];
            }
            *(u32x4*)(mix + (size_t)t * D + cch) = pack8(o); *(u32x4*)(mix + (size_t)t * D + cch + 8) = pack8(o + 8);
        }
        __builtin_amdgcn_wave_barrier();
    }
}

struct EpiX2 { float* o; const float* x; const float* gt; const float* rowtab; const float* coltab; int row0, col0;
    DI f32x16 pre(const f32x16& a, const f32x16&) const { return a; }
    DI void post(int r, int c, const f32x4& v) const {
        const int t = row0 + r, d = col0 + c;
        const float* pt = d < 512 ? rowtab + (t >> 6) * 512 + d : coltab + (t & 63) * 512 + (d - 512);
        const f32x4 xv = __builtin_nontemporal_load((const f32x4*)(x + (size_t)t * D + d)), pv = *(const f32x4*)pt, gv = *(const f32x4*)(gt + d);
        const __amdgpu_buffer_rsrc_t rsrc = __builtin_amdgcn_make_buffer_rsrc((void*)o, (short)0, (int)((size_t)S * D * 4), 0x00020000);
        __builtin_amdgcn_raw_buffer_store_b128(__builtin_bit_cast(u32x4, xv + pv + gv * v), rsrc, (unsigned)(t * D + d) * 4u, 0, 16); } };
struct EpiNull { DI f32x16 pre(const f32x16& a, const f32x16&) const { return a; } DI void post(int, int, const f32x4& v) const { asm volatile("" :: "v"(v)); } };
DI void phase_g2_null(const Params& p, int bid, int nblk, char* lds) {
    const bf16_t* mix = (const bf16_t*)(p.ws + OFF_MIX);
    const XcdOrder ord(bid, nblk, 64 * 4);
    for (int i = 0, q; (q = ord.item(i)) >= 0; ++i) {
        int tm, tn; tile_rc(q, 64, 4, tm, tn);
        PlainA al{mix + (size_t)tm * 256 * D, D};
        EpiNull e;
        gemm8<1, true, 2>(al, (const bf16_t*)(p.ws + OFF_WOUTB) + tn * 256, nullptr, D, D, lds, e);
    }
}
struct PgEpiX2 { static constexpr bool PERM = false, AFTER = true; float* o; const float* x; const float* gt; const float* rowtab; const float* coltab;
    DI void post(int t, int d, const f32x4& v) const {
        const float* pt = d < 512 ? rowtab + (t >> 6) * 512 + d : coltab + (t & 63) * 512 + (d - 512);
        const f32x4 xv = __builtin_nontemporal_load((const f32x4*)(x + (size_t)t * D + d)), pv = *(const f32x4*)pt, gv = *(const f32x4*)(gt + d);
        const __amdgpu_buffer_rsrc_t rsrc = __builtin_amdgcn_make_buffer_rsrc((void*)o, (short)0, (int)((size_t)S * D * 4), 0x00020000);
        __builtin_amdgcn_raw_buffer_store_b128(__builtin_bit_cast(u32x4, xv + pv + gv * v), rsrc, (unsigned)(t * D + d) * 4u, 0, 16); }
    DI void operator()(const f32x4 (&acc)[2][2][4][2], const PgUnit& un, int wr, int wc, int fr, int fq, const LAS int*, const LAS float*) const {
#pragma unroll
        for (int ai = 0; ai < 2; ++ai)
#pragma unroll
            for (int m = 0; m < 4; ++m)
#pragma unroll
                for (int bj = 0; bj < 2; ++bj)
#pragma unroll
                    for (int n = 0; n < 2; ++n) post(un.pm * 256 + ai * 128 + wr * 64 + m * 16 + fr, un.pn * 256 + bj * 128 + wc * 32 + n * 16 + 4 * fq, acc[ai][bj][m][n]);
    }
    DI void after(const f32x4 (&acc)[2][2][4][2], const PgUnit& un, int wr, int wc, int fr, int fq, char* ldsg, int wid, int lane) const {
        float* tile = (float*)ldsg + wid * (64 * 36);
#pragma unroll
        for (int ai = 0; ai < 2; ++ai)
#pragma unroll
            for (int bj = 0; bj < 2; ++bj) {
#pragma unroll
                for (int m = 0; m < 4; ++m)
#pragma unroll
                    for (int n = 0; n < 2; ++n) *(f32x4*)(tile + (16 * m + fr) * 36 + 16 * n + 4 * fq) = acc[ai][bj][m][n];
                asm volatile("s_waitcnt lgkmcnt(0)" ::: "memory"); __builtin_amdgcn_wave_barrier();
#pragma unroll
                for (int ps = 0; ps < 8; ++ps) { const int idx = ps * 64 + lane, row = idx >> 3, ck = idx & 7;
                    post(un.pm * 256 + ai * 128 + wr * 64 + row, un.pn * 256 + bj * 128 + wc * 32 + ck * 4, *(const f32x4*)(tile + row * 36 + ck * 4)); }
                asm volatile("s_waitcnt lgkmcnt(0)" ::: "memory"); __builtin_amdgcn_wave_barrier();
            }
    }
};
DI void phase_g2(const Params& p, int bid, int nblk, char* lds) {
    if ((S / 256) * (D / 256) == nblk) {
        const SchedDense sd{p.ws + OFF_MIX, p.ws + OFF_WOUTT, S / 256, D / 256, D, PgOrder{(S / 256) * (D / 256), nblk, bid}};
        const PgEpiX2 E{(float*)(p.ws + OFF_X2), p.x, (const float*)(p.ws + OFF_MODX) + 2048, (const float*)(p.ws + OFF_ROWTAB), (const float*)(p.ws + OFF_COLTAB)};
        gemm_pg<0>(lds, D, sd, E);
        return;
    }
    const bf16_t* mix = (const bf16_t*)(p.ws + OFF_MIX);
    const XcdOrder ord(bid, nblk, 64 * 4);
    for (int i = 0, q; (q = ord.item(i)) >= 0; ++i) {
        int tm, tn; tile_rc(q, 64, 4, tm, tn);
        PlainA al{mix + (size_t)tm * 256 * D, D};
        EpiX2 e{(float*)(p.ws + OFF_X2), p.x, (const float*)(p.ws + OFF_MODX) + 2048, (const float*)(p.ws + OFF_ROWTAB), (const float*)(p.ws + OFF_COLTAB), tm * 256, tn * 256};
        gemm8<1, true, 2>(al, (const bf16_t*)(p.ws + OFF_WOUTB) + tn * 256, nullptr, D, D, lds, e);
    }
}

DI float router_w(const Params& p, int k, int n) { return n < 4 ? p.w_rg[k * 4 + n] : (n < 36 ? p.w_re[k * 32 + (n - 4)] : 0.f); }
DI void phase_router_prep(const Params& p, int bid, int nblk) {
    const float* modx = (const float*)(p.ws + OFF_MODX);
    float* wp = (float*)(p.ws + OFF_WP); float* b2 = (float*)(p.ws + OFF_B2);
    for (int idx = bid * NTH + threadIdx.x; idx < 64 * 4 * 3 * 64; idx += nblk * NTH) {
        const int ln = idx & 63, r = idx >> 6, nt = r % 3, me = r / 3, e = me & 3, m = me >> 2;
        const int k = 16 * m + 4 * (ln >> 4) + e, n = 16 * nt + (ln & 15);
        wp[idx] = p.norm2_g[k] * (1.f + modx[4096 + k]) * router_w(p, k, n);
    }
    const int lane = threadIdx.x & 63, wv = bid * NWV + (threadIdx.x >> 6);
    if (wv < 36) {
        float sacc = 0.f;
        for (int k = lane; k < D; k += 64) sacc += modx[3072 + k] * router_w(p, k, wv);
        sacc = wave_sum(sacc);
        if (lane == 0) b2[wv] = sacc + (wv < 4 ? p.b_rg[wv] : p.b_re[wv - 4]);
    }
}

DI void convert_T_dyn(const Params& p, int bid, int nblk, unsigned* ctr, float* tile) {
    const int lane = threadIdx.x & 63, kr = lane >> 4, c4 = lane & 15, nl = lane & 7, kp = lane >> 3;
    constexpr int K = D, N = DE, nkb = K >> 6, per = (K >> 6) * (N >> 6);
    const int ufirst = nblk == 256 ? 2048 : 0;
    const int gfirst = ((NT / 256) * (DINP / 256)) % nblk ? 2048 : 0, total = (4096 - gfirst) + (4096 - ufirst), pw = (total + nblk - 1) / nblk, g0 = bid * pw, g1 = (g0 + pw) < total ? (g0 + pw) : total;
#define CTD_CLAIM(g_) do { unsigned c_ = 0; if (lane == 0) c_ = __hip_atomic_fetch_add(ctr, 1u, __ATOMIC_RELAXED, __HIP_MEMORY_SCOPE_WORKGROUP); g_ = g0 + __builtin_amdgcn_readfirstlane((int)c_); } while (0)
#define CTD_ADDR(g_, s_, d_) do { const bool up_ = (g_) >= 4096 - gfirst; const int t_ = up_ ? (g_) - (4096 - gfirst) + ufirst : (g_) + gfirst; const int mat = t_ / per, rem = t_ - mat * per, nb = rem / nkb, kb = rem - nb * nkb; \
        s_ = (up_ ? p.w_up : p.w_gate) + (size_t)mat * K * N + (size_t)(kb * 64 + kr) * N + nb * 64 + 4 * c4; \
        d_ = (bf16_t*)p.out + (up_ ? (size_t)NE * D * DE : 0) + (size_t)mat * K * N + (size_t)(nb * 64 + nl) * K + kb * 64 + 8 * kp; } while (0)
    f32x4 cur[16], nxt[16];
    int g; CTD_CLAIM(g);
    if (g >= g1) return;
    const float* s; bf16_t* d; CTD_ADDR(g, s, d);
#pragma unroll
    for (int j = 0; j < 16; ++j) cur[j] = __builtin_nontemporal_load((const f32x4*)(s + (size_t)(4 * j) * N));
    for (;;) {
        int gn; CTD_CLAIM(gn); const bool more = gn < g1;
        const float* s2 = s; bf16_t* d2 = d;
        if (more) { CTD_ADDR(gn, s2, d2);
#pragma unroll
            for (int j = 0; j < 16; ++j) nxt[j] = __builtin_nontemporal_load((const f32x4*)(s2 + (size_t)(4 * j) * N)); }
#pragma unroll
        for (int j = 0; j < 16; ++j) { float* w = tile + (4 * j + kr) * 66 + 4 * c4; *(f32x2*)w = (f32x2){cur[j][0], cur[j][1]}; *(f32x2*)(w + 2) = (f32x2){cur[j][2], cur[j][3]}; }
        asm volatile("s_waitcnt lgkmcnt(0)" ::: "memory"); __builtin_amdgcn_wave_barrier();
#pragma unroll
        for (int ps = 0; ps < 8; ++ps) { float v[8];
#pragma unroll
            for (int j = 0; j < 8; ++j) v[j] = tile[(8 * kp + j) * 66 + 8 * ps + nl];
            *(u32x4*)(d + (size_t)(8 * ps) * K) = pack8(v); }
        asm volatile("s_waitcnt lgkmcnt(0)" ::: "memory"); __builtin_amdgcn_wave_barrier();
        if (!more) break;
        s = s2; d = d2;
#pragma unroll
        for (int j = 0; j < 16; ++j) cur[j] = nxt[j];
    }
#undef CTD_CLAIM
#undef CTD_ADDR
}
DI void phase_router(const Params& p, int bid, int nblk, char* lds, bool dry = false, bool conv = true) {
    const int lane = threadIdx.x & 63, wid = threadIdx.x >> 6, tr = lane & 15, kq = lane >> 4, pw = wid & 3, half = wid >> 2;
    const float* x2 = (const float*)(p.ws + OFF_X2); const float* modx = (const float*)(p.ws + OFF_MODX);
    const float* wp = (const float*)(p.ws + OFF_WP); const float* b2 = (const float*)(p.ws + OFF_B2);
    bf16_t* h2 = (bf16_t*)(p.ws + OFF_H2); int* cnt = (int*)(p.ws + OFF_CNT); float* gate = (float*)(p.ws + OFF_GATE); int* list = (int*)(p.ws + OFF_LIST); float* glist = (float*)(p.ws + OFF_GLIST);
    float* slog = (float*)lds + pw * (64 * 13);
    volatile float* pex = (volatile float*)lds + pw * (64 * 13);
    volatile unsigned* ctl = (volatile unsigned*)(lds + 13312);
    if (threadIdx.x < 16) ctl[threadIdx.x] = 0u;
    __syncthreads();
    int it = 0;
    for (int task = pw * nblk + bid; task < S / 16; task += nblk * 4, ++it) {
        const int t0 = task * 16;
        f32x4 acc[3];
#pragma unroll
        for (int i = 0; i < 3; ++i) acc[i] = (f32x4){0, 0, 0, 0};
        float ss = 0.f;
        {
            const float* xr = x2 + (size_t)(t0 + tr) * D + 4 * kq + 512 * half;
#pragma unroll 16
            for (int m2 = 0; m2 < 32; ++m2) {
                const int m = 32 * half + m2;
                const f32x4 xv = *(const f32x4*)(xr + 16 * m2);
                ss += xv[0] * xv[0] + xv[1] * xv[1] + xv[2] * xv[2] + xv[3] * xv[3];
#pragma unroll
                for (int e = 0; e < 4; ++e)
#pragma unroll
                    for (int nt = 0; nt < 3; ++nt) acc[nt] = __builtin_amdgcn_mfma_f32_16x16x4f32(xv[e], wp[((m * 4 + e) * 3 + nt) * 64 + lane], acc[nt], 0, 0, 0);
            }
        }
        if (half == 1) {
            while (ctl[4 + pw] < (unsigned)it) __builtin_amdgcn_s_sleep(2);
#pragma unroll
            for (int nt = 0; nt < 3; ++nt)
#pragma unroll
                for (int r = 0; r < 4; ++r) pex[lane * 13 + nt * 4 + r] = acc[nt][r];
            pex[lane * 13 + 12] = ss;
            asm volatile("s_waitcnt lgkmcnt(0)" ::: "memory"); __builtin_amdgcn_wave_barrier();
            if (lane == 0) ctl[pw] = (unsigned)(it + 1);
            continue;
        }
        while (ctl[pw] < (unsigned)(it + 1)) __builtin_amdgcn_s_sleep(2);
#pragma unroll
        for (int nt = 0; nt < 3; ++nt)
#pragma unroll
            for (int r = 0; r < 4; ++r) acc[nt][r] += pex[lane * 13 + nt * 4 + r];
        ss += pex[lane * 13 + 12];
        asm volatile("s_waitcnt lgkmcnt(0)" ::: "memory"); __builtin_amdgcn_wave_barrier();
        ss += __shfl_xor(ss, 16, 64); ss += __shfl_xor(ss, 32, 64);
        const float rstd = rsqrtf(ss * (1.f / 1024.f) + 1e-6f);
#pragma unroll
        for (int nt = 0; nt < 3; ++nt)
#pragma unroll
            for (int r = 0; r < 4; ++r) slog[(4 * kq + r) * 49 + 16 * nt + tr] = acc[nt][r];
        asm volatile("s_waitcnt lgkmcnt(0)" ::: "memory"); __builtin_amdgcn_wave_barrier();
        if (lane < 16) {
            const int t = t0 + lane;
            const float* lg = slog + lane * 49;
            const float l0 = rstd * lg[0] + b2[0], l1 = rstd * lg[1] + b2[1], l2 = rstd * lg[2] + b2[2], l3 = rstd * lg[3] + b2[3];
            int grp = 0; float mx = l0;
            if (l1 > mx) { mx = l1; grp = 1; }
            if (l2 > mx) { mx = l2; grp = 2; }
            if (l3 > mx) { mx = l3; grp = 3; }
            const float den = __expf(l0 - mx) + __expf(l1 - mx) + __expf(l2 - mx) + __expf(l3 - mx);
            const float pgrp = 1.f / den;
            int i1 = 0, i2 = -1; float v1 = -3.0e38f, v2 = -3.0e38f;
            for (int n = 0; n < 8; ++n) {
                const float sv = rstd * lg[4 + grp * 8 + n] + b2[4 + grp * 8 + n];
                if (sv > v1) { v2 = v1; i2 = i1; v1 = sv; i1 = n; } else if (sv > v2) { v2 = sv; i2 = n; }
            }
            const float e2 = __expf(v2 - v1), g1 = pgrp / (1.f + e2), g2v = pgrp * e2 / (1.f + e2);
            const int ea = grp * 8 + i1, eb = grp * 8 + i2;
            if (!dry) {
                const int pa = atomicAdd(&cnt[ea], 1), pb = atomicAdd(&cnt[eb], 1);
                list[ea * LCAP + pa] = t * 2; list[eb * LCAP + pb] = t * 2 + 1;
                glist[ea * LCAP + pa] = g1; glist[eb * LCAP + pb] = g2v;
            }
            gate[t * 2] = g1; gate[t * 2 + 1] = g2v;
        }
        asm volatile("s_waitcnt lgkmcnt(0)" ::: "memory"); __builtin_amdgcn_wave_barrier();
        if (lane == 0) ctl[4 + pw] = (unsigned)(it + 1);
        for (int r0 = 0; r0 < 16; r0 += 4) {
            f32x4 xv[4][4];
#pragma unroll
            for (int rr = 0; rr < 4; ++rr)
#pragma unroll
                for (int i = 0; i < 4; ++i) xv[rr][i] = __builtin_nontemporal_load((const f32x4*)(x2 + (size_t)(t0 + r0 + rr) * D + (i * 64 + lane) * 4));
#pragma unroll
            for (int i = 0; i < 4; ++i) {
                const int d = (i * 64 + lane) * 4;
                const f32x4 gg = *(const f32x4*)(p.norm2_g + d), sh = *(const f32x4*)(modx + 3072 + d), sc = *(const f32x4*)(modx + 4096 + d);
#pragma unroll
                for (int rr = 0; rr < 4; ++rr) {
                    const float rs = __shfl(rstd, r0 + rr, 64);
                    f32x4 hv;
#pragma unroll
                    for (int j = 0; j < 4; ++j) hv[j] = (xv[rr][i][j] * rs * gg[j]) * (1.f + sc[j]) + sh[j];
                    u32x2 pk = {pack2(hv[0], hv[1]), pack2(hv[2], hv[3])};
                    *(u32x2*)(h2 + (size_t)(t0 + r0 + rr) * D + d) = pk;
                }
            }
        }
        __builtin_amdgcn_wave_barrier();
    }
    if (conv) convert_T_dyn(p, bid, nblk, (unsigned*)(lds + 13312) + 8, (float*)(lds + 13568) + wid * (64 * 66));
}

DI void moe_tiles_pg(const int* cnt, char* lds) {
    int* tstart = (int*)(lds + PG_STAGE); int* tcnt = (int*)(lds + PG_STAGE + 256);
    if (threadIdx.x == 0) { int acc = 0; for (int e = 0; e < NE; ++e) { tstart[e] = acc; acc += (cnt[e] + 255) >> 8; } tstart[NE] = acc; }
    if (threadIdx.x >= 64 && threadIdx.x < 64 + NE) tcnt[threadIdx.x - 64] = cnt[threadIdx.x - 64];
    __syncthreads();
}
struct SchedMoe { const int* tstart; const int* tcnt; PgOrder ord; const int* list; const float* glist; const char* A; const char* B0; const char* B1; int g3; const unsigned* ready;
    DI int item(int i) const {
        const int U = ord.total, G = ord.G, c = ord.c, pos = ((G & 7) == 0) ? (c & 7) * (G >> 3) + (c >> 3) : c;
        if (g3) { const long q = (long)i * G + pos; return q < U ? (int)q : -1; }
        const int R = U % G, nb = G - R;
        if (i == 0) return pos < U ? pos : -1;
        if (pos < R) return -1;
        const long q = (long)G + (long)(i - 1) * nb + (pos - R);
        return q < U ? (int)q : -1;
    }
    DI bool next(int i, PgUnit& u) const { const int w = item(i); if (w < 0) return false; const int ti = w >> 2; int e = 0; while (e < NE - 1 && tstart[e + 1] <= ti) ++e;
        u.pm = ti; u.pn = w & 3; u.e = e; u.pos0 = (ti - tstart[e]) * 256; u.ne = tcnt[e]; return true; }
    DI const char* aptr(const PgUnit& u) const { return A + (size_t)u.pm * 256 * DE * 2; }
    DI const char* b0(const PgUnit& u) const { return g3 ? B0 + ((size_t)u.e * DE + u.pn * 128) * D * 2 : B0 + ((size_t)u.e * D + u.pn * 256) * DE * 2; }
    DI const char* b1(const PgUnit& u) const { return g3 ? B1 + ((size_t)u.e * DE + u.pn * 128) * D * 2 : B0 + ((size_t)u.e * D + u.pn * 256 + 128) * DE * 2; }
    DI const char* abase() const { return A; }
    DI unsigned rowoff(const PgUnit& u, int R) const { const int pos = u.pos0 + R; const int tok = pos < u.ne ? (list[u.e * LCAP + pos] >> 1) : 0; return (unsigned)tok * (unsigned)(D * 2); }
    DI void rowinfo(const PgUnit& u, int r, int& slot, float& g) const { const int pos = u.pos0 + r; const bool ok = pos < u.ne; slot = ok ? list[u.e * LCAP + pos] : -1; g = ok ? glist[u.e * LCAP + pos] : 0.f; }
    DI void done(const PgUnit& u) const {
        asm volatile("s_waitcnt vmcnt(0)" ::: "memory");
        if ((threadIdx.x & 63) == 0) __hip_atomic_fetch_add((GAS_ unsigned*)ready + 64 * u.pm, 2u, __ATOMIC_RELAXED, __HIP_MEMORY_SCOPE_AGENT);
    }
    DI void a_ready(const PgUnit& u) const {
        if (threadIdx.x < 64) {
            unsigned sp = 0;
            while ((unsigned)__builtin_amdgcn_readfirstlane((int)__hip_atomic_load((GAS_ unsigned*)ready + 64 * u.pm, __ATOMIC_RELAXED, __HIP_MEMORY_SCOPE_AGENT)) < 64u && ++sp < (1u << 22)) __builtin_amdgcn_s_sleep(2);
            __builtin_amdgcn_fence(__ATOMIC_ACQUIRE, "agent");
            asm volatile("s_waitcnt vmcnt(0)" ::: "memory");
        }
        asm volatile("" ::: "memory"); __builtin_amdgcn_s_barrier(); asm volatile("" ::: "memory");
    }
};
struct PgEpiHid { static constexpr bool PERM = true, AFTER = false; bf16_t* hid;
    DI void operator()(const f32x4 (&acc)[2][2][4][2], const PgUnit& un, int wr, int wc, int fr, int fq, const LAS int*, const LAS float*) const {
        const __amdgpu_buffer_rsrc_t rsrc = __builtin_amdgcn_make_buffer_rsrc((void*)hid, (short)0, (int)((size_t)160 * 256 * DE * 2), 0x00020000);
        const int row0 = un.pm * 256 + wr * 64 + fr, col0 = un.pn * 128 + wc * 32 + 8 * fq;
#pragma unroll
        for (int ai = 0; ai < 2; ++ai)
#pragma unroll
            for (int m = 0; m < 4; ++m) { f32x4 h[2];
#pragma unroll
                for (int n = 0; n < 2; ++n)
#pragma unroll
                    for (int j = 0; j < 4; ++j) { const float g = acc[ai][0][m][n][j]; h[n][j] = g * sigmoidf_(g) * acc[ai][1][m][n][j]; }
                __builtin_amdgcn_raw_buffer_store_b128(pack8v(h[0], h[1]), rsrc, (unsigned)((row0 + ai * 128 + m * 16) * DE + col0) * 2u, 0, 16); }
    } };
DI void phase_g3(const Params& p, int bid, int nblk, char* lds) {
    moe_tiles_pg((const int*)(p.ws + OFF_CNT), lds);
    const int* tstart = (const int*)(lds + PG_STAGE);
    const SchedMoe sm{tstart, tstart + 64, PgOrder{tstart[NE] * 4, nblk, bid}, (const int*)(p.ws + OFF_LIST), (const float*)(p.ws + OFF_GLIST), p.ws + OFF_H2, (const char*)p.out, (const char*)p.out + (size_t)NE * D * DE * 2, 1, (const unsigned*)(p.ws + OFF_TCNT)};
    const PgEpiHid E{(bf16_t*)(p.ws + OFF_HID)};
    gemm_pg<1>(lds, D, sm, E);
}
struct PgEpiDown { static constexpr bool PERM = true, AFTER = false; bf16_t* ybuf;
    DI void operator()(const f32x4 (&acc)[2][2][4][2], const PgUnit& un, int wr, int wc, int fr, int fq, const LAS int* stab, const LAS float* gtab) const {
        const int col0 = un.pn * 256 + wc * 32 + 8 * fq;
#pragma unroll
        for (int ai = 0; ai < 2; ++ai)
#pragma unroll
            for (int m = 0; m < 4; ++m) { const int r = ai * 128 + wr * 64 + m * 16 + fr; const int slot = stab[r]; const float g = gtab[r];
                if (slot >= 0) {
#pragma unroll
                    for (int bj = 0; bj < 2; ++bj) *(u32x4*)(ybuf + (size_t)slot * D + col0 + bj * 128) = pack8v(acc[ai][bj][m][0] * g, acc[ai][bj][m][1] * g); } }
    } };
DI void phase_g4(const Params& p, int bid, int nblk, char* lds) {
    moe_tiles_pg((const int*)(p.ws + OFF_CNT), lds);
    const int* tstart = (const int*)(lds + PG_STAGE);
    const SchedMoe sm{tstart, tstart + 64, PgOrder{tstart[NE] * 4, nblk, bid}, (const int*)(p.ws + OFF_LIST), (const float*)(p.ws + OFF_GLIST), p.ws + OFF_HID, p.ws + OFF_WDB, nullptr, 0, (const unsigned*)(p.ws + OFF_TCNT)};
    const PgEpiDown E{(bf16_t*)(p.ws + OFF_YBUF)};
    gemm_pg<2>(lds, DE, sm, E);
}


DI void phase_final(const Params& p, int bid, int nblk) {
    const int lane = threadIdx.x & 63, wid = threadIdx.x >> 6;
    const float* x2 = (const float*)(p.ws + OFF_X2); const float* gt = (const float*)(p.ws + OFF_MODX) + 5120; const bf16_t* yb = (const bf16_t*)(p.ws + OFF_YBUF);
    f32x4 hgt[4], hfg[4];
#pragma unroll
    for (int i = 0; i < 4; ++i) { const int d = (i * 64 + lane) * 4; hgt[i] = *(const f32x4*)(gt + d); hfg[i] = *(const f32x4*)(p.final_g + d); }
    for (int tp = bid * NWV + wid; tp < S / 2; tp += nblk * NWV) {
        f32x4 v[2][4]; float ss[2] = {0.f, 0.f};
        u32x2 ya[2][4], ybv[2][4];
#pragma unroll
        for (int r = 0; r < 2; ++r)
#pragma unroll
            for (int i = 0; i < 4; ++i) {
                const int t = 2 * tp + r, d = (i * 64 + lane) * 4;
                v[r][i] = __builtin_nontemporal_load((const f32x4*)(x2 + (size_t)t * D + d));
                ya[r][i] = __builtin_nontemporal_load((const u32x2*)(yb + (size_t)(2 * t) * D + d)); ybv[r][i] = __builtin_nontemporal_load((const u32x2*)(yb + (size_t)(2 * t + 1) * D + d));
            }
#pragma unroll
        for (int r = 0; r < 2; ++r)
#pragma unroll
            for (int i = 0; i < 4; ++i) {
                const f32x4 g = hgt[i]; const u32x2 a = ya[r][i], b = ybv[r][i];
                v[r][i][0] += g[0] * (bflo(a.x) + bflo(b.x)); v[r][i][1] += g[1] * (bfhi(a.x) + bfhi(b.x));
                v[r][i][2] += g[2] * (bflo(a.y) + bflo(b.y)); v[r][i][3] += g[3] * (bfhi(a.y) + bfhi(b.y));
                ss[r] += v[r][i][0] * v[r][i][0] + v[r][i][1] * v[r][i][1] + v[r][i][2] * v[r][i][2] + v[r][i][3] * v[r][i][3];
            }
#pragma unroll
        for (int r = 0; r < 2; ++r) {
            const float rstd = rsqrtf(wave_sum(ss[r]) * (1.f / 1024.f) + 1e-6f);
#pragma unroll
            for (int i = 0; i < 4; ++i) {
                const int d = (i * 64 + lane) * 4; const f32x4 fg = hfg[i]; f32x4 o;
#pragma unroll
                for (int j = 0; j < 4; ++j) o[j] = v[r][i][j] * rstd * fg[j];
                __builtin_nontemporal_store(o, (f32x4*)(p.out + (size_t)(2 * tp + r) * D + d));
            }
        }
    }
}

#define XB_TMO      128
#define XB_XCNT(j)  (256  + 64 * (j))
#define XB_XSUB(j)  (1280 + 64 * (j))
#define XB_XGEN(j)  (2304 + 64 * (j))
#define XB_TOP      3328
#define XB_TOPGEN   3392
#define XCD_BAR_WORDS 3456
#define XB_SPIN_CAP (1u << 18)
DI unsigned xb_ld(unsigned* p) { return __hip_atomic_load(p, __ATOMIC_RELAXED, __HIP_MEMORY_SCOPE_AGENT); }
DI unsigned xb_add(unsigned* p, unsigned v) { return __hip_atomic_fetch_add(p, v, __ATOMIC_RELAXED, __HIP_MEMORY_SCOPE_AGENT); }
DI unsigned xb_xcc_id() { return (unsigned)__builtin_amdgcn_s_getreg((3 << 11) | 20) & 0xFu; }
#define XB_SPIN(cond, bar) do { unsigned _sp = 0; while (cond) { __builtin_amdgcn_s_sleep(1); \
    if ((++_sp & 255u) == 0u) { if (xb_ld(&(bar)[XB_TMO])) break; if (_sp > XB_SPIN_CAP) { atomicAdd(&(bar)[XB_TMO], 1u); break; } } } } while (0)
struct XcdBarrier { unsigned* bar; unsigned x; volatile LAS unsigned* st; };
DI XcdBarrier xcd_barrier_post(unsigned* bar, volatile LAS unsigned* st) {
    XcdBarrier b; b.bar = bar; b.x = xb_xcc_id(); b.st = st;
    if (threadIdx.x == 0) (void)xb_add(&bar[XB_XCNT(b.x)], 1u);
    return b;
}
DI void xcd_barrier_complete(unsigned* bar, unsigned x, unsigned& nloc, unsigned& nx) {
    const unsigned G = gridDim.x * gridDim.y * gridDim.z;
    unsigned sum, cnt, mine, sp = 0u;
    for (;;) {
        sum = 0u; cnt = 0u; mine = 0u;
#pragma unroll
        for (unsigned j = 0; j < 16; ++j) { const unsigned c = xb_ld(&bar[XB_XCNT(j)]); sum += c; cnt += (c > 0u) ? 1u : 0u; mine = (j == x) ? c : mine; }
        if (sum == G) break;
        __builtin_amdgcn_s_sleep(1);
        if ((++sp & 255u) == 0u) { if (xb_ld(&bar[XB_TMO])) break; if (sp > XB_SPIN_CAP) { atomicAdd(&bar[XB_TMO], 1u); break; } }
    }
    nloc = mine > 0u ? mine : 1u; nx = cnt > 0u ? cnt : 1u;
}
DI void xcd_barrier(const XcdBarrier& b) {
    asm volatile("s_waitcnt vmcnt(0)" ::: "memory");
    __syncthreads();
    if (threadIdx.x == 0) {
        unsigned* bar = b.bar;
        __builtin_amdgcn_s_waitcnt(0);
        unsigned nloc = b.st[0], nx = b.st[1];
        if (nloc == 0u) { xcd_barrier_complete(bar, b.x, nloc, nx); b.st[0] = nloc; b.st[1] = nx; }
        const unsigned old = xb_add(&bar[XB_XSUB(b.x)], 1u);
        const unsigned gen = old / nloc;
        if (old + 1u == (gen + 1u) * nloc) {
            __builtin_amdgcn_fence(__ATOMIC_RELEASE, "agent");
            asm volatile("s_waitcnt vmcnt(0)" ::: "memory");
            const unsigned og = xb_add(&bar[XB_TOP], 1u);
            const unsigned tg = og / nx;
            if (og + 1u == (tg + 1u) * nx) xb_add(&bar[XB_TOPGEN], 1u);
            else XB_SPIN(xb_ld(&bar[XB_TOPGEN]) == tg, bar);
            __builtin_amdgcn_fence(__ATOMIC_ACQUIRE, "agent");
            xb_add(&bar[XB_XGEN(b.x)], 1u);
            asm volatile("s_waitcnt vmcnt(0)" ::: "memory");
        } else {
            XB_SPIN(xb_ld(&bar[XB_XGEN(b.x)]) == gen, bar);
            __builtin_amdgcn_fence(__ATOMIC_ACQUIRE, "agent");
            asm volatile("s_waitcnt vmcnt(0)" ::: "memory");
        }
    }
    __syncthreads();
}

DI void convert_T(const float* __restrict__ src, bf16_t* __restrict__ dst, int K, int N, int task0, int task1, int wv, int nwv, float* tile) {
    const int lane = threadIdx.x & 63, kr = lane >> 4, c4 = lane & 15, nl = lane & 7, kp = lane >> 3;
    const int nkb = K >> 6, nnb = N >> 6, per = nkb * nnb;
    f32x4 cur[16], nxt[16];
    int task = task0 + wv;
    if (task >= task1) return;
#define CT_ADDR(t_, s_, d_) do { const int mat = (t_) / per, rem = (t_) - mat * per, nb = rem / nkb, kb = rem - nb * nkb; \
        s_ = src + (size_t)mat * K * N + (size_t)(kb * 64 + kr) * N + nb * 64 + 4 * c4; d_ = dst + (size_t)mat * K * N + (size_t)(nb * 64 + nl) * K + kb * 64 + 8 * kp; } while (0)
    const float* s; bf16_t* d; CT_ADDR(task, s, d);
#pragma unroll
    for (int j = 0; j < 16; ++j) cur[j] = __builtin_nontemporal_load((const f32x4*)(s + (size_t)(4 * j) * N));
    for (;;) {
        const int tn = task + nwv; const bool more = tn < task1;
        const float* s2 = s; bf16_t* d2 = d;
        if (more) { CT_ADDR(tn, s2, d2);
#pragma unroll
            for (int j = 0; j < 16; ++j) nxt[j] = __builtin_nontemporal_load((const f32x4*)(s2 + (size_t)(4 * j) * N)); }
#pragma unroll
        for (int j = 0; j < 16; ++j) { float* w = tile + (4 * j + kr) * 66 + 4 * c4; *(f32x2*)w = (f32x2){cur[j][0], cur[j][1]}; *(f32x2*)(w + 2) = (f32x2){cur[j][2], cur[j][3]}; }
        asm volatile("s_waitcnt lgkmcnt(0)" ::: "memory"); __builtin_amdgcn_wave_barrier();
#pragma unroll
        for (int ps = 0; ps < 8; ++ps) { float v[8];
#pragma unroll
            for (int j = 0; j < 8; ++j) v[j] = tile[(8 * kp + j) * 66 + 8 * ps + nl];
            __builtin_nontemporal_store(pack8(v), (u32x4*)(d + (size_t)(8 * ps) * K)); }
        asm volatile("s_waitcnt lgkmcnt(0)" ::: "memory"); __builtin_amdgcn_wave_barrier();
        if (!more) break;
        task = tn; s = s2; d = d2;
#pragma unroll
        for (int j = 0; j < 16; ++j) cur[j] = nxt[j];
    }
#undef CT_ADDR
}

DI void convert_perm(const float* __restrict__ src, bf16_t* __restrict__ dst, int row0, int row1, int ncols, int wkr, int nwkr) {
    const int n8 = ncols >> 3; const long total = (long)(row1 - row0) * n8;
    for (long idx0 = wkr; idx0 < total; idx0 += 4L * nwkr) {
        f32x4 lo[4], hi[4]; long off[4];
#pragma unroll
        for (int uu = 0; uu < 4; ++uu) {
            long idx = idx0 + (long)uu * nwkr; idx = idx < total ? idx : total - 1;
            const long k = row0 + idx / n8; const int g8 = (int)(idx % n8), blk = g8 >> 2, q = g8 & 3;
            off[uu] = k * ncols + blk * 32;
            lo[uu] = __builtin_nontemporal_load((const f32x4*)(src + off[uu] + 4 * q)); hi[uu] = __builtin_nontemporal_load((const f32x4*)(src + off[uu] + 16 + 4 * q));
            off[uu] += 8 * q;
        }
#pragma unroll
        for (int uu = 0; uu < 4; ++uu)
            *(u32x4*)(dst + off[uu]) = (u32x4){pack2(lo[uu][0], lo[uu][1]), pack2(lo[uu][2], lo[uu][3]), pack2(hi[uu][0], hi[uu][1]), pack2(hi[uu][2], hi[uu][3])};
    }
}

#ifndef PROBE
#define PROBE 0
#endif
constexpr int MEGA_LDS = SCANA_LDS > (GEMM_LDS + 256) ? SCANA_LDS : (GEMM_LDS + 256);
__global__ void __launch_bounds__(NTH) k_mega(Params p) {
    extern __shared__ __attribute__((aligned(16))) char lds[];
    const int bid = blockIdx.x, nblk = gridDim.x;
    volatile LAS unsigned* st = (volatile LAS unsigned*)(lds + MEGA_LDS);
    if (threadIdx.x < 4) st[threadIdx.x] = 0u;
    __syncthreads();
    const XcdBarrier gb = xcd_barrier_post((unsigned*)(p.ws + OFF_BAR), st);
#define GSYNC() xcd_barrier(gb)
#define CT_TILE ((float*)(lds + 16384) + ((threadIdx.x >> 6) & 3) * (64 * 66))
    phase_p0(p, bid, nblk, lds); GSYNC();
    if (PROBE == 1) { phase_p0(p, bid, nblk, lds); GSYNC(); }
    phase_xn(p, bid, nblk, lds); phase_router_prep(p, bid, nblk); GSYNC();
    if (PROBE == 2) { phase_xn(p, bid, nblk, lds); GSYNC(); }
    phase_g1(p, bid, nblk, lds); GSYNC();
    if (PROBE == 3) { phase_g1(p, bid, nblk, lds); GSYNC(); }
    phase_scanA(p, bid, nblk, lds);
    { const int nx = (NCH * 16) % nblk;
      if (nx == 0 || 2 * nx > nblk) phase_pool(p, bid, nblk); else if (bid >= nx) phase_pool(p, bid - nx, nblk - nx); }
    const bool b1_local = nblk == 256;
    if (b1_local) { __builtin_amdgcn_fence(__ATOMIC_RELEASE, "workgroup"); __syncthreads(); __builtin_amdgcn_fence(__ATOMIC_ACQUIRE, "workgroup"); }
    else GSYNC();
    if (PROBE == 4) { phase_scanA(p, bid, nblk, lds); GSYNC(); }
    if (PROBE == 15) { phase_pool(p, bid, nblk); GSYNC(); }
    if (PROBE == 16) { GSYNC(); GSYNC(); GSYNC(); GSYNC(); }
    if (threadIdx.x < 256) { if (b1_local) chain_run<1>(p, (bid & 1) * 8 + ((bid & 15) >> 1), bid >> 4); else for (int it = bid; it < 256; it += nblk) chain_run<1>(p, it >> 4, it & 15); }
    else if (b1_local) convert_T(p.w_up, (bf16_t*)p.out + (size_t)NE * D * DE, D, DE, 0, 2048, bid * 4 + (threadIdx.x >> 6) - 4, nblk * 4, CT_TILE);
    GSYNC();
    if (PROBE == 22) { if (threadIdx.x < 256) { for (int it = bid; it < 256; it += nblk) chain_run<1>(p, it >> 4, it & 15); }
        else convert_T(p.w_down, (bf16_t*)(p.ws + OFF_WDB), DE, D, 0, 2048, bid * 4 + (threadIdx.x >> 6) - 4, nblk * 4, CT_TILE); GSYNC(); }
    if (PROBE == 5) { if (threadIdx.x < 256) for (int it = bid; it < 256; it += nblk) chain_run<1>(p, it >> 4, it & 15); GSYNC(); }
    if (bid < 16) chain_groups(p, bid, lds);
    else { phase_poolgemm(p, bid - 16, nblk - 16, lds);
        __syncthreads();
        convert_T(p.w_down, (bf16_t*)(p.ws + OFF_WDB), DE, D, 0, 2048, (bid - 16) * NWV + (threadIdx.x >> 6), (nblk - 16) * NWV, (float*)(lds + 16384) + (threadIdx.x >> 6) * (64 * 66)); }
    GSYNC();
    if (PROBE == 6) { if (bid < 16) chain_groups(p, bid, lds); GSYNC(); }
    if (threadIdx.x < 256) { if (b1_local) chain_run<3>(p, (bid & 1) * 8 + ((bid & 15) >> 1), bid >> 4);
        else for (int it = bid; it < 256; it += nblk) chain_run<3>(p, it >> 4, it & 15); }
    else convert_T(p.w_down, (bf16_t*)(p.ws + OFF_WDB), DE, D, 2048, 4096, bid * 4 + (threadIdx.x >> 6) - 4, nblk * 4, CT_TILE);
    GSYNC();
    if (PROBE == 7) { if (threadIdx.x < 256) for (int it = bid; it < 256; it += nblk) chain_run<3>(p, it >> 4, it & 15); GSYNC(); }
    phase_scanC(p, bid, nblk, lds); GSYNC();
    if (PROBE == 8) { phase_scanC(p, bid, nblk, lds); GSYNC(); }
    phase_g2(p, bid, nblk, lds); GSYNC();
    if (PROBE == 9) { phase_g2(p, bid, nblk, lds); GSYNC(); }
    if (PROBE == 14) { phase_g2_null(p, bid, nblk, lds); GSYNC(); }
    if (PROBE == 10) { phase_router(p, bid, nblk, lds, true, false); GSYNC(); }
    if (PROBE == 18) { if (threadIdx.x >= 256) convert_T(p.w_down, (bf16_t*)(p.ws + OFF_WDB), DE, D, 0, 2048, bid * 4 + (threadIdx.x >> 6) - 4, nblk * 4, CT_TILE); GSYNC(); }
    phase_router(p, bid, nblk, lds);
    GSYNC();
    phase_g3(p, bid, nblk, lds);
    phase_g4(p, bid, nblk, lds); GSYNC();
    if (PROBE == 12) { phase_g4(p, bid, nblk, lds); GSYNC(); }
    if (PROBE == 13) { phase_final(p, bid, nblk); GSYNC(); }
    phase_final(p, bid, nblk);
}

extern "C" void kernel_launch(void* const* d_in, const int* in_sizes, int n_in, void* d_out, int out_size, void* d_ws, size_t ws_size, hipStream_t stream) {
    if (ws_size < WS_NEED) { fprintf(stderr, "workspace too small: %zu < %zu\n", ws_size, (size_t)WS_NEED); return; }
    Params p{};
    const float** f = (const float**)&p;
    for (int i = 0; i < 36; ++i) f[i] = (const float*)d_in[i];
    p.out = (float*)d_out; p.ws = (char*)d_ws;
    static int grid_blocks = 0;
    if (!grid_blocks) {
        (void)hipFuncSetAttribute((const void*)k_mega, hipFuncAttributeMaxDynamicSharedMemorySize, MEGA_LDS + 16);
        int dev = 0, cus = 0, per_cu = 0;
        (void)hipGetDevice(&dev);
        (void)hipDeviceGetAttribute(&cus, hipDeviceAttributeMultiprocessorCount, dev);
        (void)hipOccupancyMaxActiveBlocksPerMultiprocessor(&per_cu, k_mega, NTH, MEGA_LDS + 16);
        if (per_cu > 1) per_cu = 1;
        grid_blocks = cus * per_cu;
    }
    (void)hipMemsetAsync((char*)d_ws + OFF_BAR, 0, 16384, stream);
    void* args[] = {&p};
    hipError_t e = hipLaunchCooperativeKernel((const void*)k_mega, dim3(grid_blocks), dim3(NTH), args, MEGA_LDS + 16, stream);
    if (e != hipSuccess) fprintf(stderr, "cooperative launch failed: %s (grid %d)\n", hipGetErrorString(e), grid_blocks);
}
```
